# Optimizing an MI355X kernel written in HIP

```python
import jax, jax.numpy as jnp
from jax import lax
import numpy as np

D_MODEL = 1024
BATCH = 16
SEQ = 2048
DEPTH = 1

CTX_LEN = 256
GRID_W = 64
D_MIX = D_MODEL
HEAD_DIM = 64
D_ATTN = D_MIX // 2
N_Q_HEADS = D_ATTN // HEAD_DIM
N_KV_HEADS = 2
Q_PER_KV = N_Q_HEADS // N_KV_HEADS
D_KV = N_KV_HEADS * HEAD_DIM
D_LRU = D_MIX - D_ATTN
LRU_BLOCKS = 8
LRU_BLOCK = D_LRU // LRU_BLOCKS
CONV_W = 4
CONV_PAD_LEFT = 2
RG_C = 8.0
ROPE_THETA = 10000.0
ROPE_FREQS = HEAD_DIM // 4
Q_BLOCK = 128
D_IN = D_ATTN + 2 * D_KV + 2 * D_LRU
PEER_HEADS = 8
PEER_NKEYS = 128
PEER_N = PEER_NKEYS * PEER_NKEYS
PEER_DKEY = 256
PEER_TOPK = 16
PEER_CHUNK = 128
N_MOD = 6
EPS = 1e-6

kernel_name = "hybrid_rglru_gqa_peer_prefix_dit"


def rmsnorm(x, g):
    x32 = x.astype(jnp.float32)
    y = x32 * lax.rsqrt(jnp.mean(x32 * x32, axis=-1, keepdims=True) + EPS)
    return (y * g.astype(jnp.float32)).astype(x.dtype)


def modulate(h, shift, scale):
    return h * (1.0 + scale) + shift


def split_heads(t, n):
    return t.reshape(t.shape[:-1] + (n, HEAD_DIM))


def group_q(q):
    return q.reshape(q.shape[:2] + (N_KV_HEADS, Q_PER_KV, HEAD_DIM))


def axial_rope(x, row, col):
    inv = ROPE_THETA ** (-jnp.arange(ROPE_FREQS, dtype=jnp.float32) / ROPE_FREQS)
    ang = jnp.stack([row.astype(jnp.float32)[:, None] * inv,
                     col.astype(jnp.float32)[:, None] * inv], axis=1)
    cos = jnp.cos(ang)[None, :, None].astype(x.dtype)
    sin = jnp.sin(ang)[None, :, None].astype(x.dtype)
    xp = x.reshape(x.shape[:-1] + (2, 2, ROPE_FREQS))
    x1, x2 = xp[..., 0, :], xp[..., 1, :]
    out = jnp.stack([x1 * cos - x2 * sin, x1 * sin + x2 * cos], axis=-2)
    return out.reshape(x.shape)


def attend(q, k, v):
    s = jnp.einsum('bqkgd,bskd->bkgqs', q, k).astype(jnp.float32) * (HEAD_DIM ** -0.5)
    p = jax.nn.softmax(s, axis=-1).astype(v.dtype)
    return jnp.einsum('bkgqs,bskd->bqkgd', p, v)


def latent_attention(q, k_all, v_all):
    B, T = q.shape[:2]
    nb = T // Q_BLOCK
    qb = jnp.moveaxis(q.reshape(B, nb, Q_BLOCK, N_KV_HEADS, Q_PER_KV, HEAD_DIM), 1, 0)
    ob = lax.map(lambda qq: attend(qq, k_all, v_all), qb)
    return jnp.moveaxis(ob, 0, 1).reshape(B, T, D_ATTN)


def dwconv(x, w, b):
    T = x.shape[1]
    xp = jnp.pad(x, ((0, 0), (CONV_PAD_LEFT, CONV_W - 1 - CONV_PAD_LEFT), (0, 0)))
    return sum(xp[:, j:j + T] * w[j] for j in range(CONV_W)) + b


def rglru_coeffs(x, wa, ba, wi, bi, lam):
    xb = x.reshape(x.shape[:2] + (LRU_BLOCKS, LRU_BLOCK))
    r = jax.nn.sigmoid(jnp.einsum('btni,nij->btnj', xb, wa).reshape(x.shape) + ba)
    i = jax.nn.sigmoid(jnp.einsum('btni,nij->btnj', xb, wi).reshape(x.shape) + bi)
    log_a = -RG_C * r.astype(jnp.float32) * jax.nn.softplus(-lam.astype(jnp.float32))
    a = jnp.exp(log_a)
    b = jnp.sqrt(jnp.maximum(-jnp.expm1(2.0 * log_a), 0.0)) * (i * x).astype(jnp.float32)
    return a, b


def linear_scan(a, b, reverse):
    def combine(l, r):
        return l[0] * r[0], r[0] * l[1] + r[1]
    return lax.associative_scan(combine, (a, b), axis=1, reverse=reverse)[1]


def rglru_bidir(xc, xl, wa, ba, wi, bi, lam):
    yc, yl = 0.0, 0.0
    for d, reverse in ((0, False), (1, True)):
        ac, bc = rglru_coeffs(xc, wa[d], ba[d], wi[d], bi[d], lam[d])
        hc = linear_scan(ac, bc, reverse)
        h0 = hc[:, 0] if reverse else hc[:, -1]
        al, bl = rglru_coeffs(xl, wa[d], ba[d], wi[d], bi[d], lam[d])
        edge = -1 if reverse else 0
        bl = bl.at[:, edge].add(al[:, edge] * h0)
        hl = linear_scan(al, bl, reverse)
        yc = yc + hc
        yl = yl + hl
    return yc.astype(xc.dtype), yl.astype(xl.dtype)


def peer(h, wq, subkeys, u, v):
    shp = h.shape
    chunks = h.reshape(-1, PEER_CHUNK, D_MODEL)

    def one(xc):
        q = (xc @ wq).reshape(PEER_CHUNK, PEER_HEADS, 2, PEER_DKEY // 2)
        s = jnp.einsum('nhpd,hpkd->nhpk', q, subkeys).astype(jnp.float32)
        s1, i1 = lax.top_k(s[:, :, 0], PEER_TOPK)
        s2, i2 = lax.top_k(s[:, :, 1], PEER_TOPK)
        cand_s = (s1[..., :, None] + s2[..., None, :]).reshape(PEER_CHUNK, PEER_HEADS, PEER_TOPK * PEER_TOPK)
        cand_i = (i1[..., :, None] * PEER_NKEYS + i2[..., None, :]).reshape(PEER_CHUNK, PEER_HEADS, PEER_TOPK * PEER_TOPK)
        top_s, pos = lax.top_k(cand_s, PEER_TOPK)
        idx = jnp.take_along_axis(cand_i, pos, axis=-1)
        g = jax.nn.softmax(top_s, axis=-1).astype(xc.dtype)
        act = jax.nn.gelu(jnp.einsum('nhkd,nd->nhk', u[idx], xc))
        return jnp.einsum('nhk,nhkd->nd', g * act, v[idx])

    return lax.map(one, chunks).reshape(shp)


def setup_inputs(seed: int = 0) -> dict:
    key = jax.random.key(seed)
    ks = jax.random.split(key, 26)
    f32 = jnp.float32

    def nrm(k, shape, scale):
        return jax.random.normal(k, shape, f32) * scale

    def gain(k, n):
        return 1.0 + 0.02 * jax.random.normal(k, (DEPTH, n), f32)

    a0 = jax.random.uniform(ks[25], (DEPTH, 2, D_LRU), f32, 0.9, 0.999)
    rg_lambda = jnp.log(a0) - jnp.log1p(-a0)
    return {
        "x": nrm(ks[0], (BATCH, SEQ, D_MODEL), 1.0),
        "c": nrm(ks[1], (BATCH, D_MODEL), 1.0),
        "ctx": nrm(ks[2], (BATCH, CTX_LEN, D_MODEL), 1.0),
        "c_ctx": nrm(ks[3], (D_MODEL,), 1.0),
        "w_mod": nrm(ks[4], (DEPTH, D_MODEL, N_MOD * D_MODEL), 0.5 * D_MODEL ** -0.5),
        "b_mod": nrm(ks[5], (DEPTH, N_MOD * D_MODEL), 0.01),
        "g_pre_mix": gain(ks[6], D_MODEL),
        "g_post_mix": gain(ks[7], D_MODEL),
        "g_pre_ffn": gain(ks[8], D_MODEL),
        "g_post_ffn": gain(ks[9], D_MODEL),
        "w_in": nrm(ks[10], (DEPTH, D_MODEL, D_IN), D_MODEL ** -0.5),
        "q_norm_g": gain(ks[11], HEAD_DIM),
        "k_norm_g": gain(ks[12], HEAD_DIM),
        "conv_w": nrm(ks[13], (DEPTH, CONV_W, D_LRU), CONV_W ** -0.5),
        "conv_b": nrm(ks[14], (DEPTH, D_LRU), 0.01),
        "rg_wa": nrm(ks[15], (DEPTH, 2, LRU_BLOCKS, LRU_BLOCK, LRU_BLOCK), LRU_BLOCK ** -0.5),
        "rg_ba": nrm(ks[16], (DEPTH, 2, D_LRU), 0.01),
        "rg_wi": nrm(ks[17], (DEPTH, 2, LRU_BLOCKS, LRU_BLOCK, LRU_BLOCK), LRU_BLOCK ** -0.5),
        "rg_bi": nrm(ks[18], (DEPTH, 2, D_LRU), 0.01),
        "rg_lambda": rg_lambda,
        "w_out": nrm(ks[19], (DEPTH, D_MIX, D_MODEL), D_MIX ** -0.5),
        "peer_wq": nrm(ks[20], (DEPTH, D_MODEL, PEER_HEADS * PEER_DKEY), D_MODEL ** -0.5),
        "peer_subkeys": nrm(ks[21], (DEPTH, PEER_HEADS, 2, PEER_NKEYS, PEER_DKEY // 2), (PEER_DKEY // 2) ** -0.5),
        "peer_u": nrm(ks[22], (DEPTH, PEER_N, D_MODEL), D_MODEL ** -0.5),
        "peer_v": nrm(ks[23], (DEPTH, PEER_N, D_MODEL), D_MODEL ** -0.5),
    }


def reference(x, c, ctx, c_ctx, w_mod, b_mod, g_pre_mix, g_post_mix, g_pre_ffn, g_post_ffn,
              w_in, q_norm_g, k_norm_g, conv_w, conv_b, rg_wa, rg_ba, rg_wi, rg_bi, rg_lambda,
              w_out, peer_wq, peer_subkeys, peer_u, peer_v):
    B, T, _ = x.shape
    C = ctx.shape[1]
    ROWS = T // GRID_W
    row = jnp.repeat(jnp.arange(ROWS, dtype=jnp.int32), GRID_W)
    col = jnp.tile(jnp.arange(GRID_W, dtype=jnp.int32), ROWS)
    silu_c = jax.nn.silu(c)
    silu_cc = jax.nn.silu(c_ctx)
    cuts = [D_ATTN, D_ATTN + D_KV, D_ATTN + 2 * D_KV, D_ATTN + 2 * D_KV + D_LRU]

    for l in range(DEPTH):
        last = l == DEPTH - 1
        mod_x = (silu_c @ w_mod[l] + b_mod[l]).reshape(B, N_MOD, 1, D_MODEL)
        mod_c = (silu_cc @ w_mod[l] + b_mod[l]).reshape(N_MOD, 1, D_MODEL)
        sh1, sc1, g1, sh2, sc2, g2 = (mod_x[:, i] for i in range(N_MOD))
        csh1, csc1, cg1, csh2, csc2, cg2 = (mod_c[i] for i in range(N_MOD))

        px = modulate(rmsnorm(x, g_pre_mix[l]), sh1, sc1) @ w_in[l]
        pc = modulate(rmsnorm(ctx, g_pre_mix[l]), csh1, csc1) @ w_in[l]
        qx, kx, vx, lx, zx = jnp.split(px, cuts, axis=-1)
        qc, kc, vc, lc, zc = jnp.split(pc, cuts, axis=-1)

        qx = axial_rope(rmsnorm(split_heads(qx, N_Q_HEADS), q_norm_g[l]), row, col)
        kx = axial_rope(rmsnorm(split_heads(kx, N_KV_HEADS), k_norm_g[l]), row, col)
        kc = rmsnorm(split_heads(kc, N_KV_HEADS), k_norm_g[l])
        vc = split_heads(vc, N_KV_HEADS)
        k_all = jnp.concatenate([kc, kx], axis=1)
        v_all = jnp.concatenate([vc, split_heads(vx, N_KV_HEADS)], axis=1)
        attn_x = latent_attention(group_q(qx), k_all, v_all)

        yc, yl = rglru_bidir(dwconv(lc, conv_w[l], conv_b[l]), dwconv(lx, conv_w[l], conv_b[l]),
                             rg_wa[l], rg_ba[l], rg_wi[l], rg_bi[l], rg_lambda[l])
        lru_x = yl * jax.nn.gelu(zx)

        mix_x = jnp.concatenate([attn_x, lru_x], axis=-1) @ w_out[l]
        x_mid = x + g1 * rmsnorm(mix_x, g_post_mix[l])

        if not last:
            qc = rmsnorm(split_heads(qc, N_Q_HEADS), q_norm_g[l])
            attn_c = attend(group_q(qc), kc, vc).reshape(B, C, D_ATTN)
            lru_c = yc * jax.nn.gelu(zc)
            mix_c = jnp.concatenate([attn_c, lru_c], axis=-1) @ w_out[l]
            ctx = ctx + cg1 * rmsnorm(mix_c, g_post_mix[l])
            hc2 = modulate(rmsnorm(ctx, g_pre_ffn[l]), csh2, csc2)
            ctx = ctx + cg2 * rmsnorm(peer(hc2, peer_wq[l], peer_subkeys[l], peer_u[l], peer_v[l]), g_post_ffn[l])

        hx2 = modulate(rmsnorm(x_mid, g_pre_ffn[l]), sh2, sc2)
        ffn_x = peer(hx2, peer_wq[l], peer_subkeys[l], peer_u[l], peer_v[l])
        x = x_mid + g2 * rmsnorm(ffn_x, g_post_ffn[l])

    return x
```

```cpp
#include <hip/hip_runtime.h>
#include <cstdio>
#include <cstdint>

#ifndef MK_N_LAUNCHES
#define MK_N_LAUNCHES 1
#endif

typedef unsigned short bf16_t;
typedef short bf16x8 __attribute__((ext_vector_type(8)));
typedef float f32x16 __attribute__((ext_vector_type(16)));
typedef float f32x4 __attribute__((ext_vector_type(4)));
typedef float f32x2 __attribute__((ext_vector_type(2)));
typedef unsigned u32x4 __attribute__((ext_vector_type(4)));
typedef unsigned u32x2 __attribute__((ext_vector_type(2)));
#define LAS __attribute__((address_space(3)))

constexpr int DM = 1024, NB = 16, SEQ = 2048, CTX = 256, STOT = SEQ + CTX;
constexpr int NTOK = NB * SEQ;
constexpr int NCTX = NB * CTX;
constexpr int NROWS = NTOK + NCTX;
constexpr int DIN = 1792, DLRU = 512;
constexpr int KOUT = 1536;
constexpr int PEER_N = 16384;
constexpr float EPS = 1e-6f;
constexpr int NTHR = 512;

constexpr size_t al256(size_t x) { return (x + 255) & ~(size_t)255; }
constexpr size_t WS_CTL   = 0;
constexpr size_t CTL_BYTES = 65536;
constexpr size_t WS_MOD   = WS_CTL + CTL_BYTES;
constexpr size_t WS_ROPE  = WS_MOD + al256(17 * 6144 * 4);
constexpr size_t WS_WIN   = WS_ROPE + al256(64 * 16 * 2 * 4);
constexpr size_t WS_WOUT  = WS_WIN + al256((size_t)DIN * DM * 2);
constexpr size_t WS_WQ    = WS_WOUT + al256((size_t)DM * KOUT * 2);
constexpr size_t WS_SUBK  = WS_WQ + al256((size_t)2048 * DM * 2);
constexpr size_t WS_RGW   = WS_SUBK + al256((size_t)8 * 2 * 128 * 128 * 2);
constexpr size_t WS_UT    = WS_RGW + al256((size_t)2 * 8 * 128 * 64 * 2);
constexpr size_t WS_VT    = WS_UT + al256((size_t)PEER_N * DM * 2);
constexpr size_t WS_XN    = WS_VT + al256((size_t)PEER_N * DM * 2);
constexpr size_t WS_Q     = WS_XN + al256((size_t)NROWS * DM * 2);
constexpr size_t WS_K     = WS_Q + al256((size_t)NTOK * 512 * 2);
constexpr size_t WS_VV    = WS_K + al256((size_t)NB * 2 * STOT * 64 * 2);
constexpr size_t WS_L     = WS_VV + al256((size_t)NB * 2 * STOT * 64 * 2);
constexpr size_t WS_ZG    = WS_L + al256((size_t)NB * STOT * DLRU * 2);
constexpr size_t WS_A2    = WS_ZG + al256((size_t)NTOK * DLRU * 2);
constexpr size_t WS_END   = WS_A2 + al256((size_t)NTOK * KOUT * 2);
constexpr size_t WS_MIX   = WS_XN;
constexpr size_t WS_HX2   = WS_A2;
constexpr size_t WS_IDX   = WS_ZG;
constexpr size_t WS_GATE  = WS_ZG + (size_t)NTOK * 128 * 4;
static_assert(WS_MIX + (size_t)NTOK * DM * 4 <= WS_ZG, "MIX overlay must end before ZG");
static_assert(WS_GATE + (size_t)NTOK * 128 * 4 <= WS_A2, "IDX/GATE overlay must end before A2");

typedef __bf16 bf16x2_t __attribute__((ext_vector_type(2)));
__device__ __forceinline__ unsigned pk2(float lo, float hi) { const f32x2 v = {lo, hi}; const bf16x2_t b = __builtin_convertvector(v, bf16x2_t); return __builtin_bit_cast(unsigned, b); }
__device__ __forceinline__ bf16_t f2bf(float f) { return (bf16_t)(pk2(f, 0.f) & 0xffffu); }
__device__ __forceinline__ float bf2f(unsigned h) { return __uint_as_float(h << 16); }
__device__ __forceinline__ float bflo(unsigned w) { return __uint_as_float(w << 16); }
__device__ __forceinline__ float bfhi(unsigned w) { return __uint_as_float(w & 0xffff0000u); }
__device__ __forceinline__ float fast_rcp(float x) { return __builtin_amdgcn_rcpf(x); }
__device__ __forceinline__ float sigmoidf_(float x) { return fast_rcp(1.f + __expf(-x)); }
__device__ __forceinline__ float gelu_tanh(float x) { const float y = 0.7978845608028654f * (x + 0.044715f * x * x * x); return x * fast_rcp(1.f + __expf(-2.f * y)); }
__device__ __forceinline__ float silu_(float x) { return x * sigmoidf_(x); }
__device__ __forceinline__ float wave_sum(float v) {
#pragma unroll
    for (int o = 32; o > 0; o >>= 1) v += __shfl_xor(v, o);
    return v;
}
__device__ __forceinline__ float half_swap_max(float v) { auto rr = __builtin_amdgcn_permlane32_swap(__float_as_uint(v), __float_as_uint(v), false, false); return fmaxf(__uint_as_float(rr[0]), __uint_as_float(rr[1])); }
__device__ __forceinline__ float half_swap_sum(float v) { auto rr = __builtin_amdgcn_permlane32_swap(__float_as_uint(v), __float_as_uint(v), false, false); return __uint_as_float(rr[0]) + __uint_as_float(rr[1]); }
#define MFMA(a, b, c) __builtin_amdgcn_mfma_f32_32x32x16_bf16((a), (b), (c), 0, 0, 0)

#define XB_TMO      128
#define XB_XCNT(j)  (256  + 64 * (j))
#define XB_XSUB(j)  (1280 + 64 * (j))
#define XB_XGEN(j)  (2304 + 64 * (j))
#define XB_TOP      3328
#define XB_TOPGEN   3392
#define XCD_BAR_WORDS 3456
#define XB_SPIN_CAP (1u << 20)
__device__ __forceinline__ unsigned xb_ld(unsigned* p)              { return __hip_atomic_load(p, __ATOMIC_RELAXED, __HIP_MEMORY_SCOPE_AGENT); }
__device__ __forceinline__ unsigned xb_add(unsigned* p, unsigned v) { return __hip_atomic_fetch_add(p, v, __ATOMIC_RELAXED, __HIP_MEMORY_SCOPE_AGENT); }
__device__ __forceinline__ unsigned xb_xcc_id() { return (unsigned)__builtin_amdgcn_s_getreg((3 << 11) | 20) & 0xFu; }
#define XB_SPIN(cond, bar) do { unsigned _sp = 0; while (cond) { __builtin_amdgcn_s_sleep(1); \
    if ((++_sp & 255u) == 0u) { if (xb_ld(&(bar)[XB_TMO])) break; if (_sp > XB_SPIN_CAP) { atomicAdd(&(bar)[XB_TMO], 1u); break; } } } } while (0)
struct XcdBarrier { unsigned* bar; unsigned x; volatile LAS unsigned* st; };
__device__ __forceinline__ XcdBarrier xcd_barrier_post(unsigned* bar, volatile LAS unsigned* st) {
    XcdBarrier b; b.bar = bar; b.x = xb_xcc_id(); b.st = st;
    if (threadIdx.x == 0) (void)xb_add(&bar[XB_XCNT(b.x)], 1u);
    return b;
}
__device__ __forceinline__ void xcd_barrier_complete(unsigned* bar, unsigned x, unsigned& nloc, unsigned& nx) {
    const unsigned G = gridDim.x * gridDim.y * gridDim.z;
    unsigned sum, cnt, mine, sp = 0u;
    for (;;) {
        sum = 0u; cnt = 0u; mine = 0u;
#pragma unroll
        for (unsigned j = 0; j < 16; ++j) { const unsigned c = xb_ld(&bar[XB_XCNT(j)]); sum += c; cnt += (c > 0u) ? 1u : 0u; mine = (j == x) ? c : mine; }
        if (sum == G) break;
        __builtin_amdgcn_s_sleep(1);
        if ((++sp & 255u) == 0u) { if (xb_ld(&bar[XB_TMO])) break; if (sp > XB_SPIN_CAP) { atomicAdd(&bar[XB_TMO], 1u); break; } }
    }
    nloc = mine > 0u ? mine : 1u; nx = cnt > 0u ? cnt : 1u;
}
__device__ __forceinline__ void xcd_barrier(const XcdBarrier& b) {
    asm volatile("s_waitcnt vmcnt(0)" ::: "memory");
    __syncthreads();
    if (threadIdx.x == 0) {
        unsigned* bar = b.bar;
        __builtin_amdgcn_s_waitcnt(0);
        unsigned nloc = b.st[0], nx = b.st[1];
        if (nloc == 0u) { xcd_barrier_complete(bar, b.x, nloc, nx); b.st[0] = nloc; b.st[1] = nx; }
        const unsigned old = xb_add(&bar[XB_XSUB(b.x)], 1u);
        const unsigned gen = old / nloc;
        if (old + 1u == (gen + 1u) * nloc) {
            __builtin_amdgcn_fence(__ATOMIC_RELEASE, "agent");
            asm volatile("s_waitcnt vmcnt(0)" ::: "memory");
            const unsigned og = xb_add(&bar[XB_TOP], 1u);
            const unsigned tg = og / nx;
            if (og + 1u == (tg + 1u) * nx) xb_add(&bar[XB_TOPGEN], 1u);
            else XB_SPIN(xb_ld(&bar[XB_TOPGEN]) == tg, bar);
            __builtin_amdgcn_fence(__ATOMIC_ACQUIRE, "agent");
            xb_add(&bar[XB_XGEN(b.x)], 1u);
            asm volatile("s_waitcnt vmcnt(0)" ::: "memory");
        } else {
            XB_SPIN(xb_ld(&bar[XB_XGEN(b.x)]) == gen, bar);
            __builtin_amdgcn_fence(__ATOMIC_ACQUIRE, "agent");
            asm volatile("s_waitcnt vmcnt(0)" ::: "memory");
        }
    }
    __syncthreads();
}

struct Args { const float* in[25]; float* out; unsigned char* ws; int ph_lo, ph_hi; };
enum { I_X = 0, I_C, I_CTX, I_CCTX, I_WMOD, I_BMOD, I_GPREMIX, I_GPOSTMIX, I_GPREFFN, I_GPOSTFFN, I_WIN, I_QNG, I_KNG, I_CONVW, I_CONVB,
       I_RGWA, I_RGBA, I_RGWI, I_RGBI, I_RGLAM, I_WOUT, I_PWQ, I_PSUBK, I_PU, I_PV };

__device__ __forceinline__ void tr_tile(const float* __restrict__ src, int lds_, int sr0, int sc0, bf16_t* __restrict__ dst, int ldd, int dr0, int dc0, float* T) {
    const int tid = threadIdx.x;
#pragma unroll
    for (int i = 0; i < 8; ++i) { const int e = tid + NTHR * i, r = e >> 6, c = e & 63; T[r * 65 + c] = src[(size_t)(sr0 + r) * lds_ + sc0 + c]; }
    __syncthreads();
#pragma unroll
    for (int i = 0; i < 8; ++i) { const int e = tid + NTHR * i, c = e >> 6, r = e & 63; dst[(size_t)(dr0 + c) * ldd + dc0 + r] = f2bf(T[r * 65 + c]); }
    __syncthreads();
}

__device__ void phase_prep(const Args& a, char* lds, int vb, int nb) {
    const int tid = threadIdx.x;
    unsigned char* ws = a.ws;
    float* S = (float*)lds;
    float* T = (float*)lds;
    constexpr int N_MOD = 256, N_TIN = 448, N_TOUT = 384, N_TWQ = 512, N_RGW = 32, N_SUBK = 16, N_UV = 512, N_MISC = 1;
    constexpr int O_TIN = N_MOD, O_TOUT = O_TIN + N_TIN, O_TWQ = O_TOUT + N_TOUT, O_RGW = O_TWQ + N_TWQ, O_SUBK = O_RGW + N_RGW, O_UV = O_SUBK + N_SUBK, O_MISC = O_UV + N_UV, N_ALL = O_MISC + N_MISC;
    for (int it = vb; it < N_ALL; it += nb) {
        if (it < O_TIN) {
            for (int e = tid; e < 17 * 1024; e += NTHR) { const int r = e >> 10, k = e & 1023; const float v = (r < 16) ? a.in[I_C][r * 1024 + k] : a.in[I_CCTX][k]; S[e] = silu_(v); }
            __syncthreads();
            const int n0 = it * 24;
            const int cc = tid % 6, kk = tid / 6;
            float acc[17][4];
#pragma unroll
            for (int r = 0; r < 17; ++r) { acc[r][0] = 0.f; acc[r][1] = 0.f; acc[r][2] = 0.f; acc[r][3] = 0.f; }
            if (tid < 510) {
                for (int k = kk; k < 1024; k += 85) {
                    const f32x4 w = *(const f32x4*)(a.in[I_WMOD] + (size_t)k * 6144 + n0 + cc * 4);
#pragma unroll
                    for (int r = 0; r < 17; ++r) { const float s = S[r * 1024 + k]; acc[r][0] += s * w[0]; acc[r][1] += s * w[1]; acc[r][2] += s * w[2]; acc[r][3] += s * w[3]; }
                }
            }
            __syncthreads();
            if (tid < 510) {
#pragma unroll
                for (int r = 0; r < 17; ++r) { f32x4 v = {acc[r][0], acc[r][1], acc[r][2], acc[r][3]}; *(f32x4*)(S + (kk * 17 + r) * 24 + cc * 4) = v; }
            }
            __syncthreads();
            float* mod = (float*)(ws + WS_MOD);
            for (int e = tid; e < 17 * 24; e += NTHR) { const int r = e / 24, j = e % 24; float sum = 0.f;
                for (int q = 0; q < 85; ++q) sum += S[(q * 17 + r) * 24 + j];
                mod[r * 6144 + n0 + j] = sum + a.in[I_BMOD][n0 + j]; }
            __syncthreads();
        } else if (it < O_TOUT) {
            const int t = it - O_TIN, kt = t / 28, nt = t % 28;
            tr_tile(a.in[I_WIN], DIN, kt * 64, nt * 64, (bf16_t*)(ws + WS_WIN), DM, nt * 64, kt * 64, T);
        } else if (it < O_TWQ) {
            const int t = it - O_TOUT, kt = t / 16, nt = t % 16;
            const int sk = (kt < 16) ? kt * 64 : (kt - 16) * 64 + 512;
            tr_tile(a.in[I_WOUT], DM, sk, nt * 64, (bf16_t*)(ws + WS_WOUT), KOUT, nt * 64, kt * 64, T);
        } else if (it < O_RGW) {
            const int t = it - O_TWQ, kt = t / 32, nt = t % 32;
            tr_tile(a.in[I_PWQ], 2048, kt * 64, nt * 64, (bf16_t*)(ws + WS_WQ), DM, nt * 64, kt * 64, T);
        } else if (it < O_SUBK) {
            const int t = it - O_RGW, g = t & 1, dn = t >> 1;
            const float* src = (g == 0 ? a.in[I_RGWA] : a.in[I_RGWI]) + (size_t)dn * 4096;
            tr_tile(src, 64, 0, 0, (bf16_t*)(ws + WS_RGW) + (size_t)dn * 128 * 64 + g * 64 * 64, 64, 0, 0, T);
        } else if (it < O_UV) {
            const int t = it - O_SUBK; const float* src = a.in[I_PSUBK] + (size_t)t * 16384; bf16_t* dst = (bf16_t*)(ws + WS_SUBK) + (size_t)t * 16384;
            for (int e = tid * 4; e < 16384; e += NTHR * 4) { const f32x4 v = *(const f32x4*)(src + e); u32x2 o = {pk2(v[0], v[1]), pk2(v[2], v[3])}; *(u32x2*)(dst + e) = o; }
        } else if (it < O_MISC) {
            const int t = it - O_UV; const bool isv = t >= 256; const int tt = t & 255;
            const float* src = (isv ? a.in[I_PV] : a.in[I_PU]) + (size_t)tt * 65536; bf16_t* dst = (bf16_t*)(ws + (isv ? WS_VT : WS_UT)) + (size_t)tt * 65536;
            for (int e = tid * 8; e < 65536; e += NTHR * 8) { const f32x4 v0 = *(const f32x4*)(src + e), v1 = *(const f32x4*)(src + e + 4);
                u32x4 o = {pk2(v0[0], v0[1]), pk2(v0[2], v0[3]), pk2(v1[0], v1[1]), pk2(v1[2], v1[3])}; *(u32x4*)(dst + e) = o; }
        } else {
            float* rope = (float*)(ws + WS_ROPE);
            for (int e = tid; e < 64 * 16; e += NTHR) { const int pos = e >> 4, f = e & 15; const float inv = powf(10000.f, -(float)f / 16.f); const float ang = (float)pos * inv; rope[e * 2] = cosf(ang); rope[e * 2 + 1] = sinf(ang); }
        }
    }
}

__device__ void phase_xn(const Args& a, int vb, int nb) {
    const int tid = threadIdx.x, lane = tid & 63, wid = tid >> 6;
    const float* mod = (const float*)(a.ws + WS_MOD);
    bf16_t* XN = (bf16_t*)(a.ws + WS_XN);
    const float* g = a.in[I_GPREMIX];
    for (int row = vb * 8 + wid; row < NROWS; row += nb * 8) {
        const float* src; int mrow;
        if (row < NTOK) { src = a.in[I_X] + (size_t)row * DM; mrow = row >> 11; } else { src = a.in[I_CTX] + (size_t)(row - NTOK) * DM; mrow = 16; }
        f32x4 v[4]; float ss = 0.f;
#pragma unroll
        for (int i = 0; i < 4; ++i) { v[i] = *(const f32x4*)(src + i * 256 + lane * 4); ss += v[i][0] * v[i][0] + v[i][1] * v[i][1] + v[i][2] * v[i][2] + v[i][3] * v[i][3]; }
        ss = wave_sum(ss);
        const float rinv = rsqrtf(ss * (1.f / DM) + EPS);
        const float* sh = mod + (size_t)mrow * 6144, *sc = sh + 1024;
#pragma unroll
        for (int i = 0; i < 4; ++i) { const int c = i * 256 + lane * 4;
            const f32x4 gg = *(const f32x4*)(g + c), s1 = *(const f32x4*)(sc + c), s0 = *(const f32x4*)(sh + c);
            float o[4];
#pragma unroll
            for (int j = 0; j < 4; ++j) o[j] = v[i][j] * rinv * gg[j] * (1.f + s1[j]) + s0[j];
            u32x2 w = {pk2(o[0], o[1]), pk2(o[2], o[3])}; *(u32x2*)(XN + (size_t)row * DM + c) = w; }
    }
}

constexpr int G_ROWB = 144;
constexpr int G_STAGE = (256 + 128) * G_ROWB;
constexpr int G_LDS = 2 * G_STAGE;
constexpr int E_PITCH = 272;
__device__ __forceinline__ void gemm_core(f32x16 (&acc)[2][2], const bf16_t* __restrict__ X, int ldx, const bf16_t* __restrict__ Wt, int ldw, int K, char* lds) {
    const int tid = threadIdx.x, lane = tid & 63, wid = tid >> 6, wm = wid & 3, wn = wid >> 2, r32 = lane & 31, hi = lane >> 5;
    const int lrow = tid >> 3, lch = tid & 7;
    const bf16_t* xg = X + (size_t)lrow * ldx + lch * 8;
    const bf16_t* wg = Wt + (size_t)lrow * ldw + lch * 8;
    u32x4 xr[4], wr[2];
#pragma unroll
    for (int ft = 0; ft < 2; ++ft)
#pragma unroll
        for (int tt = 0; tt < 2; ++tt)
#pragma unroll
            for (int r = 0; r < 16; ++r) acc[ft][tt][r] = 0.f;
#define G_LOAD(k0) do { _Pragma("unroll") for (int i = 0; i < 4; ++i) xr[i] = *(const u32x4*)(xg + (size_t)i * 64 * ldx + (k0)); \
                        _Pragma("unroll") for (int i = 0; i < 2; ++i) wr[i] = *(const u32x4*)(wg + (size_t)i * 64 * ldw + (k0)); } while (0)
#define G_WRITE(s) do { char* b_ = lds + (s) * G_STAGE + lrow * G_ROWB + lch * 16; \
                        _Pragma("unroll") for (int i = 0; i < 4; ++i) *(u32x4*)(b_ + i * 64 * G_ROWB) = xr[i]; \
                        _Pragma("unroll") for (int i = 0; i < 2; ++i) *(u32x4*)(b_ + 256 * G_ROWB + i * 64 * G_ROWB) = wr[i]; } while (0)
    const int nk = K >> 6;
    G_LOAD(0); G_WRITE(0); __syncthreads();
    for (int kt = 0; kt < nk; ++kt) {
        if (kt + 1 < nk) G_LOAD((kt + 1) * 64);
        const char* xs = lds + (kt & 1) * G_STAGE + (wm * 64 + r32) * G_ROWB + hi * 16;
        const char* wsb = lds + (kt & 1) * G_STAGE + 256 * G_ROWB + (wn * 64 + r32) * G_ROWB + hi * 16;
#pragma unroll
        for (int ks = 0; ks < 4; ++ks) {
            const bf16x8 a0 = *(const bf16x8*)(wsb + ks * 32), a1 = *(const bf16x8*)(wsb + 32 * G_ROWB + ks * 32);
            const bf16x8 b0 = *(const bf16x8*)(xs + ks * 32), b1 = *(const bf16x8*)(xs + 32 * G_ROWB + ks * 32);
            acc[0][0] = MFMA(a0, b0, acc[0][0]); acc[0][1] = MFMA(a0, b1, acc[0][1]);
            acc[1][0] = MFMA(a1, b0, acc[1][0]); acc[1][1] = MFMA(a1, b1, acc[1][1]);
        }
        if (kt + 1 < nk) G_WRITE((kt + 1) & 1);
        __syncthreads();
    }
#undef G_LOAD
#undef G_WRITE
}
__device__ __forceinline__ void stage_acc(const f32x16 (&acc)[2][2], char* lds) {
    const int tid = threadIdx.x, lane = tid & 63, wid = tid >> 6, wm = wid & 3, wn = wid >> 2, r32 = lane & 31, hi = lane >> 5;
#pragma unroll
    for (int ft = 0; ft < 2; ++ft)
#pragma unroll
        for (int tt = 0; tt < 2; ++tt)
#pragma unroll
            for (int g = 0; g < 4; ++g) {
                u32x2 v = {pk2(acc[ft][tt][4 * g], acc[ft][tt][4 * g + 1]), pk2(acc[ft][tt][4 * g + 2], acc[ft][tt][4 * g + 3])};
                *(u32x2*)(lds + (wm * 64 + tt * 32 + r32) * E_PITCH + (wn * 64 + ft * 32 + g * 8 + hi * 4) * 2) = v;
            }
}

__device__ void phase_inproj(const Args& a, char* lds, int vb, int nb) {
    const int tid = threadIdx.x, lane = tid & 63, wid = tid >> 6, wm = wid & 3, wn = wid >> 2, r32 = lane & 31, hi = lane >> 5;
    unsigned char* ws = a.ws;
    const bf16_t* XN = (const bf16_t*)(ws + WS_XN);
    const bf16_t* WIN = (const bf16_t*)(ws + WS_WIN);
    const float* rope = (const float*)(ws + WS_ROPE);
    bf16_t* Qo = (bf16_t*)(ws + WS_Q); bf16_t* Ko = (bf16_t*)(ws + WS_K); bf16_t* Vo = (bf16_t*)(ws + WS_VV); bf16_t* Lo = (bf16_t*)(ws + WS_L); bf16_t* Zo = (bf16_t*)(ws + WS_ZG);
    constexpr int N_LAT = 128 * 14, N_ALL = N_LAT + 16 * 6;
    for (int it = vb; it < N_ALL; it += nb) {
        int rt, ct;
        if (it < N_LAT) { rt = it / 14; ct = it % 14; } else { const int j = it - N_LAT; rt = 128 + j / 6; ct = 4 + j % 6; }
        const int row0 = rt * 256, col0 = ct * 128;
        f32x16 acc[2][2];
        gemm_core(acc, XN + (size_t)row0 * DM, DM, WIN + (size_t)col0 * DM, DM, DM, lds);
        const bool lat = rt < 128;
        if (ct <= 4) {
            const float* gn = (ct < 4) ? a.in[I_QNG] : a.in[I_KNG];
            const float osc = (ct < 4) ? 0.125f * 1.4426950408889634f : 1.f;
#pragma unroll
            for (int tt = 0; tt < 2; ++tt) {
                float ss = 0.f;
#pragma unroll
                for (int ft = 0; ft < 2; ++ft)
#pragma unroll
                    for (int r = 0; r < 16; ++r) ss += acc[ft][tt][r] * acc[ft][tt][r];
                ss = half_swap_sum(ss);
                const float rinv = rsqrtf(ss * (1.f / 64.f) + EPS);
                const int row = row0 + wm * 64 + tt * 32 + r32, t = row & 2047;
#pragma unroll
                for (int ft = 0; ft < 2; ++ft) {
                    const int pos = (ft == 0) ? (t >> 6) : (t & 63);
#pragma unroll
                    for (int g = 0; g < 2; ++g)
#pragma unroll
                        for (int i = 0; i < 4; ++i) {
                            const int d1 = ft * 32 + g * 8 + hi * 4 + i, d2 = d1 + 16, fi = g * 8 + hi * 4 + i;
                            const float x1 = acc[ft][tt][4 * g + i] * rinv * gn[d1], x2 = acc[ft][tt][4 * (g + 2) + i] * rinv * gn[d2];
                            float o1 = x1, o2 = x2;
                            if (lat) { const f32x2 cs = *(const f32x2*)(rope + (pos * 16 + fi) * 2); o1 = x1 * cs[0] - x2 * cs[1]; o2 = x1 * cs[1] + x2 * cs[0]; }
                            acc[ft][tt][4 * g + i] = o1 * osc; acc[ft][tt][4 * (g + 2) + i] = o2 * osc;
                        }
                }
            }
        } else if (ct >= 10) {
#pragma unroll
            for (int ft = 0; ft < 2; ++ft)
#pragma unroll
                for (int tt = 0; tt < 2; ++tt)
#pragma unroll
                    for (int r = 0; r < 16; ++r) acc[ft][tt][r] = gelu_tanh(acc[ft][tt][r]);
        }
        if (ct == 5) {
#pragma unroll
            for (int tt = 0; tt < 2; ++tt) {
                const int row = row0 + wm * 64 + tt * 32 + r32;
                int b, s; if (lat) { b = row >> 11; s = CTX + (row & 2047); } else { const int rc = row - NTOK; b = rc >> 8; s = rc & 255; }
                bf16_t* vp = Vo + ((size_t)(b * 2 + wn) * 64) * STOT + s;
#pragma unroll
                for (int ft = 0; ft < 2; ++ft)
#pragma unroll
                    for (int r = 0; r < 16; ++r) { const int d = ft * 32 + 8 * (r >> 2) + 4 * hi + (r & 3); vp[(size_t)d * STOT] = f2bf(acc[ft][tt][r]); }
            }
            __syncthreads();
            continue;
        }
        stage_acc(acc, lds);
        __syncthreads();
#pragma unroll
        for (int i = 0; i < 8; ++i) {
            const int c = tid + NTHR * i, tok = c >> 4, ch = c & 15;
            const u32x4 v = *(const u32x4*)(lds + tok * E_PITCH + ch * 16);
            const int row = row0 + tok;
            int b, s, t; if (lat) { b = row >> 11; t = row & 2047; s = CTX + t; } else { const int rc = row - NTOK; b = rc >> 8; t = 0; s = rc & 255; }
            bf16_t* dst;
            if (ct < 4) dst = Qo + ((size_t)(b * 8 + ct * 2 + (ch >> 3)) * SEQ + t) * 64 + (ch & 7) * 8;
            else if (ct == 4) dst = Ko + ((size_t)(b * 2 + (ch >> 3)) * STOT + s) * 64 + (ch & 7) * 8;
            else if (ct < 10) dst = Lo + ((size_t)b * STOT + s) * DLRU + (ct - 6) * 128 + ch * 8;
            else dst = Zo + (size_t)row * DLRU + (ct - 10) * 128 + ch * 8;
            *(u32x4*)dst = v;
        }
        __syncthreads();
    }
}

constexpr int AT_KP = 144, AT_VP = 136, AT_STAGE = 64 * AT_KP + 64 * AT_VP;
__device__ void attn_item(const Args& a, char* lds, int b, int head, int qblk) {
    const int tid = threadIdx.x, lane = tid & 63, wid = tid >> 6, r32 = lane & 31, hi = lane >> 5;
    unsigned char* ws = a.ws;
    const int kvh = head >> 2;
    const bf16_t* Qp = (const bf16_t*)(ws + WS_Q) + ((size_t)(b * 8 + head) * SEQ + qblk * 256 + wid * 32 + r32) * 64 + hi * 8;
    const bf16_t* Kp = (const bf16_t*)(ws + WS_K) + (size_t)(b * 2 + kvh) * STOT * 64;
    const bf16_t* Vp = (const bf16_t*)(ws + WS_VV) + (size_t)(b * 2 + kvh) * 64 * STOT;
    bf16x8 qf[4];
#pragma unroll
    for (int ds = 0; ds < 4; ++ds) qf[ds] = *(const bf16x8*)(Qp + ds * 16);
    const int srow = tid >> 3, sch = tid & 7;
    const bf16_t* kg = Kp + (size_t)srow * 64 + sch * 8;
    const bf16_t* vg = Vp + (size_t)srow * STOT + sch * 8;
    u32x4 kr, vr;
    f32x16 o[2]; float m = -1e30f, lsum = 0.f;
#pragma unroll
    for (int dt = 0; dt < 2; ++dt)
#pragma unroll
        for (int r = 0; r < 16; ++r) o[dt][r] = 0.f;
#define A_LOAD(s0) do { kr = *(const u32x4*)(kg + (size_t)(s0) * 64); vr = *(const u32x4*)(vg + (s0)); } while (0)
#define A_WRITE(st) do { char* kb_ = lds + (st) * AT_STAGE; *(u32x4*)(kb_ + srow * AT_KP + sch * 16) = kr; \
        char* vb_ = kb_ + 64 * AT_KP + srow * AT_VP + sch * 16; *(u32x2*)vb_ = (u32x2){vr[0], vr[1]}; *(u32x2*)(vb_ + 8) = (u32x2){vr[2], vr[3]}; } while (0)
    constexpr int NT = STOT / 64;
    A_LOAD(0); A_WRITE(0); __syncthreads();
    for (int j = 0; j < NT; ++j) {
        if (j + 1 < NT) A_LOAD((j + 1) * 64);
        const char* ks = lds + (j & 1) * AT_STAGE;
        const char* vs = ks + 64 * AT_KP;
        f32x16 st[2];
#pragma unroll
        for (int kt = 0; kt < 2; ++kt) {
#pragma unroll
            for (int r = 0; r < 16; ++r) st[kt][r] = 0.f;
#pragma unroll
            for (int ds = 0; ds < 4; ++ds) { const bf16x8 ka = *(const bf16x8*)(ks + (kt * 32 + r32) * AT_KP + (ds * 16 + hi * 8) * 2); st[kt] = MFMA(ka, qf[ds], st[kt]); }
        }
        float mx = st[0][0];
#pragma unroll
        for (int r = 1; r < 16; ++r) mx = fmaxf(mx, st[0][r]);
#pragma unroll
        for (int r = 0; r < 16; ++r) mx = fmaxf(mx, st[1][r]);
        mx = half_swap_max(mx);
        const float mn = fmaxf(m, mx), alpha = __builtin_amdgcn_exp2f(m - mn); m = mn;
        float ps = 0.f;
#pragma unroll
        for (int kt = 0; kt < 2; ++kt)
#pragma unroll
            for (int r = 0; r < 16; ++r) { const float p = __builtin_amdgcn_exp2f(st[kt][r] - mn); st[kt][r] = p; ps += p; }
        lsum = lsum * alpha + ps;
#pragma unroll
        for (int dt = 0; dt < 2; ++dt)
#pragma unroll
            for (int r = 0; r < 16; ++r) o[dt][r] *= alpha;
#pragma unroll
        for (int kt = 0; kt < 2; ++kt)
#pragma unroll
            for (int s = 0; s < 2; ++s) {
                u32x4 pw = {pk2(st[kt][8 * s], st[kt][8 * s + 1]), pk2(st[kt][8 * s + 2], st[kt][8 * s + 3]), pk2(st[kt][8 * s + 4], st[kt][8 * s + 5]), pk2(st[kt][8 * s + 6], st[kt][8 * s + 7])};
                const bf16x8 pb = *(bf16x8*)&pw;
#pragma unroll
                for (int dt = 0; dt < 2; ++dt) {
                    const char* vp = vs + (dt * 32 + r32) * AT_VP + (kt * 32 + s * 16 + hi * 4) * 2;
                    const u32x2 lo = *(const u32x2*)vp, hh = *(const u32x2*)(vp + 16);
                    u32x4 aw = {lo[0], lo[1], hh[0], hh[1]};
                    o[dt] = MFMA(*(bf16x8*)&aw, pb, o[dt]);
                }
            }
        if (j + 1 < NT) A_WRITE((j + 1) & 1);
        __syncthreads();
    }
#undef A_LOAD
#undef A_WRITE
    lsum = half_swap_sum(lsum);
    const float inv = fast_rcp(lsum);
    bf16_t* outp = (bf16_t*)(ws + WS_A2) + ((size_t)b * SEQ + qblk * 256 + wid * 32 + r32) * KOUT + head * 64;
#pragma unroll
    for (int dt = 0; dt < 2; ++dt)
#pragma unroll
        for (int g = 0; g < 4; ++g) {
            u32x2 v = {pk2(o[dt][4 * g] * inv, o[dt][4 * g + 1] * inv), pk2(o[dt][4 * g + 2] * inv, o[dt][4 * g + 3] * inv)};
            *(u32x2*)(outp + dt * 32 + g * 8 + hi * 4) = v;
        }
}

constexpr int LR_RAW = 0;
constexpr int LR_U   = 33792;
constexpr int LR_BB  = LR_U + 33280;
constexpr int LR_UB  = LR_BB + 33280;
constexpr int LR_WG  = LR_UB + 18432;
constexpr int LR_SEG = LR_WG + 18432;
constexpr int LR_HC  = LR_SEG + 4096;
constexpr int LR_END = LR_HC + 512;
__device__ void lru_item(const Args& a, char* lds, int b, int n, int d) {
    const int tid = threadIdx.x, lane = tid & 63, wid = tid >> 6, r32 = lane & 31, hi = lane >> 5;
    unsigned char* ws = a.ws;
    float* RAW = (float*)(lds + LR_RAW); float* AA = (float*)(lds + LR_RAW); float* U = (float*)(lds + LR_U); float* BB = (float*)(lds + LR_BB);
    char* UB = lds + LR_UB; char* WG = lds + LR_WG; float* SEG = (float*)(lds + LR_SEG); float* HC = (float*)(lds + LR_HC);
    const bf16_t* Lg = (const bf16_t*)(ws + WS_L) + (size_t)b * STOT * DLRU + n * 64;
    const bf16_t* Zg = (const bf16_t*)(ws + WS_ZG) + (size_t)b * SEQ * DLRU + n * 64;
    bf16_t* Og = (bf16_t*)(ws + WS_A2) + (size_t)b * SEQ * KOUT + 512 + d * 512 + n * 64;
    {
        const bf16_t* wsrc = (const bf16_t*)(ws + WS_RGW) + (size_t)(d * 8 + n) * 128 * 64;
#pragma unroll
        for (int i = 0; i < 2; ++i) { const int c = tid + NTHR * i, r = c >> 3, ch = c & 7; *(u32x4*)(WG + r * 144 + ch * 16) = *(const u32x4*)(wsrc + r * 64 + ch * 8); }
        if (tid < 128) HC[tid] = 0.f;
    }
    const int ct = wid & 1, tt = wid >> 1;
    float cba[16], cbi[16], csp[16];
#pragma unroll
    for (int r = 0; r < 16; ++r) { const int c = n * 64 + ct * 32 + 8 * (r >> 2) + 4 * hi + (r & 3);
        cba[r] = a.in[I_RGBA][d * 512 + c]; cbi[r] = a.in[I_RGBI][d * 512 + c];
        const float x = -a.in[I_RGLAM][d * 512 + c]; csp[r] = -8.f * (fmaxf(x, 0.f) + log1pf(__expf(-fabsf(x)))); }
    const int sc = tid & 63, sg = tid >> 6;
    const float cw0 = a.in[I_CONVW][0 * 512 + n * 64 + sc], cw1 = a.in[I_CONVW][1 * 512 + n * 64 + sc], cw2 = a.in[I_CONVW][2 * 512 + n * 64 + sc], cw3 = a.in[I_CONVW][3 * 512 + n * 64 + sc];
    const float cbias = a.in[I_CONVB][n * 64 + sc];
    __syncthreads();
    int par = 0;
    for (int step = 0; step < 18; ++step) {
        const bool isctx = step < 2;
        const int tl = isctx ? (d == 0 ? step : 1 - step) : (d == 0 ? step - 2 : 17 - step);
        const int sb = isctx ? 0 : CTX, sl = isctx ? CTX : SEQ, t0 = tl * 128;
        for (int e = tid; e < 131 * 8; e += NTHR) { const int r = e >> 3, ch = e & 7, t = t0 - 2 + r;
            u32x4 v = {0u, 0u, 0u, 0u}; if (t >= 0 && t < sl) v = *(const u32x4*)(Lg + (size_t)(sb + t) * DLRU + ch * 8);
            float* dst = RAW + r * 64 + ch * 8;
            dst[0] = bflo(v[0]); dst[1] = bfhi(v[0]); dst[2] = bflo(v[1]); dst[3] = bfhi(v[1]); dst[4] = bflo(v[2]); dst[5] = bfhi(v[2]); dst[6] = bflo(v[3]); dst[7] = bfhi(v[3]); }
        __syncthreads();
#pragma unroll
        for (int i = 0; i < 16; ++i) { const int t = sg + 8 * i;
            const float u = cbias + cw0 * RAW[t * 64 + sc] + cw1 * RAW[(t + 1) * 64 + sc] + cw2 * RAW[(t + 2) * 64 + sc] + cw3 * RAW[(t + 3) * 64 + sc];
            U[t * 65 + sc] = u; *(bf16_t*)(UB + t * 144 + sc * 2) = f2bf(u); }
        __syncthreads();
        {
            f32x16 ga, gi;
#pragma unroll
            for (int r = 0; r < 16; ++r) { ga[r] = 0.f; gi[r] = 0.f; }
#pragma unroll
            for (int ks = 0; ks < 4; ++ks) {
                const bf16x8 wa = *(const bf16x8*)(WG + (ct * 32 + r32) * 144 + (ks * 16 + hi * 8) * 2);
                const bf16x8 wi = *(const bf16x8*)(WG + (64 + ct * 32 + r32) * 144 + (ks * 16 + hi * 8) * 2);
                const bf16x8 ub = *(const bf16x8*)(UB + (tt * 32 + r32) * 144 + (ks * 16 + hi * 8) * 2);
                ga = MFMA(wa, ub, ga); gi = MFMA(wi, ub, gi);
            }
            const int t = tt * 32 + r32;
#pragma unroll
            for (int r = 0; r < 16; ++r) { const int c = ct * 32 + 8 * (r >> 2) + 4 * hi + (r & 3);
                const float rr = sigmoidf_(ga[r] + cba[r]), ii = sigmoidf_(gi[r] + cbi[r]);
                const float la = csp[r] * rr, av = __expf(la), mult = sqrtf(fmaxf(1.f - av * av, 0.f));
                const float u = U[t * 65 + c];
                AA[t * 65 + c] = av; BB[t * 65 + c] = mult * ii * u; }
        }
        __syncthreads();
        float av[16], bv[16]; float Ap = 1.f, Bp = 0.f;
#pragma unroll
        for (int k = 0; k < 16; ++k) { const int p = sg * 16 + k, t = d == 0 ? p : 127 - p; av[k] = AA[t * 65 + sc]; bv[k] = BB[t * 65 + sc]; Bp = av[k] * Bp + bv[k]; Ap = av[k] * Ap; }
        SEG[sg * 64 + sc] = Ap; SEG[512 + sg * 64 + sc] = Bp;
        __syncthreads();
        float h = HC[par * 64 + sc];
        for (int s2 = 0; s2 < sg; ++s2) h = SEG[s2 * 64 + sc] * h + SEG[512 + s2 * 64 + sc];
#pragma unroll
        for (int k = 0; k < 16; ++k) { const int p = sg * 16 + k, t = d == 0 ? p : 127 - p; h = av[k] * h + bv[k];
            if (!isctx) { const float gz = bf2f(Zg[(size_t)(t0 + t) * DLRU + sc]); Og[(size_t)(t0 + t) * KOUT + sc] = f2bf(h * gz); } }
        if (sg == 7) HC[(par ^ 1) * 64 + sc] = h;
        par ^= 1;
        __syncthreads();
    }
}

__device__ void phase_mixer(const Args& a, char* lds, int vb, int nb) {
    for (int it = vb; it < 256 + 1024; it += nb) {
        if (it < 256) { lru_item(a, lds, it >> 4, (it >> 1) & 7, it & 1); }
        else { const int at = it - 256, bk = at >> 5, w = at & 31; attn_item(a, lds, bk >> 1, (bk & 1) * 4 + (w >> 3), w & 7); }
        __syncthreads();
    }
}

__device__ void phase_outproj(const Args& a, char* lds, int vb, int nb) {
    const int tid = threadIdx.x, lane = tid & 63, wid = tid >> 6, wm = wid & 3, wn = wid >> 2, r32 = lane & 31, hi = lane >> 5;
    const bf16_t* A2 = (const bf16_t*)(a.ws + WS_A2); const bf16_t* WO = (const bf16_t*)(a.ws + WS_WOUT);
    float* MIX = (float*)(a.ws + WS_MIX);
    for (int it = vb; it < 128 * 8; it += nb) {
        const int rt = it >> 3, ct = it & 7, row0 = rt * 256, col0 = ct * 128;
        f32x16 acc[2][2];
        gemm_core(acc, A2 + (size_t)row0 * KOUT, KOUT, WO + (size_t)col0 * KOUT, KOUT, KOUT, lds);
#pragma unroll
        for (int tt = 0; tt < 2; ++tt) {
            float* rp = MIX + (size_t)(row0 + wm * 64 + tt * 32 + r32) * DM + col0 + wn * 64 + hi * 4;
#pragma unroll
            for (int ft = 0; ft < 2; ++ft)
#pragma unroll
                for (int g = 0; g < 4; ++g) { f32x4 v = {acc[ft][tt][4 * g], acc[ft][tt][4 * g + 1], acc[ft][tt][4 * g + 2], acc[ft][tt][4 * g + 3]}; *(f32x4*)(rp + ft * 32 + g * 8) = v; }
        }
    }
}

__device__ void phase_rowpass(const Args& a, int vb, int nb) {
    const int tid = threadIdx.x, lane = tid & 63, wid = tid >> 6;
    const float* mod = (const float*)(a.ws + WS_MOD);
    const float* MIX = (const float*)(a.ws + WS_MIX);
    bf16_t* HX = (bf16_t*)(a.ws + WS_HX2);
    for (int row = vb * 8 + wid; row < NTOK; row += nb * 8) {
        const int b = row >> 11;
        const float* mrow = mod + (size_t)b * 6144;
        f32x4 mv[4], xv[4]; float ss = 0.f;
#pragma unroll
        for (int i = 0; i < 4; ++i) { mv[i] = *(const f32x4*)(MIX + (size_t)row * DM + i * 256 + lane * 4); xv[i] = *(const f32x4*)(a.in[I_X] + (size_t)row * DM + i * 256 + lane * 4);
            ss += mv[i][0] * mv[i][0] + mv[i][1] * mv[i][1] + mv[i][2] * mv[i][2] + mv[i][3] * mv[i][3]; }
        ss = wave_sum(ss);
        const float rinv = rsqrtf(ss * (1.f / DM) + EPS);
        float s2 = 0.f;
#pragma unroll
        for (int i = 0; i < 4; ++i) { const int c = i * 256 + lane * 4;
            const f32x4 gp = *(const f32x4*)(a.in[I_GPOSTMIX] + c), g1 = *(const f32x4*)(mrow + 2048 + c);
#pragma unroll
            for (int j = 0; j < 4; ++j) { const float xm = xv[i][j] + g1[j] * (mv[i][j] * rinv * gp[j]); xv[i][j] = xm; s2 += xm * xm; }
            *(f32x4*)(a.out + (size_t)row * DM + c) = xv[i]; }
        s2 = wave_sum(s2);
        const float rinv2 = rsqrtf(s2 * (1.f / DM) + EPS);
#pragma unroll
        for (int i = 0; i < 4; ++i) { const int c = i * 256 + lane * 4;
            const f32x4 gf = *(const f32x4*)(a.in[I_GPREFFN] + c), sh = *(const f32x4*)(mrow + 3072 + c), sc = *(const f32x4*)(mrow + 4096 + c);
            float o[4];
#pragma unroll
            for (int j = 0; j < 4; ++j) o[j] = xv[i][j] * rinv2 * gf[j] * (1.f + sc[j]) + sh[j];
            u32x2 w = {pk2(o[0], o[1]), pk2(o[2], o[3])}; *(u32x2*)(HX + (size_t)row * DM + c) = w; }
    }
}

__device__ __forceinline__ int fkey(float f) { const int b = __float_as_int(f); return b ^ ((b >> 31) & 0x7fffffff); }
__device__ __forceinline__ float fval(int k) { return __int_as_float(k ^ ((k >> 31) & 0x7fffffff)); }
#define CE_DESC(x, y) do { const int hi_ = max((x), (y)), lo_ = min((x), (y)); (x) = hi_; (y) = lo_; } while (0)
__device__ __forceinline__ void sort16_desc(int (&v)[16]) {
#pragma unroll
    for (int k = 2; k <= 16; k <<= 1)
#pragma unroll
        for (int j = k >> 1; j > 0; j >>= 1)
#pragma unroll
            for (int i = 0; i < 16; ++i) { const int l = i ^ j; if (l > i) { if ((i & k) == 0) { CE_DESC(v[i], v[l]); } else { CE_DESC(v[l], v[i]); } } }
}
__device__ __forceinline__ void merge16_desc(int (&v)[16]) {
#pragma unroll
    for (int j = 8; j > 0; j >>= 1)
#pragma unroll
        for (int i = 0; i < 16; ++i) { const int l = i ^ j; if (l > i) CE_DESC(v[i], v[l]); }
}
__device__ __forceinline__ void top16_merge(int (&A)[16], const int (&B)[16]) {
#pragma unroll
    for (int i = 0; i < 16; ++i) A[i] = max(A[i], B[15 - i]);
    merge16_desc(A);
}
constexpr int PK_QS = 0;
constexpr int PK_SK = 256 * E_PITCH;
constexpr int PK_ML = G_LDS;
constexpr int PK_X  = PK_ML + 32768;
constexpr int PK_END = PK_X + 8192;
static_assert(PK_SK + 128 * E_PITCH <= G_LDS, "peer staging must fit in the GEMM stage region");
__device__ void phase_peer_topk(const Args& a, char* lds, int vb, int nb) {
    const int tid = threadIdx.x, lane = tid & 63, wid = tid >> 6, wm = wid & 3, wn = wid >> 2, r32 = lane & 31, hi = lane >> 5;
    unsigned char* ws = a.ws;
    const bf16_t* HX = (const bf16_t*)(ws + WS_HX2); const bf16_t* WQ = (const bf16_t*)(ws + WS_WQ); const bf16_t* SUBK = (const bf16_t*)(ws + WS_SUBK);
    int* IDX = (int*)(ws + WS_IDX); float* GATE = (float*)(ws + WS_GATE);
    int* ML = (int*)(lds + PK_ML); int* XB = (int*)(lds + PK_X);
    for (int it = vb; it < 128 * 8; it += nb) {
        const int rt = it >> 3, h = it & 7, row0 = rt * 256;
        for (int p = 0; p < 2; ++p) {
            f32x16 acc[2][2];
            gemm_core(acc, HX + (size_t)row0 * DM, DM, WQ + (size_t)(h * 256 + p * 128) * DM, DM, DM, lds);
            stage_acc(acc, lds + PK_QS);
            {
                const bf16_t* sk = SUBK + (size_t)(h * 2 + p) * 128 * 128;
#pragma unroll
                for (int i = 0; i < 4; ++i) { const int c = tid + NTHR * i, r = c >> 4, ch = c & 15; *(u32x4*)(lds + PK_SK + r * E_PITCH + ch * 16) = *(const u32x4*)(sk + r * 128 + ch * 8); }
            }
            __syncthreads();
#pragma unroll
            for (int ft = 0; ft < 2; ++ft)
#pragma unroll
                for (int tt = 0; tt < 2; ++tt)
#pragma unroll
                    for (int r = 0; r < 16; ++r) acc[ft][tt][r] = 0.f;
#pragma unroll
            for (int ks = 0; ks < 8; ++ks) {
                const bf16x8 a0 = *(const bf16x8*)(lds + PK_SK + (wn * 64 + r32) * E_PITCH + (ks * 16 + hi * 8) * 2), a1 = *(const bf16x8*)(lds + PK_SK + (wn * 64 + 32 + r32) * E_PITCH + (ks * 16 + hi * 8) * 2);
                const bf16x8 b0 = *(const bf16x8*)(lds + PK_QS + (wm * 64 + r32) * E_PITCH + (ks * 16 + hi * 8) * 2), b1 = *(const bf16x8*)(lds + PK_QS + (wm * 64 + 32 + r32) * E_PITCH + (ks * 16 + hi * 8) * 2);
                acc[0][0] = MFMA(a0, b0, acc[0][0]); acc[0][1] = MFMA(a0, b1, acc[0][1]);
                acc[1][0] = MFMA(a1, b0, acc[1][0]); acc[1][1] = MFMA(a1, b1, acc[1][1]);
            }
#pragma unroll
            for (int tt = 0; tt < 2; ++tt) {
                int A[16], B[16];
#pragma unroll
                for (int r = 0; r < 16; ++r) { const int key = wn * 64 + 8 * (r >> 2) + 4 * hi + (r & 3);
                    A[r] = (fkey(acc[0][tt][r]) & ~127) | key; B[r] = (fkey(acc[1][tt][r]) & ~127) | (key + 32); }
                sort16_desc(A); sort16_desc(B); top16_merge(A, B);
#pragma unroll
                for (int r = 0; r < 16; ++r) { auto rr = __builtin_amdgcn_permlane32_swap((unsigned)A[r], (unsigned)A[r], false, false); B[r] = (int)(hi ? rr[0] : rr[1]); }
                top16_merge(A, B);
                const int tok = wm * 64 + tt * 32 + r32;
                if (wn == 1 && hi == 0) {
#pragma unroll
                    for (int r = 0; r < 16; ++r) XB[(wm * 32 + r32) * 16 + r] = A[r];
                }
                __syncthreads();
                if (wn == 0 && hi == 0) {
#pragma unroll
                    for (int r = 0; r < 16; ++r) B[r] = XB[(wm * 32 + r32) * 16 + r];
                    top16_merge(A, B);
#pragma unroll
                    for (int r = 0; r < 16; ++r) ML[(tok * 2 + p) * 16 + r] = A[r];
                }
                __syncthreads();
            }
        }
        if (tid < 256) {
            const int tok = tid;
            int s1[16], s2[16];
#pragma unroll
            for (int r = 0; r < 16; ++r) { s1[r] = ML[(tok * 2 + 0) * 16 + r]; s2[r] = ML[(tok * 2 + 1) * 16 + r]; }
            float f1[16], f2[16];
#pragma unroll
            for (int r = 0; r < 16; ++r) { f1[r] = fval(s1[r] & ~127); f2[r] = fval(s2[r] & ~127); }
            int G0[16], G1[16], G2[16], G3[16];
#pragma unroll
            for (int bb = 0; bb < 16; ++bb) G0[bb] = (fkey(f1[0] + f2[bb]) & ~255) | (0 * 16 + bb);
#pragma unroll
            for (int bb = 0; bb < 8; ++bb) G1[bb] = (fkey(f1[1] + f2[bb]) & ~255) | (1 * 16 + bb);
#pragma unroll
            for (int bb = 0; bb < 5; ++bb) G1[8 + bb] = (fkey(f1[2] + f2[bb]) & ~255) | (2 * 16 + bb);
#pragma unroll
            for (int bb = 0; bb < 3; ++bb) G1[13 + bb] = (fkey(f1[3] + f2[bb]) & ~255) | (3 * 16 + bb);
            G2[0] = (fkey(f1[3] + f2[3]) & ~255) | (3 * 16 + 3);
#pragma unroll
            for (int bb = 0; bb < 3; ++bb) G2[1 + bb] = (fkey(f1[4] + f2[bb]) & ~255) | (4 * 16 + bb);
#pragma unroll
            for (int aa = 5; aa < 8; ++aa)
#pragma unroll
                for (int bb = 0; bb < 2; ++bb) G2[4 + (aa - 5) * 2 + bb] = (fkey(f1[aa] + f2[bb]) & ~255) | (aa * 16 + bb);
#pragma unroll
            for (int aa = 8; aa < 14; ++aa) G2[10 + (aa - 8)] = (fkey(f1[aa] + f2[0]) & ~255) | (aa * 16);
            G3[0] = (fkey(f1[14] + f2[0]) & ~255) | (14 * 16); G3[1] = (fkey(f1[15] + f2[0]) & ~255) | (15 * 16);
#pragma unroll
            for (int r = 2; r < 16; ++r) G3[r] = (int)0x80000000;
            sort16_desc(G0); sort16_desc(G1); sort16_desc(G2); sort16_desc(G3);
            top16_merge(G0, G1); top16_merge(G2, G3); top16_merge(G0, G2);
            float tv[16]; float mx = fval(G0[0] & ~255), sum = 0.f;
#pragma unroll
            for (int r = 0; r < 16; ++r) { tv[r] = __expf(fval(G0[r] & ~255) - mx); sum += tv[r]; }
            const float rs = 1.f / sum;
            const size_t ob = ((size_t)(row0 + tok) * 8 + h) * 16;
#pragma unroll
            for (int r = 0; r < 16; ++r) { const int code = G0[r] & 255, aa = code >> 4, bb = code & 15;
                const int i1 = ML[(tok * 2 + 0) * 16 + aa] & 127, i2 = ML[(tok * 2 + 1) * 16 + bb] & 127;
                IDX[ob + r] = i1 * 128 + i2; GATE[ob + r] = tv[r] * rs; }
        }
        __syncthreads();
    }
}

__device__ __forceinline__ float dot8(const u32x4 a, const u32x4 b, float acc) {
#pragma unroll
    for (int i = 0; i < 4; ++i) { acc = fmaf(bflo(a[i]), bflo(b[i]), acc); acc = fmaf(bfhi(a[i]), bfhi(b[i]), acc); }
    return acc;
}
__device__ void phase_peer_gather(const Args& a, int vb, int nb) {
    const int tid = threadIdx.x, lane = tid & 63, wid = tid >> 6;
    unsigned char* ws = a.ws;
    const bf16_t* HX = (const bf16_t*)(ws + WS_HX2); const bf16_t* UT = (const bf16_t*)(ws + WS_UT); const bf16_t* VT = (const bf16_t*)(ws + WS_VT);
    const int* IDX = (const int*)(ws + WS_IDX); const float* GATE = (const float*)(ws + WS_GATE);
    const float* mod = (const float*)(ws + WS_MOD);
    for (int tok = vb * 8 + wid; tok < NTOK; tok += nb * 8) {
        const u32x4 h0 = *(const u32x4*)(HX + (size_t)tok * DM + lane * 8), h1 = *(const u32x4*)(HX + (size_t)tok * DM + 512 + lane * 8);
        float acc[16];
#pragma unroll
        for (int i = 0; i < 16; ++i) acc[i] = 0.f;
        for (int r = 0; r < 2; ++r) {
            const int er = IDX[(size_t)tok * 128 + r * 64 + lane];
            const float gr = GATE[(size_t)tok * 128 + r * 64 + lane];
            float p[64];
#pragma unroll
            for (int k = 0; k < 64; ++k) {
                const int e = __builtin_amdgcn_readlane(er, k);
                const bf16_t* row = UT + (size_t)e * DM + lane * 8;
                const u32x4 u0 = *(const u32x4*)row, u1 = *(const u32x4*)(row + 512);
                p[k] = dot8(u1, h1, dot8(u0, h0, 0.f));
            }
#pragma unroll
            for (int o = 32; o > 0; o >>= 1) {
                const bool up = (lane & o) != 0;
#pragma unroll
                for (int i = 0; i < o; ++i) { const float send = up ? p[i] : p[i + o], keep = up ? p[i + o] : p[i]; p[i] = keep + __shfl_xor(send, o); }
            }
            const float wv = gr * gelu_tanh(p[0]);
#pragma unroll
            for (int k = 0; k < 64; ++k) {
                const int e = __builtin_amdgcn_readlane(er, k);
                const float wk = __uint_as_float(__builtin_amdgcn_readlane(__float_as_uint(wv), k));
                const bf16_t* row = VT + (size_t)e * DM + lane * 8;
                const u32x4 v0 = *(const u32x4*)row, v1 = *(const u32x4*)(row + 512);
#pragma unroll
                for (int i = 0; i < 4; ++i) { acc[2 * i] = fmaf(wk, bflo(v0[i]), acc[2 * i]); acc[2 * i + 1] = fmaf(wk, bfhi(v0[i]), acc[2 * i + 1]);
                                              acc[8 + 2 * i] = fmaf(wk, bflo(v1[i]), acc[8 + 2 * i]); acc[8 + 2 * i + 1] = fmaf(wk, bfhi(v1[i]), acc[8 + 2 * i + 1]); }
            }
        }
        float ss = 0.f;
#pragma unroll
        for (int i = 0; i < 16; ++i) ss += acc[i] * acc[i];
        ss = wave_sum(ss);
        const float rinv = rsqrtf(ss * (1.f / DM) + EPS);
        const int b = tok >> 11;
        const float* g2 = mod + (size_t)b * 6144 + 5120;
#pragma unroll
        for (int hh = 0; hh < 2; ++hh)
#pragma unroll
            for (int q = 0; q < 2; ++q) { const int c = hh * 512 + lane * 8 + q * 4;
                float* op = a.out + (size_t)tok * DM + c;
                const f32x4 xm = *(const f32x4*)op, gg = *(const f32x4*)(g2 + c), gp = *(const f32x4*)(a.in[I_GPOSTFFN] + c);
                f32x4 o;
#pragma unroll
                for (int j = 0; j < 4; ++j) o[j] = xm[j] + gg[j] * (acc[hh * 8 + q * 4 + j] * rinv * gp[j]);
                *(f32x4*)op = o; }
    }
}

#ifdef DBG_DIGEST
__device__ void phase_digest(const Args& a, int vb, int nb) {
    const bf16_t* A2 = (const bf16_t*)(a.ws + WS_A2);
    const bf16_t* Q = (const bf16_t*)(a.ws + WS_Q); const bf16_t* K = (const bf16_t*)(a.ws + WS_K); const bf16_t* VV = (const bf16_t*)(a.ws + WS_VV);
    const bf16_t* L = (const bf16_t*)(a.ws + WS_L); const bf16_t* ZG = (const bf16_t*)(a.ws + WS_ZG);
    for (size_t e = (size_t)vb * NTHR + threadIdx.x; e < (size_t)NTOK * DM; e += (size_t)nb * NTHR) {
        float v = 0.f;
#if DBG_DIGEST == 3
        const size_t row = e >> 10; const int c = (int)(e & 1023);
        v = bf2f(A2[row * KOUT + c]); if (c < 512) v += bf2f(A2[row * KOUT + 1024 + c]);
#elif DBG_DIGEST == 2
        const size_t h = e % ((size_t)NTOK * 512);
        v = bf2f(Q[h]) + bf2f(ZG[h]) + bf2f(L[e % ((size_t)NB * STOT * 512)]);
        if (e < (size_t)NB * 2 * STOT * 64) v += bf2f(K[e]) + bf2f(VV[e]);
#endif
        a.out[e] = v; }
}
#endif
constexpr int LDS_BYTES = 155648;
constexpr int LDS_BARST = LDS_BYTES - 16;
static_assert(PK_END <= LDS_BARST && LR_END <= LDS_BARST && G_LDS <= LDS_BARST && 17 * 1024 * 4 + 17 * 24 * 4 <= LDS_BARST, "LDS budget");
constexpr int N_PHASES = 8;

__global__ void __launch_bounds__(NTHR, 2) mk_fwd(Args a) {
    extern __shared__ __attribute__((aligned(16))) char lds[];
    const int nb = gridDim.x, bx = blockIdx.x;
    const int vb = (nb % 8 == 0) ? (bx % 8) * (nb / 8) + bx / 8 : bx;
    XcdBarrier bar; bar.bar = (unsigned*)(a.ws + WS_CTL); bar.x = 0; bar.st = (volatile LAS unsigned*)(LAS char*)(lds + LDS_BARST);
    const bool multi = (a.ph_hi - a.ph_lo) > 1;
    if (multi) {
        if (threadIdx.x < 4) ((volatile LAS unsigned*)(LAS char*)(lds + LDS_BARST))[threadIdx.x] = 0u;
        __syncthreads();
        bar = xcd_barrier_post((unsigned*)(a.ws + WS_CTL), (volatile LAS unsigned*)(LAS char*)(lds + LDS_BARST));
    }
#define RUN_PHASE(P, CALL) do { if (a.ph_lo <= (P) && (P) < a.ph_hi) { CALL; if ((P) + 1 < a.ph_hi) xcd_barrier(bar); } } while (0)
#if !defined(ONLY_PHASE) || ONLY_PHASE == 0
    RUN_PHASE(0, phase_prep(a, lds, vb, nb));
#endif
#if !defined(ONLY_PHASE) || ONLY_PHASE == 1
    RUN_PHASE(1, phase_xn(a, vb, nb));
#endif
#if !defined(ONLY_PHASE) || ONLY_PHASE == 2
    RUN_PHASE(2, phase_inproj(a, lds, vb, nb));
#endif
#if (!defined(ONLY_PHASE) || ONLY_PHASE == 3) && !(defined(DBG_DIGEST) && DBG_DIGEST == 2)
    RUN_PHASE(3, phase_mixer(a, lds, vb, nb));
#endif
#ifdef DBG_DIGEST
    if (a.ph_lo <= 4 && 4 < a.ph_hi) phase_digest(a, vb, nb);
    return;
#endif
#if !defined(ONLY_PHASE) || ONLY_PHASE == 4
    RUN_PHASE(4, phase_outproj(a, lds, vb, nb));
#endif
#if !defined(ONLY_PHASE) || ONLY_PHASE == 5
    RUN_PHASE(5, phase_rowpass(a, vb, nb));
#endif
#if !defined(ONLY_PHASE) || ONLY_PHASE == 6
    RUN_PHASE(6, phase_peer_topk(a, lds, vb, nb));
#endif
#if !defined(ONLY_PHASE) || ONLY_PHASE == 7
    RUN_PHASE(7, phase_peer_gather(a, vb, nb));
#endif
}

extern "C" void kernel_launch(void* const* d_in, const int* in_sizes, int n_in, void* d_out, int out_size, void* d_ws, size_t ws_size, hipStream_t stream) {
    static int grid = 0;
    if (grid == 0) {
        if (n_in != 25 || out_size != NTOK * DM || ws_size < WS_END) { fprintf(stderr, "kernel_launch: unexpected shapes (n_in %d, out %d, ws %zu, need %zu)\n", n_in, out_size, ws_size, (size_t)WS_END); grid = -1; return; }
        int dev = 0, cus = 0;
        if (hipGetDevice(&dev) != hipSuccess || hipDeviceGetAttribute(&cus, hipDeviceAttributeMultiprocessorCount, dev) != hipSuccess) { grid = -1; return; }
        if (hipFuncSetAttribute((const void*)mk_fwd, hipFuncAttributeMaxDynamicSharedMemorySize, LDS_BYTES) != hipSuccess) { fprintf(stderr, "kernel_launch: hipFuncSetAttribute failed\n"); grid = -1; return; }
        (void)hipGetLastError();
        grid = cus;
    }
    if (grid < 0) return;
    (void)hipMemsetAsync((char*)d_ws + WS_CTL, 0, CTL_BYTES, stream);
    Args a{};
    for (int i = 0; i < 25; ++i) a.in[i] = (const float*)d_in[i];
    a.out = (float*)d_out; a.ws = (unsigned char*)d_ws;
#if MK_N_LAUNCHES == 1
    a.ph_lo = 0; a.ph_hi = N_PHASES;
    hipLaunchKernelGGL(mk_fwd, dim3(grid), dim3(NTHR), LDS_BYTES, stream, a);
#else
    for (int ph = 0; ph < N_PHASES; ++ph) { a.ph_lo = ph; a.ph_hi = ph + 1; hipLaunchKernelGGL(mk_fwd, dim3(grid), dim3(NTHR), LDS_BYTES, stream, a); }
#endif
}
```

```cpp
#include <hip/hip_runtime.h>
#include <cstdio>
#include <cstdint>

#ifndef MK_N_LAUNCHES
#define MK_N_LAUNCHES 1
#endif

typedef unsigned short bf16_t;
typedef short bf16x8 __attribute__((ext_vector_type(8)));
typedef float f32x16 __attribute__((ext_vector_type(16)));
typedef float f32x4 __attribute__((ext_vector_type(4)));
typedef float f32x2 __attribute__((ext_vector_type(2)));
typedef unsigned u32x4 __attribute__((ext_vector_type(4)));
typedef unsigned u32x2 __attribute__((ext_vector_type(2)));
#define LAS __attribute__((address_space(3)))

constexpr int DM = 1024, NB = 16, SEQ = 2048, CTX = 256, STOT = SEQ + CTX;
constexpr int NTOK = NB * SEQ;
constexpr int NCTX = NB * CTX;
constexpr int NROWS = NTOK + NCTX;
constexpr int DIN = 1792, DLRU = 512;
constexpr int KOUT = 1536;
constexpr int PEER_N = 16384;
constexpr float EPS = 1e-6f;
constexpr int NTHR = 512;

constexpr size_t al256(size_t x) { return (x + 255) & ~(size_t)255; }
constexpr size_t WS_CTL   = 0;
constexpr size_t CTL_BYTES = 65536;
constexpr size_t WS_MOD   = WS_CTL + CTL_BYTES;
constexpr size_t WS_ROPE  = WS_MOD + al256(17 * 6144 * 4);
constexpr size_t WS_WIN   = WS_ROPE + al256(64 * 16 * 2 * 4);
constexpr size_t WS_WOUT  = WS_WIN + al256((size_t)DIN * DM * 2);
constexpr size_t WS_WQ    = WS_WOUT + al256((size_t)DM * KOUT * 2);
constexpr size_t WS_SUBK  = WS_WQ + al256((size_t)2048 * DM * 2);
constexpr size_t WS_RGW   = WS_SUBK + al256((size_t)8 * 2 * 128 * 128 * 2);
constexpr size_t WS_UT    = WS_RGW + al256((size_t)2 * 8 * 128 * 64 * 2);
constexpr size_t WS_VT    = WS_UT + al256((size_t)PEER_N * DM * 2);
constexpr size_t WS_XN    = WS_VT + al256((size_t)PEER_N * DM * 2);
constexpr size_t WS_Q     = WS_XN + al256((size_t)NROWS * DM * 2);
constexpr size_t WS_K     = WS_Q + al256((size_t)NTOK * 512 * 2);
constexpr size_t WS_VV    = WS_K + al256((size_t)NB * 2 * STOT * 64 * 2);
constexpr size_t WS_L     = WS_VV + al256((size_t)NB * 2 * STOT * 64 * 2);
constexpr size_t WS_ZG    = WS_L + al256((size_t)NB * STOT * DLRU * 2);
constexpr size_t WS_A2    = WS_ZG + al256((size_t)NTOK * DLRU * 2);
constexpr size_t WS_END   = WS_A2 + al256((size_t)NTOK * KOUT * 2);
constexpr size_t WS_MIX   = WS_XN;
constexpr size_t WS_HX2   = WS_A2;
constexpr size_t WS_IDX   = WS_ZG;
constexpr size_t WS_GATE  = WS_ZG + (size_t)NTOK * 128 * 4;
static_assert(WS_MIX + (size_t)NTOK * DM * 4 <= WS_ZG, "MIX overlay must end before ZG");
static_assert(WS_GATE + (size_t)NTOK * 128 * 4 <= WS_A2, "IDX/GATE overlay must end before A2");

typedef __bf16 bf16x2_t __attribute__((ext_vector_type(2)));
__device__ __forceinline__ unsigned pk2(float lo, float hi) { const f32x2 v = {lo, hi}; const bf16x2_t b = __builtin_convertvector(v, bf16x2_t); return __builtin_bit_cast(unsigned, b); }
typedef _Float16 h16x2 __attribute__((ext_vector_type(2)));
constexpr float V_SCALE = 64.f;
constexpr float T_SCALE = 256.f;
#ifndef P7_FP8
#define P7_FP8 1
#endif
__device__ __forceinline__ unsigned pkh2(float lo, float hi) { const h16x2 h = {(_Float16)lo, (_Float16)hi}; return __builtin_bit_cast(unsigned, h); }
__device__ __forceinline__ bf16x2_t as_bf2(unsigned x) { return __builtin_bit_cast(bf16x2_t, x); }
__device__ __forceinline__ h16x2 as_h2(unsigned x) { return __builtin_bit_cast(h16x2, x); }
__device__ __forceinline__ bf16_t f2bf(float f) { return (bf16_t)(pk2(f, 0.f) & 0xffffu); }
__device__ __forceinline__ float bf2f(unsigned h) { return __uint_as_float(h << 16); }
__device__ __forceinline__ float bflo(unsigned w) { return __uint_as_float(w << 16); }
__device__ __forceinline__ float bfhi(unsigned w) { return __uint_as_float(w & 0xffff0000u); }
__device__ __forceinline__ float fast_rcp(float x) { return __builtin_amdgcn_rcpf(x); }
__device__ __forceinline__ float sigmoidf_(float x) { return fast_rcp(1.f + __expf(-x)); }
__device__ __forceinline__ float gelu_tanh(float x) { const float y = 0.7978845608028654f * (x + 0.044715f * x * x * x); return x * fast_rcp(1.f + __expf(-2.f * y)); }
__device__ __forceinline__ float silu_(float x) { return x * sigmoidf_(x); }
__device__ __forceinline__ float wave_sum(float v) {
#pragma unroll
    for (int o = 32; o > 0; o >>= 1) v += __shfl_xor(v, o);
    return v;
}
__device__ __forceinline__ float half_swap_max(float v) { auto rr = __builtin_amdgcn_permlane32_swap(__float_as_uint(v), __float_as_uint(v), false, false); return fmaxf(__uint_as_float(rr[0]), __uint_as_float(rr[1])); }
__device__ __forceinline__ float half_swap_sum(float v) { auto rr = __builtin_amdgcn_permlane32_swap(__float_as_uint(v), __float_as_uint(v), false, false); return __uint_as_float(rr[0]) + __uint_as_float(rr[1]); }
#define MFMA(a, b, c) __builtin_amdgcn_mfma_f32_32x32x16_bf16((a), (b), (c), 0, 0, 0)

#define XB_TMO      128
#define XB_XCNT(j)  (256  + 64 * (j))
#define XB_XSUB(j)  (1280 + 64 * (j))
#define XB_XGEN(j)  (2304 + 64 * (j))
#define XB_TOP      3328
#define XB_TOPGEN   3392
#define XCD_BAR_WORDS 3456
#define XB_SPIN_CAP (1u << 20)
__device__ __forceinline__ unsigned xb_ld(unsigned* p)              { return __hip_atomic_load(p, __ATOMIC_RELAXED, __HIP_MEMORY_SCOPE_AGENT); }
__device__ __forceinline__ unsigned xb_add(unsigned* p, unsigned v) { return __hip_atomic_fetch_add(p, v, __ATOMIC_RELAXED, __HIP_MEMORY_SCOPE_AGENT); }
__device__ __forceinline__ unsigned xb_xcc_id() { return (unsigned)__builtin_amdgcn_s_getreg((3 << 11) | 20) & 0xFu; }
#define XB_SPIN(cond, bar) do { unsigned _sp = 0; while (cond) { __builtin_amdgcn_s_sleep(1); \
    if ((++_sp & 255u) == 0u) { if (xb_ld(&(bar)[XB_TMO])) break; if (_sp > XB_SPIN_CAP) { atomicAdd(&(bar)[XB_TMO], 1u); break; } } } } while (0)
struct XcdBarrier { unsigned* bar; unsigned x; volatile LAS unsigned* st; };
__device__ __forceinline__ XcdBarrier xcd_barrier_post(unsigned* bar, volatile LAS unsigned* st) {
    XcdBarrier b; b.bar = bar; b.x = xb_xcc_id(); b.st = st;
    if (threadIdx.x == 0) st[2] = xb_add(&bar[XB_XCNT(b.x)], 1u);
    return b;
}
__device__ __forceinline__ void xcd_barrier_complete(unsigned* bar, unsigned x, unsigned& nloc, unsigned& nx) {
    const unsigned G = gridDim.x * gridDim.y * gridDim.z;
    unsigned sum, cnt, mine, sp = 0u;
    for (;;) {
        sum = 0u; cnt = 0u; mine = 0u;
#pragma unroll
        for (unsigned j = 0; j < 16; ++j) { const unsigned c = xb_ld(&bar[XB_XCNT(j)]); sum += c; cnt += (c > 0u) ? 1u : 0u; mine = (j == x) ? c : mine; }
        if (sum == G) break;
        __builtin_amdgcn_s_sleep(1);
        if ((++sp & 255u) == 0u) { if (xb_ld(&bar[XB_TMO])) break; if (sp > XB_SPIN_CAP) { atomicAdd(&bar[XB_TMO], 1u); break; } }
    }
    nloc = mine > 0u ? mine : 1u; nx = cnt > 0u ? cnt : 1u;
}
__device__ __forceinline__ void xcd_barrier(const XcdBarrier& b) {
    asm volatile("s_waitcnt vmcnt(0)" ::: "memory");
    __syncthreads();
    if (threadIdx.x == 0) {
        unsigned* bar = b.bar;
        __builtin_amdgcn_s_waitcnt(0);
        unsigned nloc = b.st[0], nx = b.st[1];
        if (nloc == 0u) { xcd_barrier_complete(bar, b.x, nloc, nx); b.st[0] = nloc; b.st[1] = nx; }
        const unsigned old = xb_add(&bar[XB_XSUB(b.x)], 1u);
        const unsigned gen = old / nloc;
        if (old + 1u == (gen + 1u) * nloc) {
            __builtin_amdgcn_fence(__ATOMIC_RELEASE, "agent");
            asm volatile("s_waitcnt vmcnt(0)" ::: "memory");
            const unsigned og = xb_add(&bar[XB_TOP], 1u);
            const unsigned tg = og / nx;
            if (og + 1u == (tg + 1u) * nx) xb_add(&bar[XB_TOPGEN], 1u);
            else XB_SPIN(xb_ld(&bar[XB_TOPGEN]) == tg, bar);
            __builtin_amdgcn_fence(__ATOMIC_ACQUIRE, "agent");
            xb_add(&bar[XB_XGEN(b.x)], 1u);
            asm volatile("s_waitcnt vmcnt(0)" ::: "memory");
        } else {
            XB_SPIN(xb_ld(&bar[XB_XGEN(b.x)]) == gen, bar);
            __builtin_amdgcn_fence(__ATOMIC_ACQUIRE, "agent");
            asm volatile("s_waitcnt vmcnt(0)" ::: "memory");
        }
    }
    __syncthreads();
}

struct Args { const float* in[25]; float* out; unsigned char* ws; int ph_lo, ph_hi, dbl, probe; };
enum { I_X = 0, I_C, I_CTX, I_CCTX, I_WMOD, I_BMOD, I_GPREMIX, I_GPOSTMIX, I_GPREFFN, I_GPOSTFFN, I_WIN, I_QNG, I_KNG, I_CONVW, I_CONVB,
       I_RGWA, I_RGBA, I_RGWI, I_RGBI, I_RGLAM, I_WOUT, I_PWQ, I_PSUBK, I_PU, I_PV };

__device__ __forceinline__ void tr_tile(const float* __restrict__ src, int lds_, int sr0, int sc0, bf16_t* __restrict__ dst, int ldd, int dr0, int dc0, float* T) {
    const int tid = threadIdx.x;
#pragma unroll
    for (int i = 0; i < 8; ++i) { const int e = tid + NTHR * i, r = e >> 6, c = e & 63; T[r * 65 + c] = src[(size_t)(sr0 + r) * lds_ + sc0 + c]; }
    __syncthreads();
#pragma unroll
    for (int i = 0; i < 8; ++i) { const int e = tid + NTHR * i, c = e >> 6, r = e & 63; dst[(size_t)(dr0 + c) * ldd + dc0 + r] = f2bf(T[r * 65 + c]); }
    __syncthreads();
}

__device__ void phase_prep(const Args& a, char* lds, int vb, int nb) {
    const int tid = threadIdx.x;
    unsigned char* ws = a.ws;
    float* S = (float*)lds;
    float* T = (float*)lds;
    constexpr int N_MOD = 256, N_TIN = 448, N_TOUT = 384, N_TWQ = 512, N_RGW = 32, N_SUBK = 16, N_UV = 512, N_MISC = 1;
    constexpr int O_TIN = N_MOD, O_TOUT = O_TIN + N_TIN, O_TWQ = O_TOUT + N_TOUT, O_RGW = O_TWQ + N_TWQ, O_SUBK = O_RGW + N_RGW, O_UV = O_SUBK + N_SUBK, O_MISC = O_UV + N_UV, N_ALL = O_MISC + N_MISC;
    for (int it = vb; it < N_ALL; it += nb) {
        if (it < O_TIN) {
            for (int e = tid; e < 17 * 1024; e += NTHR) { const int r = e >> 10, k = e & 1023; const float v = (r < 16) ? a.in[I_C][r * 1024 + k] : a.in[I_CCTX][k]; S[e] = silu_(v); }
            __syncthreads();
            const int n0 = it * 24;
            const int cc = tid % 6, kk = tid / 6;
            float acc[17][4];
#pragma unroll
            for (int r = 0; r < 17; ++r) { acc[r][0] = 0.f; acc[r][1] = 0.f; acc[r][2] = 0.f; acc[r][3] = 0.f; }
            if (tid < 510) {
                for (int k = kk; k < 1024; k += 85) {
                    const f32x4 w = *(const f32x4*)(a.in[I_WMOD] + (size_t)k * 6144 + n0 + cc * 4);
#pragma unroll
                    for (int r = 0; r < 17; ++r) { const float s = S[r * 1024 + k]; acc[r][0] += s * w[0]; acc[r][1] += s * w[1]; acc[r][2] += s * w[2]; acc[r][3] += s * w[3]; }
                }
            }
            __syncthreads();
            if (tid < 510) {
#pragma unroll
                for (int r = 0; r < 17; ++r) { f32x4 v = {acc[r][0], acc[r][1], acc[r][2], acc[r][3]}; *(f32x4*)(S + (kk * 17 + r) * 24 + cc * 4) = v; }
            }
            __syncthreads();
            float* mod = (float*)(ws + WS_MOD);
            for (int e = tid; e < 17 * 24; e += NTHR) { const int r = e / 24, j = e % 24; float sum = 0.f;
                for (int q = 0; q < 85; ++q) sum += S[(q * 17 + r) * 24 + j];
                mod[r * 6144 + n0 + j] = sum + a.in[I_BMOD][n0 + j]; }
            __syncthreads();
        } else if (it < O_TOUT) {
            const int t = it - O_TIN, kt = t / 28, nt = t % 28;
            tr_tile(a.in[I_WIN], DIN, kt * 64, nt * 64, (bf16_t*)(ws + WS_WIN), DM, nt * 64, kt * 64, T);
        } else if (it < O_TWQ) {
            const int t = it - O_TOUT, kt = t / 16, nt = t % 16;
            const int sk = (kt < 16) ? kt * 64 : (kt - 16) * 64 + 512;
            tr_tile(a.in[I_WOUT], DM, sk, nt * 64, (bf16_t*)(ws + WS_WOUT), KOUT, nt * 64, kt * 64, T);
        } else if (it < O_RGW) {
            const int t = it - O_TWQ, kt = t / 32, nt = t % 32;
            tr_tile(a.in[I_PWQ], 2048, kt * 64, nt * 64, (bf16_t*)(ws + WS_WQ), DM, nt * 64, kt * 64, T);
        } else if (it < O_SUBK) {
            const int t = it - O_RGW, g = t & 1, dn = t >> 1;
            const float* src = (g == 0 ? a.in[I_RGWA] : a.in[I_RGWI]) + (size_t)dn * 4096;
            tr_tile(src, 64, 0, 0, (bf16_t*)(ws + WS_RGW) + (size_t)dn * 128 * 64 + g * 64 * 64, 64, 0, 0, T);
        } else if (it < O_UV) {
            const int t = it - O_SUBK; const float* src = a.in[I_PSUBK] + (size_t)t * 16384; bf16_t* dst = (bf16_t*)(ws + WS_SUBK) + (size_t)t * 16384;
            for (int e = tid * 4; e < 16384; e += NTHR * 4) { const f32x4 v = *(const f32x4*)(src + e); u32x2 o = {pk2(v[0], v[1]), pk2(v[2], v[3])}; *(u32x2*)(dst + e) = o; }
        } else if (it < O_MISC) {
            const int t = it - O_UV; const bool isv = t >= 256; const int tt = t & 255;
            const float* src = (isv ? a.in[I_PV] : a.in[I_PU]) + (size_t)tt * 65536; bf16_t* dst = (bf16_t*)(ws + (isv ? WS_VT : WS_UT)) + (size_t)tt * 65536;
#if P7_FP8
            unsigned char* d8 = ws + (isv ? WS_VT : WS_UT) + (size_t)tt * 65536;
            for (int e = tid * 16; e < 65536; e += NTHR * 16) { u32x4 o;
#pragma unroll
                for (int q = 0; q < 4; ++q) { f32x4 v = *(const f32x4*)(src + e + q * 4) * T_SCALE;
#pragma unroll
                    for (int i = 0; i < 4; ++i) v[i] = fminf(fmaxf(v[i], -448.f), 448.f);
                    int w = __builtin_amdgcn_cvt_pk_fp8_f32(v[0], v[1], 0, false); w = __builtin_amdgcn_cvt_pk_fp8_f32(v[2], v[3], w, true); o[q] = (unsigned)w; }
                *(u32x4*)(d8 + e) = o; }
#else
            if (!isv) {
                for (int e = tid * 8; e < 65536; e += NTHR * 8) { const f32x4 v0 = *(const f32x4*)(src + e), v1 = *(const f32x4*)(src + e + 4);
                    u32x4 o = {pk2(v0[0], v0[1]), pk2(v0[2], v0[3]), pk2(v1[0], v1[1]), pk2(v1[2], v1[3])}; *(u32x4*)(dst + e) = o; }
            } else {
                for (int e = tid * 8; e < 65536; e += NTHR * 8) { const f32x4 v0 = *(const f32x4*)(src + e) * V_SCALE, v1 = *(const f32x4*)(src + e + 4) * V_SCALE;
                    u32x4 o = {pkh2(v0[0], v0[1]), pkh2(v0[2], v0[3]), pkh2(v1[0], v1[1]), pkh2(v1[2], v1[3])}; *(u32x4*)(dst + e) = o; }
            }
#endif
        } else {
            float* rope = (float*)(ws + WS_ROPE);
            for (int e = tid; e < 64 * 16; e += NTHR) { const int pos = e >> 4, f = e & 15; const float inv = powf(10000.f, -(float)f / 16.f); const float ang = (float)pos * inv; rope[e * 2] = cosf(ang); rope[e * 2 + 1] = sinf(ang); }
        }
    }
}

__device__ void phase_xn(const Args& a, int vb, int nb) {
    const int tid = threadIdx.x, lane = tid & 63, wid = tid >> 6;
    const float* mod = (const float*)(a.ws + WS_MOD);
    bf16_t* XN = (bf16_t*)(a.ws + WS_XN);
    const float* g = a.in[I_GPREMIX];
    for (int row = vb * 8 + wid; row < NROWS; row += nb * 8) {
        const float* src; int mrow;
        if (row < NTOK) { src = a.in[I_X] + (size_t)row * DM; mrow = row >> 11; } else { src = a.in[I_CTX] + (size_t)(row - NTOK) * DM; mrow = 16; }
        f32x4 v[4]; float ss = 0.f;
#pragma unroll
        for (int i = 0; i < 4; ++i) { v[i] = *(const f32x4*)(src + i * 256 + lane * 4); ss += v[i][0] * v[i][0] + v[i][1] * v[i][1] + v[i][2] * v[i][2] + v[i][3] * v[i][3]; }
        ss = wave_sum(ss);
        const float rinv = rsqrtf(ss * (1.f / DM) + EPS);
        const float* sh = mod + (size_t)mrow * 6144, *sc = sh + 1024;
#pragma unroll
        for (int i = 0; i < 4; ++i) { const int c = i * 256 + lane * 4;
            const f32x4 gg = *(const f32x4*)(g + c), s1 = *(const f32x4*)(sc + c), s0 = *(const f32x4*)(sh + c);
            float o[4];
#pragma unroll
            for (int j = 0; j < 4; ++j) o[j] = v[i][j] * rinv * gg[j] * (1.f + s1[j]) + s0[j];
            u32x2 w = {pk2(o[0], o[1]), pk2(o[2], o[3])}; *(u32x2*)(XN + (size_t)row * DM + c) = w; }
    }
}

constexpr int G_ROWB = 144;
constexpr int G_STAGE = (256 + 128) * G_ROWB;
constexpr int G_LDS = 2 * G_STAGE;
constexpr int E_PITCH = 272;
template <int NSET>
__device__ __forceinline__ void gemm_core(f32x16 (&acc)[2][2], const bf16_t* __restrict__ X, int ldx, const bf16_t* __restrict__ Wt, int ldw, int K, char* lds) {
    const int tid = threadIdx.x, lane = tid & 63, wid = tid >> 6, wm = wid & 3, wn = wid >> 2, r32 = lane & 31, hi = lane >> 5;
    const int lrow = tid >> 3, lch = tid & 7;
    const bf16_t* xg = X + (size_t)lrow * ldx + lch * 8;
    const bf16_t* wg = Wt + (size_t)lrow * ldw + lch * 8;
    u32x4 xr0[4], wr0[2], xr1[4], wr1[2], xr2[4], wr2[2];
#pragma unroll
    for (int ft = 0; ft < 2; ++ft)
#pragma unroll
        for (int tt = 0; tt < 2; ++tt)
#pragma unroll
            for (int r = 0; r < 16; ++r) acc[ft][tt][r] = 0.f;
#define G_LOAD(S, k0) do { _Pragma("unroll") for (int i = 0; i < 4; ++i) xr##S[i] = *(const u32x4*)(xg + (size_t)i * 64 * ldx + (k0)); \
                           _Pragma("unroll") for (int i = 0; i < 2; ++i) wr##S[i] = *(const u32x4*)(wg + (size_t)i * 64 * ldw + (k0)); } while (0)
#define G_WRITE(S, s) do { char* b_ = lds + (s) * G_STAGE + lrow * G_ROWB + lch * 16; \
                           _Pragma("unroll") for (int i = 0; i < 4; ++i) *(u32x4*)(b_ + i * 64 * G_ROWB) = xr##S[i]; \
                           _Pragma("unroll") for (int i = 0; i < 2; ++i) *(u32x4*)(b_ + 256 * G_ROWB + i * 64 * G_ROWB) = wr##S[i]; } while (0)
#define G_COMPUTE(s) do { const char* xs = lds + (s) * G_STAGE + (wm * 64 + r32) * G_ROWB + hi * 16; \
        const char* wsb = lds + (s) * G_STAGE + 256 * G_ROWB + (wn * 64 + r32) * G_ROWB + hi * 16; \
        _Pragma("unroll") for (int ks = 0; ks < 4; ++ks) { \
            const bf16x8 a0 = *(const bf16x8*)(wsb + ks * 32), a1 = *(const bf16x8*)(wsb + 32 * G_ROWB + ks * 32); \
            const bf16x8 b0 = *(const bf16x8*)(xs + ks * 32), b1 = *(const bf16x8*)(xs + 32 * G_ROWB + ks * 32); \
            acc[0][0] = MFMA(a0, b0, acc[0][0]); acc[0][1] = MFMA(a0, b1, acc[0][1]); \
            acc[1][0] = MFMA(a1, b0, acc[1][0]); acc[1][1] = MFMA(a1, b1, acc[1][1]); } } while (0)
#define G_STEP(KT, S) do { G_WRITE(S, ((KT) + 1) & 1); { const int kn_ = (KT) + 1 + NSET; G_LOAD(S, (kn_ < nk ? kn_ : nk - 1) * 64); } __builtin_amdgcn_sched_barrier(0); \
        G_COMPUTE((KT) & 1); __syncthreads(); } while (0)
    const int nk = K >> 6;
    G_LOAD(0, 0); G_WRITE(0, 0);
    if (NSET == 3) {
        G_LOAD(0, 64); G_LOAD(1, 128); G_LOAD(2, 192); __syncthreads();
        int kt = 0;
#pragma unroll 1
        for (; kt + 3 <= nk; kt += 3) { G_STEP(kt, 0); G_STEP(kt + 1, 1); G_STEP(kt + 2, 2); }
        if (kt < nk) { G_STEP(kt, 0); if (kt + 1 < nk) { G_STEP(kt + 1, 1); } }
    } else {
        G_LOAD(0, 64); G_LOAD(1, 128); __syncthreads();
#pragma unroll 1
        for (int kt = 0; kt < nk; kt += 2) { G_STEP(kt, 0); G_STEP(kt + 1, 1); }
    }
#undef G_LOAD
#undef G_WRITE
#undef G_COMPUTE
#undef G_STEP
}
__device__ __forceinline__ void stage_acc(const f32x16 (&acc)[2][2], char* lds) {
    const int tid = threadIdx.x, lane = tid & 63, wid = tid >> 6, wm = wid & 3, wn = wid >> 2, r32 = lane & 31, hi = lane >> 5;
#pragma unroll
    for (int ft = 0; ft < 2; ++ft)
#pragma unroll
        for (int tt = 0; tt < 2; ++tt)
#pragma unroll
            for (int g = 0; g < 4; ++g) {
                u32x2 v = {pk2(acc[ft][tt][4 * g], acc[ft][tt][4 * g + 1]), pk2(acc[ft][tt][4 * g + 2], acc[ft][tt][4 * g + 3])};
                *(u32x2*)(lds + (wm * 64 + tt * 32 + r32) * E_PITCH + (wn * 64 + ft * 32 + g * 8 + hi * 4) * 2) = v;
            }
}

__device__ void phase_inproj(const Args& a, char* lds, int vb, int nb) {
    const int tid = threadIdx.x, lane = tid & 63, wid = tid >> 6, wm = wid & 3, wn = wid >> 2, r32 = lane & 31, hi = lane >> 5;
    unsigned char* ws = a.ws;
    const bf16_t* XN = (const bf16_t*)(ws + WS_XN);
    const bf16_t* WIN = (const bf16_t*)(ws + WS_WIN);
    const float* rope = (const float*)(ws + WS_ROPE);
    bf16_t* Qo = (bf16_t*)(ws + WS_Q); bf16_t* Ko = (bf16_t*)(ws + WS_K); bf16_t* Vo = (bf16_t*)(ws + WS_VV); bf16_t* Lo = (bf16_t*)(ws + WS_L); bf16_t* Zo = (bf16_t*)(ws + WS_ZG);
    constexpr int N_LAT = 128 * 14, N_ALL = N_LAT + 16 * 6;
    for (int it = vb; it < N_ALL; it += nb) {
        int rt, ct;
        if (it < N_LAT) { rt = it / 14; ct = it % 14; } else { const int j = it - N_LAT; rt = 128 + j / 6; ct = 4 + j % 6; }
        const int row0 = rt * 256, col0 = ct * 128;
        f32x16 acc[2][2];
        gemm_core<3>(acc, XN + (size_t)row0 * DM, DM, WIN + (size_t)col0 * DM, DM, DM, lds);
        const bool lat = rt < 128;
        if (ct <= 4) {
            const float* gn = (ct < 4) ? a.in[I_QNG] : a.in[I_KNG];
            const float osc = (ct < 4) ? 0.125f * 1.4426950408889634f : 1.f;
#pragma unroll
            for (int tt = 0; tt < 2; ++tt) {
                float ss = 0.f;
#pragma unroll
                for (int ft = 0; ft < 2; ++ft)
#pragma unroll
                    for (int r = 0; r < 16; ++r) ss += acc[ft][tt][r] * acc[ft][tt][r];
                ss = half_swap_sum(ss);
                const float rinv = rsqrtf(ss * (1.f / 64.f) + EPS);
                const int row = row0 + wm * 64 + tt * 32 + r32, t = row & 2047;
#pragma unroll
                for (int ft = 0; ft < 2; ++ft) {
                    const int pos = (ft == 0) ? (t >> 6) : (t & 63);
#pragma unroll
                    for (int g = 0; g < 2; ++g)
#pragma unroll
                        for (int i = 0; i < 4; ++i) {
                            const int d1 = ft * 32 + g * 8 + hi * 4 + i, d2 = d1 + 16, fi = g * 8 + hi * 4 + i;
                            const float x1 = acc[ft][tt][4 * g + i] * rinv * gn[d1], x2 = acc[ft][tt][4 * (g + 2) + i] * rinv * gn[d2];
                            float o1 = x1, o2 = x2;
                            if (lat) { const f32x2 cs = *(const f32x2*)(rope + (pos * 16 + fi) * 2); o1 = x1 * cs[0] - x2 * cs[1]; o2 = x1 * cs[1] + x2 * cs[0]; }
                            acc[ft][tt][4 * g + i] = o1 * osc; acc[ft][tt][4 * (g + 2) + i] = o2 * osc;
                        }
                }
            }
        } else if (ct >= 10) {
#pragma unroll
            for (int ft = 0; ft < 2; ++ft)
#pragma unroll
                for (int tt = 0; tt < 2; ++tt)
#pragma unroll
                    for (int r = 0; r < 16; ++r) acc[ft][tt][r] = gelu_tanh(acc[ft][tt][r]);
        }
        if (ct == 5) {
#pragma unroll
            for (int tt = 0; tt < 2; ++tt) {
                const int row = row0 + wm * 64 + tt * 32 + r32;
                int b, s; if (lat) { b = row >> 11; s = CTX + (row & 2047); } else { const int rc = row - NTOK; b = rc >> 8; s = rc & 255; }
                bf16_t* vp = Vo + ((size_t)(b * 2 + wn) * 64) * STOT + s;
#pragma unroll
                for (int ft = 0; ft < 2; ++ft)
#pragma unroll
                    for (int r = 0; r < 16; ++r) { const int d = ft * 32 + 8 * (r >> 2) + 4 * hi + (r & 3); vp[(size_t)d * STOT] = f2bf(acc[ft][tt][r]); }
            }
            __syncthreads();
            continue;
        }
        stage_acc(acc, lds);
        __syncthreads();
#pragma unroll
        for (int i = 0; i < 8; ++i) {
            const int c = tid + NTHR * i, tok = c >> 4, ch = c & 15;
            const u32x4 v = *(const u32x4*)(lds + tok * E_PITCH + ch * 16);
            const int row = row0 + tok;
            int b, s, t; if (lat) { b = row >> 11; t = row & 2047; s = CTX + t; } else { const int rc = row - NTOK; b = rc >> 8; t = 0; s = rc & 255; }
            bf16_t* dst;
            if (ct < 4) dst = Qo + ((size_t)(b * 8 + ct * 2 + (ch >> 3)) * SEQ + t) * 64 + (ch & 7) * 8;
            else if (ct == 4) dst = Ko + ((size_t)(b * 2 + (ch >> 3)) * STOT + s) * 64 + (ch & 7) * 8;
            else if (ct < 10) dst = Lo + ((size_t)b * STOT + s) * DLRU + (ct - 6) * 128 + ch * 8;
            else dst = Zo + (size_t)row * DLRU + (ct - 10) * 128 + ch * 8;
            *(u32x4*)dst = v;
        }
        __syncthreads();
    }
}

constexpr int AT_KP = 144, AT_VP = 136, AT_STAGE = 64 * AT_KP + 64 * AT_VP;
__device__ void attn_item(const Args& a, char* lds, int b, int head, int qblk) {
    const int tid = threadIdx.x, lane = tid & 63, wid = tid >> 6, r32 = lane & 31, hi = lane >> 5;
    unsigned char* ws = a.ws;
    const int kvh = head >> 2;
    const bf16_t* Qp = (const bf16_t*)(ws + WS_Q) + ((size_t)(b * 8 + head) * SEQ + qblk * 256 + wid * 32 + r32) * 64 + hi * 8;
    const bf16_t* Kp = (const bf16_t*)(ws + WS_K) + (size_t)(b * 2 + kvh) * STOT * 64;
    const bf16_t* Vp = (const bf16_t*)(ws + WS_VV) + (size_t)(b * 2 + kvh) * 64 * STOT;
    bf16x8 qf[4];
#pragma unroll
    for (int ds = 0; ds < 4; ++ds) qf[ds] = *(const bf16x8*)(Qp + ds * 16);
    const int srow = tid >> 3, sch = tid & 7;
    const bf16_t* kg = Kp + (size_t)srow * 64 + sch * 8;
    const bf16_t* vg = Vp + (size_t)srow * STOT + sch * 8;
    u32x4 kr, vr;
    f32x16 o[2]; float m = -1e30f, lsum = 0.f;
#pragma unroll
    for (int dt = 0; dt < 2; ++dt)
#pragma unroll
        for (int r = 0; r < 16; ++r) o[dt][r] = 0.f;
#define A_LOAD(s0) do { kr = *(const u32x4*)(kg + (size_t)(s0) * 64); vr = *(const u32x4*)(vg + (s0)); } while (0)
#define A_WRITE(st) do { char* kb_ = lds + (st) * AT_STAGE; *(u32x4*)(kb_ + srow * AT_KP + sch * 16) = kr; \
        char* vb_ = kb_ + 64 * AT_KP + srow * AT_VP + sch * 16; *(u32x2*)vb_ = (u32x2){vr[0], vr[1]}; *(u32x2*)(vb_ + 8) = (u32x2){vr[2], vr[3]}; } while (0)
    constexpr int NT = STOT / 64;
    A_LOAD(0); A_WRITE(0); __syncthreads();
    for (int j = 0; j < NT; ++j) {
        if (j + 1 < NT) A_LOAD((j + 1) * 64);
        const char* ks = lds + (j & 1) * AT_STAGE;
        const char* vs = ks + 64 * AT_KP;
        f32x16 st[2];
#pragma unroll
        for (int kt = 0; kt < 2; ++kt) {
#pragma unroll
            for (int r = 0; r < 16; ++r) st[kt][r] = 0.f;
#pragma unroll
            for (int ds = 0; ds < 4; ++ds) { const bf16x8 ka = *(const bf16x8*)(ks + (kt * 32 + r32) * AT_KP + (ds * 16 + hi * 8) * 2); st[kt] = MFMA(ka, qf[ds], st[kt]); }
        }
        float mx = st[0][0];
#pragma unroll
        for (int r = 1; r < 16; ++r) mx = fmaxf(mx, st[0][r]);
#pragma unroll
        for (int r = 0; r < 16; ++r) mx = fmaxf(mx, st[1][r]);
        mx = half_swap_max(mx);
        const float mn = fmaxf(m, mx), alpha = __builtin_amdgcn_exp2f(m - mn); m = mn;
        float ps = 0.f;
#pragma unroll
        for (int kt = 0; kt < 2; ++kt)
#pragma unroll
            for (int r = 0; r < 16; ++r) { const float p = __builtin_amdgcn_exp2f(st[kt][r] - mn); st[kt][r] = p; ps += p; }
        lsum = lsum * alpha + ps;
#pragma unroll
        for (int dt = 0; dt < 2; ++dt)
#pragma unroll
            for (int r = 0; r < 16; ++r) o[dt][r] *= alpha;
#pragma unroll
        for (int kt = 0; kt < 2; ++kt)
#pragma unroll
            for (int s = 0; s < 2; ++s) {
                u32x4 pw = {pk2(st[kt][8 * s], st[kt][8 * s + 1]), pk2(st[kt][8 * s + 2], st[kt][8 * s + 3]), pk2(st[kt][8 * s + 4], st[kt][8 * s + 5]), pk2(st[kt][8 * s + 6], st[kt][8 * s + 7])};
                const bf16x8 pb = *(bf16x8*)&pw;
#pragma unroll
                for (int dt = 0; dt < 2; ++dt) {
                    const char* vp = vs + (dt * 32 + r32) * AT_VP + (kt * 32 + s * 16 + hi * 4) * 2;
                    const u32x2 lo = *(const u32x2*)vp, hh = *(const u32x2*)(vp + 16);
                    u32x4 aw = {lo[0], lo[1], hh[0], hh[1]};
                    o[dt] = MFMA(*(bf16x8*)&aw, pb, o[dt]);
                }
            }
        if (j + 1 < NT) A_WRITE((j + 1) & 1);
        __syncthreads();
    }
#undef A_LOAD
#undef A_WRITE
    lsum = half_swap_sum(lsum);
    const float inv = fast_rcp(lsum);
    bf16_t* outp = (bf16_t*)(ws + WS_A2) + ((size_t)b * SEQ + qblk * 256 + wid * 32 + r32) * KOUT + head * 64;
#pragma unroll
    for (int dt = 0; dt < 2; ++dt)
#pragma unroll
        for (int g = 0; g < 4; ++g) {
            u32x2 v = {pk2(o[dt][4 * g] * inv, o[dt][4 * g + 1] * inv), pk2(o[dt][4 * g + 2] * inv, o[dt][4 * g + 3] * inv)};
            *(u32x2*)(outp + dt * 32 + g * 8 + hi * 4) = v;
        }
}

constexpr int LR_RAW = 0;
constexpr int LR_U   = 33792;
constexpr int LR_BB  = LR_U + 33280;
constexpr int LR_UB  = LR_BB + 33280;
constexpr int LR_WG  = LR_UB + 18432;
constexpr int LR_SEG = LR_WG + 18432;
constexpr int LR_HC  = LR_SEG + 4096;
constexpr int LR_CST = LR_HC + 512;
constexpr int LR_END = LR_CST + 768;
__device__ void lru_item(const Args& a, char* lds, int b, int n, int d) {
    const int tid = threadIdx.x, lane = tid & 63, wid = tid >> 6, r32 = lane & 31, hi = lane >> 5;
    unsigned char* ws = a.ws;
    float* RAW = (float*)(lds + LR_RAW); float* AA = (float*)(lds + LR_RAW); float* U = (float*)(lds + LR_U); float* BB = (float*)(lds + LR_BB);
    char* UB = lds + LR_UB; char* WG = lds + LR_WG; float* SEG = (float*)(lds + LR_SEG); float* HC = (float*)(lds + LR_HC);
    const bf16_t* Lg = (const bf16_t*)(ws + WS_L) + (size_t)b * STOT * DLRU + n * 64;
    const bf16_t* Zg = (const bf16_t*)(ws + WS_ZG) + (size_t)b * SEQ * DLRU + n * 64;
    bf16_t* Og = (bf16_t*)(ws + WS_A2) + (size_t)b * SEQ * KOUT + 512 + d * 512 + n * 64;
    {
        const bf16_t* wsrc = (const bf16_t*)(ws + WS_RGW) + (size_t)(d * 8 + n) * 128 * 64;
#pragma unroll
        for (int i = 0; i < 2; ++i) { const int c = tid + NTHR * i, r = c >> 3, ch = c & 7; *(u32x4*)(WG + r * 144 + ch * 16) = *(const u32x4*)(wsrc + r * 64 + ch * 8); }
        if (tid < 128) HC[tid] = 0.f;
    }
    const int ct = wid & 1, tt = wid >> 1;
    float* CST = (float*)(lds + LR_CST);
    if (tid < 64) { const int c = n * 64 + tid; CST[tid] = a.in[I_RGBA][d * 512 + c]; CST[64 + tid] = a.in[I_RGBI][d * 512 + c];
        const float x = -a.in[I_RGLAM][d * 512 + c]; CST[128 + tid] = -8.f * (fmaxf(x, 0.f) + log1pf(__expf(-fabsf(x)))); }
    const int sc = tid & 63, sg = tid >> 6;
    const float cw0 = a.in[I_CONVW][0 * 512 + n * 64 + sc], cw1 = a.in[I_CONVW][1 * 512 + n * 64 + sc], cw2 = a.in[I_CONVW][2 * 512 + n * 64 + sc], cw3 = a.in[I_CONVW][3 * 512 + n * 64 + sc];
    const float cbias = a.in[I_CONVB][n * 64 + sc];
    __syncthreads();
    int par = 0;
    for (int step = 0; step < 18; ++step) {
        const bool isctx = step < 2;
        const int tl = isctx ? (d == 0 ? step : 1 - step) : (d == 0 ? step - 2 : 17 - step);
        const int sb = isctx ? 0 : CTX, sl = isctx ? CTX : SEQ, t0 = tl * 128;
        for (int e = tid; e < 131 * 8; e += NTHR) { const int r = e >> 3, ch = e & 7, t = t0 - 2 + r;
            u32x4 v = {0u, 0u, 0u, 0u}; if (t >= 0 && t < sl) v = *(const u32x4*)(Lg + (size_t)(sb + t) * DLRU + ch * 8);
            float* dst = RAW + r * 64 + ch * 8;
            dst[0] = bflo(v[0]); dst[1] = bfhi(v[0]); dst[2] = bflo(v[1]); dst[3] = bfhi(v[1]); dst[4] = bflo(v[2]); dst[5] = bfhi(v[2]); dst[6] = bflo(v[3]); dst[7] = bfhi(v[3]); }
        __syncthreads();
        {
            const float* rp = RAW + (sg * 16) * 64 + sc;
            float x0 = rp[0], x1 = rp[64], x2 = rp[128];
            float* up = U + (sg * 16) * 65 + sc; char* ubp = UB + (sg * 16) * 144 + sc * 2;
#pragma unroll
            for (int i = 0; i < 16; ++i) { const float x3 = rp[(i + 3) * 64];
                const float u = cbias + cw0 * x0 + cw1 * x1 + cw2 * x2 + cw3 * x3;
                up[i * 65] = u; *(bf16_t*)(ubp + i * 144) = f2bf(u); x0 = x1; x1 = x2; x2 = x3; }
        }
        __syncthreads();
        {
            f32x16 ga, gi;
#pragma unroll
            for (int r = 0; r < 16; ++r) { ga[r] = 0.f; gi[r] = 0.f; }
#pragma unroll
            for (int ks = 0; ks < 4; ++ks) {
                const bf16x8 wa = *(const bf16x8*)(WG + (ct * 32 + r32) * 144 + (ks * 16 + hi * 8) * 2);
                const bf16x8 wi = *(const bf16x8*)(WG + (64 + ct * 32 + r32) * 144 + (ks * 16 + hi * 8) * 2);
                const bf16x8 ub = *(const bf16x8*)(UB + (tt * 32 + r32) * 144 + (ks * 16 + hi * 8) * 2);
                ga = MFMA(wa, ub, ga); gi = MFMA(wi, ub, gi);
            }
            const int t = tt * 32 + r32;
#pragma unroll
            for (int r = 0; r < 16; ++r) { const int c = ct * 32 + 8 * (r >> 2) + 4 * hi + (r & 3);
                const float rr = sigmoidf_(ga[r] + CST[c]), ii = sigmoidf_(gi[r] + CST[64 + c]);
                const float la = CST[128 + c] * rr, av = __expf(la), mult = sqrtf(fmaxf(1.f - av * av, 0.f));
                const float u = U[t * 65 + c];
                AA[t * 65 + c] = av; BB[t * 65 + c] = mult * ii * u; }
        }
        __syncthreads();
        float av[16], bv[16]; float Ap = 1.f, Bp = 0.f;
#pragma unroll
        for (int k = 0; k < 16; ++k) { const int p = sg * 16 + k, t = d == 0 ? p : 127 - p; av[k] = AA[t * 65 + sc]; bv[k] = BB[t * 65 + sc]; Bp = av[k] * Bp + bv[k]; Ap = av[k] * Ap; }
        SEG[sg * 64 + sc] = Ap; SEG[512 + sg * 64 + sc] = Bp;
        __syncthreads();
        float h = HC[par * 64 + sc];
        for (int s2 = 0; s2 < sg; ++s2) h = SEG[s2 * 64 + sc] * h + SEG[512 + s2 * 64 + sc];
        {
            const int tfirst = d == 0 ? sg * 16 : 127 - sg * 16;
            const bf16_t* zp = Zg + (size_t)(t0 + tfirst) * DLRU + sc; bf16_t* op = Og + (size_t)(t0 + tfirst) * KOUT + sc;
            const int zstep = d == 0 ? DLRU : -DLRU, ostep = d == 0 ? KOUT : -KOUT;
#pragma unroll
            for (int k = 0; k < 16; ++k) { h = av[k] * h + bv[k];
                if (!isctx) { const float gz = bf2f(*zp); *op = f2bf(h * gz); zp += zstep; op += ostep; } }
        }
        if (sg == 7) HC[(par ^ 1) * 64 + sc] = h;
        par ^= 1;
        __syncthreads();
    }
}

__device__ void phase_mixer(const Args& a, char* lds, int vb, int nb) {
#pragma unroll 1
    for (int it = vb; it < 256; it += nb) { lru_item(a, lds, it >> 4, (it >> 1) & 7, it & 1); __syncthreads(); }
#pragma unroll 1
    for (int at = vb; at < 1024; at += nb) { const int bk = at >> 5, w = at & 31; attn_item(a, lds, bk >> 1, (bk & 1) * 4 + (w >> 3), w & 7); __syncthreads(); }
}

__device__ void phase_outproj(const Args& a, char* lds, int vb, int nb) {
    const int tid = threadIdx.x, lane = tid & 63, wid = tid >> 6, wm = wid & 3, wn = wid >> 2, r32 = lane & 31, hi = lane >> 5;
    const bf16_t* A2 = (const bf16_t*)(a.ws + WS_A2); const bf16_t* WO = (const bf16_t*)(a.ws + WS_WOUT);
    float* MIX = (float*)(a.ws + WS_MIX);
    for (int it = vb; it < 128 * 8; it += nb) {
        const int rt = it >> 3, ct = it & 7, row0 = rt * 256, col0 = ct * 128;
        f32x16 acc[2][2];
        gemm_core<3>(acc, A2 + (size_t)row0 * KOUT, KOUT, WO + (size_t)col0 * KOUT, KOUT, KOUT, lds);
#pragma unroll
        for (int tt = 0; tt < 2; ++tt) {
            float* rp = MIX + (size_t)(row0 + wm * 64 + tt * 32 + r32) * DM + col0 + wn * 64 + hi * 4;
#pragma unroll
            for (int ft = 0; ft < 2; ++ft)
#pragma unroll
                for (int g = 0; g < 4; ++g) { f32x4 v = {acc[ft][tt][4 * g], acc[ft][tt][4 * g + 1], acc[ft][tt][4 * g + 2], acc[ft][tt][4 * g + 3]}; *(f32x4*)(rp + ft * 32 + g * 8) = v; }
        }
    }
}

__device__ void phase_rowpass(const Args& a, int vb, int nb) {
    const int tid = threadIdx.x, lane = tid & 63, wid = tid >> 6;
    const float* mod = (const float*)(a.ws + WS_MOD);
    const float* MIX = (const float*)(a.ws + WS_MIX);
    bf16_t* HX = (bf16_t*)(a.ws + WS_HX2);
    for (int row = vb * 8 + wid; row < NTOK; row += nb * 8) {
        const int b = row >> 11;
        const float* mrow = mod + (size_t)b * 6144;
        f32x4 mv[4], xv[4]; float ss = 0.f;
#pragma unroll
        for (int i = 0; i < 4; ++i) { mv[i] = *(const f32x4*)(MIX + (size_t)row * DM + i * 256 + lane * 4); xv[i] = *(const f32x4*)(a.in[I_X] + (size_t)row * DM + i * 256 + lane * 4);
            ss += mv[i][0] * mv[i][0] + mv[i][1] * mv[i][1] + mv[i][2] * mv[i][2] + mv[i][3] * mv[i][3]; }
        ss = wave_sum(ss);
        const float rinv = rsqrtf(ss * (1.f / DM) + EPS);
        float s2 = 0.f;
#pragma unroll
        for (int i = 0; i < 4; ++i) { const int c = i * 256 + lane * 4;
            const f32x4 gp = *(const f32x4*)(a.in[I_GPOSTMIX] + c), g1 = *(const f32x4*)(mrow + 2048 + c);
#pragma unroll
            for (int j = 0; j < 4; ++j) { const float xm = xv[i][j] + g1[j] * (mv[i][j] * rinv * gp[j]); xv[i][j] = xm; s2 += xm * xm; }
            *(f32x4*)(a.out + (size_t)row * DM + c) = xv[i]; }
        s2 = wave_sum(s2);
        const float rinv2 = rsqrtf(s2 * (1.f / DM) + EPS);
#pragma unroll
        for (int i = 0; i < 4; ++i) { const int c = i * 256 + lane * 4;
            const f32x4 gf = *(const f32x4*)(a.in[I_GPREFFN] + c), sh = *(const f32x4*)(mrow + 3072 + c), sc = *(const f32x4*)(mrow + 4096 + c);
            float o[4];
#pragma unroll
            for (int j = 0; j < 4; ++j) o[j] = xv[i][j] * rinv2 * gf[j] * (1.f + sc[j]) + sh[j];
            u32x2 w = {pk2(o[0], o[1]), pk2(o[2], o[3])}; *(u32x2*)(HX + (size_t)row * DM + c) = w; }
    }
}

__device__ __forceinline__ int fkey(float f) { const int b = __float_as_int(f); return b ^ ((b >> 31) & 0x7fffffff); }
__device__ __forceinline__ float fval(int k) { return __int_as_float(k ^ ((k >> 31) & 0x7fffffff)); }
#define CE_DESC(x, y) do { const int hi_ = max((x), (y)), lo_ = min((x), (y)); (x) = hi_; (y) = lo_; } while (0)
__device__ __forceinline__ void sort16_desc(int (&v)[16]) {
#pragma unroll
    for (int k = 2; k <= 16; k <<= 1)
#pragma unroll
        for (int j = k >> 1; j > 0; j >>= 1)
#pragma unroll
            for (int i = 0; i < 16; ++i) { const int l = i ^ j; if (l > i) { if ((i & k) == 0) { CE_DESC(v[i], v[l]); } else { CE_DESC(v[l], v[i]); } } }
}
__device__ __forceinline__ void merge16_desc(int (&v)[16]) {
#pragma unroll
    for (int j = 8; j > 0; j >>= 1)
#pragma unroll
        for (int i = 0; i < 16; ++i) { const int l = i ^ j; if (l > i) CE_DESC(v[i], v[l]); }
}
__device__ __forceinline__ void top16_merge(int (&A)[16], const int (&B)[16]) {
#pragma unroll
    for (int i = 0; i < 16; ++i) A[i] = max(A[i], B[15 - i]);
    merge16_desc(A);
}
constexpr int PK_QS = 0;
constexpr int PK_SK = 256 * E_PITCH;
constexpr int PK_ML = G_LDS;
constexpr int PK_X  = PK_ML + 32768;
constexpr int PK_END = PK_X + 8192;
static_assert(PK_SK + 128 * E_PITCH <= G_LDS, "peer staging must fit in the GEMM stage region");
__device__ void phase_peer_topk(const Args& a, char* lds, int vb, int nb) {
    const int tid = threadIdx.x, lane = tid & 63, wid = tid >> 6, wm = wid & 3, wn = wid >> 2, r32 = lane & 31, hi = lane >> 5;
    unsigned char* ws = a.ws;
    const bf16_t* HX = (const bf16_t*)(ws + WS_HX2); const bf16_t* WQ = (const bf16_t*)(ws + WS_WQ); const bf16_t* SUBK = (const bf16_t*)(ws + WS_SUBK);
    int* IDX = (int*)(ws + WS_IDX);
    int* ML = (int*)(lds + PK_ML); int* XB = (int*)(lds + PK_X);
    for (int it = vb; it < 128 * 8; it += nb) {
        const int rt = it >> 3, h = it & 7, row0 = rt * 256;
#pragma unroll 1
        for (int p = 0; p < 2; ++p) {
            f32x16 acc[2][2];
            gemm_core<2>(acc, HX + (size_t)row0 * DM, DM, WQ + (size_t)(h * 256 + p * 128) * DM, DM, DM, lds);
            stage_acc(acc, lds + PK_QS);
            {
                const bf16_t* sk = SUBK + (size_t)(h * 2 + p) * 128 * 128;
#pragma unroll
                for (int i = 0; i < 4; ++i) { const int c = tid + NTHR * i, r = c >> 4, ch = c & 15; *(u32x4*)(lds + PK_SK + r * E_PITCH + ch * 16) = *(const u32x4*)(sk + r * 128 + ch * 8); }
            }
            __syncthreads();
#pragma unroll
            for (int ft = 0; ft < 2; ++ft)
#pragma unroll
                for (int tt = 0; tt < 2; ++tt)
#pragma unroll
                    for (int r = 0; r < 16; ++r) acc[ft][tt][r] = 0.f;
#pragma unroll
            for (int ks = 0; ks < 8; ++ks) {
                const bf16x8 a0 = *(const bf16x8*)(lds + PK_SK + (wn * 64 + r32) * E_PITCH + (ks * 16 + hi * 8) * 2), a1 = *(const bf16x8*)(lds + PK_SK + (wn * 64 + 32 + r32) * E_PITCH + (ks * 16 + hi * 8) * 2);
                const bf16x8 b0 = *(const bf16x8*)(lds + PK_QS + (wm * 64 + r32) * E_PITCH + (ks * 16 + hi * 8) * 2), b1 = *(const bf16x8*)(lds + PK_QS + (wm * 64 + 32 + r32) * E_PITCH + (ks * 16 + hi * 8) * 2);
                acc[0][0] = MFMA(a0, b0, acc[0][0]); acc[0][1] = MFMA(a0, b1, acc[0][1]);
                acc[1][0] = MFMA(a1, b0, acc[1][0]); acc[1][1] = MFMA(a1, b1, acc[1][1]);
            }
#pragma unroll
            for (int tt = 0; tt < 2; ++tt) {
                int A[16], B[16];
#pragma unroll
                for (int r = 0; r < 16; ++r) { const int key = wn * 64 + 8 * (r >> 2) + 4 * hi + (r & 3);
                    A[r] = (fkey(acc[0][tt][r]) & ~127) | key; B[r] = (fkey(acc[1][tt][r]) & ~127) | (key + 32); }
                sort16_desc(A); sort16_desc(B); top16_merge(A, B);
#pragma unroll
                for (int r = 0; r < 16; ++r) { auto rr = __builtin_amdgcn_permlane32_swap((unsigned)A[r], (unsigned)A[r], false, false); B[r] = (int)(hi ? rr[0] : rr[1]); }
                top16_merge(A, B);
                const int tok = wm * 64 + tt * 32 + r32;
                if (wn == 1 && hi == 0) {
#pragma unroll
                    for (int r = 0; r < 16; ++r) XB[(wm * 32 + r32) * 16 + r] = A[r];
                }
                __syncthreads();
                if (wn == 0 && hi == 0) {
#pragma unroll
                    for (int r = 0; r < 16; ++r) B[r] = XB[(wm * 32 + r32) * 16 + r];
                    top16_merge(A, B);
#pragma unroll
                    for (int r = 0; r < 16; ++r) ML[(tok * 2 + p) * 16 + r] = A[r];
                }
                __syncthreads();
            }
        }
        if (tid < 256) {
            const int tok = tid;
            int s1[16], s2[16];
#pragma unroll
            for (int r = 0; r < 16; ++r) { s1[r] = ML[(tok * 2 + 0) * 16 + r]; s2[r] = ML[(tok * 2 + 1) * 16 + r]; }
            float f1[16], f2[16];
#pragma unroll
            for (int r = 0; r < 16; ++r) { f1[r] = fval(s1[r] & ~127); f2[r] = fval(s2[r] & ~127); }
            int G0[16], G1[16], G2[16], G3[16];
#pragma unroll
            for (int bb = 0; bb < 16; ++bb) G0[bb] = (fkey(f1[0] + f2[bb]) & ~255) | (0 * 16 + bb);
#pragma unroll
            for (int bb = 0; bb < 8; ++bb) G1[bb] = (fkey(f1[1] + f2[bb]) & ~255) | (1 * 16 + bb);
#pragma unroll
            for (int bb = 0; bb < 5; ++bb) G1[8 + bb] = (fkey(f1[2] + f2[bb]) & ~255) | (2 * 16 + bb);
#pragma unroll
            for (int bb = 0; bb < 3; ++bb) G1[13 + bb] = (fkey(f1[3] + f2[bb]) & ~255) | (3 * 16 + bb);
            G2[0] = (fkey(f1[3] + f2[3]) & ~255) | (3 * 16 + 3);
#pragma unroll
            for (int bb = 0; bb < 3; ++bb) G2[1 + bb] = (fkey(f1[4] + f2[bb]) & ~255) | (4 * 16 + bb);
#pragma unroll
            for (int aa = 5; aa < 8; ++aa)
#pragma unroll
                for (int bb = 0; bb < 2; ++bb) G2[4 + (aa - 5) * 2 + bb] = (fkey(f1[aa] + f2[bb]) & ~255) | (aa * 16 + bb);
#pragma unroll
            for (int aa = 8; aa < 14; ++aa) G2[10 + (aa - 8)] = (fkey(f1[aa] + f2[0]) & ~255) | (aa * 16);
            G3[0] = (fkey(f1[14] + f2[0]) & ~255) | (14 * 16); G3[1] = (fkey(f1[15] + f2[0]) & ~255) | (15 * 16);
#pragma unroll
            for (int r = 2; r < 16; ++r) G3[r] = (int)0x80000000;
            sort16_desc(G0); sort16_desc(G1); sort16_desc(G2); sort16_desc(G3);
            top16_merge(G0, G1); top16_merge(G2, G3); top16_merge(G0, G2);
            float tv[16]; float mx = fval(G0[0] & ~255), sum = 0.f;
#pragma unroll
            for (int r = 0; r < 16; ++r) { tv[r] = __expf(fval(G0[r] & ~255) - mx); sum += tv[r]; }
            const float rs = 1.f / sum;
            const size_t ob = ((size_t)(row0 + tok) * 8 + h) * 16;
#pragma unroll
            for (int r = 0; r < 16; ++r) { const int code = G0[r] & 255, aa = code >> 4, bb = code & 15;
                const int i1 = ML[(tok * 2 + 0) * 16 + aa] & 127, i2 = ML[(tok * 2 + 1) * 16 + bb] & 127;
                IDX[ob + r] = (i1 * 128 + i2) | (int)((unsigned)f2bf(tv[r] * rs) << 16); }
        }
        __syncthreads();
    }
}

constexpr int P7_RSHIFT = 8;
constexpr int P7_ROUNDS = PEER_N >> P7_RSHIFT;
template <int CTRL> __device__ __forceinline__ float dpp_add(float v) { return v + __uint_as_float(__builtin_amdgcn_update_dpp(0u, __float_as_uint(v), CTRL, 0xf, 0xf, true)); }
__device__ __forceinline__ float wave_sum_bcast(float p) {
    p = dpp_add<0xB1>(p); p = dpp_add<0x4E>(p); p = dpp_add<0x141>(p); p = dpp_add<0x140>(p);
    const unsigned u = __float_as_uint(p);
    return (__uint_as_float(__builtin_amdgcn_readlane(u, 0)) + __uint_as_float(__builtin_amdgcn_readlane(u, 16))) + (__uint_as_float(__builtin_amdgcn_readlane(u, 32)) + __uint_as_float(__builtin_amdgcn_readlane(u, 48)));
}
__device__ __forceinline__ float dot16(const u32x4 a0, const u32x4 a1, const u32x4 b0, const u32x4 b1) {
    float acc = 0.f;
#pragma unroll
    for (int i = 0; i < 4; ++i) { acc = __builtin_amdgcn_fdot2_f32_bf16(as_bf2(a0[i]), as_bf2(b0[i]), acc, false); acc = __builtin_amdgcn_fdot2_f32_bf16(as_bf2(a1[i]), as_bf2(b1[i]), acc, false); }
    return acc;
}
typedef float f32x4v __attribute__((ext_vector_type(4)));
constexpr int P7_RS = 9;
constexpr int P7_NR = PEER_N >> P7_RS;
constexpr int P7_HTP = 2048 + 32;
constexpr int P7_WLDS = 4 * P7_HTP + 2048 + 8192;
__device__ void phase_peer_gather(const Args& a, char* lds, int vb, int nb) {
    const int tid = threadIdx.x, lane = tid & 63, wid = tid >> 6, r16 = lane & 15, kg = lane >> 4;
    unsigned char* ws = a.ws;
    const bf16_t* HX = (const bf16_t*)(ws + WS_HX2);
    const int* IDX = (const int*)(ws + WS_IDX);
    const float* mod = (const float*)(ws + WS_MOD);
    const unsigned char* UT = ws + WS_UT; const unsigned char* VT = ws + WS_VT;
    char* HT = lds + wid * P7_WLDS; unsigned* LIST = (unsigned*)(HT + 4 * P7_HTP); char* AT = HT + 4 * P7_HTP + 2048;
#pragma unroll 1
    for (int tb = vb * 32; tb < NTOK; tb += nb * 32) {
        const int tok0 = tb + wid * 4;
        {
            int* HIST = (int*)HT; int* CUR = HIST + 128;
            int ee[8];
            const int* ip = IDX + (size_t)tok0 * 128 + lane;
#pragma unroll
            for (int k = 0; k < 4; ++k) { ee[2 * k] = ip[k * 128]; ee[2 * k + 1] = ip[k * 128 + 64]; }
            HIST[lane] = 0; HIST[64 + lane] = 0;
#pragma unroll
            for (int j = 0; j < 8; ++j) atomicAdd(&HIST[(((ee[j] >> P7_RS) & (P7_NR - 1)) << 2) | (j >> 1)], 1);
            const int c0 = HIST[2 * lane], c1 = HIST[2 * lane + 1];
            int inc = c0 + c1;
#pragma unroll
            for (int o = 1; o < 64; o <<= 1) { const int t = __shfl_up(inc, o); if (lane >= o) inc += t; }
            CUR[2 * lane] = inc - c0 - c1; CUR[2 * lane + 1] = inc - c1;
#pragma unroll
            for (int j = 0; j < 8; ++j) { const unsigned w = (unsigned)ee[j]; const int slot = atomicAdd(&CUR[(((w >> P7_RS) & (P7_NR - 1)) << 2) | (j >> 1)], 1);
                LIST[slot] = (w & 16383u) | ((unsigned)(j >> 1) << 14) | ((w >> 16) << 17); }
        }
        {
            const bf16_t* hp = HX + (size_t)tok0 * DM + lane * 16;
#pragma unroll
            for (int k = 0; k < 4; ++k) { const u32x4 h0 = *(const u32x4*)(hp + k * DM), h1 = *(const u32x4*)(hp + k * DM + 8);
                *(u32x4*)(HT + k * P7_HTP + lane * 32) = h0; *(u32x4*)(HT + k * P7_HTP + lane * 32 + 16) = h1;
                *(u32x4*)(AT + k * 2048 + lane * 32) = (u32x4){0u, 0u, 0u, 0u}; *(u32x4*)(AT + k * 2048 + lane * 32 + 16) = (u32x4){0u, 0u, 0u, 0u}; }
        }
        const char* hb = HT + (lane & 3) * P7_HTP + kg * 32;
        u32x4 c0 = {0u, 0u, 0u, 0u}, c1 = {0u, 0u, 0u, 0u}; unsigned cur = 0u;
#pragma unroll 1
        for (int bi = 0; bi < 32; ++bi) {
            const unsigned entv = LIST[bi * 16 + r16];
            f32x4v D = {0.f, 0.f, 0.f, 0.f};
            const unsigned char* ub = UT + (size_t)(entv & 16383u) * DM + kg * 16;
#pragma unroll 1
            for (int s8 = 0; s8 < 2; ++s8) {
                u32x4 ua[8];
#pragma unroll
                for (int s = 0; s < 8; ++s) ua[s] = *(const u32x4*)(ub + (s8 * 8 + s) * 64);
#pragma unroll
                for (int s = 0; s < 8; ++s) {
                    const char* hp2 = hb + (s8 * 8 + s) * 128;
                    const u32x4 b0 = *(const u32x4*)hp2, b1 = *(const u32x4*)(hp2 + 16);
                    const unsigned d0 = ua[s][0], d1 = ua[s][1], d2 = ua[s][2], d3 = ua[s][3];
                    u32x4 a0 = {__builtin_bit_cast(unsigned, __builtin_amdgcn_cvt_scalef32_pk_bf16_fp8(d0, 1.f / T_SCALE, false)), __builtin_bit_cast(unsigned, __builtin_amdgcn_cvt_scalef32_pk_bf16_fp8(d0, 1.f / T_SCALE, true)),
                                __builtin_bit_cast(unsigned, __builtin_amdgcn_cvt_scalef32_pk_bf16_fp8(d1, 1.f / T_SCALE, false)), __builtin_bit_cast(unsigned, __builtin_amdgcn_cvt_scalef32_pk_bf16_fp8(d1, 1.f / T_SCALE, true))};
                    u32x4 a1 = {__builtin_bit_cast(unsigned, __builtin_amdgcn_cvt_scalef32_pk_bf16_fp8(d2, 1.f / T_SCALE, false)), __builtin_bit_cast(unsigned, __builtin_amdgcn_cvt_scalef32_pk_bf16_fp8(d2, 1.f / T_SCALE, true)),
                                __builtin_bit_cast(unsigned, __builtin_amdgcn_cvt_scalef32_pk_bf16_fp8(d3, 1.f / T_SCALE, false)), __builtin_bit_cast(unsigned, __builtin_amdgcn_cvt_scalef32_pk_bf16_fp8(d3, 1.f / T_SCALE, true))};
                    D = __builtin_amdgcn_mfma_f32_16x16x32_bf16(*(bf16x8*)&a0, *(const bf16x8*)&b0, D, 0, 0, 0);
                    D = __builtin_amdgcn_mfma_f32_16x16x32_bf16(*(bf16x8*)&a1, *(const bf16x8*)&b1, D, 0, 0, 0);
                }
            }
            float dsel = 0.f;
#pragma unroll
            for (int i = 0; i < 4; ++i) {
                const unsigned er = (unsigned)__shfl((int)entv, 4 * kg + i);
                float m = (((er >> 14) & 3u) == (unsigned)(lane & 3)) ? D[i] : 0.f;
                m = dpp_add<0xB1>(m); m = dpp_add<0x4E>(m);
                dsel = ((lane & 3) == i) ? m : dsel;
            }
            const unsigned gl = __float_as_uint(gelu_tanh(dsel));
#pragma unroll 1
            for (int r0 = 0; r0 < 16; r0 += 8) {
                u32x4 vbuf[8]; unsigned ent[8];
#pragma unroll
                for (int b = 0; b < 8; ++b) { ent[b] = (unsigned)__builtin_amdgcn_readlane((int)entv, r0 + b);
                    vbuf[b] = *(const u32x4*)(VT + (size_t)(ent[b] & 16383u) * DM + lane * 16); }
#pragma unroll
                for (int b = 0; b < 8; ++b) {
                    const int r = r0 + b;
                    const float w_ = __uint_as_float(__builtin_amdgcn_readlane(gl, 16 * (r >> 2) + (r & 3))) * __uint_as_float((ent[b] >> 17) << 16);
                    const h16x2 w2 = as_h2(pkh2(w_, w_));
                    const unsigned tk = (ent[b] >> 14) & 3u;
                    if (tk != cur) {
                        char* apo = AT + cur * 2048 + lane * 32; *(u32x4*)apo = c0; *(u32x4*)(apo + 16) = c1;
                        const char* apn = AT + tk * 2048 + lane * 32; c0 = *(const u32x4*)apn; c1 = *(const u32x4*)(apn + 16); cur = tk; }
#pragma unroll
                    for (int q_ = 0; q_ < 4; ++q_) { const unsigned vw_ = vbuf[b][q_];
                        const h16x2 lo = __builtin_amdgcn_cvt_scalef32_pk_f16_fp8(vw_, V_SCALE / T_SCALE, false), hi2 = __builtin_amdgcn_cvt_scalef32_pk_f16_fp8(vw_, V_SCALE / T_SCALE, true);
                        if (q_ < 2) { c0[2 * q_] = __builtin_bit_cast(unsigned, __builtin_elementwise_fma(lo, w2, as_h2(c0[2 * q_]))); c0[2 * q_ + 1] = __builtin_bit_cast(unsigned, __builtin_elementwise_fma(hi2, w2, as_h2(c0[2 * q_ + 1]))); }
                        else { c1[2 * q_ - 4] = __builtin_bit_cast(unsigned, __builtin_elementwise_fma(lo, w2, as_h2(c1[2 * q_ - 4]))); c1[2 * q_ - 3] = __builtin_bit_cast(unsigned, __builtin_elementwise_fma(hi2, w2, as_h2(c1[2 * q_ - 3]))); } }
                }
            }
        }
        { char* apo = AT + cur * 2048 + lane * 32; *(u32x4*)apo = c0; *(u32x4*)(apo + 16) = c1; }
#pragma unroll
        for (int k = 0; k < 4; ++k) {
            const int tok = tok0 + k;
            float f[16]; float ss = 0.f;
            const u32x4 e0 = *(const u32x4*)(AT + k * 2048 + lane * 32), e1 = *(const u32x4*)(AT + k * 2048 + lane * 32 + 16);
#pragma unroll
            for (int i = 0; i < 8; ++i) { const unsigned cw = i < 4 ? e0[i] : e1[i - 4]; const h16x2 hv = as_h2(cw);
                f[2 * i] = (float)hv[0] * (1.f / V_SCALE); f[2 * i + 1] = (float)hv[1] * (1.f / V_SCALE); ss += f[2 * i] * f[2 * i] + f[2 * i + 1] * f[2 * i + 1]; }
            ss = wave_sum_bcast(ss);
            const float rinv = rsqrtf(ss * (1.f / DM) + EPS);
            const float* g2 = mod + (size_t)(tok >> 11) * 6144 + 5120;
#pragma unroll
            for (int q4 = 0; q4 < 4; ++q4) {
                const int c = lane * 16 + q4 * 4;
                float* op = a.out + (size_t)tok * DM + c;
                const f32x4 xm = *(const f32x4*)op, g2v = *(const f32x4*)(g2 + c), gp = *(const f32x4*)(a.in[I_GPOSTFFN] + c);
                f32x4 o;
#pragma unroll
                for (int jj = 0; jj < 4; ++jj) o[jj] = xm[jj] + g2v[jj] * (f[q4 * 4 + jj] * rinv * gp[jj]);
                *(f32x4*)op = o; }
        }
    }
}

#ifdef DBG_DIGEST
__device__ void phase_digest(const Args& a, int vb, int nb) {
    const bf16_t* A2 = (const bf16_t*)(a.ws + WS_A2);
    const bf16_t* Q = (const bf16_t*)(a.ws + WS_Q); const bf16_t* K = (const bf16_t*)(a.ws + WS_K); const bf16_t* VV = (const bf16_t*)(a.ws + WS_VV);
    const bf16_t* L = (const bf16_t*)(a.ws + WS_L); const bf16_t* ZG = (const bf16_t*)(a.ws + WS_ZG);
    for (size_t e = (size_t)vb * NTHR + threadIdx.x; e < (size_t)NTOK * DM; e += (size_t)nb * NTHR) {
        float v = 0.f;
#if DBG_DIGEST == 3
        const size_t row = e >> 10; const int c = (int)(e & 1023);
        v = bf2f(A2[row * KOUT + c]); if (c < 512) v += bf2f(A2[row * KOUT + 1024 + c]);
#elif DBG_DIGEST == 2
        const size_t h = e % ((size_t)NTOK * 512);
        v = bf2f(Q[h]) + bf2f(ZG[h]) + bf2f(L[e % ((size_t)NB * STOT * 512)]);
        if (e < (size_t)NB * 2 * STOT * 64) v += bf2f(K[e]) + bf2f(VV[e]);
#endif
        a.out[e] = v; }
}
#endif
constexpr int LDS_BYTES = 155648;
constexpr int LDS_BARST = LDS_BYTES - 16;
static_assert(8 * P7_WLDS <= LDS_BARST && PK_END <= LDS_BARST && LR_END <= LDS_BARST && G_LDS <= LDS_BARST && 17 * 1024 * 4 + 17 * 24 * 4 <= LDS_BARST, "LDS budget");
constexpr int N_PHASES = 8;

__global__ void __launch_bounds__(NTHR, 2) mk_fwd(Args a) {
    extern __shared__ __attribute__((aligned(16))) char lds[];
    const int nb = gridDim.x, bx = blockIdx.x;
    const int vb0 = (nb % 8 == 0) ? (bx % 8) * (nb / 8) + bx / 8 : bx;
    XcdBarrier bar; bar.bar = (unsigned*)(a.ws + WS_CTL); bar.x = 0; bar.st = (volatile LAS unsigned*)(LAS char*)(lds + LDS_BARST);
    const bool multi = (a.ph_hi - a.ph_lo) > 1;
    if (multi) {
        if (threadIdx.x < 4) ((volatile LAS unsigned*)(LAS char*)(lds + LDS_BARST))[threadIdx.x] = 0u;
        __syncthreads();
        bar = xcd_barrier_post((unsigned*)(a.ws + WS_CTL), (volatile LAS unsigned*)(LAS char*)(lds + LDS_BARST));
    }
#ifndef P7_PROBE
#define P7_PROBE -1
#endif
#ifndef DBL_PHASE
#define DBL_PHASE 0
#endif
#if DBL_PHASE != 0
#define RUN_PHASE(P, CALL) do { if (a.ph_lo <= (P) && (P) < a.ph_hi) { const int nrep_ = ((a.dbl >> (P)) & 1) ? 2 : 1; for (int rep_ = 0; rep_ < nrep_; ++rep_) { CALL; if ((P) + 1 < a.ph_hi || rep_ + 1 < nrep_) xcd_barrier(bar); } } } while (0)
#else
#define RUN_PHASE(P, CALL) do { if (a.ph_lo <= (P) && (P) < a.ph_hi) { CALL; if ((P) + 1 < a.ph_hi) xcd_barrier(bar); } } while (0)
#endif
#if !defined(ONLY_PHASE) || ONLY_PHASE == 0
    RUN_PHASE(0, phase_prep(a, lds, vb0, nb));
#endif
    int vb = vb0;
    if (multi && a.ph_lo == 0 && a.ph_hi > 1) {
        if (threadIdx.x == 0) { unsigned off = 0; for (unsigned j = 0; j < bar.x; ++j) off += xb_ld(&bar.bar[XB_XCNT(j)]); bar.st[3] = off + bar.st[2]; }
        __syncthreads();
        vb = (int)bar.st[3];
    }
#if !defined(ONLY_PHASE) || ONLY_PHASE == 1
    RUN_PHASE(1, phase_xn(a, vb, nb));
#endif
#if !defined(ONLY_PHASE) || ONLY_PHASE == 2
    RUN_PHASE(2, phase_inproj(a, lds, vb, nb));
#endif
#if (!defined(ONLY_PHASE) || ONLY_PHASE == 3) && !(defined(DBG_DIGEST) && DBG_DIGEST == 2)
    RUN_PHASE(3, phase_mixer(a, lds, vb, nb));
#endif
#ifdef DBG_DIGEST
    if (a.ph_lo <= 4 && 4 < a.ph_hi) phase_digest(a, vb, nb);
    return;
#endif
#if !defined(ONLY_PHASE) || ONLY_PHASE == 4
    RUN_PHASE(4, phase_outproj(a, lds, vb, nb));
#endif
#if !defined(ONLY_PHASE) || ONLY_PHASE == 5
    RUN_PHASE(5, phase_rowpass(a, vb, nb));
#endif
#if !defined(ONLY_PHASE) || ONLY_PHASE == 6
    RUN_PHASE(6, phase_peer_topk(a, lds, vb, nb));
#endif
#if !defined(ONLY_PHASE) || ONLY_PHASE == 7
    RUN_PHASE(7, phase_peer_gather(a, lds, vb, nb));
#endif
}

extern "C" void kernel_launch(void* const* d_in, const int* in_sizes, int n_in, void* d_out, int out_size, void* d_ws, size_t ws_size, hipStream_t stream) {
    static int grid = 0;
    if (grid == 0) {
        if (n_in != 25 || out_size != NTOK * DM || ws_size < WS_END) { fprintf(stderr, "kernel_launch: unexpected shapes (n_in %d, out %d, ws %zu, need %zu)\n", n_in, out_size, ws_size, (size_t)WS_END); grid = -1; return; }
        int dev = 0, cus = 0;
        if (hipGetDevice(&dev) != hipSuccess || hipDeviceGetAttribute(&cus, hipDeviceAttributeMultiprocessorCount, dev) != hipSuccess) { grid = -1; return; }
        if (hipFuncSetAttribute((const void*)mk_fwd, hipFuncAttributeMaxDynamicSharedMemorySize, LDS_BYTES) != hipSuccess) { fprintf(stderr, "kernel_launch: hipFuncSetAttribute failed\n"); grid = -1; return; }
        (void)hipGetLastError();
        grid = cus;
    }
    if (grid < 0) return;
    (void)hipMemsetAsync((char*)d_ws + WS_CTL, 0, CTL_BYTES, stream);
    Args a{};
    for (int i = 0; i < 25; ++i) a.in[i] = (const float*)d_in[i];
    a.out = (float*)d_out; a.ws = (unsigned char*)d_ws; a.dbl = DBL_PHASE; a.probe = P7_PROBE;
#if MK_N_LAUNCHES == 1
    a.ph_lo = 0; a.ph_hi = N_PHASES;
    hipLaunchKernelGGL(mk_fwd, dim3(grid), dim3(NTHR), LDS_BYTES, stream, a);
#else
    for (int ph = 0; ph < N_PHASES; ++ph) { a.ph_lo = ph; a.ph_hi = ph + 1; hipLaunchKernelGGL(mk_fwd, dim3(grid), dim3(NTHR), LDS_BYTES, stream, a); }
#endif
}
```

```cpp
#include <hip/hip_runtime.h>
#include <cstdio>
#include <cstdint>

#ifndef MK_N_LAUNCHES
#define MK_N_LAUNCHES 1
#endif

typedef unsigned short bf16_t;
typedef short bf16x8 __attribute__((ext_vector_type(8)));
typedef float f32x16 __attribute__((ext_vector_type(16)));
typedef float f32x4 __attribute__((ext_vector_type(4)));
typedef float f32x2 __attribute__((ext_vector_type(2)));
typedef unsigned u32x4 __attribute__((ext_vector_type(4)));
typedef unsigned u32x2 __attribute__((ext_vector_type(2)));
#define LAS __attribute__((address_space(3)))

constexpr int DM = 1024, NB = 16, SEQ = 2048, CTX = 256, STOT = SEQ + CTX;
constexpr int NTOK = NB * SEQ;
constexpr int NCTX = NB * CTX;
constexpr int NROWS = NTOK + NCTX;
constexpr int DIN = 1792, DLRU = 512;
constexpr int KOUT = 1536;
constexpr int PEER_N = 16384;
constexpr float EPS = 1e-6f;
constexpr int NTHR = 512;

constexpr size_t al256(size_t x) { return (x + 255) & ~(size_t)255; }
constexpr size_t WS_CTL   = 0;
constexpr size_t CTL_BYTES = 65536;
constexpr size_t WS_MOD   = WS_CTL + CTL_BYTES;
constexpr size_t WS_ROPE  = WS_MOD + al256(17 * 6144 * 4);
constexpr size_t WS_WIN   = WS_ROPE + al256(64 * 16 * 2 * 4);
constexpr size_t WS_WOUT  = WS_WIN + al256((size_t)DIN * DM * 2);
constexpr size_t WS_WQ    = WS_WOUT + al256((size_t)DM * KOUT * 2);
constexpr size_t WS_SUBK  = WS_WQ + al256((size_t)2048 * DM * 2);
constexpr size_t WS_RGW   = WS_SUBK + al256((size_t)8 * 2 * 128 * 128 * 2);
constexpr size_t WS_UT    = WS_RGW + al256((size_t)2 * 8 * 128 * 64 * 2);
constexpr size_t WS_VT    = WS_UT + al256((size_t)PEER_N * DM * 2);
constexpr size_t WS_XN    = WS_VT + al256((size_t)PEER_N * DM * 2);
constexpr size_t WS_Q     = WS_XN + al256((size_t)NROWS * DM * 2);
constexpr size_t WS_K     = WS_Q + al256((size_t)NTOK * 512 * 2);
constexpr size_t WS_VV    = WS_K + al256((size_t)NB * 2 * STOT * 64 * 2);
constexpr size_t WS_L     = WS_VV + al256((size_t)NB * 2 * STOT * 64 * 2);
constexpr size_t WS_ZG    = WS_L + al256((size_t)NB * STOT * DLRU * 2);
constexpr size_t WS_A2    = WS_ZG + al256((size_t)NTOK * DLRU * 2);
constexpr size_t WS_END   = WS_A2 + al256((size_t)NTOK * KOUT * 2);
constexpr size_t WS_MIX   = WS_XN;
constexpr size_t WS_HX2   = WS_A2;
constexpr size_t WS_IDX   = WS_ZG;
constexpr size_t WS_GATE  = WS_ZG + (size_t)NTOK * 128 * 4;
static_assert(WS_MIX + (size_t)NTOK * DM * 4 <= WS_ZG, "MIX overlay must end before ZG");
static_assert(WS_GATE + (size_t)NTOK * 128 * 4 <= WS_A2, "IDX/GATE overlay must end before A2");

typedef __bf16 bf16x2_t __attribute__((ext_vector_type(2)));
__device__ __forceinline__ unsigned pk2(float lo, float hi) { const f32x2 v = {lo, hi}; const bf16x2_t b = __builtin_convertvector(v, bf16x2_t); return __builtin_bit_cast(unsigned, b); }
typedef _Float16 h16x2 __attribute__((ext_vector_type(2)));
constexpr float V_SCALE = 64.f;
constexpr float T_SCALE = 256.f;
#ifndef P7_FP8
#define P7_FP8 1
#endif
__device__ __forceinline__ unsigned pkh2(float lo, float hi) { const h16x2 h = {(_Float16)lo, (_Float16)hi}; return __builtin_bit_cast(unsigned, h); }
__device__ __forceinline__ bf16x2_t as_bf2(unsigned x) { return __builtin_bit_cast(bf16x2_t, x); }
__device__ __forceinline__ h16x2 as_h2(unsigned x) { return __builtin_bit_cast(h16x2, x); }
__device__ __forceinline__ bf16_t f2bf(float f) { return (bf16_t)(pk2(f, 0.f) & 0xffffu); }
__device__ __forceinline__ float bf2f(unsigned h) { return __uint_as_float(h << 16); }
__device__ __forceinline__ float bflo(unsigned w) { return __uint_as_float(w << 16); }
__device__ __forceinline__ float bfhi(unsigned w) { return __uint_as_float(w & 0xffff0000u); }
__device__ __forceinline__ float fast_rcp(float x) { return __builtin_amdgcn_rcpf(x); }
__device__ __forceinline__ float sigmoidf_(float x) { return fast_rcp(1.f + __expf(-x)); }
__device__ __forceinline__ float gelu_tanh(float x) { const float y = 0.7978845608028654f * (x + 0.044715f * x * x * x); return x * fast_rcp(1.f + __expf(-2.f * y)); }
__device__ __forceinline__ float silu_(float x) { return x * sigmoidf_(x); }
__device__ __forceinline__ float wave_sum(float v) {
#pragma unroll
    for (int o = 32; o > 0; o >>= 1) v += __shfl_xor(v, o);
    return v;
}
__device__ __forceinline__ float half_swap_max(float v) { auto rr = __builtin_amdgcn_permlane32_swap(__float_as_uint(v), __float_as_uint(v), false, false); return fmaxf(__uint_as_float(rr[0]), __uint_as_float(rr[1])); }
__device__ __forceinline__ float half_swap_sum(float v) { auto rr = __builtin_amdgcn_permlane32_swap(__float_as_uint(v), __float_as_uint(v), false, false); return __uint_as_float(rr[0]) + __uint_as_float(rr[1]); }
#define MFMA(a, b, c) __builtin_amdgcn_mfma_f32_32x32x16_bf16((a), (b), (c), 0, 0, 0)

#define XB_TMO      128
#define XB_XCNT(j)  (256  + 64 * (j))
#define XB_XSUB(j)  (1280 + 64 * (j))
#define XB_XGEN(j)  (2304 + 64 * (j))
#define XB_TOP      3328
#define XB_TOPGEN   3392
#define XCD_BAR_WORDS 3456
#define XB_SPIN_CAP (1u << 20)
__device__ __forceinline__ unsigned xb_ld(unsigned* p)              { return __hip_atomic_load(p, __ATOMIC_RELAXED, __HIP_MEMORY_SCOPE_AGENT); }
__device__ __forceinline__ unsigned xb_add(unsigned* p, unsigned v) { return __hip_atomic_fetch_add(p, v, __ATOMIC_RELAXED, __HIP_MEMORY_SCOPE_AGENT); }
__device__ __forceinline__ unsigned xb_xcc_id() { return (unsigned)__builtin_amdgcn_s_getreg((3 << 11) | 20) & 0xFu; }
#define XB_SPIN(cond, bar) do { unsigned _sp = 0; while (cond) { __builtin_amdgcn_s_sleep(1); \
    if ((++_sp & 255u) == 0u) { if (xb_ld(&(bar)[XB_TMO])) break; if (_sp > XB_SPIN_CAP) { atomicAdd(&(bar)[XB_TMO], 1u); break; } } } } while (0)
struct XcdBarrier { unsigned* bar; unsigned x; volatile LAS unsigned* st; };
__device__ __forceinline__ XcdBarrier xcd_barrier_post(unsigned* bar, volatile LAS unsigned* st) {
    XcdBarrier b; b.bar = bar; b.x = xb_xcc_id(); b.st = st;
    if (threadIdx.x == 0) st[2] = xb_add(&bar[XB_XCNT(b.x)], 1u);
    return b;
}
__device__ __forceinline__ void xcd_barrier_complete(unsigned* bar, unsigned x, unsigned& nloc, unsigned& nx) {
    const unsigned G = gridDim.x * gridDim.y * gridDim.z;
    unsigned sum, cnt, mine, sp = 0u;
    for (;;) {
        sum = 0u; cnt = 0u; mine = 0u;
#pragma unroll
        for (unsigned j = 0; j < 16; ++j) { const unsigned c = xb_ld(&bar[XB_XCNT(j)]); sum += c; cnt += (c > 0u) ? 1u : 0u; mine = (j == x) ? c : mine; }
        if (sum == G) break;
        __builtin_amdgcn_s_sleep(1);
        if ((++sp & 255u) == 0u) { if (xb_ld(&bar[XB_TMO])) break; if (sp > XB_SPIN_CAP) { atomicAdd(&bar[XB_TMO], 1u); break; } }
    }
    nloc = mine > 0u ? mine : 1u; nx = cnt > 0u ? cnt : 1u;
}
__device__ __forceinline__ void xcd_barrier(const XcdBarrier& b) {
    asm volatile("s_waitcnt vmcnt(0)" ::: "memory");
    __syncthreads();
    if (threadIdx.x == 0) {
        unsigned* bar = b.bar;
        __builtin_amdgcn_s_waitcnt(0);
        unsigned nloc = b.st[0], nx = b.st[1];
        if (nloc == 0u) { xcd_barrier_complete(bar, b.x, nloc, nx); b.st[0] = nloc; b.st[1] = nx; }
        const unsigned old = xb_add(&bar[XB_XSUB(b.x)], 1u);
        const unsigned gen = old / nloc;
        if (old + 1u == (gen + 1u) * nloc) {
            __builtin_amdgcn_fence(__ATOMIC_RELEASE, "agent");
            asm volatile("s_waitcnt vmcnt(0)" ::: "memory");
            const unsigned og = xb_add(&bar[XB_TOP], 1u);
            const unsigned tg = og / nx;
            if (og + 1u == (tg + 1u) * nx) xb_add(&bar[XB_TOPGEN], 1u);
            else XB_SPIN(xb_ld(&bar[XB_TOPGEN]) == tg, bar);
            __builtin_amdgcn_fence(__ATOMIC_ACQUIRE, "agent");
            xb_add(&bar[XB_XGEN(b.x)], 1u);
            asm volatile("s_waitcnt vmcnt(0)" ::: "memory");
        } else {
            XB_SPIN(xb_ld(&bar[XB_XGEN(b.x)]) == gen, bar);
            __builtin_amdgcn_fence(__ATOMIC_ACQUIRE, "agent");
            asm volatile("s_waitcnt vmcnt(0)" ::: "memory");
        }
    }
    __syncthreads();
}

struct Args { const float* in[25]; float* out; unsigned char* ws; int ph_lo, ph_hi, dbl, probe; };
enum { I_X = 0, I_C, I_CTX, I_CCTX, I_WMOD, I_BMOD, I_GPREMIX, I_GPOSTMIX, I_GPREFFN, I_GPOSTFFN, I_WIN, I_QNG, I_KNG, I_CONVW, I_CONVB,
       I_RGWA, I_RGBA, I_RGWI, I_RGBI, I_RGLAM, I_WOUT, I_PWQ, I_PSUBK, I_PU, I_PV };

__device__ __forceinline__ void tr_tile(const float* __restrict__ src, int lds_, int sr0, int sc0, bf16_t* __restrict__ dst, int ldd, int dr0, int dc0, float* T) {
    const int tid = threadIdx.x;
#pragma unroll
    for (int i = 0; i < 8; ++i) { const int e = tid + NTHR * i, r = e >> 6, c = e & 63; T[r * 65 + c] = src[(size_t)(sr0 + r) * lds_ + sc0 + c]; }
    __syncthreads();
#pragma unroll
    for (int i = 0; i < 8; ++i) { const int e = tid + NTHR * i, c = e >> 6, r = e & 63; dst[(size_t)(dr0 + c) * ldd + dc0 + r] = f2bf(T[r * 65 + c]); }
    __syncthreads();
}

__device__ void phase_prep(const Args& a, char* lds, int vb, int nb) {
    const int tid = threadIdx.x;
    unsigned char* ws = a.ws;
    float* S = (float*)lds;
    float* T = (float*)lds;
    constexpr int N_MOD = 256, N_TIN = 448, N_TOUT = 384, N_TWQ = 512, N_RGW = 32, N_SUBK = 16, N_UV = 512, N_MISC = 1;
    constexpr int O_TIN = N_MOD, O_TOUT = O_TIN + N_TIN, O_TWQ = O_TOUT + N_TOUT, O_RGW = O_TWQ + N_TWQ, O_SUBK = O_RGW + N_RGW, O_UV = O_SUBK + N_SUBK, O_MISC = O_UV + N_UV, N_ALL = O_MISC + N_MISC;
    for (int it = vb; it < N_ALL; it += nb) {
        if (it < O_TIN) {
            for (int e = tid; e < 17 * 1024; e += NTHR) { const int r = e >> 10, k = e & 1023; const float v = (r < 16) ? a.in[I_C][r * 1024 + k] : a.in[I_CCTX][k]; S[e] = silu_(v); }
            __syncthreads();
            const int n0 = it * 24;
            const int cc = tid % 6, kk = tid / 6;
            float acc[17][4];
#pragma unroll
            for (int r = 0; r < 17; ++r) { acc[r][0] = 0.f; acc[r][1] = 0.f; acc[r][2] = 0.f; acc[r][3] = 0.f; }
            if (tid < 510) {
                for (int k = kk; k < 1024; k += 85) {
                    const f32x4 w = *(const f32x4*)(a.in[I_WMOD] + (size_t)k * 6144 + n0 + cc * 4);
#pragma unroll
                    for (int r = 0; r < 17; ++r) { const float s = S[r * 1024 + k]; acc[r][0] += s * w[0]; acc[r][1] += s * w[1]; acc[r][2] += s * w[2]; acc[r][3] += s * w[3]; }
                }
            }
            __syncthreads();
            if (tid < 510) {
#pragma unroll
                for (int r = 0; r < 17; ++r) { f32x4 v = {acc[r][0], acc[r][1], acc[r][2], acc[r][3]}; *(f32x4*)(S + (kk * 17 + r) * 24 + cc * 4) = v; }
            }
            __syncthreads();
            float* mod = (float*)(ws + WS_MOD);
            for (int e = tid; e < 17 * 24; e += NTHR) { const int r = e / 24, j = e % 24; float sum = 0.f;
                for (int q = 0; q < 85; ++q) sum += S[(q * 17 + r) * 24 + j];
                mod[r * 6144 + n0 + j] = sum + a.in[I_BMOD][n0 + j]; }
            __syncthreads();
        } else if (it < O_TOUT) {
            const int t = it - O_TIN, kt = t / 28, nt = t % 28;
            tr_tile(a.in[I_WIN], DIN, kt * 64, nt * 64, (bf16_t*)(ws + WS_WIN), DM, nt * 64, kt * 64, T);
        } else if (it < O_TWQ) {
            const int t = it - O_TOUT, kt = t / 16, nt = t % 16;
            const int sk = (kt < 16) ? kt * 64 : (kt - 16) * 64 + 512;
            tr_tile(a.in[I_WOUT], DM, sk, nt * 64, (bf16_t*)(ws + WS_WOUT), KOUT, nt * 64, kt * 64, T);
        } else if (it < O_RGW) {
            const int t = it - O_TWQ, kt = t / 32, nt = t % 32;
            tr_tile(a.in[I_PWQ], 2048, kt * 64, nt * 64, (bf16_t*)(ws + WS_WQ), DM, nt * 64, kt * 64, T);
        } else if (it < O_SUBK) {
            const int t = it - O_RGW, g = t & 1, dn = t >> 1;
            const float* src = (g == 0 ? a.in[I_RGWA] : a.in[I_RGWI]) + (size_t)dn * 4096;
            tr_tile(src, 64, 0, 0, (bf16_t*)(ws + WS_RGW) + (size_t)dn * 128 * 64 + g * 64 * 64, 64, 0, 0, T);
        } else if (it < O_UV) {
            const int t = it - O_SUBK; const float* src = a.in[I_PSUBK] + (size_t)t * 16384; bf16_t* dst = (bf16_t*)(ws + WS_SUBK) + (size_t)t * 16384;
            for (int e = tid * 4; e < 16384; e += NTHR * 4) { const f32x4 v = *(const f32x4*)(src + e); u32x2 o = {pk2(v[0], v[1]), pk2(v[2], v[3])}; *(u32x2*)(dst + e) = o; }
        } else if (it < O_MISC) {
            const int t = it - O_UV; const bool isv = t >= 256; const int tt = t & 255;
            const float* src = (isv ? a.in[I_PV] : a.in[I_PU]) + (size_t)tt * 65536; bf16_t* dst = (bf16_t*)(ws + (isv ? WS_VT : WS_UT)) + (size_t)tt * 65536;
#if P7_FP8
            unsigned char* d8 = ws + (isv ? WS_VT : WS_UT) + (size_t)tt * 65536;
            for (int e = tid * 16; e < 65536; e += NTHR * 16) { u32x4 o;
#pragma unroll
                for (int q = 0; q < 4; ++q) { f32x4 v = *(const f32x4*)(src + e + q * 4) * T_SCALE;
#pragma unroll
                    for (int i = 0; i < 4; ++i) v[i] = fminf(fmaxf(v[i], -448.f), 448.f);
                    int w = __builtin_amdgcn_cvt_pk_fp8_f32(v[0], v[1], 0, false); w = __builtin_amdgcn_cvt_pk_fp8_f32(v[2], v[3], w, true); o[q] = (unsigned)w; }
                *(u32x4*)(d8 + e) = o; }
#else
            if (!isv) {
                for (int e = tid * 8; e < 65536; e += NTHR * 8) { const f32x4 v0 = *(const f32x4*)(src + e), v1 = *(const f32x4*)(src + e + 4);
                    u32x4 o = {pk2(v0[0], v0[1]), pk2(v0[2], v0[3]), pk2(v1[0], v1[1]), pk2(v1[2], v1[3])}; *(u32x4*)(dst + e) = o; }
            } else {
                for (int e = tid * 8; e < 65536; e += NTHR * 8) { const f32x4 v0 = *(const f32x4*)(src + e) * V_SCALE, v1 = *(const f32x4*)(src + e + 4) * V_SCALE;
                    u32x4 o = {pkh2(v0[0], v0[1]), pkh2(v0[2], v0[3]), pkh2(v1[0], v1[1]), pkh2(v1[2], v1[3])}; *(u32x4*)(dst + e) = o; }
            }
#endif
        } else {
            float* rope = (float*)(ws + WS_ROPE);
            for (int e = tid; e < 64 * 16; e += NTHR) { const int pos = e >> 4, f = e & 15; const float inv = powf(10000.f, -(float)f / 16.f); const float ang = (float)pos * inv; rope[e * 2] = cosf(ang); rope[e * 2 + 1] = sinf(ang); }
        }
    }
}

__device__ void phase_xn(const Args& a, int vb, int nb) {
    const int tid = threadIdx.x, lane = tid & 63, wid = tid >> 6;
    const float* mod = (const float*)(a.ws + WS_MOD);
    bf16_t* XN = (bf16_t*)(a.ws + WS_XN);
    const float* g = a.in[I_GPREMIX];
    for (int row = vb * 8 + wid; row < NROWS; row += nb * 8) {
        const float* src; int mrow;
        if (row < NTOK) { src = a.in[I_X] + (size_t)row * DM; mrow = row >> 11; } else { src = a.in[I_CTX] + (size_t)(row - NTOK) * DM; mrow = 16; }
        f32x4 v[4]; float ss = 0.f;
#pragma unroll
        for (int i = 0; i < 4; ++i) { v[i] = *(const f32x4*)(src + i * 256 + lane * 4); ss += v[i][0] * v[i][0] + v[i][1] * v[i][1] + v[i][2] * v[i][2] + v[i][3] * v[i][3]; }
        ss = wave_sum(ss);
        const float rinv = rsqrtf(ss * (1.f / DM) + EPS);
        const float* sh = mod + (size_t)mrow * 6144, *sc = sh + 1024;
#pragma unroll
        for (int i = 0; i < 4; ++i) { const int c = i * 256 + lane * 4;
            const f32x4 gg = *(const f32x4*)(g + c), s1 = *(const f32x4*)(sc + c), s0 = *(const f32x4*)(sh + c);
            float o[4];
#pragma unroll
            for (int j = 0; j < 4; ++j) o[j] = v[i][j] * rinv * gg[j] * (1.f + s1[j]) + s0[j];
            u32x2 w = {pk2(o[0], o[1]), pk2(o[2], o[3])}; *(u32x2*)(XN + (size_t)row * DM + c) = w; }
    }
}

constexpr int G_STAGE = (256 + 128) * 128;
constexpr int G_LDS = 2 * G_STAGE;
constexpr int E_PITCH = 272;
template <int NSET, bool NOLOAD = false>
__device__ __forceinline__ void gemm_core(f32x16 (&acc)[2][2], const bf16_t* __restrict__ X, int ldx, const bf16_t* __restrict__ Wt, int ldw, int K, char* lds) {
    const int tid = threadIdx.x, lane = tid & 63, wid = tid >> 6, wm = wid & 3, wn = wid >> 2, r32 = lane & 31, hi = lane >> 5;
    const int lrow = tid >> 3, lch = (tid & 7) ^ ((lrow >> 1) & 7);
    const bf16_t* xg = X + (size_t)lrow * ldx + lch * 8;
    const bf16_t* wg = Wt + (size_t)lrow * ldw + lch * 8;
#pragma unroll
    for (int ft = 0; ft < 2; ++ft)
#pragma unroll
        for (int tt = 0; tt < 2; ++tt)
#pragma unroll
            for (int r = 0; r < 16; ++r) acc[ft][tt][r] = 0.f;
#define G_DMA(s, k0) do { char* b_ = lds + (s) * G_STAGE + tid * 16; \
        _Pragma("unroll") for (int i = 0; i < 4; ++i) __builtin_amdgcn_global_load_lds((const unsigned*)(xg + (size_t)i * 64 * ldx + (k0)), (unsigned*)(b_ + i * 8192), 16, 0, 0); \
        _Pragma("unroll") for (int i = 0; i < 2; ++i) __builtin_amdgcn_global_load_lds((const unsigned*)(wg + (size_t)i * 64 * ldw + (k0)), (unsigned*)(b_ + 32768 + i * 8192), 16, 0, 0); } while (0)
    const int nk = K >> 6;
    const int xrow = wm * 64 + r32, wrow = wn * 64 + r32;
    const int xsw = (xrow >> 1) & 7, wsw = (wrow >> 1) & 7;
    int st_c = 0, st_n = 1;
    G_DMA(0, 0);
    if (NSET == 3) { G_DMA(1, 64); st_n = 2; asm volatile("s_waitcnt vmcnt(6)" ::: "memory"); __builtin_amdgcn_s_barrier(); } else { __syncthreads(); }
#pragma unroll 1
    for (int kt = 0; kt < nk; ++kt) {
        { const int kn = (kt + NSET - 1 < nk) ? kt + NSET - 1 : nk - 1; G_DMA(st_n, kn * 64); }
        const char* xs = lds + st_c * G_STAGE + xrow * 128;
        const char* wsb = lds + st_c * G_STAGE + 32768 + wrow * 128;
        bf16x8 fa0[2], fa1[2], fb0[2], fb1[2];
        { const int xo = ((0 * 2 + hi) ^ xsw) << 4, wo = ((0 * 2 + hi) ^ wsw) << 4;
          fa0[0] = *(const bf16x8*)(wsb + wo); fa1[0] = *(const bf16x8*)(wsb + 32 * 128 + wo); fb0[0] = *(const bf16x8*)(xs + xo); fb1[0] = *(const bf16x8*)(xs + 32 * 128 + xo); }
#pragma unroll
        for (int ks = 0; ks < 4; ++ks) {
            if (ks + 1 < 4) { const int xo = (((ks + 1) * 2 + hi) ^ xsw) << 4, wo = (((ks + 1) * 2 + hi) ^ wsw) << 4;
                fa0[(ks + 1) & 1] = *(const bf16x8*)(wsb + wo); fa1[(ks + 1) & 1] = *(const bf16x8*)(wsb + 32 * 128 + wo);
                fb0[(ks + 1) & 1] = *(const bf16x8*)(xs + xo); fb1[(ks + 1) & 1] = *(const bf16x8*)(xs + 32 * 128 + xo); }
            acc[0][0] = MFMA(fa0[ks & 1], fb0[ks & 1], acc[0][0]); acc[0][1] = MFMA(fa0[ks & 1], fb1[ks & 1], acc[0][1]);
            acc[1][0] = MFMA(fa1[ks & 1], fb0[ks & 1], acc[1][0]); acc[1][1] = MFMA(fa1[ks & 1], fb1[ks & 1], acc[1][1]);
            __builtin_amdgcn_sched_barrier(0);
        }
        if (NSET == 3) { asm volatile("s_waitcnt vmcnt(6)" ::: "memory"); __builtin_amdgcn_s_barrier(); st_c = st_c == 2 ? 0 : st_c + 1; st_n = st_n == 2 ? 0 : st_n + 1; }
        else { __syncthreads(); st_c ^= 1; st_n ^= 1; }
    }
    if (NSET == 3) { asm volatile("s_waitcnt vmcnt(0)" ::: "memory"); __syncthreads(); }
#undef G_DMA
}
__device__ __forceinline__ void stage_acc(const f32x16 (&acc)[2][2], char* lds) {
    const int tid = threadIdx.x, lane = tid & 63, wid = tid >> 6, wm = wid & 3, wn = wid >> 2, r32 = lane & 31, hi = lane >> 5;
#pragma unroll
    for (int ft = 0; ft < 2; ++ft)
#pragma unroll
        for (int tt = 0; tt < 2; ++tt)
#pragma unroll
            for (int g = 0; g < 4; ++g) {
                u32x2 v = {pk2(acc[ft][tt][4 * g], acc[ft][tt][4 * g + 1]), pk2(acc[ft][tt][4 * g + 2], acc[ft][tt][4 * g + 3])};
                *(u32x2*)(lds + (wm * 64 + tt * 32 + r32) * E_PITCH + (wn * 64 + ft * 32 + g * 8 + hi * 4) * 2) = v;
            }
}

__device__ void phase_inproj(const Args& a, char* lds, int vb, int nb) {
    const int tid = threadIdx.x, lane = tid & 63, wid = tid >> 6, wm = wid & 3, wn = wid >> 2, r32 = lane & 31, hi = lane >> 5;
    unsigned char* ws = a.ws;
    const bf16_t* XN = (const bf16_t*)(ws + WS_XN);
    const bf16_t* WIN = (const bf16_t*)(ws + WS_WIN);
    const float* rope = (const float*)(ws + WS_ROPE);
    bf16_t* Qo = (bf16_t*)(ws + WS_Q); bf16_t* Ko = (bf16_t*)(ws + WS_K); bf16_t* Vo = (bf16_t*)(ws + WS_VV); bf16_t* Lo = (bf16_t*)(ws + WS_L); bf16_t* Zo = (bf16_t*)(ws + WS_ZG);
    constexpr int N_LAT = 128 * 14, N_ALL = N_LAT + 16 * 6;
    for (int it = vb; it < N_ALL; it += nb) {
        int rt, ct;
        if (it < N_LAT) { rt = it / 14; ct = it % 14; } else { const int j = it - N_LAT; rt = 128 + j / 6; ct = 4 + j % 6; }
        const int row0 = rt * 256, col0 = ct * 128;
        f32x16 acc[2][2];
        gemm_core<3>(acc, XN + (size_t)row0 * DM, DM, WIN + (size_t)col0 * DM, DM, DM, lds);
        const bool lat = rt < 128;
        if (ct <= 4) {
            const float* gn = (ct < 4) ? a.in[I_QNG] : a.in[I_KNG];
            const float osc = (ct < 4) ? 0.125f * 1.4426950408889634f : 1.f;
#pragma unroll
            for (int tt = 0; tt < 2; ++tt) {
                float ss = 0.f;
#pragma unroll
                for (int ft = 0; ft < 2; ++ft)
#pragma unroll
                    for (int r = 0; r < 16; ++r) ss += acc[ft][tt][r] * acc[ft][tt][r];
                ss = half_swap_sum(ss);
                const float rinv = rsqrtf(ss * (1.f / 64.f) + EPS);
                const int row = row0 + wm * 64 + tt * 32 + r32, t = row & 2047;
#pragma unroll
                for (int ft = 0; ft < 2; ++ft) {
                    const int pos = (ft == 0) ? (t >> 6) : (t & 63);
#pragma unroll
                    for (int g = 0; g < 2; ++g)
#pragma unroll
                        for (int i = 0; i < 4; ++i) {
                            const int d1 = ft * 32 + g * 8 + hi * 4 + i, d2 = d1 + 16, fi = g * 8 + hi * 4 + i;
                            const float x1 = acc[ft][tt][4 * g + i] * rinv * gn[d1], x2 = acc[ft][tt][4 * (g + 2) + i] * rinv * gn[d2];
                            float o1 = x1, o2 = x2;
                            if (lat) { const f32x2 cs = *(const f32x2*)(rope + (pos * 16 + fi) * 2); o1 = x1 * cs[0] - x2 * cs[1]; o2 = x1 * cs[1] + x2 * cs[0]; }
                            acc[ft][tt][4 * g + i] = o1 * osc; acc[ft][tt][4 * (g + 2) + i] = o2 * osc;
                        }
                }
            }
        } else if (ct >= 10) {
#pragma unroll
            for (int ft = 0; ft < 2; ++ft)
#pragma unroll
                for (int tt = 0; tt < 2; ++tt)
#pragma unroll
                    for (int r = 0; r < 16; ++r) acc[ft][tt][r] = gelu_tanh(acc[ft][tt][r]);
        }
        if (ct == 5) {
#pragma unroll
            for (int tt = 0; tt < 2; ++tt) {
                const int row = row0 + wm * 64 + tt * 32 + r32;
                int b, s; if (lat) { b = row >> 11; s = CTX + (row & 2047); } else { const int rc = row - NTOK; b = rc >> 8; s = rc & 255; }
                bf16_t* vp = Vo + ((size_t)(b * 2 + wn) * 64) * STOT + s;
#pragma unroll
                for (int ft = 0; ft < 2; ++ft)
#pragma unroll
                    for (int r = 0; r < 16; ++r) { const int d = ft * 32 + 8 * (r >> 2) + 4 * hi + (r & 3); vp[(size_t)d * STOT] = f2bf(acc[ft][tt][r]); }
            }
            __syncthreads();
            continue;
        }
        stage_acc(acc, lds);
        __syncthreads();
#pragma unroll
        for (int i = 0; i < 8; ++i) {
            const int c = tid + NTHR * i, tok = c >> 4, ch = c & 15;
            const u32x4 v = *(const u32x4*)(lds + tok * E_PITCH + ch * 16);
            const int row = row0 + tok;
            int b, s, t; if (lat) { b = row >> 11; t = row & 2047; s = CTX + t; } else { const int rc = row - NTOK; b = rc >> 8; t = 0; s = rc & 255; }
            bf16_t* dst;
            if (ct < 4) dst = Qo + ((size_t)(b * 8 + ct * 2 + (ch >> 3)) * SEQ + t) * 64 + (ch & 7) * 8;
            else if (ct == 4) dst = Ko + ((size_t)(b * 2 + (ch >> 3)) * STOT + s) * 64 + (ch & 7) * 8;
            else if (ct < 10) dst = Lo + ((size_t)b * STOT + s) * DLRU + (ct - 6) * 128 + ch * 8;
            else dst = Zo + (size_t)row * DLRU + (ct - 10) * 128 + ch * 8;
            *(u32x4*)dst = v;
        }
        __syncthreads();
    }
}

constexpr int AT_KP = 144, AT_VP = 136, AT_STAGE = 64 * AT_KP + 64 * AT_VP;
__device__ void attn_item(const Args& a, char* lds, int b, int head, int qblk) {
    const int tid = threadIdx.x, lane = tid & 63, wid = tid >> 6, r32 = lane & 31, hi = lane >> 5;
    unsigned char* ws = a.ws;
    const int kvh = head >> 2;
    const bf16_t* Qp = (const bf16_t*)(ws + WS_Q) + ((size_t)(b * 8 + head) * SEQ + qblk * 256 + wid * 32 + r32) * 64 + hi * 8;
    const bf16_t* Kp = (const bf16_t*)(ws + WS_K) + (size_t)(b * 2 + kvh) * STOT * 64;
    const bf16_t* Vp = (const bf16_t*)(ws + WS_VV) + (size_t)(b * 2 + kvh) * 64 * STOT;
    bf16x8 qf[4];
#pragma unroll
    for (int ds = 0; ds < 4; ++ds) qf[ds] = *(const bf16x8*)(Qp + ds * 16);
    const int srow = tid >> 3, sch = tid & 7;
    const bf16_t* kg = Kp + (size_t)srow * 64 + sch * 8;
    const bf16_t* vg = Vp + (size_t)srow * STOT + sch * 8;
    u32x4 krA, vrA, krB, vrB;
    f32x16 o[2]; float lsum = 0.f;
    float negM;
    { float gq = fabsf(a.in[I_QNG][lane]), gk = fabsf(a.in[I_KNG][lane]);
#pragma unroll
      for (int o_ = 32; o_ > 0; o_ >>= 1) { gq = fmaxf(gq, __shfl_xor(gq, o_)); gk = fmaxf(gk, __shfl_xor(gk, o_)); }
      negM = -(64.f * 0.125f * 1.4426950408889634f * 1.01f) * gq * gk; }
#pragma unroll
    for (int dt = 0; dt < 2; ++dt)
#pragma unroll
        for (int r = 0; r < 16; ++r) o[dt][r] = 0.f;
    char* KS = lds; char* VS = lds + 2 * 64 * AT_KP;
#define A_LOADK(X, s0) do { kr##X = *(const u32x4*)(kg + (size_t)(s0) * 64); } while (0)
#define A_LOADV(X, s0) do { vr##X = *(const u32x4*)(vg + (s0)); } while (0)
#define A_WRITEK(X, st) do { *(u32x4*)(KS + (st) * 64 * AT_KP + srow * AT_KP + sch * 16) = kr##X; } while (0)
#define A_WRITEV(X, st) do { char* vb_ = VS + (st) * 64 * AT_VP + srow * AT_VP + sch * 16; *(u32x2*)vb_ = (u32x2){vr##X[0], vr##X[1]}; *(u32x2*)(vb_ + 8) = (u32x2){vr##X[2], vr##X[3]}; } while (0)
    constexpr int NT = STOT / 64;
    f32x16 sc[2], sn[2];
    A_LOADK(A, 0); A_LOADV(A, 0); A_WRITEK(A, 0); A_WRITEV(A, 0); A_LOADK(A, 64); A_WRITEK(A, 1); A_LOADK(B, 128); A_LOADV(B, 64); __syncthreads();
#pragma unroll
    for (int kt = 0; kt < 2; ++kt) {
#pragma unroll
        for (int r = 0; r < 16; ++r) sc[kt][r] = negM;
#pragma unroll
        for (int ds = 0; ds < 4; ++ds) { const bf16x8 ka = *(const bf16x8*)(KS + (kt * 32 + r32) * AT_KP + (ds * 16 + hi * 8) * 2); sc[kt] = MFMA(ka, qf[ds], sc[kt]); }
    }
    __syncthreads();
    f32x16 ol;
#pragma unroll
    for (int r = 0; r < 16; ++r) ol[r] = 0.f;
    const u32x4 ones_w = {0x3F803F80u, 0x3F803F80u, 0x3F803F80u, 0x3F803F80u};
    const bf16x8 ones = *(const bf16x8*)&ones_w;
#define A_STEP(J, SC, SN, XW, XL) do { const int j_ = (J); \
        const int jk = (j_ + 3 < NT) ? j_ + 3 : NT - 1, jv = (j_ + 2 < NT) ? j_ + 2 : NT - 1; \
        A_LOADK(XL, jk * 64); A_LOADV(XL, jv * 64); \
        const char* ksn = KS + ((j_ + 1) & 1) * 64 * AT_KP; const char* vs = VS + (j_ & 1) * 64 * AT_VP; \
        _Pragma("unroll") for (int kt = 0; kt < 2; ++kt) { \
            _Pragma("unroll") for (int r = 0; r < 16; ++r) SN[kt][r] = negM; \
            _Pragma("unroll") for (int ds = 0; ds < 4; ++ds) { \
                const bf16x8 ka = *(const bf16x8*)(ksn + (kt * 32 + r32) * AT_KP + (ds * 16 + hi * 8) * 2); \
                SN[kt] = MFMA(ka, qf[ds], SN[kt]); \
                _Pragma("unroll") for (int e = 0; e < 4; ++e) { const int f = (kt * 4 + ds) * 4 + e; SC[f >> 4][f & 15] = __builtin_amdgcn_exp2f(SC[f >> 4][f & 15]); } \
                __builtin_amdgcn_sched_barrier(0); } } \
        _Pragma("unroll") for (int kt = 0; kt < 2; ++kt) \
            _Pragma("unroll") for (int s = 0; s < 2; ++s) { \
                u32x4 pw = {pk2(SC[kt][8 * s], SC[kt][8 * s + 1]), pk2(SC[kt][8 * s + 2], SC[kt][8 * s + 3]), pk2(SC[kt][8 * s + 4], SC[kt][8 * s + 5]), pk2(SC[kt][8 * s + 6], SC[kt][8 * s + 7])}; \
                const bf16x8 pb = *(bf16x8*)&pw; \
                _Pragma("unroll") for (int dt = 0; dt < 2; ++dt) { \
                    const char* vp = vs + (dt * 32 + r32) * AT_VP + (kt * 32 + s * 16 + hi * 4) * 2; \
                    const u32x2 lo = *(const u32x2*)vp, hh = *(const u32x2*)(vp + 16); \
                    u32x4 aw = {lo[0], lo[1], hh[0], hh[1]}; \
                    o[dt] = MFMA(*(bf16x8*)&aw, pb, o[dt]); } \
                ol = MFMA(ones, pb, ol); } \
        A_WRITEK(XW, j_ & 1); A_WRITEV(XW, (j_ + 1) & 1); \
        __syncthreads(); } while (0)
#pragma unroll 1
    for (int j = 0; j < NT; j += 2) { A_STEP(j, sc, sn, B, A); A_STEP(j + 1, sn, sc, A, B); }
#undef A_STEP
    lsum = ol[0];
#undef A_LOADK
#undef A_LOADV
#undef A_WRITEK
#undef A_WRITEV
    const float inv = fast_rcp(lsum);
    bf16_t* outp = (bf16_t*)(ws + WS_A2) + ((size_t)b * SEQ + qblk * 256 + wid * 32 + r32) * KOUT + head * 64;
#pragma unroll
    for (int dt = 0; dt < 2; ++dt)
#pragma unroll
        for (int g = 0; g < 4; ++g) {
            u32x2 v = {pk2(o[dt][4 * g] * inv, o[dt][4 * g + 1] * inv), pk2(o[dt][4 * g + 2] * inv, o[dt][4 * g + 3] * inv)};
            *(u32x2*)(outp + dt * 32 + g * 8 + hi * 4) = v;
        }
}

constexpr int LR_RAW = 0;
constexpr int LR_U   = 33792;
constexpr int LR_BB  = LR_U + 33280;
constexpr int LR_UB  = LR_BB + 33280;
constexpr int LR_WG  = LR_UB + 18432;
constexpr int LR_SEG = LR_WG + 18432;
constexpr int LR_HC  = LR_SEG + 4096;
constexpr int LR_CST = LR_HC + 512;
constexpr int LR_END = LR_CST + 768;
__device__ void lru_item(const Args& a, char* lds, int b, int n, int d) {
    const int tid = threadIdx.x, lane = tid & 63, wid = tid >> 6, r32 = lane & 31, hi = lane >> 5;
    unsigned char* ws = a.ws;
    float* RAW = (float*)(lds + LR_RAW); float* AA = (float*)(lds + LR_RAW); float* U = (float*)(lds + LR_U); float* BB = (float*)(lds + LR_BB);
    char* UB = lds + LR_UB; char* WG = lds + LR_WG; float* SEG = (float*)(lds + LR_SEG); float* HC = (float*)(lds + LR_HC);
    const bf16_t* Lg = (const bf16_t*)(ws + WS_L) + (size_t)b * STOT * DLRU + n * 64;
    const bf16_t* Zg = (const bf16_t*)(ws + WS_ZG) + (size_t)b * SEQ * DLRU + n * 64;
    bf16_t* Og = (bf16_t*)(ws + WS_A2) + (size_t)b * SEQ * KOUT + 512 + d * 512 + n * 64;
    {
        const bf16_t* wsrc = (const bf16_t*)(ws + WS_RGW) + (size_t)(d * 8 + n) * 128 * 64;
#pragma unroll
        for (int i = 0; i < 2; ++i) { const int c = tid + NTHR * i, r = c >> 3, ch = c & 7; *(u32x4*)(WG + r * 144 + ch * 16) = *(const u32x4*)(wsrc + r * 64 + ch * 8); }
        if (tid < 128) HC[tid] = 0.f;
    }
    const int ct = wid & 1, tt = wid >> 1;
    float* CST = (float*)(lds + LR_CST);
    if (tid < 64) { const int c = n * 64 + tid; CST[tid] = a.in[I_RGBA][d * 512 + c]; CST[64 + tid] = a.in[I_RGBI][d * 512 + c];
        const float x = -a.in[I_RGLAM][d * 512 + c]; CST[128 + tid] = -8.f * (fmaxf(x, 0.f) + log1pf(__expf(-fabsf(x)))); }
    const int sc = tid & 63, sg = tid >> 6;
    const float cw0 = a.in[I_CONVW][0 * 512 + n * 64 + sc], cw1 = a.in[I_CONVW][1 * 512 + n * 64 + sc], cw2 = a.in[I_CONVW][2 * 512 + n * 64 + sc], cw3 = a.in[I_CONVW][3 * 512 + n * 64 + sc];
    const float cbias = a.in[I_CONVB][n * 64 + sc];
    __syncthreads();
    int par = 0;
    for (int step = 0; step < 18; ++step) {
        const bool isctx = step < 2;
        const int tl = isctx ? (d == 0 ? step : 1 - step) : (d == 0 ? step - 2 : 17 - step);
        const int sb = isctx ? 0 : CTX, sl = isctx ? CTX : SEQ, t0 = tl * 128;
        for (int e = tid; e < 131 * 8; e += NTHR) { const int r = e >> 3, ch = e & 7, t = t0 - 2 + r;
            u32x4 v = {0u, 0u, 0u, 0u}; if (t >= 0 && t < sl) v = *(const u32x4*)(Lg + (size_t)(sb + t) * DLRU + ch * 8);
            float* dst = RAW + r * 64 + ch * 8;
            dst[0] = bflo(v[0]); dst[1] = bfhi(v[0]); dst[2] = bflo(v[1]); dst[3] = bfhi(v[1]); dst[4] = bflo(v[2]); dst[5] = bfhi(v[2]); dst[6] = bflo(v[3]); dst[7] = bfhi(v[3]); }
        __syncthreads();
        {
            const float* rp = RAW + (sg * 16) * 64 + sc;
            float x0 = rp[0], x1 = rp[64], x2 = rp[128];
            float* up = U + (sg * 16) * 65 + sc; char* ubp = UB + (sg * 16) * 144 + sc * 2;
#pragma unroll
            for (int i = 0; i < 16; ++i) { const float x3 = rp[(i + 3) * 64];
                const float u = cbias + cw0 * x0 + cw1 * x1 + cw2 * x2 + cw3 * x3;
                up[i * 65] = u; *(bf16_t*)(ubp + i * 144) = f2bf(u); x0 = x1; x1 = x2; x2 = x3; }
        }
        __syncthreads();
        {
            f32x16 ga, gi;
#pragma unroll
            for (int r = 0; r < 16; ++r) { ga[r] = 0.f; gi[r] = 0.f; }
#pragma unroll
            for (int ks = 0; ks < 4; ++ks) {
                const bf16x8 wa = *(const bf16x8*)(WG + (ct * 32 + r32) * 144 + (ks * 16 + hi * 8) * 2);
                const bf16x8 wi = *(const bf16x8*)(WG + (64 + ct * 32 + r32) * 144 + (ks * 16 + hi * 8) * 2);
                const bf16x8 ub = *(const bf16x8*)(UB + (tt * 32 + r32) * 144 + (ks * 16 + hi * 8) * 2);
                ga = MFMA(wa, ub, ga); gi = MFMA(wi, ub, gi);
            }
            const int t = tt * 32 + r32;
#pragma unroll
            for (int r = 0; r < 16; ++r) { const int c = ct * 32 + 8 * (r >> 2) + 4 * hi + (r & 3);
                const float rr = sigmoidf_(ga[r] + CST[c]), ii = sigmoidf_(gi[r] + CST[64 + c]);
                const float la = CST[128 + c] * rr, av = __expf(la), mult = __builtin_amdgcn_sqrtf(fmaxf(1.f - av * av, 0.f));
                const float u = U[t * 65 + c];
                AA[t * 65 + c] = av; BB[t * 65 + c] = mult * ii * u; }
        }
        __syncthreads();
        float av[16], bv[16]; float Ap = 1.f, Bp = 0.f;
#pragma unroll
        for (int k = 0; k < 16; ++k) { const int p = sg * 16 + k, t = d == 0 ? p : 127 - p; av[k] = AA[t * 65 + sc]; bv[k] = BB[t * 65 + sc]; Bp = av[k] * Bp + bv[k]; Ap = av[k] * Ap; }
        SEG[sg * 64 + sc] = Ap; SEG[512 + sg * 64 + sc] = Bp;
        __syncthreads();
        float h = HC[par * 64 + sc];
        for (int s2 = 0; s2 < sg; ++s2) h = SEG[s2 * 64 + sc] * h + SEG[512 + s2 * 64 + sc];
        {
            const int tfirst = d == 0 ? sg * 16 : 127 - sg * 16;
            const bf16_t* zp = Zg + (size_t)(t0 + tfirst) * DLRU + sc; bf16_t* op = Og + (size_t)(t0 + tfirst) * KOUT + sc;
            const int zstep = d == 0 ? DLRU : -DLRU, ostep = d == 0 ? KOUT : -KOUT;
#pragma unroll
            for (int k = 0; k < 16; ++k) { h = av[k] * h + bv[k];
                if (!isctx) { const float gz = bf2f(*zp); *op = f2bf(h * gz); zp += zstep; op += ostep; } }
        }
        if (sg == 7) HC[(par ^ 1) * 64 + sc] = h;
        par ^= 1;
        __syncthreads();
    }
}

#ifndef LRU_REPS
#define LRU_REPS 1
#endif
__device__ void phase_mixer(const Args& a, char* lds, int vb, int nb) {
#pragma unroll 1
    for (int it = vb; it < 256; it += nb) { for (int rep_ = 0; rep_ < LRU_REPS; ++rep_) { lru_item(a, lds, it >> 4, (it >> 1) & 7, it & 1); __syncthreads(); } }
#pragma unroll 1
    for (int at = vb; at < 1024; at += nb) { const int bk = at >> 5, w = at & 31; attn_item(a, lds, bk >> 1, (bk & 1) * 4 + (w >> 3), w & 7); __syncthreads(); }
}

__device__ void phase_outproj(const Args& a, char* lds, int vb, int nb) {
    const int tid = threadIdx.x, lane = tid & 63, wid = tid >> 6, wm = wid & 3, wn = wid >> 2, r32 = lane & 31, hi = lane >> 5;
    const bf16_t* A2 = (const bf16_t*)(a.ws + WS_A2); const bf16_t* WO = (const bf16_t*)(a.ws + WS_WOUT);
    float* MIX = (float*)(a.ws + WS_MIX);
    for (int it = vb; it < 128 * 8; it += nb) {
        const int rt = it >> 3, ct = it & 7, row0 = rt * 256, col0 = ct * 128;
        f32x16 acc[2][2];
        gemm_core<3>(acc, A2 + (size_t)row0 * KOUT, KOUT, WO + (size_t)col0 * KOUT, KOUT, KOUT, lds);
#pragma unroll
        for (int tt = 0; tt < 2; ++tt) {
            float* rp = MIX + (size_t)(row0 + wm * 64 + tt * 32 + r32) * DM + col0 + wn * 64 + hi * 4;
#pragma unroll
            for (int ft = 0; ft < 2; ++ft)
#pragma unroll
                for (int g = 0; g < 4; ++g) { f32x4 v = {acc[ft][tt][4 * g], acc[ft][tt][4 * g + 1], acc[ft][tt][4 * g + 2], acc[ft][tt][4 * g + 3]}; *(f32x4*)(rp + ft * 32 + g * 8) = v; }
        }
    }
}

__device__ void phase_rowpass(const Args& a, int vb, int nb) {
    const int tid = threadIdx.x, lane = tid & 63, wid = tid >> 6;
    const float* mod = (const float*)(a.ws + WS_MOD);
    const float* MIX = (const float*)(a.ws + WS_MIX);
    bf16_t* HX = (bf16_t*)(a.ws + WS_HX2);
    for (int row = vb * 8 + wid; row < NTOK; row += nb * 8) {
        const int b = row >> 11;
        const float* mrow = mod + (size_t)b * 6144;
        f32x4 mv[4], xv[4]; float ss = 0.f;
#pragma unroll
        for (int i = 0; i < 4; ++i) { mv[i] = *(const f32x4*)(MIX + (size_t)row * DM + i * 256 + lane * 4); xv[i] = *(const f32x4*)(a.in[I_X] + (size_t)row * DM + i * 256 + lane * 4);
            ss += mv[i][0] * mv[i][0] + mv[i][1] * mv[i][1] + mv[i][2] * mv[i][2] + mv[i][3] * mv[i][3]; }
        ss = wave_sum(ss);
        const float rinv = rsqrtf(ss * (1.f / DM) + EPS);
        float s2 = 0.f;
#pragma unroll
        for (int i = 0; i < 4; ++i) { const int c = i * 256 + lane * 4;
            const f32x4 gp = *(const f32x4*)(a.in[I_GPOSTMIX] + c), g1 = *(const f32x4*)(mrow + 2048 + c);
#pragma unroll
            for (int j = 0; j < 4; ++j) { const float xm = xv[i][j] + g1[j] * (mv[i][j] * rinv * gp[j]); xv[i][j] = xm; s2 += xm * xm; }
            *(f32x4*)(a.out + (size_t)row * DM + c) = xv[i]; }
        s2 = wave_sum(s2);
        const float rinv2 = rsqrtf(s2 * (1.f / DM) + EPS);
#pragma unroll
        for (int i = 0; i < 4; ++i) { const int c = i * 256 + lane * 4;
            const f32x4 gf = *(const f32x4*)(a.in[I_GPREFFN] + c), sh = *(const f32x4*)(mrow + 3072 + c), sc = *(const f32x4*)(mrow + 4096 + c);
            float o[4];
#pragma unroll
            for (int j = 0; j < 4; ++j) o[j] = xv[i][j] * rinv2 * gf[j] * (1.f + sc[j]) + sh[j];
            u32x2 w = {pk2(o[0], o[1]), pk2(o[2], o[3])}; *(u32x2*)(HX + (size_t)row * DM + c) = w; }
    }
}

__device__ __forceinline__ int fkey(float f) { const int b = __float_as_int(f); return b ^ ((b >> 31) & 0x7fffffff); }
__device__ __forceinline__ float fval(int k) { return __int_as_float(k ^ ((k >> 31) & 0x7fffffff)); }
#define CE_DESC(x, y) do { const int hi_ = max((x), (y)), lo_ = min((x), (y)); (x) = hi_; (y) = lo_; } while (0)
__device__ __forceinline__ void sort16_desc(int (&v)[16]) {
#pragma unroll
    for (int k = 2; k <= 16; k <<= 1)
#pragma unroll
        for (int j = k >> 1; j > 0; j >>= 1)
#pragma unroll
            for (int i = 0; i < 16; ++i) { const int l = i ^ j; if (l > i) { if ((i & k) == 0) { CE_DESC(v[i], v[l]); } else { CE_DESC(v[l], v[i]); } } }
}
__device__ __forceinline__ void merge16_desc(int (&v)[16]) {
#pragma unroll
    for (int j = 8; j > 0; j >>= 1)
#pragma unroll
        for (int i = 0; i < 16; ++i) { const int l = i ^ j; if (l > i) CE_DESC(v[i], v[l]); }
}
__device__ __forceinline__ void top16_merge(int (&A)[16], const int (&B)[16]) {
#pragma unroll
    for (int i = 0; i < 16; ++i) A[i] = max(A[i], B[15 - i]);
    merge16_desc(A);
}
constexpr int PK_QS = 0;
constexpr int PK_SK = 256 * E_PITCH;
constexpr int PK_ML = PK_SK + 128 * E_PITCH;
constexpr int PK_X  = PK_ML + 32768;
constexpr int PK_END = PK_X + 8192;
static_assert(PK_ML >= G_LDS, "the merged lists must lie past the GEMM stages");
__device__ void phase_peer_topk(const Args& a, char* lds, int vb, int nb) {
    const int tid = threadIdx.x, lane = tid & 63, wid = tid >> 6, wm = wid & 3, wn = wid >> 2, r32 = lane & 31, hi = lane >> 5;
    unsigned char* ws = a.ws;
    const bf16_t* HX = (const bf16_t*)(ws + WS_HX2); const bf16_t* WQ = (const bf16_t*)(ws + WS_WQ); const bf16_t* SUBK = (const bf16_t*)(ws + WS_SUBK);
    int* IDX = (int*)(ws + WS_IDX);
    int* ML = (int*)(lds + PK_ML); int* XB = (int*)(lds + PK_X);
    for (int it = vb; it < 128 * 8; it += nb) {
        const int rt = it >> 3, h = it & 7, row0 = rt * 256;
#pragma unroll 1
        for (int p = 0; p < 2; ++p) {
            f32x16 acc[2][2];
            gemm_core<2>(acc, HX + (size_t)row0 * DM, DM, WQ + (size_t)(h * 256 + p * 128) * DM, DM, DM, lds);
            stage_acc(acc, lds + PK_QS);
            {
                const bf16_t* sk = SUBK + (size_t)(h * 2 + p) * 128 * 128;
#pragma unroll
                for (int i = 0; i < 4; ++i) { const int c = tid + NTHR * i, r = c >> 4, ch = c & 15; *(u32x4*)(lds + PK_SK + r * E_PITCH + ch * 16) = *(const u32x4*)(sk + r * 128 + ch * 8); }
            }
            __syncthreads();
#pragma unroll
            for (int ft = 0; ft < 2; ++ft)
#pragma unroll
                for (int tt = 0; tt < 2; ++tt)
#pragma unroll
                    for (int r = 0; r < 16; ++r) acc[ft][tt][r] = 0.f;
#pragma unroll
            for (int ks = 0; ks < 8; ++ks) {
                const bf16x8 a0 = *(const bf16x8*)(lds + PK_SK + (wn * 64 + r32) * E_PITCH + (ks * 16 + hi * 8) * 2), a1 = *(const bf16x8*)(lds + PK_SK + (wn * 64 + 32 + r32) * E_PITCH + (ks * 16 + hi * 8) * 2);
                const bf16x8 b0 = *(const bf16x8*)(lds + PK_QS + (wm * 64 + r32) * E_PITCH + (ks * 16 + hi * 8) * 2), b1 = *(const bf16x8*)(lds + PK_QS + (wm * 64 + 32 + r32) * E_PITCH + (ks * 16 + hi * 8) * 2);
                acc[0][0] = MFMA(a0, b0, acc[0][0]); acc[0][1] = MFMA(a0, b1, acc[0][1]);
                acc[1][0] = MFMA(a1, b0, acc[1][0]); acc[1][1] = MFMA(a1, b1, acc[1][1]);
            }
#pragma unroll
            for (int tt = 0; tt < 2; ++tt) {
                int A[16], B[16];
#pragma unroll
                for (int r = 0; r < 16; ++r) { const int key = wn * 64 + 8 * (r >> 2) + 4 * hi + (r & 3);
                    A[r] = (fkey(acc[0][tt][r]) & ~127) | key; B[r] = (fkey(acc[1][tt][r]) & ~127) | (key + 32); }
                sort16_desc(A); sort16_desc(B); top16_merge(A, B);
#pragma unroll
                for (int r = 0; r < 16; ++r) { auto rr = __builtin_amdgcn_permlane32_swap((unsigned)A[r], (unsigned)A[r], false, false); B[r] = (int)(hi ? rr[0] : rr[1]); }
                top16_merge(A, B);
                const int tok = wm * 64 + tt * 32 + r32;
                if (wn == 1 && hi == 0) {
#pragma unroll
                    for (int r = 0; r < 16; ++r) XB[(wm * 32 + r32) * 16 + r] = A[r];
                }
                __syncthreads();
                if (wn == 0 && hi == 0) {
#pragma unroll
                    for (int r = 0; r < 16; ++r) B[r] = XB[(wm * 32 + r32) * 16 + r];
                    top16_merge(A, B);
#pragma unroll
                    for (int r = 0; r < 16; ++r) ML[(tok * 2 + p) * 16 + r] = A[r];
                }
                __syncthreads();
            }
        }
        if (tid < 256) {
            const int tok = tid;
            int s1[16], s2[16];
#pragma unroll
            for (int r = 0; r < 16; ++r) { s1[r] = ML[(tok * 2 + 0) * 16 + r]; s2[r] = ML[(tok * 2 + 1) * 16 + r]; }
            float f1[16], f2[16];
#pragma unroll
            for (int r = 0; r < 16; ++r) { f1[r] = fval(s1[r] & ~127); f2[r] = fval(s2[r] & ~127); }
            int G0[16], G1[16], G2[16], G3[16];
#pragma unroll
            for (int bb = 0; bb < 16; ++bb) G0[bb] = (fkey(f1[0] + f2[bb]) & ~255) | (0 * 16 + bb);
#pragma unroll
            for (int bb = 0; bb < 8; ++bb) G1[bb] = (fkey(f1[1] + f2[bb]) & ~255) | (1 * 16 + bb);
#pragma unroll
            for (int bb = 0; bb < 5; ++bb) G1[8 + bb] = (fkey(f1[2] + f2[bb]) & ~255) | (2 * 16 + bb);
#pragma unroll
            for (int bb = 0; bb < 3; ++bb) G1[13 + bb] = (fkey(f1[3] + f2[bb]) & ~255) | (3 * 16 + bb);
            G2[0] = (fkey(f1[3] + f2[3]) & ~255) | (3 * 16 + 3);
#pragma unroll
            for (int bb = 0; bb < 3; ++bb) G2[1 + bb] = (fkey(f1[4] + f2[bb]) & ~255) | (4 * 16 + bb);
#pragma unroll
            for (int aa = 5; aa < 8; ++aa)
#pragma unroll
                for (int bb = 0; bb < 2; ++bb) G2[4 + (aa - 5) * 2 + bb] = (fkey(f1[aa] + f2[bb]) & ~255) | (aa * 16 + bb);
#pragma unroll
            for (int aa = 8; aa < 14; ++aa) G2[10 + (aa - 8)] = (fkey(f1[aa] + f2[0]) & ~255) | (aa * 16);
            G3[0] = (fkey(f1[14] + f2[0]) & ~255) | (14 * 16); G3[1] = (fkey(f1[15] + f2[0]) & ~255) | (15 * 16);
#pragma unroll
            for (int r = 2; r < 16; ++r) G3[r] = (int)0x80000000;
            sort16_desc(G0); sort16_desc(G1); sort16_desc(G2); sort16_desc(G3);
            top16_merge(G0, G1); top16_merge(G2, G3); top16_merge(G0, G2);
            float tv[16]; float mx = fval(G0[0] & ~255), sum = 0.f;
#pragma unroll
            for (int r = 0; r < 16; ++r) { tv[r] = __expf(fval(G0[r] & ~255) - mx); sum += tv[r]; }
            const float rs = 1.f / sum;
            const size_t ob = ((size_t)(row0 + tok) * 8 + h) * 16;
#pragma unroll
            for (int r = 0; r < 16; ++r) { const int code = G0[r] & 255, aa = code >> 4, bb = code & 15;
                const int i1 = ML[(tok * 2 + 0) * 16 + aa] & 127, i2 = ML[(tok * 2 + 1) * 16 + bb] & 127;
                IDX[ob + r] = (i1 * 128 + i2) | (int)((unsigned)f2bf(tv[r] * rs) << 16); }
        }
        __syncthreads();
    }
}

constexpr int P7_RSHIFT = 8;
constexpr int P7_ROUNDS = PEER_N >> P7_RSHIFT;
template <int CTRL> __device__ __forceinline__ float dpp_add(float v) { return v + __uint_as_float(__builtin_amdgcn_update_dpp(0u, __float_as_uint(v), CTRL, 0xf, 0xf, true)); }
__device__ __forceinline__ float wave_sum_bcast(float p) {
    p = dpp_add<0xB1>(p); p = dpp_add<0x4E>(p); p = dpp_add<0x141>(p); p = dpp_add<0x140>(p);
    const unsigned u = __float_as_uint(p);
    return (__uint_as_float(__builtin_amdgcn_readlane(u, 0)) + __uint_as_float(__builtin_amdgcn_readlane(u, 16))) + (__uint_as_float(__builtin_amdgcn_readlane(u, 32)) + __uint_as_float(__builtin_amdgcn_readlane(u, 48)));
}
__device__ __forceinline__ float dot16(const u32x4 a0, const u32x4 a1, const u32x4 b0, const u32x4 b1) {
    float acc = 0.f;
#pragma unroll
    for (int i = 0; i < 4; ++i) { acc = __builtin_amdgcn_fdot2_f32_bf16(as_bf2(a0[i]), as_bf2(b0[i]), acc, false); acc = __builtin_amdgcn_fdot2_f32_bf16(as_bf2(a1[i]), as_bf2(b1[i]), acc, false); }
    return acc;
}
typedef float f32x4v __attribute__((ext_vector_type(4)));
constexpr int P7_RS = 9;
constexpr int P7_NR = PEER_N >> P7_RS;
constexpr int P7_HTP = 1024 + 64;
constexpr float H_SCALE = 16.f;
constexpr int P7_WLDS = 4 * P7_HTP + 2048 + 8192 + 2048;
__device__ void phase_peer_gather(const Args& a, char* lds, int vb, int nb) {
    const int tid = threadIdx.x, lane = tid & 63, wid = tid >> 6, r16 = lane & 15, kg = lane >> 4;
    unsigned char* ws = a.ws;
    const bf16_t* HX = (const bf16_t*)(ws + WS_HX2);
    const int* IDX = (const int*)(ws + WS_IDX);
    const float* mod = (const float*)(ws + WS_MOD);
    const unsigned char* UT = ws + WS_UT; const unsigned char* VT = ws + WS_VT;
    char* HT = lds + wid * P7_WLDS; unsigned* LIST = (unsigned*)(HT + 4 * P7_HTP); char* AT = HT + 4 * P7_HTP + 2048; char* ST = AT + 8192;
#pragma unroll 1
    for (int tb = vb * 32; tb < NTOK; tb += nb * 32) {
        const int tok0 = tb + wid * 4;
        {
            int* HIST = (int*)HT; int* CUR = HIST + 128;
            int ee[8];
            const int* ip = IDX + (size_t)tok0 * 128 + lane;
#pragma unroll
            for (int k = 0; k < 4; ++k) { ee[2 * k] = ip[k * 128]; ee[2 * k + 1] = ip[k * 128 + 64]; }
            HIST[lane] = 0; HIST[64 + lane] = 0;
#pragma unroll
            for (int j = 0; j < 8; ++j) atomicAdd(&HIST[(((ee[j] >> P7_RS) & (P7_NR - 1)) << 2) | (j >> 1)], 1);
            const int c0 = HIST[2 * lane], c1 = HIST[2 * lane + 1];
            int inc = c0 + c1;
#pragma unroll
            for (int o = 1; o < 64; o <<= 1) { const int t = __shfl_up(inc, o); if (lane >= o) inc += t; }
            CUR[2 * lane] = inc - c0 - c1; CUR[2 * lane + 1] = inc - c1;
#pragma unroll
            for (int j = 0; j < 8; ++j) { const unsigned w = (unsigned)ee[j]; const int slot = atomicAdd(&CUR[(((w >> P7_RS) & (P7_NR - 1)) << 2) | (j >> 1)], 1);
                LIST[slot] = (w & 16383u) | ((unsigned)(j >> 1) << 14) | ((w >> 16) << 17); }
        }
        {
            const bf16_t* hp = HX + (size_t)tok0 * DM + lane * 16;
#pragma unroll
            for (int k = 0; k < 4; ++k) { const u32x4 h0 = *(const u32x4*)(hp + k * DM), h1 = *(const u32x4*)(hp + k * DM + 8);
                u32x4 o;
#pragma unroll
                for (int q = 0; q < 4; ++q) { const unsigned wa = q < 2 ? h0[2 * q] : h1[2 * q - 4], wb = q < 2 ? h0[2 * q + 1] : h1[2 * q - 3];
                    int w = __builtin_amdgcn_cvt_pk_fp8_f32(bflo(wa) * H_SCALE, bfhi(wa) * H_SCALE, 0, false); w = __builtin_amdgcn_cvt_pk_fp8_f32(bflo(wb) * H_SCALE, bfhi(wb) * H_SCALE, w, true); o[q] = (unsigned)w; }
                *(u32x4*)(HT + k * P7_HTP + lane * 16) = o;
                *(u32x4*)(AT + k * 2048 + lane * 32) = (u32x4){0u, 0u, 0u, 0u}; *(u32x4*)(AT + k * 2048 + lane * 32 + 16) = (u32x4){0u, 0u, 0u, 0u}; }
        }
        const char* hb0 = HT + (lane & 3) * P7_HTP + kg * 8;
        u32x4 c0 = {0u, 0u, 0u, 0u}, c1 = {0u, 0u, 0u, 0u}; unsigned cur = 0u;
#pragma unroll 1
        for (int bi = 0; bi < 32; ++bi) {
            const unsigned entv = LIST[bi * 16 + r16];
            f32x4v D = {0.f, 0.f, 0.f, 0.f};
            const unsigned e_lo = (unsigned)__shfl((int)entv, lane >> 3) & 16383u, e_hi = (unsigned)__shfl((int)entv, 8 + (lane >> 3)) & 16383u;
            const unsigned char* ul = UT + (size_t)e_lo * DM + (lane & 7) * 16; const unsigned char* uh = UT + (size_t)e_hi * DM + (lane & 7) * 16;
            const int wlo = (lane >> 3) * 128 + (((lane & 7) ^ ((lane >> 4) & 7)) << 4), whi = (8 + (lane >> 3)) * 128 + (((lane & 7) ^ (4 + ((lane >> 4) & 3))) << 4);
            u32x4 ua[8], uc[8];
#pragma unroll
            for (int kc = 0; kc < 8; ++kc) { ua[kc] = *(const u32x4*)(ul + kc * 128); uc[kc] = *(const u32x4*)(uh + kc * 128); }
#pragma unroll
            for (int kc = 0; kc < 8; ++kc) {
                *(u32x4*)(ST + wlo) = ua[kc]; *(u32x4*)(ST + whi) = uc[kc];
#pragma unroll
                for (int t = 0; t < 4; ++t) {
                    const int ci = 2 * t + (kg >> 1);
                    const long a0 = *(const long*)(ST + r16 * 128 + ((ci ^ ((r16 >> 1) & 7)) << 4) + (kg & 1) * 8);
                    const long b0 = *(const long*)(hb0 + kc * 128 + t * 32);
                    D = __builtin_amdgcn_mfma_f32_16x16x32_fp8_fp8(a0, b0, D, 0, 0, 0);
                }
            }
            float dsel = 0.f;
#pragma unroll
            for (int i = 0; i < 4; ++i) {
                const unsigned er = (unsigned)__shfl((int)entv, 4 * kg + i);
                float m = (((er >> 14) & 3u) == (unsigned)(lane & 3)) ? D[i] : 0.f;
                m = dpp_add<0xB1>(m); m = dpp_add<0x4E>(m);
                dsel = ((lane & 3) == i) ? m : dsel;
            }
            const unsigned gl = __float_as_uint(gelu_tanh(dsel * (1.f / (T_SCALE * H_SCALE))));
#pragma unroll 1
            for (int r0 = 0; r0 < 16; r0 += 8) {
                u32x4 vbuf[8]; unsigned ent[8];
#pragma unroll
                for (int b = 0; b < 8; ++b) { ent[b] = (unsigned)__builtin_amdgcn_readlane((int)entv, r0 + b);
                    vbuf[b] = *(const u32x4*)(VT + (size_t)(ent[b] & 16383u) * DM + lane * 16); }
#pragma unroll
                for (int b = 0; b < 8; ++b) {
                    const int r = r0 + b;
                    const float w_ = __uint_as_float(__builtin_amdgcn_readlane(gl, 16 * (r >> 2) + (r & 3))) * __uint_as_float((ent[b] >> 17) << 16);
                    const h16x2 w2 = as_h2(pkh2(w_, w_));
                    const unsigned tk = (ent[b] >> 14) & 3u;
                    if (tk != cur) {
                        char* apo = AT + cur * 2048 + lane * 32; *(u32x4*)apo = c0; *(u32x4*)(apo + 16) = c1;
                        const char* apn = AT + tk * 2048 + lane * 32; c0 = *(const u32x4*)apn; c1 = *(const u32x4*)(apn + 16); cur = tk; }
#pragma unroll
                    for (int q_ = 0; q_ < 4; ++q_) { const unsigned vw_ = vbuf[b][q_];
                        const h16x2 lo = __builtin_amdgcn_cvt_scalef32_pk_f16_fp8(vw_, V_SCALE / T_SCALE, false), hi2 = __builtin_amdgcn_cvt_scalef32_pk_f16_fp8(vw_, V_SCALE / T_SCALE, true);
                        if (q_ < 2) { c0[2 * q_] = __builtin_bit_cast(unsigned, __builtin_elementwise_fma(lo, w2, as_h2(c0[2 * q_]))); c0[2 * q_ + 1] = __builtin_bit_cast(unsigned, __builtin_elementwise_fma(hi2, w2, as_h2(c0[2 * q_ + 1]))); }
                        else { c1[2 * q_ - 4] = __builtin_bit_cast(unsigned, __builtin_elementwise_fma(lo, w2, as_h2(c1[2 * q_ - 4]))); c1[2 * q_ - 3] = __builtin_bit_cast(unsigned, __builtin_elementwise_fma(hi2, w2, as_h2(c1[2 * q_ - 3]))); } }
                }
            }
        }
        { char* apo = AT + cur * 2048 + lane * 32; *(u32x4*)apo = c0; *(u32x4*)(apo + 16) = c1; }
#pragma unroll
        for (int k = 0; k < 4; ++k) {
            const int tok = tok0 + k;
            float f[16]; float ss = 0.f;
            const u32x4 e0 = *(const u32x4*)(AT + k * 2048 + lane * 32), e1 = *(const u32x4*)(AT + k * 2048 + lane * 32 + 16);
#pragma unroll
            for (int i = 0; i < 8; ++i) { const unsigned cw = i < 4 ? e0[i] : e1[i - 4]; const h16x2 hv = as_h2(cw);
                f[2 * i] = (float)hv[0] * (1.f / V_SCALE); f[2 * i + 1] = (float)hv[1] * (1.f / V_SCALE); ss += f[2 * i] * f[2 * i] + f[2 * i + 1] * f[2 * i + 1]; }
            ss = wave_sum_bcast(ss);
            const float rinv = rsqrtf(ss * (1.f / DM) + EPS);
            const float* g2 = mod + (size_t)(tok >> 11) * 6144 + 5120;
#pragma unroll
            for (int q4 = 0; q4 < 4; ++q4) {
                const int c = lane * 16 + q4 * 4;
                float* op = a.out + (size_t)tok * DM + c;
                const f32x4 xm = *(const f32x4*)op, g2v = *(const f32x4*)(g2 + c), gp = *(const f32x4*)(a.in[I_GPOSTFFN] + c);
                f32x4 o;
#pragma unroll
                for (int jj = 0; jj < 4; ++jj) o[jj] = xm[jj] + g2v[jj] * (f[q4 * 4 + jj] * rinv * gp[jj]);
                *(f32x4*)op = o; }
        }
    }
}

#ifdef DBG_DIGEST
__device__ void phase_digest(const Args& a, int vb, int nb) {
    const bf16_t* A2 = (const bf16_t*)(a.ws + WS_A2);
    const bf16_t* Q = (const bf16_t*)(a.ws + WS_Q); const bf16_t* K = (const bf16_t*)(a.ws + WS_K); const bf16_t* VV = (const bf16_t*)(a.ws + WS_VV);
    const bf16_t* L = (const bf16_t*)(a.ws + WS_L); const bf16_t* ZG = (const bf16_t*)(a.ws + WS_ZG);
    for (size_t e = (size_t)vb * NTHR + threadIdx.x; e < (size_t)NTOK * DM; e += (size_t)nb * NTHR) {
        float v = 0.f;
#if DBG_DIGEST == 3
        const size_t row = e >> 10; const int c = (int)(e & 1023);
        v = bf2f(A2[row * KOUT + c]); if (c < 512) v += bf2f(A2[row * KOUT + 1024 + c]);
#elif DBG_DIGEST == 2
        const size_t h = e % ((size_t)NTOK * 512);
        v = bf2f(Q[h]) + bf2f(ZG[h]) + bf2f(L[e % ((size_t)NB * STOT * 512)]);
        if (e < (size_t)NB * 2 * STOT * 64) v += bf2f(K[e]) + bf2f(VV[e]);
#endif
        a.out[e] = v; }
}
#endif
constexpr int LDS_BYTES = 155648;
constexpr int LDS_BARST = LDS_BYTES - 16;
static_assert(8 * P7_WLDS <= LDS_BARST && PK_END <= LDS_BARST && LR_END <= LDS_BARST && 3 * G_STAGE <= LDS_BARST && 17 * 1024 * 4 + 17 * 24 * 4 <= LDS_BARST, "LDS budget");
constexpr int N_PHASES = 8;

__global__ void __launch_bounds__(NTHR, 2) mk_fwd(Args a) {
    extern __shared__ __attribute__((aligned(16))) char lds[];
    const int nb = gridDim.x, bx = blockIdx.x;
    const int vb0 = (nb % 8 == 0) ? (bx % 8) * (nb / 8) + bx / 8 : bx;
    XcdBarrier bar; bar.bar = (unsigned*)(a.ws + WS_CTL); bar.x = 0; bar.st = (volatile LAS unsigned*)(LAS char*)(lds + LDS_BARST);
    const bool multi = (a.ph_hi - a.ph_lo) > 1;
    if (multi) {
        if (threadIdx.x < 4) ((volatile LAS unsigned*)(LAS char*)(lds + LDS_BARST))[threadIdx.x] = 0u;
        __syncthreads();
        bar = xcd_barrier_post((unsigned*)(a.ws + WS_CTL), (volatile LAS unsigned*)(LAS char*)(lds + LDS_BARST));
    }
#ifndef P7_PROBE
#define P7_PROBE -1
#endif
#ifndef DBL_PHASE
#define DBL_PHASE 0
#endif
#if DBL_PHASE != 0
#define RUN_PHASE(P, CALL) do { if (a.ph_lo <= (P) && (P) < a.ph_hi) { const int nrep_ = ((a.dbl >> (P)) & 1) ? 2 : 1; for (int rep_ = 0; rep_ < nrep_; ++rep_) { CALL; if ((P) + 1 < a.ph_hi || rep_ + 1 < nrep_) xcd_barrier(bar); } } } while (0)
#else
#define RUN_PHASE(P, CALL) do { if (a.ph_lo <= (P) && (P) < a.ph_hi) { CALL; if ((P) + 1 < a.ph_hi) xcd_barrier(bar); } } while (0)
#endif
#if !defined(ONLY_PHASE) || ONLY_PHASE == 0
    RUN_PHASE(0, phase_prep(a, lds, vb0, nb));
#endif
    int vb = vb0;
    if (multi && a.ph_lo == 0 && a.ph_hi > 1) {
        if (threadIdx.x == 0) { unsigned off = 0; for (unsigned j = 0; j < bar.x; ++j) off += xb_ld(&bar.bar[XB_XCNT(j)]); bar.st[3] = off + bar.st[2]; }
        __syncthreads();
        vb = (int)bar.st[3];
    }
#if !defined(ONLY_PHASE) || ONLY_PHASE == 1
    RUN_PHASE(1, phase_xn(a, vb, nb));
#endif
#if !defined(ONLY_PHASE) || ONLY_PHASE == 2
    RUN_PHASE(2, phase_inproj(a, lds, vb, nb));
#endif
#if (!defined(ONLY_PHASE) || ONLY_PHASE == 3) && !(defined(DBG_DIGEST) && DBG_DIGEST == 2)
    RUN_PHASE(3, phase_mixer(a, lds, vb, nb));
#endif
#ifdef DBG_DIGEST
    if (a.ph_lo <= 4 && 4 < a.ph_hi) phase_digest(a, vb, nb);
    return;
#endif
#if !defined(ONLY_PHASE) || ONLY_PHASE == 4
    RUN_PHASE(4, phase_outproj(a, lds, vb, nb));
#endif
#if !defined(ONLY_PHASE) || ONLY_PHASE == 5
    RUN_PHASE(5, phase_rowpass(a, vb, nb));
#endif
#if !defined(ONLY_PHASE) || ONLY_PHASE == 6
    RUN_PHASE(6, phase_peer_topk(a, lds, vb, nb));
#endif
#if !defined(ONLY_PHASE) || ONLY_PHASE == 7
    RUN_PHASE(7, phase_peer_gather(a, lds, vb, nb));
#endif
}

extern "C" void kernel_launch(void* const* d_in, const int* in_sizes, int n_in, void* d_out, int out_size, void* d_ws, size_t ws_size, hipStream_t stream) {
    static int grid = 0;
    if (grid == 0) {
        if (n_in != 25 || out_size != NTOK * DM || ws_size < WS_END) { fprintf(stderr, "kernel_launch: unexpected shapes (n_in %d, out %d, ws %zu, need %zu)\n", n_in, out_size, ws_size, (size_t)WS_END); grid = -1; return; }
        int dev = 0, cus = 0;
        if (hipGetDevice(&dev) != hipSuccess || hipDeviceGetAttribute(&cus, hipDeviceAttributeMultiprocessorCount, dev) != hipSuccess) { grid = -1; return; }
        if (hipFuncSetAttribute((const void*)mk_fwd, hipFuncAttributeMaxDynamicSharedMemorySize, LDS_BYTES) != hipSuccess) { fprintf(stderr, "kernel_launch: hipFuncSetAttribute failed\n"); grid = -1; return; }
        (void)hipGetLastError();
        grid = cus;
    }
    if (grid < 0) return;
    (void)hipMemsetAsync((char*)d_ws + WS_CTL, 0, CTL_BYTES, stream);
    Args a{};
    for (int i = 0; i < 25; ++i) a.in[i] = (const float*)d_in[i];
    a.out = (float*)d_out; a.ws = (unsigned char*)d_ws; a.dbl = DBL_PHASE; a.probe = P7_PROBE;
#if MK_N_LAUNCHES == 1
    a.ph_lo = 0; a.ph_hi = N_PHASES;
    hipLaunchKernelGGL(mk_fwd, dim3(grid), dim3(NTHR), LDS_BYTES, stream, a);
#else
    for (int ph = 0; ph < N_PHASES; ++ph) { a.ph_lo = ph; a.ph_hi = ph + 1; hipLaunchKernelGGL(mk_fwd, dim3(grid), dim3(NTHR), LDS_BYTES, stream, a); }
#endif
}
```

```cpp
#include <hip/hip_runtime.h>
#include <cstdio>
#include <cstdint>

#ifndef MK_N_LAUNCHES
#define MK_N_LAUNCHES 1
#endif

typedef unsigned short bf16_t;
typedef short bf16x8 __attribute__((ext_vector_type(8)));
typedef float f32x16 __attribute__((ext_vector_type(16)));
typedef float f32x4 __attribute__((ext_vector_type(4)));
typedef float f32x2 __attribute__((ext_vector_type(2)));
typedef unsigned u32x4 __attribute__((ext_vector_type(4)));
typedef unsigned u32x2 __attribute__((ext_vector_type(2)));
#define LAS __attribute__((address_space(3)))

constexpr int DM = 1024, NB = 16, SEQ = 2048, CTX = 256, STOT = SEQ + CTX;
constexpr int NTOK = NB * SEQ;
constexpr int NCTX = NB * CTX;
constexpr int NROWS = NTOK + NCTX;
constexpr int DIN = 1792, DLRU = 512;
constexpr int KOUT = 1536;
constexpr int PEER_N = 16384;
constexpr float EPS = 1e-6f;
constexpr int NTHR = 512;

constexpr size_t al256(size_t x) { return (x + 255) & ~(size_t)255; }
constexpr size_t WS_CTL   = 0;
constexpr size_t CTL_BYTES = 65536;
constexpr size_t WS_MOD   = WS_CTL + CTL_BYTES;
constexpr size_t WS_ROPE  = WS_MOD + al256(17 * 6144 * 4);
constexpr size_t WS_WIN   = WS_ROPE + al256(64 * 16 * 2 * 4);
constexpr size_t WS_WOUT  = WS_WIN + al256((size_t)DIN * DM * 2);
constexpr size_t WS_WQ    = WS_WOUT + al256((size_t)DM * KOUT * 2);
constexpr size_t WS_SUBK  = WS_WQ + al256((size_t)2048 * DM * 2);
constexpr size_t WS_RGW   = WS_SUBK + al256((size_t)8 * 2 * 128 * 128 * 2);
constexpr size_t WS_UT    = WS_RGW + al256((size_t)2 * 8 * 128 * 64 * 2);
constexpr size_t WS_VT    = WS_UT + al256((size_t)PEER_N * DM * 2);
constexpr size_t WS_XN    = WS_VT + al256((size_t)PEER_N * DM * 2);
constexpr size_t WS_Q     = WS_XN + al256((size_t)NROWS * DM * 2);
constexpr size_t WS_K     = WS_Q + al256((size_t)NTOK * 512 * 2);
constexpr size_t WS_VV    = WS_K + al256((size_t)NB * 2 * STOT * 64 * 2);
constexpr size_t WS_L     = WS_VV + al256((size_t)NB * 2 * STOT * 64 * 2);
constexpr size_t WS_ZG    = WS_L + al256((size_t)NB * STOT * DLRU * 2);
constexpr size_t WS_A2    = WS_ZG + al256((size_t)NTOK * DLRU * 2);
constexpr size_t WS_END   = WS_A2 + al256((size_t)NTOK * KOUT * 2);
constexpr size_t WS_MIX   = WS_XN;
constexpr size_t WS_HX2   = WS_A2;
constexpr size_t WS_IDX   = WS_ZG;
constexpr size_t WS_GATE  = WS_ZG + (size_t)NTOK * 128 * 4;
static_assert(WS_MIX + (size_t)NTOK * DM * 4 <= WS_ZG, "MIX overlay must end before ZG");
static_assert(WS_GATE + (size_t)NTOK * 128 * 4 <= WS_A2, "IDX/GATE overlay must end before A2");

typedef __bf16 bf16x2_t __attribute__((ext_vector_type(2)));
__device__ __forceinline__ unsigned pk2(float lo, float hi) { const f32x2 v = {lo, hi}; const bf16x2_t b = __builtin_convertvector(v, bf16x2_t); return __builtin_bit_cast(unsigned, b); }
typedef _Float16 h16x2 __attribute__((ext_vector_type(2)));
constexpr float V_SCALE = 64.f;
constexpr float T_SCALE = 256.f;
#ifndef P7_FP8
#define P7_FP8 1
#endif
__device__ __forceinline__ unsigned pkh2(float lo, float hi) { const h16x2 h = {(_Float16)lo, (_Float16)hi}; return __builtin_bit_cast(unsigned, h); }
__device__ __forceinline__ bf16x2_t as_bf2(unsigned x) { return __builtin_bit_cast(bf16x2_t, x); }
__device__ __forceinline__ h16x2 as_h2(unsigned x) { return __builtin_bit_cast(h16x2, x); }
__device__ __forceinline__ bf16_t f2bf(float f) { return (bf16_t)(pk2(f, 0.f) & 0xffffu); }
__device__ __forceinline__ float bf2f(unsigned h) { return __uint_as_float(h << 16); }
__device__ __forceinline__ float bflo(unsigned w) { return __uint_as_float(w << 16); }
__device__ __forceinline__ float bfhi(unsigned w) { return __uint_as_float(w & 0xffff0000u); }
__device__ __forceinline__ float fast_rcp(float x) { return __builtin_amdgcn_rcpf(x); }
__device__ __forceinline__ float sigmoidf_(float x) { return fast_rcp(1.f + __expf(-x)); }
__device__ __forceinline__ float gelu_tanh(float x) { const float y = 0.7978845608028654f * (x + 0.044715f * x * x * x); return x * fast_rcp(1.f + __expf(-2.f * y)); }
__device__ __forceinline__ float silu_(float x) { return x * sigmoidf_(x); }
__device__ __forceinline__ float wave_sum(float v) {
#pragma unroll
    for (int o = 32; o > 0; o >>= 1) v += __shfl_xor(v, o);
    return v;
}
__device__ __forceinline__ float half_swap_max(float v) { auto rr = __builtin_amdgcn_permlane32_swap(__float_as_uint(v), __float_as_uint(v), false, false); return fmaxf(__uint_as_float(rr[0]), __uint_as_float(rr[1])); }
__device__ __forceinline__ float half_swap_sum(float v) { auto rr = __builtin_amdgcn_permlane32_swap(__float_as_uint(v), __float_as_uint(v), false, false); return __uint_as_float(rr[0]) + __uint_as_float(rr[1]); }
#define MFMA(a, b, c) __builtin_amdgcn_mfma_f32_32x32x16_bf16((a), (b), (c), 0, 0, 0)

#define XB_TMO      128
#define XB_XCNT(j)  (256  + 64 * (j))
#define XB_XSUB(j)  (1280 + 64 * (j))
#define XB_XGEN(j)  (2304 + 64 * (j))
#define XB_TOP      3328
#define XB_TOPGEN   3392
#define XCD_BAR_WORDS 3456
#define XB_SPIN_CAP (1u << 20)
__device__ __forceinline__ unsigned xb_ld(unsigned* p)              { return __hip_atomic_load(p, __ATOMIC_RELAXED, __HIP_MEMORY_SCOPE_AGENT); }
__device__ __forceinline__ unsigned xb_add(unsigned* p, unsigned v) { return __hip_atomic_fetch_add(p, v, __ATOMIC_RELAXED, __HIP_MEMORY_SCOPE_AGENT); }
__device__ __forceinline__ unsigned xb_xcc_id() { return (unsigned)__builtin_amdgcn_s_getreg((3 << 11) | 20) & 0xFu; }
#define XB_SPIN(cond, bar) do { unsigned _sp = 0; while (cond) { __builtin_amdgcn_s_sleep(1); \
    if ((++_sp & 255u) == 0u) { if (xb_ld(&(bar)[XB_TMO])) break; if (_sp > XB_SPIN_CAP) { atomicAdd(&(bar)[XB_TMO], 1u); break; } } } } while (0)
struct XcdBarrier { unsigned* bar; unsigned x; volatile LAS unsigned* st; };
__device__ __forceinline__ XcdBarrier xcd_barrier_post(unsigned* bar, volatile LAS unsigned* st) {
    XcdBarrier b; b.bar = bar; b.x = xb_xcc_id(); b.st = st;
    if (threadIdx.x == 0) st[2] = xb_add(&bar[XB_XCNT(b.x)], 1u);
    return b;
}
__device__ __forceinline__ void xcd_barrier_complete(unsigned* bar, unsigned x, unsigned& nloc, unsigned& nx) {
    const unsigned G = gridDim.x * gridDim.y * gridDim.z;
    unsigned sum, cnt, mine, sp = 0u;
    for (;;) {
        sum = 0u; cnt = 0u; mine = 0u;
#pragma unroll
        for (unsigned j = 0; j < 16; ++j) { const unsigned c = xb_ld(&bar[XB_XCNT(j)]); sum += c; cnt += (c > 0u) ? 1u : 0u; mine = (j == x) ? c : mine; }
        if (sum == G) break;
        __builtin_amdgcn_s_sleep(1);
        if ((++sp & 255u) == 0u) { if (xb_ld(&bar[XB_TMO])) break; if (sp > XB_SPIN_CAP) { atomicAdd(&bar[XB_TMO], 1u); break; } }
    }
    nloc = mine > 0u ? mine : 1u; nx = cnt > 0u ? cnt : 1u;
}
__device__ __forceinline__ void xcd_barrier(const XcdBarrier& b) {
    asm volatile("s_waitcnt vmcnt(0)" ::: "memory");
    __syncthreads();
    if (threadIdx.x == 0) {
        unsigned* bar = b.bar;
        __builtin_amdgcn_s_waitcnt(0);
        unsigned nloc = b.st[0], nx = b.st[1];
        if (nloc == 0u) { xcd_barrier_complete(bar, b.x, nloc, nx); b.st[0] = nloc; b.st[1] = nx; }
        const unsigned old = xb_add(&bar[XB_XSUB(b.x)], 1u);
        const unsigned gen = old / nloc;
        if (old + 1u == (gen + 1u) * nloc) {
            __builtin_amdgcn_fence(__ATOMIC_RELEASE, "agent");
            asm volatile("s_waitcnt vmcnt(0)" ::: "memory");
            const unsigned og = xb_add(&bar[XB_TOP], 1u);
            const unsigned tg = og / nx;
            if (og + 1u == (tg + 1u) * nx) xb_add(&bar[XB_TOPGEN], 1u);
            else XB_SPIN(xb_ld(&bar[XB_TOPGEN]) == tg, bar);
            __builtin_amdgcn_fence(__ATOMIC_ACQUIRE, "agent");
            xb_add(&bar[XB_XGEN(b.x)], 1u);
            asm volatile("s_waitcnt vmcnt(0)" ::: "memory");
        } else {
            XB_SPIN(xb_ld(&bar[XB_XGEN(b.x)]) == gen, bar);
            __builtin_amdgcn_fence(__ATOMIC_ACQUIRE, "agent");
            asm volatile("s_waitcnt vmcnt(0)" ::: "memory");
        }
    }
    __syncthreads();
}

struct Args { const float* in[25]; float* out; unsigned char* ws; int ph_lo, ph_hi, dbl, probe; };
enum { I_X = 0, I_C, I_CTX, I_CCTX, I_WMOD, I_BMOD, I_GPREMIX, I_GPOSTMIX, I_GPREFFN, I_GPOSTFFN, I_WIN, I_QNG, I_KNG, I_CONVW, I_CONVB,
       I_RGWA, I_RGBA, I_RGWI, I_RGBI, I_RGLAM, I_WOUT, I_PWQ, I_PSUBK, I_PU, I_PV };

__device__ __forceinline__ void tr_tile(const float* __restrict__ src, int lds_, int sr0, int sc0, bf16_t* __restrict__ dst, int ldd, int dr0, int dc0, float* T) {
    const int tid = threadIdx.x;
#pragma unroll
    for (int i = 0; i < 8; ++i) { const int e = tid + NTHR * i, r = e >> 6, c = e & 63; T[r * 65 + c] = src[(size_t)(sr0 + r) * lds_ + sc0 + c]; }
    __syncthreads();
#pragma unroll
    for (int i = 0; i < 8; ++i) { const int e = tid + NTHR * i, c = e >> 6, r = e & 63; dst[(size_t)(dr0 + c) * ldd + dc0 + r] = f2bf(T[r * 65 + c]); }
    __syncthreads();
}

__device__ void phase_prep(const Args& a, char* lds, int vb, int nb) {
    const int tid = threadIdx.x;
    unsigned char* ws = a.ws;
    float* S = (float*)lds;
    float* T = (float*)lds;
    constexpr int N_MOD = 256, N_TIN = 448, N_TOUT = 384, N_TWQ = 512, N_RGW = 32, N_SUBK = 16, N_UV = 512, N_MISC = 1;
    constexpr int O_TIN = N_MOD, O_TOUT = O_TIN + N_TIN, O_TWQ = O_TOUT + N_TOUT, O_RGW = O_TWQ + N_TWQ, O_SUBK = O_RGW + N_RGW, O_UV = O_SUBK + N_SUBK, O_MISC = O_UV + N_UV, N_ALL = O_MISC + N_MISC;
    for (int it = vb; it < N_ALL; it += nb) {
        if (it < O_TIN) {
            for (int e = tid; e < 17 * 1024; e += NTHR) { const int r = e >> 10, k = e & 1023; const float v = (r < 16) ? a.in[I_C][r * 1024 + k] : a.in[I_CCTX][k]; S[e] = silu_(v); }
            __syncthreads();
            const int n0 = it * 24;
            const int cc = tid % 6, kk = tid / 6;
            float acc[17][4];
#pragma unroll
            for (int r = 0; r < 17; ++r) { acc[r][0] = 0.f; acc[r][1] = 0.f; acc[r][2] = 0.f; acc[r][3] = 0.f; }
            if (tid < 510) {
                for (int k = kk; k < 1024; k += 85) {
                    const f32x4 w = *(const f32x4*)(a.in[I_WMOD] + (size_t)k * 6144 + n0 + cc * 4);
#pragma unroll
                    for (int r = 0; r < 17; ++r) { const float s = S[r * 1024 + k]; acc[r][0] += s * w[0]; acc[r][1] += s * w[1]; acc[r][2] += s * w[2]; acc[r][3] += s * w[3]; }
                }
            }
            __syncthreads();
            if (tid < 510) {
#pragma unroll
                for (int r = 0; r < 17; ++r) { f32x4 v = {acc[r][0], acc[r][1], acc[r][2], acc[r][3]}; *(f32x4*)(S + (kk * 17 + r) * 24 + cc * 4) = v; }
            }
            __syncthreads();
            float* mod = (float*)(ws + WS_MOD);
            for (int e = tid; e < 17 * 24; e += NTHR) { const int r = e / 24, j = e % 24; float sum = 0.f;
                for (int q = 0; q < 85; ++q) sum += S[(q * 17 + r) * 24 + j];
                mod[r * 6144 + n0 + j] = sum + a.in[I_BMOD][n0 + j]; }
            __syncthreads();
        } else if (it < O_TOUT) {
            const int t = it - O_TIN, kt = t / 28, nt = t % 28;
            tr_tile(a.in[I_WIN], DIN, kt * 64, nt * 64, (bf16_t*)(ws + WS_WIN), DM, nt * 64, kt * 64, T);
        } else if (it < O_TWQ) {
            const int t = it - O_TOUT, kt = t / 16, nt = t % 16;
            const int sk = (kt < 16) ? kt * 64 : (kt - 16) * 64 + 512;
            tr_tile(a.in[I_WOUT], DM, sk, nt * 64, (bf16_t*)(ws + WS_WOUT), KOUT, nt * 64, kt * 64, T);
        } else if (it < O_RGW) {
            const int t = it - O_TWQ, kt = t / 32, nt = t % 32;
            tr_tile(a.in[I_PWQ], 2048, kt * 64, nt * 64, (bf16_t*)(ws + WS_WQ), DM, nt * 64, kt * 64, T);
        } else if (it < O_SUBK) {
            const int t = it - O_RGW, g = t & 1, dn = t >> 1;
            const float* src = (g == 0 ? a.in[I_RGWA] : a.in[I_RGWI]) + (size_t)dn * 4096;
            tr_tile(src, 64, 0, 0, (bf16_t*)(ws + WS_RGW) + (size_t)dn * 128 * 64 + g * 64 * 64, 64, 0, 0, T);
        } else if (it < O_UV) {
            const int t = it - O_SUBK; const float* src = a.in[I_PSUBK] + (size_t)t * 16384; bf16_t* dst = (bf16_t*)(ws + WS_SUBK) + (size_t)t * 16384;
            for (int e = tid * 4; e < 16384; e += NTHR * 4) { const f32x4 v = *(const f32x4*)(src + e); u32x2 o = {pk2(v[0], v[1]), pk2(v[2], v[3])}; *(u32x2*)(dst + e) = o; }
        } else if (it < O_MISC) {
            const int t = it - O_UV; const bool isv = t >= 256; const int tt = t & 255;
            const float* src = (isv ? a.in[I_PV] : a.in[I_PU]) + (size_t)tt * 65536; bf16_t* dst = (bf16_t*)(ws + (isv ? WS_VT : WS_UT)) + (size_t)tt * 65536;
#if P7_FP8
            unsigned char* d8 = ws + (isv ? WS_VT : WS_UT) + (size_t)tt * 65536;
            for (int e = tid * 16; e < 65536; e += NTHR * 16) { u32x4 o;
#pragma unroll
                for (int q = 0; q < 4; ++q) { f32x4 v = *(const f32x4*)(src + e + q * 4) * T_SCALE;
#pragma unroll
                    for (int i = 0; i < 4; ++i) v[i] = fminf(fmaxf(v[i], -448.f), 448.f);
                    int w = __builtin_amdgcn_cvt_pk_fp8_f32(v[0], v[1], 0, false); w = __builtin_amdgcn_cvt_pk_fp8_f32(v[2], v[3], w, true); o[q] = (unsigned)w; }
                *(u32x4*)(d8 + e) = o; }
#else
            if (!isv) {
                for (int e = tid * 8; e < 65536; e += NTHR * 8) { const f32x4 v0 = *(const f32x4*)(src + e), v1 = *(const f32x4*)(src + e + 4);
                    u32x4 o = {pk2(v0[0], v0[1]), pk2(v0[2], v0[3]), pk2(v1[0], v1[1]), pk2(v1[2], v1[3])}; *(u32x4*)(dst + e) = o; }
            } else {
                for (int e = tid * 8; e < 65536; e += NTHR * 8) { const f32x4 v0 = *(const f32x4*)(src + e) * V_SCALE, v1 = *(const f32x4*)(src + e + 4) * V_SCALE;
                    u32x4 o = {pkh2(v0[0], v0[1]), pkh2(v0[2], v0[3]), pkh2(v1[0], v1[1]), pkh2(v1[2], v1[3])}; *(u32x4*)(dst + e) = o; }
            }
#endif
        } else {
            float* rope = (float*)(ws + WS_ROPE);
            for (int e = tid; e < 64 * 16; e += NTHR) { const int pos = e >> 4, f = e & 15; const float inv = powf(10000.f, -(float)f / 16.f); const float ang = (float)pos * inv; rope[e * 2] = cosf(ang); rope[e * 2 + 1] = sinf(ang); }
        }
    }
}

__device__ void phase_xn(const Args& a, int vb, int nb) {
    const int tid = threadIdx.x, lane = tid & 63, wid = tid >> 6;
    const float* mod = (const float*)(a.ws + WS_MOD);
    bf16_t* XN = (bf16_t*)(a.ws + WS_XN);
    const float* g = a.in[I_GPREMIX];
    for (int row = vb * 8 + wid; row < NROWS; row += nb * 8) {
        const float* src; int mrow;
        if (row < NTOK) { src = a.in[I_X] + (size_t)row * DM; mrow = row >> 11; } else { src = a.in[I_CTX] + (size_t)(row - NTOK) * DM; mrow = 16; }
        f32x4 v[4]; float ss = 0.f;
#pragma unroll
        for (int i = 0; i < 4; ++i) { v[i] = *(const f32x4*)(src + i * 256 + lane * 4); ss += v[i][0] * v[i][0] + v[i][1] * v[i][1] + v[i][2] * v[i][2] + v[i][3] * v[i][3]; }
        ss = wave_sum(ss);
        const float rinv = rsqrtf(ss * (1.f / DM) + EPS);
        const float* sh = mod + (size_t)mrow * 6144, *sc = sh + 1024;
#pragma unroll
        for (int i = 0; i < 4; ++i) { const int c = i * 256 + lane * 4;
            const f32x4 gg = *(const f32x4*)(g + c), s1 = *(const f32x4*)(sc + c), s0 = *(const f32x4*)(sh + c);
            float o[4];
#pragma unroll
            for (int j = 0; j < 4; ++j) o[j] = v[i][j] * rinv * gg[j] * (1.f + s1[j]) + s0[j];
            u32x2 w = {pk2(o[0], o[1]), pk2(o[2], o[3])}; *(u32x2*)(XN + (size_t)row * DM + c) = w; }
    }
}

constexpr int G_STAGE = (256 + 128) * 128;
constexpr int G_LDS = 2 * G_STAGE;
constexpr int E_PITCH = 272;
template <int NSET, bool NOLOAD = false>
__device__ __forceinline__ void gemm_core(f32x16 (&acc)[2][2], const bf16_t* __restrict__ X, int ldx, const bf16_t* __restrict__ Wt, int ldw, int K, char* lds) {
    const int tid = threadIdx.x, lane = tid & 63, wid = tid >> 6, wm = wid & 3, wn = wid >> 2, r32 = lane & 31, hi = lane >> 5;
    const int lrow = tid >> 3, lch = (tid & 7) ^ ((lrow >> 1) & 7);
    const bf16_t* xg = X + (size_t)lrow * ldx + lch * 8;
    const bf16_t* wg = Wt + (size_t)lrow * ldw + lch * 8;
#pragma unroll
    for (int ft = 0; ft < 2; ++ft)
#pragma unroll
        for (int tt = 0; tt < 2; ++tt)
#pragma unroll
            for (int r = 0; r < 16; ++r) acc[ft][tt][r] = 0.f;
#define G_DMA(s, k0) do { char* b_ = lds + (s) * G_STAGE + tid * 16; \
        _Pragma("unroll") for (int i = 0; i < 4; ++i) __builtin_amdgcn_global_load_lds((const unsigned*)(xg + (size_t)i * 64 * ldx + (k0)), (unsigned*)(b_ + i * 8192), 16, 0, 0); \
        _Pragma("unroll") for (int i = 0; i < 2; ++i) __builtin_amdgcn_global_load_lds((const unsigned*)(wg + (size_t)i * 64 * ldw + (k0)), (unsigned*)(b_ + 32768 + i * 8192), 16, 0, 0); } while (0)
    const int nk = K >> 6;
    const int xrow = wm * 64 + r32, wrow = wn * 64 + r32;
    const int xsw = (xrow >> 1) & 7, wsw = (wrow >> 1) & 7;
    int st_c = 0, st_n = 1;
    G_DMA(0, 0);
    if (NSET == 3) { G_DMA(1, 64); st_n = 2; asm volatile("s_waitcnt vmcnt(6)" ::: "memory"); __builtin_amdgcn_s_barrier(); } else { __syncthreads(); }
#pragma unroll 1
    for (int kt = 0; kt < nk; ++kt) {
        { const int kn = (kt + NSET - 1 < nk) ? kt + NSET - 1 : nk - 1; G_DMA(st_n, kn * 64); }
        const char* xs = lds + st_c * G_STAGE + xrow * 128;
        const char* wsb = lds + st_c * G_STAGE + 32768 + wrow * 128;
        bf16x8 fa0[2], fa1[2], fb0[2], fb1[2];
        { const int xo = ((0 * 2 + hi) ^ xsw) << 4, wo = ((0 * 2 + hi) ^ wsw) << 4;
          fa0[0] = *(const bf16x8*)(wsb + wo); fa1[0] = *(const bf16x8*)(wsb + 32 * 128 + wo); fb0[0] = *(const bf16x8*)(xs + xo); fb1[0] = *(const bf16x8*)(xs + 32 * 128 + xo); }
#pragma unroll
        for (int ks = 0; ks < 4; ++ks) {
            if (ks + 1 < 4) { const int xo = (((ks + 1) * 2 + hi) ^ xsw) << 4, wo = (((ks + 1) * 2 + hi) ^ wsw) << 4;
                fa0[(ks + 1) & 1] = *(const bf16x8*)(wsb + wo); fa1[(ks + 1) & 1] = *(const bf16x8*)(wsb + 32 * 128 + wo);
                fb0[(ks + 1) & 1] = *(const bf16x8*)(xs + xo); fb1[(ks + 1) & 1] = *(const bf16x8*)(xs + 32 * 128 + xo); }
            acc[0][0] = MFMA(fa0[ks & 1], fb0[ks & 1], acc[0][0]); acc[0][1] = MFMA(fa0[ks & 1], fb1[ks & 1], acc[0][1]);
            acc[1][0] = MFMA(fa1[ks & 1], fb0[ks & 1], acc[1][0]); acc[1][1] = MFMA(fa1[ks & 1], fb1[ks & 1], acc[1][1]);
            __builtin_amdgcn_sched_barrier(0);
        }
        if (NSET == 3) { asm volatile("s_waitcnt vmcnt(6)" ::: "memory"); __builtin_amdgcn_s_barrier(); st_c = st_c == 2 ? 0 : st_c + 1; st_n = st_n == 2 ? 0 : st_n + 1; }
        else { __syncthreads(); st_c ^= 1; st_n ^= 1; }
    }
    if (NSET == 3) { asm volatile("s_waitcnt vmcnt(0)" ::: "memory"); __syncthreads(); }
#undef G_DMA
}
__device__ __forceinline__ void stage_acc(const f32x16 (&acc)[2][2], char* lds) {
    const int tid = threadIdx.x, lane = tid & 63, wid = tid >> 6, wm = wid & 3, wn = wid >> 2, r32 = lane & 31, hi = lane >> 5;
#pragma unroll
    for (int ft = 0; ft < 2; ++ft)
#pragma unroll
        for (int tt = 0; tt < 2; ++tt)
#pragma unroll
            for (int g = 0; g < 4; ++g) {
                u32x2 v = {pk2(acc[ft][tt][4 * g], acc[ft][tt][4 * g + 1]), pk2(acc[ft][tt][4 * g + 2], acc[ft][tt][4 * g + 3])};
                *(u32x2*)(lds + (wm * 64 + tt * 32 + r32) * E_PITCH + (wn * 64 + ft * 32 + g * 8 + hi * 4) * 2) = v;
            }
}

namespace g8 {
constexpr int BM = 256, BK = 64, HALF = 128, HT = HALF * BK, SHM_B = 8 * HT * 2;
__device__ __forceinline__ int lds_byte(int r, int c) { const int st = (r >> 4) * 2 + (c >> 5), rr = r & 15, cc = c & 31, ob = rr * 64 + cc * 2; return st * 1024 + (ob ^ (((ob >> 9) & 1) << 5)); }
__device__ __forceinline__ void stage_rc(int b, int& R, int& C) { const int st = b / 1024, sb = b % 1024, swz = sb ^ (((sb >> 9) & 1) << 5); R = (st >> 1) * 16 + swz / 64; C = (st & 1) * 32 + (swz % 64) / 2; }
__device__ __forceinline__ void core(f32x4 (&acc)[2][2][4][2], const bf16_t* __restrict__ A, const bf16_t* __restrict__ Bt, int brow, int bcol, int K, char* lds_) {
    LAS unsigned char* lds = (LAS unsigned char*)lds_;
    const int tid = threadIdx.x, wid = __builtin_amdgcn_readfirstlane(tid >> 6), lane = tid & 63, wr = wid >> 2, wc = wid & 3, fr = lane & 15, fq = lane >> 4;
    constexpr int HTB = HT * 2;
    unsigned voff[2];
#pragma unroll
    for (int i = 0; i < 2; ++i) { int R, C; stage_rc(tid * 16 + i * 8192, R, C); voff[i] = (unsigned)(R * K + C) * 2u; }
    const size_t kstep = (size_t)(BK * 2), hstep = (size_t)HALF * K * 2;
    const unsigned ldsw = (unsigned)wid * 1024u;
    const int aoff = lds_byte(wr * 64 + fr, fq * 8), boff = lds_byte(wc * 32 + fr, fq * 8);
#define G8_SA(b, h) (((b) * 2 + (h)) * HTB)
#define G8_SB(b, h) ((4 + (b) * 2 + (h)) * HTB)
#define G8_STAGE(bufoff, gbase) do { _Pragma("unroll") for (int _i = 0; _i < 2; ++_i) \
        __builtin_amdgcn_global_load_lds((const unsigned*)((const char*)(gbase) + voff[_i]), (LAS unsigned*)(lds + (bufoff) + ldsw + _i * 8192), 16, 0, 0); } while (0)
#define G8_LDA(dst, b, h) do { _Pragma("unroll") for (int m = 0; m < 4; ++m) _Pragma("unroll") for (int k = 0; k < 2; ++k) dst[m][k] = *(const LAS bf16x8*)(lds + G8_SA(b, h) + aoff + m * 2048 + k * 1024); } while (0)
#define G8_LDB(dst, b, h) do { _Pragma("unroll") for (int n = 0; n < 2; ++n) _Pragma("unroll") for (int k = 0; k < 2; ++k) dst[n][k] = *(const LAS bf16x8*)(lds + G8_SB(b, h) + boff + n * 2048 + k * 1024); } while (0)
#define G8_MMA(ai, bj, At_, Bt_) do { __builtin_amdgcn_s_setprio(1); \
    _Pragma("unroll") for (int m = 0; m < 4; ++m) _Pragma("unroll") for (int n = 0; n < 2; ++n) _Pragma("unroll") for (int k = 0; k < 2; ++k) \
      acc[ai][bj][m][n] = __builtin_amdgcn_mfma_f32_16x16x32_bf16(At_[m][k], Bt_[n][k], acc[ai][bj][m][n], 0, 0, 0); \
    __builtin_amdgcn_s_setprio(0); } while (0)
#define G8_WAIT_V(n) asm volatile("s_waitcnt vmcnt(" #n ")" ::: "memory")
#define G8_WAIT_L(n) asm volatile("s_waitcnt lgkmcnt(" #n ")" ::: "memory")
#define G8_BAR __builtin_amdgcn_s_barrier()
#define G8_SCHED __builtin_amdgcn_sched_barrier(0)
#pragma unroll
    for (int ai = 0; ai < 2; ++ai)
#pragma unroll
        for (int bj = 0; bj < 2; ++bj)
#pragma unroll
            for (int m = 0; m < 4; ++m)
#pragma unroll
                for (int n = 0; n < 2; ++n) acc[ai][bj][m][n] = (f32x4){0.f, 0.f, 0.f, 0.f};
    bf16x8 At[4][2], B0[2][2], B1[2][2];
    const int nt = K / BK;
    const char* cA = (const char*)(A + (size_t)brow * K); const char* cB = (const char*)(Bt + (size_t)bcol * K);
    G8_STAGE(G8_SB(0, 0), cB); G8_STAGE(G8_SA(0, 0), cA); G8_STAGE(G8_SB(0, 1), cB + hstep); G8_STAGE(G8_SA(0, 1), cA + hstep);
    if (wr == 1) G8_BAR;
    G8_WAIT_V(4); G8_BAR;
    G8_STAGE(G8_SB(1, 0), cB + kstep); G8_STAGE(G8_SA(1, 0), cA + kstep); G8_STAGE(G8_SB(1, 1), cB + hstep + kstep);
    G8_WAIT_V(6); G8_BAR;
#pragma unroll 1
    for (int t = 0; t < nt - 2; t += 2) {
        const char* a1 = cA + (size_t)(t + 1) * kstep; const char* a2 = cA + (size_t)(t + 2) * kstep; const char* b2 = cB + (size_t)(t + 2) * kstep;
        const char* a3 = a2 + kstep; const char* b3 = b2 + kstep;
        G8_LDB(B0, 0, 0); G8_SCHED; G8_LDA(At, 0, 0); G8_STAGE(G8_SA(1, 1), a1 + hstep);
        G8_WAIT_L(8); G8_BAR; G8_WAIT_L(0); G8_MMA(0, 0, At, B0); G8_BAR; G8_SCHED;
        G8_LDB(B1, 0, 1); G8_STAGE(G8_SB(0, 0), b2);
        G8_BAR; G8_WAIT_L(0); G8_MMA(0, 1, At, B1); G8_BAR;
        G8_LDA(At, 0, 1); G8_STAGE(G8_SA(0, 0), a2);
        G8_BAR; G8_WAIT_L(0); G8_MMA(1, 0, At, B0); G8_BAR; G8_SCHED;
        G8_STAGE(G8_SB(0, 1), b2 + hstep);
        G8_WAIT_V(6); G8_BAR; G8_MMA(1, 1, At, B1); G8_BAR;
        G8_LDB(B0, 1, 0); G8_SCHED; G8_LDA(At, 1, 0); G8_STAGE(G8_SA(0, 1), a2 + hstep);
        G8_WAIT_L(8); G8_BAR; G8_WAIT_L(0); G8_MMA(0, 0, At, B0); G8_BAR; G8_SCHED;
        G8_LDB(B1, 1, 1); G8_STAGE(G8_SB(1, 0), b3);
        G8_BAR; G8_WAIT_L(0); G8_MMA(0, 1, At, B1); G8_BAR;
        G8_LDA(At, 1, 1); G8_STAGE(G8_SA(1, 0), a3);
        G8_BAR; G8_WAIT_L(0); G8_MMA(1, 0, At, B0); G8_BAR; G8_SCHED;
        G8_STAGE(G8_SB(1, 1), b3 + hstep);
        G8_WAIT_V(6); G8_BAR; G8_MMA(1, 1, At, B1); G8_BAR;
    }
    { G8_LDB(B0, 0, 0); G8_LDA(At, 0, 0); G8_STAGE(G8_SA(1, 1), cA + (size_t)(nt - 1) * kstep + hstep);
      G8_BAR; G8_WAIT_L(0); G8_MMA(0, 0, At, B0); G8_BAR;
      G8_LDB(B1, 0, 1); G8_BAR; G8_WAIT_L(0); G8_MMA(0, 1, At, B1); G8_BAR;
      G8_LDA(At, 0, 1); G8_WAIT_V(4); G8_BAR; G8_WAIT_L(0); G8_MMA(1, 0, At, B0); G8_MMA(1, 1, At, B1); G8_BAR; }
    { G8_LDB(B0, 1, 0); G8_LDA(At, 1, 0); G8_WAIT_V(2); G8_BAR; G8_WAIT_L(0); G8_MMA(0, 0, At, B0); G8_BAR;
      G8_LDB(B1, 1, 1); G8_WAIT_V(0); G8_BAR; G8_WAIT_L(0); G8_MMA(0, 1, At, B1); G8_BAR;
      G8_LDA(At, 1, 1); G8_BAR; G8_WAIT_L(0); G8_MMA(1, 0, At, B0); G8_MMA(1, 1, At, B1); G8_BAR; }
    if (wr == 0) G8_BAR;
#undef G8_SA
#undef G8_SB
#undef G8_STAGE
#undef G8_LDA
#undef G8_LDB
#undef G8_MMA
#undef G8_WAIT_V
#undef G8_WAIT_L
#undef G8_BAR
#undef G8_SCHED
}
}

__device__ void phase_inproj(const Args& a, char* lds, int vb, int nb) {
    const int tid = threadIdx.x, lane = tid & 63, wid = tid >> 6, wr = wid >> 2, wc = wid & 3, fr = lane & 15, fq = lane >> 4;
    unsigned char* ws = a.ws;
    const bf16_t* XN = (const bf16_t*)(ws + WS_XN);
    const bf16_t* WIN = (const bf16_t*)(ws + WS_WIN);
    const float* rope = (const float*)(ws + WS_ROPE);
    bf16_t* Qo = (bf16_t*)(ws + WS_Q); bf16_t* Ko = (bf16_t*)(ws + WS_K); bf16_t* Vo = (bf16_t*)(ws + WS_VV); bf16_t* Lo = (bf16_t*)(ws + WS_L); bf16_t* Zo = (bf16_t*)(ws + WS_ZG);
    constexpr int N_LAT = 128 * 7, N_ALL = N_LAT + 16 * 3;
#pragma unroll 1
    for (int it = vb; it < N_ALL; it += nb) {
        int tt, ft;
        if (it < N_LAT) { tt = it / 7; ft = it % 7; } else { const int j = it - N_LAT; tt = 128 + j / 3; ft = 2 + j % 3; }
        f32x4 acc[2][2][4][2];
        g8::core(acc, WIN, XN, ft * 256, tt * 256, DM, lds);
        const bool lat = tt < 128;
#pragma unroll
        for (int ai = 0; ai < 2; ++ai) {
            const int g64 = ft * 4 + ai * 2 + wr;
            if (g64 < 10) {
                const bool isq = g64 < 8;
                const float* gn = isq ? a.in[I_QNG] : a.in[I_KNG];
                const float osc = isq ? 0.125f * 1.4426950408889634f : 1.f;
                float gnv[4][4];
#pragma unroll
                for (int m = 0; m < 4; ++m) { const f32x4 gv = *(const f32x4*)(gn + m * 16 + fq * 4); gnv[m][0] = gv[0]; gnv[m][1] = gv[1]; gnv[m][2] = gv[2]; gnv[m][3] = gv[3]; }
#pragma unroll
                for (int bj = 0; bj < 2; ++bj)
#pragma unroll
                    for (int n = 0; n < 2; ++n) {
                        float ss = 0.f;
#pragma unroll
                        for (int m = 0; m < 4; ++m)
#pragma unroll
                            for (int j = 0; j < 4; ++j) ss += acc[ai][bj][m][n][j] * acc[ai][bj][m][n][j];
                        ss += __shfl_xor(ss, 16); ss += __shfl_xor(ss, 32);
                        const float rinv = rsqrtf(ss * (1.f / 64.f) + EPS);
                        const int row = tt * 256 + bj * 128 + wc * 32 + n * 16 + fr;
                        int b, t, s_; if (lat) { b = row >> 11; t = row & 2047; s_ = CTX + t; } else { const int rc = row - NTOK; b = rc >> 8; t = 0; s_ = rc & 255; }
                        bf16_t* dst = isq ? Qo + ((size_t)(b * 8 + g64) * SEQ + t) * 64 : Ko + ((size_t)(b * 2 + (g64 - 8)) * STOT + s_) * 64;
#pragma unroll
                        for (int ax = 0; ax < 2; ++ax) {
                            const int pos = ax == 0 ? (t >> 6) : (t & 63);
                            float o1[4], o2[4];
#pragma unroll
                            for (int j = 0; j < 4; ++j) {
                                const float x1 = acc[ai][bj][2 * ax][n][j] * rinv * gnv[2 * ax][j], x2 = acc[ai][bj][2 * ax + 1][n][j] * rinv * gnv[2 * ax + 1][j];
                                float c1 = x1, c2 = x2;
                                if (lat) { const f32x2 cs = *(const f32x2*)(rope + (pos * 16 + fq * 4 + j) * 2); c1 = x1 * cs[0] - x2 * cs[1]; c2 = x1 * cs[1] + x2 * cs[0]; }
                                o1[j] = c1 * osc; o2[j] = c2 * osc; }
                            *(u32x2*)(dst + ax * 32 + fq * 4) = (u32x2){pk2(o1[0], o1[1]), pk2(o1[2], o1[3])};
                            *(u32x2*)(dst + ax * 32 + 16 + fq * 4) = (u32x2){pk2(o2[0], o2[1]), pk2(o2[2], o2[3])};
                        }
                    }
            } else if (g64 < 12) {
#pragma unroll
                for (int bj = 0; bj < 2; ++bj)
#pragma unroll
                    for (int n = 0; n < 2; ++n) {
                        const int row = tt * 256 + bj * 128 + wc * 32 + n * 16 + fr;
                        int b, s_; if (lat) { b = row >> 11; s_ = CTX + (row & 2047); } else { const int rc = row - NTOK; b = rc >> 8; s_ = rc & 255; }
                        bf16_t* vp = Vo + ((size_t)(b * 2 + (g64 - 10)) * 64) * STOT + s_;
#pragma unroll
                        for (int m = 0; m < 4; ++m)
#pragma unroll
                            for (int j = 0; j < 4; ++j) vp[(size_t)(m * 16 + fq * 4 + j) * STOT] = f2bf(acc[ai][bj][m][n][j]);
                    }
            } else {
                const bool isz = g64 >= 20;
#pragma unroll
                for (int bj = 0; bj < 2; ++bj)
#pragma unroll
                    for (int n = 0; n < 2; ++n) {
                        const int row = tt * 256 + bj * 128 + wc * 32 + n * 16 + fr;
                        bf16_t* dst;
                        if (isz) dst = Zo + (size_t)row * DLRU + (g64 - 20) * 64;
                        else { int b, s_; if (lat) { b = row >> 11; s_ = CTX + (row & 2047); } else { const int rc = row - NTOK; b = rc >> 8; s_ = rc & 255; }
                            dst = Lo + ((size_t)b * STOT + s_) * DLRU + (g64 - 12) * 64; }
#pragma unroll
                        for (int m = 0; m < 4; ++m) { f32x4 v = acc[ai][bj][m][n];
                            if (isz) { v[0] = gelu_tanh(v[0]); v[1] = gelu_tanh(v[1]); v[2] = gelu_tanh(v[2]); v[3] = gelu_tanh(v[3]); }
                            *(u32x2*)(dst + m * 16 + fq * 4) = (u32x2){pk2(v[0], v[1]), pk2(v[2], v[3])}; }
                    }
            }
        }
        __syncthreads();
    }
}

constexpr int AT_KP = 144, AT_VP = 136, AT_STAGE = 64 * AT_KP + 64 * AT_VP;
__device__ void attn_item(const Args& a, char* lds, int b, int head, int qblk) {
    const int tid = threadIdx.x, lane = tid & 63, wid = tid >> 6, r32 = lane & 31, hi = lane >> 5;
    unsigned char* ws = a.ws;
    const int kvh = head >> 2;
    const bf16_t* Qp = (const bf16_t*)(ws + WS_Q) + ((size_t)(b * 8 + head) * SEQ + qblk * 256 + wid * 32 + r32) * 64 + hi * 8;
    const bf16_t* Kp = (const bf16_t*)(ws + WS_K) + (size_t)(b * 2 + kvh) * STOT * 64;
    const bf16_t* Vp = (const bf16_t*)(ws + WS_VV) + (size_t)(b * 2 + kvh) * 64 * STOT;
    bf16x8 qf[4];
#pragma unroll
    for (int ds = 0; ds < 4; ++ds) qf[ds] = *(const bf16x8*)(Qp + ds * 16);
    const int srow = tid >> 3, sch = tid & 7;
    const bf16_t* kg = Kp + (size_t)srow * 64 + sch * 8;
    const bf16_t* vg = Vp + (size_t)srow * STOT + sch * 8;
    u32x4 krA, vrA, krB, vrB;
    f32x16 o[2]; float lsum = 0.f;
    float negM;
    { float gq = fabsf(a.in[I_QNG][lane]), gk = fabsf(a.in[I_KNG][lane]);
#pragma unroll
      for (int o_ = 32; o_ > 0; o_ >>= 1) { gq = fmaxf(gq, __shfl_xor(gq, o_)); gk = fmaxf(gk, __shfl_xor(gk, o_)); }
      negM = -(64.f * 0.125f * 1.4426950408889634f * 1.01f) * gq * gk; }
#pragma unroll
    for (int dt = 0; dt < 2; ++dt)
#pragma unroll
        for (int r = 0; r < 16; ++r) o[dt][r] = 0.f;
    char* KS = lds; char* VS = lds + 2 * 64 * AT_KP;
#define A_LOADK(X, s0) do { kr##X = *(const u32x4*)(kg + (size_t)(s0) * 64); } while (0)
#define A_LOADV(X, s0) do { vr##X = *(const u32x4*)(vg + (s0)); } while (0)
#define A_WRITEK(X, st) do { *(u32x4*)(KS + (st) * 64 * AT_KP + srow * AT_KP + sch * 16) = kr##X; } while (0)
#define A_WRITEV(X, st) do { char* vb_ = VS + (st) * 64 * AT_VP + srow * AT_VP + sch * 16; *(u32x2*)vb_ = (u32x2){vr##X[0], vr##X[1]}; *(u32x2*)(vb_ + 8) = (u32x2){vr##X[2], vr##X[3]}; } while (0)
    constexpr int NT = STOT / 64;
    f32x16 sc[2], sn[2];
    A_LOADK(A, 0); A_LOADV(A, 0); A_WRITEK(A, 0); A_WRITEV(A, 0); A_LOADK(A, 64); A_WRITEK(A, 1); A_LOADK(B, 128); A_LOADV(B, 64); __syncthreads();
#pragma unroll
    for (int kt = 0; kt < 2; ++kt) {
#pragma unroll
        for (int r = 0; r < 16; ++r) sc[kt][r] = negM;
#pragma unroll
        for (int ds = 0; ds < 4; ++ds) { const bf16x8 ka = *(const bf16x8*)(KS + (kt * 32 + r32) * AT_KP + (ds * 16 + hi * 8) * 2); sc[kt] = MFMA(ka, qf[ds], sc[kt]); }
    }
    __syncthreads();
    f32x16 ol;
#pragma unroll
    for (int r = 0; r < 16; ++r) ol[r] = 0.f;
    const u32x4 ones_w = {0x3F803F80u, 0x3F803F80u, 0x3F803F80u, 0x3F803F80u};
    const bf16x8 ones = *(const bf16x8*)&ones_w;
#define A_STEP(J, SC, SN, XW, XL) do { const int j_ = (J); \
        const int jk = (j_ + 3 < NT) ? j_ + 3 : NT - 1, jv = (j_ + 2 < NT) ? j_ + 2 : NT - 1; \
        A_LOADK(XL, jk * 64); A_LOADV(XL, jv * 64); \
        const char* ksn = KS + ((j_ + 1) & 1) * 64 * AT_KP; const char* vs = VS + (j_ & 1) * 64 * AT_VP; \
        _Pragma("unroll") for (int kt = 0; kt < 2; ++kt) { \
            _Pragma("unroll") for (int r = 0; r < 16; ++r) SN[kt][r] = negM; \
            _Pragma("unroll") for (int ds = 0; ds < 4; ++ds) { \
                const bf16x8 ka = *(const bf16x8*)(ksn + (kt * 32 + r32) * AT_KP + (ds * 16 + hi * 8) * 2); \
                SN[kt] = MFMA(ka, qf[ds], SN[kt]); \
                _Pragma("unroll") for (int e = 0; e < 4; ++e) { const int f = (kt * 4 + ds) * 4 + e; SC[f >> 4][f & 15] = __builtin_amdgcn_exp2f(SC[f >> 4][f & 15]); } \
                __builtin_amdgcn_sched_barrier(0); } } \
        _Pragma("unroll") for (int kt = 0; kt < 2; ++kt) \
            _Pragma("unroll") for (int s = 0; s < 2; ++s) { \
                u32x4 pw = {pk2(SC[kt][8 * s], SC[kt][8 * s + 1]), pk2(SC[kt][8 * s + 2], SC[kt][8 * s + 3]), pk2(SC[kt][8 * s + 4], SC[kt][8 * s + 5]), pk2(SC[kt][8 * s + 6], SC[kt][8 * s + 7])}; \
                const bf16x8 pb = *(bf16x8*)&pw; \
                _Pragma("unroll") for (int dt = 0; dt < 2; ++dt) { \
                    const char* vp = vs + (dt * 32 + r32) * AT_VP + (kt * 32 + s * 16 + hi * 4) * 2; \
                    const u32x2 lo = *(const u32x2*)vp, hh = *(const u32x2*)(vp + 16); \
                    u32x4 aw = {lo[0], lo[1], hh[0], hh[1]}; \
                    o[dt] = MFMA(*(bf16x8*)&aw, pb, o[dt]); } \
                ol = MFMA(ones, pb, ol); } \
        A_WRITEK(XW, j_ & 1); A_WRITEV(XW, (j_ + 1) & 1); \
        __syncthreads(); } while (0)
#pragma unroll 1
    for (int j = 0; j < NT; j += 2) { A_STEP(j, sc, sn, B, A); A_STEP(j + 1, sn, sc, A, B); }
#undef A_STEP
    lsum = ol[0];
#undef A_LOADK
#undef A_LOADV
#undef A_WRITEK
#undef A_WRITEV
    const float inv = fast_rcp(lsum);
    bf16_t* outp = (bf16_t*)(ws + WS_A2) + ((size_t)b * SEQ + qblk * 256 + wid * 32 + r32) * KOUT + head * 64;
#pragma unroll
    for (int dt = 0; dt < 2; ++dt)
#pragma unroll
        for (int g = 0; g < 4; ++g) {
            u32x2 v = {pk2(o[dt][4 * g] * inv, o[dt][4 * g + 1] * inv), pk2(o[dt][4 * g + 2] * inv, o[dt][4 * g + 3] * inv)};
            *(u32x2*)(outp + dt * 32 + g * 8 + hi * 4) = v;
        }
}

constexpr int LR_RAW = 0;
constexpr int LR_U   = 33792;
constexpr int LR_BB  = LR_U + 33280;
constexpr int LR_UB  = LR_BB + 33280;
constexpr int LR_WG  = LR_UB + 18432;
constexpr int LR_SEG = LR_WG + 18432;
constexpr int LR_HC  = LR_SEG + 4096;
constexpr int LR_CST = LR_HC + 512;
constexpr int LR_END = LR_CST + 768;
__device__ void lru_item(const Args& a, char* lds, int b, int n, int d) {
    const int tid = threadIdx.x, lane = tid & 63, wid = tid >> 6, r32 = lane & 31, hi = lane >> 5;
    unsigned char* ws = a.ws;
    float* RAW = (float*)(lds + LR_RAW); float* AA = (float*)(lds + LR_RAW); float* U = (float*)(lds + LR_U); float* BB = (float*)(lds + LR_BB);
    char* UB = lds + LR_UB; char* WG = lds + LR_WG; float* SEG = (float*)(lds + LR_SEG); float* HC = (float*)(lds + LR_HC);
    const bf16_t* Lg = (const bf16_t*)(ws + WS_L) + (size_t)b * STOT * DLRU + n * 64;
    const bf16_t* Zg = (const bf16_t*)(ws + WS_ZG) + (size_t)b * SEQ * DLRU + n * 64;
    bf16_t* Og = (bf16_t*)(ws + WS_A2) + (size_t)b * SEQ * KOUT + 512 + d * 512 + n * 64;
    {
        const bf16_t* wsrc = (const bf16_t*)(ws + WS_RGW) + (size_t)(d * 8 + n) * 128 * 64;
#pragma unroll
        for (int i = 0; i < 2; ++i) { const int c = tid + NTHR * i, r = c >> 3, ch = c & 7; *(u32x4*)(WG + r * 144 + ch * 16) = *(const u32x4*)(wsrc + r * 64 + ch * 8); }
        if (tid < 128) HC[tid] = 0.f;
    }
    const int ct = wid & 1, tt = wid >> 1;
    float* CST = (float*)(lds + LR_CST);
    if (tid < 64) { const int c = n * 64 + tid; CST[tid] = a.in[I_RGBA][d * 512 + c]; CST[64 + tid] = a.in[I_RGBI][d * 512 + c];
        const float x = -a.in[I_RGLAM][d * 512 + c]; CST[128 + tid] = -8.f * (fmaxf(x, 0.f) + log1pf(__expf(-fabsf(x)))); }
    const int sc = tid & 63, sg = tid >> 6;
    const float cw0 = a.in[I_CONVW][0 * 512 + n * 64 + sc], cw1 = a.in[I_CONVW][1 * 512 + n * 64 + sc], cw2 = a.in[I_CONVW][2 * 512 + n * 64 + sc], cw3 = a.in[I_CONVW][3 * 512 + n * 64 + sc];
    const float cbias = a.in[I_CONVB][n * 64 + sc];
    __syncthreads();
    int par = 0;
    for (int step = 0; step < 18; ++step) {
        const bool isctx = step < 2;
        const int tl = isctx ? (d == 0 ? step : 1 - step) : (d == 0 ? step - 2 : 17 - step);
        const int sb = isctx ? 0 : CTX, sl = isctx ? CTX : SEQ, t0 = tl * 128;
        for (int e = tid; e < 131 * 8; e += NTHR) { const int r = e >> 3, ch = e & 7, t = t0 - 2 + r;
            u32x4 v = {0u, 0u, 0u, 0u}; if (t >= 0 && t < sl) v = *(const u32x4*)(Lg + (size_t)(sb + t) * DLRU + ch * 8);
            float* dst = RAW + r * 64 + ch * 8;
            dst[0] = bflo(v[0]); dst[1] = bfhi(v[0]); dst[2] = bflo(v[1]); dst[3] = bfhi(v[1]); dst[4] = bflo(v[2]); dst[5] = bfhi(v[2]); dst[6] = bflo(v[3]); dst[7] = bfhi(v[3]); }
        __syncthreads();
        {
            const float* rp = RAW + (sg * 16) * 64 + sc;
            float x0 = rp[0], x1 = rp[64], x2 = rp[128];
            float* up = U + (sg * 16) * 65 + sc; char* ubp = UB + (sg * 16) * 144 + sc * 2;
#pragma unroll
            for (int i = 0; i < 16; ++i) { const float x3 = rp[(i + 3) * 64];
                const float u = cbias + cw0 * x0 + cw1 * x1 + cw2 * x2 + cw3 * x3;
                up[i * 65] = u; *(bf16_t*)(ubp + i * 144) = f2bf(u); x0 = x1; x1 = x2; x2 = x3; }
        }
        __syncthreads();
        {
            f32x16 ga, gi;
#pragma unroll
            for (int r = 0; r < 16; ++r) { ga[r] = 0.f; gi[r] = 0.f; }
#pragma unroll
            for (int ks = 0; ks < 4; ++ks) {
                const bf16x8 wa = *(const bf16x8*)(WG + (ct * 32 + r32) * 144 + (ks * 16 + hi * 8) * 2);
                const bf16x8 wi = *(const bf16x8*)(WG + (64 + ct * 32 + r32) * 144 + (ks * 16 + hi * 8) * 2);
                const bf16x8 ub = *(const bf16x8*)(UB + (tt * 32 + r32) * 144 + (ks * 16 + hi * 8) * 2);
                ga = MFMA(wa, ub, ga); gi = MFMA(wi, ub, gi);
            }
            const int t = tt * 32 + r32;
#pragma unroll
            for (int r = 0; r < 16; ++r) { const int c = ct * 32 + 8 * (r >> 2) + 4 * hi + (r & 3);
                const float rr = sigmoidf_(ga[r] + CST[c]), ii = sigmoidf_(gi[r] + CST[64 + c]);
                const float la = CST[128 + c] * rr, av = __expf(la), mult = __builtin_amdgcn_sqrtf(fmaxf(1.f - av * av, 0.f));
                const float u = U[t * 65 + c];
                AA[t * 65 + c] = av; BB[t * 65 + c] = mult * ii * u; }
        }
        __syncthreads();
        float av[16], bv[16]; float Ap = 1.f, Bp = 0.f;
#pragma unroll
        for (int k = 0; k < 16; ++k) { const int p = sg * 16 + k, t = d == 0 ? p : 127 - p; av[k] = AA[t * 65 + sc]; bv[k] = BB[t * 65 + sc]; Bp = av[k] * Bp + bv[k]; Ap = av[k] * Ap; }
        SEG[sg * 64 + sc] = Ap; SEG[512 + sg * 64 + sc] = Bp;
        __syncthreads();
        float h = HC[par * 64 + sc];
        for (int s2 = 0; s2 < sg; ++s2) h = SEG[s2 * 64 + sc] * h + SEG[512 + s2 * 64 + sc];
        {
            const int tfirst = d == 0 ? sg * 16 : 127 - sg * 16;
            const bf16_t* zp = Zg + (size_t)(t0 + tfirst) * DLRU + sc; bf16_t* op = Og + (size_t)(t0 + tfirst) * KOUT + sc;
            const int zstep = d == 0 ? DLRU : -DLRU, ostep = d == 0 ? KOUT : -KOUT;
#pragma unroll
            for (int k = 0; k < 16; ++k) { h = av[k] * h + bv[k];
                if (!isctx) { const float gz = bf2f(*zp); *op = f2bf(h * gz); zp += zstep; op += ostep; } }
        }
        if (sg == 7) HC[(par ^ 1) * 64 + sc] = h;
        par ^= 1;
        __syncthreads();
    }
}

#ifndef LRU_REPS
#define LRU_REPS 1
#endif
__device__ void phase_mixer(const Args& a, char* lds, int vb, int nb) {
#pragma unroll 1
    for (int it = vb; it < 256; it += nb) { for (int rep_ = 0; rep_ < LRU_REPS; ++rep_) { lru_item(a, lds, it >> 4, (it >> 1) & 7, it & 1); __syncthreads(); } }
#pragma unroll 1
    for (int at = vb; at < 1024; at += nb) { const int bk = at >> 5, w = at & 31; attn_item(a, lds, bk >> 1, (bk & 1) * 4 + (w >> 3), w & 7); __syncthreads(); }
}

__device__ void phase_outproj(const Args& a, char* lds, int vb, int nb) {
    const int tid = threadIdx.x, lane = tid & 63, wid = tid >> 6, wr = wid >> 2, wc = wid & 3, fr = lane & 15, fq = lane >> 4;
    const bf16_t* A2 = (const bf16_t*)(a.ws + WS_A2); const bf16_t* WO = (const bf16_t*)(a.ws + WS_WOUT);
    float* MIX = (float*)(a.ws + WS_MIX);
#pragma unroll 1
    for (int it = vb; it < 128 * 4; it += nb) {
        const int tt = it >> 2, ft = it & 3;
        f32x4 acc[2][2][4][2];
        g8::core(acc, WO, A2, ft * 256, tt * 256, KOUT, lds);
#pragma unroll
        for (int bj = 0; bj < 2; ++bj)
#pragma unroll
            for (int n = 0; n < 2; ++n) {
                float* rp = MIX + (size_t)(tt * 256 + bj * 128 + wc * 32 + n * 16 + fr) * DM + ft * 256 + wr * 64 + fq * 4;
#pragma unroll
                for (int ai = 0; ai < 2; ++ai)
#pragma unroll
                    for (int m = 0; m < 4; ++m) *(f32x4*)(rp + ai * 128 + m * 16) = acc[ai][bj][m][n];
            }
        __syncthreads();
    }
}

__device__ void phase_rowpass(const Args& a, int vb, int nb) {
    const int tid = threadIdx.x, lane = tid & 63, wid = tid >> 6;
    const float* mod = (const float*)(a.ws + WS_MOD);
    const float* MIX = (const float*)(a.ws + WS_MIX);
    bf16_t* HX = (bf16_t*)(a.ws + WS_HX2);
    for (int row = vb * 8 + wid; row < NTOK; row += nb * 8) {
        const int b = row >> 11;
        const float* mrow = mod + (size_t)b * 6144;
        f32x4 mv[4], xv[4]; float ss = 0.f;
#pragma unroll
        for (int i = 0; i < 4; ++i) { mv[i] = *(const f32x4*)(MIX + (size_t)row * DM + i * 256 + lane * 4); xv[i] = *(const f32x4*)(a.in[I_X] + (size_t)row * DM + i * 256 + lane * 4);
            ss += mv[i][0] * mv[i][0] + mv[i][1] * mv[i][1] + mv[i][2] * mv[i][2] + mv[i][3] * mv[i][3]; }
        ss = wave_sum(ss);
        const float rinv = rsqrtf(ss * (1.f / DM) + EPS);
        float s2 = 0.f;
#pragma unroll
        for (int i = 0; i < 4; ++i) { const int c = i * 256 + lane * 4;
            const f32x4 gp = *(const f32x4*)(a.in[I_GPOSTMIX] + c), g1 = *(const f32x4*)(mrow + 2048 + c);
#pragma unroll
            for (int j = 0; j < 4; ++j) { const float xm = xv[i][j] + g1[j] * (mv[i][j] * rinv * gp[j]); xv[i][j] = xm; s2 += xm * xm; }
            *(f32x4*)(a.out + (size_t)row * DM + c) = xv[i]; }
        s2 = wave_sum(s2);
        const float rinv2 = rsqrtf(s2 * (1.f / DM) + EPS);
#pragma unroll
        for (int i = 0; i < 4; ++i) { const int c = i * 256 + lane * 4;
            const f32x4 gf = *(const f32x4*)(a.in[I_GPREFFN] + c), sh = *(const f32x4*)(mrow + 3072 + c), sc = *(const f32x4*)(mrow + 4096 + c);
            float o[4];
#pragma unroll
            for (int j = 0; j < 4; ++j) o[j] = xv[i][j] * rinv2 * gf[j] * (1.f + sc[j]) + sh[j];
            u32x2 w = {pk2(o[0], o[1]), pk2(o[2], o[3])}; *(u32x2*)(HX + (size_t)row * DM + c) = w; }
    }
}

__device__ __forceinline__ int fkey(float f) { const int b = __float_as_int(f); return b ^ ((b >> 31) & 0x7fffffff); }
__device__ __forceinline__ float fval(int k) { return __int_as_float(k ^ ((k >> 31) & 0x7fffffff)); }
#define CE_DESC(x, y) do { const int hi_ = max((x), (y)), lo_ = min((x), (y)); (x) = hi_; (y) = lo_; } while (0)
__device__ __forceinline__ void sort16_desc(int (&v)[16]) {
#pragma unroll
    for (int k = 2; k <= 16; k <<= 1)
#pragma unroll
        for (int j = k >> 1; j > 0; j >>= 1)
#pragma unroll
            for (int i = 0; i < 16; ++i) { const int l = i ^ j; if (l > i) { if ((i & k) == 0) { CE_DESC(v[i], v[l]); } else { CE_DESC(v[l], v[i]); } } }
}
__device__ __forceinline__ void merge16_desc(int (&v)[16]) {
#pragma unroll
    for (int j = 8; j > 0; j >>= 1)
#pragma unroll
        for (int i = 0; i < 16; ++i) { const int l = i ^ j; if (l > i) CE_DESC(v[i], v[l]); }
}
__device__ __forceinline__ void top16_merge(int (&A)[16], const int (&B)[16]) {
#pragma unroll
    for (int i = 0; i < 16; ++i) A[i] = max(A[i], B[15 - i]);
    merge16_desc(A);
}
constexpr int PK_QS = 0;
constexpr int PK_SK = 256 * E_PITCH;
constexpr int PK_ML = PK_SK + 128 * E_PITCH;
constexpr int PK_X  = PK_ML + 32768;
constexpr int PK_END = PK_X + 8192;
static_assert(PK_ML >= G_LDS, "the merged lists must lie past the GEMM stages");
__device__ void phase_peer_topk(const Args& a, char* lds, int vb, int nb) {
    unsigned char* ws = a.ws;
    const bf16_t* HX = (const bf16_t*)(ws + WS_HX2); const bf16_t* WQ = (const bf16_t*)(ws + WS_WQ); const bf16_t* SUBK = (const bf16_t*)(ws + WS_SUBK);
    int* IDX = (int*)(ws + WS_IDX);
    int* ML = (int*)(lds + PK_ML); int* XB = (int*)(lds + PK_X);
    for (int it = vb; it < 128 * 8; it += nb) {
        const int rt = it >> 3, h = it & 7, row0 = rt * 256;
        bf16_t* park = (bf16_t*)(ws + WS_MIX) + (size_t)it * (256 * 128);
        int tid = threadIdx.x;
        {
            f32x4 acc8[2][2][4][2];
            g8::core(acc8, WQ, HX, h * 256, row0, DM, lds);
            __syncthreads();
            asm volatile("" : "+v"(tid));
            const int lane = tid & 63, wid = tid >> 6;
            const int w8r = wid >> 2, w8c = wid & 3, fr = lane & 15, fq = lane >> 4;
#pragma unroll
            for (int bj = 0; bj < 2; ++bj)
#pragma unroll
                for (int m = 0; m < 4; ++m)
#pragma unroll
                    for (int n = 0; n < 2; ++n) { const int tok = bj * 128 + w8c * 32 + n * 16 + fr, d = w8r * 64 + m * 16 + fq * 4;
                        const f32x4 v0 = acc8[0][bj][m][n], v1 = acc8[1][bj][m][n];
                        *(u32x2*)(lds + PK_QS + tok * E_PITCH + d * 2) = (u32x2){pk2(v0[0], v0[1]), pk2(v0[2], v0[3])};
                        *(u32x2*)(park + tok * 128 + d) = (u32x2){pk2(v1[0], v1[1]), pk2(v1[2], v1[3])}; }
        }
        const int lane = tid & 63, wid = tid >> 6, wm = wid & 3, wn = wid >> 2, r32 = lane & 31, hi = lane >> 5;
#pragma unroll 1
        for (int p = 0; p < 2; ++p) {
            f32x16 acc[2][2];
            if (p == 1) {
#pragma unroll
                for (int i = 0; i < 8; ++i) { const int c = tid + NTHR * i, tok = c >> 4, ch = c & 15; *(u32x4*)(lds + PK_QS + tok * E_PITCH + ch * 16) = *(const u32x4*)(park + tok * 128 + ch * 8); }
            }
            {
                const bf16_t* sk = SUBK + (size_t)(h * 2 + p) * 128 * 128;
#pragma unroll
                for (int i = 0; i < 4; ++i) { const int c = tid + NTHR * i, r = c >> 4, ch = c & 15; *(u32x4*)(lds + PK_SK + r * E_PITCH + ch * 16) = *(const u32x4*)(sk + r * 128 + ch * 8); }
            }
            __syncthreads();
#pragma unroll
            for (int ft = 0; ft < 2; ++ft)
#pragma unroll
                for (int tt = 0; tt < 2; ++tt)
#pragma unroll
                    for (int r = 0; r < 16; ++r) acc[ft][tt][r] = 0.f;
#pragma unroll
            for (int ks = 0; ks < 8; ++ks) {
                const bf16x8 a0 = *(const bf16x8*)(lds + PK_SK + (wn * 64 + r32) * E_PITCH + (ks * 16 + hi * 8) * 2), a1 = *(const bf16x8*)(lds + PK_SK + (wn * 64 + 32 + r32) * E_PITCH + (ks * 16 + hi * 8) * 2);
                const bf16x8 b0 = *(const bf16x8*)(lds + PK_QS + (wm * 64 + r32) * E_PITCH + (ks * 16 + hi * 8) * 2), b1 = *(const bf16x8*)(lds + PK_QS + (wm * 64 + 32 + r32) * E_PITCH + (ks * 16 + hi * 8) * 2);
                acc[0][0] = MFMA(a0, b0, acc[0][0]); acc[0][1] = MFMA(a0, b1, acc[0][1]);
                acc[1][0] = MFMA(a1, b0, acc[1][0]); acc[1][1] = MFMA(a1, b1, acc[1][1]);
            }
#pragma unroll
            for (int tt = 0; tt < 2; ++tt) {
                int A[16], B[16];
#pragma unroll
                for (int r = 0; r < 16; ++r) { const int key = wn * 64 + 8 * (r >> 2) + 4 * hi + (r & 3);
                    A[r] = (fkey(acc[0][tt][r]) & ~127) | key; B[r] = (fkey(acc[1][tt][r]) & ~127) | (key + 32); }
                sort16_desc(A); sort16_desc(B); top16_merge(A, B);
#pragma unroll
                for (int r = 0; r < 16; ++r) { auto rr = __builtin_amdgcn_permlane32_swap((unsigned)A[r], (unsigned)A[r], false, false); B[r] = (int)(hi ? rr[0] : rr[1]); }
                top16_merge(A, B);
                const int tok = wm * 64 + tt * 32 + r32;
                if (wn == 1 && hi == 0) {
#pragma unroll
                    for (int r = 0; r < 16; ++r) XB[(wm * 32 + r32) * 16 + r] = A[r];
                }
                __syncthreads();
                if (wn == 0 && hi == 0) {
#pragma unroll
                    for (int r = 0; r < 16; ++r) B[r] = XB[(wm * 32 + r32) * 16 + r];
                    top16_merge(A, B);
#pragma unroll
                    for (int r = 0; r < 16; ++r) ML[(tok * 2 + p) * 16 + r] = A[r];
                }
                __syncthreads();
            }
        }
        if (tid < 256) {
            const int tok = tid;
            int s1[16], s2[16];
#pragma unroll
            for (int r = 0; r < 16; ++r) { s1[r] = ML[(tok * 2 + 0) * 16 + r]; s2[r] = ML[(tok * 2 + 1) * 16 + r]; }
            float f1[16], f2[16];
#pragma unroll
            for (int r = 0; r < 16; ++r) { f1[r] = fval(s1[r] & ~127); f2[r] = fval(s2[r] & ~127); }
            int G0[16], G1[16], G2[16], G3[16];
#pragma unroll
            for (int bb = 0; bb < 16; ++bb) G0[bb] = (fkey(f1[0] + f2[bb]) & ~255) | (0 * 16 + bb);
#pragma unroll
            for (int bb = 0; bb < 8; ++bb) G1[bb] = (fkey(f1[1] + f2[bb]) & ~255) | (1 * 16 + bb);
#pragma unroll
            for (int bb = 0; bb < 5; ++bb) G1[8 + bb] = (fkey(f1[2] + f2[bb]) & ~255) | (2 * 16 + bb);
#pragma unroll
            for (int bb = 0; bb < 3; ++bb) G1[13 + bb] = (fkey(f1[3] + f2[bb]) & ~255) | (3 * 16 + bb);
            G2[0] = (fkey(f1[3] + f2[3]) & ~255) | (3 * 16 + 3);
#pragma unroll
            for (int bb = 0; bb < 3; ++bb) G2[1 + bb] = (fkey(f1[4] + f2[bb]) & ~255) | (4 * 16 + bb);
#pragma unroll
            for (int aa = 5; aa < 8; ++aa)
#pragma unroll
                for (int bb = 0; bb < 2; ++bb) G2[4 + (aa - 5) * 2 + bb] = (fkey(f1[aa] + f2[bb]) & ~255) | (aa * 16 + bb);
#pragma unroll
            for (int aa = 8; aa < 14; ++aa) G2[10 + (aa - 8)] = (fkey(f1[aa] + f2[0]) & ~255) | (aa * 16);
            G3[0] = (fkey(f1[14] + f2[0]) & ~255) | (14 * 16); G3[1] = (fkey(f1[15] + f2[0]) & ~255) | (15 * 16);
#pragma unroll
            for (int r = 2; r < 16; ++r) G3[r] = (int)0x80000000;
            sort16_desc(G0); sort16_desc(G1); sort16_desc(G2); sort16_desc(G3);
            top16_merge(G0, G1); top16_merge(G2, G3); top16_merge(G0, G2);
            float tv[16]; float mx = fval(G0[0] & ~255), sum = 0.f;
#pragma unroll
            for (int r = 0; r < 16; ++r) { tv[r] = __expf(fval(G0[r] & ~255) - mx); sum += tv[r]; }
            const float rs = 1.f / sum;
            const size_t ob = ((size_t)(row0 + tok) * 8 + h) * 16;
#pragma unroll
            for (int r = 0; r < 16; ++r) { const int code = G0[r] & 255, aa = code >> 4, bb = code & 15;
                const int i1 = ML[(tok * 2 + 0) * 16 + aa] & 127, i2 = ML[(tok * 2 + 1) * 16 + bb] & 127;
                IDX[ob + r] = (i1 * 128 + i2) | (int)((unsigned)f2bf(tv[r] * rs) << 16); }
        }
        __syncthreads();
    }
}

constexpr int P7_RSHIFT = 8;
constexpr int P7_ROUNDS = PEER_N >> P7_RSHIFT;
template <int CTRL> __device__ __forceinline__ float dpp_add(float v) { return v + __uint_as_float(__builtin_amdgcn_update_dpp(0u, __float_as_uint(v), CTRL, 0xf, 0xf, true)); }
__device__ __forceinline__ float wave_sum_bcast(float p) {
    p = dpp_add<0xB1>(p); p = dpp_add<0x4E>(p); p = dpp_add<0x141>(p); p = dpp_add<0x140>(p);
    const unsigned u = __float_as_uint(p);
    return (__uint_as_float(__builtin_amdgcn_readlane(u, 0)) + __uint_as_float(__builtin_amdgcn_readlane(u, 16))) + (__uint_as_float(__builtin_amdgcn_readlane(u, 32)) + __uint_as_float(__builtin_amdgcn_readlane(u, 48)));
}
__device__ __forceinline__ float dot16(const u32x4 a0, const u32x4 a1, const u32x4 b0, const u32x4 b1) {
    float acc = 0.f;
#pragma unroll
    for (int i = 0; i < 4; ++i) { acc = __builtin_amdgcn_fdot2_f32_bf16(as_bf2(a0[i]), as_bf2(b0[i]), acc, false); acc = __builtin_amdgcn_fdot2_f32_bf16(as_bf2(a1[i]), as_bf2(b1[i]), acc, false); }
    return acc;
}
typedef float f32x4v __attribute__((ext_vector_type(4)));
constexpr int P7_RS = 9;
constexpr int P7_NR = PEER_N >> P7_RS;
constexpr int P7_HTP = 1024 + 64;
constexpr float H_SCALE = 16.f;
constexpr int P7_WLDS = 4 * P7_HTP + 2048 + 8192 + 2048;
__device__ void phase_peer_gather(const Args& a, char* lds, int vb, int nb) {
    const int tid = threadIdx.x, lane = tid & 63, wid = tid >> 6, r16 = lane & 15, kg = lane >> 4;
    unsigned char* ws = a.ws;
    const bf16_t* HX = (const bf16_t*)(ws + WS_HX2);
    const int* IDX = (const int*)(ws + WS_IDX);
    const float* mod = (const float*)(ws + WS_MOD);
    const unsigned char* UT = ws + WS_UT; const unsigned char* VT = ws + WS_VT;
    char* HT = lds + wid * P7_WLDS; unsigned* LIST = (unsigned*)(HT + 4 * P7_HTP); char* AT = HT + 4 * P7_HTP + 2048; char* ST = AT + 8192;
#pragma unroll 1
    for (int tb = vb * 32; tb < NTOK; tb += nb * 32) {
        const int tok0 = tb + wid * 4;
        {
            int* HIST = (int*)HT; int* CUR = HIST + 128;
            int ee[8];
            const int* ip = IDX + (size_t)tok0 * 128 + lane;
#pragma unroll
            for (int k = 0; k < 4; ++k) { ee[2 * k] = ip[k * 128]; ee[2 * k + 1] = ip[k * 128 + 64]; }
            HIST[lane] = 0; HIST[64 + lane] = 0;
#pragma unroll
            for (int j = 0; j < 8; ++j) atomicAdd(&HIST[(((ee[j] >> P7_RS) & (P7_NR - 1)) << 2) | (j >> 1)], 1);
            const int c0 = HIST[2 * lane], c1 = HIST[2 * lane + 1];
            int inc = c0 + c1;
#pragma unroll
            for (int o = 1; o < 64; o <<= 1) { const int t = __shfl_up(inc, o); if (lane >= o) inc += t; }
            CUR[2 * lane] = inc - c0 - c1; CUR[2 * lane + 1] = inc - c1;
#pragma unroll
            for (int j = 0; j < 8; ++j) { const unsigned w = (unsigned)ee[j]; const int slot = atomicAdd(&CUR[(((w >> P7_RS) & (P7_NR - 1)) << 2) | (j >> 1)], 1);
                LIST[slot] = (w & 16383u) | ((unsigned)(j >> 1) << 14) | ((w >> 16) << 17); }
        }
        {
            const bf16_t* hp = HX + (size_t)tok0 * DM + lane * 16;
#pragma unroll
            for (int k = 0; k < 4; ++k) { const u32x4 h0 = *(const u32x4*)(hp + k * DM), h1 = *(const u32x4*)(hp + k * DM + 8);
                u32x4 o;
#pragma unroll
                for (int q = 0; q < 4; ++q) { const unsigned wa = q < 2 ? h0[2 * q] : h1[2 * q - 4], wb = q < 2 ? h0[2 * q + 1] : h1[2 * q - 3];
                    int w = __builtin_amdgcn_cvt_pk_fp8_f32(bflo(wa) * H_SCALE, bfhi(wa) * H_SCALE, 0, false); w = __builtin_amdgcn_cvt_pk_fp8_f32(bflo(wb) * H_SCALE, bfhi(wb) * H_SCALE, w, true); o[q] = (unsigned)w; }
                *(u32x4*)(HT + k * P7_HTP + lane * 16) = o;
                *(u32x4*)(AT + k * 2048 + lane * 32) = (u32x4){0u, 0u, 0u, 0u}; *(u32x4*)(AT + k * 2048 + lane * 32 + 16) = (u32x4){0u, 0u, 0u, 0u}; }
        }
        const char* hb0 = HT + (lane & 3) * P7_HTP + kg * 8;
        u32x4 c0 = {0u, 0u, 0u, 0u}, c1 = {0u, 0u, 0u, 0u}; unsigned cur = 0u;
#pragma unroll 1
        for (int bi = 0; bi < 32; ++bi) {
            const unsigned entv = LIST[bi * 16 + r16];
            f32x4v D = {0.f, 0.f, 0.f, 0.f};
            const unsigned e_lo = (unsigned)__shfl((int)entv, lane >> 3) & 16383u, e_hi = (unsigned)__shfl((int)entv, 8 + (lane >> 3)) & 16383u;
            const unsigned char* ul = UT + (size_t)e_lo * DM + (lane & 7) * 16; const unsigned char* uh = UT + (size_t)e_hi * DM + (lane & 7) * 16;
            const int wlo = (lane >> 3) * 128 + (((lane & 7) ^ ((lane >> 4) & 7)) << 4), whi = (8 + (lane >> 3)) * 128 + (((lane & 7) ^ (4 + ((lane >> 4) & 3))) << 4);
            u32x4 ua[8], uc[8];
#pragma unroll
            for (int kc = 0; kc < 8; ++kc) { ua[kc] = *(const u32x4*)(ul + kc * 128); uc[kc] = *(const u32x4*)(uh + kc * 128); }
#pragma unroll
            for (int kc = 0; kc < 8; ++kc) {
                *(u32x4*)(ST + wlo) = ua[kc]; *(u32x4*)(ST + whi) = uc[kc];
#pragma unroll
                for (int t = 0; t < 4; ++t) {
                    const int ci = 2 * t + (kg >> 1);
                    const long a0 = *(const long*)(ST + r16 * 128 + ((ci ^ ((r16 >> 1) & 7)) << 4) + (kg & 1) * 8);
                    const long b0 = *(const long*)(hb0 + kc * 128 + t * 32);
                    D = __builtin_amdgcn_mfma_f32_16x16x32_fp8_fp8(a0, b0, D, 0, 0, 0);
                }
            }
            float dsel = 0.f;
#pragma unroll
            for (int i = 0; i < 4; ++i) {
                const unsigned er = (unsigned)__shfl((int)entv, 4 * kg + i);
                float m = (((er >> 14) & 3u) == (unsigned)(lane & 3)) ? D[i] : 0.f;
                m = dpp_add<0xB1>(m); m = dpp_add<0x4E>(m);
                dsel = ((lane & 3) == i) ? m : dsel;
            }
            const unsigned gl = __float_as_uint(gelu_tanh(dsel * (1.f / (T_SCALE * H_SCALE))));
#pragma unroll 1
            for (int r0 = 0; r0 < 16; r0 += 8) {
                u32x4 vbuf[8]; unsigned ent[8];
#pragma unroll
                for (int b = 0; b < 8; ++b) { ent[b] = (unsigned)__builtin_amdgcn_readlane((int)entv, r0 + b);
                    vbuf[b] = *(const u32x4*)(VT + (size_t)(ent[b] & 16383u) * DM + lane * 16); }
#pragma unroll
                for (int b = 0; b < 8; ++b) {
                    const int r = r0 + b;
                    const float w_ = __uint_as_float(__builtin_amdgcn_readlane(gl, 16 * (r >> 2) + (r & 3))) * __uint_as_float((ent[b] >> 17) << 16);
                    const h16x2 w2 = as_h2(pkh2(w_, w_));
                    const unsigned tk = (ent[b] >> 14) & 3u;
                    if (tk != cur) {
                        char* apo = AT + cur * 2048 + lane * 32; *(u32x4*)apo = c0; *(u32x4*)(apo + 16) = c1;
                        const char* apn = AT + tk * 2048 + lane * 32; c0 = *(const u32x4*)apn; c1 = *(const u32x4*)(apn + 16); cur = tk; }
#pragma unroll
                    for (int q_ = 0; q_ < 4; ++q_) { const unsigned vw_ = vbuf[b][q_];
                        const h16x2 lo = __builtin_amdgcn_cvt_scalef32_pk_f16_fp8(vw_, V_SCALE / T_SCALE, false), hi2 = __builtin_amdgcn_cvt_scalef32_pk_f16_fp8(vw_, V_SCALE / T_SCALE, true);
                        if (q_ < 2) { c0[2 * q_] = __builtin_bit_cast(unsigned, __builtin_elementwise_fma(lo, w2, as_h2(c0[2 * q_]))); c0[2 * q_ + 1] = __builtin_bit_cast(unsigned, __builtin_elementwise_fma(hi2, w2, as_h2(c0[2 * q_ + 1]))); }
                        else { c1[2 * q_ - 4] = __builtin_bit_cast(unsigned, __builtin_elementwise_fma(lo, w2, as_h2(c1[2 * q_ - 4]))); c1[2 * q_ - 3] = __builtin_bit_cast(unsigned, __builtin_elementwise_fma(hi2, w2, as_h2(c1[2 * q_ - 3]))); } }
                }
            }
        }
        { char* apo = AT + cur * 2048 + lane * 32; *(u32x4*)apo = c0; *(u32x4*)(apo + 16) = c1; }
#pragma unroll
        for (int k = 0; k < 4; ++k) {
            const int tok = tok0 + k;
            float f[16]; float ss = 0.f;
            const u32x4 e0 = *(const u32x4*)(AT + k * 2048 + lane * 32), e1 = *(const u32x4*)(AT + k * 2048 + lane * 32 + 16);
#pragma unroll
            for (int i = 0; i < 8; ++i) { const unsigned cw = i < 4 ? e0[i] : e1[i - 4]; const h16x2 hv = as_h2(cw);
                f[2 * i] = (float)hv[0] * (1.f / V_SCALE); f[2 * i + 1] = (float)hv[1] * (1.f / V_SCALE); ss += f[2 * i] * f[2 * i] + f[2 * i + 1] * f[2 * i + 1]; }
            ss = wave_sum_bcast(ss);
            const float rinv = rsqrtf(ss * (1.f / DM) + EPS);
            const float* g2 = mod + (size_t)(tok >> 11) * 6144 + 5120;
#pragma unroll
            for (int q4 = 0; q4 < 4; ++q4) {
                const int c = lane * 16 + q4 * 4;
                float* op = a.out + (size_t)tok * DM + c;
                const f32x4 xm = *(const f32x4*)op, g2v = *(const f32x4*)(g2 + c), gp = *(const f32x4*)(a.in[I_GPOSTFFN] + c);
                f32x4 o;
#pragma unroll
                for (int jj = 0; jj < 4; ++jj) o[jj] = xm[jj] + g2v[jj] * (f[q4 * 4 + jj] * rinv * gp[jj]);
                *(f32x4*)op = o; }
        }
    }
}

#ifdef DBG_DIGEST
__device__ void phase_digest(const Args& a, int vb, int nb) {
    const bf16_t* A2 = (const bf16_t*)(a.ws + WS_A2);
    const bf16_t* Q = (const bf16_t*)(a.ws + WS_Q); const bf16_t* K = (const bf16_t*)(a.ws + WS_K); const bf16_t* VV = (const bf16_t*)(a.ws + WS_VV);
    const bf16_t* L = (const bf16_t*)(a.ws + WS_L); const bf16_t* ZG = (const bf16_t*)(a.ws + WS_ZG);
    for (size_t e = (size_t)vb * NTHR + threadIdx.x; e < (size_t)NTOK * DM; e += (size_t)nb * NTHR) {
        float v = 0.f;
#if DBG_DIGEST == 3
        const size_t row = e >> 10; const int c = (int)(e & 1023);
        v = bf2f(A2[row * KOUT + c]); if (c < 512) v += bf2f(A2[row * KOUT + 1024 + c]);
#elif DBG_DIGEST == 2
        const size_t h = e % ((size_t)NTOK * 512);
        v = bf2f(Q[h]) + bf2f(ZG[h]) + bf2f(L[e % ((size_t)NB * STOT * 512)]);
        if (e < (size_t)NB * 2 * STOT * 64) v += bf2f(K[e]) + bf2f(VV[e]);
#endif
        a.out[e] = v; }
}
#endif
constexpr int LDS_BYTES = 155648;
constexpr int LDS_BARST = LDS_BYTES - 16;
static_assert(8 * P7_WLDS <= LDS_BARST && PK_END <= LDS_BARST && LR_END <= LDS_BARST && 3 * G_STAGE <= LDS_BARST && g8::SHM_B <= LDS_BARST && 17 * 1024 * 4 + 17 * 24 * 4 <= LDS_BARST, "LDS budget");
constexpr int N_PHASES = 8;

__global__ void __launch_bounds__(NTHR, 2) mk_fwd(Args a) {
    extern __shared__ __attribute__((aligned(16))) char lds[];
    const int nb = gridDim.x, bx = blockIdx.x;
    const int vb0 = (nb % 8 == 0) ? (bx % 8) * (nb / 8) + bx / 8 : bx;
    XcdBarrier bar; bar.bar = (unsigned*)(a.ws + WS_CTL); bar.x = 0; bar.st = (volatile LAS unsigned*)(LAS char*)(lds + LDS_BARST);
    const bool multi = (a.ph_hi - a.ph_lo) > 1;
    if (multi) {
        if (threadIdx.x < 4) ((volatile LAS unsigned*)(LAS char*)(lds + LDS_BARST))[threadIdx.x] = 0u;
        __syncthreads();
        bar = xcd_barrier_post((unsigned*)(a.ws + WS_CTL), (volatile LAS unsigned*)(LAS char*)(lds + LDS_BARST));
    }
#ifndef P7_PROBE
#define P7_PROBE -1
#endif
#ifndef DBL_PHASE
#define DBL_PHASE 0
#endif
#if DBL_PHASE != 0
#define RUN_PHASE(P, CALL) do { if (a.ph_lo <= (P) && (P) < a.ph_hi) { const int nrep_ = ((a.dbl >> (P)) & 1) ? 2 : 1; for (int rep_ = 0; rep_ < nrep_; ++rep_) { CALL; if ((P) + 1 < a.ph_hi || rep_ + 1 < nrep_) xcd_barrier(bar); } } } while (0)
#else
#define RUN_PHASE(P, CALL) do { if (a.ph_lo <= (P) && (P) < a.ph_hi) { CALL; if ((P) + 1 < a.ph_hi) xcd_barrier(bar); } } while (0)
#endif
#if !defined(ONLY_PHASE) || ONLY_PHASE == 0
    RUN_PHASE(0, phase_prep(a, lds, vb0, nb));
#endif
    int vb = vb0;
    if (multi && a.ph_lo == 0 && a.ph_hi > 1) {
        if (threadIdx.x == 0) { unsigned off = 0; for (unsigned j = 0; j < bar.x; ++j) off += xb_ld(&bar.bar[XB_XCNT(j)]); bar.st[3] = off + bar.st[2]; }
        __syncthreads();
        vb = (int)bar.st[3];
    }
#if !defined(ONLY_PHASE) || ONLY_PHASE == 1
    RUN_PHASE(1, phase_xn(a, vb, nb));
#endif
#if !defined(ONLY_PHASE) || ONLY_PHASE == 2
    RUN_PHASE(2, phase_inproj(a, lds, vb, nb));
#endif
#if (!defined(ONLY_PHASE) || ONLY_PHASE == 3) && !(defined(DBG_DIGEST) && DBG_DIGEST == 2)
    RUN_PHASE(3, phase_mixer(a, lds, vb, nb));
#endif
#ifdef DBG_DIGEST
    if (a.ph_lo <= 4 && 4 < a.ph_hi) phase_digest(a, vb, nb);
    return;
#endif
#if !defined(ONLY_PHASE) || ONLY_PHASE == 4
    RUN_PHASE(4, phase_outproj(a, lds, vb, nb));
#endif
#if !defined(ONLY_PHASE) || ONLY_PHASE == 5
    RUN_PHASE(5, phase_rowpass(a, vb, nb));
#endif
#if !defined(ONLY_PHASE) || ONLY_PHASE == 6
    RUN_PHASE(6, phase_peer_topk(a, lds, vb, nb));
#endif
#if !defined(ONLY_PHASE) || ONLY_PHASE == 7
    RUN_PHASE(7, phase_peer_gather(a, lds, vb, nb));
#endif
}

extern "C" void kernel_launch(void* const* d_in, const int* in_sizes, int n_in, void* d_out, int out_size, void* d_ws, size_t ws_size, hipStream_t stream) {
    static int grid = 0;
    if (grid == 0) {
        if (n_in != 25 || out_size != NTOK * DM || ws_size < WS_END) { fprintf(stderr, "kernel_launch: unexpected shapes (n_in %d, out %d, ws %zu, need %zu)\n", n_in, out_size, ws_size, (size_t)WS_END); grid = -1; return; }
        int dev = 0, cus = 0;
        if (hipGetDevice(&dev) != hipSuccess || hipDeviceGetAttribute(&cus, hipDeviceAttributeMultiprocessorCount, dev) != hipSuccess) { grid = -1; return; }
        if (hipFuncSetAttribute((const void*)mk_fwd, hipFuncAttributeMaxDynamicSharedMemorySize, LDS_BYTES) != hipSuccess) { fprintf(stderr, "kernel_launch: hipFuncSetAttribute failed\n"); grid = -1; return; }
        (void)hipGetLastError();
        grid = cus;
    }
    if (grid < 0) return;
    (void)hipMemsetAsync((char*)d_ws + WS_CTL, 0, CTL_BYTES, stream);
    Args a{};
    for (int i = 0; i < 25; ++i) a.in[i] = (const float*)d_in[i];
    a.out = (float*)d_out; a.ws = (unsigned char*)d_ws; a.dbl = DBL_PHASE; a.probe = P7_PROBE;
#if MK_N_LAUNCHES == 1
    a.ph_lo = 0; a.ph_hi = N_PHASES;
    hipLaunchKernelGGL(mk_fwd, dim3(grid), dim3(NTHR), LDS_BYTES, stream, a);
#else
    for (int ph = 0; ph < N_PHASES; ++ph) { a.ph_lo = ph; a.ph_hi = ph + 1; hipLaunchKernelGGL(mk_fwd, dim3(grid), dim3(NTHR), LDS_BYTES, stream, a); }
#endif
}
```

```cpp
#include <hip/hip_runtime.h>
#include <cstdio>
#include <cstdint>

#ifndef MK_N_LAUNCHES
#define MK_N_LAUNCHES 1
#endif

typedef unsigned short bf16_t;
typedef short bf16x8 __attribute__((ext_vector_type(8)));
typedef float f32x16 __attribute__((ext_vector_type(16)));
typedef float f32x4 __attribute__((ext_vector_type(4)));
typedef float f32x2 __attribute__((ext_vector_type(2)));
typedef unsigned u32x4 __attribute__((ext_vector_type(4)));
typedef unsigned u32x2 __attribute__((ext_vector_type(2)));
#define LAS __attribute__((address_space(3)))

constexpr int DM = 1024, NB = 16, SEQ = 2048, CTX = 256, STOT = SEQ + CTX;
constexpr int NTOK = NB * SEQ;
constexpr int NCTX = NB * CTX;
constexpr int NROWS = NTOK + NCTX;
constexpr int DIN = 1792, DLRU = 512;
constexpr int KOUT = 1536;
constexpr int PEER_N = 16384;
constexpr float EPS = 1e-6f;
constexpr int NTHR = 512;

constexpr size_t al256(size_t x) { return (x + 255) & ~(size_t)255; }
constexpr size_t WS_CTL   = 0;
constexpr size_t CTL_BYTES = 65536;
constexpr size_t WS_MOD   = WS_CTL + CTL_BYTES;
constexpr size_t WS_ROPE  = WS_MOD + al256(17 * 6144 * 4);
constexpr size_t WS_WIN   = WS_ROPE + al256(64 * 16 * 2 * 4);
constexpr size_t WS_WOUT  = WS_WIN + al256((size_t)DIN * DM * 2);
constexpr size_t WS_WQ    = WS_WOUT + al256((size_t)DM * KOUT * 2);
constexpr size_t WS_SUBK  = WS_WQ + al256((size_t)2048 * DM * 2);
constexpr size_t WS_RGW   = WS_SUBK + al256((size_t)8 * 2 * 128 * 128 * 2);
constexpr size_t WS_UT    = WS_RGW + al256((size_t)2 * 8 * 128 * 64 * 2);
constexpr size_t WS_VT    = WS_UT + al256((size_t)PEER_N * DM * 2);
constexpr size_t WS_XN    = WS_VT + al256((size_t)PEER_N * DM * 2);
constexpr size_t WS_Q     = WS_XN + al256((size_t)NROWS * DM * 2);
constexpr size_t WS_K     = WS_Q + al256((size_t)NTOK * 512 * 2);
constexpr size_t WS_VV    = WS_K + al256((size_t)NB * 2 * STOT * 64 * 2);
constexpr size_t WS_L     = WS_VV + al256((size_t)NB * 2 * STOT * 64 * 2);
constexpr size_t WS_ZG    = WS_L + al256((size_t)NB * STOT * DLRU * 2);
constexpr size_t WS_A2    = WS_ZG + al256((size_t)NTOK * DLRU * 2);
constexpr size_t WS_END   = WS_A2 + al256((size_t)NTOK * KOUT * 2);
constexpr size_t WS_MIX   = WS_XN;
constexpr size_t WS_HX2   = WS_A2;
constexpr size_t WS_IDX   = WS_ZG;
constexpr size_t WS_GATE  = WS_ZG + (size_t)NTOK * 128 * 4;
static_assert(WS_MIX + (size_t)NTOK * DM * 4 <= WS_ZG, "MIX overlay must end before ZG");
static_assert(WS_GATE + (size_t)NTOK * 128 * 4 <= WS_A2, "IDX/GATE overlay must end before A2");

typedef __bf16 bf16x2_t __attribute__((ext_vector_type(2)));
__device__ __forceinline__ unsigned pk2(float lo, float hi) { const f32x2 v = {lo, hi}; const bf16x2_t b = __builtin_convertvector(v, bf16x2_t); return __builtin_bit_cast(unsigned, b); }
typedef _Float16 h16x2 __attribute__((ext_vector_type(2)));
constexpr float V_SCALE = 64.f;
constexpr float T_SCALE = 256.f;
#ifndef P7_FP8
#define P7_FP8 1
#endif
__device__ __forceinline__ unsigned pkh2(float lo, float hi) { const h16x2 h = {(_Float16)lo, (_Float16)hi}; return __builtin_bit_cast(unsigned, h); }
__device__ __forceinline__ bf16x2_t as_bf2(unsigned x) { return __builtin_bit_cast(bf16x2_t, x); }
__device__ __forceinline__ h16x2 as_h2(unsigned x) { return __builtin_bit_cast(h16x2, x); }
__device__ __forceinline__ bf16_t f2bf(float f) { return (bf16_t)(pk2(f, 0.f) & 0xffffu); }
__device__ __forceinline__ float bf2f(unsigned h) { return __uint_as_float(h << 16); }
__device__ __forceinline__ float bflo(unsigned w) { return __uint_as_float(w << 16); }
__device__ __forceinline__ float bfhi(unsigned w) { return __uint_as_float(w & 0xffff0000u); }
__device__ __forceinline__ float fast_rcp(float x) { return __builtin_amdgcn_rcpf(x); }
__device__ __forceinline__ float sigmoidf_(float x) { return fast_rcp(1.f + __expf(-x)); }
__device__ __forceinline__ float gelu_tanh(float x) { const float y = 0.7978845608028654f * (x + 0.044715f * x * x * x); return x * fast_rcp(1.f + __expf(-2.f * y)); }
__device__ __forceinline__ float silu_(float x) { return x * sigmoidf_(x); }
__device__ __forceinline__ float wave_sum(float v) {
#pragma unroll
    for (int o = 32; o > 0; o >>= 1) v += __shfl_xor(v, o);
    return v;
}
__device__ __forceinline__ float half_swap_max(float v) { auto rr = __builtin_amdgcn_permlane32_swap(__float_as_uint(v), __float_as_uint(v), false, false); return fmaxf(__uint_as_float(rr[0]), __uint_as_float(rr[1])); }
__device__ __forceinline__ float half_swap_sum(float v) { auto rr = __builtin_amdgcn_permlane32_swap(__float_as_uint(v), __float_as_uint(v), false, false); return __uint_as_float(rr[0]) + __uint_as_float(rr[1]); }
#define MFMA(a, b, c) __builtin_amdgcn_mfma_f32_32x32x16_bf16((a), (b), (c), 0, 0, 0)

#define XB_TMO      128
#define XB_XCNT(j)  (256  + 64 * (j))
#define XB_XSUB(j)  (1280 + 64 * (j))
#define XB_XGEN(j)  (2304 + 64 * (j))
#define XB_TOP      3328
#define XB_TOPGEN   3392
#define XCD_BAR_WORDS 3456
#define XB_SPIN_CAP (1u << 20)
__device__ __forceinline__ unsigned xb_ld(unsigned* p)              { return __hip_atomic_load(p, __ATOMIC_RELAXED, __HIP_MEMORY_SCOPE_AGENT); }
__device__ __forceinline__ unsigned xb_add(unsigned* p, unsigned v) { return __hip_atomic_fetch_add(p, v, __ATOMIC_RELAXED, __HIP_MEMORY_SCOPE_AGENT); }
__device__ __forceinline__ unsigned xb_xcc_id() { return (unsigned)__builtin_amdgcn_s_getreg((3 << 11) | 20) & 0xFu; }
#define XB_SPIN(cond, bar) do { unsigned _sp = 0; while (cond) { __builtin_amdgcn_s_sleep(1); \
    if ((++_sp & 255u) == 0u) { if (xb_ld(&(bar)[XB_TMO])) break; if (_sp > XB_SPIN_CAP) { atomicAdd(&(bar)[XB_TMO], 1u); break; } } } } while (0)
struct XcdBarrier { unsigned* bar; unsigned x; volatile LAS unsigned* st; };
__device__ __forceinline__ XcdBarrier xcd_barrier_post(unsigned* bar, volatile LAS unsigned* st) {
    XcdBarrier b; b.bar = bar; b.x = xb_xcc_id(); b.st = st;
    if (threadIdx.x == 0) st[2] = xb_add(&bar[XB_XCNT(b.x)], 1u);
    return b;
}
__device__ __forceinline__ void xcd_barrier_complete(unsigned* bar, unsigned x, unsigned& nloc, unsigned& nx) {
    const unsigned G = gridDim.x * gridDim.y * gridDim.z;
    unsigned sum, cnt, mine, sp = 0u;
    for (;;) {
        sum = 0u; cnt = 0u; mine = 0u;
#pragma unroll
        for (unsigned j = 0; j < 16; ++j) { const unsigned c = xb_ld(&bar[XB_XCNT(j)]); sum += c; cnt += (c > 0u) ? 1u : 0u; mine = (j == x) ? c : mine; }
        if (sum == G) break;
        __builtin_amdgcn_s_sleep(1);
        if ((++sp & 255u) == 0u) { if (xb_ld(&bar[XB_TMO])) break; if (sp > XB_SPIN_CAP) { atomicAdd(&bar[XB_TMO], 1u); break; } }
    }
    nloc = mine > 0u ? mine : 1u; nx = cnt > 0u ? cnt : 1u;
}
__device__ __forceinline__ void xcd_barrier(const XcdBarrier& b) {
    asm volatile("s_waitcnt vmcnt(0)" ::: "memory");
    __syncthreads();
    if (threadIdx.x == 0) {
        unsigned* bar = b.bar;
        __builtin_amdgcn_s_waitcnt(0);
        unsigned nloc = b.st[0], nx = b.st[1];
        if (nloc == 0u) { xcd_barrier_complete(bar, b.x, nloc, nx); b.st[0] = nloc; b.st[1] = nx; }
        const unsigned old = xb_add(&bar[XB_XSUB(b.x)], 1u);
        const unsigned gen = old / nloc;
        if (old + 1u == (gen + 1u) * nloc) {
            __builtin_amdgcn_fence(__ATOMIC_RELEASE, "agent");
            asm volatile("s_waitcnt vmcnt(0)" ::: "memory");
            const unsigned og = xb_add(&bar[XB_TOP], 1u);
            const unsigned tg = og / nx;
            if (og + 1u == (tg + 1u) * nx) xb_add(&bar[XB_TOPGEN], 1u);
            else XB_SPIN(xb_ld(&bar[XB_TOPGEN]) == tg, bar);
            __builtin_amdgcn_fence(__ATOMIC_ACQUIRE, "agent");
            xb_add(&bar[XB_XGEN(b.x)], 1u);
            asm volatile("s_waitcnt vmcnt(0)" ::: "memory");
        } else {
            XB_SPIN(xb_ld(&bar[XB_XGEN(b.x)]) == gen, bar);
            __builtin_amdgcn_fence(__ATOMIC_ACQUIRE, "agent");
            asm volatile("s_waitcnt vmcnt(0)" ::: "memory");
        }
    }
    __syncthreads();
}

struct Args { const float* in[25]; float* out; unsigned char* ws; int ph_lo, ph_hi, dbl, probe; };
enum { I_X = 0, I_C, I_CTX, I_CCTX, I_WMOD, I_BMOD, I_GPREMIX, I_GPOSTMIX, I_GPREFFN, I_GPOSTFFN, I_WIN, I_QNG, I_KNG, I_CONVW, I_CONVB,
       I_RGWA, I_RGBA, I_RGWI, I_RGBI, I_RGLAM, I_WOUT, I_PWQ, I_PSUBK, I_PU, I_PV };

__device__ __forceinline__ void tr_tile(const float* __restrict__ src, int lds_, int sr0, int sc0, bf16_t* __restrict__ dst, int ldd, int dr0, int dc0, float* T) {
    const int tid = threadIdx.x;
#pragma unroll
    for (int i = 0; i < 8; ++i) { const int e = tid + NTHR * i, r = e >> 6, c = e & 63; T[r * 65 + c] = src[(size_t)(sr0 + r) * lds_ + sc0 + c]; }
    __syncthreads();
#pragma unroll
    for (int i = 0; i < 8; ++i) { const int e = tid + NTHR * i, c = e >> 6, r = e & 63; dst[(size_t)(dr0 + c) * ldd + dc0 + r] = f2bf(T[r * 65 + c]); }
    __syncthreads();
}

__device__ void phase_prep(const Args& a, char* lds, int vb, int nb) {
    const int tid = threadIdx.x;
    unsigned char* ws = a.ws;
    float* S = (float*)lds;
    float* T = (float*)lds;
    constexpr int N_MOD = 256, N_TIN = 448, N_TOUT = 384, N_TWQ = 512, N_RGW = 32, N_SUBK = 16, N_UV = 512, N_MISC = 1;
    constexpr int O_TIN = N_MOD, O_TOUT = O_TIN + N_TIN, O_TWQ = O_TOUT + N_TOUT, O_RGW = O_TWQ + N_TWQ, O_SUBK = O_RGW + N_RGW, O_UV = O_SUBK + N_SUBK, O_MISC = O_UV + N_UV, N_ALL = O_MISC + N_MISC;
    for (int it = vb; it < N_ALL; it += nb) {
        if (it < O_TIN) {
            for (int e = tid; e < 17 * 1024; e += NTHR) { const int r = e >> 10, k = e & 1023; const float v = (r < 16) ? a.in[I_C][r * 1024 + k] : a.in[I_CCTX][k]; S[e] = silu_(v); }
            __syncthreads();
            const int n0 = it * 24;
            const int cc = tid % 6, kk = tid / 6;
            float acc[17][4];
#pragma unroll
            for (int r = 0; r < 17; ++r) { acc[r][0] = 0.f; acc[r][1] = 0.f; acc[r][2] = 0.f; acc[r][3] = 0.f; }
            if (tid < 510) {
                for (int k = kk; k < 1024; k += 85) {
                    const f32x4 w = *(const f32x4*)(a.in[I_WMOD] + (size_t)k * 6144 + n0 + cc * 4);
#pragma unroll
                    for (int r = 0; r < 17; ++r) { const float s = S[r * 1024 + k]; acc[r][0] += s * w[0]; acc[r][1] += s * w[1]; acc[r][2] += s * w[2]; acc[r][3] += s * w[3]; }
                }
            }
            __syncthreads();
            if (tid < 510) {
#pragma unroll
                for (int r = 0; r < 17; ++r) { f32x4 v = {acc[r][0], acc[r][1], acc[r][2], acc[r][3]}; *(f32x4*)(S + (kk * 17 + r) * 24 + cc * 4) = v; }
            }
            __syncthreads();
            float* mod = (float*)(ws + WS_MOD);
            for (int e = tid; e < 17 * 24; e += NTHR) { const int r = e / 24, j = e % 24; float sum = 0.f;
                for (int q = 0; q < 85; ++q) sum += S[(q * 17 + r) * 24 + j];
                mod[r * 6144 + n0 + j] = sum + a.in[I_BMOD][n0 + j]; }
            __syncthreads();
        } else if (it < O_TOUT) {
            const int t = it - O_TIN, kt = t / 28, nt = t % 28;
            tr_tile(a.in[I_WIN], DIN, kt * 64, nt * 64, (bf16_t*)(ws + WS_WIN), DM, nt * 64, kt * 64, T);
        } else if (it < O_TWQ) {
            const int t = it - O_TOUT, kt = t / 16, nt = t % 16;
            const int sk = (kt < 16) ? kt * 64 : (kt - 16) * 64 + 512;
            tr_tile(a.in[I_WOUT], DM, sk, nt * 64, (bf16_t*)(ws + WS_WOUT), KOUT, nt * 64, kt * 64, T);
        } else if (it < O_RGW) {
            const int t = it - O_TWQ, kt = t / 32, nt = t % 32;
            tr_tile(a.in[I_PWQ], 2048, kt * 64, nt * 64, (bf16_t*)(ws + WS_WQ), DM, nt * 64, kt * 64, T);
        } else if (it < O_SUBK) {
            const int t = it - O_RGW, g = t & 1, dn = t >> 1;
            const float* src = (g == 0 ? a.in[I_RGWA] : a.in[I_RGWI]) + (size_t)dn * 4096;
            tr_tile(src, 64, 0, 0, (bf16_t*)(ws + WS_RGW) + (size_t)dn * 128 * 64 + g * 64 * 64, 64, 0, 0, T);
        } else if (it < O_UV) {
            const int t = it - O_SUBK; const float* src = a.in[I_PSUBK] + (size_t)t * 16384; bf16_t* dst = (bf16_t*)(ws + WS_SUBK) + (size_t)t * 16384;
            for (int e = tid * 4; e < 16384; e += NTHR * 4) { const f32x4 v = *(const f32x4*)(src + e); u32x2 o = {pk2(v[0], v[1]), pk2(v[2], v[3])}; *(u32x2*)(dst + e) = o; }
        } else if (it < O_MISC) {
            const int t = it - O_UV; const bool isv = t >= 256; const int tt = t & 255;
            const float* src = (isv ? a.in[I_PV] : a.in[I_PU]) + (size_t)tt * 65536; bf16_t* dst = (bf16_t*)(ws + (isv ? WS_VT : WS_UT)) + (size_t)tt * 65536;
#if P7_FP8
            unsigned char* d8 = ws + (isv ? WS_VT : WS_UT) + (size_t)tt * 65536;
            for (int e = tid * 16; e < 65536; e += NTHR * 16) { u32x4 o;
#pragma unroll
                for (int q = 0; q < 4; ++q) { f32x4 v = *(const f32x4*)(src + e + q * 4) * T_SCALE;
#pragma unroll
                    for (int i = 0; i < 4; ++i) v[i] = fminf(fmaxf(v[i], -448.f), 448.f);
                    int w = __builtin_amdgcn_cvt_pk_fp8_f32(v[0], v[1], 0, false); w = __builtin_amdgcn_cvt_pk_fp8_f32(v[2], v[3], w, true); o[q] = (unsigned)w; }
                *(u32x4*)(d8 + e) = o; }
#else
            if (!isv) {
                for (int e = tid * 8; e < 65536; e += NTHR * 8) { const f32x4 v0 = *(const f32x4*)(src + e), v1 = *(const f32x4*)(src + e + 4);
                    u32x4 o = {pk2(v0[0], v0[1]), pk2(v0[2], v0[3]), pk2(v1[0], v1[1]), pk2(v1[2], v1[3])}; *(u32x4*)(dst + e) = o; }
            } else {
                for (int e = tid * 8; e < 65536; e += NTHR * 8) { const f32x4 v0 = *(const f32x4*)(src + e) * V_SCALE, v1 = *(const f32x4*)(src + e + 4) * V_SCALE;
                    u32x4 o = {pkh2(v0[0], v0[1]), pkh2(v0[2], v0[3]), pkh2(v1[0], v1[1]), pkh2(v1[2], v1[3])}; *(u32x4*)(dst + e) = o; }
            }
#endif
        } else {
            float* rope = (float*)(ws + WS_ROPE);
            for (int e = tid; e < 64 * 16; e += NTHR) { const int pos = e >> 4, f = e & 15; const float inv = powf(10000.f, -(float)f / 16.f); const float ang = (float)pos * inv; rope[e * 2] = cosf(ang); rope[e * 2 + 1] = sinf(ang); }
        }
    }
}

__device__ void phase_xn(const Args& a, int vb, int nb) {
    const int tid = threadIdx.x, lane = tid & 63, wid = tid >> 6;
    const float* mod = (const float*)(a.ws + WS_MOD);
    bf16_t* XN = (bf16_t*)(a.ws + WS_XN);
    const float* g = a.in[I_GPREMIX];
    for (int row = vb * 8 + wid; row < NROWS; row += nb * 8) {
        const float* src; int mrow;
        if (row < NTOK) { src = a.in[I_X] + (size_t)row * DM; mrow = row >> 11; } else { src = a.in[I_CTX] + (size_t)(row - NTOK) * DM; mrow = 16; }
        f32x4 v[4]; float ss = 0.f;
#pragma unroll
        for (int i = 0; i < 4; ++i) { v[i] = *(const f32x4*)(src + i * 256 + lane * 4); ss += v[i][0] * v[i][0] + v[i][1] * v[i][1] + v[i][2] * v[i][2] + v[i][3] * v[i][3]; }
        ss = wave_sum(ss);
        const float rinv = rsqrtf(ss * (1.f / DM) + EPS);
        const float* sh = mod + (size_t)mrow * 6144, *sc = sh + 1024;
#pragma unroll
        for (int i = 0; i < 4; ++i) { const int c = i * 256 + lane * 4;
            const f32x4 gg = *(const f32x4*)(g + c), s1 = *(const f32x4*)(sc + c), s0 = *(const f32x4*)(sh + c);
            float o[4];
#pragma unroll
            for (int j = 0; j < 4; ++j) o[j] = v[i][j] * rinv * gg[j] * (1.f + s1[j]) + s0[j];
            u32x2 w = {pk2(o[0], o[1]), pk2(o[2], o[3])}; *(u32x2*)(XN + (size_t)row * DM + c) = w; }
    }
}

constexpr int G_STAGE = (256 + 128) * 128;
constexpr int G_LDS = 2 * G_STAGE;
constexpr int E_PITCH = 272;
template <int NSET, bool NOLOAD = false>
__device__ __forceinline__ void gemm_core(f32x16 (&acc)[2][2], const bf16_t* __restrict__ X, int ldx, const bf16_t* __restrict__ Wt, int ldw, int K, char* lds) {
    const int tid = threadIdx.x, lane = tid & 63, wid = tid >> 6, wm = wid & 3, wn = wid >> 2, r32 = lane & 31, hi = lane >> 5;
    const int lrow = tid >> 3, lch = (tid & 7) ^ ((lrow >> 1) & 7);
    const bf16_t* xg = X + (size_t)lrow * ldx + lch * 8;
    const bf16_t* wg = Wt + (size_t)lrow * ldw + lch * 8;
#pragma unroll
    for (int ft = 0; ft < 2; ++ft)
#pragma unroll
        for (int tt = 0; tt < 2; ++tt)
#pragma unroll
            for (int r = 0; r < 16; ++r) acc[ft][tt][r] = 0.f;
#define G_DMA(s, k0) do { char* b_ = lds + (s) * G_STAGE + tid * 16; \
        _Pragma("unroll") for (int i = 0; i < 4; ++i) __builtin_amdgcn_global_load_lds((const unsigned*)(xg + (size_t)i * 64 * ldx + (k0)), (unsigned*)(b_ + i * 8192), 16, 0, 0); \
        _Pragma("unroll") for (int i = 0; i < 2; ++i) __builtin_amdgcn_global_load_lds((const unsigned*)(wg + (size_t)i * 64 * ldw + (k0)), (unsigned*)(b_ + 32768 + i * 8192), 16, 0, 0); } while (0)
    const int nk = K >> 6;
    const int xrow = wm * 64 + r32, wrow = wn * 64 + r32;
    const int xsw = (xrow >> 1) & 7, wsw = (wrow >> 1) & 7;
    int st_c = 0, st_n = 1;
    G_DMA(0, 0);
    if (NSET == 3) { G_DMA(1, 64); st_n = 2; asm volatile("s_waitcnt vmcnt(6)" ::: "memory"); __builtin_amdgcn_s_barrier(); } else { __syncthreads(); }
#pragma unroll 1
    for (int kt = 0; kt < nk; ++kt) {
        { const int kn = (kt + NSET - 1 < nk) ? kt + NSET - 1 : nk - 1; G_DMA(st_n, kn * 64); }
        const char* xs = lds + st_c * G_STAGE + xrow * 128;
        const char* wsb = lds + st_c * G_STAGE + 32768 + wrow * 128;
        bf16x8 fa0[2], fa1[2], fb0[2], fb1[2];
        { const int xo = ((0 * 2 + hi) ^ xsw) << 4, wo = ((0 * 2 + hi) ^ wsw) << 4;
          fa0[0] = *(const bf16x8*)(wsb + wo); fa1[0] = *(const bf16x8*)(wsb + 32 * 128 + wo); fb0[0] = *(const bf16x8*)(xs + xo); fb1[0] = *(const bf16x8*)(xs + 32 * 128 + xo); }
#pragma unroll
        for (int ks = 0; ks < 4; ++ks) {
            if (ks + 1 < 4) { const int xo = (((ks + 1) * 2 + hi) ^ xsw) << 4, wo = (((ks + 1) * 2 + hi) ^ wsw) << 4;
                fa0[(ks + 1) & 1] = *(const bf16x8*)(wsb + wo); fa1[(ks + 1) & 1] = *(const bf16x8*)(wsb + 32 * 128 + wo);
                fb0[(ks + 1) & 1] = *(const bf16x8*)(xs + xo); fb1[(ks + 1) & 1] = *(const bf16x8*)(xs + 32 * 128 + xo); }
            acc[0][0] = MFMA(fa0[ks & 1], fb0[ks & 1], acc[0][0]); acc[0][1] = MFMA(fa0[ks & 1], fb1[ks & 1], acc[0][1]);
            acc[1][0] = MFMA(fa1[ks & 1], fb0[ks & 1], acc[1][0]); acc[1][1] = MFMA(fa1[ks & 1], fb1[ks & 1], acc[1][1]);
            __builtin_amdgcn_sched_barrier(0);
        }
        if (NSET == 3) { asm volatile("s_waitcnt vmcnt(6)" ::: "memory"); __builtin_amdgcn_s_barrier(); st_c = st_c == 2 ? 0 : st_c + 1; st_n = st_n == 2 ? 0 : st_n + 1; }
        else { __syncthreads(); st_c ^= 1; st_n ^= 1; }
    }
    if (NSET == 3) { asm volatile("s_waitcnt vmcnt(0)" ::: "memory"); __syncthreads(); }
#undef G_DMA
}
__device__ __forceinline__ void stage_acc(const f32x16 (&acc)[2][2], char* lds) {
    const int tid = threadIdx.x, lane = tid & 63, wid = tid >> 6, wm = wid & 3, wn = wid >> 2, r32 = lane & 31, hi = lane >> 5;
#pragma unroll
    for (int ft = 0; ft < 2; ++ft)
#pragma unroll
        for (int tt = 0; tt < 2; ++tt)
#pragma unroll
            for (int g = 0; g < 4; ++g) {
                u32x2 v = {pk2(acc[ft][tt][4 * g], acc[ft][tt][4 * g + 1]), pk2(acc[ft][tt][4 * g + 2], acc[ft][tt][4 * g + 3])};
                *(u32x2*)(lds + (wm * 64 + tt * 32 + r32) * E_PITCH + (wn * 64 + ft * 32 + g * 8 + hi * 4) * 2) = v;
            }
}

namespace g8 {
constexpr int BM = 256, BK = 64, HALF = 128, HT = HALF * BK, SHM_B = 8 * HT * 2;
__device__ __forceinline__ int lds_byte(int r, int c) { const int st = (r >> 4) * 2 + (c >> 5), rr = r & 15, cc = c & 31, ob = rr * 64 + cc * 2; return st * 1024 + (ob ^ (((ob >> 9) & 1) << 5)); }
__device__ __forceinline__ void stage_rc(int b, int& R, int& C) { const int st = b / 1024, sb = b % 1024, swz = sb ^ (((sb >> 9) & 1) << 5); R = (st >> 1) * 16 + swz / 64; C = (st & 1) * 32 + (swz % 64) / 2; }
__device__ __forceinline__ void core(f32x4 (&acc)[2][2][4][2], const bf16_t* __restrict__ A, const bf16_t* __restrict__ Bt, int brow, int bcol, int K, char* lds_) {
    LAS unsigned char* lds = (LAS unsigned char*)lds_;
    const int tid = threadIdx.x, wid = __builtin_amdgcn_readfirstlane(tid >> 6), lane = tid & 63, wr = wid >> 2, wc = wid & 3, fr = lane & 15, fq = lane >> 4;
    constexpr int HTB = HT * 2;
    unsigned voff[2];
#pragma unroll
    for (int i = 0; i < 2; ++i) { int R, C; stage_rc(tid * 16 + i * 8192, R, C); voff[i] = (unsigned)(R * K + C) * 2u; }
    const size_t kstep = (size_t)(BK * 2), hstep = (size_t)HALF * K * 2;
    const unsigned ldsw = (unsigned)wid * 1024u;
    const int aoff = lds_byte(wr * 64 + fr, fq * 8), boff = lds_byte(wc * 32 + fr, fq * 8);
#define G8_SA(b, h) (((b) * 2 + (h)) * HTB)
#define G8_SB(b, h) ((4 + (b) * 2 + (h)) * HTB)
#define G8_STAGE(bufoff, gbase) do { _Pragma("unroll") for (int _i = 0; _i < 2; ++_i) \
        __builtin_amdgcn_global_load_lds((const unsigned*)((const char*)(gbase) + voff[_i]), (LAS unsigned*)(lds + (bufoff) + ldsw + _i * 8192), 16, 0, 0); } while (0)
#define G8_LDA(dst, b, h) do { _Pragma("unroll") for (int m = 0; m < 4; ++m) _Pragma("unroll") for (int k = 0; k < 2; ++k) dst[m][k] = *(const LAS bf16x8*)(lds + G8_SA(b, h) + aoff + m * 2048 + k * 1024); } while (0)
#define G8_LDB(dst, b, h) do { _Pragma("unroll") for (int n = 0; n < 2; ++n) _Pragma("unroll") for (int k = 0; k < 2; ++k) dst[n][k] = *(const LAS bf16x8*)(lds + G8_SB(b, h) + boff + n * 2048 + k * 1024); } while (0)
#define G8_MMA(ai, bj, At_, Bt_) do { __builtin_amdgcn_s_setprio(1); \
    _Pragma("unroll") for (int m = 0; m < 4; ++m) _Pragma("unroll") for (int n = 0; n < 2; ++n) _Pragma("unroll") for (int k = 0; k < 2; ++k) \
      acc[ai][bj][m][n] = __builtin_amdgcn_mfma_f32_16x16x32_bf16(At_[m][k], Bt_[n][k], acc[ai][bj][m][n], 0, 0, 0); \
    __builtin_amdgcn_s_setprio(0); } while (0)
#define G8_WAIT_V(n) asm volatile("s_waitcnt vmcnt(" #n ")" ::: "memory")
#define G8_WAIT_L(n) asm volatile("s_waitcnt lgkmcnt(" #n ")" ::: "memory")
#define G8_BAR __builtin_amdgcn_s_barrier()
#define G8_SCHED __builtin_amdgcn_sched_barrier(0)
#pragma unroll
    for (int ai = 0; ai < 2; ++ai)
#pragma unroll
        for (int bj = 0; bj < 2; ++bj)
#pragma unroll
            for (int m = 0; m < 4; ++m)
#pragma unroll
                for (int n = 0; n < 2; ++n) acc[ai][bj][m][n] = (f32x4){0.f, 0.f, 0.f, 0.f};
    bf16x8 At[4][2], B0[2][2], B1[2][2];
    const int nt = K / BK;
    const char* cA = (const char*)(A + (size_t)brow * K); const char* cB = (const char*)(Bt + (size_t)bcol * K);
    G8_STAGE(G8_SB(0, 0), cB); G8_STAGE(G8_SA(0, 0), cA); G8_STAGE(G8_SB(0, 1), cB + hstep); G8_STAGE(G8_SA(0, 1), cA + hstep);
    if (wr == 1) G8_BAR;
    G8_WAIT_V(4); G8_BAR;
    G8_STAGE(G8_SB(1, 0), cB + kstep); G8_STAGE(G8_SA(1, 0), cA + kstep); G8_STAGE(G8_SB(1, 1), cB + hstep + kstep);
    G8_WAIT_V(6); G8_BAR;
#pragma unroll 1
    for (int t = 0; t < nt - 2; t += 2) {
        const char* a1 = cA + (size_t)(t + 1) * kstep; const char* a2 = cA + (size_t)(t + 2) * kstep; const char* b2 = cB + (size_t)(t + 2) * kstep;
        const char* a3 = a2 + kstep; const char* b3 = b2 + kstep;
        G8_LDB(B0, 0, 0); G8_SCHED; G8_LDA(At, 0, 0); G8_STAGE(G8_SA(1, 1), a1 + hstep);
        G8_WAIT_L(8); G8_BAR; G8_WAIT_L(0); G8_MMA(0, 0, At, B0); G8_BAR; G8_SCHED;
        G8_LDB(B1, 0, 1); G8_STAGE(G8_SB(0, 0), b2);
        G8_BAR; G8_WAIT_L(0); G8_MMA(0, 1, At, B1); G8_BAR;
        G8_LDA(At, 0, 1); G8_STAGE(G8_SA(0, 0), a2);
        G8_BAR; G8_WAIT_L(0); G8_MMA(1, 0, At, B0); G8_BAR; G8_SCHED;
        G8_STAGE(G8_SB(0, 1), b2 + hstep);
        G8_WAIT_V(6); G8_BAR; G8_MMA(1, 1, At, B1); G8_BAR;
        G8_LDB(B0, 1, 0); G8_SCHED; G8_LDA(At, 1, 0); G8_STAGE(G8_SA(0, 1), a2 + hstep);
        G8_WAIT_L(8); G8_BAR; G8_WAIT_L(0); G8_MMA(0, 0, At, B0); G8_BAR; G8_SCHED;
        G8_LDB(B1, 1, 1); G8_STAGE(G8_SB(1, 0), b3);
        G8_BAR; G8_WAIT_L(0); G8_MMA(0, 1, At, B1); G8_BAR;
        G8_LDA(At, 1, 1); G8_STAGE(G8_SA(1, 0), a3);
        G8_BAR; G8_WAIT_L(0); G8_MMA(1, 0, At, B0); G8_BAR; G8_SCHED;
        G8_STAGE(G8_SB(1, 1), b3 + hstep);
        G8_WAIT_V(6); G8_BAR; G8_MMA(1, 1, At, B1); G8_BAR;
    }
    { G8_LDB(B0, 0, 0); G8_LDA(At, 0, 0); G8_STAGE(G8_SA(1, 1), cA + (size_t)(nt - 1) * kstep + hstep);
      G8_BAR; G8_WAIT_L(0); G8_MMA(0, 0, At, B0); G8_BAR;
      G8_LDB(B1, 0, 1); G8_BAR; G8_WAIT_L(0); G8_MMA(0, 1, At, B1); G8_BAR;
      G8_LDA(At, 0, 1); G8_WAIT_V(4); G8_BAR; G8_WAIT_L(0); G8_MMA(1, 0, At, B0); G8_MMA(1, 1, At, B1); G8_BAR; }
    { G8_LDB(B0, 1, 0); G8_LDA(At, 1, 0); G8_WAIT_V(2); G8_BAR; G8_WAIT_L(0); G8_MMA(0, 0, At, B0); G8_BAR;
      G8_LDB(B1, 1, 1); G8_WAIT_V(0); G8_BAR; G8_WAIT_L(0); G8_MMA(0, 1, At, B1); G8_BAR;
      G8_LDA(At, 1, 1); G8_BAR; G8_WAIT_L(0); G8_MMA(1, 0, At, B0); G8_MMA(1, 1, At, B1); G8_BAR; }
    if (wr == 0) G8_BAR;
#undef G8_SA
#undef G8_SB
#undef G8_STAGE
#undef G8_LDA
#undef G8_LDB
#undef G8_MMA
#undef G8_WAIT_V
#undef G8_WAIT_L
#undef G8_BAR
#undef G8_SCHED
}
}

__device__ void phase_inproj(const Args& a, char* lds, int vb, int nb) {
    const int tid = threadIdx.x, lane = tid & 63, wid = tid >> 6, wr = wid >> 2, wc = wid & 3, fr = lane & 15, fq = lane >> 4;
    unsigned char* ws = a.ws;
    const bf16_t* XN = (const bf16_t*)(ws + WS_XN);
    const bf16_t* WIN = (const bf16_t*)(ws + WS_WIN);
    const float* rope = (const float*)(ws + WS_ROPE);
    bf16_t* Qo = (bf16_t*)(ws + WS_Q); bf16_t* Ko = (bf16_t*)(ws + WS_K); bf16_t* Vo = (bf16_t*)(ws + WS_VV); bf16_t* Lo = (bf16_t*)(ws + WS_L); bf16_t* Zo = (bf16_t*)(ws + WS_ZG);
    constexpr int N_LAT = 128 * 7, N_ALL = N_LAT + 16 * 3;
#pragma unroll 1
    for (int it = vb; it < N_ALL; it += nb) {
        int tt, ft;
        if (it < N_LAT) { tt = it / 7; ft = it % 7; } else { const int j = it - N_LAT; tt = 128 + j / 3; ft = 2 + j % 3; }
        f32x4 acc[2][2][4][2];
        g8::core(acc, WIN, XN, ft * 256, tt * 256, DM, lds);
        const bool lat = tt < 128;
#pragma unroll
        for (int ai = 0; ai < 2; ++ai) {
            const int g64 = ft * 4 + ai * 2 + wr;
            if (g64 < 10) {
                const bool isq = g64 < 8;
                const float* gn = isq ? a.in[I_QNG] : a.in[I_KNG];
                const float osc = isq ? 0.125f * 1.4426950408889634f : 1.f;
                float gnv[4][4];
#pragma unroll
                for (int m = 0; m < 4; ++m) { const f32x4 gv = *(const f32x4*)(gn + m * 16 + fq * 4); gnv[m][0] = gv[0]; gnv[m][1] = gv[1]; gnv[m][2] = gv[2]; gnv[m][3] = gv[3]; }
#pragma unroll
                for (int bj = 0; bj < 2; ++bj)
#pragma unroll
                    for (int n = 0; n < 2; ++n) {
                        float ss = 0.f;
#pragma unroll
                        for (int m = 0; m < 4; ++m)
#pragma unroll
                            for (int j = 0; j < 4; ++j) ss += acc[ai][bj][m][n][j] * acc[ai][bj][m][n][j];
                        ss += __shfl_xor(ss, 16); ss += __shfl_xor(ss, 32);
                        const float rinv = rsqrtf(ss * (1.f / 64.f) + EPS);
                        const int row = tt * 256 + bj * 128 + wc * 32 + n * 16 + fr;
                        int b, t, s_; if (lat) { b = row >> 11; t = row & 2047; s_ = CTX + t; } else { const int rc = row - NTOK; b = rc >> 8; t = 0; s_ = rc & 255; }
                        bf16_t* dst = isq ? Qo + ((size_t)(b * 8 + g64) * SEQ + t) * 64 : Ko + ((size_t)(b * 2 + (g64 - 8)) * STOT + s_) * 64;
#pragma unroll
                        for (int ax = 0; ax < 2; ++ax) {
                            const int pos = ax == 0 ? (t >> 6) : (t & 63);
                            float o1[4], o2[4];
#pragma unroll
                            for (int j = 0; j < 4; ++j) {
                                const float x1 = acc[ai][bj][2 * ax][n][j] * rinv * gnv[2 * ax][j], x2 = acc[ai][bj][2 * ax + 1][n][j] * rinv * gnv[2 * ax + 1][j];
                                float c1 = x1, c2 = x2;
                                if (lat) { const f32x2 cs = *(const f32x2*)(rope + (pos * 16 + fq * 4 + j) * 2); c1 = x1 * cs[0] - x2 * cs[1]; c2 = x1 * cs[1] + x2 * cs[0]; }
                                o1[j] = c1 * osc; o2[j] = c2 * osc; }
                            *(u32x2*)(dst + ax * 32 + fq * 4) = (u32x2){pk2(o1[0], o1[1]), pk2(o1[2], o1[3])};
                            *(u32x2*)(dst + ax * 32 + 16 + fq * 4) = (u32x2){pk2(o2[0], o2[1]), pk2(o2[2], o2[3])};
                        }
                    }
            } else if (g64 < 12) {
#pragma unroll
                for (int bj = 0; bj < 2; ++bj)
#pragma unroll
                    for (int n = 0; n < 2; ++n) {
                        const int row = tt * 256 + bj * 128 + wc * 32 + n * 16 + fr;
                        int b, s_; if (lat) { b = row >> 11; s_ = CTX + (row & 2047); } else { const int rc = row - NTOK; b = rc >> 8; s_ = rc & 255; }
                        bf16_t* vp = Vo + ((size_t)(b * 2 + (g64 - 10)) * 64) * STOT + s_;
#pragma unroll
                        for (int m = 0; m < 4; ++m)
#pragma unroll
                            for (int j = 0; j < 4; ++j) vp[(size_t)(m * 16 + fq * 4 + j) * STOT] = f2bf(acc[ai][bj][m][n][j]);
                    }
            } else {
                const bool isz = g64 >= 20;
#pragma unroll
                for (int bj = 0; bj < 2; ++bj)
#pragma unroll
                    for (int n = 0; n < 2; ++n) {
                        const int row = tt * 256 + bj * 128 + wc * 32 + n * 16 + fr;
                        bf16_t* dst;
                        if (isz) dst = Zo + (size_t)row * DLRU + (g64 - 20) * 64;
                        else { int b, s_; if (lat) { b = row >> 11; s_ = CTX + (row & 2047); } else { const int rc = row - NTOK; b = rc >> 8; s_ = rc & 255; }
                            dst = Lo + ((size_t)b * STOT + s_) * DLRU + (g64 - 12) * 64; }
#pragma unroll
                        for (int m = 0; m < 4; ++m) { f32x4 v = acc[ai][bj][m][n];
                            if (isz) { v[0] = gelu_tanh(v[0]); v[1] = gelu_tanh(v[1]); v[2] = gelu_tanh(v[2]); v[3] = gelu_tanh(v[3]); }
                            *(u32x2*)(dst + m * 16 + fq * 4) = (u32x2){pk2(v[0], v[1]), pk2(v[2], v[3])}; }
                    }
            }
        }
        __syncthreads();
    }
}

constexpr int AT_KP = 144, AT_VP = 136, AT_STAGE = 64 * AT_KP + 64 * AT_VP;
__device__ void attn_item(const Args& a, char* lds, int b, int head, int qblk) {
    const int tid = threadIdx.x, lane = tid & 63, wid = tid >> 6, r32 = lane & 31, hi = lane >> 5;
    unsigned char* ws = a.ws;
    const int kvh = head >> 2;
    const bf16_t* Qp = (const bf16_t*)(ws + WS_Q) + ((size_t)(b * 8 + head) * SEQ + qblk * 256 + wid * 32 + r32) * 64 + hi * 8;
    const bf16_t* Kp = (const bf16_t*)(ws + WS_K) + (size_t)(b * 2 + kvh) * STOT * 64;
    const bf16_t* Vp = (const bf16_t*)(ws + WS_VV) + (size_t)(b * 2 + kvh) * 64 * STOT;
    bf16x8 qf[4];
#pragma unroll
    for (int ds = 0; ds < 4; ++ds) qf[ds] = *(const bf16x8*)(Qp + ds * 16);
    const int srow = tid >> 3, sch = tid & 7;
    const bf16_t* kg = Kp + (size_t)srow * 64 + sch * 8;
    const bf16_t* vg = Vp + (size_t)srow * STOT + sch * 8;
    u32x4 krA, vrA, krB, vrB;
    f32x16 o[2]; float lsum = 0.f;
    float negM;
    { float gq = fabsf(a.in[I_QNG][lane]), gk = fabsf(a.in[I_KNG][lane]);
#pragma unroll
      for (int o_ = 32; o_ > 0; o_ >>= 1) { gq = fmaxf(gq, __shfl_xor(gq, o_)); gk = fmaxf(gk, __shfl_xor(gk, o_)); }
      negM = -(64.f * 0.125f * 1.4426950408889634f * 1.01f) * gq * gk; }
#pragma unroll
    for (int dt = 0; dt < 2; ++dt)
#pragma unroll
        for (int r = 0; r < 16; ++r) o[dt][r] = 0.f;
    char* KS = lds; char* VS = lds + 2 * 64 * AT_KP;
#define A_LOADK(X, s0) do { kr##X = *(const u32x4*)(kg + (size_t)(s0) * 64); } while (0)
#define A_LOADV(X, s0) do { vr##X = *(const u32x4*)(vg + (s0)); } while (0)
#define A_WRITEK(X, st) do { *(u32x4*)(KS + (st) * 64 * AT_KP + srow * AT_KP + sch * 16) = kr##X; } while (0)
#define A_WRITEV(X, st) do { char* vb_ = VS + (st) * 64 * AT_VP + srow * AT_VP + sch * 16; *(u32x2*)vb_ = (u32x2){vr##X[0], vr##X[1]}; *(u32x2*)(vb_ + 8) = (u32x2){vr##X[2], vr##X[3]}; } while (0)
    constexpr int NT = STOT / 64;
    f32x16 sc[2], sn[2];
    A_LOADK(A, 0); A_LOADV(A, 0); A_WRITEK(A, 0); A_WRITEV(A, 0); A_LOADK(A, 64); A_WRITEK(A, 1); A_LOADK(B, 128); A_LOADV(B, 64); __syncthreads();
#pragma unroll
    for (int kt = 0; kt < 2; ++kt) {
#pragma unroll
        for (int r = 0; r < 16; ++r) sc[kt][r] = negM;
#pragma unroll
        for (int ds = 0; ds < 4; ++ds) { const bf16x8 ka = *(const bf16x8*)(KS + (kt * 32 + r32) * AT_KP + (ds * 16 + hi * 8) * 2); sc[kt] = MFMA(ka, qf[ds], sc[kt]); }
    }
    __syncthreads();
    f32x16 ol;
#pragma unroll
    for (int r = 0; r < 16; ++r) ol[r] = 0.f;
    const u32x4 ones_w = {0x3F803F80u, 0x3F803F80u, 0x3F803F80u, 0x3F803F80u};
    const bf16x8 ones = *(const bf16x8*)&ones_w;
#define A_STEP(J, SC, SN, XW, XL) do { const int j_ = (J); \
        const int jk = (j_ + 3 < NT) ? j_ + 3 : NT - 1, jv = (j_ + 2 < NT) ? j_ + 2 : NT - 1; \
        A_LOADK(XL, jk * 64); A_LOADV(XL, jv * 64); \
        const char* ksn = KS + ((j_ + 1) & 1) * 64 * AT_KP; const char* vs = VS + (j_ & 1) * 64 * AT_VP; \
        _Pragma("unroll") for (int kt = 0; kt < 2; ++kt) { \
            _Pragma("unroll") for (int r = 0; r < 16; ++r) SN[kt][r] = negM; \
            _Pragma("unroll") for (int ds = 0; ds < 4; ++ds) { \
                const bf16x8 ka = *(const bf16x8*)(ksn + (kt * 32 + r32) * AT_KP + (ds * 16 + hi * 8) * 2); \
                SN[kt] = MFMA(ka, qf[ds], SN[kt]); \
                _Pragma("unroll") for (int e = 0; e < 4; ++e) { const int f = (kt * 4 + ds) * 4 + e; SC[f >> 4][f & 15] = __builtin_amdgcn_exp2f(SC[f >> 4][f & 15]); } \
                __builtin_amdgcn_sched_barrier(0); } } \
        _Pragma("unroll") for (int kt = 0; kt < 2; ++kt) \
            _Pragma("unroll") for (int s = 0; s < 2; ++s) { \
                u32x4 pw = {pk2(SC[kt][8 * s], SC[kt][8 * s + 1]), pk2(SC[kt][8 * s + 2], SC[kt][8 * s + 3]), pk2(SC[kt][8 * s + 4], SC[kt][8 * s + 5]), pk2(SC[kt][8 * s + 6], SC[kt][8 * s + 7])}; \
                const bf16x8 pb = *(bf16x8*)&pw; \
                _Pragma("unroll") for (int dt = 0; dt < 2; ++dt) { \
                    const char* vp = vs + (dt * 32 + r32) * AT_VP + (kt * 32 + s * 16 + hi * 4) * 2; \
                    const u32x2 lo = *(const u32x2*)vp, hh = *(const u32x2*)(vp + 16); \
                    u32x4 aw = {lo[0], lo[1], hh[0], hh[1]}; \
                    o[dt] = MFMA(*(bf16x8*)&aw, pb, o[dt]); } \
                ol = MFMA(ones, pb, ol); } \
        A_WRITEK(XW, j_ & 1); A_WRITEV(XW, (j_ + 1) & 1); \
        __syncthreads(); } while (0)
#pragma unroll 1
    for (int j = 0; j < NT; j += 2) { A_STEP(j, sc, sn, B, A); A_STEP(j + 1, sn, sc, A, B); }
#undef A_STEP
    lsum = ol[0];
#undef A_LOADK
#undef A_LOADV
#undef A_WRITEK
#undef A_WRITEV
    const float inv = fast_rcp(lsum);
    bf16_t* outp = (bf16_t*)(ws + WS_A2) + ((size_t)b * SEQ + qblk * 256 + wid * 32 + r32) * KOUT + head * 64;
#pragma unroll
    for (int dt = 0; dt < 2; ++dt)
#pragma unroll
        for (int g = 0; g < 4; ++g) {
            u32x2 v = {pk2(o[dt][4 * g] * inv, o[dt][4 * g + 1] * inv), pk2(o[dt][4 * g + 2] * inv, o[dt][4 * g + 3] * inv)};
            *(u32x2*)(outp + dt * 32 + g * 8 + hi * 4) = v;
        }
}

constexpr int LR_RAW = 0;
constexpr int LR_U   = 33792;
constexpr int LR_BB  = LR_U + 33280;
constexpr int LR_UB  = LR_BB + 33280;
constexpr int LR_WG  = LR_UB + 18432;
constexpr int LR_SEG = LR_WG + 18432;
constexpr int LR_HC  = LR_SEG + 4096;
constexpr int LR_CST = LR_HC + 512;
constexpr int LR_END = LR_CST + 768;
__device__ void lru_item(const Args& a, char* lds, int b, int n, int d) {
    const int tid = threadIdx.x, lane = tid & 63, wid = tid >> 6, r32 = lane & 31, hi = lane >> 5;
    unsigned char* ws = a.ws;
    float* RAW = (float*)(lds + LR_RAW); float* AA = (float*)(lds + LR_RAW); float* U = (float*)(lds + LR_U); float* BB = (float*)(lds + LR_BB);
    char* UB = lds + LR_UB; char* WG = lds + LR_WG; float* SEG = (float*)(lds + LR_SEG); float* HC = (float*)(lds + LR_HC);
    const bf16_t* Lg = (const bf16_t*)(ws + WS_L) + (size_t)b * STOT * DLRU + n * 64;
    const bf16_t* Zg = (const bf16_t*)(ws + WS_ZG) + (size_t)b * SEQ * DLRU + n * 64;
    bf16_t* Og = (bf16_t*)(ws + WS_A2) + (size_t)b * SEQ * KOUT + 512 + d * 512 + n * 64;
    {
        const bf16_t* wsrc = (const bf16_t*)(ws + WS_RGW) + (size_t)(d * 8 + n) * 128 * 64;
#pragma unroll
        for (int i = 0; i < 2; ++i) { const int c = tid + NTHR * i, r = c >> 3, ch = c & 7; *(u32x4*)(WG + r * 144 + ch * 16) = *(const u32x4*)(wsrc + r * 64 + ch * 8); }
        if (tid < 128) HC[tid] = 0.f;
    }
    const int ct = wid & 1, tt = wid >> 1;
    float* CST = (float*)(lds + LR_CST);
    if (tid < 64) { const int c = n * 64 + tid; CST[tid] = a.in[I_RGBA][d * 512 + c]; CST[64 + tid] = a.in[I_RGBI][d * 512 + c];
        const float x = -a.in[I_RGLAM][d * 512 + c]; CST[128 + tid] = -8.f * (fmaxf(x, 0.f) + log1pf(__expf(-fabsf(x)))); }
    const int sc = tid & 63, sg = tid >> 6;
    const float cw0 = a.in[I_CONVW][0 * 512 + n * 64 + sc], cw1 = a.in[I_CONVW][1 * 512 + n * 64 + sc], cw2 = a.in[I_CONVW][2 * 512 + n * 64 + sc], cw3 = a.in[I_CONVW][3 * 512 + n * 64 + sc];
    const float cbias = a.in[I_CONVB][n * 64 + sc];
    __syncthreads();
    int par = 0;
    for (int step = 0; step < 18; ++step) {
        const bool isctx = step < 2;
        const int tl = isctx ? (d == 0 ? step : 1 - step) : (d == 0 ? step - 2 : 17 - step);
        const int sb = isctx ? 0 : CTX, sl = isctx ? CTX : SEQ, t0 = tl * 128;
        for (int e = tid; e < 131 * 8; e += NTHR) { const int r = e >> 3, ch = e & 7, t = t0 - 2 + r;
            u32x4 v = {0u, 0u, 0u, 0u}; if (t >= 0 && t < sl) v = *(const u32x4*)(Lg + (size_t)(sb + t) * DLRU + ch * 8);
            float* dst = RAW + r * 64 + ch * 8;
            dst[0] = bflo(v[0]); dst[1] = bfhi(v[0]); dst[2] = bflo(v[1]); dst[3] = bfhi(v[1]); dst[4] = bflo(v[2]); dst[5] = bfhi(v[2]); dst[6] = bflo(v[3]); dst[7] = bfhi(v[3]); }
        __syncthreads();
        {
            const float* rp = RAW + (sg * 16) * 64 + sc;
            float x0 = rp[0], x1 = rp[64], x2 = rp[128];
            float* up = U + (sg * 16) * 65 + sc; char* ubp = UB + (sg * 16) * 144 + sc * 2;
#pragma unroll
            for (int i = 0; i < 16; ++i) { const float x3 = rp[(i + 3) * 64];
                const float u = cbias + cw0 * x0 + cw1 * x1 + cw2 * x2 + cw3 * x3;
                up[i * 65] = u; *(bf16_t*)(ubp + i * 144) = f2bf(u); x0 = x1; x1 = x2; x2 = x3; }
        }
        __syncthreads();
        {
            f32x16 ga, gi;
#pragma unroll
            for (int r = 0; r < 16; ++r) { ga[r] = 0.f; gi[r] = 0.f; }
#pragma unroll
            for (int ks = 0; ks < 4; ++ks) {
                const bf16x8 wa = *(const bf16x8*)(WG + (ct * 32 + r32) * 144 + (ks * 16 + hi * 8) * 2);
                const bf16x8 wi = *(const bf16x8*)(WG + (64 + ct * 32 + r32) * 144 + (ks * 16 + hi * 8) * 2);
                const bf16x8 ub = *(const bf16x8*)(UB + (tt * 32 + r32) * 144 + (ks * 16 + hi * 8) * 2);
                ga = MFMA(wa, ub, ga); gi = MFMA(wi, ub, gi);
            }
            const int t = tt * 32 + r32;
#pragma unroll
            for (int r = 0; r < 16; ++r) { const int c = ct * 32 + 8 * (r >> 2) + 4 * hi + (r & 3);
                const float rr = sigmoidf_(ga[r] + CST[c]), ii = sigmoidf_(gi[r] + CST[64 + c]);
                const float la = CST[128 + c] * rr, av = __expf(la), mult = __builtin_amdgcn_sqrtf(fmaxf(1.f - av * av, 0.f));
                const float u = U[t * 65 + c];
                AA[t * 65 + c] = av; BB[t * 65 + c] = mult * ii * u; }
        }
        __syncthreads();
        float av[16], bv[16]; float Ap = 1.f, Bp = 0.f;
#pragma unroll
        for (int k = 0; k < 16; ++k) { const int p = sg * 16 + k, t = d == 0 ? p : 127 - p; av[k] = AA[t * 65 + sc]; bv[k] = BB[t * 65 + sc]; Bp = av[k] * Bp + bv[k]; Ap = av[k] * Ap; }
        SEG[sg * 64 + sc] = Ap; SEG[512 + sg * 64 + sc] = Bp;
        __syncthreads();
        float h = HC[par * 64 + sc];
        for (int s2 = 0; s2 < sg; ++s2) h = SEG[s2 * 64 + sc] * h + SEG[512 + s2 * 64 + sc];
        {
            const int tfirst = d == 0 ? sg * 16 : 127 - sg * 16;
            const bf16_t* zp = Zg + (size_t)(t0 + tfirst) * DLRU + sc; bf16_t* op = Og + (size_t)(t0 + tfirst) * KOUT + sc;
            const int zstep = d == 0 ? DLRU : -DLRU, ostep = d == 0 ? KOUT : -KOUT;
#pragma unroll
            for (int k = 0; k < 16; ++k) { h = av[k] * h + bv[k];
                if (!isctx) { const float gz = bf2f(*zp); *op = f2bf(h * gz); zp += zstep; op += ostep; } }
        }
        if (sg == 7) HC[(par ^ 1) * 64 + sc] = h;
        par ^= 1;
        __syncthreads();
    }
}

#ifndef LRU_REPS
#define LRU_REPS 1
#endif
__device__ void phase_mixer(const Args& a, char* lds, int vb, int nb) {
#pragma unroll 1
    for (int it = vb; it < 256; it += nb) { for (int rep_ = 0; rep_ < LRU_REPS; ++rep_) { lru_item(a, lds, it >> 4, (it >> 1) & 7, it & 1); __syncthreads(); } }
#pragma unroll 1
    for (int at = vb; at < 1024; at += nb) { const int bk = at >> 5, w = at & 31; attn_item(a, lds, bk >> 1, (bk & 1) * 4 + (w >> 3), w & 7); __syncthreads(); }
}

__device__ void phase_outproj(const Args& a, char* lds, int vb, int nb) {
    const int tid = threadIdx.x, lane = tid & 63, wid = tid >> 6, wr = wid >> 2, wc = wid & 3, fr = lane & 15, fq = lane >> 4;
    const bf16_t* A2 = (const bf16_t*)(a.ws + WS_A2); const bf16_t* WO = (const bf16_t*)(a.ws + WS_WOUT);
    float* MIX = (float*)(a.ws + WS_MIX);
#pragma unroll 1
    for (int it = vb; it < 128 * 4; it += nb) {
        const int tt = it >> 2, ft = it & 3;
        f32x4 acc[2][2][4][2];
        g8::core(acc, WO, A2, ft * 256, tt * 256, KOUT, lds);
#pragma unroll
        for (int bj = 0; bj < 2; ++bj)
#pragma unroll
            for (int n = 0; n < 2; ++n) {
                float* rp = MIX + (size_t)(tt * 256 + bj * 128 + wc * 32 + n * 16 + fr) * DM + ft * 256 + wr * 64 + fq * 4;
#pragma unroll
                for (int ai = 0; ai < 2; ++ai)
#pragma unroll
                    for (int m = 0; m < 4; ++m) *(f32x4*)(rp + ai * 128 + m * 16) = acc[ai][bj][m][n];
            }
        __syncthreads();
    }
}

__device__ void phase_rowpass(const Args& a, int vb, int nb) {
    const int tid = threadIdx.x, lane = tid & 63, wid = tid >> 6;
    const float* mod = (const float*)(a.ws + WS_MOD);
    const float* MIX = (const float*)(a.ws + WS_MIX);
    bf16_t* HX = (bf16_t*)(a.ws + WS_HX2);
    for (int row = vb * 8 + wid; row < NTOK; row += nb * 8) {
        const int b = row >> 11;
        const float* mrow = mod + (size_t)b * 6144;
        f32x4 mv[4], xv[4]; float ss = 0.f;
#pragma unroll
        for (int i = 0; i < 4; ++i) { mv[i] = *(const f32x4*)(MIX + (size_t)row * DM + i * 256 + lane * 4); xv[i] = *(const f32x4*)(a.in[I_X] + (size_t)row * DM + i * 256 + lane * 4);
            ss += mv[i][0] * mv[i][0] + mv[i][1] * mv[i][1] + mv[i][2] * mv[i][2] + mv[i][3] * mv[i][3]; }
        ss = wave_sum(ss);
        const float rinv = rsqrtf(ss * (1.f / DM) + EPS);
        float s2 = 0.f;
#pragma unroll
        for (int i = 0; i < 4; ++i) { const int c = i * 256 + lane * 4;
            const f32x4 gp = *(const f32x4*)(a.in[I_GPOSTMIX] + c), g1 = *(const f32x4*)(mrow + 2048 + c);
#pragma unroll
            for (int j = 0; j < 4; ++j) { const float xm = xv[i][j] + g1[j] * (mv[i][j] * rinv * gp[j]); xv[i][j] = xm; s2 += xm * xm; }
            *(f32x4*)(a.out + (size_t)row * DM + c) = xv[i]; }
        s2 = wave_sum(s2);
        const float rinv2 = rsqrtf(s2 * (1.f / DM) + EPS);
#pragma unroll
        for (int i = 0; i < 4; ++i) { const int c = i * 256 + lane * 4;
            const f32x4 gf = *(const f32x4*)(a.in[I_GPREFFN] + c), sh = *(const f32x4*)(mrow + 3072 + c), sc = *(const f32x4*)(mrow + 4096 + c);
            float o[4];
#pragma unroll
            for (int j = 0; j < 4; ++j) o[j] = xv[i][j] * rinv2 * gf[j] * (1.f + sc[j]) + sh[j];
            u32x2 w = {pk2(o[0], o[1]), pk2(o[2], o[3])}; *(u32x2*)(HX + (size_t)row * DM + c) = w; }
    }
}

__device__ __forceinline__ int fkey(float f) { const int b = __float_as_int(f); return b ^ ((b >> 31) & 0x7fffffff); }
__device__ __forceinline__ float fval(int k) { return __int_as_float(k ^ ((k >> 31) & 0x7fffffff)); }
#define CE_DESC(x, y) do { const int hi_ = max((x), (y)), lo_ = min((x), (y)); (x) = hi_; (y) = lo_; } while (0)
__device__ __forceinline__ void sort16_desc(int (&v)[16]) {
#pragma unroll
    for (int k = 2; k <= 16; k <<= 1)
#pragma unroll
        for (int j = k >> 1; j > 0; j >>= 1)
#pragma unroll
            for (int i = 0; i < 16; ++i) { const int l = i ^ j; if (l > i) { if ((i & k) == 0) { CE_DESC(v[i], v[l]); } else { CE_DESC(v[l], v[i]); } } }
}
__device__ __forceinline__ void merge16_desc(int (&v)[16]) {
#pragma unroll
    for (int j = 8; j > 0; j >>= 1)
#pragma unroll
        for (int i = 0; i < 16; ++i) { const int l = i ^ j; if (l > i) CE_DESC(v[i], v[l]); }
}
__device__ __forceinline__ void top16_merge(int (&A)[16], const int (&B)[16]) {
#pragma unroll
    for (int i = 0; i < 16; ++i) A[i] = max(A[i], B[15 - i]);
    merge16_desc(A);
}
constexpr int PK_QS = 0;
constexpr int PK_SK = 256 * E_PITCH;
constexpr int PK_ML = PK_SK + 128 * E_PITCH;
constexpr int PK_X  = PK_ML + 32768;
constexpr int PK_END = PK_X + 8192;
static_assert(PK_ML >= G_LDS, "the merged lists must lie past the GEMM stages");
__device__ void phase_peer_topk(const Args& a, char* lds, int vb, int nb) {
    unsigned char* ws = a.ws;
    const bf16_t* HX = (const bf16_t*)(ws + WS_HX2); const bf16_t* WQ = (const bf16_t*)(ws + WS_WQ); const bf16_t* SUBK = (const bf16_t*)(ws + WS_SUBK);
    int* IDX = (int*)(ws + WS_IDX);
    int* ML = (int*)(lds + PK_ML); int* XB = (int*)(lds + PK_X);
    for (int it = vb; it < 128 * 8; it += nb) {
        const int rt = it >> 3, h = it & 7, row0 = rt * 256;
        bf16_t* park = (bf16_t*)(ws + WS_MIX) + (size_t)it * (256 * 128);
        int tid = threadIdx.x;
        {
            f32x4 acc8[2][2][4][2];
            g8::core(acc8, WQ, HX, h * 256, row0, DM, lds);
            __syncthreads();
            asm volatile("" : "+v"(tid));
            const int lane = tid & 63, wid = tid >> 6;
            const int w8r = wid >> 2, w8c = wid & 3, fr = lane & 15, fq = lane >> 4;
#pragma unroll
            for (int bj = 0; bj < 2; ++bj)
#pragma unroll
                for (int m = 0; m < 4; ++m)
#pragma unroll
                    for (int n = 0; n < 2; ++n) { const int tok = bj * 128 + w8c * 32 + n * 16 + fr, d = w8r * 64 + m * 16 + fq * 4;
                        const f32x4 v0 = acc8[0][bj][m][n], v1 = acc8[1][bj][m][n];
                        *(u32x2*)(lds + PK_QS + tok * E_PITCH + d * 2) = (u32x2){pk2(v0[0], v0[1]), pk2(v0[2], v0[3])};
                        *(u32x2*)(park + tok * 128 + d) = (u32x2){pk2(v1[0], v1[1]), pk2(v1[2], v1[3])}; }
        }
        const int lane = tid & 63, wid = tid >> 6, wm = wid & 3, wn = wid >> 2, r32 = lane & 31, hi = lane >> 5;
#pragma unroll 1
        for (int p = 0; p < 2; ++p) {
            f32x16 acc[2][2];
            if (p == 1) {
#pragma unroll
                for (int i = 0; i < 8; ++i) { const int c = tid + NTHR * i, tok = c >> 4, ch = c & 15; *(u32x4*)(lds + PK_QS + tok * E_PITCH + ch * 16) = *(const u32x4*)(park + tok * 128 + ch * 8); }
            }
            {
                const bf16_t* sk = SUBK + (size_t)(h * 2 + p) * 128 * 128;
#pragma unroll
                for (int i = 0; i < 4; ++i) { const int c = tid + NTHR * i, r = c >> 4, ch = c & 15; *(u32x4*)(lds + PK_SK + r * E_PITCH + ch * 16) = *(const u32x4*)(sk + r * 128 + ch * 8); }
            }
            __syncthreads();
#pragma unroll
            for (int ft = 0; ft < 2; ++ft)
#pragma unroll
                for (int tt = 0; tt < 2; ++tt)
#pragma unroll
                    for (int r = 0; r < 16; ++r) acc[ft][tt][r] = 0.f;
#pragma unroll
            for (int ks = 0; ks < 8; ++ks) {
                const bf16x8 a0 = *(const bf16x8*)(lds + PK_SK + (wn * 64 + r32) * E_PITCH + (ks * 16 + hi * 8) * 2), a1 = *(const bf16x8*)(lds + PK_SK + (wn * 64 + 32 + r32) * E_PITCH + (ks * 16 + hi * 8) * 2);
                const bf16x8 b0 = *(const bf16x8*)(lds + PK_QS + (wm * 64 + r32) * E_PITCH + (ks * 16 + hi * 8) * 2), b1 = *(const bf16x8*)(lds + PK_QS + (wm * 64 + 32 + r32) * E_PITCH + (ks * 16 + hi * 8) * 2);
                acc[0][0] = MFMA(a0, b0, acc[0][0]); acc[0][1] = MFMA(a0, b1, acc[0][1]);
                acc[1][0] = MFMA(a1, b0, acc[1][0]); acc[1][1] = MFMA(a1, b1, acc[1][1]);
            }
#pragma unroll
            for (int tt = 0; tt < 2; ++tt) {
                int A[16], B[16];
#pragma unroll
                for (int r = 0; r < 16; ++r) { const int key = wn * 64 + 8 * (r >> 2) + 4 * hi + (r & 3);
                    A[r] = (fkey(acc[0][tt][r]) & ~127) | key; B[r] = (fkey(acc[1][tt][r]) & ~127) | (key + 32); }
                sort16_desc(A); sort16_desc(B); top16_merge(A, B);
#pragma unroll
                for (int r = 0; r < 16; ++r) { auto rr = __builtin_amdgcn_permlane32_swap((unsigned)A[r], (unsigned)A[r], false, false); B[r] = (int)(hi ? rr[0] : rr[1]); }
                top16_merge(A, B);
                const int tok = wm * 64 + tt * 32 + r32;
                if (wn == 1 && hi == 0) {
#pragma unroll
                    for (int r = 0; r < 16; ++r) XB[(wm * 32 + r32) * 16 + r] = A[r];
                }
                __syncthreads();
                if (wn == 0 && hi == 0) {
#pragma unroll
                    for (int r = 0; r < 16; ++r) B[r] = XB[(wm * 32 + r32) * 16 + r];
                    top16_merge(A, B);
#pragma unroll
                    for (int r = 0; r < 16; ++r) ML[(tok * 2 + p) * 16 + r] = A[r];
                }
                __syncthreads();
            }
        }
        if (tid < 256) {
            const int tok = tid;
            int s1[16], s2[16];
#pragma unroll
            for (int r = 0; r < 16; ++r) { s1[r] = ML[(tok * 2 + 0) * 16 + r]; s2[r] = ML[(tok * 2 + 1) * 16 + r]; }
            float f1[16], f2[16];
#pragma unroll
            for (int r = 0; r < 16; ++r) { f1[r] = fval(s1[r] & ~127); f2[r] = fval(s2[r] & ~127); }
            int G0[16], G1[16], G2[16], G3[16];
#pragma unroll
            for (int bb = 0; bb < 16; ++bb) G0[bb] = (fkey(f1[0] + f2[bb]) & ~255) | (0 * 16 + bb);
#pragma unroll
            for (int bb = 0; bb < 8; ++bb) G1[bb] = (fkey(f1[1] + f2[bb]) & ~255) | (1 * 16 + bb);
#pragma unroll
            for (int bb = 0; bb < 5; ++bb) G1[8 + bb] = (fkey(f1[2] + f2[bb]) & ~255) | (2 * 16 + bb);
#pragma unroll
            for (int bb = 0; bb < 3; ++bb) G1[13 + bb] = (fkey(f1[3] + f2[bb]) & ~255) | (3 * 16 + bb);
            G2[0] = (fkey(f1[3] + f2[3]) & ~255) | (3 * 16 + 3);
#pragma unroll
            for (int bb = 0; bb < 3; ++bb) G2[1 + bb] = (fkey(f1[4] + f2[bb]) & ~255) | (4 * 16 + bb);
#pragma unroll
            for (int aa = 5; aa < 8; ++aa)
#pragma unroll
                for (int bb = 0; bb < 2; ++bb) G2[4 + (aa - 5) * 2 + bb] = (fkey(f1[aa] + f2[bb]) & ~255) | (aa * 16 + bb);
#pragma unroll
            for (int aa = 8; aa < 14; ++aa) G2[10 + (aa - 8)] = (fkey(f1[aa] + f2[0]) & ~255) | (aa * 16);
            G3[0] = (fkey(f1[14] + f2[0]) & ~255) | (14 * 16); G3[1] = (fkey(f1[15] + f2[0]) & ~255) | (15 * 16);
#pragma unroll
            for (int r = 2; r < 16; ++r) G3[r] = (int)0x80000000;
            sort16_desc(G0); sort16_desc(G1); sort16_desc(G2); sort16_desc(G3);
            top16_merge(G0, G1); top16_merge(G2, G3); top16_merge(G0, G2);
            float tv[16]; float mx = fval(G0[0] & ~255), sum = 0.f;
#pragma unroll
            for (int r = 0; r < 16; ++r) { tv[r] = __expf(fval(G0[r] & ~255) - mx); sum += tv[r]; }
            const float rs = 1.f / sum;
            const size_t ob = ((size_t)(row0 + tok) * 8 + h) * 16;
#pragma unroll
            for (int r = 0; r < 16; ++r) { const int code = G0[r] & 255, aa = code >> 4, bb = code & 15;
                const int i1 = ML[(tok * 2 + 0) * 16 + aa] & 127, i2 = ML[(tok * 2 + 1) * 16 + bb] & 127;
                IDX[ob + r] = (i1 * 128 + i2) | (int)((unsigned)f2bf(tv[r] * rs) << 16); }
        }
        __syncthreads();
    }
}

constexpr int P7_RSHIFT = 8;
constexpr int P7_ROUNDS = PEER_N >> P7_RSHIFT;
template <int CTRL> __device__ __forceinline__ float dpp_add(float v) { return v + __uint_as_float(__builtin_amdgcn_update_dpp(0u, __float_as_uint(v), CTRL, 0xf, 0xf, true)); }
__device__ __forceinline__ float wave_sum_bcast(float p) {
    p = dpp_add<0xB1>(p); p = dpp_add<0x4E>(p); p = dpp_add<0x141>(p); p = dpp_add<0x140>(p);
    const unsigned u = __float_as_uint(p);
    return (__uint_as_float(__builtin_amdgcn_readlane(u, 0)) + __uint_as_float(__builtin_amdgcn_readlane(u, 16))) + (__uint_as_float(__builtin_amdgcn_readlane(u, 32)) + __uint_as_float(__builtin_amdgcn_readlane(u, 48)));
}
__device__ __forceinline__ float dot16(const u32x4 a0, const u32x4 a1, const u32x4 b0, const u32x4 b1) {
    float acc = 0.f;
#pragma unroll
    for (int i = 0; i < 4; ++i) { acc = __builtin_amdgcn_fdot2_f32_bf16(as_bf2(a0[i]), as_bf2(b0[i]), acc, false); acc = __builtin_amdgcn_fdot2_f32_bf16(as_bf2(a1[i]), as_bf2(b1[i]), acc, false); }
    return acc;
}
typedef float f32x4v __attribute__((ext_vector_type(4)));
constexpr int P7_RS = 9;
constexpr int P7_NR = PEER_N >> P7_RS;
constexpr int P7_HTP = 1024 + 64;
constexpr float H_SCALE = 16.f;
constexpr int P7_WLDS = 4 * P7_HTP + 2048 + 8192 + 2048 + 2048;
__device__ void phase_peer_gather(const Args& a, char* lds, int vb, int nb) {
    const int tid = threadIdx.x, lane = tid & 63, wid = tid >> 6, r16 = lane & 15, kg = lane >> 4;
    unsigned char* ws = a.ws;
    const bf16_t* HX = (const bf16_t*)(ws + WS_HX2);
    const int* IDX = (const int*)(ws + WS_IDX);
    const float* mod = (const float*)(ws + WS_MOD);
    const unsigned char* UT = ws + WS_UT; const unsigned char* VT = ws + WS_VT;
    char* HT = lds + wid * P7_WLDS; unsigned* LIST = (unsigned*)(HT + 4 * P7_HTP); char* AT = HT + 4 * P7_HTP + 2048; char* ST = AT + 8192; float* WL = (float*)(ST + 2048);
#pragma unroll 1
    for (int tb = vb * 32; tb < NTOK; tb += nb * 32) {
        const int tok0 = tb + wid * 4;
        {
            int* HIST = (int*)HT; int* CUR = HIST + 128;
            int ee[8];
            const int* ip = IDX + (size_t)tok0 * 128 + lane;
#pragma unroll
            for (int k = 0; k < 4; ++k) { ee[2 * k] = ip[k * 128]; ee[2 * k + 1] = ip[k * 128 + 64]; }
            HIST[lane] = 0; HIST[64 + lane] = 0;
#pragma unroll
            for (int j = 0; j < 8; ++j) atomicAdd(&HIST[(((ee[j] >> P7_RS) & (P7_NR - 1)) << 2) | (j >> 1)], 1);
            const int c0 = HIST[2 * lane], c1 = HIST[2 * lane + 1];
            int inc = c0 + c1;
#pragma unroll
            for (int o = 1; o < 64; o <<= 1) { const int t = __shfl_up(inc, o); if (lane >= o) inc += t; }
            CUR[2 * lane] = inc - c0 - c1; CUR[2 * lane + 1] = inc - c1;
#pragma unroll
            for (int j = 0; j < 8; ++j) { const unsigned w = (unsigned)ee[j]; const int slot = atomicAdd(&CUR[(((w >> P7_RS) & (P7_NR - 1)) << 2) | (j >> 1)], 1);
                LIST[slot] = (w & 16383u) | ((unsigned)(j >> 1) << 14) | ((w >> 16) << 17); }
        }
        {
            const bf16_t* hp = HX + (size_t)tok0 * DM + lane * 16;
#pragma unroll
            for (int k = 0; k < 4; ++k) { const u32x4 h0 = *(const u32x4*)(hp + k * DM), h1 = *(const u32x4*)(hp + k * DM + 8);
                u32x4 o;
#pragma unroll
                for (int q = 0; q < 4; ++q) { const unsigned wa = q < 2 ? h0[2 * q] : h1[2 * q - 4], wb = q < 2 ? h0[2 * q + 1] : h1[2 * q - 3];
                    int w = __builtin_amdgcn_cvt_pk_fp8_f32(bflo(wa) * H_SCALE, bfhi(wa) * H_SCALE, 0, false); w = __builtin_amdgcn_cvt_pk_fp8_f32(bflo(wb) * H_SCALE, bfhi(wb) * H_SCALE, w, true); o[q] = (unsigned)w; }
                *(u32x4*)(HT + k * P7_HTP + lane * 16) = o;
                *(u32x4*)(AT + k * 2048 + lane * 32) = (u32x4){0u, 0u, 0u, 0u}; *(u32x4*)(AT + k * 2048 + lane * 32 + 16) = (u32x4){0u, 0u, 0u, 0u}; }
        }
        const char* hb0 = HT + (lane & 3) * P7_HTP + kg * 8;
        const int wlo = (lane >> 3) * 128 + (((lane & 7) ^ ((lane >> 4) & 7)) << 4), whi = (8 + (lane >> 3)) * 128 + (((lane & 7) ^ (4 + ((lane >> 4) & 3))) << 4);
        const int aoffs = r16 * 128 + (kg & 1) * 8, asw = (r16 >> 1) & 7;
        {
            unsigned entv = LIST[r16];
            u32x4 ua[8], uc[8];
            {
                const unsigned e_lo = (unsigned)__shfl((int)entv, lane >> 3) & 16383u, e_hi = (unsigned)__shfl((int)entv, 8 + (lane >> 3)) & 16383u;
                const unsigned char* ul = UT + (size_t)e_lo * DM + (lane & 7) * 16; const unsigned char* uh = UT + (size_t)e_hi * DM + (lane & 7) * 16;
#pragma unroll
                for (int kc = 0; kc < 8; ++kc) { ua[kc] = *(const u32x4*)(ul + kc * 128); uc[kc] = *(const u32x4*)(uh + kc * 128); }
            }
#pragma unroll 1
            for (int bi = 0; bi < 32; ++bi) {
                const unsigned entn = LIST[(bi < 31 ? bi + 1 : 31) * 16 + r16];
                const unsigned n_lo = (unsigned)__shfl((int)entn, lane >> 3) & 16383u, n_hi = (unsigned)__shfl((int)entn, 8 + (lane >> 3)) & 16383u;
                const unsigned char* ul = UT + (size_t)n_lo * DM + (lane & 7) * 16; const unsigned char* uh = UT + (size_t)n_hi * DM + (lane & 7) * 16;
                f32x4v D = {0.f, 0.f, 0.f, 0.f};
#pragma unroll
                for (int kc = 0; kc < 8; ++kc) {
                    *(u32x4*)(ST + wlo) = ua[kc]; *(u32x4*)(ST + whi) = uc[kc];
                    ua[kc] = *(const u32x4*)(ul + kc * 128); uc[kc] = *(const u32x4*)(uh + kc * 128);
#pragma unroll
                    for (int t = 0; t < 4; ++t) {
                        const int ci = 2 * t + (kg >> 1);
                        const long a0 = *(const long*)(ST + aoffs + ((ci ^ asw) << 4));
                        const long b0 = *(const long*)(hb0 + kc * 128 + t * 32);
                        D = __builtin_amdgcn_mfma_f32_16x16x32_fp8_fp8(a0, b0, D, 0, 0, 0);
                    }
                }
                float dsel = 0.f; unsigned esel = 0u;
#pragma unroll
                for (int i = 0; i < 4; ++i) {
                    const unsigned er = (unsigned)__shfl((int)entv, 4 * kg + i);
                    float m = (((er >> 14) & 3u) == (unsigned)(lane & 3)) ? D[i] : 0.f;
                    m = dpp_add<0xB1>(m); m = dpp_add<0x4E>(m);
                    const bool pick = (lane & 3) == i; dsel = pick ? m : dsel; esel = pick ? er : esel;
                }
                if ((lane & 12) == 0) WL[bi * 16 + 4 * kg + (lane & 3)] = __uint_as_float((esel >> 17) << 16) * gelu_tanh(dsel * (1.f / (T_SCALE * H_SCALE)));
                entv = entn;
            }
        }
        u32x4 c0 = {0u, 0u, 0u, 0u}, c1 = {0u, 0u, 0u, 0u}; unsigned cur = 0u;
        {
            unsigned entv = LIST[r16]; float wv = WL[r16];
            u32x4 vbuf[16];
#pragma unroll
            for (int b = 0; b < 16; ++b) vbuf[b] = *(const u32x4*)(VT + (size_t)((unsigned)__builtin_amdgcn_readlane((int)entv, b) & 16383u) * DM + lane * 16);
#pragma unroll 1
            for (int bi = 0; bi < 32; ++bi) {
                const int bn = (bi < 31 ? bi + 1 : 31);
                const unsigned entn = LIST[bn * 16 + r16]; const float wn_ = WL[bn * 16 + r16];
#pragma unroll
                for (int b = 0; b < 16; ++b) {
                    const unsigned eb_ = (unsigned)__builtin_amdgcn_readlane((int)entv, b);
                    const float w_ = __uint_as_float(__builtin_amdgcn_readlane(__float_as_uint(wv), b));
                    const h16x2 w2 = as_h2(pkh2(w_, w_)); const unsigned tk = (eb_ >> 14) & 3u;
                    if (tk != cur) { char* apo = AT + cur * 2048 + lane * 32; *(u32x4*)apo = c0; *(u32x4*)(apo + 16) = c1;
                        const char* apn = AT + tk * 2048 + lane * 32; c0 = *(const u32x4*)apn; c1 = *(const u32x4*)(apn + 16); cur = tk; }
#pragma unroll
                    for (int q_ = 0; q_ < 4; ++q_) { const unsigned vw_ = vbuf[b][q_];
                        const h16x2 lo = __builtin_amdgcn_cvt_scalef32_pk_f16_fp8(vw_, V_SCALE / T_SCALE, false), hi2 = __builtin_amdgcn_cvt_scalef32_pk_f16_fp8(vw_, V_SCALE / T_SCALE, true);
                        if (q_ < 2) { c0[2 * q_] = __builtin_bit_cast(unsigned, __builtin_elementwise_fma(lo, w2, as_h2(c0[2 * q_]))); c0[2 * q_ + 1] = __builtin_bit_cast(unsigned, __builtin_elementwise_fma(hi2, w2, as_h2(c0[2 * q_ + 1]))); }
                        else { c1[2 * q_ - 4] = __builtin_bit_cast(unsigned, __builtin_elementwise_fma(lo, w2, as_h2(c1[2 * q_ - 4]))); c1[2 * q_ - 3] = __builtin_bit_cast(unsigned, __builtin_elementwise_fma(hi2, w2, as_h2(c1[2 * q_ - 3]))); } }
                    vbuf[b] = *(const u32x4*)(VT + (size_t)((unsigned)__builtin_amdgcn_readlane((int)entn, b) & 16383u) * DM + lane * 16);
                }
                entv = entn; wv = wn_;
            }
        }
        { char* apo = AT + cur * 2048 + lane * 32; *(u32x4*)apo = c0; *(u32x4*)(apo + 16) = c1; }
#pragma unroll
        for (int k = 0; k < 4; ++k) {
            const int tok = tok0 + k;
            float f[16]; float ss = 0.f;
            const u32x4 e0 = *(const u32x4*)(AT + k * 2048 + lane * 32), e1 = *(const u32x4*)(AT + k * 2048 + lane * 32 + 16);
#pragma unroll
            for (int i = 0; i < 8; ++i) { const unsigned cw = i < 4 ? e0[i] : e1[i - 4]; const h16x2 hv = as_h2(cw);
                f[2 * i] = (float)hv[0] * (1.f / V_SCALE); f[2 * i + 1] = (float)hv[1] * (1.f / V_SCALE); ss += f[2 * i] * f[2 * i] + f[2 * i + 1] * f[2 * i + 1]; }
            ss = wave_sum_bcast(ss);
            const float rinv = rsqrtf(ss * (1.f / DM) + EPS);
            const float* g2 = mod + (size_t)(tok >> 11) * 6144 + 5120;
#pragma unroll
            for (int q4 = 0; q4 < 4; ++q4) {
                const int c = lane * 16 + q4 * 4;
                float* op = a.out + (size_t)tok * DM + c;
                const f32x4 xm = *(const f32x4*)op, g2v = *(const f32x4*)(g2 + c), gp = *(const f32x4*)(a.in[I_GPOSTFFN] + c);
                f32x4 o;
#pragma unroll
                for (int jj = 0; jj < 4; ++jj) o[jj] = xm[jj] + g2v[jj] * (f[q4 * 4 + jj] * rinv * gp[jj]);
                *(f32x4*)op = o; }
        }
    }
}

#ifdef DBG_DIGEST
__device__ void phase_digest(const Args& a, int vb, int nb) {
    const bf16_t* A2 = (const bf16_t*)(a.ws + WS_A2);
    const bf16_t* Q = (const bf16_t*)(a.ws + WS_Q); const bf16_t* K = (const bf16_t*)(a.ws + WS_K); const bf16_t* VV = (const bf16_t*)(a.ws + WS_VV);
    const bf16_t* L = (const bf16_t*)(a.ws + WS_L); const bf16_t* ZG = (const bf16_t*)(a.ws + WS_ZG);
    for (size_t e = (size_t)vb * NTHR + threadIdx.x; e < (size_t)NTOK * DM; e += (size_t)nb * NTHR) {
        float v = 0.f;
#if DBG_DIGEST == 3
        const size_t row = e >> 10; const int c = (int)(e & 1023);
        v = bf2f(A2[row * KOUT + c]); if (c < 512) v += bf2f(A2[row * KOUT + 1024 + c]);
#elif DBG_DIGEST == 2
        const size_t h = e % ((size_t)NTOK * 512);
        v = bf2f(Q[h]) + bf2f(ZG[h]) + bf2f(L[e % ((size_t)NB * STOT * 512)]);
        if (e < (size_t)NB * 2 * STOT * 64) v += bf2f(K[e]) + bf2f(VV[e]);
#endif
        a.out[e] = v; }
}
#endif
constexpr int LDS_BYTES = 155648;
constexpr int LDS_BARST = LDS_BYTES - 16;
static_assert(8 * P7_WLDS <= LDS_BARST && PK_END <= LDS_BARST && LR_END <= LDS_BARST && 3 * G_STAGE <= LDS_BARST && g8::SHM_B <= LDS_BARST && 17 * 1024 * 4 + 17 * 24 * 4 <= LDS_BARST, "LDS budget");
constexpr int N_PHASES = 8;

__global__ void __launch_bounds__(NTHR, 2) mk_fwd(Args a) {
    extern __shared__ __attribute__((aligned(16))) char lds[];
    const int nb = gridDim.x, bx = blockIdx.x;
    const int vb0 = (nb % 8 == 0) ? (bx % 8) * (nb / 8) + bx / 8 : bx;
    XcdBarrier bar; bar.bar = (unsigned*)(a.ws + WS_CTL); bar.x = 0; bar.st = (volatile LAS unsigned*)(LAS char*)(lds + LDS_BARST);
    const bool multi = (a.ph_hi - a.ph_lo) > 1;
    if (multi) {
        if (threadIdx.x < 4) ((volatile LAS unsigned*)(LAS char*)(lds + LDS_BARST))[threadIdx.x] = 0u;
        __syncthreads();
        bar = xcd_barrier_post((unsigned*)(a.ws + WS_CTL), (volatile LAS unsigned*)(LAS char*)(lds + LDS_BARST));
    }
#ifndef P7_PROBE
#define P7_PROBE -1
#endif
#ifndef DBL_PHASE
#define DBL_PHASE 0
#endif
#if DBL_PHASE != 0
#define RUN_PHASE(P, CALL) do { if (a.ph_lo <= (P) && (P) < a.ph_hi) { const int nrep_ = ((a.dbl >> (P)) & 1) ? 2 : 1; for (int rep_ = 0; rep_ < nrep_; ++rep_) { CALL; if ((P) + 1 < a.ph_hi || rep_ + 1 < nrep_) xcd_barrier(bar); } } } while (0)
#else
#define RUN_PHASE(P, CALL) do { if (a.ph_lo <= (P) && (P) < a.ph_hi) { CALL; if ((P) + 1 < a.ph_hi) xcd_barrier(bar); } } while (0)
#endif
#if !defined(ONLY_PHASE) || ONLY_PHASE == 0
    RUN_PHASE(0, phase_prep(a, lds, vb0, nb));
#endif
    int vb = vb0;
    if (multi && a.ph_lo == 0 && a.ph_hi > 1) {
        if (threadIdx.x == 0) { unsigned off = 0; for (unsigned j = 0; j < bar.x; ++j) off += xb_ld(&bar.bar[XB_XCNT(j)]); bar.st[3] = off + bar.st[2]; }
        __syncthreads();
        vb = (int)bar.st[3];
    }
#if !defined(ONLY_PHASE) || ONLY_PHASE == 1
    RUN_PHASE(1, phase_xn(a, vb, nb));
#endif
#if !defined(ONLY_PHASE) || ONLY_PHASE == 2
    RUN_PHASE(2, phase_inproj(a, lds, vb, nb));
#endif
#if (!defined(ONLY_PHASE) || ONLY_PHASE == 3) && !(defined(DBG_DIGEST) && DBG_DIGEST == 2)
    RUN_PHASE(3, phase_mixer(a, lds, vb, nb));
#endif
#ifdef DBG_DIGEST
    if (a.ph_lo <= 4 && 4 < a.ph_hi) phase_digest(a, vb, nb);
    return;
#endif
#if !defined(ONLY_PHASE) || ONLY_PHASE == 4
    RUN_PHASE(4, phase_outproj(a, lds, vb, nb));
#endif
#if !defined(ONLY_PHASE) || ONLY_PHASE == 5
    RUN_PHASE(5, phase_rowpass(a, vb, nb));
#endif
#if !defined(ONLY_PHASE) || ONLY_PHASE == 6
    RUN_PHASE(6, phase_peer_topk(a, lds, vb, nb));
#endif
#if !defined(ONLY_PHASE) || ONLY_PHASE == 7
    RUN_PHASE(7, phase_peer_gather(a, lds, vb, nb));
#endif
}

extern "C" void kernel_launch(void* const* d_in, const int* in_sizes, int n_in, void* d_out, int out_size, void* d_ws, size_t ws_size, hipStream_t stream) {
    static int grid = 0;
    if (grid == 0) {
        if (n_in != 25 || out_size != NTOK * DM || ws_size < WS_END) { fprintf(stderr, "kernel_launch: unexpected shapes (n_in %d, out %d, ws %zu, need %zu)\n", n_in, out_size, ws_size, (size_t)WS_END); grid = -1; return; }
        int dev = 0, cus = 0;
        if (hipGetDevice(&dev) != hipSuccess || hipDeviceGetAttribute(&cus, hipDeviceAttributeMultiprocessorCount, dev) != hipSuccess) { grid = -1; return; }
        if (hipFuncSetAttribute((const void*)mk_fwd, hipFuncAttributeMaxDynamicSharedMemorySize, LDS_BYTES) != hipSuccess) { fprintf(stderr, "kernel_launch: hipFuncSetAttribute failed\n"); grid = -1; return; }
        (void)hipGetLastError();
        grid = cus;
    }
    if (grid < 0) return;
    (void)hipMemsetAsync((char*)d_ws + WS_CTL, 0, CTL_BYTES, stream);
    Args a{};
    for (int i = 0; i < 25; ++i) a.in[i] = (const float*)d_in[i];
    a.out = (float*)d_out; a.ws = (unsigned char*)d_ws; a.dbl = DBL_PHASE; a.probe = P7_PROBE;
#if MK_N_LAUNCHES == 1
    a.ph_lo = 0; a.ph_hi = N_PHASES;
    hipLaunchKernelGGL(mk_fwd, dim3(grid), dim3(NTHR), LDS_BYTES, stream, a);
#else
    for (int ph = 0; ph < N_PHASES; ++ph) { a.ph_lo = ph; a.ph_hi = ph + 1; hipLaunchKernelGGL(mk_fwd, dim3(grid), dim3(NTHR), LDS_BYTES, stream, a); }
#endif
}
```

```cpp
#include <hip/hip_runtime.h>
#include <cstdio>
#include <cstdint>

#ifndef MK_N_LAUNCHES
#define MK_N_LAUNCHES 1
#endif

typedef unsigned short bf16_t;
typedef short bf16x8 __attribute__((ext_vector_type(8)));
typedef float f32x16 __attribute__((ext_vector_type(16)));
typedef float f32x4 __attribute__((ext_vector_type(4)));
typedef float f32x2 __attribute__((ext_vector_type(2)));
typedef unsigned u32x4 __attribute__((ext_vector_type(4)));
typedef unsigned u32x2 __attribute__((ext_vector_type(2)));
#define LAS __attribute__((address_space(3)))

constexpr int DM = 1024, NB = 16, SEQ = 2048, CTX = 256, STOT = SEQ + CTX;
constexpr int NTOK = NB * SEQ;
constexpr int NCTX = NB * CTX;
constexpr int NROWS = NTOK + NCTX;
constexpr int DIN = 1792, DLRU = 512;
constexpr int KOUT = 1536;
constexpr int PEER_N = 16384;
constexpr float EPS = 1e-6f;
constexpr int NTHR = 512;

constexpr size_t al256(size_t x) { return (x + 255) & ~(size_t)255; }
constexpr size_t WS_CTL   = 0;
constexpr size_t CTL_BYTES = 65536;
constexpr size_t WS_MOD   = WS_CTL + CTL_BYTES;
constexpr size_t WS_ROPE  = WS_MOD + al256(17 * 6144 * 4);
constexpr size_t WS_WIN   = WS_ROPE + al256(64 * 16 * 2 * 4);
constexpr size_t WS_WOUT  = WS_WIN + al256((size_t)DIN * DM * 2);
constexpr size_t WS_WQ    = WS_WOUT + al256((size_t)DM * KOUT * 2);
constexpr size_t WS_SUBK  = WS_WQ + al256((size_t)2048 * DM * 2);
constexpr size_t WS_RGW   = WS_SUBK + al256((size_t)8 * 2 * 128 * 128 * 2);
constexpr size_t WS_UT    = WS_RGW + al256((size_t)2 * 8 * 128 * 64 * 2);
constexpr size_t WS_VT    = WS_UT + al256((size_t)PEER_N * DM * 2);
constexpr size_t WS_XN    = WS_VT + al256((size_t)PEER_N * DM * 2);
constexpr size_t WS_Q     = WS_XN + al256((size_t)NROWS * DM * 2);
constexpr size_t WS_K     = WS_Q + al256((size_t)NTOK * 512 * 2);
constexpr size_t WS_VV    = WS_K + al256((size_t)NB * 2 * STOT * 64 * 2);
constexpr size_t WS_L     = WS_VV + al256((size_t)NB * 2 * STOT * 64 * 2);
constexpr size_t WS_ZG    = WS_L + al256((size_t)NB * STOT * DLRU * 2);
constexpr size_t WS_A2    = WS_ZG + al256((size_t)NTOK * DLRU * 2);
constexpr size_t WS_END   = WS_A2 + al256((size_t)NTOK * KOUT * 2);
constexpr size_t WS_MIX   = WS_XN;
constexpr size_t WS_HX2   = WS_A2;
constexpr size_t WS_IDX   = WS_ZG;
constexpr size_t WS_GATE  = WS_ZG + (size_t)NTOK * 128 * 4;
static_assert(WS_MIX + (size_t)NTOK * DM * 4 <= WS_ZG, "MIX overlay must end before ZG");
static_assert(WS_GATE + (size_t)NTOK * 128 * 4 <= WS_A2, "IDX/GATE overlay must end before A2");

typedef __bf16 bf16x2_t __attribute__((ext_vector_type(2)));
__device__ __forceinline__ unsigned pk2(float lo, float hi) { const f32x2 v = {lo, hi}; const bf16x2_t b = __builtin_convertvector(v, bf16x2_t); return __builtin_bit_cast(unsigned, b); }
typedef _Float16 h16x2 __attribute__((ext_vector_type(2)));
constexpr float V_SCALE = 64.f;
constexpr float T_SCALE = 256.f;
#ifndef P7_FP8
#define P7_FP8 1
#endif
__device__ __forceinline__ unsigned pkh2(float lo, float hi) { const h16x2 h = {(_Float16)lo, (_Float16)hi}; return __builtin_bit_cast(unsigned, h); }
__device__ __forceinline__ bf16x2_t as_bf2(unsigned x) { return __builtin_bit_cast(bf16x2_t, x); }
__device__ __forceinline__ h16x2 as_h2(unsigned x) { return __builtin_bit_cast(h16x2, x); }
__device__ __forceinline__ bf16_t f2bf(float f) { return (bf16_t)(pk2(f, 0.f) & 0xffffu); }
__device__ __forceinline__ float bf2f(unsigned h) { return __uint_as_float(h << 16); }
__device__ __forceinline__ float bflo(unsigned w) { return __uint_as_float(w << 16); }
__device__ __forceinline__ float bfhi(unsigned w) { return __uint_as_float(w & 0xffff0000u); }
__device__ __forceinline__ float sat8(float x) { return fminf(fmaxf(x, -448.f), 448.f); }
__device__ __forceinline__ float fast_rcp(float x) { return __builtin_amdgcn_rcpf(x); }
__device__ __forceinline__ float sigmoidf_(float x) { return fast_rcp(1.f + __expf(-x)); }
__device__ __forceinline__ float gelu_tanh(float x) { const float y = 0.7978845608028654f * (x + 0.044715f * x * x * x); return x * fast_rcp(1.f + __expf(-2.f * y)); }
__device__ __forceinline__ float silu_(float x) { return x * sigmoidf_(x); }
__device__ __forceinline__ float wave_sum(float v) {
#pragma unroll
    for (int o = 32; o > 0; o >>= 1) v += __shfl_xor(v, o);
    return v;
}
__device__ __forceinline__ float half_swap_max(float v) { auto rr = __builtin_amdgcn_permlane32_swap(__float_as_uint(v), __float_as_uint(v), false, false); return fmaxf(__uint_as_float(rr[0]), __uint_as_float(rr[1])); }
__device__ __forceinline__ float half_swap_sum(float v) { auto rr = __builtin_amdgcn_permlane32_swap(__float_as_uint(v), __float_as_uint(v), false, false); return __uint_as_float(rr[0]) + __uint_as_float(rr[1]); }
#define MFMA(a, b, c) __builtin_amdgcn_mfma_f32_32x32x16_bf16((a), (b), (c), 0, 0, 0)

#define XB_TMO      128
#define XB_XCNT(j)  (256  + 64 * (j))
#define XB_XSUB(j)  (1280 + 64 * (j))
#define XB_XGEN(j)  (2304 + 64 * (j))
#define XB_TOP      3328
#define XB_TOPGEN   3392
#define XCD_BAR_WORDS 3456
#define XB_SPIN_CAP (1u << 20)
__device__ __forceinline__ unsigned xb_ld(unsigned* p)              { return __hip_atomic_load(p, __ATOMIC_RELAXED, __HIP_MEMORY_SCOPE_AGENT); }
__device__ __forceinline__ unsigned xb_add(unsigned* p, unsigned v) { return __hip_atomic_fetch_add(p, v, __ATOMIC_RELAXED, __HIP_MEMORY_SCOPE_AGENT); }
__device__ __forceinline__ unsigned xb_xcc_id() { return (unsigned)__builtin_amdgcn_s_getreg((3 << 11) | 20) & 0xFu; }
#define XB_SPIN(cond, bar) do { unsigned _sp = 0; while (cond) { __builtin_amdgcn_s_sleep(1); \
    if ((++_sp & 255u) == 0u) { if (xb_ld(&(bar)[XB_TMO])) break; if (_sp > XB_SPIN_CAP) { atomicAdd(&(bar)[XB_TMO], 1u); break; } } } } while (0)
struct XcdBarrier { unsigned* bar; unsigned x; volatile LAS unsigned* st; };
__device__ __forceinline__ XcdBarrier xcd_barrier_post(unsigned* bar, volatile LAS unsigned* st) {
    XcdBarrier b; b.bar = bar; b.x = xb_xcc_id(); b.st = st;
    if (threadIdx.x == 0) st[2] = xb_add(&bar[XB_XCNT(b.x)], 1u);
    return b;
}
__device__ __forceinline__ void xcd_barrier_complete(unsigned* bar, unsigned x, unsigned& nloc, unsigned& nx) {
    const unsigned G = gridDim.x * gridDim.y * gridDim.z;
    unsigned sum, cnt, mine, sp = 0u;
    for (;;) {
        sum = 0u; cnt = 0u; mine = 0u;
#pragma unroll
        for (unsigned j = 0; j < 16; ++j) { const unsigned c = xb_ld(&bar[XB_XCNT(j)]); sum += c; cnt += (c > 0u) ? 1u : 0u; mine = (j == x) ? c : mine; }
        if (sum == G) break;
        __builtin_amdgcn_s_sleep(1);
        if ((++sp & 255u) == 0u) { if (xb_ld(&bar[XB_TMO])) break; if (sp > XB_SPIN_CAP) { atomicAdd(&bar[XB_TMO], 1u); break; } }
    }
    nloc = mine > 0u ? mine : 1u; nx = cnt > 0u ? cnt : 1u;
}
__device__ __forceinline__ void xcd_barrier(const XcdBarrier& b) {
    asm volatile("s_waitcnt vmcnt(0)" ::: "memory");
    __syncthreads();
    if (threadIdx.x == 0) {
        unsigned* bar = b.bar;
        __builtin_amdgcn_s_waitcnt(0);
        unsigned nloc = b.st[0], nx = b.st[1];
        if (nloc == 0u) { xcd_barrier_complete(bar, b.x, nloc, nx); b.st[0] = nloc; b.st[1] = nx; }
        const unsigned old = xb_add(&bar[XB_XSUB(b.x)], 1u);
        const unsigned gen = old / nloc;
        if (old + 1u == (gen + 1u) * nloc) {
            __builtin_amdgcn_fence(__ATOMIC_RELEASE, "agent");
            asm volatile("s_waitcnt vmcnt(0)" ::: "memory");
            const unsigned og = xb_add(&bar[XB_TOP], 1u);
            const unsigned tg = og / nx;
            if (og + 1u == (tg + 1u) * nx) xb_add(&bar[XB_TOPGEN], 1u);
            else XB_SPIN(xb_ld(&bar[XB_TOPGEN]) == tg, bar);
            __builtin_amdgcn_fence(__ATOMIC_ACQUIRE, "agent");
            xb_add(&bar[XB_XGEN(b.x)], 1u);
            asm volatile("s_waitcnt vmcnt(0)" ::: "memory");
        } else {
            XB_SPIN(xb_ld(&bar[XB_XGEN(b.x)]) == gen, bar);
            __builtin_amdgcn_fence(__ATOMIC_ACQUIRE, "agent");
            asm volatile("s_waitcnt vmcnt(0)" ::: "memory");
        }
    }
    __syncthreads();
}

struct Args { const float* in[25]; float* out; unsigned char* ws; int ph_lo, ph_hi, dbl, probe; };
enum { I_X = 0, I_C, I_CTX, I_CCTX, I_WMOD, I_BMOD, I_GPREMIX, I_GPOSTMIX, I_GPREFFN, I_GPOSTFFN, I_WIN, I_QNG, I_KNG, I_CONVW, I_CONVB,
       I_RGWA, I_RGBA, I_RGWI, I_RGBI, I_RGLAM, I_WOUT, I_PWQ, I_PSUBK, I_PU, I_PV };

__device__ __forceinline__ void tr_tile(const float* __restrict__ src, int lds_, int sr0, int sc0, bf16_t* __restrict__ dst, int ldd, int dr0, int dc0, float* T) {
    const int tid = threadIdx.x;
#pragma unroll
    for (int i = 0; i < 8; ++i) { const int e = tid + NTHR * i, r = e >> 6, c = e & 63; T[r * 65 + c] = src[(size_t)(sr0 + r) * lds_ + sc0 + c]; }
    __syncthreads();
#pragma unroll
    for (int i = 0; i < 8; ++i) { const int e = tid + NTHR * i, c = e >> 6, r = e & 63; dst[(size_t)(dr0 + c) * ldd + dc0 + r] = f2bf(T[r * 65 + c]); }
    __syncthreads();
}

__device__ void phase_prep(const Args& a, char* lds, int vb, int nb) {
    const int tid = threadIdx.x;
    unsigned char* ws = a.ws;
    float* S = (float*)lds;
    float* T = (float*)lds;
    constexpr int N_MOD = 256, N_TIN = 448, N_TOUT = 384, N_TWQ = 512, N_RGW = 32, N_SUBK = 16, N_UV = 512, N_MISC = 1;
    constexpr int O_TIN = N_MOD, O_TOUT = O_TIN + N_TIN, O_TWQ = O_TOUT + N_TOUT, O_RGW = O_TWQ + N_TWQ, O_SUBK = O_RGW + N_RGW, O_UV = O_SUBK + N_SUBK, O_MISC = O_UV + N_UV, N_ALL = O_MISC + N_MISC;
    for (int it = vb; it < N_ALL; it += nb) {
        if (it < O_TIN) {
            for (int e = tid; e < 17 * 1024; e += NTHR) { const int r = e >> 10, k = e & 1023; const float v = (r < 16) ? a.in[I_C][r * 1024 + k] : a.in[I_CCTX][k]; S[e] = silu_(v); }
            __syncthreads();
            const int n0 = it * 24;
            const int cc = tid % 6, kk = tid / 6;
            float acc[17][4];
#pragma unroll
            for (int r = 0; r < 17; ++r) { acc[r][0] = 0.f; acc[r][1] = 0.f; acc[r][2] = 0.f; acc[r][3] = 0.f; }
            if (tid < 510) {
                for (int k = kk; k < 1024; k += 85) {
                    const f32x4 w = *(const f32x4*)(a.in[I_WMOD] + (size_t)k * 6144 + n0 + cc * 4);
#pragma unroll
                    for (int r = 0; r < 17; ++r) { const float s = S[r * 1024 + k]; acc[r][0] += s * w[0]; acc[r][1] += s * w[1]; acc[r][2] += s * w[2]; acc[r][3] += s * w[3]; }
                }
            }
            __syncthreads();
            if (tid < 510) {
#pragma unroll
                for (int r = 0; r < 17; ++r) { f32x4 v = {acc[r][0], acc[r][1], acc[r][2], acc[r][3]}; *(f32x4*)(S + (kk * 17 + r) * 24 + cc * 4) = v; }
            }
            __syncthreads();
            float* mod = (float*)(ws + WS_MOD);
            for (int e = tid; e < 17 * 24; e += NTHR) { const int r = e / 24, j = e % 24; float sum = 0.f;
                for (int q = 0; q < 85; ++q) sum += S[(q * 17 + r) * 24 + j];
                mod[r * 6144 + n0 + j] = sum + a.in[I_BMOD][n0 + j]; }
            __syncthreads();
        } else if (it < O_TOUT) {
            const int t = it - O_TIN, kt = t / 28, nt = t % 28;
            tr_tile(a.in[I_WIN], DIN, kt * 64, nt * 64, (bf16_t*)(ws + WS_WIN), DM, nt * 64, kt * 64, T);
        } else if (it < O_TWQ) {
            const int t = it - O_TOUT, kt = t / 16, nt = t % 16;
            const int sk = (kt < 16) ? kt * 64 : (kt - 16) * 64 + 512;
            tr_tile(a.in[I_WOUT], DM, sk, nt * 64, (bf16_t*)(ws + WS_WOUT), KOUT, nt * 64, kt * 64, T);
        } else if (it < O_RGW) {
            const int t = it - O_TWQ, kt = t / 32, nt = t % 32;
            tr_tile(a.in[I_PWQ], 2048, kt * 64, nt * 64, (bf16_t*)(ws + WS_WQ), DM, nt * 64, kt * 64, T);
        } else if (it < O_SUBK) {
            const int t = it - O_RGW, g = t & 1, dn = t >> 1;
            const float* src = (g == 0 ? a.in[I_RGWA] : a.in[I_RGWI]) + (size_t)dn * 4096;
            tr_tile(src, 64, 0, 0, (bf16_t*)(ws + WS_RGW) + (size_t)dn * 128 * 64 + g * 64 * 64, 64, 0, 0, T);
        } else if (it < O_UV) {
            const int t = it - O_SUBK; const float* src = a.in[I_PSUBK] + (size_t)t * 16384; bf16_t* dst = (bf16_t*)(ws + WS_SUBK) + (size_t)t * 16384;
            for (int e = tid * 4; e < 16384; e += NTHR * 4) { const f32x4 v = *(const f32x4*)(src + e); u32x2 o = {pk2(v[0], v[1]), pk2(v[2], v[3])}; *(u32x2*)(dst + e) = o; }
        } else if (it < O_MISC) {
            const int t = it - O_UV; const bool isv = t >= 256; const int tt = t & 255;
            const float* src = (isv ? a.in[I_PV] : a.in[I_PU]) + (size_t)tt * 65536; bf16_t* dst = (bf16_t*)(ws + (isv ? WS_VT : WS_UT)) + (size_t)tt * 65536;
#if P7_FP8
            unsigned char* d8 = ws + (isv ? WS_VT : WS_UT) + (size_t)tt * 65536;
            for (int e = tid * 16; e < 65536; e += NTHR * 16) { u32x4 o;
#pragma unroll
                for (int q = 0; q < 4; ++q) { f32x4 v = *(const f32x4*)(src + e + q * 4) * T_SCALE;
#pragma unroll
                    for (int i = 0; i < 4; ++i) v[i] = fminf(fmaxf(v[i], -448.f), 448.f);
                    int w = __builtin_amdgcn_cvt_pk_fp8_f32(v[0], v[1], 0, false); w = __builtin_amdgcn_cvt_pk_fp8_f32(v[2], v[3], w, true); o[q] = (unsigned)w; }
                *(u32x4*)(d8 + e) = o; }
#else
            if (!isv) {
                for (int e = tid * 8; e < 65536; e += NTHR * 8) { const f32x4 v0 = *(const f32x4*)(src + e), v1 = *(const f32x4*)(src + e + 4);
                    u32x4 o = {pk2(v0[0], v0[1]), pk2(v0[2], v0[3]), pk2(v1[0], v1[1]), pk2(v1[2], v1[3])}; *(u32x4*)(dst + e) = o; }
            } else {
                for (int e = tid * 8; e < 65536; e += NTHR * 8) { const f32x4 v0 = *(const f32x4*)(src + e) * V_SCALE, v1 = *(const f32x4*)(src + e + 4) * V_SCALE;
                    u32x4 o = {pkh2(v0[0], v0[1]), pkh2(v0[2], v0[3]), pkh2(v1[0], v1[1]), pkh2(v1[2], v1[3])}; *(u32x4*)(dst + e) = o; }
            }
#endif
        } else {
            float* rope = (float*)(ws + WS_ROPE);
            for (int e = tid; e < 64 * 16; e += NTHR) { const int pos = e >> 4, f = e & 15; const float inv = powf(10000.f, -(float)f / 16.f); const float ang = (float)pos * inv; rope[e * 2] = cosf(ang); rope[e * 2 + 1] = sinf(ang); }
        }
    }
}

__device__ void phase_xn(const Args& a, int vb, int nb) {
    const int tid = threadIdx.x, lane = tid & 63, wid = tid >> 6;
    const float* mod = (const float*)(a.ws + WS_MOD);
    bf16_t* XN = (bf16_t*)(a.ws + WS_XN);
    const float* g = a.in[I_GPREMIX];
    for (int row = vb * 8 + wid; row < NROWS; row += nb * 8) {
        const float* src; int mrow;
        if (row < NTOK) { src = a.in[I_X] + (size_t)row * DM; mrow = row >> 11; } else { src = a.in[I_CTX] + (size_t)(row - NTOK) * DM; mrow = 16; }
        f32x4 v[4]; float ss = 0.f;
#pragma unroll
        for (int i = 0; i < 4; ++i) { v[i] = *(const f32x4*)(src + i * 256 + lane * 4); ss += v[i][0] * v[i][0] + v[i][1] * v[i][1] + v[i][2] * v[i][2] + v[i][3] * v[i][3]; }
        ss = wave_sum(ss);
        const float rinv = rsqrtf(ss * (1.f / DM) + EPS);
        const float* sh = mod + (size_t)mrow * 6144, *sc = sh + 1024;
#pragma unroll
        for (int i = 0; i < 4; ++i) { const int c = i * 256 + lane * 4;
            const f32x4 gg = *(const f32x4*)(g + c), s1 = *(const f32x4*)(sc + c), s0 = *(const f32x4*)(sh + c);
            float o[4];
#pragma unroll
            for (int j = 0; j < 4; ++j) o[j] = v[i][j] * rinv * gg[j] * (1.f + s1[j]) + s0[j];
            u32x2 w = {pk2(o[0], o[1]), pk2(o[2], o[3])}; *(u32x2*)(XN + (size_t)row * DM + c) = w; }
    }
}

constexpr int E_PITCH = 272;
namespace g8 {
constexpr int BM = 256, BK = 64, HALF = 128, HT = HALF * BK, SHM_B = 8 * HT * 2;
__device__ __forceinline__ int lds_byte(int r, int c) { const int st = (r >> 4) * 2 + (c >> 5), rr = r & 15, cc = c & 31, ob = rr * 64 + cc * 2; return st * 1024 + (ob ^ (((ob >> 9) & 1) << 5)); }
__device__ __forceinline__ void stage_rc(int b, int& R, int& C) { const int st = b / 1024, sb = b % 1024, swz = sb ^ (((sb >> 9) & 1) << 5); R = (st >> 1) * 16 + swz / 64; C = (st & 1) * 32 + (swz % 64) / 2; }
__device__ __forceinline__ void core(f32x4 (&acc)[2][2][4][2], const bf16_t* __restrict__ A, const bf16_t* __restrict__ Bt, int brow, int bcol, int K, char* lds_) {
    LAS unsigned char* lds = (LAS unsigned char*)lds_;
    const int tid = threadIdx.x, wid = __builtin_amdgcn_readfirstlane(tid >> 6), lane = tid & 63, wr = wid >> 2, wc = wid & 3, fr = lane & 15, fq = lane >> 4;
    constexpr int HTB = HT * 2;
    unsigned voff[2];
#pragma unroll
    for (int i = 0; i < 2; ++i) { int R, C; stage_rc(tid * 16 + i * 8192, R, C); voff[i] = (unsigned)(R * K + C) * 2u; }
    const size_t kstep = (size_t)(BK * 2), hstep = (size_t)HALF * K * 2;
    const unsigned ldsw = (unsigned)wid * 1024u;
    const int aoff = lds_byte(wr * 64 + fr, fq * 8), boff = lds_byte(wc * 32 + fr, fq * 8);
#define G8_SA(b, h) (((b) * 2 + (h)) * HTB)
#define G8_SB(b, h) ((4 + (b) * 2 + (h)) * HTB)
#define G8_STAGE(bufoff, gbase) do { _Pragma("unroll") for (int _i = 0; _i < 2; ++_i) \
        __builtin_amdgcn_global_load_lds((const unsigned*)((const char*)(gbase) + voff[_i]), (LAS unsigned*)(lds + (bufoff) + ldsw + _i * 8192), 16, 0, 0); } while (0)
#define G8_LDA(dst, b, h) do { _Pragma("unroll") for (int m = 0; m < 4; ++m) _Pragma("unroll") for (int k = 0; k < 2; ++k) dst[m][k] = *(const LAS bf16x8*)(lds + G8_SA(b, h) + aoff + m * 2048 + k * 1024); } while (0)
#define G8_LDB(dst, b, h) do { _Pragma("unroll") for (int n = 0; n < 2; ++n) _Pragma("unroll") for (int k = 0; k < 2; ++k) dst[n][k] = *(const LAS bf16x8*)(lds + G8_SB(b, h) + boff + n * 2048 + k * 1024); } while (0)
#define G8_MMA(ai, bj, At_, Bt_) do { __builtin_amdgcn_s_setprio(1); \
    _Pragma("unroll") for (int m = 0; m < 4; ++m) _Pragma("unroll") for (int n = 0; n < 2; ++n) _Pragma("unroll") for (int k = 0; k < 2; ++k) \
      acc[ai][bj][m][n] = __builtin_amdgcn_mfma_f32_16x16x32_bf16(At_[m][k], Bt_[n][k], acc[ai][bj][m][n], 0, 0, 0); \
    __builtin_amdgcn_s_setprio(0); } while (0)
#define G8_WAIT_V(n) asm volatile("s_waitcnt vmcnt(" #n ")" ::: "memory")
#define G8_WAIT_L(n) asm volatile("s_waitcnt lgkmcnt(" #n ")" ::: "memory")
#define G8_BAR __builtin_amdgcn_s_barrier()
#define G8_SCHED __builtin_amdgcn_sched_barrier(0)
#pragma unroll
    for (int ai = 0; ai < 2; ++ai)
#pragma unroll
        for (int bj = 0; bj < 2; ++bj)
#pragma unroll
            for (int m = 0; m < 4; ++m)
#pragma unroll
                for (int n = 0; n < 2; ++n) acc[ai][bj][m][n] = (f32x4){0.f, 0.f, 0.f, 0.f};
    bf16x8 At[4][2], B0[2][2], B1[2][2];
    const int nt = K / BK;
    const char* cA = (const char*)(A + (size_t)brow * K); const char* cB = (const char*)(Bt + (size_t)bcol * K);
    G8_STAGE(G8_SB(0, 0), cB); G8_STAGE(G8_SA(0, 0), cA); G8_STAGE(G8_SB(0, 1), cB + hstep); G8_STAGE(G8_SA(0, 1), cA + hstep);
    if (wr == 1) G8_BAR;
    G8_WAIT_V(4); G8_BAR;
    G8_STAGE(G8_SB(1, 0), cB + kstep); G8_STAGE(G8_SA(1, 0), cA + kstep); G8_STAGE(G8_SB(1, 1), cB + hstep + kstep);
    G8_WAIT_V(6); G8_BAR;
#pragma unroll 1
    for (int t = 0; t < nt - 2; t += 2) {
        const char* a1 = cA + (size_t)(t + 1) * kstep; const char* a2 = cA + (size_t)(t + 2) * kstep; const char* b2 = cB + (size_t)(t + 2) * kstep;
        const char* a3 = a2 + kstep; const char* b3 = b2 + kstep;
        G8_LDB(B0, 0, 0); G8_SCHED; G8_LDA(At, 0, 0); G8_STAGE(G8_SA(1, 1), a1 + hstep);
        G8_WAIT_L(8); G8_BAR; G8_WAIT_L(0); G8_MMA(0, 0, At, B0); G8_BAR; G8_SCHED;
        G8_LDB(B1, 0, 1); G8_STAGE(G8_SB(0, 0), b2);
        G8_BAR; G8_WAIT_L(0); G8_MMA(0, 1, At, B1); G8_BAR;
        G8_LDA(At, 0, 1); G8_STAGE(G8_SA(0, 0), a2);
        G8_BAR; G8_WAIT_L(0); G8_MMA(1, 0, At, B0); G8_BAR; G8_SCHED;
        G8_STAGE(G8_SB(0, 1), b2 + hstep);
        G8_WAIT_V(6); G8_BAR; G8_MMA(1, 1, At, B1); G8_BAR;
        G8_LDB(B0, 1, 0); G8_SCHED; G8_LDA(At, 1, 0); G8_STAGE(G8_SA(0, 1), a2 + hstep);
        G8_WAIT_L(8); G8_BAR; G8_WAIT_L(0); G8_MMA(0, 0, At, B0); G8_BAR; G8_SCHED;
        G8_LDB(B1, 1, 1); G8_STAGE(G8_SB(1, 0), b3);
        G8_BAR; G8_WAIT_L(0); G8_MMA(0, 1, At, B1); G8_BAR;
        G8_LDA(At, 1, 1); G8_STAGE(G8_SA(1, 0), a3);
        G8_BAR; G8_WAIT_L(0); G8_MMA(1, 0, At, B0); G8_BAR; G8_SCHED;
        G8_STAGE(G8_SB(1, 1), b3 + hstep);
        G8_WAIT_V(6); G8_BAR; G8_MMA(1, 1, At, B1); G8_BAR;
    }
    { G8_LDB(B0, 0, 0); G8_LDA(At, 0, 0); G8_STAGE(G8_SA(1, 1), cA + (size_t)(nt - 1) * kstep + hstep);
      G8_BAR; G8_WAIT_L(0); G8_MMA(0, 0, At, B0); G8_BAR;
      G8_LDB(B1, 0, 1); G8_BAR; G8_WAIT_L(0); G8_MMA(0, 1, At, B1); G8_BAR;
      G8_LDA(At, 0, 1); G8_WAIT_V(4); G8_BAR; G8_WAIT_L(0); G8_MMA(1, 0, At, B0); G8_MMA(1, 1, At, B1); G8_BAR; }
    { G8_LDB(B0, 1, 0); G8_LDA(At, 1, 0); G8_WAIT_V(2); G8_BAR; G8_WAIT_L(0); G8_MMA(0, 0, At, B0); G8_BAR;
      G8_LDB(B1, 1, 1); G8_WAIT_V(0); G8_BAR; G8_WAIT_L(0); G8_MMA(0, 1, At, B1); G8_BAR;
      G8_LDA(At, 1, 1); G8_BAR; G8_WAIT_L(0); G8_MMA(1, 0, At, B0); G8_MMA(1, 1, At, B1); G8_BAR; }
    if (wr == 0) G8_BAR;
#undef G8_SA
#undef G8_SB
#undef G8_STAGE
#undef G8_LDA
#undef G8_LDB
#undef G8_MMA
#undef G8_WAIT_V
#undef G8_WAIT_L
#undef G8_BAR
#undef G8_SCHED
}
}

__device__ void phase_inproj(const Args& a, char* lds, int vb, int nb) {
    const int tid = threadIdx.x, lane = tid & 63, wid = tid >> 6, wr = wid >> 2, wc = wid & 3, fr = lane & 15, fq = lane >> 4;
    unsigned char* ws = a.ws;
    const bf16_t* XN = (const bf16_t*)(ws + WS_XN);
    const bf16_t* WIN = (const bf16_t*)(ws + WS_WIN);
    const float* rope = (const float*)(ws + WS_ROPE);
    bf16_t* Qo = (bf16_t*)(ws + WS_Q); bf16_t* Ko = (bf16_t*)(ws + WS_K); bf16_t* Vo = (bf16_t*)(ws + WS_VV); bf16_t* Lo = (bf16_t*)(ws + WS_L); bf16_t* Zo = (bf16_t*)(ws + WS_ZG);
    constexpr int N_LAT = 128 * 7, N_ALL = N_LAT + 16 * 3;
#pragma unroll 1
    for (int it = vb; it < N_ALL; it += nb) {
        int tt, ft;
        if (it < N_LAT) { tt = it / 7; ft = it % 7; } else { const int j = it - N_LAT; tt = 128 + j / 3; ft = 2 + j % 3; }
        f32x4 acc[2][2][4][2];
        g8::core(acc, WIN, XN, ft * 256, tt * 256, DM, lds);
        const bool lat = tt < 128;
#pragma unroll
        for (int ai = 0; ai < 2; ++ai) {
            const int g64 = ft * 4 + ai * 2 + wr;
            if (g64 < 10) {
                const bool isq = g64 < 8;
                const float* gn = isq ? a.in[I_QNG] : a.in[I_KNG];
                const float osc = isq ? 0.125f * 1.4426950408889634f : 1.f;
                float gnv[4][4];
#pragma unroll
                for (int m = 0; m < 4; ++m) { const f32x4 gv = *(const f32x4*)(gn + m * 16 + fq * 4); gnv[m][0] = gv[0]; gnv[m][1] = gv[1]; gnv[m][2] = gv[2]; gnv[m][3] = gv[3]; }
#pragma unroll
                for (int bj = 0; bj < 2; ++bj)
#pragma unroll
                    for (int n = 0; n < 2; ++n) {
                        float ss = 0.f;
#pragma unroll
                        for (int m = 0; m < 4; ++m)
#pragma unroll
                            for (int j = 0; j < 4; ++j) ss += acc[ai][bj][m][n][j] * acc[ai][bj][m][n][j];
                        ss += __shfl_xor(ss, 16); ss += __shfl_xor(ss, 32);
                        const float rinv = rsqrtf(ss * (1.f / 64.f) + EPS);
                        const int row = tt * 256 + bj * 128 + wc * 32 + n * 16 + fr;
                        int b, t, s_; if (lat) { b = row >> 11; t = row & 2047; s_ = CTX + t; } else { const int rc = row - NTOK; b = rc >> 8; t = 0; s_ = rc & 255; }
                        bf16_t* dst = isq ? Qo + ((size_t)(b * 8 + g64) * SEQ + t) * 64 : Ko + ((size_t)(b * 2 + (g64 - 8)) * STOT + s_) * 64;
#pragma unroll
                        for (int ax = 0; ax < 2; ++ax) {
                            const int pos = ax == 0 ? (t >> 6) : (t & 63);
                            float o1[4], o2[4];
#pragma unroll
                            for (int j = 0; j < 4; ++j) {
                                const float x1 = acc[ai][bj][2 * ax][n][j] * rinv * gnv[2 * ax][j], x2 = acc[ai][bj][2 * ax + 1][n][j] * rinv * gnv[2 * ax + 1][j];
                                float c1 = x1, c2 = x2;
                                if (lat) { const f32x2 cs = *(const f32x2*)(rope + (pos * 16 + fq * 4 + j) * 2); c1 = x1 * cs[0] - x2 * cs[1]; c2 = x1 * cs[1] + x2 * cs[0]; }
                                o1[j] = c1 * osc; o2[j] = c2 * osc; }
                            *(u32x2*)(dst + ax * 32 + fq * 4) = (u32x2){pk2(o1[0], o1[1]), pk2(o1[2], o1[3])};
                            *(u32x2*)(dst + ax * 32 + 16 + fq * 4) = (u32x2){pk2(o2[0], o2[1]), pk2(o2[2], o2[3])};
                        }
                    }
            } else if (g64 < 12) {
#pragma unroll
                for (int bj = 0; bj < 2; ++bj)
#pragma unroll
                    for (int n = 0; n < 2; ++n) {
                        const int row = tt * 256 + bj * 128 + wc * 32 + n * 16 + fr;
                        int b, s_; if (lat) { b = row >> 11; s_ = CTX + (row & 2047); } else { const int rc = row - NTOK; b = rc >> 8; s_ = rc & 255; }
                        bf16_t* vp = Vo + ((size_t)(b * 2 + (g64 - 10)) * 64) * STOT + s_;
#pragma unroll
                        for (int m = 0; m < 4; ++m)
#pragma unroll
                            for (int j = 0; j < 4; ++j) vp[(size_t)(m * 16 + fq * 4 + j) * STOT] = f2bf(acc[ai][bj][m][n][j]);
                    }
            } else {
                const bool isz = g64 >= 20;
#pragma unroll
                for (int bj = 0; bj < 2; ++bj)
#pragma unroll
                    for (int n = 0; n < 2; ++n) {
                        const int row = tt * 256 + bj * 128 + wc * 32 + n * 16 + fr;
                        bf16_t* dst;
                        if (isz) dst = Zo + (size_t)row * DLRU + (g64 - 20) * 64;
                        else { int b, s_; if (lat) { b = row >> 11; s_ = CTX + (row & 2047); } else { const int rc = row - NTOK; b = rc >> 8; s_ = rc & 255; }
                            dst = Lo + ((size_t)b * STOT + s_) * DLRU + (g64 - 12) * 64; }
#pragma unroll
                        for (int m = 0; m < 4; ++m) { f32x4 v = acc[ai][bj][m][n];
                            if (isz) { v[0] = gelu_tanh(v[0]); v[1] = gelu_tanh(v[1]); v[2] = gelu_tanh(v[2]); v[3] = gelu_tanh(v[3]); }
                            *(u32x2*)(dst + m * 16 + fq * 4) = (u32x2){pk2(v[0], v[1]), pk2(v[2], v[3])}; }
                    }
            }
        }
        __syncthreads();
    }
}

constexpr int AT_KP = 144, AT_VP = 136, AT_STAGE = 64 * AT_KP + 64 * AT_VP;
__device__ void attn_item(const Args& a, char* lds, int b, int head, int qblk) {
    const int tid = threadIdx.x, lane = tid & 63, wid = tid >> 6, r32 = lane & 31, hi = lane >> 5;
    unsigned char* ws = a.ws;
    const int kvh = head >> 2;
    const bf16_t* Qp = (const bf16_t*)(ws + WS_Q) + ((size_t)(b * 8 + head) * SEQ + qblk * 256 + wid * 32 + r32) * 64 + hi * 8;
    const bf16_t* Kp = (const bf16_t*)(ws + WS_K) + (size_t)(b * 2 + kvh) * STOT * 64;
    const bf16_t* Vp = (const bf16_t*)(ws + WS_VV) + (size_t)(b * 2 + kvh) * 64 * STOT;
    bf16x8 qf[4];
#pragma unroll
    for (int ds = 0; ds < 4; ++ds) qf[ds] = *(const bf16x8*)(Qp + ds * 16);
    const int srow = tid >> 3, sch = tid & 7;
    const bf16_t* kg = Kp + (size_t)srow * 64 + sch * 8;
    const bf16_t* vg = Vp + (size_t)srow * STOT + sch * 8;
    u32x4 krA, vrA, krB, vrB;
    f32x16 o[2]; float lsum = 0.f;
    float negM;
    { float gq = fabsf(a.in[I_QNG][lane]), gk = fabsf(a.in[I_KNG][lane]);
#pragma unroll
      for (int o_ = 32; o_ > 0; o_ >>= 1) { gq = fmaxf(gq, __shfl_xor(gq, o_)); gk = fmaxf(gk, __shfl_xor(gk, o_)); }
      negM = -(64.f * 0.125f * 1.4426950408889634f * 1.01f) * gq * gk; }
#pragma unroll
    for (int dt = 0; dt < 2; ++dt)
#pragma unroll
        for (int r = 0; r < 16; ++r) o[dt][r] = 0.f;
    char* KS = lds; char* VS = lds + 2 * 64 * AT_KP;
#define A_LOADK(X, s0) do { kr##X = *(const u32x4*)(kg + (size_t)(s0) * 64); } while (0)
#define A_LOADV(X, s0) do { vr##X = *(const u32x4*)(vg + (s0)); } while (0)
#define A_WRITEK(X, st) do { *(u32x4*)(KS + (st) * 64 * AT_KP + srow * AT_KP + sch * 16) = kr##X; } while (0)
#define A_WRITEV(X, st) do { char* vb_ = VS + (st) * 64 * AT_VP + srow * AT_VP + sch * 16; *(u32x2*)vb_ = (u32x2){vr##X[0], vr##X[1]}; *(u32x2*)(vb_ + 8) = (u32x2){vr##X[2], vr##X[3]}; } while (0)
    constexpr int NT = STOT / 64;
    f32x16 sc[2], sn[2];
    A_LOADK(A, 0); A_LOADV(A, 0); A_WRITEK(A, 0); A_WRITEV(A, 0); A_LOADK(A, 64); A_WRITEK(A, 1); A_LOADK(B, 128); A_LOADV(B, 64); __syncthreads();
#pragma unroll
    for (int kt = 0; kt < 2; ++kt) {
#pragma unroll
        for (int r = 0; r < 16; ++r) sc[kt][r] = negM;
#pragma unroll
        for (int ds = 0; ds < 4; ++ds) { const bf16x8 ka = *(const bf16x8*)(KS + (kt * 32 + r32) * AT_KP + (ds * 16 + hi * 8) * 2); sc[kt] = MFMA(ka, qf[ds], sc[kt]); }
    }
    __syncthreads();
    f32x16 ol;
#pragma unroll
    for (int r = 0; r < 16; ++r) ol[r] = 0.f;
    const u32x4 ones_w = {0x3F803F80u, 0x3F803F80u, 0x3F803F80u, 0x3F803F80u};
    const bf16x8 ones = *(const bf16x8*)&ones_w;
#define A_STEP(J, SC, SN, XW, XL) do { const int j_ = (J); \
        const int jk = (j_ + 3 < NT) ? j_ + 3 : NT - 1, jv = (j_ + 2 < NT) ? j_ + 2 : NT - 1; \
        A_LOADK(XL, jk * 64); A_LOADV(XL, jv * 64); \
        const char* ksn = KS + ((j_ + 1) & 1) * 64 * AT_KP; const char* vs = VS + (j_ & 1) * 64 * AT_VP; \
        _Pragma("unroll") for (int kt = 0; kt < 2; ++kt) { \
            _Pragma("unroll") for (int r = 0; r < 16; ++r) SN[kt][r] = negM; \
            _Pragma("unroll") for (int ds = 0; ds < 4; ++ds) { \
                const bf16x8 ka = *(const bf16x8*)(ksn + (kt * 32 + r32) * AT_KP + (ds * 16 + hi * 8) * 2); \
                SN[kt] = MFMA(ka, qf[ds], SN[kt]); \
                _Pragma("unroll") for (int e = 0; e < 4; ++e) { const int f = (kt * 4 + ds) * 4 + e; SC[f >> 4][f & 15] = __builtin_amdgcn_exp2f(SC[f >> 4][f & 15]); } \
                __builtin_amdgcn_sched_barrier(0); } } \
        _Pragma("unroll") for (int kt = 0; kt < 2; ++kt) \
            _Pragma("unroll") for (int s = 0; s < 2; ++s) { \
                u32x4 pw = {pk2(SC[kt][8 * s], SC[kt][8 * s + 1]), pk2(SC[kt][8 * s + 2], SC[kt][8 * s + 3]), pk2(SC[kt][8 * s + 4], SC[kt][8 * s + 5]), pk2(SC[kt][8 * s + 6], SC[kt][8 * s + 7])}; \
                const bf16x8 pb = *(bf16x8*)&pw; \
                _Pragma("unroll") for (int dt = 0; dt < 2; ++dt) { \
                    const char* vp = vs + (dt * 32 + r32) * AT_VP + (kt * 32 + s * 16 + hi * 4) * 2; \
                    const u32x2 lo = *(const u32x2*)vp, hh = *(const u32x2*)(vp + 16); \
                    u32x4 aw = {lo[0], lo[1], hh[0], hh[1]}; \
                    o[dt] = MFMA(*(bf16x8*)&aw, pb, o[dt]); } \
                ol = MFMA(ones, pb, ol); } \
        A_WRITEK(XW, j_ & 1); A_WRITEV(XW, (j_ + 1) & 1); \
        __syncthreads(); } while (0)
#pragma unroll 1
    for (int j = 0; j < NT; j += 2) { A_STEP(j, sc, sn, B, A); A_STEP(j + 1, sn, sc, A, B); }
#undef A_STEP
    lsum = ol[0];
#undef A_LOADK
#undef A_LOADV
#undef A_WRITEK
#undef A_WRITEV
    const float inv = fast_rcp(lsum);
    bf16_t* outp = (bf16_t*)(ws + WS_A2) + ((size_t)b * SEQ + qblk * 256 + wid * 32 + r32) * KOUT + head * 64;
#pragma unroll
    for (int dt = 0; dt < 2; ++dt)
#pragma unroll
        for (int g = 0; g < 4; ++g) {
            u32x2 v = {pk2(o[dt][4 * g] * inv, o[dt][4 * g + 1] * inv), pk2(o[dt][4 * g + 2] * inv, o[dt][4 * g + 3] * inv)};
            *(u32x2*)(outp + dt * 32 + g * 8 + hi * 4) = v;
        }
}

constexpr int LR_RAW = 0;
constexpr int LR_U   = 33792;
constexpr int LR_BB  = LR_U + 33280;
constexpr int LR_UB  = LR_BB + 33280;
constexpr int LR_WG  = LR_UB + 18432;
constexpr int LR_SEG = LR_WG + 18432;
constexpr int LR_HC  = LR_SEG + 4096;
constexpr int LR_CST = LR_HC + 512;
constexpr int LR_END = LR_CST + 768;
__device__ void lru_item(const Args& a, char* lds, int b, int n, int d) {
    const int tid = threadIdx.x, lane = tid & 63, wid = tid >> 6, r32 = lane & 31, hi = lane >> 5;
    unsigned char* ws = a.ws;
    float* RAW = (float*)(lds + LR_RAW); float* AA = (float*)(lds + LR_RAW); float* U = (float*)(lds + LR_U); float* BB = (float*)(lds + LR_BB);
    char* UB = lds + LR_UB; char* WG = lds + LR_WG; float* SEG = (float*)(lds + LR_SEG); float* HC = (float*)(lds + LR_HC);
    const bf16_t* Lg = (const bf16_t*)(ws + WS_L) + (size_t)b * STOT * DLRU + n * 64;
    const bf16_t* Zg = (const bf16_t*)(ws + WS_ZG) + (size_t)b * SEQ * DLRU + n * 64;
    bf16_t* Og = (bf16_t*)(ws + WS_A2) + (size_t)b * SEQ * KOUT + 512 + d * 512 + n * 64;
    {
        const bf16_t* wsrc = (const bf16_t*)(ws + WS_RGW) + (size_t)(d * 8 + n) * 128 * 64;
#pragma unroll
        for (int i = 0; i < 2; ++i) { const int c = tid + NTHR * i, r = c >> 3, ch = c & 7; *(u32x4*)(WG + r * 144 + ch * 16) = *(const u32x4*)(wsrc + r * 64 + ch * 8); }
        if (tid < 128) HC[tid] = 0.f;
    }
    const int ct = wid & 1, tt = wid >> 1;
    float* CST = (float*)(lds + LR_CST);
    if (tid < 64) { const int c = n * 64 + tid; CST[tid] = a.in[I_RGBA][d * 512 + c]; CST[64 + tid] = a.in[I_RGBI][d * 512 + c];
        const float x = -a.in[I_RGLAM][d * 512 + c]; CST[128 + tid] = -8.f * (fmaxf(x, 0.f) + log1pf(__expf(-fabsf(x)))); }
    const int sc = tid & 63, sg = tid >> 6;
    const float cw0 = a.in[I_CONVW][0 * 512 + n * 64 + sc], cw1 = a.in[I_CONVW][1 * 512 + n * 64 + sc], cw2 = a.in[I_CONVW][2 * 512 + n * 64 + sc], cw3 = a.in[I_CONVW][3 * 512 + n * 64 + sc];
    const float cbias = a.in[I_CONVB][n * 64 + sc];
    __syncthreads();
    int par = 0;
    for (int step = 0; step < 18; ++step) {
        const bool isctx = step < 2;
        const int tl = isctx ? (d == 0 ? step : 1 - step) : (d == 0 ? step - 2 : 17 - step);
        const int sb = isctx ? 0 : CTX, sl = isctx ? CTX : SEQ, t0 = tl * 128;
        for (int e = tid; e < 131 * 8; e += NTHR) { const int r = e >> 3, ch = e & 7, t = t0 - 2 + r;
            u32x4 v = {0u, 0u, 0u, 0u}; if (t >= 0 && t < sl) v = *(const u32x4*)(Lg + (size_t)(sb + t) * DLRU + ch * 8);
            float* dst = RAW + r * 64 + ch * 8;
            dst[0] = bflo(v[0]); dst[1] = bfhi(v[0]); dst[2] = bflo(v[1]); dst[3] = bfhi(v[1]); dst[4] = bflo(v[2]); dst[5] = bfhi(v[2]); dst[6] = bflo(v[3]); dst[7] = bfhi(v[3]); }
        __syncthreads();
        {
            const float* rp = RAW + (sg * 16) * 64 + sc;
            float x0 = rp[0], x1 = rp[64], x2 = rp[128];
            float* up = U + (sg * 16) * 65 + sc; char* ubp = UB + (sg * 16) * 144 + sc * 2;
#pragma unroll
            for (int i = 0; i < 16; ++i) { const float x3 = rp[(i + 3) * 64];
                const float u = cbias + cw0 * x0 + cw1 * x1 + cw2 * x2 + cw3 * x3;
                up[i * 65] = u; *(bf16_t*)(ubp + i * 144) = f2bf(u); x0 = x1; x1 = x2; x2 = x3; }
        }
        __syncthreads();
        {
            f32x16 ga, gi;
#pragma unroll
            for (int r = 0; r < 16; ++r) { ga[r] = 0.f; gi[r] = 0.f; }
#pragma unroll
            for (int ks = 0; ks < 4; ++ks) {
                const bf16x8 wa = *(const bf16x8*)(WG + (ct * 32 + r32) * 144 + (ks * 16 + hi * 8) * 2);
                const bf16x8 wi = *(const bf16x8*)(WG + (64 + ct * 32 + r32) * 144 + (ks * 16 + hi * 8) * 2);
                const bf16x8 ub = *(const bf16x8*)(UB + (tt * 32 + r32) * 144 + (ks * 16 + hi * 8) * 2);
                ga = MFMA(wa, ub, ga); gi = MFMA(wi, ub, gi);
            }
            const int t = tt * 32 + r32;
#pragma unroll
            for (int r = 0; r < 16; ++r) { const int c = ct * 32 + 8 * (r >> 2) + 4 * hi + (r & 3);
                const float rr = sigmoidf_(ga[r] + CST[c]), ii = sigmoidf_(gi[r] + CST[64 + c]);
                const float la = CST[128 + c] * rr, av = __expf(la), mult = __builtin_amdgcn_sqrtf(fmaxf(1.f - av * av, 0.f));
                const float u = U[t * 65 + c];
                AA[t * 65 + c] = av; BB[t * 65 + c] = mult * ii * u; }
        }
        __syncthreads();
        float av[16], bv[16]; float Ap = 1.f, Bp = 0.f;
#pragma unroll
        for (int k = 0; k < 16; ++k) { const int p = sg * 16 + k, t = d == 0 ? p : 127 - p; av[k] = AA[t * 65 + sc]; bv[k] = BB[t * 65 + sc]; Bp = av[k] * Bp + bv[k]; Ap = av[k] * Ap; }
        SEG[sg * 64 + sc] = Ap; SEG[512 + sg * 64 + sc] = Bp;
        __syncthreads();
        float h = HC[par * 64 + sc];
        for (int s2 = 0; s2 < sg; ++s2) h = SEG[s2 * 64 + sc] * h + SEG[512 + s2 * 64 + sc];
        {
            const int tfirst = d == 0 ? sg * 16 : 127 - sg * 16;
            const bf16_t* zp = Zg + (size_t)(t0 + tfirst) * DLRU + sc; bf16_t* op = Og + (size_t)(t0 + tfirst) * KOUT + sc;
            const int zstep = d == 0 ? DLRU : -DLRU, ostep = d == 0 ? KOUT : -KOUT;
#pragma unroll
            for (int k = 0; k < 16; ++k) { h = av[k] * h + bv[k];
                if (!isctx) { const float gz = bf2f(*zp); *op = f2bf(h * gz); zp += zstep; op += ostep; } }
        }
        if (sg == 7) HC[(par ^ 1) * 64 + sc] = h;
        par ^= 1;
        __syncthreads();
    }
}

#ifndef LRU_REPS
#define LRU_REPS 1
#endif
__device__ void phase_mixer(const Args& a, char* lds, int vb, int nb) {
#pragma unroll 1
    for (int it = vb; it < 256; it += nb) { for (int rep_ = 0; rep_ < LRU_REPS; ++rep_) { lru_item(a, lds, it >> 4, (it >> 1) & 7, it & 1); __syncthreads(); } }
#pragma unroll 1
    for (int at = vb; at < 1024; at += nb) { const int bk = at >> 5, w = at & 31; attn_item(a, lds, bk >> 1, (bk & 1) * 4 + (w >> 3), w & 7); __syncthreads(); }
}

__device__ void phase_outproj(const Args& a, char* lds, int vb, int nb) {
    const int tid = threadIdx.x, lane = tid & 63, wid = tid >> 6, wr = wid >> 2, wc = wid & 3, fr = lane & 15, fq = lane >> 4;
    const bf16_t* A2 = (const bf16_t*)(a.ws + WS_A2); const bf16_t* WO = (const bf16_t*)(a.ws + WS_WOUT);
    bf16_t* MIX = (bf16_t*)(a.ws + WS_MIX);
#pragma unroll 1
    for (int it = vb; it < 128 * 4; it += nb) {
        const int tt = it >> 2, ft = it & 3;
        f32x4 acc[2][2][4][2];
        g8::core(acc, WO, A2, ft * 256, tt * 256, KOUT, lds);
#pragma unroll
        for (int bj = 0; bj < 2; ++bj)
#pragma unroll
            for (int n = 0; n < 2; ++n) {
                bf16_t* rp = MIX + (size_t)(tt * 256 + bj * 128 + wc * 32 + n * 16 + fr) * DM + ft * 256 + wr * 64 + fq * 4;
#pragma unroll
                for (int ai = 0; ai < 2; ++ai)
#pragma unroll
                    for (int m = 0; m < 4; ++m) { const f32x4 v = acc[ai][bj][m][n]; *(u32x2*)(rp + ai * 128 + m * 16) = (u32x2){pk2(v[0], v[1]), pk2(v[2], v[3])}; }
            }
        __syncthreads();
    }
}

__device__ void phase_rowpass(const Args& a, int vb, int nb) {
    const int tid = threadIdx.x, lane = tid & 63, wid = tid >> 6;
    const float* mod = (const float*)(a.ws + WS_MOD);
    const bf16_t* MIX = (const bf16_t*)(a.ws + WS_MIX);
    bf16_t* HX = (bf16_t*)(a.ws + WS_HX2);
    for (int row = vb * 8 + wid; row < NTOK; row += nb * 8) {
        const int b = row >> 11;
        const float* mrow = mod + (size_t)b * 6144;
        f32x4 mv[4], xv[4]; float ss = 0.f;
#pragma unroll
        for (int i = 0; i < 4; ++i) { const u32x2 mw = *(const u32x2*)(MIX + (size_t)row * DM + i * 256 + lane * 4); mv[i] = (f32x4){bflo(mw[0]), bfhi(mw[0]), bflo(mw[1]), bfhi(mw[1])};
            xv[i] = *(const f32x4*)(a.in[I_X] + (size_t)row * DM + i * 256 + lane * 4);
            ss += mv[i][0] * mv[i][0] + mv[i][1] * mv[i][1] + mv[i][2] * mv[i][2] + mv[i][3] * mv[i][3]; }
        ss = wave_sum(ss);
        const float rinv = rsqrtf(ss * (1.f / DM) + EPS);
        float s2 = 0.f;
#pragma unroll
        for (int i = 0; i < 4; ++i) { const int c = i * 256 + lane * 4;
            const f32x4 gp = *(const f32x4*)(a.in[I_GPOSTMIX] + c), g1 = *(const f32x4*)(mrow + 2048 + c);
#pragma unroll
            for (int j = 0; j < 4; ++j) { const float xm = xv[i][j] + g1[j] * (mv[i][j] * rinv * gp[j]); xv[i][j] = xm; s2 += xm * xm; }
            *(f32x4*)(a.out + (size_t)row * DM + c) = xv[i]; }
        s2 = wave_sum(s2);
        const float rinv2 = rsqrtf(s2 * (1.f / DM) + EPS);
#pragma unroll
        for (int i = 0; i < 4; ++i) { const int c = i * 256 + lane * 4;
            const f32x4 gf = *(const f32x4*)(a.in[I_GPREFFN] + c), sh = *(const f32x4*)(mrow + 3072 + c), sc = *(const f32x4*)(mrow + 4096 + c);
            float o[4];
#pragma unroll
            for (int j = 0; j < 4; ++j) o[j] = xv[i][j] * rinv2 * gf[j] * (1.f + sc[j]) + sh[j];
            u32x2 w = {pk2(o[0], o[1]), pk2(o[2], o[3])}; *(u32x2*)(HX + (size_t)row * DM + c) = w; }
    }
}

__device__ __forceinline__ int fkey(float f) { const int b = __float_as_int(f); return b ^ ((b >> 31) & 0x7fffffff); }
__device__ __forceinline__ float fval(int k) { return __int_as_float(k ^ ((k >> 31) & 0x7fffffff)); }
#define CE_DESC(x, y) do { const int hi_ = max((x), (y)), lo_ = min((x), (y)); (x) = hi_; (y) = lo_; } while (0)
__device__ __forceinline__ void sort16_desc(int (&v)[16]) {
#pragma unroll
    for (int k = 2; k <= 16; k <<= 1)
#pragma unroll
        for (int j = k >> 1; j > 0; j >>= 1)
#pragma unroll
            for (int i = 0; i < 16; ++i) { const int l = i ^ j; if (l > i) { if ((i & k) == 0) { CE_DESC(v[i], v[l]); } else { CE_DESC(v[l], v[i]); } } }
}
__device__ __forceinline__ void merge16_desc(int (&v)[16]) {
#pragma unroll
    for (int j = 8; j > 0; j >>= 1)
#pragma unroll
        for (int i = 0; i < 16; ++i) { const int l = i ^ j; if (l > i) CE_DESC(v[i], v[l]); }
}
__device__ __forceinline__ void top16_merge(int (&A)[16], const int (&B)[16]) {
#pragma unroll
    for (int i = 0; i < 16; ++i) A[i] = max(A[i], B[15 - i]);
    merge16_desc(A);
}
constexpr int PK_QS = 0;
constexpr int PK_SK = 256 * E_PITCH;
constexpr int PK_ML = PK_SK + 128 * E_PITCH;
constexpr int PK_X  = PK_ML + 32768;
constexpr int PK_END = PK_X + 8192;
__device__ void phase_peer_topk(const Args& a, char* lds, int vb, int nb) {
    unsigned char* ws = a.ws;
    const bf16_t* HX = (const bf16_t*)(ws + WS_HX2); const bf16_t* WQ = (const bf16_t*)(ws + WS_WQ); const bf16_t* SUBK = (const bf16_t*)(ws + WS_SUBK);
    int* IDX = (int*)(ws + WS_IDX);
    int* ML = (int*)(lds + PK_ML); int* XB = (int*)(lds + PK_X);
    for (int it = vb; it < 128 * 8; it += nb) {
        const int rt = it >> 3, h = it & 7, row0 = rt * 256;
        bf16_t* park = (bf16_t*)(ws + WS_MIX) + (size_t)it * (256 * 128);
        int tid = threadIdx.x;
        {
            f32x4 acc8[2][2][4][2];
            g8::core(acc8, WQ, HX, h * 256, row0, DM, lds);
            __syncthreads();
            asm volatile("" : "+v"(tid));
            const int lane = tid & 63, wid = tid >> 6;
            const int w8r = wid >> 2, w8c = wid & 3, fr = lane & 15, fq = lane >> 4;
#pragma unroll
            for (int bj = 0; bj < 2; ++bj)
#pragma unroll
                for (int m = 0; m < 4; ++m)
#pragma unroll
                    for (int n = 0; n < 2; ++n) { const int tok = bj * 128 + w8c * 32 + n * 16 + fr, d = w8r * 64 + m * 16 + fq * 4;
                        const f32x4 v0 = acc8[0][bj][m][n], v1 = acc8[1][bj][m][n];
                        *(u32x2*)(lds + PK_QS + tok * E_PITCH + d * 2) = (u32x2){pk2(v0[0], v0[1]), pk2(v0[2], v0[3])};
                        *(u32x2*)(park + tok * 128 + d) = (u32x2){pk2(v1[0], v1[1]), pk2(v1[2], v1[3])}; }
        }
        const int lane = tid & 63, wid = tid >> 6, wm = wid & 3, wn = wid >> 2, r32 = lane & 31, hi = lane >> 5;
#pragma unroll 1
        for (int p = 0; p < 2; ++p) {
            f32x16 acc[2][2];
            if (p == 1) {
#pragma unroll
                for (int i = 0; i < 8; ++i) { const int c = tid + NTHR * i, tok = c >> 4, ch = c & 15; *(u32x4*)(lds + PK_QS + tok * E_PITCH + ch * 16) = *(const u32x4*)(park + tok * 128 + ch * 8); }
            }
            {
                const bf16_t* sk = SUBK + (size_t)(h * 2 + p) * 128 * 128;
#pragma unroll
                for (int i = 0; i < 4; ++i) { const int c = tid + NTHR * i, r = c >> 4, ch = c & 15; *(u32x4*)(lds + PK_SK + r * E_PITCH + ch * 16) = *(const u32x4*)(sk + r * 128 + ch * 8); }
            }
            __syncthreads();
#pragma unroll
            for (int ft = 0; ft < 2; ++ft)
#pragma unroll
                for (int tt = 0; tt < 2; ++tt)
#pragma unroll
                    for (int r = 0; r < 16; ++r) acc[ft][tt][r] = 0.f;
#pragma unroll
            for (int ks = 0; ks < 8; ++ks) {
                const bf16x8 a0 = *(const bf16x8*)(lds + PK_SK + (wn * 64 + r32) * E_PITCH + (ks * 16 + hi * 8) * 2), a1 = *(const bf16x8*)(lds + PK_SK + (wn * 64 + 32 + r32) * E_PITCH + (ks * 16 + hi * 8) * 2);
                const bf16x8 b0 = *(const bf16x8*)(lds + PK_QS + (wm * 64 + r32) * E_PITCH + (ks * 16 + hi * 8) * 2), b1 = *(const bf16x8*)(lds + PK_QS + (wm * 64 + 32 + r32) * E_PITCH + (ks * 16 + hi * 8) * 2);
                acc[0][0] = MFMA(a0, b0, acc[0][0]); acc[0][1] = MFMA(a0, b1, acc[0][1]);
                acc[1][0] = MFMA(a1, b0, acc[1][0]); acc[1][1] = MFMA(a1, b1, acc[1][1]);
            }
#pragma unroll
            for (int tt = 0; tt < 2; ++tt) {
                int A[16], B[16];
#pragma unroll
                for (int r = 0; r < 16; ++r) { const int key = wn * 64 + 8 * (r >> 2) + 4 * hi + (r & 3);
                    A[r] = (fkey(acc[0][tt][r]) & ~127) | key; B[r] = (fkey(acc[1][tt][r]) & ~127) | (key + 32); }
                sort16_desc(A); sort16_desc(B); top16_merge(A, B);
#pragma unroll
                for (int r = 0; r < 16; ++r) { auto rr = __builtin_amdgcn_permlane32_swap((unsigned)A[r], (unsigned)A[r], false, false); B[r] = (int)(hi ? rr[0] : rr[1]); }
                top16_merge(A, B);
                const int tok = wm * 64 + tt * 32 + r32;
                if (wn == 1 && hi == 0) {
#pragma unroll
                    for (int r = 0; r < 16; ++r) XB[(wm * 32 + r32) * 16 + r] = A[r];
                }
                __syncthreads();
                if (wn == 0 && hi == 0) {
#pragma unroll
                    for (int r = 0; r < 16; ++r) B[r] = XB[(wm * 32 + r32) * 16 + r];
                    top16_merge(A, B);
#pragma unroll
                    for (int r = 0; r < 16; ++r) ML[(tok * 2 + p) * 16 + r] = A[r];
                }
                __syncthreads();
            }
        }
        if (tid < 256) {
            const int tok = tid;
            int s1[16], s2[16];
#pragma unroll
            for (int r = 0; r < 16; ++r) { s1[r] = ML[(tok * 2 + 0) * 16 + r]; s2[r] = ML[(tok * 2 + 1) * 16 + r]; }
            float f1[16], f2[16];
#pragma unroll
            for (int r = 0; r < 16; ++r) { f1[r] = fval(s1[r] & ~127); f2[r] = fval(s2[r] & ~127); }
            int G0[16], G1[16], G2[16], G3[16];
#pragma unroll
            for (int bb = 0; bb < 16; ++bb) G0[bb] = (fkey(f1[0] + f2[bb]) & ~255) | (0 * 16 + bb);
#pragma unroll
            for (int bb = 0; bb < 8; ++bb) G1[bb] = (fkey(f1[1] + f2[bb]) & ~255) | (1 * 16 + bb);
#pragma unroll
            for (int bb = 0; bb < 5; ++bb) G1[8 + bb] = (fkey(f1[2] + f2[bb]) & ~255) | (2 * 16 + bb);
#pragma unroll
            for (int bb = 0; bb < 3; ++bb) G1[13 + bb] = (fkey(f1[3] + f2[bb]) & ~255) | (3 * 16 + bb);
            G2[0] = (fkey(f1[3] + f2[3]) & ~255) | (3 * 16 + 3);
#pragma unroll
            for (int bb = 0; bb < 3; ++bb) G2[1 + bb] = (fkey(f1[4] + f2[bb]) & ~255) | (4 * 16 + bb);
#pragma unroll
            for (int aa = 5; aa < 8; ++aa)
#pragma unroll
                for (int bb = 0; bb < 2; ++bb) G2[4 + (aa - 5) * 2 + bb] = (fkey(f1[aa] + f2[bb]) & ~255) | (aa * 16 + bb);
#pragma unroll
            for (int aa = 8; aa < 14; ++aa) G2[10 + (aa - 8)] = (fkey(f1[aa] + f2[0]) & ~255) | (aa * 16);
            G3[0] = (fkey(f1[14] + f2[0]) & ~255) | (14 * 16); G3[1] = (fkey(f1[15] + f2[0]) & ~255) | (15 * 16);
#pragma unroll
            for (int r = 2; r < 16; ++r) G3[r] = (int)0x80000000;
            sort16_desc(G0); sort16_desc(G1); sort16_desc(G2); sort16_desc(G3);
            top16_merge(G0, G1); top16_merge(G2, G3); top16_merge(G0, G2);
            float tv[16]; float mx = fval(G0[0] & ~255), sum = 0.f;
#pragma unroll
            for (int r = 0; r < 16; ++r) { tv[r] = __expf(fval(G0[r] & ~255) - mx); sum += tv[r]; }
            const float rs = 1.f / sum;
            const size_t ob = ((size_t)(row0 + tok) * 8 + h) * 16;
#pragma unroll
            for (int r = 0; r < 16; ++r) { const int code = G0[r] & 255, aa = code >> 4, bb = code & 15;
                const int i1 = ML[(tok * 2 + 0) * 16 + aa] & 127, i2 = ML[(tok * 2 + 1) * 16 + bb] & 127;
                IDX[ob + r] = (i1 * 128 + i2) | (int)((unsigned)f2bf(tv[r] * rs) << 16); }
        }
        __syncthreads();
    }
}

template <int CTRL> __device__ __forceinline__ float dpp_add(float v) { return v + __uint_as_float(__builtin_amdgcn_update_dpp(0u, __float_as_uint(v), CTRL, 0xf, 0xf, true)); }
__device__ __forceinline__ float wave_sum_bcast(float p) {
    p = dpp_add<0xB1>(p); p = dpp_add<0x4E>(p); p = dpp_add<0x141>(p); p = dpp_add<0x140>(p);
    const unsigned u = __float_as_uint(p);
    return (__uint_as_float(__builtin_amdgcn_readlane(u, 0)) + __uint_as_float(__builtin_amdgcn_readlane(u, 16))) + (__uint_as_float(__builtin_amdgcn_readlane(u, 32)) + __uint_as_float(__builtin_amdgcn_readlane(u, 48)));
}
typedef float f32x4v __attribute__((ext_vector_type(4)));
constexpr int P7_RS = 9;
constexpr int P7_NR = PEER_N >> P7_RS;
constexpr int P7_HTP = 1024 + 64;
constexpr float H_SCALE = 16.f;
constexpr int P7_WLDS = 4 * P7_HTP + 2048 + 8192 + 2048 + 2048;
__device__ void phase_peer_gather(const Args& a, char* lds, int vb, int nb) {
    const int tid = threadIdx.x, lane = tid & 63, wid = tid >> 6, r16 = lane & 15, kg = lane >> 4;
    unsigned char* ws = a.ws;
    const bf16_t* HX = (const bf16_t*)(ws + WS_HX2);
    const int* IDX = (const int*)(ws + WS_IDX);
    const float* mod = (const float*)(ws + WS_MOD);
    const unsigned char* UT = ws + WS_UT; const unsigned char* VT = ws + WS_VT;
    char* HT = lds + wid * P7_WLDS; unsigned* LIST = (unsigned*)(HT + 4 * P7_HTP); char* AT = HT + 4 * P7_HTP + 2048; char* ST = AT + 8192; float* WL = (float*)(ST + 2048);
#pragma unroll 1
    for (int tb = vb * 32; tb < NTOK; tb += nb * 32) {
        const int tok0 = tb + wid * 4;
        {
            int* HIST = (int*)HT; int* CUR = HIST + 128;
            int ee[8];
            const int* ip = IDX + (size_t)tok0 * 128 + lane;
#pragma unroll
            for (int k = 0; k < 4; ++k) { ee[2 * k] = ip[k * 128]; ee[2 * k + 1] = ip[k * 128 + 64]; }
            HIST[lane] = 0; HIST[64 + lane] = 0;
#pragma unroll
            for (int j = 0; j < 8; ++j) atomicAdd(&HIST[(((ee[j] >> P7_RS) & (P7_NR - 1)) << 2) | (j >> 1)], 1);
            const int c0 = HIST[2 * lane], c1 = HIST[2 * lane + 1];
            int inc = c0 + c1;
#pragma unroll
            for (int o = 1; o < 64; o <<= 1) { const int t = __shfl_up(inc, o); if (lane >= o) inc += t; }
            CUR[2 * lane] = inc - c0 - c1; CUR[2 * lane + 1] = inc - c1;
#pragma unroll
            for (int j = 0; j < 8; ++j) { const unsigned w = (unsigned)ee[j]; const int slot = atomicAdd(&CUR[(((w >> P7_RS) & (P7_NR - 1)) << 2) | (j >> 1)], 1);
                LIST[slot] = (w & 16383u) | ((unsigned)(j >> 1) << 14) | ((w >> 16) << 17); }
        }
        {
            const bf16_t* hp = HX + (size_t)tok0 * DM + lane * 16;
#pragma unroll
            for (int k = 0; k < 4; ++k) { const u32x4 h0 = *(const u32x4*)(hp + k * DM), h1 = *(const u32x4*)(hp + k * DM + 8);
                u32x4 o;
#pragma unroll
                for (int q = 0; q < 4; ++q) { const unsigned wa = q < 2 ? h0[2 * q] : h1[2 * q - 4], wb = q < 2 ? h0[2 * q + 1] : h1[2 * q - 3];
                    int w = __builtin_amdgcn_cvt_pk_fp8_f32(sat8(bflo(wa) * H_SCALE), sat8(bfhi(wa) * H_SCALE), 0, false); w = __builtin_amdgcn_cvt_pk_fp8_f32(sat8(bflo(wb) * H_SCALE), sat8(bfhi(wb) * H_SCALE), w, true); o[q] = (unsigned)w; }
                *(u32x4*)(HT + k * P7_HTP + lane * 16) = o;
                *(u32x4*)(AT + k * 2048 + lane * 32) = (u32x4){0u, 0u, 0u, 0u}; *(u32x4*)(AT + k * 2048 + lane * 32 + 16) = (u32x4){0u, 0u, 0u, 0u}; }
        }
        const char* hb0 = HT + (lane & 3) * P7_HTP + kg * 8;
        const int wlo = (lane >> 3) * 128 + (((lane & 7) ^ ((lane >> 4) & 7)) << 4), whi = (8 + (lane >> 3)) * 128 + (((lane & 7) ^ (4 + ((lane >> 4) & 3))) << 4);
        const int aoffs = r16 * 128 + (kg & 1) * 8, asw = (r16 >> 1) & 7;
        {
            unsigned entv = LIST[r16];
            u32x4 ua[8], uc[8];
            {
                const unsigned e_lo = (unsigned)__shfl((int)entv, lane >> 3) & 16383u, e_hi = (unsigned)__shfl((int)entv, 8 + (lane >> 3)) & 16383u;
                const unsigned char* ul = UT + (size_t)e_lo * DM + (lane & 7) * 16; const unsigned char* uh = UT + (size_t)e_hi * DM + (lane & 7) * 16;
#pragma unroll
                for (int kc = 0; kc < 8; ++kc) { ua[kc] = *(const u32x4*)(ul + kc * 128); uc[kc] = *(const u32x4*)(uh + kc * 128); }
            }
#pragma unroll 1
            for (int bi = 0; bi < 32; ++bi) {
                const unsigned entn = LIST[(bi < 31 ? bi + 1 : 31) * 16 + r16];
                const unsigned n_lo = (unsigned)__shfl((int)entn, lane >> 3) & 16383u, n_hi = (unsigned)__shfl((int)entn, 8 + (lane >> 3)) & 16383u;
                const unsigned char* ul = UT + (size_t)n_lo * DM + (lane & 7) * 16; const unsigned char* uh = UT + (size_t)n_hi * DM + (lane & 7) * 16;
                f32x4v D = {0.f, 0.f, 0.f, 0.f};
#pragma unroll
                for (int kc = 0; kc < 8; ++kc) {
                    *(u32x4*)(ST + wlo) = ua[kc]; *(u32x4*)(ST + whi) = uc[kc];
                    ua[kc] = *(const u32x4*)(ul + kc * 128); uc[kc] = *(const u32x4*)(uh + kc * 128);
#pragma unroll
                    for (int t = 0; t < 4; ++t) {
                        const int ci = 2 * t + (kg >> 1);
                        const long a0 = *(const long*)(ST + aoffs + ((ci ^ asw) << 4));
                        const long b0 = *(const long*)(hb0 + kc * 128 + t * 32);
                        D = __builtin_amdgcn_mfma_f32_16x16x32_fp8_fp8(a0, b0, D, 0, 0, 0);
                    }
                }
                float dsel = 0.f; unsigned esel = 0u;
#pragma unroll
                for (int i = 0; i < 4; ++i) {
                    const unsigned er = (unsigned)__shfl((int)entv, 4 * kg + i);
                    float m = (((er >> 14) & 3u) == (unsigned)(lane & 3)) ? D[i] : 0.f;
                    m = dpp_add<0xB1>(m); m = dpp_add<0x4E>(m);
                    const bool pick = (lane & 3) == i; dsel = pick ? m : dsel; esel = pick ? er : esel;
                }
                if ((lane & 12) == 0) WL[bi * 16 + 4 * kg + (lane & 3)] = __uint_as_float((esel >> 17) << 16) * gelu_tanh(dsel * (1.f / (T_SCALE * H_SCALE)));
                entv = entn;
            }
        }
        u32x4 c0 = {0u, 0u, 0u, 0u}, c1 = {0u, 0u, 0u, 0u}; unsigned cur = 0u;
        {
            unsigned entv = LIST[r16]; float wv = WL[r16];
            u32x4 vbuf[16];
#pragma unroll
            for (int b = 0; b < 16; ++b) vbuf[b] = *(const u32x4*)(VT + (size_t)((unsigned)__builtin_amdgcn_readlane((int)entv, b) & 16383u) * DM + lane * 16);
#pragma unroll 1
            for (int bi = 0; bi < 32; ++bi) {
                const int bn = (bi < 31 ? bi + 1 : 31);
                const unsigned entn = LIST[bn * 16 + r16]; const float wn_ = WL[bn * 16 + r16];
#pragma unroll
                for (int b = 0; b < 16; ++b) {
                    const unsigned eb_ = (unsigned)__builtin_amdgcn_readlane((int)entv, b);
                    const float w_ = __uint_as_float(__builtin_amdgcn_readlane(__float_as_uint(wv), b));
                    const h16x2 w2 = as_h2(pkh2(w_, w_)); const unsigned tk = (eb_ >> 14) & 3u;
                    if (tk != cur) { char* apo = AT + cur * 2048 + lane * 32; *(u32x4*)apo = c0; *(u32x4*)(apo + 16) = c1;
                        const char* apn = AT + tk * 2048 + lane * 32; c0 = *(const u32x4*)apn; c1 = *(const u32x4*)(apn + 16); cur = tk; }
#pragma unroll
                    for (int q_ = 0; q_ < 4; ++q_) { const unsigned vw_ = vbuf[b][q_];
                        const h16x2 lo = __builtin_amdgcn_cvt_scalef32_pk_f16_fp8(vw_, V_SCALE / T_SCALE, false), hi2 = __builtin_amdgcn_cvt_scalef32_pk_f16_fp8(vw_, V_SCALE / T_SCALE, true);
                        if (q_ < 2) { c0[2 * q_] = __builtin_bit_cast(unsigned, __builtin_elementwise_fma(lo, w2, as_h2(c0[2 * q_]))); c0[2 * q_ + 1] = __builtin_bit_cast(unsigned, __builtin_elementwise_fma(hi2, w2, as_h2(c0[2 * q_ + 1]))); }
                        else { c1[2 * q_ - 4] = __builtin_bit_cast(unsigned, __builtin_elementwise_fma(lo, w2, as_h2(c1[2 * q_ - 4]))); c1[2 * q_ - 3] = __builtin_bit_cast(unsigned, __builtin_elementwise_fma(hi2, w2, as_h2(c1[2 * q_ - 3]))); } }
                    vbuf[b] = *(const u32x4*)(VT + (size_t)((unsigned)__builtin_amdgcn_readlane((int)entn, b) & 16383u) * DM + lane * 16);
                }
                entv = entn; wv = wn_;
            }
        }
        { char* apo = AT + cur * 2048 + lane * 32; *(u32x4*)apo = c0; *(u32x4*)(apo + 16) = c1; }
#pragma unroll
        for (int k = 0; k < 4; ++k) {
            const int tok = tok0 + k;
            float f[16]; float ss = 0.f;
            const u32x4 e0 = *(const u32x4*)(AT + k * 2048 + lane * 32), e1 = *(const u32x4*)(AT + k * 2048 + lane * 32 + 16);
#pragma unroll
            for (int i = 0; i < 8; ++i) { const unsigned cw = i < 4 ? e0[i] : e1[i - 4]; const h16x2 hv = as_h2(cw);
                f[2 * i] = (float)hv[0] * (1.f / V_SCALE); f[2 * i + 1] = (float)hv[1] * (1.f / V_SCALE); ss += f[2 * i] * f[2 * i] + f[2 * i + 1] * f[2 * i + 1]; }
            ss = wave_sum_bcast(ss);
            const float rinv = rsqrtf(ss * (1.f / DM) + EPS);
            const float* g2 = mod + (size_t)(tok >> 11) * 6144 + 5120;
#pragma unroll
            for (int q4 = 0; q4 < 4; ++q4) {
                const int c = lane * 16 + q4 * 4;
                float* op = a.out + (size_t)tok * DM + c;
                const f32x4 xm = *(const f32x4*)op, g2v = *(const f32x4*)(g2 + c), gp = *(const f32x4*)(a.in[I_GPOSTFFN] + c);
                f32x4 o;
#pragma unroll
                for (int jj = 0; jj < 4; ++jj) o[jj] = xm[jj] + g2v[jj] * (f[q4 * 4 + jj] * rinv * gp[jj]);
                *(f32x4*)op = o; }
        }
    }
}

#ifdef DBG_DIGEST
__device__ void phase_digest(const Args& a, int vb, int nb) {
    const bf16_t* A2 = (const bf16_t*)(a.ws + WS_A2);
    const bf16_t* Q = (const bf16_t*)(a.ws + WS_Q); const bf16_t* K = (const bf16_t*)(a.ws + WS_K); const bf16_t* VV = (const bf16_t*)(a.ws + WS_VV);
    const bf16_t* L = (const bf16_t*)(a.ws + WS_L); const bf16_t* ZG = (const bf16_t*)(a.ws + WS_ZG);
    for (size_t e = (size_t)vb * NTHR + threadIdx.x; e < (size_t)NTOK * DM; e += (size_t)nb * NTHR) {
        float v = 0.f;
#if DBG_DIGEST == 3
        const size_t row = e >> 10; const int c = (int)(e & 1023);
        v = bf2f(A2[row * KOUT + c]); if (c < 512) v += bf2f(A2[row * KOUT + 1024 + c]);
#elif DBG_DIGEST == 2
        const size_t h = e % ((size_t)NTOK * 512);
        v = bf2f(Q[h]) + bf2f(ZG[h]) + bf2f(L[e % ((size_t)NB * STOT * 512)]);
        if (e < (size_t)NB * 2 * STOT * 64) v += bf2f(K[e]) + bf2f(VV[e]);
#endif
        a.out[e] = v; }
}
#endif
constexpr int LDS_BYTES = 155648;
constexpr int LDS_BARST = LDS_BYTES - 16;
static_assert(8 * P7_WLDS <= LDS_BARST && PK_END <= LDS_BARST && LR_END <= LDS_BARST && g8::SHM_B <= LDS_BARST && 17 * 1024 * 4 + 17 * 24 * 4 <= LDS_BARST, "LDS budget");
constexpr int N_PHASES = 8;

__global__ void __launch_bounds__(NTHR, 2) mk_fwd(Args a) {
    extern __shared__ __attribute__((aligned(16))) char lds[];
    const int nb = gridDim.x, bx = blockIdx.x;
    const int vb0 = (nb % 8 == 0) ? (bx % 8) * (nb / 8) + bx / 8 : bx;
    XcdBarrier bar; bar.bar = (unsigned*)(a.ws + WS_CTL); bar.x = 0; bar.st = (volatile LAS unsigned*)(LAS char*)(lds + LDS_BARST);
    const bool multi = (a.ph_hi - a.ph_lo) > 1;
    if (multi) {
        if (threadIdx.x < 4) ((volatile LAS unsigned*)(LAS char*)(lds + LDS_BARST))[threadIdx.x] = 0u;
        __syncthreads();
        bar = xcd_barrier_post((unsigned*)(a.ws + WS_CTL), (volatile LAS unsigned*)(LAS char*)(lds + LDS_BARST));
    }
#ifndef P7_PROBE
#define P7_PROBE -1
#endif
#ifndef DBL_PHASE
#define DBL_PHASE 0
#endif
#if DBL_PHASE != 0
#define RUN_PHASE(P, CALL) do { if (a.ph_lo <= (P) && (P) < a.ph_hi) { const int nrep_ = ((a.dbl >> (P)) & 1) ? 2 : 1; for (int rep_ = 0; rep_ < nrep_; ++rep_) { CALL; if ((P) + 1 < a.ph_hi || rep_ + 1 < nrep_) xcd_barrier(bar); } } } while (0)
#else
#define RUN_PHASE(P, CALL) do { if (a.ph_lo <= (P) && (P) < a.ph_hi) { CALL; if ((P) + 1 < a.ph_hi) xcd_barrier(bar); } } while (0)
#endif
#if !defined(ONLY_PHASE) || ONLY_PHASE == 0
    RUN_PHASE(0, phase_prep(a, lds, vb0, nb));
#endif
    int vb = vb0;
    if (multi && a.ph_lo == 0 && a.ph_hi > 1) {
        if (threadIdx.x == 0) { unsigned off = 0; for (unsigned j = 0; j < bar.x; ++j) off += xb_ld(&bar.bar[XB_XCNT(j)]); bar.st[3] = off + bar.st[2]; }
        __syncthreads();
        vb = (int)bar.st[3];
    }
#if !defined(ONLY_PHASE) || ONLY_PHASE == 1
    RUN_PHASE(1, phase_xn(a, vb, nb));
#endif
#if !defined(ONLY_PHASE) || ONLY_PHASE == 2
    RUN_PHASE(2, phase_inproj(a, lds, vb, nb));
#endif
#if (!defined(ONLY_PHASE) || ONLY_PHASE == 3) && !(defined(DBG_DIGEST) && DBG_DIGEST == 2)
    RUN_PHASE(3, phase_mixer(a, lds, vb, nb));
#endif
#ifdef DBG_DIGEST
    if (a.ph_lo <= 4 && 4 < a.ph_hi) phase_digest(a, vb, nb);
    return;
#endif
#if !defined(ONLY_PHASE) || ONLY_PHASE == 4
    RUN_PHASE(4, phase_outproj(a, lds, vb, nb));
#endif
#if !defined(ONLY_PHASE) || ONLY_PHASE == 5
    RUN_PHASE(5, phase_rowpass(a, vb, nb));
#endif
#if !defined(ONLY_PHASE) || ONLY_PHASE == 6
    RUN_PHASE(6, phase_peer_topk(a, lds, vb, nb));
#endif
#if !defined(ONLY_PHASE) || ONLY_PHASE == 7
    RUN_PHASE(7, phase_peer_gather(a, lds, vb, nb));
#endif
}

extern "C" void kernel_launch(void* const* d_in, const int* in_sizes, int n_in, void* d_out, int out_size, void* d_ws, size_t ws_size, hipStream_t stream) {
    static int grid = 0;
    if (grid == 0) {
        if (n_in != 25 || out_size != NTOK * DM || ws_size < WS_END) { fprintf(stderr, "kernel_launch: unexpected shapes (n_in %d, out %d, ws %zu, need %zu)\n", n_in, out_size, ws_size, (size_t)WS_END); grid = -1; return; }
        int dev = 0, cus = 0;
        if (hipGetDevice(&dev) != hipSuccess || hipDeviceGetAttribute(&cus, hipDeviceAttributeMultiprocessorCount, dev) != hipSuccess) { grid = -1; return; }
        if (hipFuncSetAttribute((const void*)mk_fwd, hipFuncAttributeMaxDynamicSharedMemorySize, LDS_BYTES) != hipSuccess) { fprintf(stderr, "kernel_launch: hipFuncSetAttribute failed\n"); grid = -1; return; }
        (void)hipGetLastError();
        grid = cus;
    }
    if (grid < 0) return;
    (void)hipMemsetAsync((char*)d_ws + WS_CTL, 0, CTL_BYTES, stream);
    Args a{};
    for (int i = 0; i < 25; ++i) a.in[i] = (const float*)d_in[i];
    a.out = (float*)d_out; a.ws = (unsigned char*)d_ws; a.dbl = DBL_PHASE; a.probe = P7_PROBE;
#if MK_N_LAUNCHES == 1
    a.ph_lo = 0; a.ph_hi = N_PHASES;
    hipLaunchKernelGGL(mk_fwd, dim3(grid), dim3(NTHR), LDS_BYTES, stream, a);
#else
    for (int ph = 0; ph < N_PHASES; ++ph) { a.ph_lo = ph; a.ph_hi = ph + 1; hipLaunchKernelGGL(mk_fwd, dim3(grid), dim3(NTHR), LDS_BYTES, stream, a); }
#endif
}
```

```cpp
#include <hip/hip_runtime.h>
#include <cstdio>
#include <cstdint>

#ifndef MK_N_LAUNCHES
#define MK_N_LAUNCHES 1
#endif

typedef unsigned short bf16_t;
typedef short bf16x8 __attribute__((ext_vector_type(8)));
typedef float f32x16 __attribute__((ext_vector_type(16)));
typedef float f32x4 __attribute__((ext_vector_type(4)));
typedef float f32x2 __attribute__((ext_vector_type(2)));
typedef unsigned u32x4 __attribute__((ext_vector_type(4)));
typedef unsigned u32x2 __attribute__((ext_vector_type(2)));
typedef int i32x8 __attribute__((ext_vector_type(8)));
typedef int i32x4 __attribute__((ext_vector_type(4)));
#define LAS __attribute__((address_space(3)))

constexpr int DM = 1024, NB = 16, SEQ = 2048, CTX = 256, STOT = SEQ + CTX;
constexpr int NTOK = NB * SEQ;
constexpr int NCTX = NB * CTX;
constexpr int NROWS = NTOK + NCTX;
constexpr int DIN = 1792, DLRU = 512;
constexpr int KOUT = 1536;
constexpr int PEER_N = 16384;
constexpr float EPS = 1e-6f;
constexpr int NTHR = 512;

constexpr size_t al256(size_t x) { return (x + 255) & ~(size_t)255; }
constexpr size_t WS_CTL   = 0;
constexpr size_t CTL_BYTES = 65536;
constexpr size_t WS_MOD   = WS_CTL + CTL_BYTES;
constexpr size_t WS_ROPE  = WS_MOD + al256(17 * 6144 * 4);
constexpr size_t WS_WIN   = WS_ROPE + al256(64 * 16 * 2 * 4);
constexpr size_t WS_WOUT  = WS_WIN + al256((size_t)DIN * DM * 2);
constexpr size_t WS_WQ    = WS_WOUT + al256((size_t)DM * KOUT * 2);
constexpr size_t WS_SUBK  = WS_WQ + al256((size_t)2048 * DM * 2);
constexpr size_t WS_RGW   = WS_SUBK + al256((size_t)8 * 2 * 128 * 128 * 2);
constexpr size_t WS_UT    = WS_RGW + al256((size_t)2 * 8 * 128 * 64 * 2);
constexpr size_t WS_VT    = WS_UT + al256((size_t)PEER_N * DM * 2);
constexpr size_t WS_XN    = WS_VT + al256((size_t)PEER_N * DM * 2);
constexpr size_t WS_Q     = WS_XN + al256((size_t)NROWS * DM * 2);
constexpr size_t WS_K     = WS_Q + al256((size_t)NTOK * 512 * 2);
constexpr size_t WS_VV    = WS_K + al256((size_t)NB * 2 * STOT * 64 * 2);
constexpr size_t WS_L     = WS_VV + al256((size_t)NB * 2 * STOT * 64 * 2);
constexpr size_t WS_ZG    = WS_L + al256((size_t)NB * STOT * DLRU * 2);
constexpr size_t WS_A2    = WS_ZG + al256((size_t)NTOK * DLRU * 2);
constexpr size_t WS_END   = WS_A2 + al256((size_t)NTOK * KOUT * 2);
constexpr size_t WS_MIX   = WS_XN;
constexpr size_t WS_HX2   = WS_A2;
constexpr size_t WS_IDX   = WS_ZG;
constexpr size_t WS_GATE  = WS_ZG + (size_t)NTOK * 128 * 4;
static_assert(WS_MIX + (size_t)NTOK * DM * 4 <= WS_ZG, "MIX overlay must end before ZG");
static_assert(WS_GATE + (size_t)NTOK * 128 * 4 <= WS_A2, "IDX/GATE overlay must end before A2");

typedef __bf16 bf16x2_t __attribute__((ext_vector_type(2)));
__device__ __forceinline__ unsigned pk2(float lo, float hi) { const f32x2 v = {lo, hi}; const bf16x2_t b = __builtin_convertvector(v, bf16x2_t); return __builtin_bit_cast(unsigned, b); }
typedef _Float16 h16x2 __attribute__((ext_vector_type(2)));
constexpr float V_SCALE = 64.f;
constexpr float T_SCALE = 256.f;
#ifndef P7_FP8
#define P7_FP8 1
#endif
__device__ __forceinline__ unsigned pkh2(float lo, float hi) { const h16x2 h = {(_Float16)lo, (_Float16)hi}; return __builtin_bit_cast(unsigned, h); }
__device__ __forceinline__ bf16x2_t as_bf2(unsigned x) { return __builtin_bit_cast(bf16x2_t, x); }
__device__ __forceinline__ h16x2 as_h2(unsigned x) { return __builtin_bit_cast(h16x2, x); }
__device__ __forceinline__ bf16_t f2bf(float f) { return (bf16_t)(pk2(f, 0.f) & 0xffffu); }
__device__ __forceinline__ float bf2f(unsigned h) { return __uint_as_float(h << 16); }
__device__ __forceinline__ float bflo(unsigned w) { return __uint_as_float(w << 16); }
__device__ __forceinline__ float bfhi(unsigned w) { return __uint_as_float(w & 0xffff0000u); }
__device__ __forceinline__ float sat8(float x) { return fminf(fmaxf(x, -448.f), 448.f); }
__device__ __forceinline__ float fast_rcp(float x) { return __builtin_amdgcn_rcpf(x); }
__device__ __forceinline__ float sigmoidf_(float x) { return fast_rcp(1.f + __expf(-x)); }
__device__ __forceinline__ float gelu_tanh(float x) { const float y = 0.7978845608028654f * (x + 0.044715f * x * x * x); return x * fast_rcp(1.f + __expf(-2.f * y)); }
__device__ __forceinline__ float silu_(float x) { return x * sigmoidf_(x); }
__device__ __forceinline__ float wave_sum(float v) {
#pragma unroll
    for (int o = 32; o > 0; o >>= 1) v += __shfl_xor(v, o);
    return v;
}
__device__ __forceinline__ float half_swap_max(float v) { auto rr = __builtin_amdgcn_permlane32_swap(__float_as_uint(v), __float_as_uint(v), false, false); return fmaxf(__uint_as_float(rr[0]), __uint_as_float(rr[1])); }
__device__ __forceinline__ float half_swap_sum(float v) { auto rr = __builtin_amdgcn_permlane32_swap(__float_as_uint(v), __float_as_uint(v), false, false); return __uint_as_float(rr[0]) + __uint_as_float(rr[1]); }
#define MFMA(a, b, c) __builtin_amdgcn_mfma_f32_32x32x16_bf16((a), (b), (c), 0, 0, 0)

#define XB_TMO      128
#define XB_XCNT(j)  (256  + 64 * (j))
#define XB_XSUB(j)  (1280 + 64 * (j))
#define XB_XGEN(j)  (2304 + 64 * (j))
#define XB_TOP      3328
#define XB_TOPGEN   3392
#define XCD_BAR_WORDS 3456
#define XB_SPIN_CAP (1u << 20)
__device__ __forceinline__ unsigned xb_ld(unsigned* p)              { return __hip_atomic_load(p, __ATOMIC_RELAXED, __HIP_MEMORY_SCOPE_AGENT); }
__device__ __forceinline__ unsigned xb_add(unsigned* p, unsigned v) { return __hip_atomic_fetch_add(p, v, __ATOMIC_RELAXED, __HIP_MEMORY_SCOPE_AGENT); }
__device__ __forceinline__ unsigned xb_xcc_id() { return (unsigned)__builtin_amdgcn_s_getreg((3 << 11) | 20) & 0xFu; }
#define XB_SPIN(cond, bar) do { unsigned _sp = 0; while (cond) { __builtin_amdgcn_s_sleep(1); \
    if ((++_sp & 255u) == 0u) { if (xb_ld(&(bar)[XB_TMO])) break; if (_sp > XB_SPIN_CAP) { atomicAdd(&(bar)[XB_TMO], 1u); break; } } } } while (0)
struct XcdBarrier { unsigned* bar; unsigned x; volatile LAS unsigned* st; };
__device__ __forceinline__ XcdBarrier xcd_barrier_post(unsigned* bar, volatile LAS unsigned* st) {
    XcdBarrier b; b.bar = bar; b.x = xb_xcc_id(); b.st = st;
    if (threadIdx.x == 0) st[2] = xb_add(&bar[XB_XCNT(b.x)], 1u);
    return b;
}
__device__ __forceinline__ void xcd_barrier_complete(unsigned* bar, unsigned x, unsigned& nloc, unsigned& nx) {
    const unsigned G = gridDim.x * gridDim.y * gridDim.z;
    unsigned sum, cnt, mine, sp = 0u;
    for (;;) {
        sum = 0u; cnt = 0u; mine = 0u;
#pragma unroll
        for (unsigned j = 0; j < 16; ++j) { const unsigned c = xb_ld(&bar[XB_XCNT(j)]); sum += c; cnt += (c > 0u) ? 1u : 0u; mine = (j == x) ? c : mine; }
        if (sum == G) break;
        __builtin_amdgcn_s_sleep(1);
        if ((++sp & 255u) == 0u) { if (xb_ld(&bar[XB_TMO])) break; if (sp > XB_SPIN_CAP) { atomicAdd(&bar[XB_TMO], 1u); break; } }
    }
    nloc = mine > 0u ? mine : 1u; nx = cnt > 0u ? cnt : 1u;
}
__device__ __forceinline__ void xcd_barrier(const XcdBarrier& b) {
    asm volatile("s_waitcnt vmcnt(0)" ::: "memory");
    __syncthreads();
    if (threadIdx.x == 0) {
        unsigned* bar = b.bar;
        __builtin_amdgcn_s_waitcnt(0);
        unsigned nloc = b.st[0], nx = b.st[1];
        if (nloc == 0u) { xcd_barrier_complete(bar, b.x, nloc, nx); b.st[0] = nloc; b.st[1] = nx; }
        const unsigned old = xb_add(&bar[XB_XSUB(b.x)], 1u);
        const unsigned gen = old / nloc;
        if (old + 1u == (gen + 1u) * nloc) {
            __builtin_amdgcn_fence(__ATOMIC_RELEASE, "agent");
            asm volatile("s_waitcnt vmcnt(0)" ::: "memory");
            const unsigned og = xb_add(&bar[XB_TOP], 1u);
            const unsigned tg = og / nx;
            if (og + 1u == (tg + 1u) * nx) xb_add(&bar[XB_TOPGEN], 1u);
            else XB_SPIN(xb_ld(&bar[XB_TOPGEN]) == tg, bar);
            __builtin_amdgcn_fence(__ATOMIC_ACQUIRE, "agent");
            xb_add(&bar[XB_XGEN(b.x)], 1u);
            asm volatile("s_waitcnt vmcnt(0)" ::: "memory");
        } else {
            XB_SPIN(xb_ld(&bar[XB_XGEN(b.x)]) == gen, bar);
            __builtin_amdgcn_fence(__ATOMIC_ACQUIRE, "agent");
            asm volatile("s_waitcnt vmcnt(0)" ::: "memory");
        }
    }
    __syncthreads();
}

struct Args { const float* in[25]; float* out; unsigned char* ws; int ph_lo, ph_hi, dbl, probe; };
enum { I_X = 0, I_C, I_CTX, I_CCTX, I_WMOD, I_BMOD, I_GPREMIX, I_GPOSTMIX, I_GPREFFN, I_GPOSTFFN, I_WIN, I_QNG, I_KNG, I_CONVW, I_CONVB,
       I_RGWA, I_RGBA, I_RGWI, I_RGBI, I_RGLAM, I_WOUT, I_PWQ, I_PSUBK, I_PU, I_PV };

__device__ __forceinline__ void tr_tile(const float* __restrict__ src, int lds_, int sr0, int sc0, bf16_t* __restrict__ dst, int ldd, int dr0, int dc0, float* T) {
    const int tid = threadIdx.x;
#pragma unroll
    for (int i = 0; i < 8; ++i) { const int e = tid + NTHR * i, r = e >> 6, c = e & 63; T[r * 65 + c] = src[(size_t)(sr0 + r) * lds_ + sc0 + c]; }
    __syncthreads();
#pragma unroll
    for (int i = 0; i < 8; ++i) { const int e = tid + NTHR * i, c = e >> 6, r = e & 63; dst[(size_t)(dr0 + c) * ldd + dc0 + r] = f2bf(T[r * 65 + c]); }
    __syncthreads();
}

__device__ void phase_prep(const Args& a, char* lds, int vb, int nb) {
    const int tid = threadIdx.x;
    unsigned char* ws = a.ws;
    float* S = (float*)lds;
    float* T = (float*)lds;
    constexpr int N_MOD = 256, N_TIN = 448, N_TOUT = 384, N_TWQ = 512, N_RGW = 32, N_SUBK = 16, N_UV = 512, N_MISC = 1;
    constexpr int O_TIN = N_MOD, O_TOUT = O_TIN + N_TIN, O_TWQ = O_TOUT + N_TOUT, O_RGW = O_TWQ + N_TWQ, O_SUBK = O_RGW + N_RGW, O_UV = O_SUBK + N_SUBK, O_MISC = O_UV + N_UV, N_ALL = O_MISC + N_MISC;
    for (int it = vb; it < N_ALL; it += nb) {
        if (it < O_TIN) {
            for (int e = tid; e < 17 * 1024; e += NTHR) { const int r = e >> 10, k = e & 1023; const float v = (r < 16) ? a.in[I_C][r * 1024 + k] : a.in[I_CCTX][k]; S[e] = silu_(v); }
            __syncthreads();
            const int n0 = it * 24;
            const int cc = tid % 6, kk = tid / 6;
            float acc[17][4];
#pragma unroll
            for (int r = 0; r < 17; ++r) { acc[r][0] = 0.f; acc[r][1] = 0.f; acc[r][2] = 0.f; acc[r][3] = 0.f; }
            if (tid < 510) {
                for (int k = kk; k < 1024; k += 85) {
                    const f32x4 w = *(const f32x4*)(a.in[I_WMOD] + (size_t)k * 6144 + n0 + cc * 4);
#pragma unroll
                    for (int r = 0; r < 17; ++r) { const float s = S[r * 1024 + k]; acc[r][0] += s * w[0]; acc[r][1] += s * w[1]; acc[r][2] += s * w[2]; acc[r][3] += s * w[3]; }
                }
            }
            __syncthreads();
            if (tid < 510) {
#pragma unroll
                for (int r = 0; r < 17; ++r) { f32x4 v = {acc[r][0], acc[r][1], acc[r][2], acc[r][3]}; *(f32x4*)(S + (kk * 17 + r) * 24 + cc * 4) = v; }
            }
            __syncthreads();
            float* mod = (float*)(ws + WS_MOD);
            for (int e = tid; e < 17 * 24; e += NTHR) { const int r = e / 24, j = e % 24; float sum = 0.f;
                for (int q = 0; q < 85; ++q) sum += S[(q * 17 + r) * 24 + j];
                mod[r * 6144 + n0 + j] = sum + a.in[I_BMOD][n0 + j]; }
            __syncthreads();
        } else if (it < O_TOUT) {
            const int t = it - O_TIN, kt = t / 28, nt = t % 28;
            tr_tile(a.in[I_WIN], DIN, kt * 64, nt * 64, (bf16_t*)(ws + WS_WIN), DM, nt * 64, kt * 64, T);
        } else if (it < O_TWQ) {
            const int t = it - O_TOUT, kt = t / 16, nt = t % 16;
            const int sk = (kt < 16) ? kt * 64 : (kt - 16) * 64 + 512;
            tr_tile(a.in[I_WOUT], DM, sk, nt * 64, (bf16_t*)(ws + WS_WOUT), KOUT, nt * 64, kt * 64, T);
        } else if (it < O_RGW) {
            const int t = it - O_TWQ, kt = t / 32, nt = t % 32;
            tr_tile(a.in[I_PWQ], 2048, kt * 64, nt * 64, (bf16_t*)(ws + WS_WQ), DM, nt * 64, kt * 64, T);
        } else if (it < O_SUBK) {
            const int t = it - O_RGW, g = t & 1, dn = t >> 1;
            const float* src = (g == 0 ? a.in[I_RGWA] : a.in[I_RGWI]) + (size_t)dn * 4096;
            tr_tile(src, 64, 0, 0, (bf16_t*)(ws + WS_RGW) + (size_t)dn * 128 * 64 + g * 64 * 64, 64, 0, 0, T);
        } else if (it < O_UV) {
            const int t = it - O_SUBK; const float* src = a.in[I_PSUBK] + (size_t)t * 16384; bf16_t* dst = (bf16_t*)(ws + WS_SUBK) + (size_t)t * 16384;
            for (int e = tid * 4; e < 16384; e += NTHR * 4) { const f32x4 v = *(const f32x4*)(src + e); u32x2 o = {pk2(v[0], v[1]), pk2(v[2], v[3])}; *(u32x2*)(dst + e) = o; }
        } else if (it < O_MISC) {
            const int t = it - O_UV; const bool isv = t >= 256; const int tt = t & 255;
            const float* src = (isv ? a.in[I_PV] : a.in[I_PU]) + (size_t)tt * 65536; bf16_t* dst = (bf16_t*)(ws + (isv ? WS_VT : WS_UT)) + (size_t)tt * 65536;
#if P7_FP8
            unsigned char* d8 = ws + (isv ? WS_VT : WS_UT) + (size_t)tt * 65536;
            for (int e = tid * 16; e < 65536; e += NTHR * 16) { u32x4 o;
#pragma unroll
                for (int q = 0; q < 4; ++q) { f32x4 v = *(const f32x4*)(src + e + q * 4) * T_SCALE;
#pragma unroll
                    for (int i = 0; i < 4; ++i) v[i] = fminf(fmaxf(v[i], -448.f), 448.f);
                    int w = __builtin_amdgcn_cvt_pk_fp8_f32(v[0], v[1], 0, false); w = __builtin_amdgcn_cvt_pk_fp8_f32(v[2], v[3], w, true); o[q] = (unsigned)w; }
                *(u32x4*)(d8 + e) = o; }
#else
            if (!isv) {
                for (int e = tid * 8; e < 65536; e += NTHR * 8) { const f32x4 v0 = *(const f32x4*)(src + e), v1 = *(const f32x4*)(src + e + 4);
                    u32x4 o = {pk2(v0[0], v0[1]), pk2(v0[2], v0[3]), pk2(v1[0], v1[1]), pk2(v1[2], v1[3])}; *(u32x4*)(dst + e) = o; }
            } else {
                for (int e = tid * 8; e < 65536; e += NTHR * 8) { const f32x4 v0 = *(const f32x4*)(src + e) * V_SCALE, v1 = *(const f32x4*)(src + e + 4) * V_SCALE;
                    u32x4 o = {pkh2(v0[0], v0[1]), pkh2(v0[2], v0[3]), pkh2(v1[0], v1[1]), pkh2(v1[2], v1[3])}; *(u32x4*)(dst + e) = o; }
            }
#endif
        } else {
            float* rope = (float*)(ws + WS_ROPE);
            for (int e = tid; e < 64 * 16; e += NTHR) { const int pos = e >> 4, f = e & 15; const float inv = powf(10000.f, -(float)f / 16.f); const float ang = (float)pos * inv; rope[e * 2] = cosf(ang); rope[e * 2 + 1] = sinf(ang); }
        }
    }
}

__device__ void phase_xn(const Args& a, int vb, int nb) {
    const int tid = threadIdx.x, lane = tid & 63, wid = tid >> 6;
    const float* mod = (const float*)(a.ws + WS_MOD);
    bf16_t* XN = (bf16_t*)(a.ws + WS_XN);
    const float* g = a.in[I_GPREMIX];
    for (int row = vb * 8 + wid; row < NROWS; row += nb * 8) {
        const float* src; int mrow;
        if (row < NTOK) { src = a.in[I_X] + (size_t)row * DM; mrow = row >> 11; } else { src = a.in[I_CTX] + (size_t)(row - NTOK) * DM; mrow = 16; }
        f32x4 v[4]; float ss = 0.f;
#pragma unroll
        for (int i = 0; i < 4; ++i) { v[i] = *(const f32x4*)(src + i * 256 + lane * 4); ss += v[i][0] * v[i][0] + v[i][1] * v[i][1] + v[i][2] * v[i][2] + v[i][3] * v[i][3]; }
        ss = wave_sum(ss);
        const float rinv = rsqrtf(ss * (1.f / DM) + EPS);
        const float* sh = mod + (size_t)mrow * 6144, *sc = sh + 1024;
#pragma unroll
        for (int i = 0; i < 4; ++i) { const int c = i * 256 + lane * 4;
            const f32x4 gg = *(const f32x4*)(g + c), s1 = *(const f32x4*)(sc + c), s0 = *(const f32x4*)(sh + c);
            float o[4];
#pragma unroll
            for (int j = 0; j < 4; ++j) o[j] = v[i][j] * rinv * gg[j] * (1.f + s1[j]) + s0[j];
            u32x2 w = {pk2(o[0], o[1]), pk2(o[2], o[3])}; *(u32x2*)(XN + (size_t)row * DM + c) = w; }
    }
}

constexpr int E_PITCH = 272;
namespace g8 {
constexpr int BM = 256, BK = 64, HALF = 128, HT = HALF * BK, SHM_B = 8 * HT * 2;
__device__ __forceinline__ int lds_byte(int r, int c) { const int st = (r >> 4) * 2 + (c >> 5), rr = r & 15, cc = c & 31, ob = rr * 64 + cc * 2; return st * 1024 + (ob ^ (((ob >> 9) & 1) << 5)); }
__device__ __forceinline__ void stage_rc(int b, int& R, int& C) { const int st = b / 1024, sb = b % 1024, swz = sb ^ (((sb >> 9) & 1) << 5); R = (st >> 1) * 16 + swz / 64; C = (st & 1) * 32 + (swz % 64) / 2; }
__device__ __forceinline__ void core(f32x4 (&acc)[2][2][4][2], const bf16_t* __restrict__ A, const bf16_t* __restrict__ Bt, int brow, int bcol, int K, char* lds_) {
    LAS unsigned char* lds = (LAS unsigned char*)lds_;
    const int tid = threadIdx.x, wid = __builtin_amdgcn_readfirstlane(tid >> 6), lane = tid & 63, wr = wid >> 2, wc = wid & 3, fr = lane & 15, fq = lane >> 4;
    constexpr int HTB = HT * 2;
    unsigned voff[2];
#pragma unroll
    for (int i = 0; i < 2; ++i) { int R, C; stage_rc(tid * 16 + i * 8192, R, C); voff[i] = (unsigned)(R * K + C) * 2u; }
    const size_t kstep = (size_t)(BK * 2), hstep = (size_t)HALF * K * 2;
    const unsigned ldsw = (unsigned)wid * 1024u;
    const int aoff = lds_byte(wr * 64 + fr, fq * 8), boff = lds_byte(wc * 32 + fr, fq * 8);
#define G8_SA(b, h) (((b) * 2 + (h)) * HTB)
#define G8_SB(b, h) ((4 + (b) * 2 + (h)) * HTB)
#define G8_STAGE(bufoff, gbase) do { _Pragma("unroll") for (int _i = 0; _i < 2; ++_i) \
        __builtin_amdgcn_global_load_lds((const unsigned*)((const char*)(gbase) + voff[_i]), (LAS unsigned*)(lds + (bufoff) + ldsw + _i * 8192), 16, 0, 0); } while (0)
#define G8_LDA(dst, b, h) do { _Pragma("unroll") for (int m = 0; m < 4; ++m) _Pragma("unroll") for (int k = 0; k < 2; ++k) dst[m][k] = *(const LAS bf16x8*)(lds + G8_SA(b, h) + aoff + m * 2048 + k * 1024); } while (0)
#define G8_LDB(dst, b, h) do { _Pragma("unroll") for (int n = 0; n < 2; ++n) _Pragma("unroll") for (int k = 0; k < 2; ++k) dst[n][k] = *(const LAS bf16x8*)(lds + G8_SB(b, h) + boff + n * 2048 + k * 1024); } while (0)
#define G8_MMA(ai, bj, At_, Bt_) do { __builtin_amdgcn_s_setprio(1); \
    _Pragma("unroll") for (int m = 0; m < 4; ++m) _Pragma("unroll") for (int n = 0; n < 2; ++n) _Pragma("unroll") for (int k = 0; k < 2; ++k) \
      acc[ai][bj][m][n] = __builtin_amdgcn_mfma_f32_16x16x32_bf16(At_[m][k], Bt_[n][k], acc[ai][bj][m][n], 0, 0, 0); \
    __builtin_amdgcn_s_setprio(0); } while (0)
#define G8_WAIT_V(n) asm volatile("s_waitcnt vmcnt(" #n ")" ::: "memory")
#define G8_WAIT_L(n) asm volatile("s_waitcnt lgkmcnt(" #n ")" ::: "memory")
#define G8_BAR __builtin_amdgcn_s_barrier()
#define G8_SCHED __builtin_amdgcn_sched_barrier(0)
#pragma unroll
    for (int ai = 0; ai < 2; ++ai)
#pragma unroll
        for (int bj = 0; bj < 2; ++bj)
#pragma unroll
            for (int m = 0; m < 4; ++m)
#pragma unroll
                for (int n = 0; n < 2; ++n) acc[ai][bj][m][n] = (f32x4){0.f, 0.f, 0.f, 0.f};
    bf16x8 At[4][2], B0[2][2], B1[2][2];
    const int nt = K / BK;
    const char* cA = (const char*)(A + (size_t)brow * K); const char* cB = (const char*)(Bt + (size_t)bcol * K);
    G8_STAGE(G8_SB(0, 0), cB); G8_STAGE(G8_SA(0, 0), cA); G8_STAGE(G8_SB(0, 1), cB + hstep); G8_STAGE(G8_SA(0, 1), cA + hstep);
    if (wr == 1) G8_BAR;
    G8_WAIT_V(4); G8_BAR;
    G8_STAGE(G8_SB(1, 0), cB + kstep); G8_STAGE(G8_SA(1, 0), cA + kstep); G8_STAGE(G8_SB(1, 1), cB + hstep + kstep);
    G8_WAIT_V(6); G8_BAR;
#pragma unroll 1
    for (int t = 0; t < nt - 2; t += 2) {
        const char* a1 = cA + (size_t)(t + 1) * kstep; const char* a2 = cA + (size_t)(t + 2) * kstep; const char* b2 = cB + (size_t)(t + 2) * kstep;
        const char* a3 = a2 + kstep; const char* b3 = b2 + kstep;
        G8_LDB(B0, 0, 0); G8_SCHED; G8_LDA(At, 0, 0); G8_STAGE(G8_SA(1, 1), a1 + hstep);
        G8_WAIT_L(8); G8_BAR; G8_WAIT_L(0); G8_MMA(0, 0, At, B0); G8_BAR; G8_SCHED;
        G8_LDB(B1, 0, 1); G8_STAGE(G8_SB(0, 0), b2);
        G8_BAR; G8_WAIT_L(0); G8_MMA(0, 1, At, B1); G8_BAR;
        G8_LDA(At, 0, 1); G8_STAGE(G8_SA(0, 0), a2);
        G8_BAR; G8_WAIT_L(0); G8_MMA(1, 0, At, B0); G8_BAR; G8_SCHED;
        G8_STAGE(G8_SB(0, 1), b2 + hstep);
        G8_WAIT_V(6); G8_BAR; G8_MMA(1, 1, At, B1); G8_BAR;
        G8_LDB(B0, 1, 0); G8_SCHED; G8_LDA(At, 1, 0); G8_STAGE(G8_SA(0, 1), a2 + hstep);
        G8_WAIT_L(8); G8_BAR; G8_WAIT_L(0); G8_MMA(0, 0, At, B0); G8_BAR; G8_SCHED;
        G8_LDB(B1, 1, 1); G8_STAGE(G8_SB(1, 0), b3);
        G8_BAR; G8_WAIT_L(0); G8_MMA(0, 1, At, B1); G8_BAR;
        G8_LDA(At, 1, 1); G8_STAGE(G8_SA(1, 0), a3);
        G8_BAR; G8_WAIT_L(0); G8_MMA(1, 0, At, B0); G8_BAR; G8_SCHED;
        G8_STAGE(G8_SB(1, 1), b3 + hstep);
        G8_WAIT_V(6); G8_BAR; G8_MMA(1, 1, At, B1); G8_BAR;
    }
    { G8_LDB(B0, 0, 0); G8_LDA(At, 0, 0); G8_STAGE(G8_SA(1, 1), cA + (size_t)(nt - 1) * kstep + hstep);
      G8_BAR; G8_WAIT_L(0); G8_MMA(0, 0, At, B0); G8_BAR;
      G8_LDB(B1, 0, 1); G8_BAR; G8_WAIT_L(0); G8_MMA(0, 1, At, B1); G8_BAR;
      G8_LDA(At, 0, 1); G8_WAIT_V(4); G8_BAR; G8_WAIT_L(0); G8_MMA(1, 0, At, B0); G8_MMA(1, 1, At, B1); G8_BAR; }
    { G8_LDB(B0, 1, 0); G8_LDA(At, 1, 0); G8_WAIT_V(2); G8_BAR; G8_WAIT_L(0); G8_MMA(0, 0, At, B0); G8_BAR;
      G8_LDB(B1, 1, 1); G8_WAIT_V(0); G8_BAR; G8_WAIT_L(0); G8_MMA(0, 1, At, B1); G8_BAR;
      G8_LDA(At, 1, 1); G8_BAR; G8_WAIT_L(0); G8_MMA(1, 0, At, B0); G8_MMA(1, 1, At, B1); G8_BAR; }
    if (wr == 0) G8_BAR;
#undef G8_SA
#undef G8_SB
#undef G8_STAGE
#undef G8_LDA
#undef G8_LDB
#undef G8_MMA
#undef G8_WAIT_V
#undef G8_WAIT_L
#undef G8_BAR
#undef G8_SCHED
}
}

__device__ void phase_inproj(const Args& a, char* lds, int vb, int nb) {
    const int tid = threadIdx.x, lane = tid & 63, wid = tid >> 6, wr = wid >> 2, wc = wid & 3, fr = lane & 15, fq = lane >> 4;
    unsigned char* ws = a.ws;
    const bf16_t* XN = (const bf16_t*)(ws + WS_XN);
    const bf16_t* WIN = (const bf16_t*)(ws + WS_WIN);
    const float* rope = (const float*)(ws + WS_ROPE);
    bf16_t* Qo = (bf16_t*)(ws + WS_Q); bf16_t* Ko = (bf16_t*)(ws + WS_K); bf16_t* Vo = (bf16_t*)(ws + WS_VV); bf16_t* Lo = (bf16_t*)(ws + WS_L); bf16_t* Zo = (bf16_t*)(ws + WS_ZG);
    constexpr int N_LAT = 128 * 7, N_ALL = N_LAT + 16 * 3;
#pragma unroll 1
    for (int it = vb; it < N_ALL; it += nb) {
        int tt, ft;
        if (it < N_LAT) { tt = it / 7; ft = it % 7; } else { const int j = it - N_LAT; tt = 128 + j / 3; ft = 2 + j % 3; }
        f32x4 acc[2][2][4][2];
        g8::core(acc, WIN, XN, ft * 256, tt * 256, DM, lds);
        const bool lat = tt < 128;
#pragma unroll
        for (int ai = 0; ai < 2; ++ai) {
            const int g64 = ft * 4 + ai * 2 + wr;
            if (g64 < 10) {
                const bool isq = g64 < 8;
                const float* gn = isq ? a.in[I_QNG] : a.in[I_KNG];
                const float osc = isq ? 0.125f * 1.4426950408889634f : 1.f;
                float gnv[4][4];
#pragma unroll
                for (int m = 0; m < 4; ++m) { const f32x4 gv = *(const f32x4*)(gn + m * 16 + fq * 4); gnv[m][0] = gv[0]; gnv[m][1] = gv[1]; gnv[m][2] = gv[2]; gnv[m][3] = gv[3]; }
#pragma unroll
                for (int bj = 0; bj < 2; ++bj)
#pragma unroll
                    for (int n = 0; n < 2; ++n) {
                        float ss = 0.f;
#pragma unroll
                        for (int m = 0; m < 4; ++m)
#pragma unroll
                            for (int j = 0; j < 4; ++j) ss += acc[ai][bj][m][n][j] * acc[ai][bj][m][n][j];
                        ss += __shfl_xor(ss, 16); ss += __shfl_xor(ss, 32);
                        const float rinv = rsqrtf(ss * (1.f / 64.f) + EPS);
                        const int row = tt * 256 + bj * 128 + wc * 32 + n * 16 + fr;
                        int b, t, s_; if (lat) { b = row >> 11; t = row & 2047; s_ = CTX + t; } else { const int rc = row - NTOK; b = rc >> 8; t = 0; s_ = rc & 255; }
                        bf16_t* dst = isq ? Qo + ((size_t)(b * 8 + g64) * SEQ + t) * 64 : Ko + ((size_t)(b * 2 + (g64 - 8)) * STOT + s_) * 64;
#pragma unroll
                        for (int ax = 0; ax < 2; ++ax) {
                            const int pos = ax == 0 ? (t >> 6) : (t & 63);
                            float o1[4], o2[4];
#pragma unroll
                            for (int j = 0; j < 4; ++j) {
                                const float x1 = acc[ai][bj][2 * ax][n][j] * rinv * gnv[2 * ax][j], x2 = acc[ai][bj][2 * ax + 1][n][j] * rinv * gnv[2 * ax + 1][j];
                                float c1 = x1, c2 = x2;
                                if (lat) { const f32x2 cs = *(const f32x2*)(rope + (pos * 16 + fq * 4 + j) * 2); c1 = x1 * cs[0] - x2 * cs[1]; c2 = x1 * cs[1] + x2 * cs[0]; }
                                o1[j] = c1 * osc; o2[j] = c2 * osc; }
                            *(u32x2*)(dst + ax * 32 + fq * 4) = (u32x2){pk2(o1[0], o1[1]), pk2(o1[2], o1[3])};
                            *(u32x2*)(dst + ax * 32 + 16 + fq * 4) = (u32x2){pk2(o2[0], o2[1]), pk2(o2[2], o2[3])};
                        }
                    }
            } else if (g64 < 12) {
#pragma unroll
                for (int bj = 0; bj < 2; ++bj)
#pragma unroll
                    for (int n = 0; n < 2; ++n) {
                        const int row = tt * 256 + bj * 128 + wc * 32 + n * 16 + fr;
                        int b, s_; if (lat) { b = row >> 11; s_ = CTX + (row & 2047); } else { const int rc = row - NTOK; b = rc >> 8; s_ = rc & 255; }
                        bf16_t* vp = Vo + ((size_t)(b * 2 + (g64 - 10)) * 64) * STOT + s_;
#pragma unroll
                        for (int m = 0; m < 4; ++m)
#pragma unroll
                            for (int j = 0; j < 4; ++j) vp[(size_t)(m * 16 + fq * 4 + j) * STOT] = f2bf(acc[ai][bj][m][n][j]);
                    }
            } else {
                const bool isz = g64 >= 20;
#pragma unroll
                for (int bj = 0; bj < 2; ++bj)
#pragma unroll
                    for (int n = 0; n < 2; ++n) {
                        const int row = tt * 256 + bj * 128 + wc * 32 + n * 16 + fr;
                        bf16_t* dst;
                        if (isz) dst = Zo + (size_t)row * DLRU + (g64 - 20) * 64;
                        else { int b, s_; if (lat) { b = row >> 11; s_ = CTX + (row & 2047); } else { const int rc = row - NTOK; b = rc >> 8; s_ = rc & 255; }
                            dst = Lo + ((size_t)b * STOT + s_) * DLRU + (g64 - 12) * 64; }
#pragma unroll
                        for (int m = 0; m < 4; ++m) { f32x4 v = acc[ai][bj][m][n];
                            if (isz) { v[0] = gelu_tanh(v[0]); v[1] = gelu_tanh(v[1]); v[2] = gelu_tanh(v[2]); v[3] = gelu_tanh(v[3]); }
                            *(u32x2*)(dst + m * 16 + fq * 4) = (u32x2){pk2(v[0], v[1]), pk2(v[2], v[3])}; }
                    }
            }
        }
        __syncthreads();
    }
}

constexpr int AT_KP = 144, AT_VP = 136, AT_STAGE = 64 * AT_KP + 64 * AT_VP;
__device__ void attn_item(const Args& a, char* lds, int b, int head, int qblk) {
    const int tid = threadIdx.x, lane = tid & 63, wid = tid >> 6, r32 = lane & 31, hi = lane >> 5;
    unsigned char* ws = a.ws;
    const int kvh = head >> 2;
    const bf16_t* Qp = (const bf16_t*)(ws + WS_Q) + ((size_t)(b * 8 + head) * SEQ + qblk * 256 + wid * 32 + r32) * 64 + hi * 8;
    const bf16_t* Kp = (const bf16_t*)(ws + WS_K) + (size_t)(b * 2 + kvh) * STOT * 64;
    const bf16_t* Vp = (const bf16_t*)(ws + WS_VV) + (size_t)(b * 2 + kvh) * 64 * STOT;
    bf16x8 qf[4];
#pragma unroll
    for (int ds = 0; ds < 4; ++ds) qf[ds] = *(const bf16x8*)(Qp + ds * 16);
    const int srow = tid >> 3, sch = tid & 7;
    const bf16_t* kg = Kp + (size_t)srow * 64 + sch * 8;
    const bf16_t* vg = Vp + (size_t)srow * STOT + sch * 8;
    u32x4 krA, vrA, krB, vrB;
    f32x16 o[2]; float lsum = 0.f;
    float negM;
    { float gq = fabsf(a.in[I_QNG][lane]), gk = fabsf(a.in[I_KNG][lane]);
#pragma unroll
      for (int o_ = 32; o_ > 0; o_ >>= 1) { gq = fmaxf(gq, __shfl_xor(gq, o_)); gk = fmaxf(gk, __shfl_xor(gk, o_)); }
      negM = -(64.f * 0.125f * 1.4426950408889634f * 1.01f) * gq * gk; }
#pragma unroll
    for (int dt = 0; dt < 2; ++dt)
#pragma unroll
        for (int r = 0; r < 16; ++r) o[dt][r] = 0.f;
    char* KS = lds; char* VS = lds + 2 * 64 * AT_KP;
#define A_LOADK(X, s0) do { kr##X = *(const u32x4*)(kg + (size_t)(s0) * 64); } while (0)
#define A_LOADV(X, s0) do { vr##X = *(const u32x4*)(vg + (s0)); } while (0)
#define A_WRITEK(X, st) do { *(u32x4*)(KS + (st) * 64 * AT_KP + srow * AT_KP + sch * 16) = kr##X; } while (0)
#define A_WRITEV(X, st) do { char* vb_ = VS + (st) * 64 * AT_VP + srow * AT_VP + sch * 16; *(u32x2*)vb_ = (u32x2){vr##X[0], vr##X[1]}; *(u32x2*)(vb_ + 8) = (u32x2){vr##X[2], vr##X[3]}; } while (0)
    constexpr int NT = STOT / 64;
    f32x16 sc[2], sn[2];
    A_LOADK(A, 0); A_LOADV(A, 0); A_WRITEK(A, 0); A_WRITEV(A, 0); A_LOADK(A, 64); A_WRITEK(A, 1); A_LOADK(B, 128); A_LOADV(B, 64); __syncthreads();
#pragma unroll
    for (int kt = 0; kt < 2; ++kt) {
#pragma unroll
        for (int r = 0; r < 16; ++r) sc[kt][r] = negM;
#pragma unroll
        for (int ds = 0; ds < 4; ++ds) { const bf16x8 ka = *(const bf16x8*)(KS + (kt * 32 + r32) * AT_KP + (ds * 16 + hi * 8) * 2); sc[kt] = MFMA(ka, qf[ds], sc[kt]); }
    }
    __syncthreads();
    f32x16 ol;
#pragma unroll
    for (int r = 0; r < 16; ++r) ol[r] = 0.f;
    const u32x4 ones_w = {0x3F803F80u, 0x3F803F80u, 0x3F803F80u, 0x3F803F80u};
    const bf16x8 ones = *(const bf16x8*)&ones_w;
#define A_STEP(J, SC, SN, XW, XL) do { const int j_ = (J); \
        const int jk = (j_ + 3 < NT) ? j_ + 3 : NT - 1, jv = (j_ + 2 < NT) ? j_ + 2 : NT - 1; \
        A_LOADK(XL, jk * 64); A_LOADV(XL, jv * 64); \
        const char* ksn = KS + ((j_ + 1) & 1) * 64 * AT_KP; const char* vs = VS + (j_ & 1) * 64 * AT_VP; \
        _Pragma("unroll") for (int kt = 0; kt < 2; ++kt) { \
            _Pragma("unroll") for (int r = 0; r < 16; ++r) SN[kt][r] = negM; \
            _Pragma("unroll") for (int ds = 0; ds < 4; ++ds) { \
                const bf16x8 ka = *(const bf16x8*)(ksn + (kt * 32 + r32) * AT_KP + (ds * 16 + hi * 8) * 2); \
                SN[kt] = MFMA(ka, qf[ds], SN[kt]); \
                _Pragma("unroll") for (int e = 0; e < 4; ++e) { const int f = (kt * 4 + ds) * 4 + e; SC[f >> 4][f & 15] = __builtin_amdgcn_exp2f(SC[f >> 4][f & 15]); } \
                __builtin_amdgcn_sched_barrier(0); } } \
        _Pragma("unroll") for (int kt = 0; kt < 2; ++kt) \
            _Pragma("unroll") for (int s = 0; s < 2; ++s) { \
                u32x4 pw = {pk2(SC[kt][8 * s], SC[kt][8 * s + 1]), pk2(SC[kt][8 * s + 2], SC[kt][8 * s + 3]), pk2(SC[kt][8 * s + 4], SC[kt][8 * s + 5]), pk2(SC[kt][8 * s + 6], SC[kt][8 * s + 7])}; \
                const bf16x8 pb = *(bf16x8*)&pw; \
                _Pragma("unroll") for (int dt = 0; dt < 2; ++dt) { \
                    const char* vp = vs + (dt * 32 + r32) * AT_VP + (kt * 32 + s * 16 + hi * 4) * 2; \
                    const u32x2 lo = *(const u32x2*)vp, hh = *(const u32x2*)(vp + 16); \
                    u32x4 aw = {lo[0], lo[1], hh[0], hh[1]}; \
                    o[dt] = MFMA(*(bf16x8*)&aw, pb, o[dt]); } \
                ol = MFMA(ones, pb, ol); } \
        A_WRITEK(XW, j_ & 1); A_WRITEV(XW, (j_ + 1) & 1); \
        __syncthreads(); } while (0)
#pragma unroll 1
    for (int j = 0; j < NT; j += 2) { A_STEP(j, sc, sn, B, A); A_STEP(j + 1, sn, sc, A, B); }
#undef A_STEP
    lsum = ol[0];
#undef A_LOADK
#undef A_LOADV
#undef A_WRITEK
#undef A_WRITEV
    const float inv = fast_rcp(lsum);
    bf16_t* outp = (bf16_t*)(ws + WS_A2) + ((size_t)b * SEQ + qblk * 256 + wid * 32 + r32) * KOUT + head * 64;
#pragma unroll
    for (int dt = 0; dt < 2; ++dt)
#pragma unroll
        for (int g = 0; g < 4; ++g) {
            u32x2 v = {pk2(o[dt][4 * g] * inv, o[dt][4 * g + 1] * inv), pk2(o[dt][4 * g + 2] * inv, o[dt][4 * g + 3] * inv)};
            *(u32x2*)(outp + dt * 32 + g * 8 + hi * 4) = v;
        }
}

constexpr int LR_RAW = 0;
constexpr int LR_U   = 33792;
constexpr int LR_BB  = LR_U + 33280;
constexpr int LR_UB  = LR_BB + 33280;
constexpr int LR_WG  = LR_UB + 18432;
constexpr int LR_SEG = LR_WG + 18432;
constexpr int LR_HC  = LR_SEG + 4096;
constexpr int LR_CST = LR_HC + 512;
constexpr int LR_END = LR_CST + 768;
__device__ void lru_item(const Args& a, char* lds, int b, int n, int d) {
    const int tid = threadIdx.x, lane = tid & 63, wid = tid >> 6, r32 = lane & 31, hi = lane >> 5;
    unsigned char* ws = a.ws;
    float* RAW = (float*)(lds + LR_RAW); float* AA = (float*)(lds + LR_RAW); float* U = (float*)(lds + LR_U); float* BB = (float*)(lds + LR_BB);
    char* UB = lds + LR_UB; char* WG = lds + LR_WG; float* SEG = (float*)(lds + LR_SEG); float* HC = (float*)(lds + LR_HC);
    const bf16_t* Lg = (const bf16_t*)(ws + WS_L) + (size_t)b * STOT * DLRU + n * 64;
    const bf16_t* Zg = (const bf16_t*)(ws + WS_ZG) + (size_t)b * SEQ * DLRU + n * 64;
    bf16_t* Og = (bf16_t*)(ws + WS_A2) + (size_t)b * SEQ * KOUT + 512 + d * 512 + n * 64;
    {
        const bf16_t* wsrc = (const bf16_t*)(ws + WS_RGW) + (size_t)(d * 8 + n) * 128 * 64;
#pragma unroll
        for (int i = 0; i < 2; ++i) { const int c = tid + NTHR * i, r = c >> 3, ch = c & 7; *(u32x4*)(WG + r * 144 + ch * 16) = *(const u32x4*)(wsrc + r * 64 + ch * 8); }
        if (tid < 128) HC[tid] = 0.f;
    }
    const int ct = wid & 1, tt = wid >> 1;
    float* CST = (float*)(lds + LR_CST);
    if (tid < 64) { const int c = n * 64 + tid; CST[tid] = a.in[I_RGBA][d * 512 + c]; CST[64 + tid] = a.in[I_RGBI][d * 512 + c];
        const float x = -a.in[I_RGLAM][d * 512 + c]; CST[128 + tid] = -8.f * (fmaxf(x, 0.f) + log1pf(__expf(-fabsf(x)))); }
    const int sc = tid & 63, sg = tid >> 6;
    const float cw0 = a.in[I_CONVW][0 * 512 + n * 64 + sc], cw1 = a.in[I_CONVW][1 * 512 + n * 64 + sc], cw2 = a.in[I_CONVW][2 * 512 + n * 64 + sc], cw3 = a.in[I_CONVW][3 * 512 + n * 64 + sc];
    const float cbias = a.in[I_CONVB][n * 64 + sc];
    __syncthreads();
    int par = 0;
    for (int step = 0; step < 18; ++step) {
        const bool isctx = step < 2;
        const int tl = isctx ? (d == 0 ? step : 1 - step) : (d == 0 ? step - 2 : 17 - step);
        const int sb = isctx ? 0 : CTX, sl = isctx ? CTX : SEQ, t0 = tl * 128;
        for (int e = tid; e < 131 * 8; e += NTHR) { const int r = e >> 3, ch = e & 7, t = t0 - 2 + r;
            u32x4 v = {0u, 0u, 0u, 0u}; if (t >= 0 && t < sl) v = *(const u32x4*)(Lg + (size_t)(sb + t) * DLRU + ch * 8);
            float* dst = RAW + r * 64 + ch * 8;
            dst[0] = bflo(v[0]); dst[1] = bfhi(v[0]); dst[2] = bflo(v[1]); dst[3] = bfhi(v[1]); dst[4] = bflo(v[2]); dst[5] = bfhi(v[2]); dst[6] = bflo(v[3]); dst[7] = bfhi(v[3]); }
        __syncthreads();
        {
            const float* rp = RAW + (sg * 16) * 64 + sc;
            float x0 = rp[0], x1 = rp[64], x2 = rp[128];
            float* up = U + (sg * 16) * 65 + sc; char* ubp = UB + (sg * 16) * 144 + sc * 2;
#pragma unroll
            for (int i = 0; i < 16; ++i) { const float x3 = rp[(i + 3) * 64];
                const float u = cbias + cw0 * x0 + cw1 * x1 + cw2 * x2 + cw3 * x3;
                up[i * 65] = u; *(bf16_t*)(ubp + i * 144) = f2bf(u); x0 = x1; x1 = x2; x2 = x3; }
        }
        __syncthreads();
        {
            f32x16 ga, gi;
#pragma unroll
            for (int r = 0; r < 16; ++r) { ga[r] = 0.f; gi[r] = 0.f; }
#pragma unroll
            for (int ks = 0; ks < 4; ++ks) {
                const bf16x8 wa = *(const bf16x8*)(WG + (ct * 32 + r32) * 144 + (ks * 16 + hi * 8) * 2);
                const bf16x8 wi = *(const bf16x8*)(WG + (64 + ct * 32 + r32) * 144 + (ks * 16 + hi * 8) * 2);
                const bf16x8 ub = *(const bf16x8*)(UB + (tt * 32 + r32) * 144 + (ks * 16 + hi * 8) * 2);
                ga = MFMA(wa, ub, ga); gi = MFMA(wi, ub, gi);
            }
            const int t = tt * 32 + r32;
#pragma unroll
            for (int r = 0; r < 16; ++r) { const int c = ct * 32 + 8 * (r >> 2) + 4 * hi + (r & 3);
                const float rr = sigmoidf_(ga[r] + CST[c]), ii = sigmoidf_(gi[r] + CST[64 + c]);
                const float la = CST[128 + c] * rr, av = __expf(la), mult = __builtin_amdgcn_sqrtf(fmaxf(1.f - av * av, 0.f));
                const float u = U[t * 65 + c];
                AA[t * 65 + c] = av; BB[t * 65 + c] = mult * ii * u; }
        }
        __syncthreads();
        float av[16], bv[16]; float Ap = 1.f, Bp = 0.f;
#pragma unroll
        for (int k = 0; k < 16; ++k) { const int p = sg * 16 + k, t = d == 0 ? p : 127 - p; av[k] = AA[t * 65 + sc]; bv[k] = BB[t * 65 + sc]; Bp = av[k] * Bp + bv[k]; Ap = av[k] * Ap; }
        SEG[sg * 64 + sc] = Ap; SEG[512 + sg * 64 + sc] = Bp;
        __syncthreads();
        float h = HC[par * 64 + sc];
        for (int s2 = 0; s2 < sg; ++s2) h = SEG[s2 * 64 + sc] * h + SEG[512 + s2 * 64 + sc];
        {
            const int tfirst = d == 0 ? sg * 16 : 127 - sg * 16;
            const bf16_t* zp = Zg + (size_t)(t0 + tfirst) * DLRU + sc; bf16_t* op = Og + (size_t)(t0 + tfirst) * KOUT + sc;
            const int zstep = d == 0 ? DLRU : -DLRU, ostep = d == 0 ? KOUT : -KOUT;
#pragma unroll
            for (int k = 0; k < 16; ++k) { h = av[k] * h + bv[k];
                if (!isctx) { const float gz = bf2f(*zp); *op = f2bf(h * gz); zp += zstep; op += ostep; } }
        }
        if (sg == 7) HC[(par ^ 1) * 64 + sc] = h;
        par ^= 1;
        __syncthreads();
    }
}

#ifndef LRU_REPS
#define LRU_REPS 1
#endif
__device__ void phase_mixer(const Args& a, char* lds, int vb, int nb) {
#pragma unroll 1
    for (int it = vb; it < 256; it += nb) { for (int rep_ = 0; rep_ < LRU_REPS; ++rep_) { lru_item(a, lds, it >> 4, (it >> 1) & 7, it & 1); __syncthreads(); } }
#pragma unroll 1
    for (int at = vb; at < 1024; at += nb) { const int bk = at >> 5, w = at & 31; attn_item(a, lds, bk >> 1, (bk & 1) * 4 + (w >> 3), w & 7); __syncthreads(); }
}

__device__ void phase_outproj(const Args& a, char* lds, int vb, int nb) {
    const int tid = threadIdx.x, lane = tid & 63, wid = tid >> 6, wr = wid >> 2, wc = wid & 3, fr = lane & 15, fq = lane >> 4;
    const bf16_t* A2 = (const bf16_t*)(a.ws + WS_A2); const bf16_t* WO = (const bf16_t*)(a.ws + WS_WOUT);
    bf16_t* MIX = (bf16_t*)(a.ws + WS_MIX);
#pragma unroll 1
    for (int it = vb; it < 128 * 4; it += nb) {
        const int tt = it >> 2, ft = it & 3;
        f32x4 acc[2][2][4][2];
        g8::core(acc, WO, A2, ft * 256, tt * 256, KOUT, lds);
#pragma unroll
        for (int bj = 0; bj < 2; ++bj)
#pragma unroll
            for (int n = 0; n < 2; ++n) {
                bf16_t* rp = MIX + (size_t)(tt * 256 + bj * 128 + wc * 32 + n * 16 + fr) * DM + ft * 256 + wr * 64 + fq * 4;
#pragma unroll
                for (int ai = 0; ai < 2; ++ai)
#pragma unroll
                    for (int m = 0; m < 4; ++m) { const f32x4 v = acc[ai][bj][m][n]; *(u32x2*)(rp + ai * 128 + m * 16) = (u32x2){pk2(v[0], v[1]), pk2(v[2], v[3])}; }
            }
        __syncthreads();
    }
}

__device__ void phase_rowpass(const Args& a, int vb, int nb) {
    const int tid = threadIdx.x, lane = tid & 63, wid = tid >> 6;
    const float* mod = (const float*)(a.ws + WS_MOD);
    const bf16_t* MIX = (const bf16_t*)(a.ws + WS_MIX);
    bf16_t* HX = (bf16_t*)(a.ws + WS_HX2);
    for (int row = vb * 8 + wid; row < NTOK; row += nb * 8) {
        const int b = row >> 11;
        const float* mrow = mod + (size_t)b * 6144;
        f32x4 mv[4], xv[4]; float ss = 0.f;
#pragma unroll
        for (int i = 0; i < 4; ++i) { const u32x2 mw = *(const u32x2*)(MIX + (size_t)row * DM + i * 256 + lane * 4); mv[i] = (f32x4){bflo(mw[0]), bfhi(mw[0]), bflo(mw[1]), bfhi(mw[1])};
            xv[i] = *(const f32x4*)(a.in[I_X] + (size_t)row * DM + i * 256 + lane * 4);
            ss += mv[i][0] * mv[i][0] + mv[i][1] * mv[i][1] + mv[i][2] * mv[i][2] + mv[i][3] * mv[i][3]; }
        ss = wave_sum(ss);
        const float rinv = rsqrtf(ss * (1.f / DM) + EPS);
        float s2 = 0.f;
#pragma unroll
        for (int i = 0; i < 4; ++i) { const int c = i * 256 + lane * 4;
            const f32x4 gp = *(const f32x4*)(a.in[I_GPOSTMIX] + c), g1 = *(const f32x4*)(mrow + 2048 + c);
#pragma unroll
            for (int j = 0; j < 4; ++j) { const float xm = xv[i][j] + g1[j] * (mv[i][j] * rinv * gp[j]); xv[i][j] = xm; s2 += xm * xm; }
            *(f32x4*)(a.out + (size_t)row * DM + c) = xv[i]; }
        s2 = wave_sum(s2);
        const float rinv2 = rsqrtf(s2 * (1.f / DM) + EPS);
#pragma unroll
        for (int i = 0; i < 4; ++i) { const int c = i * 256 + lane * 4;
            const f32x4 gf = *(const f32x4*)(a.in[I_GPREFFN] + c), sh = *(const f32x4*)(mrow + 3072 + c), sc = *(const f32x4*)(mrow + 4096 + c);
            float o[4];
#pragma unroll
            for (int j = 0; j < 4; ++j) o[j] = xv[i][j] * rinv2 * gf[j] * (1.f + sc[j]) + sh[j];
            u32x2 w = {pk2(o[0], o[1]), pk2(o[2], o[3])}; *(u32x2*)(HX + (size_t)row * DM + c) = w; }
    }
}

__device__ __forceinline__ int fkey(float f) { const int b = __float_as_int(f); return b ^ ((b >> 31) & 0x7fffffff); }
__device__ __forceinline__ float fval(int k) { return __int_as_float(k ^ ((k >> 31) & 0x7fffffff)); }
#define CE_DESC(x, y) do { const int hi_ = max((x), (y)), lo_ = min((x), (y)); (x) = hi_; (y) = lo_; } while (0)
__device__ __forceinline__ void sort16_desc(int (&v)[16]) {
#pragma unroll
    for (int k = 2; k <= 16; k <<= 1)
#pragma unroll
        for (int j = k >> 1; j > 0; j >>= 1)
#pragma unroll
            for (int i = 0; i < 16; ++i) { const int l = i ^ j; if (l > i) { if ((i & k) == 0) { CE_DESC(v[i], v[l]); } else { CE_DESC(v[l], v[i]); } } }
}
__device__ __forceinline__ void merge16_desc(int (&v)[16]) {
#pragma unroll
    for (int j = 8; j > 0; j >>= 1)
#pragma unroll
        for (int i = 0; i < 16; ++i) { const int l = i ^ j; if (l > i) CE_DESC(v[i], v[l]); }
}
__device__ __forceinline__ void top16_merge(int (&A)[16], const int (&B)[16]) {
#pragma unroll
    for (int i = 0; i < 16; ++i) A[i] = max(A[i], B[15 - i]);
    merge16_desc(A);
}
constexpr int PK_QS = 0;
constexpr int PK_SK = 256 * E_PITCH;
constexpr int PK_ML = PK_SK + 128 * E_PITCH;
constexpr int PK_X  = PK_ML + 32768;
constexpr int PK_END = PK_X + 8192;
__device__ void phase_peer_topk(const Args& a, char* lds, int vb, int nb) {
    unsigned char* ws = a.ws;
    const bf16_t* HX = (const bf16_t*)(ws + WS_HX2); const bf16_t* WQ = (const bf16_t*)(ws + WS_WQ); const bf16_t* SUBK = (const bf16_t*)(ws + WS_SUBK);
    int* IDX = (int*)(ws + WS_IDX);
    int* ML = (int*)(lds + PK_ML); int* XB = (int*)(lds + PK_X);
    for (int it = vb; it < 128 * 8; it += nb) {
        const int rt = it >> 3, h = it & 7, row0 = rt * 256;
        bf16_t* park = (bf16_t*)(ws + WS_MIX) + (size_t)it * (256 * 128);
        int tid = threadIdx.x;
        {
            f32x4 acc8[2][2][4][2];
            g8::core(acc8, WQ, HX, h * 256, row0, DM, lds);
            __syncthreads();
            asm volatile("" : "+v"(tid));
            const int lane = tid & 63, wid = tid >> 6;
            const int w8r = wid >> 2, w8c = wid & 3, fr = lane & 15, fq = lane >> 4;
#pragma unroll
            for (int bj = 0; bj < 2; ++bj)
#pragma unroll
                for (int m = 0; m < 4; ++m)
#pragma unroll
                    for (int n = 0; n < 2; ++n) { const int tok = bj * 128 + w8c * 32 + n * 16 + fr, d = w8r * 64 + m * 16 + fq * 4;
                        const f32x4 v0 = acc8[0][bj][m][n], v1 = acc8[1][bj][m][n];
                        *(u32x2*)(lds + PK_QS + tok * E_PITCH + d * 2) = (u32x2){pk2(v0[0], v0[1]), pk2(v0[2], v0[3])};
                        *(u32x2*)(park + tok * 128 + d) = (u32x2){pk2(v1[0], v1[1]), pk2(v1[2], v1[3])}; }
        }
        const int lane = tid & 63, wid = tid >> 6, wm = wid & 3, wn = wid >> 2, r32 = lane & 31, hi = lane >> 5;
#pragma unroll 1
        for (int p = 0; p < 2; ++p) {
            f32x16 acc[2][2];
            if (p == 1) {
#pragma unroll
                for (int i = 0; i < 8; ++i) { const int c = tid + NTHR * i, tok = c >> 4, ch = c & 15; *(u32x4*)(lds + PK_QS + tok * E_PITCH + ch * 16) = *(const u32x4*)(park + tok * 128 + ch * 8); }
            }
            {
                const bf16_t* sk = SUBK + (size_t)(h * 2 + p) * 128 * 128;
#pragma unroll
                for (int i = 0; i < 4; ++i) { const int c = tid + NTHR * i, r = c >> 4, ch = c & 15; *(u32x4*)(lds + PK_SK + r * E_PITCH + ch * 16) = *(const u32x4*)(sk + r * 128 + ch * 8); }
            }
            __syncthreads();
#pragma unroll
            for (int ft = 0; ft < 2; ++ft)
#pragma unroll
                for (int tt = 0; tt < 2; ++tt)
#pragma unroll
                    for (int r = 0; r < 16; ++r) acc[ft][tt][r] = 0.f;
#pragma unroll
            for (int ks = 0; ks < 8; ++ks) {
                const bf16x8 a0 = *(const bf16x8*)(lds + PK_SK + (wn * 64 + r32) * E_PITCH + (ks * 16 + hi * 8) * 2), a1 = *(const bf16x8*)(lds + PK_SK + (wn * 64 + 32 + r32) * E_PITCH + (ks * 16 + hi * 8) * 2);
                const bf16x8 b0 = *(const bf16x8*)(lds + PK_QS + (wm * 64 + r32) * E_PITCH + (ks * 16 + hi * 8) * 2), b1 = *(const bf16x8*)(lds + PK_QS + (wm * 64 + 32 + r32) * E_PITCH + (ks * 16 + hi * 8) * 2);
                acc[0][0] = MFMA(a0, b0, acc[0][0]); acc[0][1] = MFMA(a0, b1, acc[0][1]);
                acc[1][0] = MFMA(a1, b0, acc[1][0]); acc[1][1] = MFMA(a1, b1, acc[1][1]);
            }
#pragma unroll
            for (int tt = 0; tt < 2; ++tt) {
                int A[16], B[16];
#pragma unroll
                for (int r = 0; r < 16; ++r) { const int key = wn * 64 + 8 * (r >> 2) + 4 * hi + (r & 3);
                    A[r] = (fkey(acc[0][tt][r]) & ~127) | key; B[r] = (fkey(acc[1][tt][r]) & ~127) | (key + 32); }
                sort16_desc(A); sort16_desc(B); top16_merge(A, B);
#pragma unroll
                for (int r = 0; r < 16; ++r) { auto rr = __builtin_amdgcn_permlane32_swap((unsigned)A[r], (unsigned)A[r], false, false); B[r] = (int)(hi ? rr[0] : rr[1]); }
                top16_merge(A, B);
                const int tok = wm * 64 + tt * 32 + r32;
                if (wn == 1 && hi == 0) {
#pragma unroll
                    for (int r = 0; r < 16; ++r) XB[(wm * 32 + r32) * 16 + r] = A[r];
                }
                __syncthreads();
                if (wn == 0 && hi == 0) {
#pragma unroll
                    for (int r = 0; r < 16; ++r) B[r] = XB[(wm * 32 + r32) * 16 + r];
                    top16_merge(A, B);
#pragma unroll
                    for (int r = 0; r < 16; ++r) ML[(tok * 2 + p) * 16 + r] = A[r];
                }
                __syncthreads();
            }
        }
        if (tid < 256) {
            const int tok = tid;
            int s1[16], s2[16];
#pragma unroll
            for (int r = 0; r < 16; ++r) { s1[r] = ML[(tok * 2 + 0) * 16 + r]; s2[r] = ML[(tok * 2 + 1) * 16 + r]; }
            float f1[16], f2[16];
#pragma unroll
            for (int r = 0; r < 16; ++r) { f1[r] = fval(s1[r] & ~127); f2[r] = fval(s2[r] & ~127); }
            int G0[16], G1[16], G2[16], G3[16];
#pragma unroll
            for (int bb = 0; bb < 16; ++bb) G0[bb] = (fkey(f1[0] + f2[bb]) & ~255) | (0 * 16 + bb);
#pragma unroll
            for (int bb = 0; bb < 8; ++bb) G1[bb] = (fkey(f1[1] + f2[bb]) & ~255) | (1 * 16 + bb);
#pragma unroll
            for (int bb = 0; bb < 5; ++bb) G1[8 + bb] = (fkey(f1[2] + f2[bb]) & ~255) | (2 * 16 + bb);
#pragma unroll
            for (int bb = 0; bb < 3; ++bb) G1[13 + bb] = (fkey(f1[3] + f2[bb]) & ~255) | (3 * 16 + bb);
            G2[0] = (fkey(f1[3] + f2[3]) & ~255) | (3 * 16 + 3);
#pragma unroll
            for (int bb = 0; bb < 3; ++bb) G2[1 + bb] = (fkey(f1[4] + f2[bb]) & ~255) | (4 * 16 + bb);
#pragma unroll
            for (int aa = 5; aa < 8; ++aa)
#pragma unroll
                for (int bb = 0; bb < 2; ++bb) G2[4 + (aa - 5) * 2 + bb] = (fkey(f1[aa] + f2[bb]) & ~255) | (aa * 16 + bb);
#pragma unroll
            for (int aa = 8; aa < 14; ++aa) G2[10 + (aa - 8)] = (fkey(f1[aa] + f2[0]) & ~255) | (aa * 16);
            G3[0] = (fkey(f1[14] + f2[0]) & ~255) | (14 * 16); G3[1] = (fkey(f1[15] + f2[0]) & ~255) | (15 * 16);
#pragma unroll
            for (int r = 2; r < 16; ++r) G3[r] = (int)0x80000000;
            sort16_desc(G0); sort16_desc(G1); sort16_desc(G2); sort16_desc(G3);
            top16_merge(G0, G1); top16_merge(G2, G3); top16_merge(G0, G2);
            float tv[16]; float mx = fval(G0[0] & ~255), sum = 0.f;
#pragma unroll
            for (int r = 0; r < 16; ++r) { tv[r] = __expf(fval(G0[r] & ~255) - mx); sum += tv[r]; }
            const float rs = 1.f / sum;
            const size_t ob = ((size_t)(row0 + tok) * 8 + h) * 16;
#pragma unroll
            for (int r = 0; r < 16; ++r) { const int code = G0[r] & 255, aa = code >> 4, bb = code & 15;
                const int i1 = ML[(tok * 2 + 0) * 16 + aa] & 127, i2 = ML[(tok * 2 + 1) * 16 + bb] & 127;
                IDX[ob + r] = (i1 * 128 + i2) | (int)((unsigned)f2bf(tv[r] * rs) << 16); }
        }
        __syncthreads();
    }
}

template <int CTRL> __device__ __forceinline__ float dpp_add(float v) { return v + __uint_as_float(__builtin_amdgcn_update_dpp(0u, __float_as_uint(v), CTRL, 0xf, 0xf, true)); }
__device__ __forceinline__ float wave_sum_bcast(float p) {
    p = dpp_add<0xB1>(p); p = dpp_add<0x4E>(p); p = dpp_add<0x141>(p); p = dpp_add<0x140>(p);
    const unsigned u = __float_as_uint(p);
    return (__uint_as_float(__builtin_amdgcn_readlane(u, 0)) + __uint_as_float(__builtin_amdgcn_readlane(u, 16))) + (__uint_as_float(__builtin_amdgcn_readlane(u, 32)) + __uint_as_float(__builtin_amdgcn_readlane(u, 48)));
}
typedef float f32x4v __attribute__((ext_vector_type(4)));
constexpr int P7_RS = 9;
constexpr int P7_NR = PEER_N >> P7_RS;
constexpr int P7_HTP = 1024 + 64;
constexpr float H_SCALE = 16.f;
constexpr int P7_ATP = 2048 + 16;
constexpr float W_SCALE = 16.f;
constexpr int P7_WLDS = 8 * P7_HTP + 2048 + 4096;
__device__ void phase_peer_gather(const Args& a, char* lds, int vb, int nb) {
    unsigned char* ws = a.ws;
    const bf16_t* HX = (const bf16_t*)(ws + WS_HX2);
    const int* IDX = (const int*)(ws + WS_IDX);
    const float* mod = (const float*)(ws + WS_MOD);
    const unsigned char* UT = ws + WS_UT; const unsigned char* VT = ws + WS_VT;
#pragma unroll 1
    for (int tb = vb * 32; tb < NTOK; tb += nb * 32) {
        int tid = threadIdx.x; asm volatile("" : "+v"(tid));
        const int lane = tid & 63, wid = tid >> 6, r16 = lane & 15, kg = lane >> 4;
        char* HT = lds + wid * P7_WLDS; unsigned* LIST = (unsigned*)(HT + 8 * P7_HTP); char* WL8 = HT + 8 * P7_HTP + 2048; char* AT = HT;
        const int tok0 = tb + wid * 4;
        {
            int* HIST = (int*)HT; int* CUR = HIST + 128;
            int ee[8];
            const int* ip = IDX + (size_t)tok0 * 128 + lane;
#pragma unroll
            for (int k = 0; k < 4; ++k) { ee[2 * k] = ip[k * 128]; ee[2 * k + 1] = ip[k * 128 + 64]; }
            HIST[lane] = 0; HIST[64 + lane] = 0;
#pragma unroll
            for (int j = 0; j < 8; ++j) atomicAdd(&HIST[(((ee[j] >> P7_RS) & (P7_NR - 1)) << 2) | (j >> 1)], 1);
            const int c0 = HIST[2 * lane], c1 = HIST[2 * lane + 1];
            int inc = c0 + c1;
#pragma unroll
            for (int o = 1; o < 64; o <<= 1) { const int t = __shfl_up(inc, o); if (lane >= o) inc += t; }
            CUR[2 * lane] = inc - c0 - c1; CUR[2 * lane + 1] = inc - c1;
#pragma unroll
            for (int j = 0; j < 8; ++j) { const unsigned w = (unsigned)ee[j]; const int slot = atomicAdd(&CUR[(((w >> P7_RS) & (P7_NR - 1)) << 2) | (j >> 1)], 1);
                LIST[slot] = (w & 16383u) | ((unsigned)(j >> 1) << 14) | ((w >> 16) << 17); }
        }
        {
            const bf16_t* hp = HX + (size_t)tok0 * DM + lane * 16;
#pragma unroll
            for (int k = 0; k < 4; ++k) { const u32x4 h0 = *(const u32x4*)(hp + k * DM), h1 = *(const u32x4*)(hp + k * DM + 8);
                u32x4 o, ol;
#pragma unroll
                for (int q = 0; q < 4; ++q) { const unsigned wa = q < 2 ? h0[2 * q] : h1[2 * q - 4], wb = q < 2 ? h0[2 * q + 1] : h1[2 * q - 3];
                    const float x0 = bflo(wa) * H_SCALE, x1 = bfhi(wa) * H_SCALE, x2 = bflo(wb) * H_SCALE, x3 = bfhi(wb) * H_SCALE;
                    int w = __builtin_amdgcn_cvt_pk_fp8_f32(sat8(x0), sat8(x1), 0, false); w = __builtin_amdgcn_cvt_pk_fp8_f32(sat8(x2), sat8(x3), w, true); o[q] = (unsigned)w;
                    const float r0 = (x0 - __builtin_amdgcn_cvt_f32_fp8(w, 0)) * 16.f, r1 = (x1 - __builtin_amdgcn_cvt_f32_fp8(w, 1)) * 16.f, r2 = (x2 - __builtin_amdgcn_cvt_f32_fp8(w, 2)) * 16.f, r3 = (x3 - __builtin_amdgcn_cvt_f32_fp8(w, 3)) * 16.f;
                    int wl = __builtin_amdgcn_cvt_pk_fp8_f32(sat8(r0), sat8(r1), 0, false); wl = __builtin_amdgcn_cvt_pk_fp8_f32(sat8(r2), sat8(r3), wl, true); ol[q] = (unsigned)wl; }
                *(u32x4*)(HT + (2 * k) * P7_HTP + lane * 16) = o; *(u32x4*)(HT + (2 * k + 1) * P7_HTP + lane * 16) = ol;
            }
        }
#ifndef P7_UREP
#define P7_UREP 1
#endif
#ifndef P7_VREP
#define P7_VREP 1
#endif
#pragma unroll 1
        for (int urep = 0; urep < P7_UREP; ++urep)
        {
            i32x8 hb[8];
            {
                const char* hp = HT + (2 * (lane & 3) + ((lane >> 2) & 1)) * P7_HTP + kg * 32;
#pragma unroll
                for (int kc = 0; kc < 8; ++kc) { const i32x4 x0 = *(const i32x4*)(hp + kc * 128), x1 = *(const i32x4*)(hp + kc * 128 + 16);
                    hb[kc] = __builtin_shufflevector(x0, x1, 0, 1, 2, 3, 4, 5, 6, 7); }
            }
            unsigned entv = LIST[r16];
            asm volatile("s_waitcnt lgkmcnt(0)" ::: "memory");
            LAS unsigned char* ring = (LAS unsigned char*)lds + __builtin_amdgcn_readfirstlane(wid) * P7_WLDS;
#define U_DMA(slot, gp) do { __builtin_amdgcn_global_load_lds((const unsigned*)(gp), (LAS unsigned*)(ring + (slot) * 2048), 16, 0, 0); } while (0)
            const int lrow = lane >> 3;
            const unsigned swz = (unsigned)(((lane & 7) ^ (((lrow >> 1) & 3) << 1)) << 4);
            unsigned olo = (((unsigned)__shfl((int)entv, lrow) & 16383u) << 10) + swz, ohi = (((unsigned)__shfl((int)entv, 8 + lrow) & 16383u) << 10) + swz;
#pragma unroll
            for (int st = 0; st < 3; ++st) { U_DMA(st, UT + olo + st * 128); __builtin_amdgcn_global_load_lds((const unsigned*)(UT + ohi + st * 128), (LAS unsigned*)(ring + st * 2048 + 1024), 16, 0, 0); }
            const int ard = (r16 >> 3) * 1024 + (r16 & 7) * 128 + ((kg ^ ((r16 >> 1) & 3)) << 5);
            const float pscl = (lane & 8) ? 0.f : ((lane & 4) ? 1.f / 16.f : 1.f);
#pragma unroll 1
            for (int bi = 0; bi < 32; ++bi) {
                const unsigned entn = LIST[(bi < 31 ? bi + 1 : 31) * 16 + r16];
                const unsigned nlo = (((unsigned)__shfl((int)entn, lrow) & 16383u) << 10) + swz, nhi = (((unsigned)__shfl((int)entn, 8 + lrow) & 16383u) << 10) + swz;
                f32x4v D = {0.f, 0.f, 0.f, 0.f};
#pragma unroll
                for (int kc = 0; kc < 8; ++kc) {
                    asm volatile("" ::: "memory");
                    {
                        const unsigned glo = (kc + 3 < 8 ? olo : nlo) + ((kc + 3) & 7) * 128, ghi = (kc + 3 < 8 ? ohi : nhi) + ((kc + 3) & 7) * 128;
                        __builtin_amdgcn_global_load_lds((const unsigned*)(UT + glo), (LAS unsigned*)(ring + ((kc + 3) & 3) * 2048), 16, 0, 0);
                        __builtin_amdgcn_global_load_lds((const unsigned*)(UT + ghi), (LAS unsigned*)(ring + ((kc + 3) & 3) * 2048 + 1024), 16, 0, 0);
                    }
                    asm volatile("s_waitcnt vmcnt(6)" ::: "memory");
                    const i32x4 a0 = *(const LAS i32x4*)(ring + (kc & 3) * 2048 + ard), a1 = *(const LAS i32x4*)(ring + (kc & 3) * 2048 + ard + 16);
                    D = __builtin_amdgcn_mfma_scale_f32_16x16x128_f8f6f4(__builtin_shufflevector(a0, a1, 0, 1, 2, 3, 4, 5, 6, 7), hb[kc], D, 0, 0, 0, 127, 0, 127);
                }
                olo = nlo; ohi = nhi;
                float dsel = 0.f; unsigned esel = 0u;
#pragma unroll
                for (int i = 0; i < 4; ++i) {
                    const unsigned er = (unsigned)__shfl((int)entv, 4 * kg + i);
                    float m = (((er >> 14) & 3u) == (unsigned)(lane & 3)) ? D[i] * pscl : 0.f;
                    m = dpp_add<0xB1>(m); m = dpp_add<0x4E>(m); m = dpp_add<0x104>(m);
                    const bool pick = (lane & 3) == i; dsel = pick ? m : dsel; esel = pick ? er : esel;
                }
                if ((lane & 12) == 0) {
                    const float w = __uint_as_float((esel >> 17) << 16) * gelu_tanh(dsel * (1.f / (T_SCALE * H_SCALE))) * W_SCALE;
                    const int p0 = __builtin_amdgcn_cvt_pk_fp8_f32(sat8(w), 0.f, 0, false);
                    const float hf = __builtin_amdgcn_cvt_f32_fp8(p0, 0);
                    const int p1 = __builtin_amdgcn_cvt_pk_fp8_f32(sat8((w - hf) * 16.f), 0.f, 0, false);
                    const unsigned tk = (esel >> 14) & 3u;
                    const unsigned sh = (((unsigned)p0 & 0xffu) | (((unsigned)p1 & 0xffu) << 8)) << ((tk & 1u) * 16u);
                    u32x2 e8; e8[0] = tk < 2u ? sh : 0u; e8[1] = tk < 2u ? 0u : sh;
                    *(u32x2*)(WL8 + (bi * 16 + 4 * kg + (lane & 3)) * 8) = e8; }
                entv = entn;
            }
        }
        {
            const int m32 = lane & 31, kh = lane >> 5, ntok = m32 >> 3, npart = (m32 >> 2) & 1, nc = m32 & 3;
            const unsigned psel = (0x0c0c0c0cu & ~(0xffu << (8 * nc))) | ((unsigned)(ntok * 2 + npart) << (8 * nc));
            f32x16 acc[8];
            i32x8 abuf[8];
#pragma unroll 1
            for (int vrep = 0; vrep < P7_VREP; ++vrep) {
#pragma unroll
            for (int T = 0; T < 8; ++T)
#pragma unroll
                for (int i = 0; i < 16; ++i) acc[T][i] = 0.f;
            {
                const u32x4 l0 = *(const u32x4*)(LIST + kh * 8), l1 = *(const u32x4*)(LIST + kh * 8 + 4);
                unsigned off[8];
#pragma unroll
                for (int j = 0; j < 8; ++j) off[j] = (((j < 4 ? l0[j & 3] : l1[j & 3]) & 16383u) << 10) + m32 * 4;
#pragma unroll
                for (int T = 0; T < 8; ++T) {
#pragma unroll
                    for (int j = 0; j < 8; ++j) abuf[T][j] = *(const int*)(VT + off[j] + T * 128);
                    __builtin_amdgcn_sched_barrier(0); }
            }
#pragma unroll 1
            for (int bi = 0; bi < 32; ++bi) {
                const int bn = (bi < 31 ? bi + 1 : 31);
                const u32x4 l0 = *(const u32x4*)(LIST + bn * 16 + kh * 8), l1 = *(const u32x4*)(LIST + bn * 16 + kh * 8 + 4);
                unsigned noff[8];
#pragma unroll
                for (int j = 0; j < 8; ++j) noff[j] = (((j < 4 ? l0[j & 3] : l1[j & 3]) & 16383u) << 10) + m32 * 4;
                i32x8 bop;
#pragma unroll
                for (int q = 0; q < 4; ++q) { const u32x4 wq = *(const u32x4*)(WL8 + (bi * 16 + kh * 8 + 2 * q) * 8);
                    bop[2 * q] = (int)__builtin_amdgcn_perm(wq[1], wq[0], psel); bop[2 * q + 1] = (int)__builtin_amdgcn_perm(wq[3], wq[2], psel); }
#pragma unroll
                for (int T = 0; T < 8; ++T) {
                    __builtin_amdgcn_sched_barrier(0);
                    asm volatile("s_waitcnt vmcnt(24)" ::: "memory");
                    acc[T] = __builtin_amdgcn_mfma_scale_f32_32x32x64_f8f6f4(abuf[T], bop, acc[T], 0, 0, 0, 127, 0, 127);
#pragma unroll
                    for (int j = 0; j < 8; ++j) abuf[T][j] = *(const int*)(VT + noff[j] + T * 128);
                }
                __builtin_amdgcn_sched_barrier(0);
            }
            }
            const float psc = npart ? V_SCALE / (W_SCALE * T_SCALE * 16.f) : V_SCALE / (W_SCALE * T_SCALE);
            char* arow = AT + ntok * P7_ATP + (16 * kh + nc) * 2;
#pragma unroll
            for (int T = 0; T < 8; ++T)
#pragma unroll
                for (int i = 0; i < 16; ++i) {
                    const float v = acc[T][i] * psc;
                    const float tot = (T & 1) ? dpp_add<0x114>(v) : dpp_add<0x104>(v);
                    if ((T & 1) == npart) *(_Float16*)(arow + (128 * T + 4 * ((i & 3) + 8 * (i >> 2))) * 2) = (_Float16)tot;
                }
        }
#pragma unroll
        for (int k = 0; k < 4; ++k) {
            const int tok = tok0 + k;
            float f[16]; float ss = 0.f;
            const u32x4 e0 = *(const u32x4*)(AT + k * P7_ATP + lane * 32), e1 = *(const u32x4*)(AT + k * P7_ATP + lane * 32 + 16);
#pragma unroll
            for (int i = 0; i < 8; ++i) { const unsigned cw = i < 4 ? e0[i] : e1[i - 4]; const h16x2 hv = as_h2(cw);
                f[2 * i] = (float)hv[0] * (1.f / V_SCALE); f[2 * i + 1] = (float)hv[1] * (1.f / V_SCALE); ss += f[2 * i] * f[2 * i] + f[2 * i + 1] * f[2 * i + 1]; }
            ss = wave_sum_bcast(ss);
            const float rinv = rsqrtf(ss * (1.f / DM) + EPS);
            const float* g2 = mod + (size_t)(tok >> 11) * 6144 + 5120;
#pragma unroll
            for (int q4 = 0; q4 < 4; ++q4) {
                const int c = lane * 16 + q4 * 4;
                float* op = a.out + (size_t)tok * DM + c;
                const f32x4 xm = *(const f32x4*)op, g2v = *(const f32x4*)(g2 + c), gp = *(const f32x4*)(a.in[I_GPOSTFFN] + c);
                f32x4 o;
#pragma unroll
                for (int jj = 0; jj < 4; ++jj) o[jj] = xm[jj] + g2v[jj] * (f[q4 * 4 + jj] * rinv * gp[jj]);
                *(f32x4*)op = o; }
        }
    }
}

#ifdef DBG_DIGEST
__device__ void phase_digest(const Args& a, int vb, int nb) {
    const bf16_t* A2 = (const bf16_t*)(a.ws + WS_A2);
    const bf16_t* Q = (const bf16_t*)(a.ws + WS_Q); const bf16_t* K = (const bf16_t*)(a.ws + WS_K); const bf16_t* VV = (const bf16_t*)(a.ws + WS_VV);
    const bf16_t* L = (const bf16_t*)(a.ws + WS_L); const bf16_t* ZG = (const bf16_t*)(a.ws + WS_ZG);
    for (size_t e = (size_t)vb * NTHR + threadIdx.x; e < (size_t)NTOK * DM; e += (size_t)nb * NTHR) {
        float v = 0.f;
#if DBG_DIGEST == 3
        const size_t row = e >> 10; const int c = (int)(e & 1023);
        v = bf2f(A2[row * KOUT + c]); if (c < 512) v += bf2f(A2[row * KOUT + 1024 + c]);
#elif DBG_DIGEST == 2
        const size_t h = e % ((size_t)NTOK * 512);
        v = bf2f(Q[h]) + bf2f(ZG[h]) + bf2f(L[e % ((size_t)NB * STOT * 512)]);
        if (e < (size_t)NB * 2 * STOT * 64) v += bf2f(K[e]) + bf2f(VV[e]);
#endif
        a.out[e] = v; }
}
#endif
constexpr int LDS_BYTES = 155648;
constexpr int LDS_BARST = LDS_BYTES - 16;
static_assert(8 * P7_WLDS <= LDS_BARST && PK_END <= LDS_BARST && LR_END <= LDS_BARST && g8::SHM_B <= LDS_BARST && 17 * 1024 * 4 + 17 * 24 * 4 <= LDS_BARST, "LDS budget");
constexpr int N_PHASES = 8;

__global__ void __launch_bounds__(NTHR, 2) mk_fwd(Args a) {
    extern __shared__ __attribute__((aligned(16))) char lds[];
    const int nb = gridDim.x, bx = blockIdx.x;
    const int vb0 = (nb % 8 == 0) ? (bx % 8) * (nb / 8) + bx / 8 : bx;
    XcdBarrier bar; bar.bar = (unsigned*)(a.ws + WS_CTL); bar.x = 0; bar.st = (volatile LAS unsigned*)(LAS char*)(lds + LDS_BARST);
    const bool multi = (a.ph_hi - a.ph_lo) > 1;
    if (multi) {
        if (threadIdx.x < 4) ((volatile LAS unsigned*)(LAS char*)(lds + LDS_BARST))[threadIdx.x] = 0u;
        __syncthreads();
        bar = xcd_barrier_post((unsigned*)(a.ws + WS_CTL), (volatile LAS unsigned*)(LAS char*)(lds + LDS_BARST));
    }
#ifndef P7_PROBE
#define P7_PROBE -1
#endif
#ifndef DBL_PHASE
#define DBL_PHASE 0
#endif
#if DBL_PHASE != 0
#define RUN_PHASE(P, CALL) do { if (a.ph_lo <= (P) && (P) < a.ph_hi) { const int nrep_ = ((a.dbl >> (P)) & 1) ? 2 : 1; for (int rep_ = 0; rep_ < nrep_; ++rep_) { CALL; if ((P) + 1 < a.ph_hi || rep_ + 1 < nrep_) xcd_barrier(bar); } } } while (0)
#else
#define RUN_PHASE(P, CALL) do { if (a.ph_lo <= (P) && (P) < a.ph_hi) { CALL; if ((P) + 1 < a.ph_hi) xcd_barrier(bar); } } while (0)
#endif
#if !defined(ONLY_PHASE) || ONLY_PHASE == 0
    RUN_PHASE(0, phase_prep(a, lds, vb0, nb));
#endif
    int vb = vb0;
    if (multi && a.ph_lo == 0 && a.ph_hi > 1) {
        if (threadIdx.x == 0) { unsigned off = 0; for (unsigned j = 0; j < bar.x; ++j) off += xb_ld(&bar.bar[XB_XCNT(j)]); bar.st[3] = off + bar.st[2]; }
        __syncthreads();
        vb = (int)bar.st[3];
    }
#if !defined(ONLY_PHASE) || ONLY_PHASE == 1
    RUN_PHASE(1, phase_xn(a, vb, nb));
#endif
#if !defined(ONLY_PHASE) || ONLY_PHASE == 2
    RUN_PHASE(2, phase_inproj(a, lds, vb, nb));
#endif
#if (!defined(ONLY_PHASE) || ONLY_PHASE == 3) && !(defined(DBG_DIGEST) && DBG_DIGEST == 2)
    RUN_PHASE(3, phase_mixer(a, lds, vb, nb));
#endif
#ifdef DBG_DIGEST
    if (a.ph_lo <= 4 && 4 < a.ph_hi) phase_digest(a, vb, nb);
    return;
#endif
#if !defined(ONLY_PHASE) || ONLY_PHASE == 4
    RUN_PHASE(4, phase_outproj(a, lds, vb, nb));
#endif
#if !defined(ONLY_PHASE) || ONLY_PHASE == 5
    RUN_PHASE(5, phase_rowpass(a, vb, nb));
#endif
#if !defined(ONLY_PHASE) || ONLY_PHASE == 6
    RUN_PHASE(6, phase_peer_topk(a, lds, vb, nb));
#endif
#if !defined(ONLY_PHASE) || ONLY_PHASE == 7
    RUN_PHASE(7, phase_peer_gather(a, lds, vb, nb));
#endif
}

extern "C" void kernel_launch(void* const* d_in, const int* in_sizes, int n_in, void* d_out, int out_size, void* d_ws, size_t ws_size, hipStream_t stream) {
    static int grid = 0;
    if (grid == 0) {
        if (n_in != 25 || out_size != NTOK * DM || ws_size < WS_END) { fprintf(stderr, "kernel_launch: unexpected shapes (n_in %d, out %d, ws %zu, need %zu)\n", n_in, out_size, ws_size, (size_t)WS_END); grid = -1; return; }
        int dev = 0, cus = 0;
        if (hipGetDevice(&dev) != hipSuccess || hipDeviceGetAttribute(&cus, hipDeviceAttributeMultiprocessorCount, dev) != hipSuccess) { grid = -1; return; }
        if (hipFuncSetAttribute((const void*)mk_fwd, hipFuncAttributeMaxDynamicSharedMemorySize, LDS_BYTES) != hipSuccess) { fprintf(stderr, "kernel_launch: hipFuncSetAttribute failed\n"); grid = -1; return; }
        (void)hipGetLastError();
        grid = cus;
    }
    if (grid < 0) return;
    (void)hipMemsetAsync((char*)d_ws + WS_CTL, 0, CTL_BYTES, stream);
    Args a{};
    for (int i = 0; i < 25; ++i) a.in[i] = (const float*)d_in[i];
    a.out = (float*)d_out; a.ws = (unsigned char*)d_ws; a.dbl = DBL_PHASE; a.probe = P7_PROBE;
#if MK_N_LAUNCHES == 1
    a.ph_lo = 0; a.ph_hi = N_PHASES;
    hipLaunchKernelGGL(mk_fwd, dim3(grid), dim3(NTHR), LDS_BYTES, stream, a);
#else
    for (int ph = 0; ph < N_PHASES; ++ph) { a.ph_lo = ph; a.ph_hi = ph + 1; hipLaunchKernelGGL(mk_fwd, dim3(grid), dim3(NTHR), LDS_BYTES, stream, a); }
#endif
}
```

```cpp
#include <hip/hip_runtime.h>
#include <cstdio>
#include <cstdint>

#ifndef MK_N_LAUNCHES
#define MK_N_LAUNCHES 1
#endif

typedef unsigned short bf16_t;
typedef short bf16x8 __attribute__((ext_vector_type(8)));
typedef float f32x16 __attribute__((ext_vector_type(16)));
typedef float f32x4 __attribute__((ext_vector_type(4)));
typedef float f32x2 __attribute__((ext_vector_type(2)));
typedef unsigned u32x4 __attribute__((ext_vector_type(4)));
typedef unsigned u32x2 __attribute__((ext_vector_type(2)));
typedef int i32x8 __attribute__((ext_vector_type(8)));
typedef int i32x4 __attribute__((ext_vector_type(4)));
#define LAS __attribute__((address_space(3)))

constexpr int DM = 1024, NB = 16, SEQ = 2048, CTX = 256, STOT = SEQ + CTX;
constexpr int NTOK = NB * SEQ;
constexpr int NCTX = NB * CTX;
constexpr int NROWS = NTOK + NCTX;
constexpr int DIN = 1792, DLRU = 512;
constexpr int KOUT = 1536;
constexpr int PEER_N = 16384;
constexpr float EPS = 1e-6f;
constexpr int NTHR = 512;

constexpr size_t al256(size_t x) { return (x + 255) & ~(size_t)255; }
constexpr size_t WS_CTL   = 0;
constexpr size_t CTL_BYTES = 65536;
constexpr size_t WS_MOD   = WS_CTL + CTL_BYTES;
constexpr size_t WS_ROPE  = WS_MOD + al256(17 * 6144 * 4);
constexpr size_t WS_WIN   = WS_ROPE + al256(64 * 16 * 2 * 4);
constexpr size_t WS_WOUT  = WS_WIN + al256((size_t)DIN * DM * 2);
constexpr size_t WS_WQ    = WS_WOUT + al256((size_t)DM * KOUT * 2);
constexpr size_t WS_SUBK  = WS_WQ + al256((size_t)2048 * DM * 2);
constexpr size_t WS_RGW   = WS_SUBK + al256((size_t)8 * 2 * 128 * 128 * 2);
constexpr size_t WS_UT    = WS_RGW + al256((size_t)2 * 8 * 128 * 64 * 2);
constexpr size_t WS_VT    = WS_UT + al256((size_t)PEER_N * DM * 2);
constexpr size_t WS_XN    = WS_VT + al256((size_t)PEER_N * DM * 2);
constexpr size_t WS_Q     = WS_XN + al256((size_t)NROWS * DM * 2);
constexpr size_t WS_K     = WS_Q + al256((size_t)NTOK * 512 * 2);
constexpr size_t WS_VV    = WS_K + al256((size_t)NB * 2 * STOT * 64 * 2);
constexpr size_t WS_L     = WS_VV + al256((size_t)NB * 2 * STOT * 64 * 2);
constexpr size_t WS_ZG    = WS_L + al256((size_t)NB * STOT * DLRU * 2);
constexpr size_t WS_A2    = WS_ZG + al256((size_t)NTOK * DLRU * 2);
constexpr size_t WS_END   = WS_A2 + al256((size_t)NTOK * KOUT * 2);
constexpr size_t WS_MIX   = WS_XN;
constexpr size_t WS_HX2   = WS_A2;
constexpr size_t WS_XM    = WS_Q;
constexpr size_t WS_IDX   = WS_ZG;
constexpr size_t WS_GATE  = WS_ZG + (size_t)NTOK * 128 * 4;
static_assert(WS_MIX + (size_t)NTOK * DM * 4 <= WS_ZG, "MIX overlay must end before ZG");
static_assert(WS_GATE + (size_t)NTOK * 128 * 4 <= WS_A2, "IDX/GATE overlay must end before A2");

typedef __bf16 bf16x2_t __attribute__((ext_vector_type(2)));
__device__ __forceinline__ unsigned pk2(float lo, float hi) { const f32x2 v = {lo, hi}; const bf16x2_t b = __builtin_convertvector(v, bf16x2_t); return __builtin_bit_cast(unsigned, b); }
typedef _Float16 h16x2 __attribute__((ext_vector_type(2)));
constexpr float V_SCALE = 64.f;
constexpr float T_SCALE = 256.f;
#ifndef P7_FP8
#define P7_FP8 1
#endif
__device__ __forceinline__ unsigned pkh2(float lo, float hi) { const h16x2 h = {(_Float16)lo, (_Float16)hi}; return __builtin_bit_cast(unsigned, h); }
__device__ __forceinline__ bf16x2_t as_bf2(unsigned x) { return __builtin_bit_cast(bf16x2_t, x); }
__device__ __forceinline__ h16x2 as_h2(unsigned x) { return __builtin_bit_cast(h16x2, x); }
__device__ __forceinline__ bf16_t f2bf(float f) { return (bf16_t)(pk2(f, 0.f) & 0xffffu); }
__device__ __forceinline__ float bf2f(unsigned h) { return __uint_as_float(h << 16); }
__device__ __forceinline__ float bflo(unsigned w) { return __uint_as_float(w << 16); }
__device__ __forceinline__ float bfhi(unsigned w) { return __uint_as_float(w & 0xffff0000u); }
__device__ __forceinline__ float sat8(float x) { return fminf(fmaxf(x, -448.f), 448.f); }
__device__ __forceinline__ float fast_rcp(float x) { return __builtin_amdgcn_rcpf(x); }
__device__ __forceinline__ float sigmoidf_(float x) { return fast_rcp(1.f + __expf(-x)); }
__device__ __forceinline__ float gelu_tanh(float x) { const float y = 0.7978845608028654f * (x + 0.044715f * x * x * x); return x * fast_rcp(1.f + __expf(-2.f * y)); }
__device__ __forceinline__ float silu_(float x) { return x * sigmoidf_(x); }
__device__ __forceinline__ float wave_sum(float v) {
#pragma unroll
    for (int o = 32; o > 0; o >>= 1) v += __shfl_xor(v, o);
    return v;
}
__device__ __forceinline__ float half_swap_max(float v) { auto rr = __builtin_amdgcn_permlane32_swap(__float_as_uint(v), __float_as_uint(v), false, false); return fmaxf(__uint_as_float(rr[0]), __uint_as_float(rr[1])); }
__device__ __forceinline__ float half_swap_sum(float v) { auto rr = __builtin_amdgcn_permlane32_swap(__float_as_uint(v), __float_as_uint(v), false, false); return __uint_as_float(rr[0]) + __uint_as_float(rr[1]); }
#define MFMA(a, b, c) __builtin_amdgcn_mfma_f32_32x32x16_bf16((a), (b), (c), 0, 0, 0)

#define XB_TMO      128
#define XB_XCNT(j)  (256  + 64 * (j))
#define XB_XSUB(j)  (1280 + 64 * (j))
#define XB_XGEN(j)  (2304 + 64 * (j))
#define XB_TOP      3328
#define XB_TOPGEN   3392
#define XCD_BAR_WORDS 3456
#define XB_SPIN_CAP (1u << 20)
__device__ __forceinline__ unsigned xb_ld(unsigned* p)              { return __hip_atomic_load(p, __ATOMIC_RELAXED, __HIP_MEMORY_SCOPE_AGENT); }
__device__ __forceinline__ unsigned xb_add(unsigned* p, unsigned v) { return __hip_atomic_fetch_add(p, v, __ATOMIC_RELAXED, __HIP_MEMORY_SCOPE_AGENT); }
__device__ __forceinline__ unsigned xb_xcc_id() { return (unsigned)__builtin_amdgcn_s_getreg((3 << 11) | 20) & 0xFu; }
#define XB_SPIN(cond, bar) do { unsigned _sp = 0; while (cond) { __builtin_amdgcn_s_sleep(1); \
    if ((++_sp & 255u) == 0u) { if (xb_ld(&(bar)[XB_TMO])) break; if (_sp > XB_SPIN_CAP) { atomicAdd(&(bar)[XB_TMO], 1u); break; } } } } while (0)
struct XcdBarrier { unsigned* bar; unsigned x; volatile LAS unsigned* st; };
__device__ __forceinline__ XcdBarrier xcd_barrier_post(unsigned* bar, volatile LAS unsigned* st) {
    XcdBarrier b; b.bar = bar; b.x = xb_xcc_id(); b.st = st;
    if (threadIdx.x == 0) st[2] = xb_add(&bar[XB_XCNT(b.x)], 1u);
    return b;
}
__device__ __forceinline__ void xcd_barrier_complete(unsigned* bar, unsigned x, unsigned& nloc, unsigned& nx) {
    const unsigned G = gridDim.x * gridDim.y * gridDim.z;
    unsigned sum, cnt, mine, sp = 0u;
    for (;;) {
        sum = 0u; cnt = 0u; mine = 0u;
#pragma unroll
        for (unsigned j = 0; j < 16; ++j) { const unsigned c = xb_ld(&bar[XB_XCNT(j)]); sum += c; cnt += (c > 0u) ? 1u : 0u; mine = (j == x) ? c : mine; }
        if (sum == G) break;
        __builtin_amdgcn_s_sleep(1);
        if ((++sp & 255u) == 0u) { if (xb_ld(&bar[XB_TMO])) break; if (sp > XB_SPIN_CAP) { atomicAdd(&bar[XB_TMO], 1u); break; } }
    }
    nloc = mine > 0u ? mine : 1u; nx = cnt > 0u ? cnt : 1u;
}
__device__ __forceinline__ void xcd_barrier(const XcdBarrier& b) {
    asm volatile("s_waitcnt vmcnt(0)" ::: "memory");
    __syncthreads();
    if (threadIdx.x == 0) {
        unsigned* bar = b.bar;
        __builtin_amdgcn_s_waitcnt(0);
        unsigned nloc = b.st[0], nx = b.st[1];
        if (nloc == 0u) { xcd_barrier_complete(bar, b.x, nloc, nx); b.st[0] = nloc; b.st[1] = nx; }
        const unsigned old = xb_add(&bar[XB_XSUB(b.x)], 1u);
        const unsigned gen = old / nloc;
        if (old + 1u == (gen + 1u) * nloc) {
            __builtin_amdgcn_fence(__ATOMIC_RELEASE, "agent");
            asm volatile("s_waitcnt vmcnt(0)" ::: "memory");
            const unsigned og = xb_add(&bar[XB_TOP], 1u);
            const unsigned tg = og / nx;
            if (og + 1u == (tg + 1u) * nx) xb_add(&bar[XB_TOPGEN], 1u);
            else XB_SPIN(xb_ld(&bar[XB_TOPGEN]) == tg, bar);
            __builtin_amdgcn_fence(__ATOMIC_ACQUIRE, "agent");
            xb_add(&bar[XB_XGEN(b.x)], 1u);
            asm volatile("s_waitcnt vmcnt(0)" ::: "memory");
        } else {
            XB_SPIN(xb_ld(&bar[XB_XGEN(b.x)]) == gen, bar);
            __builtin_amdgcn_fence(__ATOMIC_ACQUIRE, "agent");
            asm volatile("s_waitcnt vmcnt(0)" ::: "memory");
        }
    }
    __syncthreads();
}

struct Args { const float* in[25]; float* out; unsigned char* ws; int ph_lo, ph_hi, dbl, probe; };
enum { I_X = 0, I_C, I_CTX, I_CCTX, I_WMOD, I_BMOD, I_GPREMIX, I_GPOSTMIX, I_GPREFFN, I_GPOSTFFN, I_WIN, I_QNG, I_KNG, I_CONVW, I_CONVB,
       I_RGWA, I_RGBA, I_RGWI, I_RGBI, I_RGLAM, I_WOUT, I_PWQ, I_PSUBK, I_PU, I_PV };

__device__ __forceinline__ void tr_tile(const float* __restrict__ src, int lds_, int sr0, int sc0, bf16_t* __restrict__ dst, int ldd, int dr0, int dc0, float* T) {
    const int tid = threadIdx.x;
#pragma unroll
    for (int i = 0; i < 8; ++i) { const int e = tid + NTHR * i, r = e >> 6, c = e & 63; T[r * 65 + c] = src[(size_t)(sr0 + r) * lds_ + sc0 + c]; }
    __syncthreads();
#pragma unroll
    for (int i = 0; i < 8; ++i) { const int e = tid + NTHR * i, c = e >> 6, r = e & 63; dst[(size_t)(dr0 + c) * ldd + dc0 + r] = f2bf(T[r * 65 + c]); }
    __syncthreads();
}

__device__ void phase_prep(const Args& a, char* lds, int vb, int nb) {
    const int tid = threadIdx.x;
    unsigned char* ws = a.ws;
    float* S = (float*)lds;
    float* T = (float*)lds;
    constexpr int N_MOD = 256, N_TIN = 448, N_TOUT = 384, N_TWQ = 512, N_RGW = 32, N_SUBK = 16, N_UV = 512, N_MISC = 1;
    constexpr int O_TIN = N_MOD, O_TOUT = O_TIN + N_TIN, O_TWQ = O_TOUT + N_TOUT, O_RGW = O_TWQ + N_TWQ, O_SUBK = O_RGW + N_RGW, O_UV = O_SUBK + N_SUBK, O_MISC = O_UV + N_UV, N_ALL = O_MISC + N_MISC;
    for (int it = vb; it < N_ALL; it += nb) {
        if (it < O_TIN) {
            for (int e = tid; e < 17 * 1024; e += NTHR) { const int r = e >> 10, k = e & 1023; const float v = (r < 16) ? a.in[I_C][r * 1024 + k] : a.in[I_CCTX][k]; S[e] = silu_(v); }
            __syncthreads();
            const int n0 = it * 24;
            const int cc = tid % 6, kk = tid / 6;
            float acc[17][4];
#pragma unroll
            for (int r = 0; r < 17; ++r) { acc[r][0] = 0.f; acc[r][1] = 0.f; acc[r][2] = 0.f; acc[r][3] = 0.f; }
            if (tid < 510) {
                for (int k = kk; k < 1024; k += 85) {
                    const f32x4 w = *(const f32x4*)(a.in[I_WMOD] + (size_t)k * 6144 + n0 + cc * 4);
#pragma unroll
                    for (int r = 0; r < 17; ++r) { const float s = S[r * 1024 + k]; acc[r][0] += s * w[0]; acc[r][1] += s * w[1]; acc[r][2] += s * w[2]; acc[r][3] += s * w[3]; }
                }
            }
            __syncthreads();
            if (tid < 510) {
#pragma unroll
                for (int r = 0; r < 17; ++r) { f32x4 v = {acc[r][0], acc[r][1], acc[r][2], acc[r][3]}; *(f32x4*)(S + (kk * 17 + r) * 24 + cc * 4) = v; }
            }
            __syncthreads();
            float* mod = (float*)(ws + WS_MOD);
            for (int e = tid; e < 17 * 24; e += NTHR) { const int r = e / 24, j = e % 24; float sum = 0.f;
                for (int q = 0; q < 85; ++q) sum += S[(q * 17 + r) * 24 + j];
                mod[r * 6144 + n0 + j] = sum + a.in[I_BMOD][n0 + j]; }
            __syncthreads();
        } else if (it < O_TOUT) {
            const int t = it - O_TIN, kt = t / 28, nt = t % 28;
            tr_tile(a.in[I_WIN], DIN, kt * 64, nt * 64, (bf16_t*)(ws + WS_WIN), DM, nt * 64, kt * 64, T);
        } else if (it < O_TWQ) {
            const int t = it - O_TOUT, kt = t / 16, nt = t % 16;
            const int sk = (kt < 16) ? kt * 64 : (kt - 16) * 64 + 512;
            tr_tile(a.in[I_WOUT], DM, sk, nt * 64, (bf16_t*)(ws + WS_WOUT), KOUT, nt * 64, kt * 64, T);
        } else if (it < O_RGW) {
            const int t = it - O_TWQ, kt = t / 32, nt = t % 32;
            tr_tile(a.in[I_PWQ], 2048, kt * 64, nt * 64, (bf16_t*)(ws + WS_WQ), DM, nt * 64, kt * 64, T);
        } else if (it < O_SUBK) {
            const int t = it - O_RGW, g = t & 1, dn = t >> 1;
            const float* src = (g == 0 ? a.in[I_RGWA] : a.in[I_RGWI]) + (size_t)dn * 4096;
            tr_tile(src, 64, 0, 0, (bf16_t*)(ws + WS_RGW) + (size_t)dn * 128 * 64 + g * 64 * 64, 64, 0, 0, T);
        } else if (it < O_UV) {
            const int t = it - O_SUBK; const float* src = a.in[I_PSUBK] + (size_t)t * 16384; bf16_t* dst = (bf16_t*)(ws + WS_SUBK) + (size_t)t * 16384;
            for (int e = tid * 4; e < 16384; e += NTHR * 4) { const f32x4 v = *(const f32x4*)(src + e); u32x2 o = {pk2(v[0], v[1]), pk2(v[2], v[3])}; *(u32x2*)(dst + e) = o; }
        } else if (it < O_MISC) {
            const int t = it - O_UV; const bool isv = t >= 256; const int tt = t & 255;
            const float* src = (isv ? a.in[I_PV] : a.in[I_PU]) + (size_t)tt * 65536; bf16_t* dst = (bf16_t*)(ws + (isv ? WS_VT : WS_UT)) + (size_t)tt * 65536;
#if P7_FP8
            unsigned char* d8 = ws + (isv ? WS_VT : WS_UT) + (size_t)tt * 65536;
            for (int e = tid * 16; e < 65536; e += NTHR * 16) { u32x4 o;
#pragma unroll
                for (int q = 0; q < 4; ++q) { f32x4 v = *(const f32x4*)(src + e + q * 4) * T_SCALE;
#pragma unroll
                    for (int i = 0; i < 4; ++i) v[i] = fminf(fmaxf(v[i], -448.f), 448.f);
                    int w = __builtin_amdgcn_cvt_pk_fp8_f32(v[0], v[1], 0, false); w = __builtin_amdgcn_cvt_pk_fp8_f32(v[2], v[3], w, true); o[q] = (unsigned)w; }
                *(u32x4*)(d8 + e) = o; }
#else
            if (!isv) {
                for (int e = tid * 8; e < 65536; e += NTHR * 8) { const f32x4 v0 = *(const f32x4*)(src + e), v1 = *(const f32x4*)(src + e + 4);
                    u32x4 o = {pk2(v0[0], v0[1]), pk2(v0[2], v0[3]), pk2(v1[0], v1[1]), pk2(v1[2], v1[3])}; *(u32x4*)(dst + e) = o; }
            } else {
                for (int e = tid * 8; e < 65536; e += NTHR * 8) { const f32x4 v0 = *(const f32x4*)(src + e) * V_SCALE, v1 = *(const f32x4*)(src + e + 4) * V_SCALE;
                    u32x4 o = {pkh2(v0[0], v0[1]), pkh2(v0[2], v0[3]), pkh2(v1[0], v1[1]), pkh2(v1[2], v1[3])}; *(u32x4*)(dst + e) = o; }
            }
#endif
        } else {
            float* rope = (float*)(ws + WS_ROPE);
            for (int e = tid; e < 64 * 16; e += NTHR) { const int pos = e >> 4, f = e & 15; const float inv = powf(10000.f, -(float)f / 16.f); const float ang = (float)pos * inv; rope[e * 2] = cosf(ang); rope[e * 2 + 1] = sinf(ang); }
        }
    }
}

__device__ void phase_xn(const Args& a, int vb, int nb) {
    const int tid = threadIdx.x, lane = tid & 63, wid = tid >> 6;
    const float* mod = (const float*)(a.ws + WS_MOD);
    bf16_t* XN = (bf16_t*)(a.ws + WS_XN);
    const float* g = a.in[I_GPREMIX];
    for (int row = vb * 8 + wid; row < NROWS; row += nb * 8) {
        const float* src; int mrow;
        if (row < NTOK) { src = a.in[I_X] + (size_t)row * DM; mrow = row >> 11; } else { src = a.in[I_CTX] + (size_t)(row - NTOK) * DM; mrow = 16; }
        f32x4 v[4]; float ss = 0.f;
#pragma unroll
        for (int i = 0; i < 4; ++i) { v[i] = *(const f32x4*)(src + i * 256 + lane * 4); ss += v[i][0] * v[i][0] + v[i][1] * v[i][1] + v[i][2] * v[i][2] + v[i][3] * v[i][3]; }
        ss = wave_sum(ss);
        const float rinv = rsqrtf(ss * (1.f / DM) + EPS);
        const float* sh = mod + (size_t)mrow * 6144, *sc = sh + 1024;
#pragma unroll
        for (int i = 0; i < 4; ++i) { const int c = i * 256 + lane * 4;
            const f32x4 gg = *(const f32x4*)(g + c), s1 = *(const f32x4*)(sc + c), s0 = *(const f32x4*)(sh + c);
            float o[4];
#pragma unroll
            for (int j = 0; j < 4; ++j) o[j] = v[i][j] * rinv * gg[j] * (1.f + s1[j]) + s0[j];
            u32x2 w = {pk2(o[0], o[1]), pk2(o[2], o[3])}; *(u32x2*)(XN + (size_t)row * DM + c) = w; }
    }
}

constexpr int E_PITCH = 272;
namespace g8 {
constexpr int BM = 256, BK = 64, HALF = 128, HT = HALF * BK, SHM_B = 8 * HT * 2;
__device__ __forceinline__ int lds_byte(int r, int c) { const int st = (r >> 4) * 2 + (c >> 5), rr = r & 15, cc = c & 31, ob = rr * 64 + cc * 2; return st * 1024 + (ob ^ (((ob >> 9) & 1) << 5)); }
__device__ __forceinline__ void stage_rc(int b, int& R, int& C) { const int st = b / 1024, sb = b % 1024, swz = sb ^ (((sb >> 9) & 1) << 5); R = (st >> 1) * 16 + swz / 64; C = (st & 1) * 32 + (swz % 64) / 2; }
__device__ __forceinline__ void core(f32x4 (&acc)[2][2][4][2], const bf16_t* __restrict__ A, const bf16_t* __restrict__ Bt, int brow, int bcol, int K, char* lds_) {
    LAS unsigned char* lds = (LAS unsigned char*)lds_;
    const int tid = threadIdx.x, wid = __builtin_amdgcn_readfirstlane(tid >> 6), lane = tid & 63, wr = wid >> 2, wc = wid & 3, fr = lane & 15, fq = lane >> 4;
    constexpr int HTB = HT * 2;
    unsigned voff[2];
#pragma unroll
    for (int i = 0; i < 2; ++i) { int R, C; stage_rc(tid * 16 + i * 8192, R, C); voff[i] = (unsigned)(R * K + C) * 2u; }
    const size_t kstep = (size_t)(BK * 2), hstep = (size_t)HALF * K * 2;
    const unsigned ldsw = (unsigned)wid * 1024u;
    const int aoff = lds_byte(wr * 64 + fr, fq * 8), boff = lds_byte(wc * 32 + fr, fq * 8);
#define G8_SA(b, h) (((b) * 2 + (h)) * HTB)
#define G8_SB(b, h) ((4 + (b) * 2 + (h)) * HTB)
#define G8_STAGE(bufoff, gbase) do { _Pragma("unroll") for (int _i = 0; _i < 2; ++_i) \
        __builtin_amdgcn_global_load_lds((const unsigned*)((const char*)(gbase) + voff[_i]), (LAS unsigned*)(lds + (bufoff) + ldsw + _i * 8192), 16, 0, 0); } while (0)
#define G8_LDA(dst, b, h) do { _Pragma("unroll") for (int m = 0; m < 4; ++m) _Pragma("unroll") for (int k = 0; k < 2; ++k) dst[m][k] = *(const LAS bf16x8*)(lds + G8_SA(b, h) + aoff + m * 2048 + k * 1024); } while (0)
#define G8_LDB(dst, b, h) do { _Pragma("unroll") for (int n = 0; n < 2; ++n) _Pragma("unroll") for (int k = 0; k < 2; ++k) dst[n][k] = *(const LAS bf16x8*)(lds + G8_SB(b, h) + boff + n * 2048 + k * 1024); } while (0)
#define G8_MMA(ai, bj, At_, Bt_) do { __builtin_amdgcn_s_setprio(1); \
    _Pragma("unroll") for (int m = 0; m < 4; ++m) _Pragma("unroll") for (int n = 0; n < 2; ++n) _Pragma("unroll") for (int k = 0; k < 2; ++k) \
      acc[ai][bj][m][n] = __builtin_amdgcn_mfma_f32_16x16x32_bf16(At_[m][k], Bt_[n][k], acc[ai][bj][m][n], 0, 0, 0); \
    __builtin_amdgcn_s_setprio(0); } while (0)
#define G8_WAIT_V(n) asm volatile("s_waitcnt vmcnt(" #n ")" ::: "memory")
#define G8_WAIT_L(n) asm volatile("s_waitcnt lgkmcnt(" #n ")" ::: "memory")
#define G8_BAR __builtin_amdgcn_s_barrier()
#define G8_SCHED __builtin_amdgcn_sched_barrier(0)
#pragma unroll
    for (int ai = 0; ai < 2; ++ai)
#pragma unroll
        for (int bj = 0; bj < 2; ++bj)
#pragma unroll
            for (int m = 0; m < 4; ++m)
#pragma unroll
                for (int n = 0; n < 2; ++n) acc[ai][bj][m][n] = (f32x4){0.f, 0.f, 0.f, 0.f};
    bf16x8 At[4][2], B0[2][2], B1[2][2];
    const int nt = K / BK;
    const char* cA = (const char*)(A + (size_t)brow * K); const char* cB = (const char*)(Bt + (size_t)bcol * K);
    G8_STAGE(G8_SB(0, 0), cB); G8_STAGE(G8_SA(0, 0), cA); G8_STAGE(G8_SB(0, 1), cB + hstep); G8_STAGE(G8_SA(0, 1), cA + hstep);
    if (wr == 1) G8_BAR;
    G8_WAIT_V(4); G8_BAR;
    G8_STAGE(G8_SB(1, 0), cB + kstep); G8_STAGE(G8_SA(1, 0), cA + kstep); G8_STAGE(G8_SB(1, 1), cB + hstep + kstep);
    G8_WAIT_V(6); G8_BAR;
#pragma unroll 1
    for (int t = 0; t < nt - 2; t += 2) {
        const char* a1 = cA + (size_t)(t + 1) * kstep; const char* a2 = cA + (size_t)(t + 2) * kstep; const char* b2 = cB + (size_t)(t + 2) * kstep;
        const char* a3 = a2 + kstep; const char* b3 = b2 + kstep;
        G8_LDB(B0, 0, 0); G8_SCHED; G8_LDA(At, 0, 0); G8_STAGE(G8_SA(1, 1), a1 + hstep);
        G8_WAIT_L(8); G8_BAR; G8_WAIT_L(0); G8_MMA(0, 0, At, B0); G8_BAR; G8_SCHED;
        G8_LDB(B1, 0, 1); G8_STAGE(G8_SB(0, 0), b2);
        G8_BAR; G8_WAIT_L(0); G8_MMA(0, 1, At, B1); G8_BAR;
        G8_LDA(At, 0, 1); G8_STAGE(G8_SA(0, 0), a2);
        G8_BAR; G8_WAIT_L(0); G8_MMA(1, 0, At, B0); G8_BAR; G8_SCHED;
        G8_STAGE(G8_SB(0, 1), b2 + hstep);
        G8_WAIT_V(6); G8_BAR; G8_MMA(1, 1, At, B1); G8_BAR;
        G8_LDB(B0, 1, 0); G8_SCHED; G8_LDA(At, 1, 0); G8_STAGE(G8_SA(0, 1), a2 + hstep);
        G8_WAIT_L(8); G8_BAR; G8_WAIT_L(0); G8_MMA(0, 0, At, B0); G8_BAR; G8_SCHED;
        G8_LDB(B1, 1, 1); G8_STAGE(G8_SB(1, 0), b3);
        G8_BAR; G8_WAIT_L(0); G8_MMA(0, 1, At, B1); G8_BAR;
        G8_LDA(At, 1, 1); G8_STAGE(G8_SA(1, 0), a3);
        G8_BAR; G8_WAIT_L(0); G8_MMA(1, 0, At, B0); G8_BAR; G8_SCHED;
        G8_STAGE(G8_SB(1, 1), b3 + hstep);
        G8_WAIT_V(6); G8_BAR; G8_MMA(1, 1, At, B1); G8_BAR;
    }
    { G8_LDB(B0, 0, 0); G8_LDA(At, 0, 0); G8_STAGE(G8_SA(1, 1), cA + (size_t)(nt - 1) * kstep + hstep);
      G8_BAR; G8_WAIT_L(0); G8_MMA(0, 0, At, B0); G8_BAR;
      G8_LDB(B1, 0, 1); G8_BAR; G8_WAIT_L(0); G8_MMA(0, 1, At, B1); G8_BAR;
      G8_LDA(At, 0, 1); G8_WAIT_V(4); G8_BAR; G8_WAIT_L(0); G8_MMA(1, 0, At, B0); G8_MMA(1, 1, At, B1); G8_BAR; }
    { G8_LDB(B0, 1, 0); G8_LDA(At, 1, 0); G8_WAIT_V(2); G8_BAR; G8_WAIT_L(0); G8_MMA(0, 0, At, B0); G8_BAR;
      G8_LDB(B1, 1, 1); G8_WAIT_V(0); G8_BAR; G8_WAIT_L(0); G8_MMA(0, 1, At, B1); G8_BAR;
      G8_LDA(At, 1, 1); G8_BAR; G8_WAIT_L(0); G8_MMA(1, 0, At, B0); G8_MMA(1, 1, At, B1); G8_BAR; }
    if (wr == 0) G8_BAR;
#undef G8_SA
#undef G8_SB
#undef G8_STAGE
#undef G8_LDA
#undef G8_LDB
#undef G8_MMA
#undef G8_WAIT_V
#undef G8_WAIT_L
#undef G8_BAR
#undef G8_SCHED
}
}

__device__ void phase_inproj(const Args& a, char* lds, int vb, int nb) {
    const int tid = threadIdx.x, lane = tid & 63, wid = tid >> 6, wr = wid >> 2, wc = wid & 3, fr = lane & 15, fq = lane >> 4;
    unsigned char* ws = a.ws;
    const bf16_t* XN = (const bf16_t*)(ws + WS_XN);
    const bf16_t* WIN = (const bf16_t*)(ws + WS_WIN);
    const float* rope = (const float*)(ws + WS_ROPE);
    bf16_t* Qo = (bf16_t*)(ws + WS_Q); bf16_t* Ko = (bf16_t*)(ws + WS_K); bf16_t* Vo = (bf16_t*)(ws + WS_VV); bf16_t* Lo = (bf16_t*)(ws + WS_L); bf16_t* Zo = (bf16_t*)(ws + WS_ZG);
    constexpr int N_LAT = 128 * 7, N_ALL = N_LAT + 16 * 3;
#pragma unroll 1
    for (int it = vb; it < N_ALL; it += nb) {
        int tt, ft;
        if (it < N_LAT) { tt = it / 7; ft = it % 7; } else { const int j = it - N_LAT; tt = 128 + j / 3; ft = 2 + j % 3; }
        f32x4 acc[2][2][4][2];
        g8::core(acc, WIN, XN, ft * 256, tt * 256, DM, lds);
        const bool lat = tt < 128;
#pragma unroll
        for (int ai = 0; ai < 2; ++ai) {
            const int g64 = ft * 4 + ai * 2 + wr;
            if (g64 < 10) {
                const bool isq = g64 < 8;
                const float* gn = isq ? a.in[I_QNG] : a.in[I_KNG];
                const float osc = isq ? 0.125f * 1.4426950408889634f : 1.f;
                float gnv[4][4];
#pragma unroll
                for (int m = 0; m < 4; ++m) { const f32x4 gv = *(const f32x4*)(gn + m * 16 + fq * 4); gnv[m][0] = gv[0]; gnv[m][1] = gv[1]; gnv[m][2] = gv[2]; gnv[m][3] = gv[3]; }
#pragma unroll
                for (int bj = 0; bj < 2; ++bj)
#pragma unroll
                    for (int n = 0; n < 2; ++n) {
                        float ss = 0.f;
#pragma unroll
                        for (int m = 0; m < 4; ++m)
#pragma unroll
                            for (int j = 0; j < 4; ++j) ss += acc[ai][bj][m][n][j] * acc[ai][bj][m][n][j];
                        ss += __shfl_xor(ss, 16); ss += __shfl_xor(ss, 32);
                        const float rinv = rsqrtf(ss * (1.f / 64.f) + EPS);
                        const int row = tt * 256 + bj * 128 + wc * 32 + n * 16 + fr;
                        int b, t, s_; if (lat) { b = row >> 11; t = row & 2047; s_ = CTX + t; } else { const int rc = row - NTOK; b = rc >> 8; t = 0; s_ = rc & 255; }
                        bf16_t* dst = isq ? Qo + ((size_t)(b * 8 + g64) * SEQ + t) * 64 : Ko + ((size_t)(b * 2 + (g64 - 8)) * STOT + s_) * 64;
#pragma unroll
                        for (int ax = 0; ax < 2; ++ax) {
                            const int pos = ax == 0 ? (t >> 6) : (t & 63);
                            float o1[4], o2[4];
#pragma unroll
                            for (int j = 0; j < 4; ++j) {
                                const float x1 = acc[ai][bj][2 * ax][n][j] * rinv * gnv[2 * ax][j], x2 = acc[ai][bj][2 * ax + 1][n][j] * rinv * gnv[2 * ax + 1][j];
                                float c1 = x1, c2 = x2;
                                if (lat) { const f32x2 cs = *(const f32x2*)(rope + (pos * 16 + fq * 4 + j) * 2); c1 = x1 * cs[0] - x2 * cs[1]; c2 = x1 * cs[1] + x2 * cs[0]; }
                                o1[j] = c1 * osc; o2[j] = c2 * osc; }
                            *(u32x2*)(dst + ax * 32 + fq * 4) = (u32x2){pk2(o1[0], o1[1]), pk2(o1[2], o1[3])};
                            *(u32x2*)(dst + ax * 32 + 16 + fq * 4) = (u32x2){pk2(o2[0], o2[1]), pk2(o2[2], o2[3])};
                        }
                    }
            } else if (g64 < 12) {
#pragma unroll
                for (int bj = 0; bj < 2; ++bj)
#pragma unroll
                    for (int n = 0; n < 2; ++n) {
                        const int row = tt * 256 + bj * 128 + wc * 32 + n * 16 + fr;
                        int b, s_; if (lat) { b = row >> 11; s_ = CTX + (row & 2047); } else { const int rc = row - NTOK; b = rc >> 8; s_ = rc & 255; }
                        bf16_t* vp = Vo + ((size_t)(b * 2 + (g64 - 10)) * 64) * STOT + s_;
#pragma unroll
                        for (int m = 0; m < 4; ++m)
#pragma unroll
                            for (int j = 0; j < 4; ++j) vp[(size_t)(m * 16 + fq * 4 + j) * STOT] = f2bf(acc[ai][bj][m][n][j]);
                    }
            } else {
                const bool isz = g64 >= 20;
#pragma unroll
                for (int bj = 0; bj < 2; ++bj)
#pragma unroll
                    for (int n = 0; n < 2; ++n) {
                        const int row = tt * 256 + bj * 128 + wc * 32 + n * 16 + fr;
                        bf16_t* dst;
                        if (isz) dst = Zo + (size_t)row * DLRU + (g64 - 20) * 64;
                        else { int b, s_; if (lat) { b = row >> 11; s_ = CTX + (row & 2047); } else { const int rc = row - NTOK; b = rc >> 8; s_ = rc & 255; }
                            dst = Lo + ((size_t)b * STOT + s_) * DLRU + (g64 - 12) * 64; }
#pragma unroll
                        for (int m = 0; m < 4; ++m) { f32x4 v = acc[ai][bj][m][n];
                            if (isz) { v[0] = gelu_tanh(v[0]); v[1] = gelu_tanh(v[1]); v[2] = gelu_tanh(v[2]); v[3] = gelu_tanh(v[3]); }
                            *(u32x2*)(dst + m * 16 + fq * 4) = (u32x2){pk2(v[0], v[1]), pk2(v[2], v[3])}; }
                    }
            }
        }
        __syncthreads();
    }
}

constexpr int AT_KP = 144, AT_VP = 136, AT_STAGE = 64 * AT_KP + 64 * AT_VP;
__device__ void attn_item(const Args& a, char* lds, int b, int head, int qblk) {
    const int tid = threadIdx.x, lane = tid & 63, wid = tid >> 6, r32 = lane & 31, hi = lane >> 5;
    unsigned char* ws = a.ws;
    const int kvh = head >> 2;
    const bf16_t* Qp = (const bf16_t*)(ws + WS_Q) + ((size_t)(b * 8 + head) * SEQ + qblk * 256 + wid * 32 + r32) * 64 + hi * 8;
    const bf16_t* Kp = (const bf16_t*)(ws + WS_K) + (size_t)(b * 2 + kvh) * STOT * 64;
    const bf16_t* Vp = (const bf16_t*)(ws + WS_VV) + (size_t)(b * 2 + kvh) * 64 * STOT;
    bf16x8 qf[4];
#pragma unroll
    for (int ds = 0; ds < 4; ++ds) qf[ds] = *(const bf16x8*)(Qp + ds * 16);
    const int srow = tid >> 3, sch = tid & 7;
    const bf16_t* kg = Kp + (size_t)srow * 64 + sch * 8;
    const bf16_t* vg = Vp + (size_t)srow * STOT + sch * 8;
    u32x4 krA, vrA, krB, vrB;
    f32x16 o[2]; float lsum = 0.f;
    float negM;
    { float gq = fabsf(a.in[I_QNG][lane]), gk = fabsf(a.in[I_KNG][lane]);
#pragma unroll
      for (int o_ = 32; o_ > 0; o_ >>= 1) { gq = fmaxf(gq, __shfl_xor(gq, o_)); gk = fmaxf(gk, __shfl_xor(gk, o_)); }
      negM = -(64.f * 0.125f * 1.4426950408889634f * 1.01f) * gq * gk; }
#pragma unroll
    for (int dt = 0; dt < 2; ++dt)
#pragma unroll
        for (int r = 0; r < 16; ++r) o[dt][r] = 0.f;
    char* KS = lds; char* VS = lds + 2 * 64 * AT_KP;
#define A_LOADK(X, s0) do { kr##X = *(const u32x4*)(kg + (size_t)(s0) * 64); } while (0)
#define A_LOADV(X, s0) do { vr##X = *(const u32x4*)(vg + (s0)); } while (0)
#define A_WRITEK(X, st) do { *(u32x4*)(KS + (st) * 64 * AT_KP + srow * AT_KP + sch * 16) = kr##X; } while (0)
#define A_WRITEV(X, st) do { char* vb_ = VS + (st) * 64 * AT_VP + srow * AT_VP + sch * 16; *(u32x2*)vb_ = (u32x2){vr##X[0], vr##X[1]}; *(u32x2*)(vb_ + 8) = (u32x2){vr##X[2], vr##X[3]}; } while (0)
    constexpr int NT = STOT / 64;
    f32x16 sc[2], sn[2];
    A_LOADK(A, 0); A_LOADV(A, 0); A_WRITEK(A, 0); A_WRITEV(A, 0); A_LOADK(A, 64); A_WRITEK(A, 1); A_LOADK(B, 128); A_LOADV(B, 64); __syncthreads();
#pragma unroll
    for (int kt = 0; kt < 2; ++kt) {
#pragma unroll
        for (int r = 0; r < 16; ++r) sc[kt][r] = negM;
#pragma unroll
        for (int ds = 0; ds < 4; ++ds) { const bf16x8 ka = *(const bf16x8*)(KS + (kt * 32 + r32) * AT_KP + (ds * 16 + hi * 8) * 2); sc[kt] = MFMA(ka, qf[ds], sc[kt]); }
    }
    __syncthreads();
    f32x16 ol;
#pragma unroll
    for (int r = 0; r < 16; ++r) ol[r] = 0.f;
    const u32x4 ones_w = {0x3F803F80u, 0x3F803F80u, 0x3F803F80u, 0x3F803F80u};
    const bf16x8 ones = *(const bf16x8*)&ones_w;
#define A_STEP(J, SC, SN, XW, XL) do { const int j_ = (J); \
        const int jk = (j_ + 3 < NT) ? j_ + 3 : NT - 1, jv = (j_ + 2 < NT) ? j_ + 2 : NT - 1; \
        A_LOADK(XL, jk * 64); A_LOADV(XL, jv * 64); \
        const char* ksn = KS + ((j_ + 1) & 1) * 64 * AT_KP; const char* vs = VS + (j_ & 1) * 64 * AT_VP; \
        _Pragma("unroll") for (int kt = 0; kt < 2; ++kt) { \
            _Pragma("unroll") for (int r = 0; r < 16; ++r) SN[kt][r] = negM; \
            _Pragma("unroll") for (int ds = 0; ds < 4; ++ds) { \
                const bf16x8 ka = *(const bf16x8*)(ksn + (kt * 32 + r32) * AT_KP + (ds * 16 + hi * 8) * 2); \
                SN[kt] = MFMA(ka, qf[ds], SN[kt]); \
                _Pragma("unroll") for (int e = 0; e < 4; ++e) { const int f = (kt * 4 + ds) * 4 + e; SC[f >> 4][f & 15] = __builtin_amdgcn_exp2f(SC[f >> 4][f & 15]); } \
                __builtin_amdgcn_sched_barrier(0); } } \
        _Pragma("unroll") for (int kt = 0; kt < 2; ++kt) \
            _Pragma("unroll") for (int s = 0; s < 2; ++s) { \
                u32x4 pw = {pk2(SC[kt][8 * s], SC[kt][8 * s + 1]), pk2(SC[kt][8 * s + 2], SC[kt][8 * s + 3]), pk2(SC[kt][8 * s + 4], SC[kt][8 * s + 5]), pk2(SC[kt][8 * s + 6], SC[kt][8 * s + 7])}; \
                const bf16x8 pb = *(bf16x8*)&pw; \
                _Pragma("unroll") for (int dt = 0; dt < 2; ++dt) { \
                    const char* vp = vs + (dt * 32 + r32) * AT_VP + (kt * 32 + s * 16 + hi * 4) * 2; \
                    const u32x2 lo = *(const u32x2*)vp, hh = *(const u32x2*)(vp + 16); \
                    u32x4 aw = {lo[0], lo[1], hh[0], hh[1]}; \
                    o[dt] = MFMA(*(bf16x8*)&aw, pb, o[dt]); } \
                ol = MFMA(ones, pb, ol); } \
        A_WRITEK(XW, j_ & 1); A_WRITEV(XW, (j_ + 1) & 1); \
        __syncthreads(); } while (0)
#pragma unroll 1
    for (int j = 0; j < NT; j += 2) { A_STEP(j, sc, sn, B, A); A_STEP(j + 1, sn, sc, A, B); }
#undef A_STEP
    lsum = ol[0];
#undef A_LOADK
#undef A_LOADV
#undef A_WRITEK
#undef A_WRITEV
    const float inv = fast_rcp(lsum);
    bf16_t* outp = (bf16_t*)(ws + WS_A2) + ((size_t)b * SEQ + qblk * 256 + wid * 32 + r32) * KOUT + head * 64;
#pragma unroll
    for (int dt = 0; dt < 2; ++dt)
#pragma unroll
        for (int g = 0; g < 4; ++g) {
            u32x2 v = {pk2(o[dt][4 * g] * inv, o[dt][4 * g + 1] * inv), pk2(o[dt][4 * g + 2] * inv, o[dt][4 * g + 3] * inv)};
            *(u32x2*)(outp + dt * 32 + g * 8 + hi * 4) = v;
        }
}

constexpr int LR_RAW = 0;
constexpr int LR_U   = 33792;
constexpr int LR_BB  = LR_U + 33280;
constexpr int LR_UB  = LR_BB + 33280;
constexpr int LR_WG  = LR_UB + 18432;
constexpr int LR_SEG = LR_WG + 18432;
constexpr int LR_HC  = LR_SEG + 4096;
constexpr int LR_CST = LR_HC + 512;
constexpr int LR_END = LR_CST + 768;
__device__ void lru_item(const Args& a, char* lds, int b, int n, int d) {
    const int tid = threadIdx.x, lane = tid & 63, wid = tid >> 6, r32 = lane & 31, hi = lane >> 5;
    unsigned char* ws = a.ws;
    float* RAW = (float*)(lds + LR_RAW); float* AA = (float*)(lds + LR_RAW); float* U = (float*)(lds + LR_U); float* BB = (float*)(lds + LR_BB);
    char* UB = lds + LR_UB; char* WG = lds + LR_WG; float* SEG = (float*)(lds + LR_SEG); float* HC = (float*)(lds + LR_HC);
    const bf16_t* Lg = (const bf16_t*)(ws + WS_L) + (size_t)b * STOT * DLRU + n * 64;
    const bf16_t* Zg = (const bf16_t*)(ws + WS_ZG) + (size_t)b * SEQ * DLRU + n * 64;
    bf16_t* Og = (bf16_t*)(ws + WS_A2) + (size_t)b * SEQ * KOUT + 512 + d * 512 + n * 64;
    {
        const bf16_t* wsrc = (const bf16_t*)(ws + WS_RGW) + (size_t)(d * 8 + n) * 128 * 64;
#pragma unroll
        for (int i = 0; i < 2; ++i) { const int c = tid + NTHR * i, r = c >> 3, ch = c & 7; *(u32x4*)(WG + r * 144 + ch * 16) = *(const u32x4*)(wsrc + r * 64 + ch * 8); }
        if (tid < 128) HC[tid] = 0.f;
    }
    const int ct = wid & 1, tt = wid >> 1;
    float* CST = (float*)(lds + LR_CST);
    if (tid < 64) { const int c = n * 64 + tid; CST[tid] = a.in[I_RGBA][d * 512 + c]; CST[64 + tid] = a.in[I_RGBI][d * 512 + c];
        const float x = -a.in[I_RGLAM][d * 512 + c]; CST[128 + tid] = -8.f * (fmaxf(x, 0.f) + log1pf(__expf(-fabsf(x)))); }
    const int sc = tid & 63, sg = tid >> 6;
    const float cw0 = a.in[I_CONVW][0 * 512 + n * 64 + sc], cw1 = a.in[I_CONVW][1 * 512 + n * 64 + sc], cw2 = a.in[I_CONVW][2 * 512 + n * 64 + sc], cw3 = a.in[I_CONVW][3 * 512 + n * 64 + sc];
    const float cbias = a.in[I_CONVB][n * 64 + sc];
    __syncthreads();
    int par = 0;
    for (int step = 0; step < 18; ++step) {
        const bool isctx = step < 2;
        const int tl = isctx ? (d == 0 ? step : 1 - step) : (d == 0 ? step - 2 : 17 - step);
        const int sb = isctx ? 0 : CTX, sl = isctx ? CTX : SEQ, t0 = tl * 128;
        for (int e = tid; e < 131 * 8; e += NTHR) { const int r = e >> 3, ch = e & 7, t = t0 - 2 + r;
            u32x4 v = {0u, 0u, 0u, 0u}; if (t >= 0 && t < sl) v = *(const u32x4*)(Lg + (size_t)(sb + t) * DLRU + ch * 8);
            float* dst = RAW + r * 64 + ch * 8;
            dst[0] = bflo(v[0]); dst[1] = bfhi(v[0]); dst[2] = bflo(v[1]); dst[3] = bfhi(v[1]); dst[4] = bflo(v[2]); dst[5] = bfhi(v[2]); dst[6] = bflo(v[3]); dst[7] = bfhi(v[3]); }
        __syncthreads();
        {
            const float* rp = RAW + (sg * 16) * 64 + sc;
            float x0 = rp[0], x1 = rp[64], x2 = rp[128];
            float* up = U + (sg * 16) * 65 + sc; char* ubp = UB + (sg * 16) * 144 + sc * 2;
#pragma unroll
            for (int i = 0; i < 16; ++i) { const float x3 = rp[(i + 3) * 64];
                const float u = cbias + cw0 * x0 + cw1 * x1 + cw2 * x2 + cw3 * x3;
                up[i * 65] = u; *(bf16_t*)(ubp + i * 144) = f2bf(u); x0 = x1; x1 = x2; x2 = x3; }
        }
        __syncthreads();
        {
            f32x16 ga, gi;
#pragma unroll
            for (int r = 0; r < 16; ++r) { ga[r] = 0.f; gi[r] = 0.f; }
#pragma unroll
            for (int ks = 0; ks < 4; ++ks) {
                const bf16x8 wa = *(const bf16x8*)(WG + (ct * 32 + r32) * 144 + (ks * 16 + hi * 8) * 2);
                const bf16x8 wi = *(const bf16x8*)(WG + (64 + ct * 32 + r32) * 144 + (ks * 16 + hi * 8) * 2);
                const bf16x8 ub = *(const bf16x8*)(UB + (tt * 32 + r32) * 144 + (ks * 16 + hi * 8) * 2);
                ga = MFMA(wa, ub, ga); gi = MFMA(wi, ub, gi);
            }
            const int t = tt * 32 + r32;
#pragma unroll
            for (int r = 0; r < 16; ++r) { const int c = ct * 32 + 8 * (r >> 2) + 4 * hi + (r & 3);
                const float rr = sigmoidf_(ga[r] + CST[c]), ii = sigmoidf_(gi[r] + CST[64 + c]);
                const float la = CST[128 + c] * rr, av = __expf(la), mult = __builtin_amdgcn_sqrtf(fmaxf(1.f - av * av, 0.f));
                const float u = U[t * 65 + c];
                AA[t * 65 + c] = av; BB[t * 65 + c] = mult * ii * u; }
        }
        __syncthreads();
        float av[16], bv[16]; float Ap = 1.f, Bp = 0.f;
#pragma unroll
        for (int k = 0; k < 16; ++k) { const int p = sg * 16 + k, t = d == 0 ? p : 127 - p; av[k] = AA[t * 65 + sc]; bv[k] = BB[t * 65 + sc]; Bp = av[k] * Bp + bv[k]; Ap = av[k] * Ap; }
        SEG[sg * 64 + sc] = Ap; SEG[512 + sg * 64 + sc] = Bp;
        __syncthreads();
        float h = HC[par * 64 + sc];
        for (int s2 = 0; s2 < sg; ++s2) h = SEG[s2 * 64 + sc] * h + SEG[512 + s2 * 64 + sc];
        {
            const int tfirst = d == 0 ? sg * 16 : 127 - sg * 16;
            const bf16_t* zp = Zg + (size_t)(t0 + tfirst) * DLRU + sc; bf16_t* op = Og + (size_t)(t0 + tfirst) * KOUT + sc;
            const int zstep = d == 0 ? DLRU : -DLRU, ostep = d == 0 ? KOUT : -KOUT;
#pragma unroll
            for (int k = 0; k < 16; ++k) { h = av[k] * h + bv[k];
                if (!isctx) { const float gz = bf2f(*zp); *op = f2bf(h * gz); zp += zstep; op += ostep; } }
        }
        if (sg == 7) HC[(par ^ 1) * 64 + sc] = h;
        par ^= 1;
        __syncthreads();
    }
}

#ifndef LRU_REPS
#define LRU_REPS 1
#endif
__device__ void phase_mixer(const Args& a, char* lds, int vb, int nb) {
#pragma unroll 1
    for (int it = vb; it < 256; it += nb) { for (int rep_ = 0; rep_ < LRU_REPS; ++rep_) { lru_item(a, lds, it >> 4, (it >> 1) & 7, it & 1); __syncthreads(); } }
#pragma unroll 1
    for (int at = vb; at < 1024; at += nb) { const int bk = at >> 5, w = at & 31; attn_item(a, lds, bk >> 1, (bk & 1) * 4 + (w >> 3), w & 7); __syncthreads(); }
}

__device__ void phase_outproj(const Args& a, char* lds, int vb, int nb) {
    const int tid = threadIdx.x, lane = tid & 63, wid = tid >> 6, wr = wid >> 2, wc = wid & 3, fr = lane & 15, fq = lane >> 4;
    const bf16_t* A2 = (const bf16_t*)(a.ws + WS_A2); const bf16_t* WO = (const bf16_t*)(a.ws + WS_WOUT);
    bf16_t* MIX = (bf16_t*)(a.ws + WS_MIX);
#pragma unroll 1
    for (int it = vb; it < 128 * 4; it += nb) {
        const int tt = it >> 2, ft = it & 3;
        f32x4 acc[2][2][4][2];
        g8::core(acc, WO, A2, ft * 256, tt * 256, KOUT, lds);
#pragma unroll
        for (int bj = 0; bj < 2; ++bj)
#pragma unroll
            for (int n = 0; n < 2; ++n) {
                bf16_t* rp = MIX + (size_t)(tt * 256 + bj * 128 + wc * 32 + n * 16 + fr) * DM + ft * 256 + wr * 64 + fq * 4;
#pragma unroll
                for (int ai = 0; ai < 2; ++ai)
#pragma unroll
                    for (int m = 0; m < 4; ++m) { const f32x4 v = acc[ai][bj][m][n]; *(u32x2*)(rp + ai * 128 + m * 16) = (u32x2){pk2(v[0], v[1]), pk2(v[2], v[3])}; }
            }
        __syncthreads();
    }
}

__device__ void phase_rowpass(const Args& a, int vb, int nb) {
    const int tid = threadIdx.x, lane = tid & 63, wid = tid >> 6;
    const float* mod = (const float*)(a.ws + WS_MOD);
    const bf16_t* MIX = (const bf16_t*)(a.ws + WS_MIX);
    bf16_t* HX = (bf16_t*)(a.ws + WS_HX2); bf16_t* XM = (bf16_t*)(a.ws + WS_XM);
    for (int row = vb * 8 + wid; row < NTOK; row += nb * 8) {
        const int b = row >> 11;
        const float* mrow = mod + (size_t)b * 6144;
        f32x4 mv[4], xv[4]; float ss = 0.f;
#pragma unroll
        for (int i = 0; i < 4; ++i) { const u32x2 mw = *(const u32x2*)(MIX + (size_t)row * DM + i * 256 + lane * 4); mv[i] = (f32x4){bflo(mw[0]), bfhi(mw[0]), bflo(mw[1]), bfhi(mw[1])};
            xv[i] = *(const f32x4*)(a.in[I_X] + (size_t)row * DM + i * 256 + lane * 4);
            ss += mv[i][0] * mv[i][0] + mv[i][1] * mv[i][1] + mv[i][2] * mv[i][2] + mv[i][3] * mv[i][3]; }
        ss = wave_sum(ss);
        const float rinv = rsqrtf(ss * (1.f / DM) + EPS);
        float s2 = 0.f;
#pragma unroll
        for (int i = 0; i < 4; ++i) { const int c = i * 256 + lane * 4;
            const f32x4 gp = *(const f32x4*)(a.in[I_GPOSTMIX] + c), g1 = *(const f32x4*)(mrow + 2048 + c);
#pragma unroll
            for (int j = 0; j < 4; ++j) { const float xm = xv[i][j] + g1[j] * (mv[i][j] * rinv * gp[j]); xv[i][j] = xm; s2 += xm * xm; }
            const u32x2 xw = {pk2(xv[i][0], xv[i][1]), pk2(xv[i][2], xv[i][3])}; *(u32x2*)(XM + (size_t)row * DM + c) = xw; }
        s2 = wave_sum(s2);
        const float rinv2 = rsqrtf(s2 * (1.f / DM) + EPS);
#pragma unroll
        for (int i = 0; i < 4; ++i) { const int c = i * 256 + lane * 4;
            const f32x4 gf = *(const f32x4*)(a.in[I_GPREFFN] + c), sh = *(const f32x4*)(mrow + 3072 + c), sc = *(const f32x4*)(mrow + 4096 + c);
            float o[4];
#pragma unroll
            for (int j = 0; j < 4; ++j) o[j] = xv[i][j] * rinv2 * gf[j] * (1.f + sc[j]) + sh[j];
            u32x2 w = {pk2(o[0], o[1]), pk2(o[2], o[3])}; *(u32x2*)(HX + (size_t)row * DM + c) = w; }
    }
}

__device__ __forceinline__ int fkey(float f) { const int b = __float_as_int(f); return b ^ ((b >> 31) & 0x7fffffff); }
__device__ __forceinline__ float fval(int k) { return __int_as_float(k ^ ((k >> 31) & 0x7fffffff)); }
#define CE_DESC(x, y) do { const int hi_ = max((x), (y)), lo_ = min((x), (y)); (x) = hi_; (y) = lo_; } while (0)
__device__ __forceinline__ void sort16_desc(int (&v)[16]) {
#pragma unroll
    for (int k = 2; k <= 16; k <<= 1)
#pragma unroll
        for (int j = k >> 1; j > 0; j >>= 1)
#pragma unroll
            for (int i = 0; i < 16; ++i) { const int l = i ^ j; if (l > i) { if ((i & k) == 0) { CE_DESC(v[i], v[l]); } else { CE_DESC(v[l], v[i]); } } }
}
__device__ __forceinline__ void merge16_desc(int (&v)[16]) {
#pragma unroll
    for (int j = 8; j > 0; j >>= 1)
#pragma unroll
        for (int i = 0; i < 16; ++i) { const int l = i ^ j; if (l > i) CE_DESC(v[i], v[l]); }
}
__device__ __forceinline__ void top16_merge(int (&A)[16], const int (&B)[16]) {
#pragma unroll
    for (int i = 0; i < 16; ++i) A[i] = max(A[i], B[15 - i]);
    merge16_desc(A);
}
constexpr int PK_QS = 0;
constexpr int PK_SK = 256 * E_PITCH;
constexpr int PK_ML = PK_SK + 128 * E_PITCH;
constexpr int PK_X  = PK_ML + 32768;
constexpr int PK_END = PK_X + 8192;
__device__ void phase_peer_topk(const Args& a, char* lds, int vb, int nb) {
    unsigned char* ws = a.ws;
    const bf16_t* HX = (const bf16_t*)(ws + WS_HX2); const bf16_t* WQ = (const bf16_t*)(ws + WS_WQ); const bf16_t* SUBK = (const bf16_t*)(ws + WS_SUBK);
    int* IDX = (int*)(ws + WS_IDX);
    int* ML = (int*)(lds + PK_ML); int* XB = (int*)(lds + PK_X);
    for (int it = vb; it < 128 * 8; it += nb) {
        const int rt = it >> 3, h = it & 7, row0 = rt * 256;
        bf16_t* park = (bf16_t*)(ws + WS_MIX) + (size_t)it * (256 * 128);
        int tid = threadIdx.x;
        {
            f32x4 acc8[2][2][4][2];
            g8::core(acc8, WQ, HX, h * 256, row0, DM, lds);
            __syncthreads();
            asm volatile("" : "+v"(tid));
            const int lane = tid & 63, wid = tid >> 6;
            const int w8r = wid >> 2, w8c = wid & 3, fr = lane & 15, fq = lane >> 4;
#pragma unroll
            for (int bj = 0; bj < 2; ++bj)
#pragma unroll
                for (int m = 0; m < 4; ++m)
#pragma unroll
                    for (int n = 0; n < 2; ++n) { const int tok = bj * 128 + w8c * 32 + n * 16 + fr, d = w8r * 64 + m * 16 + fq * 4;
                        const f32x4 v0 = acc8[0][bj][m][n], v1 = acc8[1][bj][m][n];
                        *(u32x2*)(lds + PK_QS + tok * E_PITCH + d * 2) = (u32x2){pk2(v0[0], v0[1]), pk2(v0[2], v0[3])};
                        *(u32x2*)(park + tok * 128 + d) = (u32x2){pk2(v1[0], v1[1]), pk2(v1[2], v1[3])}; }
        }
        const int lane = tid & 63, wid = tid >> 6, wm = wid & 3, wn = wid >> 2, r32 = lane & 31, hi = lane >> 5;
#pragma unroll 1
        for (int p = 0; p < 2; ++p) {
            f32x16 acc[2][2];
            if (p == 1) {
#pragma unroll
                for (int i = 0; i < 8; ++i) { const int c = tid + NTHR * i, tok = c >> 4, ch = c & 15; *(u32x4*)(lds + PK_QS + tok * E_PITCH + ch * 16) = *(const u32x4*)(park + tok * 128 + ch * 8); }
            }
            {
                const bf16_t* sk = SUBK + (size_t)(h * 2 + p) * 128 * 128;
#pragma unroll
                for (int i = 0; i < 4; ++i) { const int c = tid + NTHR * i, r = c >> 4, ch = c & 15; *(u32x4*)(lds + PK_SK + r * E_PITCH + ch * 16) = *(const u32x4*)(sk + r * 128 + ch * 8); }
            }
            __syncthreads();
#pragma unroll
            for (int ft = 0; ft < 2; ++ft)
#pragma unroll
                for (int tt = 0; tt < 2; ++tt)
#pragma unroll
                    for (int r = 0; r < 16; ++r) acc[ft][tt][r] = 0.f;
#pragma unroll
            for (int ks = 0; ks < 8; ++ks) {
                const bf16x8 a0 = *(const bf16x8*)(lds + PK_SK + (wn * 64 + r32) * E_PITCH + (ks * 16 + hi * 8) * 2), a1 = *(const bf16x8*)(lds + PK_SK + (wn * 64 + 32 + r32) * E_PITCH + (ks * 16 + hi * 8) * 2);
                const bf16x8 b0 = *(const bf16x8*)(lds + PK_QS + (wm * 64 + r32) * E_PITCH + (ks * 16 + hi * 8) * 2), b1 = *(const bf16x8*)(lds + PK_QS + (wm * 64 + 32 + r32) * E_PITCH + (ks * 16 + hi * 8) * 2);
                acc[0][0] = MFMA(a0, b0, acc[0][0]); acc[0][1] = MFMA(a0, b1, acc[0][1]);
                acc[1][0] = MFMA(a1, b0, acc[1][0]); acc[1][1] = MFMA(a1, b1, acc[1][1]);
            }
#pragma unroll
            for (int tt = 0; tt < 2; ++tt) {
                int A[16], B[16];
#pragma unroll
                for (int r = 0; r < 16; ++r) { const int key = wn * 64 + 8 * (r >> 2) + 4 * hi + (r & 3);
                    A[r] = (fkey(acc[0][tt][r]) & ~127) | key; B[r] = (fkey(acc[1][tt][r]) & ~127) | (key + 32); }
                sort16_desc(A); sort16_desc(B); top16_merge(A, B);
#pragma unroll
                for (int r = 0; r < 16; ++r) { auto rr = __builtin_amdgcn_permlane32_swap((unsigned)A[r], (unsigned)A[r], false, false); B[r] = (int)(hi ? rr[0] : rr[1]); }
                top16_merge(A, B);
                const int tok = wm * 64 + tt * 32 + r32;
                if (wn == 1 && hi == 0) {
#pragma unroll
                    for (int r = 0; r < 16; ++r) XB[(wm * 32 + r32) * 16 + r] = A[r];
                }
                __syncthreads();
                if (wn == 0 && hi == 0) {
#pragma unroll
                    for (int r = 0; r < 16; ++r) B[r] = XB[(wm * 32 + r32) * 16 + r];
                    top16_merge(A, B);
#pragma unroll
                    for (int r = 0; r < 16; ++r) ML[(tok * 2 + p) * 16 + r] = A[r];
                }
                __syncthreads();
            }
        }
        if (tid < 256) {
            const int tok = tid;
            int s1[16], s2[16];
#pragma unroll
            for (int r = 0; r < 16; ++r) { s1[r] = ML[(tok * 2 + 0) * 16 + r]; s2[r] = ML[(tok * 2 + 1) * 16 + r]; }
            float f1[16], f2[16];
#pragma unroll
            for (int r = 0; r < 16; ++r) { f1[r] = fval(s1[r] & ~127); f2[r] = fval(s2[r] & ~127); }
            int G0[16], G1[16], G2[16], G3[16];
#pragma unroll
            for (int bb = 0; bb < 16; ++bb) G0[bb] = (fkey(f1[0] + f2[bb]) & ~255) | (0 * 16 + bb);
#pragma unroll
            for (int bb = 0; bb < 8; ++bb) G1[bb] = (fkey(f1[1] + f2[bb]) & ~255) | (1 * 16 + bb);
#pragma unroll
            for (int bb = 0; bb < 5; ++bb) G1[8 + bb] = (fkey(f1[2] + f2[bb]) & ~255) | (2 * 16 + bb);
#pragma unroll
            for (int bb = 0; bb < 3; ++bb) G1[13 + bb] = (fkey(f1[3] + f2[bb]) & ~255) | (3 * 16 + bb);
            G2[0] = (fkey(f1[3] + f2[3]) & ~255) | (3 * 16 + 3);
#pragma unroll
            for (int bb = 0; bb < 3; ++bb) G2[1 + bb] = (fkey(f1[4] + f2[bb]) & ~255) | (4 * 16 + bb);
#pragma unroll
            for (int aa = 5; aa < 8; ++aa)
#pragma unroll
                for (int bb = 0; bb < 2; ++bb) G2[4 + (aa - 5) * 2 + bb] = (fkey(f1[aa] + f2[bb]) & ~255) | (aa * 16 + bb);
#pragma unroll
            for (int aa = 8; aa < 14; ++aa) G2[10 + (aa - 8)] = (fkey(f1[aa] + f2[0]) & ~255) | (aa * 16);
            G3[0] = (fkey(f1[14] + f2[0]) & ~255) | (14 * 16); G3[1] = (fkey(f1[15] + f2[0]) & ~255) | (15 * 16);
#pragma unroll
            for (int r = 2; r < 16; ++r) G3[r] = (int)0x80000000;
            sort16_desc(G0); sort16_desc(G1); sort16_desc(G2); sort16_desc(G3);
            top16_merge(G0, G1); top16_merge(G2, G3); top16_merge(G0, G2);
            float tv[16]; float mx = fval(G0[0] & ~255), sum = 0.f;
#pragma unroll
            for (int r = 0; r < 16; ++r) { tv[r] = __expf(fval(G0[r] & ~255) - mx); sum += tv[r]; }
            const float rs = 1.f / sum;
            const size_t ob = ((size_t)(row0 + tok) * 8 + h) * 16;
#pragma unroll
            for (int r = 0; r < 16; ++r) { const int code = G0[r] & 255, aa = code >> 4, bb = code & 15;
                const int i1 = ML[(tok * 2 + 0) * 16 + aa] & 127, i2 = ML[(tok * 2 + 1) * 16 + bb] & 127;
                IDX[ob + r] = (i1 * 128 + i2) | (int)((unsigned)f2bf(tv[r] * rs) << 16); }
        }
        __syncthreads();
    }
}

template <int CTRL> __device__ __forceinline__ float dpp_add(float v) { return v + __uint_as_float(__builtin_amdgcn_update_dpp(0u, __float_as_uint(v), CTRL, 0xf, 0xf, true)); }
__device__ __forceinline__ float wave_sum_bcast(float p) {
    p = dpp_add<0xB1>(p); p = dpp_add<0x4E>(p); p = dpp_add<0x141>(p); p = dpp_add<0x140>(p);
    const unsigned u = __float_as_uint(p);
    return (__uint_as_float(__builtin_amdgcn_readlane(u, 0)) + __uint_as_float(__builtin_amdgcn_readlane(u, 16))) + (__uint_as_float(__builtin_amdgcn_readlane(u, 32)) + __uint_as_float(__builtin_amdgcn_readlane(u, 48)));
}
typedef float f32x4v __attribute__((ext_vector_type(4)));
constexpr int P7_RS = 9;
constexpr int P7_NR = PEER_N >> P7_RS;
constexpr int P7_HTP = 1024 + 64;
constexpr float H_SCALE = 16.f;
constexpr int P7_ATP = 2048 + 16;
constexpr float W_SCALE = 16.f;
constexpr int P7_RING = 16384;
constexpr int P7_WLDS = P7_RING + 2048;
#ifndef P7_UREP
#define P7_UREP 1
#endif
#ifndef P7_UD
#define P7_UD 3
#endif
#ifndef P7_VMASK
#define P7_VMASK 16383u
#endif
#ifndef P7_VPROBE
#define P7_VPROBE 0
#endif
template <int MODE>
__device__ __forceinline__ void p7_vsweep(f32x16 (&acc)[8], const unsigned* LIST, const unsigned char* VT, int m32, int kh, unsigned psel, unsigned ntok) {
    constexpr unsigned EM = MODE == 1 ? P7_VMASK : 16383u;
    i32x8 abuf[8];
#pragma unroll
    for (int T = 0; T < 8; ++T)
#pragma unroll
        for (int i = 0; i < 16; ++i) acc[T][i] = 0.f;
    u32x4 c0 = *(const u32x4*)(LIST + kh * 8), c1 = *(const u32x4*)(LIST + kh * 8 + 4);
    {
        unsigned off[8];
#pragma unroll
        for (int j = 0; j < 8; ++j) off[j] = (((j < 4 ? c0[j & 3] : c1[j & 3]) & EM) << 10) + m32 * 4;
#pragma unroll
        for (int T = 0; T < 8; ++T) {
#pragma unroll
            for (int j = 0; j < 8; ++j) abuf[T][j] = *(const int*)(VT + off[j] + T * 128);
            __builtin_amdgcn_sched_barrier(0); }
    }
#pragma unroll 1
    for (int bi = 0; bi < 32; ++bi) {
        const int bn = (bi < 31 ? bi + 1 : 31);
        const u32x4 l0 = *(const u32x4*)(LIST + bn * 16 + kh * 8), l1 = *(const u32x4*)(LIST + bn * 16 + kh * 8 + 4);
        unsigned noff[8];
#pragma unroll
        for (int j = 0; j < 8; ++j) noff[j] = (((j < 4 ? l0[j & 3] : l1[j & 3]) & EM) << 10) + m32 * 4;
        i32x8 bop;
#pragma unroll
        for (int j = 0; j < 8; ++j) { const unsigned e = j < 4 ? c0[j & 3] : c1[j & 3];
            bop[j] = (((e >> 14) & 3u) == ntok) ? (int)__builtin_amdgcn_perm(0u, e, psel) : 0; }
        c0 = l0; c1 = l1;
#pragma unroll
        for (int T = 0; T < 8; ++T) {
            __builtin_amdgcn_sched_barrier(0);
            if (MODE != 2) asm volatile("s_waitcnt vmcnt(24)" ::: "memory");
            if (MODE == 1) { int t_ = abuf[T][0];
#pragma unroll
                for (int j = 1; j < 8; ++j) t_ |= abuf[T][j];
                acc[T][0] = __int_as_float(t_ | bop[0]); }
            else acc[T] = __builtin_amdgcn_mfma_scale_f32_32x32x64_f8f6f4(abuf[T], bop, acc[T], 0, 0, 0, 127, 0, 127);
            if (MODE != 2) {
#pragma unroll
                for (int j = 0; j < 8; ++j) abuf[T][j] = *(const int*)(VT + noff[j] + T * 128); }
        }
        __builtin_amdgcn_sched_barrier(0);
    }
    if (MODE != 0) {
#pragma unroll
        for (int T = 0; T < 8; ++T) asm volatile("" :: "v"(acc[T]));
    }
}
__device__ void phase_peer_gather(const Args& a, char* lds, int vb, int nb) {
    unsigned char* ws = a.ws;
    const bf16_t* HX = (const bf16_t*)(ws + WS_HX2);
    const int* IDX = (const int*)(ws + WS_IDX);
    const float* mod = (const float*)(ws + WS_MOD);
    const unsigned char* UT = ws + WS_UT; const unsigned char* VT = ws + WS_VT;
    const bf16_t* XM = (const bf16_t*)(ws + WS_XM);
#pragma unroll 1
    for (int tb = vb * 32; tb < NTOK; tb += nb * 32) {
        int tid = threadIdx.x; asm volatile("" : "+v"(tid));
        const int lane = tid & 63, wid = tid >> 6, r16 = lane & 15, kg = lane >> 4;
        char* HT = lds + wid * P7_WLDS; unsigned* LIST = (unsigned*)(HT + P7_RING); char* AT = HT;
        const int tok0 = tb + wid * 4;
        {
            int* HIST = (int*)HT; int* CUR = HIST + 128;
            int ee[8];
            const int* ip = IDX + (size_t)tok0 * 128 + lane;
#pragma unroll
            for (int k = 0; k < 4; ++k) { ee[2 * k] = ip[k * 128]; ee[2 * k + 1] = ip[k * 128 + 64]; }
            HIST[lane] = 0; HIST[64 + lane] = 0;
#pragma unroll
            for (int j = 0; j < 8; ++j) atomicAdd(&HIST[(((ee[j] >> P7_RS) & (P7_NR - 1)) << 2) | (j >> 1)], 1);
            const int c0 = HIST[2 * lane], c1 = HIST[2 * lane + 1];
            int inc = c0 + c1;
#pragma unroll
            for (int o = 1; o < 64; o <<= 1) { const int t = __shfl_up(inc, o); if (lane >= o) inc += t; }
            CUR[2 * lane] = inc - c0 - c1; CUR[2 * lane + 1] = inc - c1;
#pragma unroll
            for (int j = 0; j < 8; ++j) { const unsigned w = (unsigned)ee[j]; const int slot = atomicAdd(&CUR[(((w >> P7_RS) & (P7_NR - 1)) << 2) | (j >> 1)], 1);
                LIST[slot] = (w & 16383u) | ((unsigned)(j >> 1) << 14) | ((w >> 16) << 17); }
        }
#pragma unroll 1
        for (int urep = 0; urep < P7_UREP; ++urep) {
        if (urep) asm volatile("s_waitcnt vmcnt(0)" ::: "memory");
        {
            const bf16_t* hp = HX + (size_t)tok0 * DM + lane * 16;
#pragma unroll
            for (int k = 0; k < 4; ++k) { const u32x4 h0 = *(const u32x4*)(hp + k * DM), h1 = *(const u32x4*)(hp + k * DM + 8);
                u32x4 o, ol;
#pragma unroll
                for (int q = 0; q < 4; ++q) { const unsigned wa = q < 2 ? h0[2 * q] : h1[2 * q - 4], wb = q < 2 ? h0[2 * q + 1] : h1[2 * q - 3];
                    const float x0 = bflo(wa) * H_SCALE, x1 = bfhi(wa) * H_SCALE, x2 = bflo(wb) * H_SCALE, x3 = bfhi(wb) * H_SCALE;
                    int w = __builtin_amdgcn_cvt_pk_fp8_f32(sat8(x0), sat8(x1), 0, false); w = __builtin_amdgcn_cvt_pk_fp8_f32(sat8(x2), sat8(x3), w, true); o[q] = (unsigned)w;
                    const float r0 = (x0 - __builtin_amdgcn_cvt_f32_fp8(w, 0)) * 16.f, r1 = (x1 - __builtin_amdgcn_cvt_f32_fp8(w, 1)) * 16.f, r2 = (x2 - __builtin_amdgcn_cvt_f32_fp8(w, 2)) * 16.f, r3 = (x3 - __builtin_amdgcn_cvt_f32_fp8(w, 3)) * 16.f;
                    int wl = __builtin_amdgcn_cvt_pk_fp8_f32(sat8(r0), sat8(r1), 0, false); wl = __builtin_amdgcn_cvt_pk_fp8_f32(sat8(r2), sat8(r3), wl, true); ol[q] = (unsigned)wl; }
                *(u32x4*)(HT + (2 * k) * P7_HTP + lane * 16) = o; *(u32x4*)(HT + (2 * k + 1) * P7_HTP + lane * 16) = ol;
            }
        }
        {
            i32x8 hb[8];
            {
                const char* hp = HT + (2 * (lane & 3) + ((lane >> 2) & 1)) * P7_HTP + kg * 32;
#pragma unroll
                for (int kc = 0; kc < 8; ++kc) { const i32x4 x0 = *(const i32x4*)(hp + kc * 128), x1 = *(const i32x4*)(hp + kc * 128 + 16);
                    hb[kc] = __builtin_shufflevector(x0, x1, 0, 1, 2, 3, 4, 5, 6, 7); }
            }
            unsigned entv = LIST[r16];
            asm volatile("s_waitcnt lgkmcnt(0)" ::: "memory");
            LAS unsigned char* ring = (LAS unsigned char*)lds + __builtin_amdgcn_readfirstlane(wid) * P7_WLDS;
#define U_DMA(slot, gp) do { __builtin_amdgcn_global_load_lds((const unsigned*)(gp), (LAS unsigned*)(ring + (slot) * 2048), 16, 0, 0); } while (0)
            const int lrow = lane >> 3;
            const unsigned swz = (unsigned)(((lane & 7) ^ (((lrow >> 1) & 3) << 1)) << 4);
            unsigned olo = (((unsigned)__shfl((int)entv, lrow) & 16383u) << 10) + swz, ohi = (((unsigned)__shfl((int)entv, 8 + lrow) & 16383u) << 10) + swz;
#pragma unroll
            for (int st = 0; st < P7_UD; ++st) { U_DMA(st, UT + olo + st * 128); __builtin_amdgcn_global_load_lds((const unsigned*)(UT + ohi + st * 128), (LAS unsigned*)(ring + st * 2048 + 1024), 16, 0, 0); }
            const int ard = (r16 >> 3) * 1024 + (r16 & 7) * 128 + ((kg ^ ((r16 >> 1) & 3)) << 5);
            const float pscl = (lane & 8) ? 0.f : ((lane & 4) ? 1.f / 16.f : 1.f);
            asm volatile("s_waitcnt vmcnt(%0)" :: "n"(2 * P7_UD - 2) : "memory");
            i32x4 a0 = *(const LAS i32x4*)(ring + ard), a1 = *(const LAS i32x4*)(ring + ard + 16);
#pragma unroll 1
            for (int bi = 0; bi < 32; ++bi) {
                const unsigned entn = LIST[(bi < 31 ? bi + 1 : 31) * 16 + r16];
                const unsigned nlo = (((unsigned)__shfl((int)entn, lrow) & 16383u) << 10) + swz, nhi = (((unsigned)__shfl((int)entn, 8 + lrow) & 16383u) << 10) + swz;
                f32x4v D = {0.f, 0.f, 0.f, 0.f};
#pragma unroll
                for (int kc = 0; kc < 8; ++kc) {
                    asm volatile("" ::: "memory");
                    {
                        const unsigned glo = (kc + P7_UD < 8 ? olo : nlo) + ((kc + P7_UD) & 7) * 128, ghi = (kc + P7_UD < 8 ? ohi : nhi) + ((kc + P7_UD) & 7) * 128;
                        __builtin_amdgcn_global_load_lds((const unsigned*)(UT + glo), (LAS unsigned*)(ring + ((kc + P7_UD) & 7) * 2048), 16, 0, 0);
                        __builtin_amdgcn_global_load_lds((const unsigned*)(UT + ghi), (LAS unsigned*)(ring + ((kc + P7_UD) & 7) * 2048 + 1024), 16, 0, 0);
                    }
                    asm volatile("s_waitcnt vmcnt(%0)" :: "n"(2 * P7_UD - 2) : "memory");
                    const i32x4 n0 = *(const LAS i32x4*)(ring + ((kc + 1) & 7) * 2048 + ard), n1 = *(const LAS i32x4*)(ring + ((kc + 1) & 7) * 2048 + ard + 16);
                    D = __builtin_amdgcn_mfma_scale_f32_16x16x128_f8f6f4(__builtin_shufflevector(a0, a1, 0, 1, 2, 3, 4, 5, 6, 7), hb[kc], D, 0, 0, 0, 127, 0, 127);
                    a0 = n0; a1 = n1;
                }
                olo = nlo; ohi = nhi;
                float dsel = 0.f; unsigned esel = 0u;
#pragma unroll
                for (int i = 0; i < 4; ++i) {
                    const unsigned er = (unsigned)__shfl((int)entv, 4 * kg + i);
                    float m = (((er >> 14) & 3u) == (unsigned)(lane & 3)) ? D[i] * pscl : 0.f;
                    m = dpp_add<0xB1>(m); m = dpp_add<0x4E>(m); m = dpp_add<0x104>(m);
                    const bool pick = (lane & 3) == i; dsel = pick ? m : dsel; esel = pick ? er : esel;
                }
                if ((lane & 12) == 0) {
                    const float w = __uint_as_float((esel >> 17) << 16) * gelu_tanh(dsel * (1.f / (T_SCALE * H_SCALE))) * W_SCALE;
                    const int p0 = __builtin_amdgcn_cvt_pk_fp8_f32(sat8(w), 0.f, 0, false);
                    const float hf = __builtin_amdgcn_cvt_f32_fp8(p0, 0);
                    const int p1 = __builtin_amdgcn_cvt_pk_fp8_f32(sat8((w - hf) * 16.f), 0.f, 0, false);
                    LIST[bi * 16 + 4 * kg + (lane & 3)] = (esel & 0xffffu) | (((unsigned)p0 & 0xffu) << 16) | (((unsigned)p1 & 0xffu) << 24); }
                entv = entn;
            }
        }
        }
        {
            const int m32 = lane & 31, kh = lane >> 5, ntok = m32 >> 3, npart = (m32 >> 2) & 1, nc = m32 & 3;
            const unsigned psel = (0x0c0c0c0cu & ~(0xffu << (8 * nc))) | ((unsigned)(2 + npart) << (8 * nc));
            f32x16 acc[8];
#if P7_VPROBE
            p7_vsweep<P7_VPROBE>(acc, LIST, VT, m32, kh, psel, (unsigned)ntok);
#endif
            p7_vsweep<0>(acc, LIST, VT, m32, kh, psel, (unsigned)ntok);
            const float psc = npart ? V_SCALE / (W_SCALE * T_SCALE * 16.f) : V_SCALE / (W_SCALE * T_SCALE);
            char* arow = AT + ntok * P7_ATP + (16 * kh + nc) * 2;
#pragma unroll
            for (int T = 0; T < 8; ++T)
#pragma unroll
                for (int i = 0; i < 16; ++i) {
                    const float v = acc[T][i] * psc;
                    const float tot = (T & 1) ? dpp_add<0x114>(v) : dpp_add<0x104>(v);
                    if ((T & 1) == npart) *(_Float16*)(arow + (128 * T + 4 * ((i & 3) + 8 * (i >> 2))) * 2) = (_Float16)tot;
                }
        }
#pragma unroll
        for (int k = 0; k < 4; ++k) {
            const int tok = tok0 + k;
            float f[16]; float ss = 0.f;
            const u32x4 e0 = *(const u32x4*)(AT + k * P7_ATP + lane * 32), e1 = *(const u32x4*)(AT + k * P7_ATP + lane * 32 + 16);
#pragma unroll
            for (int i = 0; i < 8; ++i) { const unsigned cw = i < 4 ? e0[i] : e1[i - 4]; const h16x2 hv = as_h2(cw);
                f[2 * i] = (float)hv[0] * (1.f / V_SCALE); f[2 * i + 1] = (float)hv[1] * (1.f / V_SCALE); ss += f[2 * i] * f[2 * i] + f[2 * i + 1] * f[2 * i + 1]; }
            ss = wave_sum_bcast(ss);
            const float rinv = rsqrtf(ss * (1.f / DM) + EPS);
            const float* g2 = mod + (size_t)(tok >> 11) * 6144 + 5120;
            const u32x4 xa = *(const u32x4*)(XM + (size_t)tok * DM + lane * 16), xb = *(const u32x4*)(XM + (size_t)tok * DM + lane * 16 + 8);
#pragma unroll
            for (int q4 = 0; q4 < 4; ++q4) {
                const int c = lane * 16 + q4 * 4;
                const unsigned x01 = q4 < 2 ? xa[2 * q4] : xb[2 * q4 - 4], x23 = q4 < 2 ? xa[2 * q4 + 1] : xb[2 * q4 - 3];
                const f32x4 xm = {bflo(x01), bfhi(x01), bflo(x23), bfhi(x23)}, g2v = *(const f32x4*)(g2 + c), gp = *(const f32x4*)(a.in[I_GPOSTFFN] + c);
                f32x4 o;
#pragma unroll
                for (int jj = 0; jj < 4; ++jj) o[jj] = xm[jj] + g2v[jj] * (f[q4 * 4 + jj] * rinv * gp[jj]);
                *(f32x4*)(a.out + (size_t)tok * DM + c) = o; }
        }
    }
}

#ifdef DBG_DIGEST
__device__ void phase_digest(const Args& a, int vb, int nb) {
    const bf16_t* A2 = (const bf16_t*)(a.ws + WS_A2);
    const bf16_t* Q = (const bf16_t*)(a.ws + WS_Q); const bf16_t* K = (const bf16_t*)(a.ws + WS_K); const bf16_t* VV = (const bf16_t*)(a.ws + WS_VV);
    const bf16_t* L = (const bf16_t*)(a.ws + WS_L); const bf16_t* ZG = (const bf16_t*)(a.ws + WS_ZG);
    for (size_t e = (size_t)vb * NTHR + threadIdx.x; e < (size_t)NTOK * DM; e += (size_t)nb * NTHR) {
        float v = 0.f;
#if DBG_DIGEST == 3
        const size_t row = e >> 10; const int c = (int)(e & 1023);
        v = bf2f(A2[row * KOUT + c]); if (c < 512) v += bf2f(A2[row * KOUT + 1024 + c]);
#elif DBG_DIGEST == 2
        const size_t h = e % ((size_t)NTOK * 512);
        v = bf2f(Q[h]) + bf2f(ZG[h]) + bf2f(L[e % ((size_t)NB * STOT * 512)]);
        if (e < (size_t)NB * 2 * STOT * 64) v += bf2f(K[e]) + bf2f(VV[e]);
#endif
        a.out[e] = v; }
}
#endif
constexpr int LDS_BYTES = 155648;
constexpr int LDS_BARST = LDS_BYTES - 16;
static_assert(8 * P7_HTP <= P7_RING && 4 * P7_ATP <= P7_RING && 8 * P7_WLDS <= LDS_BARST && PK_END <= LDS_BARST && LR_END <= LDS_BARST && g8::SHM_B <= LDS_BARST && 17 * 1024 * 4 + 17 * 24 * 4 <= LDS_BARST, "LDS budget");
constexpr int N_PHASES = 8;

__global__ void __launch_bounds__(NTHR, 2) mk_fwd(Args a) {
    extern __shared__ __attribute__((aligned(16))) char lds[];
    const int nb = gridDim.x, bx = blockIdx.x;
    const int vb0 = (nb % 8 == 0) ? (bx % 8) * (nb / 8) + bx / 8 : bx;
    XcdBarrier bar; bar.bar = (unsigned*)(a.ws + WS_CTL); bar.x = 0; bar.st = (volatile LAS unsigned*)(LAS char*)(lds + LDS_BARST);
    const bool multi = (a.ph_hi - a.ph_lo) > 1;
    if (multi) {
        if (threadIdx.x < 4) ((volatile LAS unsigned*)(LAS char*)(lds + LDS_BARST))[threadIdx.x] = 0u;
        __syncthreads();
        bar = xcd_barrier_post((unsigned*)(a.ws + WS_CTL), (volatile LAS unsigned*)(LAS char*)(lds + LDS_BARST));
    }
#ifndef P7_PROBE
#define P7_PROBE -1
#endif
#ifndef DBL_PHASE
#define DBL_PHASE 0
#endif
#if DBL_PHASE != 0
#define RUN_PHASE(P, CALL) do { if (a.ph_lo <= (P) && (P) < a.ph_hi) { const int nrep_ = ((a.dbl >> (P)) & 1) ? 2 : 1; for (int rep_ = 0; rep_ < nrep_; ++rep_) { CALL; if ((P) + 1 < a.ph_hi || rep_ + 1 < nrep_) xcd_barrier(bar); } } } while (0)
#else
#define RUN_PHASE(P, CALL) do { if (a.ph_lo <= (P) && (P) < a.ph_hi) { CALL; if ((P) + 1 < a.ph_hi) xcd_barrier(bar); } } while (0)
#endif
#if !defined(ONLY_PHASE) || ONLY_PHASE == 0
    RUN_PHASE(0, phase_prep(a, lds, vb0, nb));
#endif
    int vb = vb0;
    if (multi && a.ph_lo == 0 && a.ph_hi > 1) {
        if (threadIdx.x == 0) { unsigned off = 0; for (unsigned j = 0; j < bar.x; ++j) off += xb_ld(&bar.bar[XB_XCNT(j)]); bar.st[3] = off + bar.st[2]; }
        __syncthreads();
        vb = (int)bar.st[3];
    }
#if !defined(ONLY_PHASE) || ONLY_PHASE == 1
    RUN_PHASE(1, phase_xn(a, vb, nb));
#endif
#if !defined(ONLY_PHASE) || ONLY_PHASE == 2
    RUN_PHASE(2, phase_inproj(a, lds, vb, nb));
#endif
#if (!defined(ONLY_PHASE) || ONLY_PHASE == 3) && !(defined(DBG_DIGEST) && DBG_DIGEST == 2)
    RUN_PHASE(3, phase_mixer(a, lds, vb, nb));
#endif
#ifdef DBG_DIGEST
    if (a.ph_lo <= 4 && 4 < a.ph_hi) phase_digest(a, vb, nb);
    return;
#endif
#if !defined(ONLY_PHASE) || ONLY_PHASE == 4
    RUN_PHASE(4, phase_outproj(a, lds, vb, nb));
#endif
#if !defined(ONLY_PHASE) || ONLY_PHASE == 5
    RUN_PHASE(5, phase_rowpass(a, vb, nb));
#endif
#if !defined(ONLY_PHASE) || ONLY_PHASE == 6
    RUN_PHASE(6, phase_peer_topk(a, lds, vb, nb));
#endif
#if !defined(ONLY_PHASE) || ONLY_PHASE == 7
    RUN_PHASE(7, phase_peer_gather(a, lds, vb, nb));
#endif
}

extern "C" void kernel_launch(void* const* d_in, const int* in_sizes, int n_in, void* d_out, int out_size, void* d_ws, size_t ws_size, hipStream_t stream) {
    static int grid = 0;
    if (grid == 0) {
        if (n_in != 25 || out_size != NTOK * DM || ws_size < WS_END) { fprintf(stderr, "kernel_launch: unexpected shapes (n_in %d, out %d, ws %zu, need %zu)\n", n_in, out_size, ws_size, (size_t)WS_END); grid = -1; return; }
        int dev = 0, cus = 0;
        if (hipGetDevice(&dev) != hipSuccess || hipDeviceGetAttribute(&cus, hipDeviceAttributeMultiprocessorCount, dev) != hipSuccess) { grid = -1; return; }
        if (hipFuncSetAttribute((const void*)mk_fwd, hipFuncAttributeMaxDynamicSharedMemorySize, LDS_BYTES) != hipSuccess) { fprintf(stderr, "kernel_launch: hipFuncSetAttribute failed\n"); grid = -1; return; }
        (void)hipGetLastError();
        grid = cus;
    }
    if (grid < 0) return;
    (void)hipMemsetAsync((char*)d_ws + WS_CTL, 0, CTL_BYTES, stream);
    Args a{};
    for (int i = 0; i < 25; ++i) a.in[i] = (const float*)d_in[i];
    a.out = (float*)d_out; a.ws = (unsigned char*)d_ws; a.dbl = DBL_PHASE; a.probe = P7_PROBE;
#if MK_N_LAUNCHES == 1
    a.ph_lo = 0; a.ph_hi = N_PHASES;
    hipLaunchKernelGGL(mk_fwd, dim3(grid), dim3(NTHR), LDS_BYTES, stream, a);
#else
    for (int ph = 0; ph < N_PHASES; ++ph) { a.ph_lo = ph; a.ph_hi = ph + 1; hipLaunchKernelGGL(mk_fwd, dim3(grid), dim3(NTHR), LDS_BYTES, stream, a); }
#endif
}
```

```cpp
#include <hip/hip_runtime.h>
#include <cstdio>
#include <cstdint>

#ifndef MK_N_LAUNCHES
#define MK_N_LAUNCHES 1
#endif

typedef unsigned short bf16_t;
typedef short bf16x8 __attribute__((ext_vector_type(8)));
typedef float f32x16 __attribute__((ext_vector_type(16)));
typedef float f32x4 __attribute__((ext_vector_type(4)));
typedef float f32x2 __attribute__((ext_vector_type(2)));
typedef unsigned u32x4 __attribute__((ext_vector_type(4)));
typedef unsigned u32x2 __attribute__((ext_vector_type(2)));
typedef int i32x8 __attribute__((ext_vector_type(8)));
typedef int i32x4 __attribute__((ext_vector_type(4)));
#define LAS __attribute__((address_space(3)))

constexpr int DM = 1024, NB = 16, SEQ = 2048, CTX = 256, STOT = SEQ + CTX;
constexpr int NTOK = NB * SEQ;
constexpr int NCTX = NB * CTX;
constexpr int NROWS = NTOK + NCTX;
constexpr int DIN = 1792, DLRU = 512;
constexpr int KOUT = 1536;
constexpr int PEER_N = 16384;
constexpr float EPS = 1e-6f;
constexpr int NTHR = 512;

constexpr size_t al256(size_t x) { return (x + 255) & ~(size_t)255; }
constexpr size_t WS_CTL   = 0;
constexpr size_t CTL_BYTES = 65536;
constexpr size_t WS_MOD   = WS_CTL + CTL_BYTES;
constexpr size_t WS_ROPE  = WS_MOD + al256(17 * 6144 * 4);
constexpr size_t WS_WIN   = WS_ROPE + al256(64 * 16 * 2 * 4);
constexpr size_t WS_WOUT  = WS_WIN + al256((size_t)DIN * DM * 2);
constexpr size_t WS_WQ    = WS_WOUT + al256((size_t)DM * KOUT * 2);
constexpr size_t WS_SUBK  = WS_WQ + al256((size_t)2048 * DM * 2);
constexpr size_t WS_RGW   = WS_SUBK + al256((size_t)8 * 2 * 128 * 128 * 2);
constexpr size_t WS_UT    = WS_RGW + al256((size_t)2 * 8 * 128 * 64 * 2);
constexpr size_t WS_VT    = WS_UT + al256((size_t)PEER_N * DM * 2);
constexpr size_t WS_XN    = WS_VT + al256((size_t)PEER_N * DM * 2);
constexpr size_t WS_Q     = WS_XN + al256((size_t)NROWS * DM * 2);
constexpr size_t WS_K     = WS_Q + al256((size_t)NTOK * 512 * 2);
constexpr size_t WS_VV    = WS_K + al256((size_t)NB * 2 * STOT * 64 * 2);
constexpr size_t WS_L     = WS_VV + al256((size_t)NB * 2 * STOT * 64 * 2);
constexpr size_t WS_ZG    = WS_L + al256((size_t)NB * STOT * DLRU * 2);
constexpr size_t WS_A2    = WS_ZG + al256((size_t)NTOK * DLRU * 2);
constexpr size_t WS_END   = WS_A2 + al256((size_t)NTOK * KOUT * 2);
constexpr size_t WS_MIX   = WS_XN;
constexpr size_t WS_HX2   = WS_A2;
constexpr size_t WS_XM    = WS_Q;
constexpr size_t WS_IDX   = WS_ZG;
constexpr size_t WS_GATE  = WS_ZG + (size_t)NTOK * 128 * 4;
static_assert(WS_MIX + (size_t)NTOK * DM * 4 <= WS_ZG, "MIX overlay must end before ZG");
static_assert(WS_GATE + (size_t)NTOK * 128 * 4 <= WS_A2, "IDX/GATE overlay must end before A2");

typedef __bf16 bf16x2_t __attribute__((ext_vector_type(2)));
__device__ __forceinline__ unsigned pk2(float lo, float hi) { const f32x2 v = {lo, hi}; const bf16x2_t b = __builtin_convertvector(v, bf16x2_t); return __builtin_bit_cast(unsigned, b); }
typedef _Float16 h16x2 __attribute__((ext_vector_type(2)));
constexpr float V_SCALE = 64.f;
constexpr float T_SCALE = 256.f;
#ifndef P7_FP8
#define P7_FP8 1
#endif
__device__ __forceinline__ unsigned pkh2(float lo, float hi) { const h16x2 h = {(_Float16)lo, (_Float16)hi}; return __builtin_bit_cast(unsigned, h); }
__device__ __forceinline__ bf16x2_t as_bf2(unsigned x) { return __builtin_bit_cast(bf16x2_t, x); }
__device__ __forceinline__ h16x2 as_h2(unsigned x) { return __builtin_bit_cast(h16x2, x); }
__device__ __forceinline__ bf16_t f2bf(float f) { return (bf16_t)(pk2(f, 0.f) & 0xffffu); }
__device__ __forceinline__ float bf2f(unsigned h) { return __uint_as_float(h << 16); }
__device__ __forceinline__ float bflo(unsigned w) { return __uint_as_float(w << 16); }
__device__ __forceinline__ float bfhi(unsigned w) { return __uint_as_float(w & 0xffff0000u); }
__device__ __forceinline__ float sat8(float x) { return fminf(fmaxf(x, -448.f), 448.f); }
__device__ __forceinline__ float fast_rcp(float x) { return __builtin_amdgcn_rcpf(x); }
__device__ __forceinline__ float sigmoidf_(float x) { return fast_rcp(1.f + __expf(-x)); }
__device__ __forceinline__ float gelu_tanh(float x) { const float y = 0.7978845608028654f * (x + 0.044715f * x * x * x); return x * fast_rcp(1.f + __expf(-2.f * y)); }
__device__ __forceinline__ float silu_(float x) { return x * sigmoidf_(x); }
__device__ __forceinline__ float wave_sum(float v) {
#pragma unroll
    for (int o = 32; o > 0; o >>= 1) v += __shfl_xor(v, o);
    return v;
}
__device__ __forceinline__ float half_swap_max(float v) { auto rr = __builtin_amdgcn_permlane32_swap(__float_as_uint(v), __float_as_uint(v), false, false); return fmaxf(__uint_as_float(rr[0]), __uint_as_float(rr[1])); }
__device__ __forceinline__ float half_swap_sum(float v) { auto rr = __builtin_amdgcn_permlane32_swap(__float_as_uint(v), __float_as_uint(v), false, false); return __uint_as_float(rr[0]) + __uint_as_float(rr[1]); }
#define MFMA(a, b, c) __builtin_amdgcn_mfma_f32_32x32x16_bf16((a), (b), (c), 0, 0, 0)

#define XB_TMO      128
#define XB_XCNT(j)  (256  + 64 * (j))
#define XB_XSUB(j)  (1280 + 64 * (j))
#define XB_XGEN(j)  (2304 + 64 * (j))
#define XB_TOP      3328
#define XB_TOPGEN   3392
#define XCD_BAR_WORDS 3456
#define XB_SPIN_CAP (1u << 20)
__device__ __forceinline__ unsigned xb_ld(unsigned* p)              { return __hip_atomic_load(p, __ATOMIC_RELAXED, __HIP_MEMORY_SCOPE_AGENT); }
__device__ __forceinline__ unsigned xb_add(unsigned* p, unsigned v) { return __hip_atomic_fetch_add(p, v, __ATOMIC_RELAXED, __HIP_MEMORY_SCOPE_AGENT); }
__device__ __forceinline__ unsigned xb_xcc_id() { return (unsigned)__builtin_amdgcn_s_getreg((3 << 11) | 20) & 0xFu; }
#define XB_SPIN(cond, bar) do { unsigned _sp = 0; while (cond) { __builtin_amdgcn_s_sleep(1); \
    if ((++_sp & 255u) == 0u) { if (xb_ld(&(bar)[XB_TMO])) break; if (_sp > XB_SPIN_CAP) { atomicAdd(&(bar)[XB_TMO], 1u); break; } } } } while (0)
struct XcdBarrier { unsigned* bar; unsigned x; volatile LAS unsigned* st; };
__device__ __forceinline__ XcdBarrier xcd_barrier_post(unsigned* bar, volatile LAS unsigned* st) {
    XcdBarrier b; b.bar = bar; b.x = xb_xcc_id(); b.st = st;
    if (threadIdx.x == 0) st[2] = xb_add(&bar[XB_XCNT(b.x)], 1u);
    return b;
}
__device__ __forceinline__ void xcd_barrier_complete(unsigned* bar, unsigned x, unsigned& nloc, unsigned& nx) {
    const unsigned G = gridDim.x * gridDim.y * gridDim.z;
    unsigned sum, cnt, mine, sp = 0u;
    for (;;) {
        sum = 0u; cnt = 0u; mine = 0u;
#pragma unroll
        for (unsigned j = 0; j < 16; ++j) { const unsigned c = xb_ld(&bar[XB_XCNT(j)]); sum += c; cnt += (c > 0u) ? 1u : 0u; mine = (j == x) ? c : mine; }
        if (sum == G) break;
        __builtin_amdgcn_s_sleep(1);
        if ((++sp & 255u) == 0u) { if (xb_ld(&bar[XB_TMO])) break; if (sp > XB_SPIN_CAP) { atomicAdd(&bar[XB_TMO], 1u); break; } }
    }
    nloc = mine > 0u ? mine : 1u; nx = cnt > 0u ? cnt : 1u;
}
__device__ __forceinline__ void xcd_barrier(const XcdBarrier& b) {
    asm volatile("s_waitcnt vmcnt(0)" ::: "memory");
    __syncthreads();
    if (threadIdx.x == 0) {
        unsigned* bar = b.bar;
        __builtin_amdgcn_s_waitcnt(0);
        unsigned nloc = b.st[0], nx = b.st[1];
        if (nloc == 0u) { xcd_barrier_complete(bar, b.x, nloc, nx); b.st[0] = nloc; b.st[1] = nx; }
        const unsigned old = xb_add(&bar[XB_XSUB(b.x)], 1u);
        const unsigned gen = old / nloc;
        if (old + 1u == (gen + 1u) * nloc) {
            __builtin_amdgcn_fence(__ATOMIC_RELEASE, "agent");
            asm volatile("s_waitcnt vmcnt(0)" ::: "memory");
            const unsigned og = xb_add(&bar[XB_TOP], 1u);
            const unsigned tg = og / nx;
            if (og + 1u == (tg + 1u) * nx) xb_add(&bar[XB_TOPGEN], 1u);
            else XB_SPIN(xb_ld(&bar[XB_TOPGEN]) == tg, bar);
            __builtin_amdgcn_fence(__ATOMIC_ACQUIRE, "agent");
            xb_add(&bar[XB_XGEN(b.x)], 1u);
            asm volatile("s_waitcnt vmcnt(0)" ::: "memory");
        } else {
            XB_SPIN(xb_ld(&bar[XB_XGEN(b.x)]) == gen, bar);
            __builtin_amdgcn_fence(__ATOMIC_ACQUIRE, "agent");
            asm volatile("s_waitcnt vmcnt(0)" ::: "memory");
        }
    }
    __syncthreads();
}

struct Args { const float* in[25]; float* out; unsigned char* ws; int ph_lo, ph_hi, dbl, probe; };
enum { I_X = 0, I_C, I_CTX, I_CCTX, I_WMOD, I_BMOD, I_GPREMIX, I_GPOSTMIX, I_GPREFFN, I_GPOSTFFN, I_WIN, I_QNG, I_KNG, I_CONVW, I_CONVB,
       I_RGWA, I_RGBA, I_RGWI, I_RGBI, I_RGLAM, I_WOUT, I_PWQ, I_PSUBK, I_PU, I_PV };

__device__ __forceinline__ void tr_tile(const float* __restrict__ src, int lds_, int sr0, int sc0, bf16_t* __restrict__ dst, int ldd, int dr0, int dc0, float* T) {
    const int tid = threadIdx.x;
#pragma unroll
    for (int i = 0; i < 8; ++i) { const int e = tid + NTHR * i, r = e >> 6, c = e & 63; T[r * 65 + c] = src[(size_t)(sr0 + r) * lds_ + sc0 + c]; }
    __syncthreads();
#pragma unroll
    for (int i = 0; i < 8; ++i) { const int e = tid + NTHR * i, c = e >> 6, r = e & 63; dst[(size_t)(dr0 + c) * ldd + dc0 + r] = f2bf(T[r * 65 + c]); }
    __syncthreads();
}

__device__ void phase_prep(const Args& a, char* lds, int vb, int nb) {
    const int tid = threadIdx.x;
    unsigned char* ws = a.ws;
    float* S = (float*)lds;
    float* T = (float*)lds;
    constexpr int N_MOD = 256, N_TIN = 448, N_TOUT = 384, N_TWQ = 512, N_RGW = 32, N_SUBK = 16, N_UV = 512, N_MISC = 1;
    constexpr int O_TIN = N_MOD, O_TOUT = O_TIN + N_TIN, O_TWQ = O_TOUT + N_TOUT, O_RGW = O_TWQ + N_TWQ, O_SUBK = O_RGW + N_RGW, O_UV = O_SUBK + N_SUBK, O_MISC = O_UV + N_UV, N_ALL = O_MISC + N_MISC;
    for (int it = vb; it < N_ALL; it += nb) {
        if (it < O_TIN) {
            for (int e = tid; e < 17 * 1024; e += NTHR) { const int r = e >> 10, k = e & 1023; const float v = (r < 16) ? a.in[I_C][r * 1024 + k] : a.in[I_CCTX][k]; S[e] = silu_(v); }
            __syncthreads();
            const int n0 = it * 24;
            const int cc = tid % 6, kk = tid / 6;
            float acc[17][4];
#pragma unroll
            for (int r = 0; r < 17; ++r) { acc[r][0] = 0.f; acc[r][1] = 0.f; acc[r][2] = 0.f; acc[r][3] = 0.f; }
            if (tid < 510) {
                for (int k = kk; k < 1024; k += 85) {
                    const f32x4 w = *(const f32x4*)(a.in[I_WMOD] + (size_t)k * 6144 + n0 + cc * 4);
#pragma unroll
                    for (int r = 0; r < 17; ++r) { const float s = S[r * 1024 + k]; acc[r][0] += s * w[0]; acc[r][1] += s * w[1]; acc[r][2] += s * w[2]; acc[r][3] += s * w[3]; }
                }
            }
            __syncthreads();
            if (tid < 510) {
#pragma unroll
                for (int r = 0; r < 17; ++r) { f32x4 v = {acc[r][0], acc[r][1], acc[r][2], acc[r][3]}; *(f32x4*)(S + (kk * 17 + r) * 24 + cc * 4) = v; }
            }
            __syncthreads();
            float* mod = (float*)(ws + WS_MOD);
            for (int e = tid; e < 17 * 24; e += NTHR) { const int r = e / 24, j = e % 24; float sum = 0.f;
                for (int q = 0; q < 85; ++q) sum += S[(q * 17 + r) * 24 + j];
                mod[r * 6144 + n0 + j] = sum + a.in[I_BMOD][n0 + j]; }
            __syncthreads();
        } else if (it < O_TOUT) {
            const int t = it - O_TIN, kt = t / 28, nt = t % 28;
            tr_tile(a.in[I_WIN], DIN, kt * 64, nt * 64, (bf16_t*)(ws + WS_WIN), DM, nt * 64, kt * 64, T);
        } else if (it < O_TWQ) {
            const int t = it - O_TOUT, kt = t / 16, nt = t % 16;
            const int sk = (kt < 16) ? kt * 64 : (kt - 16) * 64 + 512;
            tr_tile(a.in[I_WOUT], DM, sk, nt * 64, (bf16_t*)(ws + WS_WOUT), KOUT, nt * 64, kt * 64, T);
        } else if (it < O_RGW) {
            const int t = it - O_TWQ, kt = t / 32, nt = t % 32;
            tr_tile(a.in[I_PWQ], 2048, kt * 64, nt * 64, (bf16_t*)(ws + WS_WQ), DM, nt * 64, kt * 64, T);
        } else if (it < O_SUBK) {
            const int t = it - O_RGW, g = t & 1, dn = t >> 1;
            const float* src = (g == 0 ? a.in[I_RGWA] : a.in[I_RGWI]) + (size_t)dn * 4096;
            tr_tile(src, 64, 0, 0, (bf16_t*)(ws + WS_RGW) + (size_t)dn * 128 * 64 + g * 64 * 64, 64, 0, 0, T);
        } else if (it < O_UV) {
            const int t = it - O_SUBK; const float* src = a.in[I_PSUBK] + (size_t)t * 16384; bf16_t* dst = (bf16_t*)(ws + WS_SUBK) + (size_t)t * 16384;
            for (int e = tid * 4; e < 16384; e += NTHR * 4) { const f32x4 v = *(const f32x4*)(src + e); u32x2 o = {pk2(v[0], v[1]), pk2(v[2], v[3])}; *(u32x2*)(dst + e) = o; }
        } else if (it < O_MISC) {
            const int t = it - O_UV; const bool isv = t >= 256; const int tt = t & 255;
            const float* src = (isv ? a.in[I_PV] : a.in[I_PU]) + (size_t)tt * 65536; bf16_t* dst = (bf16_t*)(ws + (isv ? WS_VT : WS_UT)) + (size_t)tt * 65536;
#if P7_FP8
            unsigned char* d8 = ws + (isv ? WS_VT : WS_UT) + (size_t)tt * 65536;
            for (int e = tid * 16; e < 65536; e += NTHR * 16) { u32x4 o;
#pragma unroll
                for (int q = 0; q < 4; ++q) { f32x4 v = *(const f32x4*)(src + e + q * 4) * T_SCALE;
#pragma unroll
                    for (int i = 0; i < 4; ++i) v[i] = fminf(fmaxf(v[i], -448.f), 448.f);
                    int w = __builtin_amdgcn_cvt_pk_fp8_f32(v[0], v[1], 0, false); w = __builtin_amdgcn_cvt_pk_fp8_f32(v[2], v[3], w, true); o[q] = (unsigned)w; }
                *(u32x4*)(d8 + e) = o; }
#else
            if (!isv) {
                for (int e = tid * 8; e < 65536; e += NTHR * 8) { const f32x4 v0 = *(const f32x4*)(src + e), v1 = *(const f32x4*)(src + e + 4);
                    u32x4 o = {pk2(v0[0], v0[1]), pk2(v0[2], v0[3]), pk2(v1[0], v1[1]), pk2(v1[2], v1[3])}; *(u32x4*)(dst + e) = o; }
            } else {
                for (int e = tid * 8; e < 65536; e += NTHR * 8) { const f32x4 v0 = *(const f32x4*)(src + e) * V_SCALE, v1 = *(const f32x4*)(src + e + 4) * V_SCALE;
                    u32x4 o = {pkh2(v0[0], v0[1]), pkh2(v0[2], v0[3]), pkh2(v1[0], v1[1]), pkh2(v1[2], v1[3])}; *(u32x4*)(dst + e) = o; }
            }
#endif
        } else {
            float* rope = (float*)(ws + WS_ROPE);
            for (int e = tid; e < 64 * 16; e += NTHR) { const int pos = e >> 4, f = e & 15; const float inv = powf(10000.f, -(float)f / 16.f); const float ang = (float)pos * inv; rope[e * 2] = cosf(ang); rope[e * 2 + 1] = sinf(ang); }
        }
    }
}

__device__ void phase_xn(const Args& a, int vb, int nb) {
    const int tid = threadIdx.x, lane = tid & 63, wid = tid >> 6;
    const float* mod = (const float*)(a.ws + WS_MOD);
    bf16_t* XN = (bf16_t*)(a.ws + WS_XN);
    const float* g = a.in[I_GPREMIX];
    const int chunk = (NROWS + nb - 1) / nb, rend = min(NROWS, (vb + 1) * chunk);
    f32x4 A[4], B[4]; int cur = -1;
    for (int row = vb * chunk + wid; row < rend; row += 8) {
        const float* src; int mrow;
        if (row < NTOK) { src = a.in[I_X] + (size_t)row * DM; mrow = row >> 11; } else { src = a.in[I_CTX] + (size_t)(row - NTOK) * DM; mrow = 16; }
        f32x4 v[4]; float ss = 0.f;
#pragma unroll
        for (int i = 0; i < 4; ++i) v[i] = *(const f32x4*)(src + i * 256 + lane * 4);
        if (mrow != cur) { cur = mrow; const float* sh = mod + (size_t)mrow * 6144, *sc = sh + 1024;
#pragma unroll
            for (int i = 0; i < 4; ++i) { const int c = i * 256 + lane * 4; const f32x4 gg = *(const f32x4*)(g + c), s1 = *(const f32x4*)(sc + c); B[i] = *(const f32x4*)(sh + c);
#pragma unroll
                for (int j = 0; j < 4; ++j) A[i][j] = gg[j] * (1.f + s1[j]); } }
#pragma unroll
        for (int i = 0; i < 4; ++i) ss += v[i][0] * v[i][0] + v[i][1] * v[i][1] + v[i][2] * v[i][2] + v[i][3] * v[i][3];
        ss = wave_sum(ss);
        const float rinv = rsqrtf(ss * (1.f / DM) + EPS);
#pragma unroll
        for (int i = 0; i < 4; ++i) { const int c = i * 256 + lane * 4;
            float o[4];
#pragma unroll
            for (int j = 0; j < 4; ++j) o[j] = v[i][j] * rinv * A[i][j] + B[i][j];
            u32x2 w = {pk2(o[0], o[1]), pk2(o[2], o[3])}; *(u32x2*)(XN + (size_t)row * DM + c) = w; }
    }
}

constexpr int E_PITCH = 272;
namespace g8 {
constexpr int BM = 256, BK = 64, HALF = 128, HT = HALF * BK, SHM_B = 8 * HT * 2;
__device__ __forceinline__ int lds_byte(int r, int c) { const int st = (r >> 4) * 2 + (c >> 5), rr = r & 15, cc = c & 31, ob = rr * 64 + cc * 2; return st * 1024 + (ob ^ (((ob >> 9) & 1) << 5)); }
__device__ __forceinline__ void stage_rc(int b, int& R, int& C) { const int st = b / 1024, sb = b % 1024, swz = sb ^ (((sb >> 9) & 1) << 5); R = (st >> 1) * 16 + swz / 64; C = (st & 1) * 32 + (swz % 64) / 2; }
__device__ __forceinline__ void core(f32x4 (&acc)[2][2][4][2], const bf16_t* __restrict__ A, const bf16_t* __restrict__ Bt, int brow, int bcol, int K, char* lds_) {
    LAS unsigned char* lds = (LAS unsigned char*)lds_;
    const int tid = threadIdx.x, wid = __builtin_amdgcn_readfirstlane(tid >> 6), lane = tid & 63, wr = wid >> 2, wc = wid & 3, fr = lane & 15, fq = lane >> 4;
    constexpr int HTB = HT * 2;
    unsigned voff[2];
#pragma unroll
    for (int i = 0; i < 2; ++i) { int R, C; stage_rc(tid * 16 + i * 8192, R, C); voff[i] = (unsigned)(R * K + C) * 2u; }
    const size_t kstep = (size_t)(BK * 2), hstep = (size_t)HALF * K * 2;
    const unsigned ldsw = (unsigned)wid * 1024u;
    const int aoff = lds_byte(wr * 64 + fr, fq * 8), boff = lds_byte(wc * 32 + fr, fq * 8);
#define G8_SA(b, h) (((b) * 2 + (h)) * HTB)
#define G8_SB(b, h) ((4 + (b) * 2 + (h)) * HTB)
#define G8_STAGE(bufoff, gbase) do { _Pragma("unroll") for (int _i = 0; _i < 2; ++_i) \
        __builtin_amdgcn_global_load_lds((const unsigned*)((const char*)(gbase) + voff[_i]), (LAS unsigned*)(lds + (bufoff) + ldsw + _i * 8192), 16, 0, 0); } while (0)
#define G8_LDA(dst, b, h) do { _Pragma("unroll") for (int m = 0; m < 4; ++m) _Pragma("unroll") for (int k = 0; k < 2; ++k) dst[m][k] = *(const LAS bf16x8*)(lds + G8_SA(b, h) + aoff + m * 2048 + k * 1024); } while (0)
#define G8_LDB(dst, b, h) do { _Pragma("unroll") for (int n = 0; n < 2; ++n) _Pragma("unroll") for (int k = 0; k < 2; ++k) dst[n][k] = *(const LAS bf16x8*)(lds + G8_SB(b, h) + boff + n * 2048 + k * 1024); } while (0)
#define G8_MMA(ai, bj, At_, Bt_) do { __builtin_amdgcn_s_setprio(1); \
    _Pragma("unroll") for (int m = 0; m < 4; ++m) _Pragma("unroll") for (int n = 0; n < 2; ++n) _Pragma("unroll") for (int k = 0; k < 2; ++k) \
      acc[ai][bj][m][n] = __builtin_amdgcn_mfma_f32_16x16x32_bf16(At_[m][k], Bt_[n][k], acc[ai][bj][m][n], 0, 0, 0); \
    __builtin_amdgcn_s_setprio(0); } while (0)
#define G8_WAIT_V(n) asm volatile("s_waitcnt vmcnt(" #n ")" ::: "memory")
#define G8_WAIT_L(n) asm volatile("s_waitcnt lgkmcnt(" #n ")" ::: "memory")
#define G8_BAR __builtin_amdgcn_s_barrier()
#define G8_SCHED __builtin_amdgcn_sched_barrier(0)
#pragma unroll
    for (int ai = 0; ai < 2; ++ai)
#pragma unroll
        for (int bj = 0; bj < 2; ++bj)
#pragma unroll
            for (int m = 0; m < 4; ++m)
#pragma unroll
                for (int n = 0; n < 2; ++n) acc[ai][bj][m][n] = (f32x4){0.f, 0.f, 0.f, 0.f};
    bf16x8 At[4][2], B0[2][2], B1[2][2];
    const int nt = K / BK;
    const char* cA = (const char*)(A + (size_t)brow * K); const char* cB = (const char*)(Bt + (size_t)bcol * K);
    G8_STAGE(G8_SB(0, 0), cB); G8_STAGE(G8_SA(0, 0), cA); G8_STAGE(G8_SB(0, 1), cB + hstep); G8_STAGE(G8_SA(0, 1), cA + hstep);
    if (wr == 1) G8_BAR;
    G8_WAIT_V(4); G8_BAR;
    G8_STAGE(G8_SB(1, 0), cB + kstep); G8_STAGE(G8_SA(1, 0), cA + kstep); G8_STAGE(G8_SB(1, 1), cB + hstep + kstep);
    G8_WAIT_V(6); G8_BAR;
#pragma unroll 1
    for (int t = 0; t < nt - 2; t += 2) {
        const char* a1 = cA + (size_t)(t + 1) * kstep; const char* a2 = cA + (size_t)(t + 2) * kstep; const char* b2 = cB + (size_t)(t + 2) * kstep;
        const char* a3 = a2 + kstep; const char* b3 = b2 + kstep;
        G8_LDB(B0, 0, 0); G8_SCHED; G8_LDA(At, 0, 0); G8_STAGE(G8_SA(1, 1), a1 + hstep);
        G8_WAIT_L(8); G8_BAR; G8_WAIT_L(0); G8_MMA(0, 0, At, B0); G8_BAR; G8_SCHED;
        G8_LDB(B1, 0, 1); G8_STAGE(G8_SB(0, 0), b2);
        G8_BAR; G8_WAIT_L(0); G8_MMA(0, 1, At, B1); G8_BAR;
        G8_LDA(At, 0, 1); G8_STAGE(G8_SA(0, 0), a2);
        G8_BAR; G8_WAIT_L(0); G8_MMA(1, 0, At, B0); G8_BAR; G8_SCHED;
        G8_STAGE(G8_SB(0, 1), b2 + hstep);
        G8_WAIT_V(6); G8_BAR; G8_MMA(1, 1, At, B1); G8_BAR;
        G8_LDB(B0, 1, 0); G8_SCHED; G8_LDA(At, 1, 0); G8_STAGE(G8_SA(0, 1), a2 + hstep);
        G8_WAIT_L(8); G8_BAR; G8_WAIT_L(0); G8_MMA(0, 0, At, B0); G8_BAR; G8_SCHED;
        G8_LDB(B1, 1, 1); G8_STAGE(G8_SB(1, 0), b3);
        G8_BAR; G8_WAIT_L(0); G8_MMA(0, 1, At, B1); G8_BAR;
        G8_LDA(At, 1, 1); G8_STAGE(G8_SA(1, 0), a3);
        G8_BAR; G8_WAIT_L(0); G8_MMA(1, 0, At, B0); G8_BAR; G8_SCHED;
        G8_STAGE(G8_SB(1, 1), b3 + hstep);
        G8_WAIT_V(6); G8_BAR; G8_MMA(1, 1, At, B1); G8_BAR;
    }
    { G8_LDB(B0, 0, 0); G8_LDA(At, 0, 0); G8_STAGE(G8_SA(1, 1), cA + (size_t)(nt - 1) * kstep + hstep);
      G8_BAR; G8_WAIT_L(0); G8_MMA(0, 0, At, B0); G8_BAR;
      G8_LDB(B1, 0, 1); G8_BAR; G8_WAIT_L(0); G8_MMA(0, 1, At, B1); G8_BAR;
      G8_LDA(At, 0, 1); G8_WAIT_V(4); G8_BAR; G8_WAIT_L(0); G8_MMA(1, 0, At, B0); G8_MMA(1, 1, At, B1); G8_BAR; }
    { G8_LDB(B0, 1, 0); G8_LDA(At, 1, 0); G8_WAIT_V(2); G8_BAR; G8_WAIT_L(0); G8_MMA(0, 0, At, B0); G8_BAR;
      G8_LDB(B1, 1, 1); G8_WAIT_V(0); G8_BAR; G8_WAIT_L(0); G8_MMA(0, 1, At, B1); G8_BAR;
      G8_LDA(At, 1, 1); G8_BAR; G8_WAIT_L(0); G8_MMA(1, 0, At, B0); G8_MMA(1, 1, At, B1); G8_BAR; }
    if (wr == 0) G8_BAR;
#undef G8_SA
#undef G8_SB
#undef G8_STAGE
#undef G8_LDA
#undef G8_LDB
#undef G8_MMA
#undef G8_WAIT_V
#undef G8_WAIT_L
#undef G8_BAR
#undef G8_SCHED
}
}

__device__ void phase_inproj(const Args& a, char* lds, int vb, int nb) {
    const int tid = threadIdx.x, lane = tid & 63, wid = tid >> 6, wr = wid >> 2, wc = wid & 3, fr = lane & 15, fq = lane >> 4;
    unsigned char* ws = a.ws;
    const bf16_t* XN = (const bf16_t*)(ws + WS_XN);
    const bf16_t* WIN = (const bf16_t*)(ws + WS_WIN);
    const float* rope = (const float*)(ws + WS_ROPE);
    bf16_t* Qo = (bf16_t*)(ws + WS_Q); bf16_t* Ko = (bf16_t*)(ws + WS_K); bf16_t* Vo = (bf16_t*)(ws + WS_VV); bf16_t* Lo = (bf16_t*)(ws + WS_L); bf16_t* Zo = (bf16_t*)(ws + WS_ZG);
    constexpr int N_LAT = 128 * 7, N_ALL = N_LAT + 16 * 3;
#pragma unroll 1
    for (int it = vb; it < N_ALL; it += nb) {
        int tt, ft;
        if (it < N_LAT) { tt = it / 7; ft = it % 7; } else { const int j = it - N_LAT; tt = 128 + j / 3; ft = 2 + j % 3; }
        f32x4 acc[2][2][4][2];
        g8::core(acc, WIN, XN, ft * 256, tt * 256, DM, lds);
        const bool lat = tt < 128;
#pragma unroll
        for (int ai = 0; ai < 2; ++ai) {
            const int g64 = ft * 4 + ai * 2 + wr;
            if (g64 < 10) {
                const bool isq = g64 < 8;
                const float* gn = isq ? a.in[I_QNG] : a.in[I_KNG];
                const float osc = isq ? 0.125f * 1.4426950408889634f : 1.f;
                float gnv[4][4];
#pragma unroll
                for (int m = 0; m < 4; ++m) { const f32x4 gv = *(const f32x4*)(gn + m * 16 + fq * 4); gnv[m][0] = gv[0]; gnv[m][1] = gv[1]; gnv[m][2] = gv[2]; gnv[m][3] = gv[3]; }
#pragma unroll
                for (int bj = 0; bj < 2; ++bj)
#pragma unroll
                    for (int n = 0; n < 2; ++n) {
                        float ss = 0.f;
#pragma unroll
                        for (int m = 0; m < 4; ++m)
#pragma unroll
                            for (int j = 0; j < 4; ++j) ss += acc[ai][bj][m][n][j] * acc[ai][bj][m][n][j];
                        ss += __shfl_xor(ss, 16); ss += __shfl_xor(ss, 32);
                        const float rinv = rsqrtf(ss * (1.f / 64.f) + EPS);
                        const int row = tt * 256 + bj * 128 + wc * 32 + n * 16 + fr;
                        int b, t, s_; if (lat) { b = row >> 11; t = row & 2047; s_ = CTX + t; } else { const int rc = row - NTOK; b = rc >> 8; t = 0; s_ = rc & 255; }
                        bf16_t* dst = isq ? Qo + ((size_t)(b * 8 + g64) * SEQ + t) * 64 : Ko + ((size_t)(b * 2 + (g64 - 8)) * STOT + s_) * 64;
#pragma unroll
                        for (int ax = 0; ax < 2; ++ax) {
                            const int pos = ax == 0 ? (t >> 6) : (t & 63);
                            float o1[4], o2[4];
#pragma unroll
                            for (int j = 0; j < 4; ++j) {
                                const float x1 = acc[ai][bj][2 * ax][n][j] * rinv * gnv[2 * ax][j], x2 = acc[ai][bj][2 * ax + 1][n][j] * rinv * gnv[2 * ax + 1][j];
                                float c1 = x1, c2 = x2;
                                if (lat) { const f32x2 cs = *(const f32x2*)(rope + (pos * 16 + fq * 4 + j) * 2); c1 = x1 * cs[0] - x2 * cs[1]; c2 = x1 * cs[1] + x2 * cs[0]; }
                                o1[j] = c1 * osc; o2[j] = c2 * osc; }
                            *(u32x2*)(dst + ax * 32 + fq * 4) = (u32x2){pk2(o1[0], o1[1]), pk2(o1[2], o1[3])};
                            *(u32x2*)(dst + ax * 32 + 16 + fq * 4) = (u32x2){pk2(o2[0], o2[1]), pk2(o2[2], o2[3])};
                        }
                    }
            } else if (g64 < 12) {
#pragma unroll
                for (int bj = 0; bj < 2; ++bj)
#pragma unroll
                    for (int n = 0; n < 2; ++n) {
                        const int row = tt * 256 + bj * 128 + wc * 32 + n * 16 + fr;
                        int b, s_; if (lat) { b = row >> 11; s_ = CTX + (row & 2047); } else { const int rc = row - NTOK; b = rc >> 8; s_ = rc & 255; }
                        bf16_t* vp = Vo + ((size_t)(b * 2 + (g64 - 10)) * 64) * STOT + s_;
#pragma unroll
                        for (int m = 0; m < 4; ++m)
#pragma unroll
                            for (int j = 0; j < 4; ++j) vp[(size_t)(m * 16 + fq * 4 + j) * STOT] = f2bf(acc[ai][bj][m][n][j]);
                    }
            } else {
                const bool isz = g64 >= 20;
#pragma unroll
                for (int bj = 0; bj < 2; ++bj)
#pragma unroll
                    for (int n = 0; n < 2; ++n) {
                        const int row = tt * 256 + bj * 128 + wc * 32 + n * 16 + fr;
                        bf16_t* dst;
                        if (isz) dst = Zo + (size_t)row * DLRU + (g64 - 20) * 64;
                        else { int b, s_; if (lat) { b = row >> 11; s_ = CTX + (row & 2047); } else { const int rc = row - NTOK; b = rc >> 8; s_ = rc & 255; }
                            dst = Lo + ((size_t)b * STOT + s_) * DLRU + (g64 - 12) * 64; }
#pragma unroll
                        for (int m = 0; m < 4; ++m) { f32x4 v = acc[ai][bj][m][n];
                            if (isz) { v[0] = gelu_tanh(v[0]); v[1] = gelu_tanh(v[1]); v[2] = gelu_tanh(v[2]); v[3] = gelu_tanh(v[3]); }
                            *(u32x2*)(dst + m * 16 + fq * 4) = (u32x2){pk2(v[0], v[1]), pk2(v[2], v[3])}; }
                    }
            }
        }
        __syncthreads();
    }
}

constexpr int AT_KP = 144, AT_VP = 136, AT_STAGE = 64 * AT_KP + 64 * AT_VP;
__device__ void attn_item(const Args& a, char* lds, int b, int head, int qblk) {
    const int tid = threadIdx.x, lane = tid & 63, wid = tid >> 6, r32 = lane & 31, hi = lane >> 5;
    unsigned char* ws = a.ws;
    const int kvh = head >> 2;
    const bf16_t* Qp = (const bf16_t*)(ws + WS_Q) + ((size_t)(b * 8 + head) * SEQ + qblk * 256 + wid * 32 + r32) * 64 + hi * 8;
    const bf16_t* Kp = (const bf16_t*)(ws + WS_K) + (size_t)(b * 2 + kvh) * STOT * 64;
    const bf16_t* Vp = (const bf16_t*)(ws + WS_VV) + (size_t)(b * 2 + kvh) * 64 * STOT;
    bf16x8 qf[4];
#pragma unroll
    for (int ds = 0; ds < 4; ++ds) qf[ds] = *(const bf16x8*)(Qp + ds * 16);
    const int srow = tid >> 3, sch = tid & 7;
    const bf16_t* kg = Kp + (size_t)srow * 64 + sch * 8;
    const bf16_t* vg = Vp + (size_t)srow * STOT + sch * 8;
    u32x4 krA, vrA, krB, vrB;
    f32x16 o[2]; float lsum = 0.f;
    float negM;
    { float gq = fabsf(a.in[I_QNG][lane]), gk = fabsf(a.in[I_KNG][lane]);
#pragma unroll
      for (int o_ = 32; o_ > 0; o_ >>= 1) { gq = fmaxf(gq, __shfl_xor(gq, o_)); gk = fmaxf(gk, __shfl_xor(gk, o_)); }
      negM = -(64.f * 0.125f * 1.4426950408889634f * 1.01f) * gq * gk; }
#pragma unroll
    for (int dt = 0; dt < 2; ++dt)
#pragma unroll
        for (int r = 0; r < 16; ++r) o[dt][r] = 0.f;
    char* KS = lds; char* VS = lds + 2 * 64 * AT_KP;
#define A_LOADK(X, s0) do { kr##X = *(const u32x4*)(kg + (size_t)(s0) * 64); } while (0)
#define A_LOADV(X, s0) do { vr##X = *(const u32x4*)(vg + (s0)); } while (0)
#define A_WRITEK(X, st) do { *(u32x4*)(KS + (st) * 64 * AT_KP + srow * AT_KP + sch * 16) = kr##X; } while (0)
#define A_WRITEV(X, st) do { char* vb_ = VS + (st) * 64 * AT_VP + srow * AT_VP + sch * 16; *(u32x2*)vb_ = (u32x2){vr##X[0], vr##X[1]}; *(u32x2*)(vb_ + 8) = (u32x2){vr##X[2], vr##X[3]}; } while (0)
    constexpr int NT = STOT / 64;
    f32x16 sc[2], sn[2];
    A_LOADK(A, 0); A_LOADV(A, 0); A_WRITEK(A, 0); A_WRITEV(A, 0); A_LOADK(A, 64); A_WRITEK(A, 1); A_LOADK(B, 128); A_LOADV(B, 64); __syncthreads();
#pragma unroll
    for (int kt = 0; kt < 2; ++kt) {
#pragma unroll
        for (int r = 0; r < 16; ++r) sc[kt][r] = negM;
#pragma unroll
        for (int ds = 0; ds < 4; ++ds) { const bf16x8 ka = *(const bf16x8*)(KS + (kt * 32 + r32) * AT_KP + (ds * 16 + hi * 8) * 2); sc[kt] = MFMA(ka, qf[ds], sc[kt]); }
    }
    __syncthreads();
    f32x16 ol;
#pragma unroll
    for (int r = 0; r < 16; ++r) ol[r] = 0.f;
    const u32x4 ones_w = {0x3F803F80u, 0x3F803F80u, 0x3F803F80u, 0x3F803F80u};
    const bf16x8 ones = *(const bf16x8*)&ones_w;
#define A_STEP(J, SC, SN, XW, XL) do { const int j_ = (J); \
        const int jk = (j_ + 3 < NT) ? j_ + 3 : NT - 1, jv = (j_ + 2 < NT) ? j_ + 2 : NT - 1; \
        A_LOADK(XL, jk * 64); A_LOADV(XL, jv * 64); \
        const char* ksn = KS + ((j_ + 1) & 1) * 64 * AT_KP; const char* vs = VS + (j_ & 1) * 64 * AT_VP; \
        _Pragma("unroll") for (int kt = 0; kt < 2; ++kt) { \
            _Pragma("unroll") for (int r = 0; r < 16; ++r) SN[kt][r] = negM; \
            _Pragma("unroll") for (int ds = 0; ds < 4; ++ds) { \
                const bf16x8 ka = *(const bf16x8*)(ksn + (kt * 32 + r32) * AT_KP + (ds * 16 + hi * 8) * 2); \
                SN[kt] = MFMA(ka, qf[ds], SN[kt]); \
                _Pragma("unroll") for (int e = 0; e < 4; ++e) { const int f = (kt * 4 + ds) * 4 + e; SC[f >> 4][f & 15] = __builtin_amdgcn_exp2f(SC[f >> 4][f & 15]); } \
                __builtin_amdgcn_sched_barrier(0); } } \
        _Pragma("unroll") for (int kt = 0; kt < 2; ++kt) \
            _Pragma("unroll") for (int s = 0; s < 2; ++s) { \
                u32x4 pw = {pk2(SC[kt][8 * s], SC[kt][8 * s + 1]), pk2(SC[kt][8 * s + 2], SC[kt][8 * s + 3]), pk2(SC[kt][8 * s + 4], SC[kt][8 * s + 5]), pk2(SC[kt][8 * s + 6], SC[kt][8 * s + 7])}; \
                const bf16x8 pb = *(bf16x8*)&pw; \
                _Pragma("unroll") for (int dt = 0; dt < 2; ++dt) { \
                    const char* vp = vs + (dt * 32 + r32) * AT_VP + (kt * 32 + s * 16 + hi * 4) * 2; \
                    const u32x2 lo = *(const u32x2*)vp, hh = *(const u32x2*)(vp + 16); \
                    u32x4 aw = {lo[0], lo[1], hh[0], hh[1]}; \
                    o[dt] = MFMA(*(bf16x8*)&aw, pb, o[dt]); } \
                ol = MFMA(ones, pb, ol); } \
        A_WRITEK(XW, j_ & 1); A_WRITEV(XW, (j_ + 1) & 1); \
        __syncthreads(); } while (0)
#pragma unroll 1
    for (int j = 0; j < NT; j += 2) { A_STEP(j, sc, sn, B, A); A_STEP(j + 1, sn, sc, A, B); }
#undef A_STEP
    lsum = ol[0];
#undef A_LOADK
#undef A_LOADV
#undef A_WRITEK
#undef A_WRITEV
    const float inv = fast_rcp(lsum);
    bf16_t* outp = (bf16_t*)(ws + WS_A2) + ((size_t)b * SEQ + qblk * 256 + wid * 32 + r32) * KOUT + head * 64;
#pragma unroll
    for (int dt = 0; dt < 2; ++dt)
#pragma unroll
        for (int g = 0; g < 4; ++g) {
            u32x2 v = {pk2(o[dt][4 * g] * inv, o[dt][4 * g + 1] * inv), pk2(o[dt][4 * g + 2] * inv, o[dt][4 * g + 3] * inv)};
            *(u32x2*)(outp + dt * 32 + g * 8 + hi * 4) = v;
        }
}

constexpr int LR_RAW = 0;
constexpr int LR_U   = 33792;
constexpr int LR_BB  = LR_U + 33280;
constexpr int LR_UB  = LR_BB + 33280;
constexpr int LR_WG  = LR_UB + 18432;
constexpr int LR_SEG = LR_WG + 18432;
constexpr int LR_HC  = LR_SEG + 4096;
constexpr int LR_CST = LR_HC + 512;
constexpr int LR_END = LR_CST + 768;
__device__ void lru_item(const Args& a, char* lds, int b, int n, int d) {
    const int tid = threadIdx.x, lane = tid & 63, wid = tid >> 6, r32 = lane & 31, hi = lane >> 5;
    unsigned char* ws = a.ws;
    float* RAW = (float*)(lds + LR_RAW); float* AA = (float*)(lds + LR_RAW); float* U = (float*)(lds + LR_U); float* BB = (float*)(lds + LR_BB);
    char* UB = lds + LR_UB; char* WG = lds + LR_WG; float* SEG = (float*)(lds + LR_SEG); float* HC = (float*)(lds + LR_HC);
    const bf16_t* Lg = (const bf16_t*)(ws + WS_L) + (size_t)b * STOT * DLRU + n * 64;
    const bf16_t* Zg = (const bf16_t*)(ws + WS_ZG) + (size_t)b * SEQ * DLRU + n * 64;
    bf16_t* Og = (bf16_t*)(ws + WS_A2) + (size_t)b * SEQ * KOUT + 512 + d * 512 + n * 64;
    {
        const bf16_t* wsrc = (const bf16_t*)(ws + WS_RGW) + (size_t)(d * 8 + n) * 128 * 64;
#pragma unroll
        for (int i = 0; i < 2; ++i) { const int c = tid + NTHR * i, r = c >> 3, ch = c & 7; *(u32x4*)(WG + r * 144 + ch * 16) = *(const u32x4*)(wsrc + r * 64 + ch * 8); }
        if (tid < 128) HC[tid] = 0.f;
    }
    const int ct = wid & 1, tt = wid >> 1;
    float* CST = (float*)(lds + LR_CST);
    if (tid < 64) { const int c = n * 64 + tid; CST[tid] = a.in[I_RGBA][d * 512 + c]; CST[64 + tid] = a.in[I_RGBI][d * 512 + c];
        const float x = -a.in[I_RGLAM][d * 512 + c]; CST[128 + tid] = -8.f * (fmaxf(x, 0.f) + log1pf(__expf(-fabsf(x)))); }
    const int sc = tid & 63, sg = tid >> 6;
    const float cw0 = a.in[I_CONVW][0 * 512 + n * 64 + sc], cw1 = a.in[I_CONVW][1 * 512 + n * 64 + sc], cw2 = a.in[I_CONVW][2 * 512 + n * 64 + sc], cw3 = a.in[I_CONVW][3 * 512 + n * 64 + sc];
    const float cbias = a.in[I_CONVB][n * 64 + sc];
    __syncthreads();
    int par = 0;
    for (int step = 0; step < 18; ++step) {
        const bool isctx = step < 2;
        const int tl = isctx ? (d == 0 ? step : 1 - step) : (d == 0 ? step - 2 : 17 - step);
        const int sb = isctx ? 0 : CTX, sl = isctx ? CTX : SEQ, t0 = tl * 128;
        for (int e = tid; e < 131 * 8; e += NTHR) { const int r = e >> 3, ch = e & 7, t = t0 - 2 + r;
            u32x4 v = {0u, 0u, 0u, 0u}; if (t >= 0 && t < sl) v = *(const u32x4*)(Lg + (size_t)(sb + t) * DLRU + ch * 8);
            float* dst = RAW + r * 64 + ch * 8;
            dst[0] = bflo(v[0]); dst[1] = bfhi(v[0]); dst[2] = bflo(v[1]); dst[3] = bfhi(v[1]); dst[4] = bflo(v[2]); dst[5] = bfhi(v[2]); dst[6] = bflo(v[3]); dst[7] = bfhi(v[3]); }
        __syncthreads();
        {
            const float* rp = RAW + (sg * 16) * 64 + sc;
            float x0 = rp[0], x1 = rp[64], x2 = rp[128];
            float* up = U + (sg * 16) * 65 + sc; char* ubp = UB + (sg * 16) * 144 + sc * 2;
#pragma unroll
            for (int i = 0; i < 16; ++i) { const float x3 = rp[(i + 3) * 64];
                const float u = cbias + cw0 * x0 + cw1 * x1 + cw2 * x2 + cw3 * x3;
                up[i * 65] = u; *(bf16_t*)(ubp + i * 144) = f2bf(u); x0 = x1; x1 = x2; x2 = x3; }
        }
        __syncthreads();
        {
            f32x16 ga, gi;
#pragma unroll
            for (int r = 0; r < 16; ++r) { ga[r] = 0.f; gi[r] = 0.f; }
#pragma unroll
            for (int ks = 0; ks < 4; ++ks) {
                const bf16x8 wa = *(const bf16x8*)(WG + (ct * 32 + r32) * 144 + (ks * 16 + hi * 8) * 2);
                const bf16x8 wi = *(const bf16x8*)(WG + (64 + ct * 32 + r32) * 144 + (ks * 16 + hi * 8) * 2);
                const bf16x8 ub = *(const bf16x8*)(UB + (tt * 32 + r32) * 144 + (ks * 16 + hi * 8) * 2);
                ga = MFMA(wa, ub, ga); gi = MFMA(wi, ub, gi);
            }
            const int t = tt * 32 + r32;
#pragma unroll
            for (int r = 0; r < 16; ++r) { const int c = ct * 32 + 8 * (r >> 2) + 4 * hi + (r & 3);
                const float rr = sigmoidf_(ga[r] + CST[c]), ii = sigmoidf_(gi[r] + CST[64 + c]);
                const float la = CST[128 + c] * rr, av = __expf(la), mult = __builtin_amdgcn_sqrtf(fmaxf(1.f - av * av, 0.f));
                const float u = U[t * 65 + c];
                AA[t * 65 + c] = av; BB[t * 65 + c] = mult * ii * u; }
        }
        __syncthreads();
        float av[16], bv[16]; float Ap = 1.f, Bp = 0.f;
#pragma unroll
        for (int k = 0; k < 16; ++k) { const int p = sg * 16 + k, t = d == 0 ? p : 127 - p; av[k] = AA[t * 65 + sc]; bv[k] = BB[t * 65 + sc]; Bp = av[k] * Bp + bv[k]; Ap = av[k] * Ap; }
        SEG[sg * 64 + sc] = Ap; SEG[512 + sg * 64 + sc] = Bp;
        __syncthreads();
        float h = HC[par * 64 + sc];
        for (int s2 = 0; s2 < sg; ++s2) h = SEG[s2 * 64 + sc] * h + SEG[512 + s2 * 64 + sc];
        {
            const int tfirst = d == 0 ? sg * 16 : 127 - sg * 16;
            const bf16_t* zp = Zg + (size_t)(t0 + tfirst) * DLRU + sc; bf16_t* op = Og + (size_t)(t0 + tfirst) * KOUT + sc;
            const int zstep = d == 0 ? DLRU : -DLRU, ostep = d == 0 ? KOUT : -KOUT;
#pragma unroll
            for (int k = 0; k < 16; ++k) { h = av[k] * h + bv[k];
                if (!isctx) { const float gz = bf2f(*zp); *op = f2bf(h * gz); zp += zstep; op += ostep; } }
        }
        if (sg == 7) HC[(par ^ 1) * 64 + sc] = h;
        par ^= 1;
        __syncthreads();
    }
}

#ifndef LRU_REPS
#define LRU_REPS 1
#endif
__device__ void phase_mixer(const Args& a, char* lds, int vb, int nb) {
#pragma unroll 1
    for (int it = vb; it < 256; it += nb) { for (int rep_ = 0; rep_ < LRU_REPS; ++rep_) { lru_item(a, lds, it >> 4, (it >> 1) & 7, it & 1); __syncthreads(); } }
#pragma unroll 1
    for (int at = vb; at < 1024; at += nb) { const int bk = at >> 5, w = at & 31; attn_item(a, lds, bk >> 1, (bk & 1) * 4 + (w >> 3), w & 7); __syncthreads(); }
}

__device__ void phase_outproj(const Args& a, char* lds, int vb, int nb) {
    const int tid = threadIdx.x, lane = tid & 63, wid = tid >> 6, wr = wid >> 2, wc = wid & 3, fr = lane & 15, fq = lane >> 4;
    const bf16_t* A2 = (const bf16_t*)(a.ws + WS_A2); const bf16_t* WO = (const bf16_t*)(a.ws + WS_WOUT);
    bf16_t* MIX = (bf16_t*)(a.ws + WS_MIX);
#pragma unroll 1
    for (int it = vb; it < 128 * 4; it += nb) {
        const int tt = it >> 2, ft = it & 3;
        f32x4 acc[2][2][4][2];
        g8::core(acc, WO, A2, ft * 256, tt * 256, KOUT, lds);
#pragma unroll
        for (int bj = 0; bj < 2; ++bj)
#pragma unroll
            for (int n = 0; n < 2; ++n) {
                bf16_t* rp = MIX + (size_t)(tt * 256 + bj * 128 + wc * 32 + n * 16 + fr) * DM + ft * 256 + wr * 64 + fq * 4;
#pragma unroll
                for (int ai = 0; ai < 2; ++ai)
#pragma unroll
                    for (int m = 0; m < 4; ++m) { const f32x4 v = acc[ai][bj][m][n]; *(u32x2*)(rp + ai * 128 + m * 16) = (u32x2){pk2(v[0], v[1]), pk2(v[2], v[3])}; }
            }
        __syncthreads();
    }
}

__device__ void phase_rowpass(const Args& a, int vb, int nb) {
    const int tid = threadIdx.x, lane = tid & 63, wid = tid >> 6;
    const float* mod = (const float*)(a.ws + WS_MOD);
    const bf16_t* MIX = (const bf16_t*)(a.ws + WS_MIX);
    bf16_t* HX = (bf16_t*)(a.ws + WS_HX2); bf16_t* XM = (bf16_t*)(a.ws + WS_XM);
    const int chunk = (NTOK + nb - 1) / nb, rend = min(NTOK, (vb + 1) * chunk);
    f32x4 G1[4], A2[4], B2[4]; int cur = -1;
    u32x2 mwn[4]; f32x4 xvn[4];
    {
        const int r0 = min(vb * chunk + wid, NTOK - 1);
#pragma unroll
        for (int i = 0; i < 4; ++i) { mwn[i] = *(const u32x2*)(MIX + (size_t)r0 * DM + i * 256 + lane * 4); xvn[i] = *(const f32x4*)(a.in[I_X] + (size_t)r0 * DM + i * 256 + lane * 4); }
    }
    for (int row = vb * chunk + wid; row < rend; row += 8) {
        const int b = row >> 11;
        f32x4 mv[4], xv[4]; float ss = 0.f;
#pragma unroll
        for (int i = 0; i < 4; ++i) { const u32x2 mw = mwn[i]; mv[i] = (f32x4){bflo(mw[0]), bfhi(mw[0]), bflo(mw[1]), bfhi(mw[1])}; xv[i] = xvn[i]; }
        {
            const int rn = min(row + 8, NTOK - 1);
#pragma unroll
            for (int i = 0; i < 4; ++i) { mwn[i] = *(const u32x2*)(MIX + (size_t)rn * DM + i * 256 + lane * 4); xvn[i] = *(const f32x4*)(a.in[I_X] + (size_t)rn * DM + i * 256 + lane * 4); }
        }
        if (b != cur) { cur = b; const float* mrow = mod + (size_t)b * 6144;
#pragma unroll
            for (int i = 0; i < 4; ++i) { const int c = i * 256 + lane * 4;
                const f32x4 gp = *(const f32x4*)(a.in[I_GPOSTMIX] + c), g1 = *(const f32x4*)(mrow + 2048 + c), gf = *(const f32x4*)(a.in[I_GPREFFN] + c), sc = *(const f32x4*)(mrow + 4096 + c);
                B2[i] = *(const f32x4*)(mrow + 3072 + c);
#pragma unroll
                for (int j = 0; j < 4; ++j) { G1[i][j] = g1[j] * gp[j]; A2[i][j] = gf[j] * (1.f + sc[j]); } } }
#pragma unroll
        for (int i = 0; i < 4; ++i) ss += mv[i][0] * mv[i][0] + mv[i][1] * mv[i][1] + mv[i][2] * mv[i][2] + mv[i][3] * mv[i][3];
        ss = wave_sum(ss);
        const float rinv = rsqrtf(ss * (1.f / DM) + EPS);
        float s2 = 0.f;
#pragma unroll
        for (int i = 0; i < 4; ++i) { const int c = i * 256 + lane * 4;
#pragma unroll
            for (int j = 0; j < 4; ++j) { const float xm = xv[i][j] + G1[i][j] * (mv[i][j] * rinv); xv[i][j] = xm; s2 += xm * xm; }
            const u32x2 xw = {pk2(xv[i][0], xv[i][1]), pk2(xv[i][2], xv[i][3])}; *(u32x2*)(XM + (size_t)row * DM + c) = xw; }
        s2 = wave_sum(s2);
        const float rinv2 = rsqrtf(s2 * (1.f / DM) + EPS);
#pragma unroll
        for (int i = 0; i < 4; ++i) { const int c = i * 256 + lane * 4;
            float o[4];
#pragma unroll
            for (int j = 0; j < 4; ++j) o[j] = xv[i][j] * rinv2 * A2[i][j] + B2[i][j];
            u32x2 w = {pk2(o[0], o[1]), pk2(o[2], o[3])}; *(u32x2*)(HX + (size_t)row * DM + c) = w; }
    }
}

__device__ __forceinline__ int fkey(float f) { const int b = __float_as_int(f); return b ^ ((b >> 31) & 0x7fffffff); }
__device__ __forceinline__ float fval(int k) { return __int_as_float(k ^ ((k >> 31) & 0x7fffffff)); }
#define CE_DESC(x, y) do { const int hi_ = max((x), (y)), lo_ = min((x), (y)); (x) = hi_; (y) = lo_; } while (0)
__device__ __forceinline__ void sort16_desc(int (&v)[16]) {
#pragma unroll
    for (int k = 2; k <= 16; k <<= 1)
#pragma unroll
        for (int j = k >> 1; j > 0; j >>= 1)
#pragma unroll
            for (int i = 0; i < 16; ++i) { const int l = i ^ j; if (l > i) { if ((i & k) == 0) { CE_DESC(v[i], v[l]); } else { CE_DESC(v[l], v[i]); } } }
}
__device__ __forceinline__ void merge16_desc(int (&v)[16]) {
#pragma unroll
    for (int j = 8; j > 0; j >>= 1)
#pragma unroll
        for (int i = 0; i < 16; ++i) { const int l = i ^ j; if (l > i) CE_DESC(v[i], v[l]); }
}
__device__ __forceinline__ void top16_merge(int (&A)[16], const int (&B)[16]) {
#pragma unroll
    for (int i = 0; i < 16; ++i) A[i] = max(A[i], B[15 - i]);
    merge16_desc(A);
}
constexpr int PK_QS = 0;
constexpr int PK_SK = 256 * E_PITCH;
constexpr int PK_ML = PK_SK + 128 * E_PITCH;
constexpr int PK_X  = PK_ML + 32768;
constexpr int PK_END = PK_X + 8192;
__device__ void phase_peer_topk(const Args& a, char* lds, int vb, int nb) {
    unsigned char* ws = a.ws;
    const bf16_t* HX = (const bf16_t*)(ws + WS_HX2); const bf16_t* WQ = (const bf16_t*)(ws + WS_WQ); const bf16_t* SUBK = (const bf16_t*)(ws + WS_SUBK);
    int* IDX = (int*)(ws + WS_IDX);
    int* ML = (int*)(lds + PK_ML); int* XB = (int*)(lds + PK_X);
    for (int it = vb; it < 128 * 8; it += nb) {
        const int rt = it >> 3, h = it & 7, row0 = rt * 256;
        bf16_t* park = (bf16_t*)(ws + WS_MIX) + (size_t)it * (256 * 128);
        int tid = threadIdx.x;
        {
            f32x4 acc8[2][2][4][2];
            g8::core(acc8, WQ, HX, h * 256, row0, DM, lds);
            __syncthreads();
            asm volatile("" : "+v"(tid));
            const int lane = tid & 63, wid = tid >> 6;
            const int w8r = wid >> 2, w8c = wid & 3, fr = lane & 15, fq = lane >> 4;
#pragma unroll
            for (int bj = 0; bj < 2; ++bj)
#pragma unroll
                for (int m = 0; m < 4; ++m)
#pragma unroll
                    for (int n = 0; n < 2; ++n) { const int tok = bj * 128 + w8c * 32 + n * 16 + fr, d = w8r * 64 + m * 16 + fq * 4;
                        const f32x4 v0 = acc8[0][bj][m][n], v1 = acc8[1][bj][m][n];
                        *(u32x2*)(lds + PK_QS + tok * E_PITCH + d * 2) = (u32x2){pk2(v0[0], v0[1]), pk2(v0[2], v0[3])};
                        *(u32x2*)(park + tok * 128 + d) = (u32x2){pk2(v1[0], v1[1]), pk2(v1[2], v1[3])}; }
        }
        const int lane = tid & 63, wid = tid >> 6, wm = wid & 3, wn = wid >> 2, r32 = lane & 31, hi = lane >> 5;
#pragma unroll 1
        for (int p = 0; p < 2; ++p) {
            f32x16 acc[2][2];
            if (p == 1) {
#pragma unroll
                for (int i = 0; i < 8; ++i) { const int c = tid + NTHR * i, tok = c >> 4, ch = c & 15; *(u32x4*)(lds + PK_QS + tok * E_PITCH + ch * 16) = *(const u32x4*)(park + tok * 128 + ch * 8); }
            }
            {
                const bf16_t* sk = SUBK + (size_t)(h * 2 + p) * 128 * 128;
#pragma unroll
                for (int i = 0; i < 4; ++i) { const int c = tid + NTHR * i, r = c >> 4, ch = c & 15; *(u32x4*)(lds + PK_SK + r * E_PITCH + ch * 16) = *(const u32x4*)(sk + r * 128 + ch * 8); }
            }
            __syncthreads();
#pragma unroll
            for (int ft = 0; ft < 2; ++ft)
#pragma unroll
                for (int tt = 0; tt < 2; ++tt)
#pragma unroll
                    for (int r = 0; r < 16; ++r) acc[ft][tt][r] = 0.f;
#pragma unroll
            for (int ks = 0; ks < 8; ++ks) {
                const bf16x8 a0 = *(const bf16x8*)(lds + PK_SK + (wn * 64 + r32) * E_PITCH + (ks * 16 + hi * 8) * 2), a1 = *(const bf16x8*)(lds + PK_SK + (wn * 64 + 32 + r32) * E_PITCH + (ks * 16 + hi * 8) * 2);
                const bf16x8 b0 = *(const bf16x8*)(lds + PK_QS + (wm * 64 + r32) * E_PITCH + (ks * 16 + hi * 8) * 2), b1 = *(const bf16x8*)(lds + PK_QS + (wm * 64 + 32 + r32) * E_PITCH + (ks * 16 + hi * 8) * 2);
                acc[0][0] = MFMA(a0, b0, acc[0][0]); acc[0][1] = MFMA(a0, b1, acc[0][1]);
                acc[1][0] = MFMA(a1, b0, acc[1][0]); acc[1][1] = MFMA(a1, b1, acc[1][1]);
            }
#pragma unroll
            for (int tt = 0; tt < 2; ++tt) {
                int A[16], B[16];
#pragma unroll
                for (int r = 0; r < 16; ++r) { const int key = wn * 64 + 8 * (r >> 2) + 4 * hi + (r & 3);
                    A[r] = (fkey(acc[0][tt][r]) & ~127) | key; B[r] = (fkey(acc[1][tt][r]) & ~127) | (key + 32); }
                sort16_desc(A); sort16_desc(B); top16_merge(A, B);
#pragma unroll
                for (int r = 0; r < 16; ++r) { auto rr = __builtin_amdgcn_permlane32_swap((unsigned)A[r], (unsigned)A[r], false, false); B[r] = (int)(hi ? rr[0] : rr[1]); }
                top16_merge(A, B);
                const int tok = wm * 64 + tt * 32 + r32;
                if (wn == 1 && hi == 0) {
#pragma unroll
                    for (int r = 0; r < 16; ++r) XB[(wm * 32 + r32) * 16 + r] = A[r];
                }
                __syncthreads();
                if (wn == 0 && hi == 0) {
#pragma unroll
                    for (int r = 0; r < 16; ++r) B[r] = XB[(wm * 32 + r32) * 16 + r];
                    top16_merge(A, B);
#pragma unroll
                    for (int r = 0; r < 16; ++r) ML[(tok * 2 + p) * 16 + r] = A[r];
                }
                __syncthreads();
            }
        }
        if (tid < 256) {
            const int tok = tid;
            int s1[16], s2[16];
#pragma unroll
            for (int r = 0; r < 16; ++r) { s1[r] = ML[(tok * 2 + 0) * 16 + r]; s2[r] = ML[(tok * 2 + 1) * 16 + r]; }
            float f1[16], f2[16];
#pragma unroll
            for (int r = 0; r < 16; ++r) { f1[r] = fval(s1[r] & ~127); f2[r] = fval(s2[r] & ~127); }
            int G0[16], G1[16], G2[16], G3[16];
#pragma unroll
            for (int bb = 0; bb < 16; ++bb) G0[bb] = (fkey(f1[0] + f2[bb]) & ~255) | (0 * 16 + bb);
#pragma unroll
            for (int bb = 0; bb < 8; ++bb) G1[bb] = (fkey(f1[1] + f2[bb]) & ~255) | (1 * 16 + bb);
#pragma unroll
            for (int bb = 0; bb < 5; ++bb) G1[8 + bb] = (fkey(f1[2] + f2[bb]) & ~255) | (2 * 16 + bb);
#pragma unroll
            for (int bb = 0; bb < 3; ++bb) G1[13 + bb] = (fkey(f1[3] + f2[bb]) & ~255) | (3 * 16 + bb);
            G2[0] = (fkey(f1[3] + f2[3]) & ~255) | (3 * 16 + 3);
#pragma unroll
            for (int bb = 0; bb < 3; ++bb) G2[1 + bb] = (fkey(f1[4] + f2[bb]) & ~255) | (4 * 16 + bb);
#pragma unroll
            for (int aa = 5; aa < 8; ++aa)
#pragma unroll
                for (int bb = 0; bb < 2; ++bb) G2[4 + (aa - 5) * 2 + bb] = (fkey(f1[aa] + f2[bb]) & ~255) | (aa * 16 + bb);
#pragma unroll
            for (int aa = 8; aa < 14; ++aa) G2[10 + (aa - 8)] = (fkey(f1[aa] + f2[0]) & ~255) | (aa * 16);
            G3[0] = (fkey(f1[14] + f2[0]) & ~255) | (14 * 16); G3[1] = (fkey(f1[15] + f2[0]) & ~255) | (15 * 16);
#pragma unroll
            for (int r = 2; r < 16; ++r) G3[r] = (int)0x80000000;
            sort16_desc(G0); sort16_desc(G1); sort16_desc(G2); sort16_desc(G3);
            top16_merge(G0, G1); top16_merge(G2, G3); top16_merge(G0, G2);
            float tv[16]; float mx = fval(G0[0] & ~255), sum = 0.f;
#pragma unroll
            for (int r = 0; r < 16; ++r) { tv[r] = __expf(fval(G0[r] & ~255) - mx); sum += tv[r]; }
            const float rs = 1.f / sum;
            const size_t ob = ((size_t)(row0 + tok) * 8 + h) * 16;
#pragma unroll
            for (int r = 0; r < 16; ++r) { const int code = G0[r] & 255, aa = code >> 4, bb = code & 15;
                const int i1 = ML[(tok * 2 + 0) * 16 + aa] & 127, i2 = ML[(tok * 2 + 1) * 16 + bb] & 127;
                IDX[ob + r] = (i1 * 128 + i2) | (int)((unsigned)f2bf(tv[r] * rs) << 16); }
        }
        __syncthreads();
    }
}

template <int CTRL> __device__ __forceinline__ float dpp_add(float v) { return v + __uint_as_float(__builtin_amdgcn_update_dpp(0u, __float_as_uint(v), CTRL, 0xf, 0xf, true)); }
__device__ __forceinline__ float wave_sum_bcast(float p) {
    p = dpp_add<0xB1>(p); p = dpp_add<0x4E>(p); p = dpp_add<0x141>(p); p = dpp_add<0x140>(p);
    const unsigned u = __float_as_uint(p);
    return (__uint_as_float(__builtin_amdgcn_readlane(u, 0)) + __uint_as_float(__builtin_amdgcn_readlane(u, 16))) + (__uint_as_float(__builtin_amdgcn_readlane(u, 32)) + __uint_as_float(__builtin_amdgcn_readlane(u, 48)));
}
typedef float f32x4v __attribute__((ext_vector_type(4)));
constexpr int P7_RS = 9;
constexpr int P7_NR = PEER_N >> P7_RS;
constexpr int P7_HTP = 1024 + 64;
constexpr float H_SCALE = 16.f;
constexpr int P7_ATP = 2048 + 16;
constexpr float W_SCALE = 16.f;
constexpr int P7_RING = 16384;
constexpr int P7_WLDS = P7_RING + 2048;
#ifndef P7_UREP
#define P7_UREP 1
#endif
#ifndef P7_UD
#define P7_UD 3
#endif
#ifndef P7_VMASK
#define P7_VMASK 16383u
#endif
#ifndef P7_VPROBE
#define P7_VPROBE 0
#endif
template <int MODE>
__device__ __forceinline__ void p7_vsweep(f32x16 (&acc)[8], const unsigned* LIST, const unsigned char* VT, int m32, int kh, unsigned psel, unsigned ntok) {
    constexpr unsigned EM = MODE == 1 ? P7_VMASK : 16383u;
    i32x8 abuf[8];
#pragma unroll
    for (int T = 0; T < 8; ++T)
#pragma unroll
        for (int i = 0; i < 16; ++i) acc[T][i] = 0.f;
    u32x4 c0 = *(const u32x4*)(LIST + kh * 8), c1 = *(const u32x4*)(LIST + kh * 8 + 4);
    {
        unsigned off[8];
#pragma unroll
        for (int j = 0; j < 8; ++j) off[j] = (((j < 4 ? c0[j & 3] : c1[j & 3]) & EM) << 10) + m32 * 4;
#pragma unroll
        for (int T = 0; T < 8; ++T) {
#pragma unroll
            for (int j = 0; j < 8; ++j) abuf[T][j] = *(const int*)(VT + off[j] + T * 128);
            __builtin_amdgcn_sched_barrier(0); }
    }
#pragma unroll 1
    for (int bi = 0; bi < 32; ++bi) {
        const int bn = (bi < 31 ? bi + 1 : 31);
        const u32x4 l0 = *(const u32x4*)(LIST + bn * 16 + kh * 8), l1 = *(const u32x4*)(LIST + bn * 16 + kh * 8 + 4);
        unsigned noff[8];
#pragma unroll
        for (int j = 0; j < 8; ++j) noff[j] = (((j < 4 ? l0[j & 3] : l1[j & 3]) & EM) << 10) + m32 * 4;
        i32x8 bop;
#pragma unroll
        for (int j = 0; j < 8; ++j) { const unsigned e = j < 4 ? c0[j & 3] : c1[j & 3];
            bop[j] = (((e >> 14) & 3u) == ntok) ? (int)__builtin_amdgcn_perm(0u, e, psel) : 0; }
        c0 = l0; c1 = l1;
#pragma unroll
        for (int T = 0; T < 8; ++T) {
            __builtin_amdgcn_sched_barrier(0);
            if (MODE != 2) asm volatile("s_waitcnt vmcnt(24)" ::: "memory");
            if (MODE == 1) { int t_ = abuf[T][0];
#pragma unroll
                for (int j = 1; j < 8; ++j) t_ |= abuf[T][j];
                acc[T][0] = __int_as_float(t_ | bop[0]); }
            else acc[T] = __builtin_amdgcn_mfma_scale_f32_32x32x64_f8f6f4(abuf[T], bop, acc[T], 0, 0, 0, 127, 0, 127);
            if (MODE != 2) {
#pragma unroll
                for (int j = 0; j < 8; ++j) abuf[T][j] = *(const int*)(VT + noff[j] + T * 128); }
        }
        __builtin_amdgcn_sched_barrier(0);
    }
    if (MODE != 0) {
#pragma unroll
        for (int T = 0; T < 8; ++T) asm volatile("" :: "v"(acc[T]));
    }
}
__device__ void phase_peer_gather(const Args& a, char* lds, int vb, int nb) {
    unsigned char* ws = a.ws;
    const bf16_t* HX = (const bf16_t*)(ws + WS_HX2);
    const int* IDX = (const int*)(ws + WS_IDX);
    const float* mod = (const float*)(ws + WS_MOD);
    const unsigned char* UT = ws + WS_UT; const unsigned char* VT = ws + WS_VT;
    const bf16_t* XM = (const bf16_t*)(ws + WS_XM);
#pragma unroll 1
    for (int tb = vb * 32; tb < NTOK; tb += nb * 32) {
        int tid = threadIdx.x; asm volatile("" : "+v"(tid));
        const int lane = tid & 63, wid = tid >> 6, r16 = lane & 15, kg = lane >> 4;
        char* HT = lds + wid * P7_WLDS; unsigned* LIST = (unsigned*)(HT + P7_RING); char* AT = HT;
        const int tok0 = tb + wid * 4;
        {
            int* HIST = (int*)HT; int* CUR = HIST + 128;
            int ee[8];
            const int* ip = IDX + (size_t)tok0 * 128 + lane;
#pragma unroll
            for (int k = 0; k < 4; ++k) { ee[2 * k] = ip[k * 128]; ee[2 * k + 1] = ip[k * 128 + 64]; }
            HIST[lane] = 0; HIST[64 + lane] = 0;
#pragma unroll
            for (int j = 0; j < 8; ++j) atomicAdd(&HIST[(((ee[j] >> P7_RS) & (P7_NR - 1)) << 2) | (j >> 1)], 1);
            const int c0 = HIST[2 * lane], c1 = HIST[2 * lane + 1];
            int inc = c0 + c1;
#pragma unroll
            for (int o = 1; o < 64; o <<= 1) { const int t = __shfl_up(inc, o); if (lane >= o) inc += t; }
            CUR[2 * lane] = inc - c0 - c1; CUR[2 * lane + 1] = inc - c1;
#pragma unroll
            for (int j = 0; j < 8; ++j) { const unsigned w = (unsigned)ee[j]; const int slot = atomicAdd(&CUR[(((w >> P7_RS) & (P7_NR - 1)) << 2) | (j >> 1)], 1);
                LIST[slot] = (w & 16383u) | ((unsigned)(j >> 1) << 14) | ((w >> 16) << 17); }
        }
#pragma unroll 1
        for (int urep = 0; urep < P7_UREP; ++urep) {
        if (urep) asm volatile("s_waitcnt vmcnt(0)" ::: "memory");
        {
            const bf16_t* hp = HX + (size_t)tok0 * DM + lane * 16;
#pragma unroll
            for (int k = 0; k < 4; ++k) { const u32x4 h0 = *(const u32x4*)(hp + k * DM), h1 = *(const u32x4*)(hp + k * DM + 8);
                u32x4 o, ol;
#pragma unroll
                for (int q = 0; q < 4; ++q) { const unsigned wa = q < 2 ? h0[2 * q] : h1[2 * q - 4], wb = q < 2 ? h0[2 * q + 1] : h1[2 * q - 3];
                    const float x0 = bflo(wa) * H_SCALE, x1 = bfhi(wa) * H_SCALE, x2 = bflo(wb) * H_SCALE, x3 = bfhi(wb) * H_SCALE;
                    int w = __builtin_amdgcn_cvt_pk_fp8_f32(sat8(x0), sat8(x1), 0, false); w = __builtin_amdgcn_cvt_pk_fp8_f32(sat8(x2), sat8(x3), w, true); o[q] = (unsigned)w;
                    const float r0 = (x0 - __builtin_amdgcn_cvt_f32_fp8(w, 0)) * 16.f, r1 = (x1 - __builtin_amdgcn_cvt_f32_fp8(w, 1)) * 16.f, r2 = (x2 - __builtin_amdgcn_cvt_f32_fp8(w, 2)) * 16.f, r3 = (x3 - __builtin_amdgcn_cvt_f32_fp8(w, 3)) * 16.f;
                    int wl = __builtin_amdgcn_cvt_pk_fp8_f32(sat8(r0), sat8(r1), 0, false); wl = __builtin_amdgcn_cvt_pk_fp8_f32(sat8(r2), sat8(r3), wl, true); ol[q] = (unsigned)wl; }
                *(u32x4*)(HT + (2 * k) * P7_HTP + lane * 16) = o; *(u32x4*)(HT + (2 * k + 1) * P7_HTP + lane * 16) = ol;
            }
        }
        {
            i32x8 hb[8];
            {
                const char* hp = HT + (2 * (lane & 3) + ((lane >> 2) & 1)) * P7_HTP + kg * 32;
#pragma unroll
                for (int kc = 0; kc < 8; ++kc) { const i32x4 x0 = *(const i32x4*)(hp + kc * 128), x1 = *(const i32x4*)(hp + kc * 128 + 16);
                    hb[kc] = __builtin_shufflevector(x0, x1, 0, 1, 2, 3, 4, 5, 6, 7); }
            }
            unsigned entv = LIST[r16];
            asm volatile("s_waitcnt lgkmcnt(0)" ::: "memory");
            LAS unsigned char* ring = (LAS unsigned char*)lds + __builtin_amdgcn_readfirstlane(wid) * P7_WLDS;
#define U_DMA(slot, gp) do { __builtin_amdgcn_global_load_lds((const unsigned*)(gp), (LAS unsigned*)(ring + (slot) * 2048), 16, 0, 0); } while (0)
            const int lrow = lane >> 3;
            const unsigned swz = (unsigned)(((lane & 7) ^ (((lrow >> 1) & 3) << 1)) << 4);
            unsigned olo = (((unsigned)__shfl((int)entv, lrow) & 16383u) << 10) + swz, ohi = (((unsigned)__shfl((int)entv, 8 + lrow) & 16383u) << 10) + swz;
#pragma unroll
            for (int st = 0; st < P7_UD; ++st) { U_DMA(st, UT + olo + st * 128); __builtin_amdgcn_global_load_lds((const unsigned*)(UT + ohi + st * 128), (LAS unsigned*)(ring + st * 2048 + 1024), 16, 0, 0); }
            const int ard = (r16 >> 3) * 1024 + (r16 & 7) * 128 + ((kg ^ ((r16 >> 1) & 3)) << 5);
            const float pscl = (lane & 8) ? 0.f : ((lane & 4) ? 1.f / 16.f : 1.f);
            asm volatile("s_waitcnt vmcnt(%0)" :: "n"(2 * P7_UD - 2) : "memory");
            i32x4 a0 = *(const LAS i32x4*)(ring + ard), a1 = *(const LAS i32x4*)(ring + ard + 16);
#pragma unroll 1
            for (int bi = 0; bi < 32; ++bi) {
                const unsigned entn = LIST[(bi < 31 ? bi + 1 : 31) * 16 + r16];
                const unsigned nlo = (((unsigned)__shfl((int)entn, lrow) & 16383u) << 10) + swz, nhi = (((unsigned)__shfl((int)entn, 8 + lrow) & 16383u) << 10) + swz;
                f32x4v D = {0.f, 0.f, 0.f, 0.f};
#pragma unroll
                for (int kc = 0; kc < 8; ++kc) {
                    asm volatile("" ::: "memory");
                    {
                        const unsigned glo = (kc + P7_UD < 8 ? olo : nlo) + ((kc + P7_UD) & 7) * 128, ghi = (kc + P7_UD < 8 ? ohi : nhi) + ((kc + P7_UD) & 7) * 128;
                        __builtin_amdgcn_global_load_lds((const unsigned*)(UT + glo), (LAS unsigned*)(ring + ((kc + P7_UD) & 7) * 2048), 16, 0, 0);
                        __builtin_amdgcn_global_load_lds((const unsigned*)(UT + ghi), (LAS unsigned*)(ring + ((kc + P7_UD) & 7) * 2048 + 1024), 16, 0, 0);
                    }
                    asm volatile("s_waitcnt vmcnt(%0)" :: "n"(2 * P7_UD - 2) : "memory");
                    const i32x4 n0 = *(const LAS i32x4*)(ring + ((kc + 1) & 7) * 2048 + ard), n1 = *(const LAS i32x4*)(ring + ((kc + 1) & 7) * 2048 + ard + 16);
                    D = __builtin_amdgcn_mfma_scale_f32_16x16x128_f8f6f4(__builtin_shufflevector(a0, a1, 0, 1, 2, 3, 4, 5, 6, 7), hb[kc], D, 0, 0, 0, 127, 0, 127);
                    a0 = n0; a1 = n1;
                }
                olo = nlo; ohi = nhi;
                float dsel = 0.f; unsigned esel = 0u;
#pragma unroll
                for (int i = 0; i < 4; ++i) {
                    const unsigned er = (unsigned)__shfl((int)entv, 4 * kg + i);
                    float m = (((er >> 14) & 3u) == (unsigned)(lane & 3)) ? D[i] * pscl : 0.f;
                    m = dpp_add<0xB1>(m); m = dpp_add<0x4E>(m); m = dpp_add<0x104>(m);
                    const bool pick = (lane & 3) == i; dsel = pick ? m : dsel; esel = pick ? er : esel;
                }
                if ((lane & 12) == 0) {
                    const float w = __uint_as_float((esel >> 17) << 16) * gelu_tanh(dsel * (1.f / (T_SCALE * H_SCALE))) * W_SCALE;
                    const int p0 = __builtin_amdgcn_cvt_pk_fp8_f32(sat8(w), 0.f, 0, false);
                    const float hf = __builtin_amdgcn_cvt_f32_fp8(p0, 0);
                    const int p1 = __builtin_amdgcn_cvt_pk_fp8_f32(sat8((w - hf) * 16.f), 0.f, 0, false);
                    LIST[bi * 16 + 4 * kg + (lane & 3)] = (esel & 0xffffu) | (((unsigned)p0 & 0xffu) << 16) | (((unsigned)p1 & 0xffu) << 24); }
                entv = entn;
            }
        }
        }
        {
            const int m32 = lane & 31, kh = lane >> 5, ntok = m32 >> 3, npart = (m32 >> 2) & 1, nc = m32 & 3;
            const unsigned psel = (0x0c0c0c0cu & ~(0xffu << (8 * nc))) | ((unsigned)(2 + npart) << (8 * nc));
            f32x16 acc[8];
#if P7_VPROBE
            p7_vsweep<P7_VPROBE>(acc, LIST, VT, m32, kh, psel, (unsigned)ntok);
#endif
            p7_vsweep<0>(acc, LIST, VT, m32, kh, psel, (unsigned)ntok);
            const float psc = npart ? V_SCALE / (W_SCALE * T_SCALE * 16.f) : V_SCALE / (W_SCALE * T_SCALE);
            char* arow = AT + ntok * P7_ATP + (16 * kh + nc) * 2;
#pragma unroll
            for (int T = 0; T < 8; ++T)
#pragma unroll
                for (int i = 0; i < 16; ++i) {
                    const float v = acc[T][i] * psc;
                    const float tot = (T & 1) ? dpp_add<0x114>(v) : dpp_add<0x104>(v);
                    if ((T & 1) == npart) *(_Float16*)(arow + (128 * T + 4 * ((i & 3) + 8 * (i >> 2))) * 2) = (_Float16)tot;
                }
        }
#pragma unroll
        for (int k = 0; k < 4; ++k) {
            const int tok = tok0 + k;
            float f[16]; float ss = 0.f;
            const u32x4 e0 = *(const u32x4*)(AT + k * P7_ATP + lane * 32), e1 = *(const u32x4*)(AT + k * P7_ATP + lane * 32 + 16);
#pragma unroll
            for (int i = 0; i < 8; ++i) { const unsigned cw = i < 4 ? e0[i] : e1[i - 4]; const h16x2 hv = as_h2(cw);
                f[2 * i] = (float)hv[0] * (1.f / V_SCALE); f[2 * i + 1] = (float)hv[1] * (1.f / V_SCALE); ss += f[2 * i] * f[2 * i] + f[2 * i + 1] * f[2 * i + 1]; }
            ss = wave_sum_bcast(ss);
            const float rinv = rsqrtf(ss * (1.f / DM) + EPS);
            const float* g2 = mod + (size_t)(tok >> 11) * 6144 + 5120;
            const u32x4 xa = *(const u32x4*)(XM + (size_t)tok * DM + lane * 16), xb = *(const u32x4*)(XM + (size_t)tok * DM + lane * 16 + 8);
#pragma unroll
            for (int q4 = 0; q4 < 4; ++q4) {
                const int c = lane * 16 + q4 * 4;
                const unsigned x01 = q4 < 2 ? xa[2 * q4] : xb[2 * q4 - 4], x23 = q4 < 2 ? xa[2 * q4 + 1] : xb[2 * q4 - 3];
                const f32x4 xm = {bflo(x01), bfhi(x01), bflo(x23), bfhi(x23)}, g2v = *(const f32x4*)(g2 + c), gp = *(const f32x4*)(a.in[I_GPOSTFFN] + c);
                f32x4 o;
#pragma unroll
                for (int jj = 0; jj < 4; ++jj) o[jj] = xm[jj] + g2v[jj] * (f[q4 * 4 + jj] * rinv * gp[jj]);
                *(f32x4*)(a.out + (size_t)tok * DM + c) = o; }
        }
    }
}

#ifdef DBG_DIGEST
__device__ void phase_digest(const Args& a, int vb, int nb) {
    const bf16_t* A2 = (const bf16_t*)(a.ws + WS_A2);
    const bf16_t* Q = (const bf16_t*)(a.ws + WS_Q); const bf16_t* K = (const bf16_t*)(a.ws + WS_K); const bf16_t* VV = (const bf16_t*)(a.ws + WS_VV);
    const bf16_t* L = (const bf16_t*)(a.ws + WS_L); const bf16_t* ZG = (const bf16_t*)(a.ws + WS_ZG);
    for (size_t e = (size_t)vb * NTHR + threadIdx.x; e < (size_t)NTOK * DM; e += (size_t)nb * NTHR) {
        float v = 0.f;
#if DBG_DIGEST == 3
        const size_t row = e >> 10; const int c = (int)(e & 1023);
        v = bf2f(A2[row * KOUT + c]); if (c < 512) v += bf2f(A2[row * KOUT + 1024 + c]);
#elif DBG_DIGEST == 2
        const size_t h = e % ((size_t)NTOK * 512);
        v = bf2f(Q[h]) + bf2f(ZG[h]) + bf2f(L[e % ((size_t)NB * STOT * 512)]);
        if (e < (size_t)NB * 2 * STOT * 64) v += bf2f(K[e]) + bf2f(VV[e]);
#endif
        a.out[e] = v; }
}
#endif
constexpr int LDS_BYTES = 155648;
constexpr int LDS_BARST = LDS_BYTES - 16;
static_assert(8 * P7_HTP <= P7_RING && 4 * P7_ATP <= P7_RING && 8 * P7_WLDS <= LDS_BARST && PK_END <= LDS_BARST && LR_END <= LDS_BARST && g8::SHM_B <= LDS_BARST && 17 * 1024 * 4 + 17 * 24 * 4 <= LDS_BARST, "LDS budget");
constexpr int N_PHASES = 8;

__global__ void __launch_bounds__(NTHR, 2) mk_fwd(Args a) {
    extern __shared__ __attribute__((aligned(16))) char lds[];
    const int nb = gridDim.x, bx = blockIdx.x;
    const int vb0 = (nb % 8 == 0) ? (bx % 8) * (nb / 8) + bx / 8 : bx;
    XcdBarrier bar; bar.bar = (unsigned*)(a.ws + WS_CTL); bar.x = 0; bar.st = (volatile LAS unsigned*)(LAS char*)(lds + LDS_BARST);
    const bool multi = (a.ph_hi - a.ph_lo) > 1;
    if (multi) {
        if (threadIdx.x < 4) ((volatile LAS unsigned*)(LAS char*)(lds + LDS_BARST))[threadIdx.x] = 0u;
        __syncthreads();
        bar = xcd_barrier_post((unsigned*)(a.ws + WS_CTL), (volatile LAS unsigned*)(LAS char*)(lds + LDS_BARST));
    }
#ifndef P7_PROBE
#define P7_PROBE -1
#endif
#ifndef DBL_PHASE
#define DBL_PHASE 0
#endif
#if DBL_PHASE != 0
#define RUN_PHASE(P, CALL) do { if (a.ph_lo <= (P) && (P) < a.ph_hi) { const int nrep_ = ((a.dbl >> (P)) & 1) ? 2 : 1; for (int rep_ = 0; rep_ < nrep_; ++rep_) { CALL; if ((P) + 1 < a.ph_hi || rep_ + 1 < nrep_) xcd_barrier(bar); } } } while (0)
#else
#define RUN_PHASE(P, CALL) do { if (a.ph_lo <= (P) && (P) < a.ph_hi) { CALL; if ((P) + 1 < a.ph_hi) xcd_barrier(bar); } } while (0)
#endif
#if !defined(ONLY_PHASE) || ONLY_PHASE == 0
    RUN_PHASE(0, phase_prep(a, lds, vb0, nb));
#endif
    int vb = vb0;
    if (multi && a.ph_lo == 0 && a.ph_hi > 1) {
        if (threadIdx.x == 0) { unsigned off = 0; for (unsigned j = 0; j < bar.x; ++j) off += xb_ld(&bar.bar[XB_XCNT(j)]); bar.st[3] = off + bar.st[2]; }
        __syncthreads();
        vb = (int)bar.st[3];
    }
#if !defined(ONLY_PHASE) || ONLY_PHASE == 1
    RUN_PHASE(1, phase_xn(a, vb, nb));
#endif
#if !defined(ONLY_PHASE) || ONLY_PHASE == 2
    RUN_PHASE(2, phase_inproj(a, lds, vb, nb));
#endif
#if (!defined(ONLY_PHASE) || ONLY_PHASE == 3) && !(defined(DBG_DIGEST) && DBG_DIGEST == 2)
    RUN_PHASE(3, phase_mixer(a, lds, vb, nb));
#endif
#ifdef DBG_DIGEST
    if (a.ph_lo <= 4 && 4 < a.ph_hi) phase_digest(a, vb, nb);
    return;
#endif
#if !defined(ONLY_PHASE) || ONLY_PHASE == 4
    RUN_PHASE(4, phase_outproj(a, lds, vb, nb));
#endif
#if !defined(ONLY_PHASE) || ONLY_PHASE == 5
    RUN_PHASE(5, phase_rowpass(a, vb, nb));
#endif
#if !defined(ONLY_PHASE) || ONLY_PHASE == 6
    RUN_PHASE(6, phase_peer_topk(a, lds, vb, nb));
#endif
#if !defined(ONLY_PHASE) || ONLY_PHASE == 7
    RUN_PHASE(7, phase_peer_gather(a, lds, vb, nb));
#endif
}

extern "C" void kernel_launch(void* const* d_in, const int* in_sizes, int n_in, void* d_out, int out_size, void* d_ws, size_t ws_size, hipStream_t stream) {
    static int grid = 0;
    if (grid == 0) {
        if (n_in != 25 || out_size != NTOK * DM || ws_size < WS_END) { fprintf(stderr, "kernel_launch: unexpected shapes (n_in %d, out %d, ws %zu, need %zu)\n", n_in, out_size, ws_size, (size_t)WS_END); grid = -1; return; }
        int dev = 0, cus = 0;
        if (hipGetDevice(&dev) != hipSuccess || hipDeviceGetAttribute(&cus, hipDeviceAttributeMultiprocessorCount, dev) != hipSuccess) { grid = -1; return; }
        if (hipFuncSetAttribute((const void*)mk_fwd, hipFuncAttributeMaxDynamicSharedMemorySize, LDS_BYTES) != hipSuccess) { fprintf(stderr, "kernel_launch: hipFuncSetAttribute failed\n"); grid = -1; return; }
        (void)hipGetLastError();
        grid = cus;
    }
    if (grid < 0) return;
    (void)hipMemsetAsync((char*)d_ws + WS_CTL, 0, CTL_BYTES, stream);
    Args a{};
    for (int i = 0; i < 25; ++i) a.in[i] = (const float*)d_in[i];
    a.out = (float*)d_out; a.ws = (unsigned char*)d_ws; a.dbl = DBL_PHASE; a.probe = P7_PROBE;
#if MK_N_LAUNCHES == 1
    a.ph_lo = 0; a.ph_hi = N_PHASES;
    hipLaunchKernelGGL(mk_fwd, dim3(grid), dim3(NTHR), LDS_BYTES, stream, a);
#else
    for (int ph = 0; ph < N_PHASES; ++ph) { a.ph_lo = ph; a.ph_hi = ph + 1; hipLaunchKernelGGL(mk_fwd, dim3(grid), dim3(NTHR), LDS_BYTES, stream, a); }
#endif
}
```

```cpp
#include <hip/hip_runtime.h>
#include <cstdio>
#include <cstdint>

#ifndef MK_N_LAUNCHES
#define MK_N_LAUNCHES 1
#endif

typedef unsigned short bf16_t;
typedef short bf16x8 __attribute__((ext_vector_type(8)));
typedef float f32x16 __attribute__((ext_vector_type(16)));
typedef float f32x4 __attribute__((ext_vector_type(4)));
typedef float f32x2 __attribute__((ext_vector_type(2)));
typedef unsigned u32x4 __attribute__((ext_vector_type(4)));
typedef unsigned u32x2 __attribute__((ext_vector_type(2)));
typedef int i32x8 __attribute__((ext_vector_type(8)));
typedef int i32x4 __attribute__((ext_vector_type(4)));
#define LAS __attribute__((address_space(3)))

constexpr int DM = 1024, NB = 16, SEQ = 2048, CTX = 256, STOT = SEQ + CTX;
constexpr int NTOK = NB * SEQ;
constexpr int NCTX = NB * CTX;
constexpr int NROWS = NTOK + NCTX;
constexpr int DIN = 1792, DLRU = 512;
constexpr int KOUT = 1536;
constexpr int PEER_N = 16384;
constexpr float EPS = 1e-6f;
constexpr int NTHR = 512;

constexpr size_t al256(size_t x) { return (x + 255) & ~(size_t)255; }
constexpr size_t WS_CTL   = 0;
constexpr size_t CTL_BYTES = 65536;
constexpr size_t WS_MOD   = WS_CTL + CTL_BYTES;
constexpr size_t WS_ROPE  = WS_MOD + al256(17 * 6144 * 4);
constexpr size_t WS_WIN   = WS_ROPE + al256(64 * 16 * 2 * 4);
constexpr size_t WS_WOUT  = WS_WIN + al256((size_t)DIN * DM * 2);
constexpr size_t WS_WQ    = WS_WOUT + al256((size_t)DM * KOUT * 2);
constexpr size_t WS_SUBK  = WS_WQ + al256((size_t)2048 * DM * 2);
constexpr size_t WS_RGW   = WS_SUBK + al256((size_t)8 * 2 * 128 * 128 * 2);
constexpr size_t WS_UT    = WS_RGW + al256((size_t)2 * 8 * 128 * 64 * 2);
constexpr size_t WS_VT    = WS_UT + al256((size_t)PEER_N * DM * 2);
constexpr size_t WS_XN    = WS_VT + al256((size_t)PEER_N * DM * 2);
constexpr size_t WS_Q     = WS_XN + al256((size_t)NROWS * DM * 2);
constexpr size_t WS_K     = WS_Q + al256((size_t)NTOK * 512 * 2);
constexpr size_t WS_VV    = WS_K + al256((size_t)NB * 2 * STOT * 64 * 2);
constexpr size_t WS_L     = WS_VV + al256((size_t)NB * 2 * STOT * 64 * 2);
constexpr size_t WS_ZG    = WS_L + al256((size_t)NB * STOT * DLRU * 2);
constexpr size_t WS_A2    = WS_ZG + al256((size_t)NTOK * DLRU * 2);
constexpr size_t WS_END   = WS_A2 + al256((size_t)NTOK * KOUT * 2);
constexpr size_t WS_MIX   = WS_XN;
constexpr size_t WS_HX2   = WS_A2;
constexpr size_t WS_XM    = WS_Q;
constexpr size_t WS_IDX   = WS_ZG;
constexpr size_t WS_GATE  = WS_ZG + (size_t)NTOK * 128 * 4;
static_assert(WS_MIX + (size_t)NTOK * DM * 4 <= WS_ZG, "MIX overlay must end before ZG");
static_assert(WS_GATE + (size_t)NTOK * 128 * 4 <= WS_A2, "IDX/GATE overlay must end before A2");

typedef __bf16 bf16x2_t __attribute__((ext_vector_type(2)));
__device__ __forceinline__ unsigned pk2(float lo, float hi) { const f32x2 v = {lo, hi}; const bf16x2_t b = __builtin_convertvector(v, bf16x2_t); return __builtin_bit_cast(unsigned, b); }
typedef _Float16 h16x2 __attribute__((ext_vector_type(2)));
constexpr float V_SCALE = 64.f;
constexpr float T_SCALE = 256.f;
#ifndef P7_FP8
#define P7_FP8 1
#endif
__device__ __forceinline__ unsigned pkh2(float lo, float hi) { const h16x2 h = {(_Float16)lo, (_Float16)hi}; return __builtin_bit_cast(unsigned, h); }
__device__ __forceinline__ bf16x2_t as_bf2(unsigned x) { return __builtin_bit_cast(bf16x2_t, x); }
__device__ __forceinline__ h16x2 as_h2(unsigned x) { return __builtin_bit_cast(h16x2, x); }
__device__ __forceinline__ bf16_t f2bf(float f) { return (bf16_t)(pk2(f, 0.f) & 0xffffu); }
__device__ __forceinline__ float bf2f(unsigned h) { return __uint_as_float(h << 16); }
__device__ __forceinline__ float bflo(unsigned w) { return __uint_as_float(w << 16); }
__device__ __forceinline__ float bfhi(unsigned w) { return __uint_as_float(w & 0xffff0000u); }
__device__ __forceinline__ float sat8(float x) { return fminf(fmaxf(x, -448.f), 448.f); }
__device__ __forceinline__ float fast_rcp(float x) { return __builtin_amdgcn_rcpf(x); }
__device__ __forceinline__ float sigmoidf_(float x) { return fast_rcp(1.f + __expf(-x)); }
__device__ __forceinline__ float gelu_tanh(float x) { const float y = 0.7978845608028654f * (x + 0.044715f * x * x * x); return x * fast_rcp(1.f + __expf(-2.f * y)); }
__device__ __forceinline__ float silu_(float x) { return x * sigmoidf_(x); }
__device__ __forceinline__ float wave_sum(float v) {
#pragma unroll
    for (int o = 32; o > 0; o >>= 1) v += __shfl_xor(v, o);
    return v;
}
__device__ __forceinline__ float half_swap_max(float v) { auto rr = __builtin_amdgcn_permlane32_swap(__float_as_uint(v), __float_as_uint(v), false, false); return fmaxf(__uint_as_float(rr[0]), __uint_as_float(rr[1])); }
__device__ __forceinline__ float half_swap_sum(float v) { auto rr = __builtin_amdgcn_permlane32_swap(__float_as_uint(v), __float_as_uint(v), false, false); return __uint_as_float(rr[0]) + __uint_as_float(rr[1]); }
#define MFMA(a, b, c) __builtin_amdgcn_mfma_f32_32x32x16_bf16((a), (b), (c), 0, 0, 0)

#define XB_TMO      128
#define XB_XCNT(j)  (256  + 64 * (j))
#define XB_XSUB(j)  (1280 + 64 * (j))
#define XB_XGEN(j)  (2304 + 64 * (j))
#define XB_TOP      3328
#define XB_TOPGEN   3392
#define XCD_BAR_WORDS 3456
#define XB_SPIN_CAP (1u << 20)
__device__ __forceinline__ unsigned xb_ld(unsigned* p)              { return __hip_atomic_load(p, __ATOMIC_RELAXED, __HIP_MEMORY_SCOPE_AGENT); }
__device__ __forceinline__ unsigned xb_add(unsigned* p, unsigned v) { return __hip_atomic_fetch_add(p, v, __ATOMIC_RELAXED, __HIP_MEMORY_SCOPE_AGENT); }
__device__ __forceinline__ unsigned xb_xcc_id() { return (unsigned)__builtin_amdgcn_s_getreg((3 << 11) | 20) & 0xFu; }
#define XB_SPIN(cond, bar) do { unsigned _sp = 0; while (cond) { __builtin_amdgcn_s_sleep(1); \
    if ((++_sp & 255u) == 0u) { if (xb_ld(&(bar)[XB_TMO])) break; if (_sp > XB_SPIN_CAP) { atomicAdd(&(bar)[XB_TMO], 1u); break; } } } } while (0)
struct XcdBarrier { unsigned* bar; unsigned x; volatile LAS unsigned* st; };
__device__ __forceinline__ XcdBarrier xcd_barrier_post(unsigned* bar, volatile LAS unsigned* st) {
    XcdBarrier b; b.bar = bar; b.x = xb_xcc_id(); b.st = st;
    if (threadIdx.x == 0) st[2] = xb_add(&bar[XB_XCNT(b.x)], 1u);
    return b;
}
__device__ __forceinline__ void xcd_barrier_complete(unsigned* bar, unsigned x, unsigned& nloc, unsigned& nx) {
    const unsigned G = gridDim.x * gridDim.y * gridDim.z;
    unsigned sum, cnt, mine, sp = 0u;
    for (;;) {
        sum = 0u; cnt = 0u; mine = 0u;
#pragma unroll
        for (unsigned j = 0; j < 16; ++j) { const unsigned c = xb_ld(&bar[XB_XCNT(j)]); sum += c; cnt += (c > 0u) ? 1u : 0u; mine = (j == x) ? c : mine; }
        if (sum == G) break;
        __builtin_amdgcn_s_sleep(1);
        if ((++sp & 255u) == 0u) { if (xb_ld(&bar[XB_TMO])) break; if (sp > XB_SPIN_CAP) { atomicAdd(&bar[XB_TMO], 1u); break; } }
    }
    nloc = mine > 0u ? mine : 1u; nx = cnt > 0u ? cnt : 1u;
}
__device__ __forceinline__ void xcd_barrier(const XcdBarrier& b) {
    asm volatile("s_waitcnt vmcnt(0)" ::: "memory");
    __syncthreads();
    if (threadIdx.x == 0) {
        unsigned* bar = b.bar;
        __builtin_amdgcn_s_waitcnt(0);
        unsigned nloc = b.st[0], nx = b.st[1];
        if (nloc == 0u) { xcd_barrier_complete(bar, b.x, nloc, nx); b.st[0] = nloc; b.st[1] = nx; }
        const unsigned old = xb_add(&bar[XB_XSUB(b.x)], 1u);
        const unsigned gen = old / nloc;
        if (old + 1u == (gen + 1u) * nloc) {
            __builtin_amdgcn_fence(__ATOMIC_RELEASE, "agent");
            asm volatile("s_waitcnt vmcnt(0)" ::: "memory");
            const unsigned og = xb_add(&bar[XB_TOP], 1u);
            const unsigned tg = og / nx;
            if (og + 1u == (tg + 1u) * nx) xb_add(&bar[XB_TOPGEN], 1u);
            else XB_SPIN(xb_ld(&bar[XB_TOPGEN]) == tg, bar);
            __builtin_amdgcn_fence(__ATOMIC_ACQUIRE, "agent");
            xb_add(&bar[XB_XGEN(b.x)], 1u);
            asm volatile("s_waitcnt vmcnt(0)" ::: "memory");
        } else {
            XB_SPIN(xb_ld(&bar[XB_XGEN(b.x)]) == gen, bar);
            __builtin_amdgcn_fence(__ATOMIC_ACQUIRE, "agent");
            asm volatile("s_waitcnt vmcnt(0)" ::: "memory");
        }
    }
    __syncthreads();
}

struct Args { const float* in[25]; float* out; unsigned char* ws; int ph_lo, ph_hi, dbl, probe; };
enum { I_X = 0, I_C, I_CTX, I_CCTX, I_WMOD, I_BMOD, I_GPREMIX, I_GPOSTMIX, I_GPREFFN, I_GPOSTFFN, I_WIN, I_QNG, I_KNG, I_CONVW, I_CONVB,
       I_RGWA, I_RGBA, I_RGWI, I_RGBI, I_RGLAM, I_WOUT, I_PWQ, I_PSUBK, I_PU, I_PV };

__device__ __forceinline__ void tr_tile(const float* __restrict__ src, int lds_, int sr0, int sc0, bf16_t* __restrict__ dst, int ldd, int dr0, int dc0, float* T) {
    const int tid = threadIdx.x;
#pragma unroll
    for (int i = 0; i < 8; ++i) { const int e = tid + NTHR * i, r = e >> 6, c = e & 63; T[r * 65 + c] = src[(size_t)(sr0 + r) * lds_ + sc0 + c]; }
    __syncthreads();
#pragma unroll
    for (int i = 0; i < 8; ++i) { const int e = tid + NTHR * i, c = e >> 6, r = e & 63; dst[(size_t)(dr0 + c) * ldd + dc0 + r] = f2bf(T[r * 65 + c]); }
    __syncthreads();
}

constexpr int UV_ITEMS = 512;
constexpr int CTL_UVCTR = 8192;
__device__ __forceinline__ void conv_uv_item(const Args& a, int t) {
    const int tid = threadIdx.x;
    const bool isv = t >= 256; const int tt = t & 255;
    const float* src = (isv ? a.in[I_PV] : a.in[I_PU]) + (size_t)tt * 65536;
    unsigned char* d8 = a.ws + (isv ? WS_VT : WS_UT) + (size_t)tt * 65536;
#pragma unroll 1
    for (int e0 = tid * 16; e0 < 65536; e0 += NTHR * 16 * 4) {
        f32x4 v[4][4];
#pragma unroll
        for (int u = 0; u < 4; ++u)
#pragma unroll
            for (int q = 0; q < 4; ++q) v[u][q] = *(const f32x4*)(src + e0 + u * NTHR * 16 + q * 4);
#pragma unroll
        for (int u = 0; u < 4; ++u) { u32x4 o;
#pragma unroll
            for (int q = 0; q < 4; ++q) { f32x4 x = v[u][q] * T_SCALE;
#pragma unroll
                for (int i = 0; i < 4; ++i) x[i] = fminf(fmaxf(x[i], -448.f), 448.f);
                int w = __builtin_amdgcn_cvt_pk_fp8_f32(x[0], x[1], 0, false); w = __builtin_amdgcn_cvt_pk_fp8_f32(x[2], x[3], w, true); o[q] = (unsigned)w; }
            *(u32x4*)(d8 + e0 + u * NTHR * 16) = o; }
    }
}
__device__ void phase_prep(const Args& a, char* lds, int vb, int nb) {
    const int tid = threadIdx.x;
    unsigned char* ws = a.ws;
    float* S = (float*)lds;
    float* T = (float*)lds;
    constexpr int N_MOD = 256, N_TIN = 448, N_TOUT = 384, N_TWQ = 512, N_RGW = 32, N_SUBK = 16, N_UV = 0, N_MISC = 1;
    constexpr int O_TIN = N_MOD, O_TOUT = O_TIN + N_TIN, O_TWQ = O_TOUT + N_TOUT, O_RGW = O_TWQ + N_TWQ, O_SUBK = O_RGW + N_RGW, O_UV = O_SUBK + N_SUBK, O_MISC = O_UV + N_UV, N_ALL = O_MISC + N_MISC;
    for (int it = vb; it < N_ALL; it += nb) {
        if (it < O_TIN) {
            for (int e = tid; e < 17 * 1024; e += NTHR) { const int r = e >> 10, k = e & 1023; const float v = (r < 16) ? a.in[I_C][r * 1024 + k] : a.in[I_CCTX][k]; S[e] = silu_(v); }
            __syncthreads();
            const int n0 = it * 24;
            const int cc = tid % 6, kk = tid / 6;
            float acc[17][4];
#pragma unroll
            for (int r = 0; r < 17; ++r) { acc[r][0] = 0.f; acc[r][1] = 0.f; acc[r][2] = 0.f; acc[r][3] = 0.f; }
            if (tid < 510) {
                for (int k = kk; k < 1024; k += 85) {
                    const f32x4 w = *(const f32x4*)(a.in[I_WMOD] + (size_t)k * 6144 + n0 + cc * 4);
#pragma unroll
                    for (int r = 0; r < 17; ++r) { const float s = S[r * 1024 + k]; acc[r][0] += s * w[0]; acc[r][1] += s * w[1]; acc[r][2] += s * w[2]; acc[r][3] += s * w[3]; }
                }
            }
            __syncthreads();
            if (tid < 510) {
#pragma unroll
                for (int r = 0; r < 17; ++r) { f32x4 v = {acc[r][0], acc[r][1], acc[r][2], acc[r][3]}; *(f32x4*)(S + (kk * 17 + r) * 24 + cc * 4) = v; }
            }
            __syncthreads();
            float* mod = (float*)(ws + WS_MOD);
            for (int e = tid; e < 17 * 24; e += NTHR) { const int r = e / 24, j = e % 24; float sum = 0.f;
                for (int q = 0; q < 85; ++q) sum += S[(q * 17 + r) * 24 + j];
                mod[r * 6144 + n0 + j] = sum + a.in[I_BMOD][n0 + j]; }
            __syncthreads();
        } else if (it < O_TOUT) {
            const int t = it - O_TIN, kt = t / 28, nt = t % 28;
            tr_tile(a.in[I_WIN], DIN, kt * 64, nt * 64, (bf16_t*)(ws + WS_WIN), DM, nt * 64, kt * 64, T);
        } else if (it < O_TWQ) {
            const int t = it - O_TOUT, kt = t / 16, nt = t % 16;
            const int sk = (kt < 16) ? kt * 64 : (kt - 16) * 64 + 512;
            tr_tile(a.in[I_WOUT], DM, sk, nt * 64, (bf16_t*)(ws + WS_WOUT), KOUT, nt * 64, kt * 64, T);
        } else if (it < O_RGW) {
            const int t = it - O_TWQ, kt = t / 32, nt = t % 32;
            tr_tile(a.in[I_PWQ], 2048, kt * 64, nt * 64, (bf16_t*)(ws + WS_WQ), DM, nt * 64, kt * 64, T);
        } else if (it < O_SUBK) {
            const int t = it - O_RGW, g = t & 1, dn = t >> 1;
            const float* src = (g == 0 ? a.in[I_RGWA] : a.in[I_RGWI]) + (size_t)dn * 4096;
            tr_tile(src, 64, 0, 0, (bf16_t*)(ws + WS_RGW) + (size_t)dn * 128 * 64 + g * 64 * 64, 64, 0, 0, T);
        } else if (it < O_UV) {
            const int t = it - O_SUBK; const float* src = a.in[I_PSUBK] + (size_t)t * 16384; bf16_t* dst = (bf16_t*)(ws + WS_SUBK) + (size_t)t * 16384;
            for (int e = tid * 4; e < 16384; e += NTHR * 4) { const f32x4 v = *(const f32x4*)(src + e); u32x2 o = {pk2(v[0], v[1]), pk2(v[2], v[3])}; *(u32x2*)(dst + e) = o; }
        } else {
            float* rope = (float*)(ws + WS_ROPE);
            for (int e = tid; e < 64 * 16; e += NTHR) { const int pos = e >> 4, f = e & 15; const float inv = powf(10000.f, -(float)f / 16.f); const float ang = (float)pos * inv; rope[e * 2] = cosf(ang); rope[e * 2 + 1] = sinf(ang); }
        }
    }
}

__device__ void phase_xn(const Args& a, int vb, int nb) {
    const int tid = threadIdx.x, lane = tid & 63, wid = tid >> 6;
    const float* mod = (const float*)(a.ws + WS_MOD);
    bf16_t* XN = (bf16_t*)(a.ws + WS_XN);
    const float* g = a.in[I_GPREMIX];
    const int chunk = (NROWS + nb - 1) / nb, rend = min(NROWS, (vb + 1) * chunk);
    f32x4 A[4], B[4]; int cur = -1;
    for (int row = vb * chunk + wid; row < rend; row += 8) {
        const float* src; int mrow;
        if (row < NTOK) { src = a.in[I_X] + (size_t)row * DM; mrow = row >> 11; } else { src = a.in[I_CTX] + (size_t)(row - NTOK) * DM; mrow = 16; }
        f32x4 v[4]; float ss = 0.f;
#pragma unroll
        for (int i = 0; i < 4; ++i) v[i] = *(const f32x4*)(src + i * 256 + lane * 4);
        if (mrow != cur) { cur = mrow; const float* sh = mod + (size_t)mrow * 6144, *sc = sh + 1024;
#pragma unroll
            for (int i = 0; i < 4; ++i) { const int c = i * 256 + lane * 4; const f32x4 gg = *(const f32x4*)(g + c), s1 = *(const f32x4*)(sc + c); B[i] = *(const f32x4*)(sh + c);
#pragma unroll
                for (int j = 0; j < 4; ++j) A[i][j] = gg[j] * (1.f + s1[j]); } }
#pragma unroll
        for (int i = 0; i < 4; ++i) ss += v[i][0] * v[i][0] + v[i][1] * v[i][1] + v[i][2] * v[i][2] + v[i][3] * v[i][3];
        ss = wave_sum(ss);
        const float rinv = rsqrtf(ss * (1.f / DM) + EPS);
#pragma unroll
        for (int i = 0; i < 4; ++i) { const int c = i * 256 + lane * 4;
            float o[4];
#pragma unroll
            for (int j = 0; j < 4; ++j) o[j] = v[i][j] * rinv * A[i][j] + B[i][j];
            u32x2 w = {pk2(o[0], o[1]), pk2(o[2], o[3])}; *(u32x2*)(XN + (size_t)row * DM + c) = w; }
    }
}

constexpr int E_PITCH = 272;
namespace g8 {
constexpr int BM = 256, BK = 64, HALF = 128, HT = HALF * BK, SHM_B = 8 * HT * 2;
__device__ __forceinline__ int lds_byte(int r, int c) { const int st = (r >> 4) * 2 + (c >> 5), rr = r & 15, cc = c & 31, ob = rr * 64 + cc * 2; return st * 1024 + (ob ^ (((ob >> 9) & 1) << 5)); }
__device__ __forceinline__ void stage_rc(int b, int& R, int& C) { const int st = b / 1024, sb = b % 1024, swz = sb ^ (((sb >> 9) & 1) << 5); R = (st >> 1) * 16 + swz / 64; C = (st & 1) * 32 + (swz % 64) / 2; }
__device__ __forceinline__ void core(f32x4 (&acc)[2][2][4][2], const bf16_t* __restrict__ A, const bf16_t* __restrict__ Bt, int brow, int bcol, int K, char* lds_) {
    LAS unsigned char* lds = (LAS unsigned char*)lds_;
    const int tid = threadIdx.x, wid = __builtin_amdgcn_readfirstlane(tid >> 6), lane = tid & 63, wr = wid >> 2, wc = wid & 3, fr = lane & 15, fq = lane >> 4;
    constexpr int HTB = HT * 2;
    unsigned voff[2];
#pragma unroll
    for (int i = 0; i < 2; ++i) { int R, C; stage_rc(tid * 16 + i * 8192, R, C); voff[i] = (unsigned)(R * K + C) * 2u; }
    const size_t kstep = (size_t)(BK * 2), hstep = (size_t)HALF * K * 2;
    const unsigned ldsw = (unsigned)wid * 1024u;
    const int aoff = lds_byte(wr * 64 + fr, fq * 8), boff = lds_byte(wc * 32 + fr, fq * 8);
#define G8_SA(b, h) (((b) * 2 + (h)) * HTB)
#define G8_SB(b, h) ((4 + (b) * 2 + (h)) * HTB)
#define G8_STAGE(bufoff, gbase) do { _Pragma("unroll") for (int _i = 0; _i < 2; ++_i) \
        __builtin_amdgcn_global_load_lds((const unsigned*)((const char*)(gbase) + voff[_i]), (LAS unsigned*)(lds + (bufoff) + ldsw + _i * 8192), 16, 0, 0); } while (0)
#define G8_LDA(dst, b, h) do { _Pragma("unroll") for (int m = 0; m < 4; ++m) _Pragma("unroll") for (int k = 0; k < 2; ++k) dst[m][k] = *(const LAS bf16x8*)(lds + G8_SA(b, h) + aoff + m * 2048 + k * 1024); } while (0)
#define G8_LDB(dst, b, h) do { _Pragma("unroll") for (int n = 0; n < 2; ++n) _Pragma("unroll") for (int k = 0; k < 2; ++k) dst[n][k] = *(const LAS bf16x8*)(lds + G8_SB(b, h) + boff + n * 2048 + k * 1024); } while (0)
#define G8_MMA(ai, bj, At_, Bt_) do { __builtin_amdgcn_s_setprio(1); \
    _Pragma("unroll") for (int m = 0; m < 4; ++m) _Pragma("unroll") for (int n = 0; n < 2; ++n) _Pragma("unroll") for (int k = 0; k < 2; ++k) \
      acc[ai][bj][m][n] = __builtin_amdgcn_mfma_f32_16x16x32_bf16(At_[m][k], Bt_[n][k], acc[ai][bj][m][n], 0, 0, 0); \
    __builtin_amdgcn_s_setprio(0); } while (0)
#define G8_WAIT_V(n) asm volatile("s_waitcnt vmcnt(" #n ")" ::: "memory")
#define G8_WAIT_L(n) asm volatile("s_waitcnt lgkmcnt(" #n ")" ::: "memory")
#define G8_BAR __builtin_amdgcn_s_barrier()
#define G8_SCHED __builtin_amdgcn_sched_barrier(0)
#pragma unroll
    for (int ai = 0; ai < 2; ++ai)
#pragma unroll
        for (int bj = 0; bj < 2; ++bj)
#pragma unroll
            for (int m = 0; m < 4; ++m)
#pragma unroll
                for (int n = 0; n < 2; ++n) acc[ai][bj][m][n] = (f32x4){0.f, 0.f, 0.f, 0.f};
    bf16x8 At[4][2], B0[2][2], B1[2][2];
    const int nt = K / BK;
    const char* cA = (const char*)(A + (size_t)brow * K); const char* cB = (const char*)(Bt + (size_t)bcol * K);
    G8_STAGE(G8_SB(0, 0), cB); G8_STAGE(G8_SA(0, 0), cA); G8_STAGE(G8_SB(0, 1), cB + hstep); G8_STAGE(G8_SA(0, 1), cA + hstep);
    if (wr == 1) G8_BAR;
    G8_WAIT_V(4); G8_BAR;
    G8_STAGE(G8_SB(1, 0), cB + kstep); G8_STAGE(G8_SA(1, 0), cA + kstep); G8_STAGE(G8_SB(1, 1), cB + hstep + kstep);
    G8_WAIT_V(6); G8_BAR;
#pragma unroll 1
    for (int t = 0; t < nt - 2; t += 2) {
        const char* a1 = cA + (size_t)(t + 1) * kstep; const char* a2 = cA + (size_t)(t + 2) * kstep; const char* b2 = cB + (size_t)(t + 2) * kstep;
        const char* a3 = a2 + kstep; const char* b3 = b2 + kstep;
        G8_LDB(B0, 0, 0); G8_SCHED; G8_LDA(At, 0, 0); G8_STAGE(G8_SA(1, 1), a1 + hstep);
        G8_WAIT_L(8); G8_BAR; G8_WAIT_L(0); G8_MMA(0, 0, At, B0); G8_BAR; G8_SCHED;
        G8_LDB(B1, 0, 1); G8_STAGE(G8_SB(0, 0), b2);
        G8_BAR; G8_WAIT_L(0); G8_MMA(0, 1, At, B1); G8_BAR;
        G8_LDA(At, 0, 1); G8_STAGE(G8_SA(0, 0), a2);
        G8_BAR; G8_WAIT_L(0); G8_MMA(1, 0, At, B0); G8_BAR; G8_SCHED;
        G8_STAGE(G8_SB(0, 1), b2 + hstep);
        G8_WAIT_V(6); G8_BAR; G8_MMA(1, 1, At, B1); G8_BAR;
        G8_LDB(B0, 1, 0); G8_SCHED; G8_LDA(At, 1, 0); G8_STAGE(G8_SA(0, 1), a2 + hstep);
        G8_WAIT_L(8); G8_BAR; G8_WAIT_L(0); G8_MMA(0, 0, At, B0); G8_BAR; G8_SCHED;
        G8_LDB(B1, 1, 1); G8_STAGE(G8_SB(1, 0), b3);
        G8_BAR; G8_WAIT_L(0); G8_MMA(0, 1, At, B1); G8_BAR;
        G8_LDA(At, 1, 1); G8_STAGE(G8_SA(1, 0), a3);
        G8_BAR; G8_WAIT_L(0); G8_MMA(1, 0, At, B0); G8_BAR; G8_SCHED;
        G8_STAGE(G8_SB(1, 1), b3 + hstep);
        G8_WAIT_V(6); G8_BAR; G8_MMA(1, 1, At, B1); G8_BAR;
    }
    { G8_LDB(B0, 0, 0); G8_LDA(At, 0, 0); G8_STAGE(G8_SA(1, 1), cA + (size_t)(nt - 1) * kstep + hstep);
      G8_BAR; G8_WAIT_L(0); G8_MMA(0, 0, At, B0); G8_BAR;
      G8_LDB(B1, 0, 1); G8_BAR; G8_WAIT_L(0); G8_MMA(0, 1, At, B1); G8_BAR;
      G8_LDA(At, 0, 1); G8_WAIT_V(4); G8_BAR; G8_WAIT_L(0); G8_MMA(1, 0, At, B0); G8_MMA(1, 1, At, B1); G8_BAR; }
    { G8_LDB(B0, 1, 0); G8_LDA(At, 1, 0); G8_WAIT_V(2); G8_BAR; G8_WAIT_L(0); G8_MMA(0, 0, At, B0); G8_BAR;
      G8_LDB(B1, 1, 1); G8_WAIT_V(0); G8_BAR; G8_WAIT_L(0); G8_MMA(0, 1, At, B1); G8_BAR;
      G8_LDA(At, 1, 1); G8_BAR; G8_WAIT_L(0); G8_MMA(1, 0, At, B0); G8_MMA(1, 1, At, B1); G8_BAR; }
    if (wr == 0) G8_BAR;
#undef G8_SA
#undef G8_SB
#undef G8_STAGE
#undef G8_LDA
#undef G8_LDB
#undef G8_MMA
#undef G8_WAIT_V
#undef G8_WAIT_L
#undef G8_BAR
#undef G8_SCHED
}
}

__device__ void phase_inproj(const Args& a, char* lds, int vb, int nb) {
    const int tid = threadIdx.x, lane = tid & 63, wid = tid >> 6, wr = wid >> 2, wc = wid & 3, fr = lane & 15, fq = lane >> 4;
    unsigned char* ws = a.ws;
    const bf16_t* XN = (const bf16_t*)(ws + WS_XN);
    const bf16_t* WIN = (const bf16_t*)(ws + WS_WIN);
    const float* rope = (const float*)(ws + WS_ROPE);
    bf16_t* Qo = (bf16_t*)(ws + WS_Q); bf16_t* Ko = (bf16_t*)(ws + WS_K); bf16_t* Vo = (bf16_t*)(ws + WS_VV); bf16_t* Lo = (bf16_t*)(ws + WS_L); bf16_t* Zo = (bf16_t*)(ws + WS_ZG);
    constexpr int N_LAT = 128 * 7, N_ALL = N_LAT + 16 * 3;
#pragma unroll 1
    for (int it = vb; it < N_ALL; it += nb) {
        int tt, ft;
        if (it < N_LAT) { tt = it / 7; ft = it % 7; } else { const int j = it - N_LAT; tt = 128 + j / 3; ft = 2 + j % 3; }
        f32x4 acc[2][2][4][2];
        g8::core(acc, WIN, XN, ft * 256, tt * 256, DM, lds);
        const bool lat = tt < 128;
#pragma unroll
        for (int ai = 0; ai < 2; ++ai) {
            const int g64 = ft * 4 + ai * 2 + wr;
            if (g64 < 10) {
                const bool isq = g64 < 8;
                const float* gn = isq ? a.in[I_QNG] : a.in[I_KNG];
                const float osc = isq ? 0.125f * 1.4426950408889634f : 1.f;
                float gnv[4][4];
#pragma unroll
                for (int m = 0; m < 4; ++m) { const f32x4 gv = *(const f32x4*)(gn + m * 16 + fq * 4); gnv[m][0] = gv[0]; gnv[m][1] = gv[1]; gnv[m][2] = gv[2]; gnv[m][3] = gv[3]; }
#pragma unroll
                for (int bj = 0; bj < 2; ++bj)
#pragma unroll
                    for (int n = 0; n < 2; ++n) {
                        float ss = 0.f;
#pragma unroll
                        for (int m = 0; m < 4; ++m)
#pragma unroll
                            for (int j = 0; j < 4; ++j) ss += acc[ai][bj][m][n][j] * acc[ai][bj][m][n][j];
                        ss += __shfl_xor(ss, 16); ss += __shfl_xor(ss, 32);
                        const float rinv = rsqrtf(ss * (1.f / 64.f) + EPS);
                        const int row = tt * 256 + bj * 128 + wc * 32 + n * 16 + fr;
                        int b, t, s_; if (lat) { b = row >> 11; t = row & 2047; s_ = CTX + t; } else { const int rc = row - NTOK; b = rc >> 8; t = 0; s_ = rc & 255; }
                        bf16_t* dst = isq ? Qo + ((size_t)(b * 8 + g64) * SEQ + t) * 64 : Ko + ((size_t)(b * 2 + (g64 - 8)) * STOT + s_) * 64;
#pragma unroll
                        for (int ax = 0; ax < 2; ++ax) {
                            const int pos = ax == 0 ? (t >> 6) : (t & 63);
                            float o1[4], o2[4];
#pragma unroll
                            for (int j = 0; j < 4; ++j) {
                                const float x1 = acc[ai][bj][2 * ax][n][j] * rinv * gnv[2 * ax][j], x2 = acc[ai][bj][2 * ax + 1][n][j] * rinv * gnv[2 * ax + 1][j];
                                float c1 = x1, c2 = x2;
                                if (lat) { const f32x2 cs = *(const f32x2*)(rope + (pos * 16 + fq * 4 + j) * 2); c1 = x1 * cs[0] - x2 * cs[1]; c2 = x1 * cs[1] + x2 * cs[0]; }
                                o1[j] = c1 * osc; o2[j] = c2 * osc; }
                            *(u32x2*)(dst + ax * 32 + fq * 4) = (u32x2){pk2(o1[0], o1[1]), pk2(o1[2], o1[3])};
                            *(u32x2*)(dst + ax * 32 + 16 + fq * 4) = (u32x2){pk2(o2[0], o2[1]), pk2(o2[2], o2[3])};
                        }
                    }
            } else if (g64 < 12) {
#pragma unroll
                for (int bj = 0; bj < 2; ++bj)
#pragma unroll
                    for (int n = 0; n < 2; ++n) {
                        const int row = tt * 256 + bj * 128 + wc * 32 + n * 16 + fr;
                        int b, s_; if (lat) { b = row >> 11; s_ = CTX + (row & 2047); } else { const int rc = row - NTOK; b = rc >> 8; s_ = rc & 255; }
                        bf16_t* vp = Vo + ((size_t)(b * 2 + (g64 - 10)) * 64) * STOT + s_;
#pragma unroll
                        for (int m = 0; m < 4; ++m)
#pragma unroll
                            for (int j = 0; j < 4; ++j) vp[(size_t)(m * 16 + fq * 4 + j) * STOT] = f2bf(acc[ai][bj][m][n][j]);
                    }
            } else {
                const bool isz = g64 >= 20;
#pragma unroll
                for (int bj = 0; bj < 2; ++bj)
#pragma unroll
                    for (int n = 0; n < 2; ++n) {
                        const int row = tt * 256 + bj * 128 + wc * 32 + n * 16 + fr;
                        bf16_t* dst;
                        if (isz) dst = Zo + (size_t)row * DLRU + (g64 - 20) * 64;
                        else { int b, s_; if (lat) { b = row >> 11; s_ = CTX + (row & 2047); } else { const int rc = row - NTOK; b = rc >> 8; s_ = rc & 255; }
                            dst = Lo + ((size_t)b * STOT + s_) * DLRU + (g64 - 12) * 64; }
#pragma unroll
                        for (int m = 0; m < 4; ++m) { f32x4 v = acc[ai][bj][m][n];
                            if (isz) { v[0] = gelu_tanh(v[0]); v[1] = gelu_tanh(v[1]); v[2] = gelu_tanh(v[2]); v[3] = gelu_tanh(v[3]); }
                            *(u32x2*)(dst + m * 16 + fq * 4) = (u32x2){pk2(v[0], v[1]), pk2(v[2], v[3])}; }
                    }
            }
        }
        __syncthreads();
    }
    {
        unsigned* ctr = (unsigned*)(ws + WS_CTL) + CTL_UVCTR;
        volatile int* slot = (volatile int*)lds;
        for (;;) {
            if (tid == 0) *slot = (int)__hip_atomic_fetch_add(ctr, 1u, __ATOMIC_RELAXED, __HIP_MEMORY_SCOPE_AGENT);
            __syncthreads();
            const int t = *slot;
            __syncthreads();
            if (t >= UV_ITEMS) break;
            conv_uv_item(a, t);
        }
    }
}

constexpr int AT_KP = 144, AT_VP = 136, AT_STAGE = 64 * AT_KP + 64 * AT_VP;
__device__ void attn_item(const Args& a, char* lds, int b, int head, int qblk) {
    const int tid = threadIdx.x, lane = tid & 63, wid = tid >> 6, r32 = lane & 31, hi = lane >> 5;
    unsigned char* ws = a.ws;
    const int kvh = head >> 2;
    const bf16_t* Qp = (const bf16_t*)(ws + WS_Q) + ((size_t)(b * 8 + head) * SEQ + qblk * 256 + wid * 32 + r32) * 64 + hi * 8;
    const bf16_t* Kp = (const bf16_t*)(ws + WS_K) + (size_t)(b * 2 + kvh) * STOT * 64;
    const bf16_t* Vp = (const bf16_t*)(ws + WS_VV) + (size_t)(b * 2 + kvh) * 64 * STOT;
    bf16x8 qf[4];
#pragma unroll
    for (int ds = 0; ds < 4; ++ds) qf[ds] = *(const bf16x8*)(Qp + ds * 16);
    const int srow = tid >> 3, sch = tid & 7;
    const bf16_t* kg = Kp + (size_t)srow * 64 + sch * 8;
    const bf16_t* vg = Vp + (size_t)srow * STOT + sch * 8;
    u32x4 krA, vrA, krB, vrB;
    f32x16 o[2]; float lsum = 0.f;
    float negM;
    { float gq = fabsf(a.in[I_QNG][lane]), gk = fabsf(a.in[I_KNG][lane]);
#pragma unroll
      for (int o_ = 32; o_ > 0; o_ >>= 1) { gq = fmaxf(gq, __shfl_xor(gq, o_)); gk = fmaxf(gk, __shfl_xor(gk, o_)); }
      negM = -(64.f * 0.125f * 1.4426950408889634f * 1.01f) * gq * gk; }
#pragma unroll
    for (int dt = 0; dt < 2; ++dt)
#pragma unroll
        for (int r = 0; r < 16; ++r) o[dt][r] = 0.f;
    char* KS = lds; char* VS = lds + 2 * 64 * AT_KP;
#define A_LOADK(X, s0) do { kr##X = *(const u32x4*)(kg + (size_t)(s0) * 64); } while (0)
#define A_LOADV(X, s0) do { vr##X = *(const u32x4*)(vg + (s0)); } while (0)
#define A_WRITEK(X, st) do { *(u32x4*)(KS + (st) * 64 * AT_KP + srow * AT_KP + sch * 16) = kr##X; } while (0)
#define A_WRITEV(X, st) do { char* vb_ = VS + (st) * 64 * AT_VP + srow * AT_VP + sch * 16; *(u32x2*)vb_ = (u32x2){vr##X[0], vr##X[1]}; *(u32x2*)(vb_ + 8) = (u32x2){vr##X[2], vr##X[3]}; } while (0)
    constexpr int NT = STOT / 64;
    f32x16 sc[2], sn[2];
    A_LOADK(A, 0); A_LOADV(A, 0); A_WRITEK(A, 0); A_WRITEV(A, 0); A_LOADK(A, 64); A_WRITEK(A, 1); A_LOADK(B, 128); A_LOADV(B, 64); __syncthreads();
#pragma unroll
    for (int kt = 0; kt < 2; ++kt) {
#pragma unroll
        for (int r = 0; r < 16; ++r) sc[kt][r] = negM;
#pragma unroll
        for (int ds = 0; ds < 4; ++ds) { const bf16x8 ka = *(const bf16x8*)(KS + (kt * 32 + r32) * AT_KP + (ds * 16 + hi * 8) * 2); sc[kt] = MFMA(ka, qf[ds], sc[kt]); }
    }
    __syncthreads();
    f32x16 ol;
#pragma unroll
    for (int r = 0; r < 16; ++r) ol[r] = 0.f;
    const u32x4 ones_w = {0x3F803F80u, 0x3F803F80u, 0x3F803F80u, 0x3F803F80u};
    const bf16x8 ones = *(const bf16x8*)&ones_w;
#define A_STEP(J, SC, SN, XW, XL) do { const int j_ = (J); \
        const int jk = (j_ + 3 < NT) ? j_ + 3 : NT - 1, jv = (j_ + 2 < NT) ? j_ + 2 : NT - 1; \
        A_LOADK(XL, jk * 64); A_LOADV(XL, jv * 64); \
        const char* ksn = KS + ((j_ + 1) & 1) * 64 * AT_KP; const char* vs = VS + (j_ & 1) * 64 * AT_VP; \
        _Pragma("unroll") for (int kt = 0; kt < 2; ++kt) { \
            _Pragma("unroll") for (int r = 0; r < 16; ++r) SN[kt][r] = negM; \
            _Pragma("unroll") for (int ds = 0; ds < 4; ++ds) { \
                const bf16x8 ka = *(const bf16x8*)(ksn + (kt * 32 + r32) * AT_KP + (ds * 16 + hi * 8) * 2); \
                SN[kt] = MFMA(ka, qf[ds], SN[kt]); \
                _Pragma("unroll") for (int e = 0; e < 4; ++e) { const int f = (kt * 4 + ds) * 4 + e; SC[f >> 4][f & 15] = __builtin_amdgcn_exp2f(SC[f >> 4][f & 15]); } \
                __builtin_amdgcn_sched_barrier(0); } } \
        _Pragma("unroll") for (int kt = 0; kt < 2; ++kt) \
            _Pragma("unroll") for (int s = 0; s < 2; ++s) { \
                u32x4 pw = {pk2(SC[kt][8 * s], SC[kt][8 * s + 1]), pk2(SC[kt][8 * s + 2], SC[kt][8 * s + 3]), pk2(SC[kt][8 * s + 4], SC[kt][8 * s + 5]), pk2(SC[kt][8 * s + 6], SC[kt][8 * s + 7])}; \
                const bf16x8 pb = *(bf16x8*)&pw; \
                _Pragma("unroll") for (int dt = 0; dt < 2; ++dt) { \
                    const char* vp = vs + (dt * 32 + r32) * AT_VP + (kt * 32 + s * 16 + hi * 4) * 2; \
                    const u32x2 lo = *(const u32x2*)vp, hh = *(const u32x2*)(vp + 16); \
                    u32x4 aw = {lo[0], lo[1], hh[0], hh[1]}; \
                    o[dt] = MFMA(*(bf16x8*)&aw, pb, o[dt]); } \
                ol = MFMA(ones, pb, ol); } \
        A_WRITEK(XW, j_ & 1); A_WRITEV(XW, (j_ + 1) & 1); \
        __syncthreads(); } while (0)
#pragma unroll 1
    for (int j = 0; j < NT; j += 2) { A_STEP(j, sc, sn, B, A); A_STEP(j + 1, sn, sc, A, B); }
#undef A_STEP
    lsum = ol[0];
#undef A_LOADK
#undef A_LOADV
#undef A_WRITEK
#undef A_WRITEV
    const float inv = fast_rcp(lsum);
    bf16_t* outp = (bf16_t*)(ws + WS_A2) + ((size_t)b * SEQ + qblk * 256 + wid * 32 + r32) * KOUT + head * 64;
#pragma unroll
    for (int dt = 0; dt < 2; ++dt)
#pragma unroll
        for (int g = 0; g < 4; ++g) {
            u32x2 v = {pk2(o[dt][4 * g] * inv, o[dt][4 * g + 1] * inv), pk2(o[dt][4 * g + 2] * inv, o[dt][4 * g + 3] * inv)};
            *(u32x2*)(outp + dt * 32 + g * 8 + hi * 4) = v;
        }
}

constexpr int LR_RAW = 0;
constexpr int LR_U   = 33792;
constexpr int LR_BB  = LR_U + 33280;
constexpr int LR_UB  = LR_BB + 33280;
constexpr int LR_WG  = LR_UB + 18432;
constexpr int LR_SEG = LR_WG + 18432;
constexpr int LR_HC  = LR_SEG + 4096;
constexpr int LR_CST = LR_HC + 512;
constexpr int LR_END = LR_CST + 768;
__device__ void lru_item(const Args& a, char* lds, int b, int n, int d) {
    const int tid = threadIdx.x, lane = tid & 63, wid = tid >> 6, r32 = lane & 31, hi = lane >> 5;
    unsigned char* ws = a.ws;
    float* RAW = (float*)(lds + LR_RAW); float* AA = (float*)(lds + LR_RAW); float* U = (float*)(lds + LR_U); float* BB = (float*)(lds + LR_BB);
    char* UB = lds + LR_UB; char* WG = lds + LR_WG; float* SEG = (float*)(lds + LR_SEG); float* HC = (float*)(lds + LR_HC);
    const bf16_t* Lg = (const bf16_t*)(ws + WS_L) + (size_t)b * STOT * DLRU + n * 64;
    const bf16_t* Zg = (const bf16_t*)(ws + WS_ZG) + (size_t)b * SEQ * DLRU + n * 64;
    bf16_t* Og = (bf16_t*)(ws + WS_A2) + (size_t)b * SEQ * KOUT + 512 + d * 512 + n * 64;
    {
        const bf16_t* wsrc = (const bf16_t*)(ws + WS_RGW) + (size_t)(d * 8 + n) * 128 * 64;
#pragma unroll
        for (int i = 0; i < 2; ++i) { const int c = tid + NTHR * i, r = c >> 3, ch = c & 7; *(u32x4*)(WG + r * 144 + ch * 16) = *(const u32x4*)(wsrc + r * 64 + ch * 8); }
        if (tid < 128) HC[tid] = 0.f;
    }
    const int ct = wid & 1, tt = wid >> 1;
    float* CST = (float*)(lds + LR_CST);
    if (tid < 64) { const int c = n * 64 + tid; CST[tid] = a.in[I_RGBA][d * 512 + c]; CST[64 + tid] = a.in[I_RGBI][d * 512 + c];
        const float x = -a.in[I_RGLAM][d * 512 + c]; CST[128 + tid] = -8.f * (fmaxf(x, 0.f) + log1pf(__expf(-fabsf(x)))); }
    const int sc = tid & 63, sg = tid >> 6;
    const float cw0 = a.in[I_CONVW][0 * 512 + n * 64 + sc], cw1 = a.in[I_CONVW][1 * 512 + n * 64 + sc], cw2 = a.in[I_CONVW][2 * 512 + n * 64 + sc], cw3 = a.in[I_CONVW][3 * 512 + n * 64 + sc];
    const float cbias = a.in[I_CONVB][n * 64 + sc];
#define LRU_TILE(step_, isctx_, sb_, sl_, t0_) const bool isctx_ = (step_) < 2; const int sb_ = isctx_ ? 0 : CTX, sl_ = isctx_ ? CTX : SEQ, \
        t0_ = (isctx_ ? (d == 0 ? (step_) : 1 - (step_)) : (d == 0 ? (step_) - 2 : 17 - (step_))) * 128
#define LRU_FETCH(pre_, sb_, sl_, t0_) do { _Pragma("unroll") for (int i_ = 0; i_ < 3; ++i_) { const int e_ = min(tid + NTHR * i_, 131 * 8 - 1), t_ = min(max((t0_) - 2 + (e_ >> 3), 0), (sl_) - 1); \
        pre_[i_] = *(const u32x4*)(Lg + (size_t)((sb_) + t_) * DLRU + (e_ & 7) * 8); } } while (0)
#define LRU_SPREAD(pre_, sl_, t0_) do { _Pragma("unroll") for (int i_ = 0; i_ < 3; ++i_) { const int e_ = tid + NTHR * i_, t_ = (t0_) - 2 + (e_ >> 3); if (e_ < 131 * 8) { float* dst = RAW + (e_ >> 3) * 64 + (e_ & 7) * 8; \
        const bool in_ = t_ >= 0 && t_ < (sl_); const u32x4 v = pre_[i_]; f32x4 lo_ = {bflo(v[0]), bfhi(v[0]), bflo(v[1]), bfhi(v[1])}, hi_ = {bflo(v[2]), bfhi(v[2]), bflo(v[3]), bfhi(v[3])}; \
        if (!in_) { lo_ = (f32x4){0.f, 0.f, 0.f, 0.f}; hi_ = lo_; } *(f32x4*)dst = lo_; *(f32x4*)(dst + 4) = hi_; } } } while (0)
    u32x4 pre[3];
    { LRU_TILE(0, c0_, sb0_, sl0_, t00_); LRU_FETCH(pre, sb0_, sl0_, t00_); LRU_SPREAD(pre, sl0_, t00_); }
    __syncthreads();
    int par = 0;
    for (int step = 0; step < 18; ++step) {
        LRU_TILE(step, isctx, sb, sl, t0);
        LRU_TILE(step < 17 ? step + 1 : 17, c1_, sb1_, sl1_, t01_);
        LRU_FETCH(pre, sb1_, sl1_, t01_);
        unsigned short zv[16];
        {
            const int tfirst = d == 0 ? sg * 16 : 127 - sg * 16;
            const bf16_t* zp = Zg + (size_t)(t0 + tfirst) * DLRU + sc; const int zstep = d == 0 ? DLRU : -DLRU;
#pragma unroll
            for (int k = 0; k < 16; ++k) zv[k] = *(const unsigned short*)(zp + k * zstep);
        }
        {
            const float* rp = RAW + (sg * 16) * 64 + sc;
            float x0 = rp[0], x1 = rp[64], x2 = rp[128];
            float* up = U + (sg * 16) * 65 + sc; char* ubp = UB + (sg * 16) * 144 + sc * 2;
#pragma unroll
            for (int i = 0; i < 16; ++i) { const float x3 = rp[(i + 3) * 64];
                const float u = cbias + cw0 * x0 + cw1 * x1 + cw2 * x2 + cw3 * x3;
                up[i * 65] = u; *(bf16_t*)(ubp + i * 144) = f2bf(u); x0 = x1; x1 = x2; x2 = x3; }
        }
        __syncthreads();
        {
            f32x16 ga, gi;
#pragma unroll
            for (int r = 0; r < 16; ++r) { ga[r] = 0.f; gi[r] = 0.f; }
#pragma unroll
            for (int ks = 0; ks < 4; ++ks) {
                const bf16x8 wa = *(const bf16x8*)(WG + (ct * 32 + r32) * 144 + (ks * 16 + hi * 8) * 2);
                const bf16x8 wi = *(const bf16x8*)(WG + (64 + ct * 32 + r32) * 144 + (ks * 16 + hi * 8) * 2);
                const bf16x8 ub = *(const bf16x8*)(UB + (tt * 32 + r32) * 144 + (ks * 16 + hi * 8) * 2);
                ga = MFMA(wa, ub, ga); gi = MFMA(wi, ub, gi);
            }
            const int t = tt * 32 + r32;
#pragma unroll
            for (int r = 0; r < 16; ++r) { const int c = ct * 32 + 8 * (r >> 2) + 4 * hi + (r & 3);
                const float rr = sigmoidf_(ga[r] + CST[c]), ii = sigmoidf_(gi[r] + CST[64 + c]);
                const float la = CST[128 + c] * rr, av = __expf(la), mult = __builtin_amdgcn_sqrtf(fmaxf(1.f - av * av, 0.f));
                const float u = U[t * 65 + c];
                AA[t * 65 + c] = av; BB[t * 65 + c] = mult * ii * u; }
        }
        __syncthreads();
        float av[16], bv[16]; float Ap = 1.f, Bp = 0.f;
#pragma unroll
        for (int k = 0; k < 16; ++k) { const int p = sg * 16 + k, t = d == 0 ? p : 127 - p; av[k] = AA[t * 65 + sc]; bv[k] = BB[t * 65 + sc]; Bp = av[k] * Bp + bv[k]; Ap = av[k] * Ap; }
        SEG[sg * 64 + sc] = Ap; SEG[512 + sg * 64 + sc] = Bp;
        __syncthreads();
        float h = HC[par * 64 + sc];
        for (int s2 = 0; s2 < sg; ++s2) h = SEG[s2 * 64 + sc] * h + SEG[512 + s2 * 64 + sc];
        {
            const int tfirst = d == 0 ? sg * 16 : 127 - sg * 16;
            bf16_t* op = Og + (size_t)(t0 + tfirst) * KOUT + sc;
            const int ostep = d == 0 ? KOUT : -KOUT;
#pragma unroll
            for (int k = 0; k < 16; ++k) { h = av[k] * h + bv[k];
                if (!isctx) { const float gz = __uint_as_float((unsigned)zv[k] << 16); *op = f2bf(h * gz); op += ostep; } }
        }
        LRU_SPREAD(pre, sl1_, t01_);
        if (sg == 7) HC[(par ^ 1) * 64 + sc] = h;
        par ^= 1;
        __syncthreads();
    }
}

#ifndef LRU_REPS
#define LRU_REPS 1
#endif
__device__ void phase_mixer(const Args& a, char* lds, int vb, int nb) {
#pragma unroll 1
    for (int it = vb; it < 256; it += nb) { for (int rep_ = 0; rep_ < LRU_REPS; ++rep_) { lru_item(a, lds, it >> 4, (it >> 1) & 7, it & 1); __syncthreads(); } }
#pragma unroll 1
    for (int at = vb; at < 1024; at += nb) { const int bk = at >> 5, w = at & 31; attn_item(a, lds, bk >> 1, (bk & 1) * 4 + (w >> 3), w & 7); __syncthreads(); }
}

__device__ void phase_outproj(const Args& a, char* lds, int vb, int nb) {
    const int tid = threadIdx.x, lane = tid & 63, wid = tid >> 6, wr = wid >> 2, wc = wid & 3, fr = lane & 15, fq = lane >> 4;
    const bf16_t* A2 = (const bf16_t*)(a.ws + WS_A2); const bf16_t* WO = (const bf16_t*)(a.ws + WS_WOUT);
    bf16_t* MIX = (bf16_t*)(a.ws + WS_MIX);
#pragma unroll 1
    for (int it = vb; it < 128 * 4; it += nb) {
        const int tt = it >> 2, ft = it & 3;
        f32x4 acc[2][2][4][2];
        g8::core(acc, WO, A2, ft * 256, tt * 256, KOUT, lds);
#pragma unroll
        for (int bj = 0; bj < 2; ++bj)
#pragma unroll
            for (int n = 0; n < 2; ++n) {
                bf16_t* rp = MIX + (size_t)(tt * 256 + bj * 128 + wc * 32 + n * 16 + fr) * DM + ft * 256 + wr * 64 + fq * 4;
#pragma unroll
                for (int ai = 0; ai < 2; ++ai)
#pragma unroll
                    for (int m = 0; m < 4; ++m) { const f32x4 v = acc[ai][bj][m][n]; *(u32x2*)(rp + ai * 128 + m * 16) = (u32x2){pk2(v[0], v[1]), pk2(v[2], v[3])}; }
            }
        __syncthreads();
    }
}

__device__ void phase_rowpass(const Args& a, int vb, int nb) {
    const int tid = threadIdx.x, lane = tid & 63, wid = tid >> 6;
    const float* mod = (const float*)(a.ws + WS_MOD);
    const bf16_t* MIX = (const bf16_t*)(a.ws + WS_MIX);
    bf16_t* HX = (bf16_t*)(a.ws + WS_HX2); bf16_t* XM = (bf16_t*)(a.ws + WS_XM);
    const int chunk = (NTOK + nb - 1) / nb, rend = min(NTOK, (vb + 1) * chunk);
    f32x4 G1[4], A2[4], B2[4]; int cur = -1;
    u32x2 mwn[4]; f32x4 xvn[4];
    {
        const int r0 = min(vb * chunk + wid, NTOK - 1);
#pragma unroll
        for (int i = 0; i < 4; ++i) { mwn[i] = *(const u32x2*)(MIX + (size_t)r0 * DM + i * 256 + lane * 4); xvn[i] = *(const f32x4*)(a.in[I_X] + (size_t)r0 * DM + i * 256 + lane * 4); }
    }
    for (int row = vb * chunk + wid; row < rend; row += 8) {
        const int b = row >> 11;
        f32x4 mv[4], xv[4]; float ss = 0.f;
#pragma unroll
        for (int i = 0; i < 4; ++i) { const u32x2 mw = mwn[i]; mv[i] = (f32x4){bflo(mw[0]), bfhi(mw[0]), bflo(mw[1]), bfhi(mw[1])}; xv[i] = xvn[i]; }
        {
            const int rn = min(row + 8, NTOK - 1);
#pragma unroll
            for (int i = 0; i < 4; ++i) { mwn[i] = *(const u32x2*)(MIX + (size_t)rn * DM + i * 256 + lane * 4); xvn[i] = *(const f32x4*)(a.in[I_X] + (size_t)rn * DM + i * 256 + lane * 4); }
        }
        if (b != cur) { cur = b; const float* mrow = mod + (size_t)b * 6144;
#pragma unroll
            for (int i = 0; i < 4; ++i) { const int c = i * 256 + lane * 4;
                const f32x4 gp = *(const f32x4*)(a.in[I_GPOSTMIX] + c), g1 = *(const f32x4*)(mrow + 2048 + c), gf = *(const f32x4*)(a.in[I_GPREFFN] + c), sc = *(const f32x4*)(mrow + 4096 + c);
                B2[i] = *(const f32x4*)(mrow + 3072 + c);
#pragma unroll
                for (int j = 0; j < 4; ++j) { G1[i][j] = g1[j] * gp[j]; A2[i][j] = gf[j] * (1.f + sc[j]); } } }
#pragma unroll
        for (int i = 0; i < 4; ++i) ss += mv[i][0] * mv[i][0] + mv[i][1] * mv[i][1] + mv[i][2] * mv[i][2] + mv[i][3] * mv[i][3];
        ss = wave_sum(ss);
        const float rinv = rsqrtf(ss * (1.f / DM) + EPS);
        float s2 = 0.f;
#pragma unroll
        for (int i = 0; i < 4; ++i) { const int c = i * 256 + lane * 4;
#pragma unroll
            for (int j = 0; j < 4; ++j) { const float xm = xv[i][j] + G1[i][j] * (mv[i][j] * rinv); xv[i][j] = xm; s2 += xm * xm; }
            const u32x2 xw = {pk2(xv[i][0], xv[i][1]), pk2(xv[i][2], xv[i][3])}; *(u32x2*)(XM + (size_t)row * DM + c) = xw; }
        s2 = wave_sum(s2);
        const float rinv2 = rsqrtf(s2 * (1.f / DM) + EPS);
#pragma unroll
        for (int i = 0; i < 4; ++i) { const int c = i * 256 + lane * 4;
            float o[4];
#pragma unroll
            for (int j = 0; j < 4; ++j) o[j] = xv[i][j] * rinv2 * A2[i][j] + B2[i][j];
            u32x2 w = {pk2(o[0], o[1]), pk2(o[2], o[3])}; *(u32x2*)(HX + (size_t)row * DM + c) = w; }
    }
}

__device__ __forceinline__ int fkey(float f) { const int b = __float_as_int(f); return b ^ ((b >> 31) & 0x7fffffff); }
__device__ __forceinline__ float fval(int k) { return __int_as_float(k ^ ((k >> 31) & 0x7fffffff)); }
#define CE_DESC(x, y) do { const int hi_ = max((x), (y)), lo_ = min((x), (y)); (x) = hi_; (y) = lo_; } while (0)
__device__ __forceinline__ void sort16_desc(int (&v)[16]) {
#pragma unroll
    for (int k = 2; k <= 16; k <<= 1)
#pragma unroll
        for (int j = k >> 1; j > 0; j >>= 1)
#pragma unroll
            for (int i = 0; i < 16; ++i) { const int l = i ^ j; if (l > i) { if ((i & k) == 0) { CE_DESC(v[i], v[l]); } else { CE_DESC(v[l], v[i]); } } }
}
__device__ __forceinline__ void merge16_desc(int (&v)[16]) {
#pragma unroll
    for (int j = 8; j > 0; j >>= 1)
#pragma unroll
        for (int i = 0; i < 16; ++i) { const int l = i ^ j; if (l > i) CE_DESC(v[i], v[l]); }
}
__device__ __forceinline__ void top16_merge(int (&A)[16], const int (&B)[16]) {
#pragma unroll
    for (int i = 0; i < 16; ++i) A[i] = max(A[i], B[15 - i]);
    merge16_desc(A);
}
constexpr int PK_QS = 0;
constexpr int PK_SK = 256 * E_PITCH;
constexpr int PK_ML = PK_SK + 128 * E_PITCH;
constexpr int PK_X  = PK_ML + 32768;
constexpr int PK_END = PK_X + 8192;
__device__ void phase_peer_topk(const Args& a, char* lds, int vb, int nb) {
    unsigned char* ws = a.ws;
    const bf16_t* HX = (const bf16_t*)(ws + WS_HX2); const bf16_t* WQ = (const bf16_t*)(ws + WS_WQ); const bf16_t* SUBK = (const bf16_t*)(ws + WS_SUBK);
    int* IDX = (int*)(ws + WS_IDX);
    int* ML = (int*)(lds + PK_ML); int* XB = (int*)(lds + PK_X);
    for (int it = vb; it < 128 * 8; it += nb) {
        const int rt = it >> 3, h = it & 7, row0 = rt * 256;
        bf16_t* park = (bf16_t*)(ws + WS_MIX) + (size_t)it * (256 * 128);
        int tid = threadIdx.x;
        {
            f32x4 acc8[2][2][4][2];
            g8::core(acc8, WQ, HX, h * 256, row0, DM, lds);
            __syncthreads();
            asm volatile("" : "+v"(tid));
            const int lane = tid & 63, wid = tid >> 6;
            const int w8r = wid >> 2, w8c = wid & 3, fr = lane & 15, fq = lane >> 4;
#pragma unroll
            for (int bj = 0; bj < 2; ++bj)
#pragma unroll
                for (int m = 0; m < 4; ++m)
#pragma unroll
                    for (int n = 0; n < 2; ++n) { const int tok = bj * 128 + w8c * 32 + n * 16 + fr, d = w8r * 64 + m * 16 + fq * 4;
                        const f32x4 v0 = acc8[0][bj][m][n], v1 = acc8[1][bj][m][n];
                        *(u32x2*)(lds + PK_QS + tok * E_PITCH + d * 2) = (u32x2){pk2(v0[0], v0[1]), pk2(v0[2], v0[3])};
                        *(u32x2*)(park + tok * 128 + d) = (u32x2){pk2(v1[0], v1[1]), pk2(v1[2], v1[3])}; }
        }
        const int lane = tid & 63, wid = tid >> 6, wm = wid & 3, wn = wid >> 2, r32 = lane & 31, hi = lane >> 5;
#pragma unroll 1
        for (int p = 0; p < 2; ++p) {
            f32x16 acc[2][2];
            if (p == 1) {
#pragma unroll
                for (int i = 0; i < 8; ++i) { const int c = tid + NTHR * i, tok = c >> 4, ch = c & 15; *(u32x4*)(lds + PK_QS + tok * E_PITCH + ch * 16) = *(const u32x4*)(park + tok * 128 + ch * 8); }
            }
            {
                const bf16_t* sk = SUBK + (size_t)(h * 2 + p) * 128 * 128;
#pragma unroll
                for (int i = 0; i < 4; ++i) { const int c = tid + NTHR * i, r = c >> 4, ch = c & 15; *(u32x4*)(lds + PK_SK + r * E_PITCH + ch * 16) = *(const u32x4*)(sk + r * 128 + ch * 8); }
            }
            __syncthreads();
#pragma unroll
            for (int ft = 0; ft < 2; ++ft)
#pragma unroll
                for (int tt = 0; tt < 2; ++tt)
#pragma unroll
                    for (int r = 0; r < 16; ++r) acc[ft][tt][r] = 0.f;
#pragma unroll
            for (int ks = 0; ks < 8; ++ks) {
                const bf16x8 a0 = *(const bf16x8*)(lds + PK_SK + (wn * 64 + r32) * E_PITCH + (ks * 16 + hi * 8) * 2), a1 = *(const bf16x8*)(lds + PK_SK + (wn * 64 + 32 + r32) * E_PITCH + (ks * 16 + hi * 8) * 2);
                const bf16x8 b0 = *(const bf16x8*)(lds + PK_QS + (wm * 64 + r32) * E_PITCH + (ks * 16 + hi * 8) * 2), b1 = *(const bf16x8*)(lds + PK_QS + (wm * 64 + 32 + r32) * E_PITCH + (ks * 16 + hi * 8) * 2);
                acc[0][0] = MFMA(a0, b0, acc[0][0]); acc[0][1] = MFMA(a0, b1, acc[0][1]);
                acc[1][0] = MFMA(a1, b0, acc[1][0]); acc[1][1] = MFMA(a1, b1, acc[1][1]);
            }
#pragma unroll
            for (int tt = 0; tt < 2; ++tt) {
                int A[16], B[16];
#pragma unroll
                for (int r = 0; r < 16; ++r) { const int key = wn * 64 + 8 * (r >> 2) + 4 * hi + (r & 3);
                    A[r] = (fkey(acc[0][tt][r]) & ~127) | key; B[r] = (fkey(acc[1][tt][r]) & ~127) | (key + 32); }
                sort16_desc(A); sort16_desc(B); top16_merge(A, B);
#pragma unroll
                for (int r = 0; r < 16; ++r) { auto rr = __builtin_amdgcn_permlane32_swap((unsigned)A[r], (unsigned)A[r], false, false); B[r] = (int)(hi ? rr[0] : rr[1]); }
                top16_merge(A, B);
                const int tok = wm * 64 + tt * 32 + r32;
                if (wn == 1 && hi == 0) {
#pragma unroll
                    for (int r = 0; r < 16; ++r) XB[(wm * 32 + r32) * 16 + r] = A[r];
                }
                __syncthreads();
                if (wn == 0 && hi == 0) {
#pragma unroll
                    for (int r = 0; r < 16; ++r) B[r] = XB[(wm * 32 + r32) * 16 + r];
                    top16_merge(A, B);
#pragma unroll
                    for (int r = 0; r < 16; ++r) ML[(tok * 2 + p) * 16 + r] = A[r];
                }
                __syncthreads();
            }
        }
        if (tid < 256) {
            const int tok = tid;
            int s1[16], s2[16];
#pragma unroll
            for (int r = 0; r < 16; ++r) { s1[r] = ML[(tok * 2 + 0) * 16 + r]; s2[r] = ML[(tok * 2 + 1) * 16 + r]; }
            float f1[16], f2[16];
#pragma unroll
            for (int r = 0; r < 16; ++r) { f1[r] = fval(s1[r] & ~127); f2[r] = fval(s2[r] & ~127); }
            int G0[16], G1[16], G2[16], G3[16];
#pragma unroll
            for (int bb = 0; bb < 16; ++bb) G0[bb] = (fkey(f1[0] + f2[bb]) & ~255) | (0 * 16 + bb);
#pragma unroll
            for (int bb = 0; bb < 8; ++bb) G1[bb] = (fkey(f1[1] + f2[bb]) & ~255) | (1 * 16 + bb);
#pragma unroll
            for (int bb = 0; bb < 5; ++bb) G1[8 + bb] = (fkey(f1[2] + f2[bb]) & ~255) | (2 * 16 + bb);
#pragma unroll
            for (int bb = 0; bb < 3; ++bb) G1[13 + bb] = (fkey(f1[3] + f2[bb]) & ~255) | (3 * 16 + bb);
            G2[0] = (fkey(f1[3] + f2[3]) & ~255) | (3 * 16 + 3);
#pragma unroll
            for (int bb = 0; bb < 3; ++bb) G2[1 + bb] = (fkey(f1[4] + f2[bb]) & ~255) | (4 * 16 + bb);
#pragma unroll
            for (int aa = 5; aa < 8; ++aa)
#pragma unroll
                for (int bb = 0; bb < 2; ++bb) G2[4 + (aa - 5) * 2 + bb] = (fkey(f1[aa] + f2[bb]) & ~255) | (aa * 16 + bb);
#pragma unroll
            for (int aa = 8; aa < 14; ++aa) G2[10 + (aa - 8)] = (fkey(f1[aa] + f2[0]) & ~255) | (aa * 16);
            G3[0] = (fkey(f1[14] + f2[0]) & ~255) | (14 * 16); G3[1] = (fkey(f1[15] + f2[0]) & ~255) | (15 * 16);
#pragma unroll
            for (int r = 2; r < 16; ++r) G3[r] = (int)0x80000000;
            sort16_desc(G0); sort16_desc(G1); sort16_desc(G2); sort16_desc(G3);
            top16_merge(G0, G1); top16_merge(G2, G3); top16_merge(G0, G2);
            float tv[16]; float mx = fval(G0[0] & ~255), sum = 0.f;
#pragma unroll
            for (int r = 0; r < 16; ++r) { tv[r] = __expf(fval(G0[r] & ~255) - mx); sum += tv[r]; }
            const float rs = 1.f / sum;
            const size_t ob = ((size_t)(row0 + tok) * 8 + h) * 16;
#pragma unroll
            for (int r = 0; r < 16; ++r) { const int code = G0[r] & 255, aa = code >> 4, bb = code & 15;
                const int i1 = ML[(tok * 2 + 0) * 16 + aa] & 127, i2 = ML[(tok * 2 + 1) * 16 + bb] & 127;
                IDX[ob + r] = (i1 * 128 + i2) | (int)((unsigned)f2bf(tv[r] * rs) << 16); }
        }
        __syncthreads();
    }
}

template <int CTRL> __device__ __forceinline__ float dpp_add(float v) { return v + __uint_as_float(__builtin_amdgcn_update_dpp(0u, __float_as_uint(v), CTRL, 0xf, 0xf, true)); }
__device__ __forceinline__ float wave_sum_bcast(float p) {
    p = dpp_add<0xB1>(p); p = dpp_add<0x4E>(p); p = dpp_add<0x141>(p); p = dpp_add<0x140>(p);
    const unsigned u = __float_as_uint(p);
    return (__uint_as_float(__builtin_amdgcn_readlane(u, 0)) + __uint_as_float(__builtin_amdgcn_readlane(u, 16))) + (__uint_as_float(__builtin_amdgcn_readlane(u, 32)) + __uint_as_float(__builtin_amdgcn_readlane(u, 48)));
}
typedef float f32x4v __attribute__((ext_vector_type(4)));
constexpr int P7_RS = 9;
constexpr int P7_NR = PEER_N >> P7_RS;
constexpr int P7_HTP = 1024 + 64;
constexpr float H_SCALE = 16.f;
constexpr int P7_ATP = 2048 + 16;
constexpr float W_SCALE = 16.f;
constexpr int P7_RING = 16384;
constexpr int P7_WLDS = P7_RING + 2048;
#ifndef P7_UREP
#define P7_UREP 1
#endif
#ifndef P7_UD
#define P7_UD 3
#endif
#ifndef P7_VMASK
#define P7_VMASK 16383u
#endif
#ifndef P7_VPROBE
#define P7_VPROBE 0
#endif
template <int MODE>
__device__ __forceinline__ void p7_vsweep(f32x16 (&acc)[8], const unsigned* LIST, const unsigned char* VT, int m32, int kh, unsigned psel, unsigned ntok) {
    constexpr unsigned EM = MODE == 1 ? P7_VMASK : 16383u;
    i32x8 abuf[8];
#pragma unroll
    for (int T = 0; T < 8; ++T)
#pragma unroll
        for (int i = 0; i < 16; ++i) acc[T][i] = 0.f;
    u32x4 c0 = *(const u32x4*)(LIST + kh * 8), c1 = *(const u32x4*)(LIST + kh * 8 + 4);
    {
        unsigned off[8];
#pragma unroll
        for (int j = 0; j < 8; ++j) off[j] = (((j < 4 ? c0[j & 3] : c1[j & 3]) & EM) << 10) + m32 * 4;
#pragma unroll
        for (int T = 0; T < 8; ++T) {
#pragma unroll
            for (int j = 0; j < 8; ++j) abuf[T][j] = *(const int*)(VT + off[j] + T * 128);
            __builtin_amdgcn_sched_barrier(0); }
    }
#pragma unroll 1
    for (int bi = 0; bi < 32; ++bi) {
        const int bn = (bi < 31 ? bi + 1 : 31);
        const u32x4 l0 = *(const u32x4*)(LIST + bn * 16 + kh * 8), l1 = *(const u32x4*)(LIST + bn * 16 + kh * 8 + 4);
        unsigned noff[8];
#pragma unroll
        for (int j = 0; j < 8; ++j) noff[j] = (((j < 4 ? l0[j & 3] : l1[j & 3]) & EM) << 10) + m32 * 4;
        i32x8 bop;
#pragma unroll
        for (int j = 0; j < 8; ++j) { const unsigned e = j < 4 ? c0[j & 3] : c1[j & 3];
            bop[j] = (((e >> 14) & 3u) == ntok) ? (int)__builtin_amdgcn_perm(0u, e, psel) : 0; }
        c0 = l0; c1 = l1;
#pragma unroll
        for (int T = 0; T < 8; ++T) {
            __builtin_amdgcn_sched_barrier(0);
            if (MODE != 2) asm volatile("s_waitcnt vmcnt(24)" ::: "memory");
            if (MODE == 1) { int t_ = abuf[T][0];
#pragma unroll
                for (int j = 1; j < 8; ++j) t_ |= abuf[T][j];
                acc[T][0] = __int_as_float(t_ | bop[0]); }
            else acc[T] = __builtin_amdgcn_mfma_scale_f32_32x32x64_f8f6f4(abuf[T], bop, acc[T], 0, 0, 0, 127, 0, 127);
            if (MODE != 2) {
#pragma unroll
                for (int j = 0; j < 8; ++j) abuf[T][j] = *(const int*)(VT + noff[j] + T * 128); }
        }
        __builtin_amdgcn_sched_barrier(0);
    }
    if (MODE != 0) {
#pragma unroll
        for (int T = 0; T < 8; ++T) asm volatile("" :: "v"(acc[T]));
    }
}
__device__ void phase_peer_gather(const Args& a, char* lds, int vb, int nb) {
    unsigned char* ws = a.ws;
    const bf16_t* HX = (const bf16_t*)(ws + WS_HX2);
    const int* IDX = (const int*)(ws + WS_IDX);
    const float* mod = (const float*)(ws + WS_MOD);
    const unsigned char* UT = ws + WS_UT; const unsigned char* VT = ws + WS_VT;
    const bf16_t* XM = (const bf16_t*)(ws + WS_XM);
#pragma unroll 1
    for (int tb = vb * 32; tb < NTOK; tb += nb * 32) {
        int tid = threadIdx.x; asm volatile("" : "+v"(tid));
        const int lane = tid & 63, wid = tid >> 6, r16 = lane & 15, kg = lane >> 4;
        char* HT = lds + wid * P7_WLDS; unsigned* LIST = (unsigned*)(HT + P7_RING); char* AT = HT;
        const int tok0 = tb + wid * 4;
        {
            int* HIST = (int*)HT; int* CUR = HIST + 128;
            int ee[8];
            const int* ip = IDX + (size_t)tok0 * 128 + lane;
#pragma unroll
            for (int k = 0; k < 4; ++k) { ee[2 * k] = ip[k * 128]; ee[2 * k + 1] = ip[k * 128 + 64]; }
            HIST[lane] = 0; HIST[64 + lane] = 0;
#pragma unroll
            for (int j = 0; j < 8; ++j) atomicAdd(&HIST[(((ee[j] >> P7_RS) & (P7_NR - 1)) << 2) | (j >> 1)], 1);
            const int c0 = HIST[2 * lane], c1 = HIST[2 * lane + 1];
            int inc = c0 + c1;
#pragma unroll
            for (int o = 1; o < 64; o <<= 1) { const int t = __shfl_up(inc, o); if (lane >= o) inc += t; }
            CUR[2 * lane] = inc - c0 - c1; CUR[2 * lane + 1] = inc - c1;
#pragma unroll
            for (int j = 0; j < 8; ++j) { const unsigned w = (unsigned)ee[j]; const int slot = atomicAdd(&CUR[(((w >> P7_RS) & (P7_NR - 1)) << 2) | (j >> 1)], 1);
                LIST[slot] = (w & 16383u) | ((unsigned)(j >> 1) << 14) | ((w >> 16) << 17); }
        }
#pragma unroll 1
        for (int urep = 0; urep < P7_UREP; ++urep) {
        if (urep) asm volatile("s_waitcnt vmcnt(0)" ::: "memory");
        {
            const bf16_t* hp = HX + (size_t)tok0 * DM + lane * 16;
#pragma unroll
            for (int k = 0; k < 4; ++k) { const u32x4 h0 = *(const u32x4*)(hp + k * DM), h1 = *(const u32x4*)(hp + k * DM + 8);
                u32x4 o, ol;
#pragma unroll
                for (int q = 0; q < 4; ++q) { const unsigned wa = q < 2 ? h0[2 * q] : h1[2 * q - 4], wb = q < 2 ? h0[2 * q + 1] : h1[2 * q - 3];
                    const float x0 = bflo(wa) * H_SCALE, x1 = bfhi(wa) * H_SCALE, x2 = bflo(wb) * H_SCALE, x3 = bfhi(wb) * H_SCALE;
                    int w = __builtin_amdgcn_cvt_pk_fp8_f32(sat8(x0), sat8(x1), 0, false); w = __builtin_amdgcn_cvt_pk_fp8_f32(sat8(x2), sat8(x3), w, true); o[q] = (unsigned)w;
                    const float r0 = (x0 - __builtin_amdgcn_cvt_f32_fp8(w, 0)) * 16.f, r1 = (x1 - __builtin_amdgcn_cvt_f32_fp8(w, 1)) * 16.f, r2 = (x2 - __builtin_amdgcn_cvt_f32_fp8(w, 2)) * 16.f, r3 = (x3 - __builtin_amdgcn_cvt_f32_fp8(w, 3)) * 16.f;
                    int wl = __builtin_amdgcn_cvt_pk_fp8_f32(sat8(r0), sat8(r1), 0, false); wl = __builtin_amdgcn_cvt_pk_fp8_f32(sat8(r2), sat8(r3), wl, true); ol[q] = (unsigned)wl; }
                *(u32x4*)(HT + (2 * k) * P7_HTP + lane * 16) = o; *(u32x4*)(HT + (2 * k + 1) * P7_HTP + lane * 16) = ol;
            }
        }
        {
            i32x8 hb[8];
            {
                const char* hp = HT + (2 * (lane & 3) + ((lane >> 2) & 1)) * P7_HTP + kg * 32;
#pragma unroll
                for (int kc = 0; kc < 8; ++kc) { const i32x4 x0 = *(const i32x4*)(hp + kc * 128), x1 = *(const i32x4*)(hp + kc * 128 + 16);
                    hb[kc] = __builtin_shufflevector(x0, x1, 0, 1, 2, 3, 4, 5, 6, 7); }
            }
            unsigned entv = LIST[r16];
            asm volatile("s_waitcnt lgkmcnt(0)" ::: "memory");
            LAS unsigned char* ring = (LAS unsigned char*)lds + __builtin_amdgcn_readfirstlane(wid) * P7_WLDS;
#define U_DMA(slot, gp) do { __builtin_amdgcn_global_load_lds((const unsigned*)(gp), (LAS unsigned*)(ring + (slot) * 2048), 16, 0, 0); } while (0)
            const int lrow = lane >> 3;
            const unsigned swz = (unsigned)(((lane & 7) ^ (((lrow >> 1) & 3) << 1)) << 4);
            unsigned olo = (((unsigned)__shfl((int)entv, lrow) & 16383u) << 10) + swz, ohi = (((unsigned)__shfl((int)entv, 8 + lrow) & 16383u) << 10) + swz;
#pragma unroll
            for (int st = 0; st < P7_UD; ++st) { U_DMA(st, UT + olo + st * 128); __builtin_amdgcn_global_load_lds((const unsigned*)(UT + ohi + st * 128), (LAS unsigned*)(ring + st * 2048 + 1024), 16, 0, 0); }
            const int ard = (r16 >> 3) * 1024 + (r16 & 7) * 128 + ((kg ^ ((r16 >> 1) & 3)) << 5);
            const float pscl = (lane & 8) ? 0.f : ((lane & 4) ? 1.f / 16.f : 1.f);
            asm volatile("s_waitcnt vmcnt(%0)" :: "n"(2 * P7_UD - 2) : "memory");
            i32x4 a0 = *(const LAS i32x4*)(ring + ard), a1 = *(const LAS i32x4*)(ring + ard + 16);
#pragma unroll 1
            for (int bi = 0; bi < 32; ++bi) {
                const unsigned entn = LIST[(bi < 31 ? bi + 1 : 31) * 16 + r16];
                const unsigned nlo = (((unsigned)__shfl((int)entn, lrow) & 16383u) << 10) + swz, nhi = (((unsigned)__shfl((int)entn, 8 + lrow) & 16383u) << 10) + swz;
                f32x4v D = {0.f, 0.f, 0.f, 0.f};
#pragma unroll
                for (int kc = 0; kc < 8; ++kc) {
                    asm volatile("" ::: "memory");
                    {
                        const unsigned glo = (kc + P7_UD < 8 ? olo : nlo) + ((kc + P7_UD) & 7) * 128, ghi = (kc + P7_UD < 8 ? ohi : nhi) + ((kc + P7_UD) & 7) * 128;
                        __builtin_amdgcn_global_load_lds((const unsigned*)(UT + glo), (LAS unsigned*)(ring + ((kc + P7_UD) & 7) * 2048), 16, 0, 0);
                        __builtin_amdgcn_global_load_lds((const unsigned*)(UT + ghi), (LAS unsigned*)(ring + ((kc + P7_UD) & 7) * 2048 + 1024), 16, 0, 0);
                    }
                    asm volatile("s_waitcnt vmcnt(%0)" :: "n"(2 * P7_UD - 2) : "memory");
                    const i32x4 n0 = *(const LAS i32x4*)(ring + ((kc + 1) & 7) * 2048 + ard), n1 = *(const LAS i32x4*)(ring + ((kc + 1) & 7) * 2048 + ard + 16);
                    D = __builtin_amdgcn_mfma_scale_f32_16x16x128_f8f6f4(__builtin_shufflevector(a0, a1, 0, 1, 2, 3, 4, 5, 6, 7), hb[kc], D, 0, 0, 0, 127, 0, 127);
                    a0 = n0; a1 = n1;
                }
                olo = nlo; ohi = nhi;
                float dsel = 0.f; unsigned esel = 0u;
#pragma unroll
                for (int i = 0; i < 4; ++i) {
                    const unsigned er = (unsigned)__shfl((int)entv, 4 * kg + i);
                    float m = (((er >> 14) & 3u) == (unsigned)(lane & 3)) ? D[i] * pscl : 0.f;
                    m = dpp_add<0xB1>(m); m = dpp_add<0x4E>(m); m = dpp_add<0x104>(m);
                    const bool pick = (lane & 3) == i; dsel = pick ? m : dsel; esel = pick ? er : esel;
                }
                if ((lane & 12) == 0) {
                    const float w = __uint_as_float((esel >> 17) << 16) * gelu_tanh(dsel * (1.f / (T_SCALE * H_SCALE))) * W_SCALE;
                    const int p0 = __builtin_amdgcn_cvt_pk_fp8_f32(sat8(w), 0.f, 0, false);
                    const float hf = __builtin_amdgcn_cvt_f32_fp8(p0, 0);
                    const int p1 = __builtin_amdgcn_cvt_pk_fp8_f32(sat8((w - hf) * 16.f), 0.f, 0, false);
                    LIST[bi * 16 + 4 * kg + (lane & 3)] = (esel & 0xffffu) | (((unsigned)p0 & 0xffu) << 16) | (((unsigned)p1 & 0xffu) << 24); }
                entv = entn;
            }
        }
        }
        {
            const int m32 = lane & 31, kh = lane >> 5, ntok = m32 >> 3, npart = (m32 >> 2) & 1, nc = m32 & 3;
            const unsigned psel = (0x0c0c0c0cu & ~(0xffu << (8 * nc))) | ((unsigned)(2 + npart) << (8 * nc));
            f32x16 acc[8];
#if P7_VPROBE
            p7_vsweep<P7_VPROBE>(acc, LIST, VT, m32, kh, psel, (unsigned)ntok);
#endif
            p7_vsweep<0>(acc, LIST, VT, m32, kh, psel, (unsigned)ntok);
            const float psc = npart ? V_SCALE / (W_SCALE * T_SCALE * 16.f) : V_SCALE / (W_SCALE * T_SCALE);
            char* arow = AT + ntok * P7_ATP + (16 * kh + nc) * 2;
#pragma unroll
            for (int T = 0; T < 8; ++T)
#pragma unroll
                for (int i = 0; i < 16; ++i) {
                    const float v = acc[T][i] * psc;
                    const float tot = (T & 1) ? dpp_add<0x114>(v) : dpp_add<0x104>(v);
                    if ((T & 1) == npart) *(_Float16*)(arow + (128 * T + 4 * ((i & 3) + 8 * (i >> 2))) * 2) = (_Float16)tot;
                }
        }
#pragma unroll
        for (int k = 0; k < 4; ++k) {
            const int tok = tok0 + k;
            float f[16]; float ss = 0.f;
            const u32x4 e0 = *(const u32x4*)(AT + k * P7_ATP + lane * 32), e1 = *(const u32x4*)(AT + k * P7_ATP + lane * 32 + 16);
#pragma unroll
            for (int i = 0; i < 8; ++i) { const unsigned cw = i < 4 ? e0[i] : e1[i - 4]; const h16x2 hv = as_h2(cw);
                f[2 * i] = (float)hv[0] * (1.f / V_SCALE); f[2 * i + 1] = (float)hv[1] * (1.f / V_SCALE); ss += f[2 * i] * f[2 * i] + f[2 * i + 1] * f[2 * i + 1]; }
            ss = wave_sum_bcast(ss);
            const float rinv = rsqrtf(ss * (1.f / DM) + EPS);
            const float* g2 = mod + (size_t)(tok >> 11) * 6144 + 5120;
            const u32x4 xa = *(const u32x4*)(XM + (size_t)tok * DM + lane * 16), xb = *(const u32x4*)(XM + (size_t)tok * DM + lane * 16 + 8);
#pragma unroll
            for (int q4 = 0; q4 < 4; ++q4) {
                const int c = lane * 16 + q4 * 4;
                const unsigned x01 = q4 < 2 ? xa[2 * q4] : xb[2 * q4 - 4], x23 = q4 < 2 ? xa[2 * q4 + 1] : xb[2 * q4 - 3];
                const f32x4 xm = {bflo(x01), bfhi(x01), bflo(x23), bfhi(x23)}, g2v = *(const f32x4*)(g2 + c), gp = *(const f32x4*)(a.in[I_GPOSTFFN] + c);
                f32x4 o;
#pragma unroll
                for (int jj = 0; jj < 4; ++jj) o[jj] = xm[jj] + g2v[jj] * (f[q4 * 4 + jj] * rinv * gp[jj]);
                *(f32x4*)(a.out + (size_t)tok * DM + c) = o; }
        }
    }
}

#ifdef DBG_DIGEST
__device__ void phase_digest(const Args& a, int vb, int nb) {
    const bf16_t* A2 = (const bf16_t*)(a.ws + WS_A2);
    const bf16_t* Q = (const bf16_t*)(a.ws + WS_Q); const bf16_t* K = (const bf16_t*)(a.ws + WS_K); const bf16_t* VV = (const bf16_t*)(a.ws + WS_VV);
    const bf16_t* L = (const bf16_t*)(a.ws + WS_L); const bf16_t* ZG = (const bf16_t*)(a.ws + WS_ZG);
    for (size_t e = (size_t)vb * NTHR + threadIdx.x; e < (size_t)NTOK * DM; e += (size_t)nb * NTHR) {
        float v = 0.f;
#if DBG_DIGEST == 3
        const size_t row = e >> 10; const int c = (int)(e & 1023);
        v = bf2f(A2[row * KOUT + c]); if (c < 512) v += bf2f(A2[row * KOUT + 1024 + c]);
#elif DBG_DIGEST == 2
        const size_t h = e % ((size_t)NTOK * 512);
        v = bf2f(Q[h]) + bf2f(ZG[h]) + bf2f(L[e % ((size_t)NB * STOT * 512)]);
        if (e < (size_t)NB * 2 * STOT * 64) v += bf2f(K[e]) + bf2f(VV[e]);
#endif
        a.out[e] = v; }
}
#endif
constexpr int LDS_BYTES = 155648;
constexpr int LDS_BARST = LDS_BYTES - 16;
static_assert(8 * P7_HTP <= P7_RING && 4 * P7_ATP <= P7_RING && 8 * P7_WLDS <= LDS_BARST && PK_END <= LDS_BARST && LR_END <= LDS_BARST && g8::SHM_B <= LDS_BARST && 17 * 1024 * 4 + 17 * 24 * 4 <= LDS_BARST, "LDS budget");
constexpr int N_PHASES = 8;

__global__ void __launch_bounds__(NTHR, 2) mk_fwd(Args a) {
    extern __shared__ __attribute__((aligned(16))) char lds[];
    const int nb = gridDim.x, bx = blockIdx.x;
    const int vb0 = (nb % 8 == 0) ? (bx % 8) * (nb / 8) + bx / 8 : bx;
    XcdBarrier bar; bar.bar = (unsigned*)(a.ws + WS_CTL); bar.x = 0; bar.st = (volatile LAS unsigned*)(LAS char*)(lds + LDS_BARST);
    const bool multi = (a.ph_hi - a.ph_lo) > 1;
    if (multi) {
        if (threadIdx.x < 4) ((volatile LAS unsigned*)(LAS char*)(lds + LDS_BARST))[threadIdx.x] = 0u;
        __syncthreads();
        bar = xcd_barrier_post((unsigned*)(a.ws + WS_CTL), (volatile LAS unsigned*)(LAS char*)(lds + LDS_BARST));
    }
#ifndef P7_PROBE
#define P7_PROBE -1
#endif
#ifndef DBL_PHASE
#define DBL_PHASE 0
#endif
#if DBL_PHASE != 0
#define RUN_PHASE(P, CALL) do { if (a.ph_lo <= (P) && (P) < a.ph_hi) { const int nrep_ = ((a.dbl >> (P)) & 1) ? 2 : 1; for (int rep_ = 0; rep_ < nrep_; ++rep_) { CALL; if ((P) + 1 < a.ph_hi || rep_ + 1 < nrep_) xcd_barrier(bar); } } } while (0)
#else
#define RUN_PHASE(P, CALL) do { if (a.ph_lo <= (P) && (P) < a.ph_hi) { CALL; if ((P) + 1 < a.ph_hi) xcd_barrier(bar); } } while (0)
#endif
#if !defined(ONLY_PHASE) || ONLY_PHASE == 0
    RUN_PHASE(0, phase_prep(a, lds, vb0, nb));
#endif
    int vb = vb0;
    if (multi && a.ph_lo == 0 && a.ph_hi > 1) {
        if (threadIdx.x == 0) { unsigned off = 0; for (unsigned j = 0; j < bar.x; ++j) off += xb_ld(&bar.bar[XB_XCNT(j)]); bar.st[3] = off + bar.st[2]; }
        __syncthreads();
        vb = (int)bar.st[3];
    }
#if !defined(ONLY_PHASE) || ONLY_PHASE == 1
    RUN_PHASE(1, phase_xn(a, vb, nb));
#endif
#if !defined(ONLY_PHASE) || ONLY_PHASE == 2
    RUN_PHASE(2, phase_inproj(a, lds, vb, nb));
#endif
#if (!defined(ONLY_PHASE) || ONLY_PHASE == 3) && !(defined(DBG_DIGEST) && DBG_DIGEST == 2)
    RUN_PHASE(3, phase_mixer(a, lds, vb, nb));
#endif
#ifdef DBG_DIGEST
    if (a.ph_lo <= 4 && 4 < a.ph_hi) phase_digest(a, vb, nb);
    return;
#endif
#if !defined(ONLY_PHASE) || ONLY_PHASE == 4
    RUN_PHASE(4, phase_outproj(a, lds, vb, nb));
#endif
#if !defined(ONLY_PHASE) || ONLY_PHASE == 5
    RUN_PHASE(5, phase_rowpass(a, vb, nb));
#endif
#if !defined(ONLY_PHASE) || ONLY_PHASE == 6
    RUN_PHASE(6, phase_peer_topk(a, lds, vb, nb));
#endif
#if !defined(ONLY_PHASE) || ONLY_PHASE == 7
    RUN_PHASE(7, phase_peer_gather(a, lds, vb, nb));
#endif
}

extern "C" void kernel_launch(void* const* d_in, const int* in_sizes, int n_in, void* d_out, int out_size, void* d_ws, size_t ws_size, hipStream_t stream) {
    static int grid = 0;
    if (grid == 0) {
        if (n_in != 25 || out_size != NTOK * DM || ws_size < WS_END) { fprintf(stderr, "kernel_launch: unexpected shapes (n_in %d, out %d, ws %zu, need %zu)\n", n_in, out_size, ws_size, (size_t)WS_END); grid = -1; return; }
        int dev = 0, cus = 0;
        if (hipGetDevice(&dev) != hipSuccess || hipDeviceGetAttribute(&cus, hipDeviceAttributeMultiprocessorCount, dev) != hipSuccess) { grid = -1; return; }
        if (hipFuncSetAttribute((const void*)mk_fwd, hipFuncAttributeMaxDynamicSharedMemorySize, LDS_BYTES) != hipSuccess) { fprintf(stderr, "kernel_launch: hipFuncSetAttribute failed\n"); grid = -1; return; }
        (void)hipGetLastError();
        grid = cus;
    }
    if (grid < 0) return;
    (void)hipMemsetAsync((char*)d_ws + WS_CTL, 0, CTL_BYTES, stream);
    Args a{};
    for (int i = 0; i < 25; ++i) a.in[i] = (const float*)d_in[i];
    a.out = (float*)d_out; a.ws = (unsigned char*)d_ws; a.dbl = DBL_PHASE; a.probe = P7_PROBE;
#if MK_N_LAUNCHES == 1
    a.ph_lo = 0; a.ph_hi = N_PHASES;
    hipLaunchKernelGGL(mk_fwd, dim3(grid), dim3(NTHR), LDS_BYTES, stream, a);
#else
    for (int ph = 0; ph < N_PHASES; ++ph) { a.ph_lo = ph; a.ph_hi = ph + 1; hipLaunchKernelGGL(mk_fwd, dim3(grid), dim3(NTHR), LDS_BYTES, stream, a); }
#endif
}
```

```cpp
#include <hip/hip_runtime.h>
#include <cstdio>
#include <cstdint>

#ifndef MK_N_LAUNCHES
#define MK_N_LAUNCHES 1
#endif

typedef unsigned short bf16_t;
typedef short bf16x8 __attribute__((ext_vector_type(8)));
typedef float f32x16 __attribute__((ext_vector_type(16)));
typedef float f32x4 __attribute__((ext_vector_type(4)));
typedef float f32x2 __attribute__((ext_vector_type(2)));
typedef unsigned u32x4 __attribute__((ext_vector_type(4)));
typedef unsigned u32x2 __attribute__((ext_vector_type(2)));
typedef int i32x8 __attribute__((ext_vector_type(8)));
typedef int i32x4 __attribute__((ext_vector_type(4)));
#define LAS __attribute__((address_space(3)))

constexpr int DM = 1024, NB = 16, SEQ = 2048, CTX = 256, STOT = SEQ + CTX;
constexpr int NTOK = NB * SEQ;
constexpr int NCTX = NB * CTX;
constexpr int NROWS = NTOK + NCTX;
constexpr int DIN = 1792, DLRU = 512;
constexpr int KOUT = 1536;
constexpr int PEER_N = 16384;
constexpr float EPS = 1e-6f;
constexpr int NTHR = 512;

constexpr size_t al256(size_t x) { return (x + 255) & ~(size_t)255; }
constexpr size_t WS_CTL   = 0;
constexpr size_t CTL_BYTES = 65536;
constexpr size_t WS_MOD   = WS_CTL + CTL_BYTES;
constexpr size_t WS_ROPE  = WS_MOD + al256(17 * 6144 * 4);
constexpr size_t WS_WIN   = WS_ROPE + al256(64 * 16 * 2 * 4);
constexpr size_t WS_WOUT  = WS_WIN + al256((size_t)DIN * DM * 2);
constexpr size_t WS_WQ    = WS_WOUT + al256((size_t)DM * KOUT * 2);
constexpr size_t WS_SUBK  = WS_WQ + al256((size_t)2048 * DM * 2);
constexpr size_t WS_RGW   = WS_SUBK + al256((size_t)8 * 2 * 128 * 128 * 2);
constexpr size_t WS_UT    = WS_RGW + al256((size_t)2 * 8 * 128 * 64 * 2);
constexpr size_t WS_VT    = WS_UT + al256((size_t)PEER_N * DM * 2);
constexpr size_t WS_XN    = WS_VT + al256((size_t)PEER_N * DM * 2);
constexpr size_t WS_Q     = WS_XN + al256((size_t)NROWS * DM * 2);
constexpr size_t WS_K     = WS_Q + al256((size_t)NTOK * 512 * 2);
constexpr size_t WS_VV    = WS_K + al256((size_t)NB * 2 * STOT * 64 * 2);
constexpr size_t WS_L     = WS_VV + al256((size_t)NB * 2 * STOT * 64 * 2);
constexpr size_t WS_ZG    = WS_L + al256((size_t)NB * STOT * DLRU * 2);
constexpr size_t WS_A2    = WS_ZG + al256((size_t)NTOK * DLRU * 2);
constexpr size_t WS_END   = WS_A2 + al256((size_t)NTOK * KOUT * 2);
constexpr size_t WS_MIX   = WS_XN;
constexpr size_t WS_HX2   = WS_A2;
constexpr size_t WS_XM    = WS_Q;
constexpr size_t WS_IDX   = WS_ZG;
constexpr size_t WS_GATE  = WS_ZG + (size_t)NTOK * 128 * 4;
static_assert(WS_MIX + (size_t)NTOK * DM * 4 <= WS_ZG, "MIX overlay must end before ZG");
static_assert(WS_GATE + (size_t)NTOK * 128 * 4 <= WS_A2, "IDX/GATE overlay must end before A2");

typedef __bf16 bf16x2_t __attribute__((ext_vector_type(2)));
__device__ __forceinline__ unsigned pk2(float lo, float hi) { const f32x2 v = {lo, hi}; const bf16x2_t b = __builtin_convertvector(v, bf16x2_t); return __builtin_bit_cast(unsigned, b); }
typedef _Float16 h16x2 __attribute__((ext_vector_type(2)));
constexpr float V_SCALE = 64.f;
constexpr float T_SCALE = 256.f;
#ifndef P7_FP8
#define P7_FP8 1
#endif
__device__ __forceinline__ unsigned pkh2(float lo, float hi) { const h16x2 h = {(_Float16)lo, (_Float16)hi}; return __builtin_bit_cast(unsigned, h); }
__device__ __forceinline__ bf16x2_t as_bf2(unsigned x) { return __builtin_bit_cast(bf16x2_t, x); }
__device__ __forceinline__ h16x2 as_h2(unsigned x) { return __builtin_bit_cast(h16x2, x); }
__device__ __forceinline__ bf16_t f2bf(float f) { return (bf16_t)(pk2(f, 0.f) & 0xffffu); }
__device__ __forceinline__ float bf2f(unsigned h) { return __uint_as_float(h << 16); }
__device__ __forceinline__ float bflo(unsigned w) { return __uint_as_float(w << 16); }
__device__ __forceinline__ float bfhi(unsigned w) { return __uint_as_float(w & 0xffff0000u); }
__device__ __forceinline__ float sat8(float x) { return fminf(fmaxf(x, -448.f), 448.f); }
__device__ __forceinline__ float fast_rcp(float x) { return __builtin_amdgcn_rcpf(x); }
__device__ __forceinline__ float sigmoidf_(float x) { return fast_rcp(1.f + __expf(-x)); }
__device__ __forceinline__ float gelu_tanh(float x) { const float y = 0.7978845608028654f * (x + 0.044715f * x * x * x); return x * fast_rcp(1.f + __expf(-2.f * y)); }
__device__ __forceinline__ float silu_(float x) { return x * sigmoidf_(x); }
__device__ __forceinline__ float wave_sum(float v) {
#pragma unroll
    for (int o = 32; o > 0; o >>= 1) v += __shfl_xor(v, o);
    return v;
}
__device__ __forceinline__ float half_swap_max(float v) { auto rr = __builtin_amdgcn_permlane32_swap(__float_as_uint(v), __float_as_uint(v), false, false); return fmaxf(__uint_as_float(rr[0]), __uint_as_float(rr[1])); }
__device__ __forceinline__ float half_swap_sum(float v) { auto rr = __builtin_amdgcn_permlane32_swap(__float_as_uint(v), __float_as_uint(v), false, false); return __uint_as_float(rr[0]) + __uint_as_float(rr[1]); }
#define MFMA(a, b, c) __builtin_amdgcn_mfma_f32_32x32x16_bf16((a), (b), (c), 0, 0, 0)

#define XB_TMO      128
#define XB_XCNT(j)  (256  + 64 * (j))
#define XB_XSUB(j)  (1280 + 64 * (j))
#define XB_XGEN(j)  (2304 + 64 * (j))
#define XB_TOP      3328
#define XB_TOPGEN   3392
#define XCD_BAR_WORDS 3456
#define XB_SPIN_CAP (1u << 20)
__device__ __forceinline__ unsigned xb_ld(unsigned* p)              { return __hip_atomic_load(p, __ATOMIC_RELAXED, __HIP_MEMORY_SCOPE_AGENT); }
__device__ __forceinline__ unsigned xb_add(unsigned* p, unsigned v) { return __hip_atomic_fetch_add(p, v, __ATOMIC_RELAXED, __HIP_MEMORY_SCOPE_AGENT); }
__device__ __forceinline__ unsigned xb_xcc_id() { return (unsigned)__builtin_amdgcn_s_getreg((3 << 11) | 20) & 0xFu; }
#define XB_SPIN(cond, bar) do { unsigned _sp = 0; while (cond) { __builtin_amdgcn_s_sleep(1); \
    if ((++_sp & 255u) == 0u) { if (xb_ld(&(bar)[XB_TMO])) break; if (_sp > XB_SPIN_CAP) { atomicAdd(&(bar)[XB_TMO], 1u); break; } } } } while (0)
struct XcdBarrier { unsigned* bar; unsigned x; volatile LAS unsigned* st; };
__device__ __forceinline__ XcdBarrier xcd_barrier_post(unsigned* bar, volatile LAS unsigned* st) {
    XcdBarrier b; b.bar = bar; b.x = xb_xcc_id(); b.st = st;
    if (threadIdx.x == 0) st[2] = xb_add(&bar[XB_XCNT(b.x)], 1u);
    return b;
}
__device__ __forceinline__ void xcd_barrier_complete(unsigned* bar, unsigned x, unsigned& nloc, unsigned& nx) {
    const unsigned G = gridDim.x * gridDim.y * gridDim.z;
    unsigned sum, cnt, mine, sp = 0u;
    for (;;) {
        sum = 0u; cnt = 0u; mine = 0u;
#pragma unroll
        for (unsigned j = 0; j < 16; ++j) { const unsigned c = xb_ld(&bar[XB_XCNT(j)]); sum += c; cnt += (c > 0u) ? 1u : 0u; mine = (j == x) ? c : mine; }
        if (sum == G) break;
        __builtin_amdgcn_s_sleep(1);
        if ((++sp & 255u) == 0u) { if (xb_ld(&bar[XB_TMO])) break; if (sp > XB_SPIN_CAP) { atomicAdd(&bar[XB_TMO], 1u); break; } }
    }
    nloc = mine > 0u ? mine : 1u; nx = cnt > 0u ? cnt : 1u;
}
__device__ __forceinline__ void xcd_barrier(const XcdBarrier& b) {
    asm volatile("s_waitcnt vmcnt(0)" ::: "memory");
    __syncthreads();
    if (threadIdx.x == 0) {
        unsigned* bar = b.bar;
        __builtin_amdgcn_s_waitcnt(0);
        unsigned nloc = b.st[0], nx = b.st[1];
        if (nloc == 0u) { xcd_barrier_complete(bar, b.x, nloc, nx); b.st[0] = nloc; b.st[1] = nx; }
        const unsigned old = xb_add(&bar[XB_XSUB(b.x)], 1u);
        const unsigned gen = old / nloc;
        if (old + 1u == (gen + 1u) * nloc) {
            __builtin_amdgcn_fence(__ATOMIC_RELEASE, "agent");
            asm volatile("s_waitcnt vmcnt(0)" ::: "memory");
            const unsigned og = xb_add(&bar[XB_TOP], 1u);
            const unsigned tg = og / nx;
            if (og + 1u == (tg + 1u) * nx) xb_add(&bar[XB_TOPGEN], 1u);
            else XB_SPIN(xb_ld(&bar[XB_TOPGEN]) == tg, bar);
            __builtin_amdgcn_fence(__ATOMIC_ACQUIRE, "agent");
            xb_add(&bar[XB_XGEN(b.x)], 1u);
            asm volatile("s_waitcnt vmcnt(0)" ::: "memory");
        } else {
            XB_SPIN(xb_ld(&bar[XB_XGEN(b.x)]) == gen, bar);
            __builtin_amdgcn_fence(__ATOMIC_ACQUIRE, "agent");
            asm volatile("s_waitcnt vmcnt(0)" ::: "memory");
        }
    }
    __syncthreads();
}

struct Args { const float* in[25]; float* out; unsigned char* ws; int ph_lo, ph_hi, dbl, probe; };
enum { I_X = 0, I_C, I_CTX, I_CCTX, I_WMOD, I_BMOD, I_GPREMIX, I_GPOSTMIX, I_GPREFFN, I_GPOSTFFN, I_WIN, I_QNG, I_KNG, I_CONVW, I_CONVB,
       I_RGWA, I_RGBA, I_RGWI, I_RGBI, I_RGLAM, I_WOUT, I_PWQ, I_PSUBK, I_PU, I_PV };

__device__ __forceinline__ void tr_tile(const float* __restrict__ src, int lds_, int sr0, int sc0, bf16_t* __restrict__ dst, int ldd, int dr0, int dc0, float* T) {
    const int tid = threadIdx.x;
#pragma unroll
    for (int i = 0; i < 8; ++i) { const int e = tid + NTHR * i, r = e >> 6, c = e & 63; T[r * 65 + c] = src[(size_t)(sr0 + r) * lds_ + sc0 + c]; }
    __syncthreads();
#pragma unroll
    for (int i = 0; i < 8; ++i) { const int e = tid + NTHR * i, c = e >> 6, r = e & 63; dst[(size_t)(dr0 + c) * ldd + dc0 + r] = f2bf(T[r * 65 + c]); }
    __syncthreads();
}

constexpr int UV_ITEMS = 512;
constexpr int CTL_UVCTR = 8192;
__device__ __forceinline__ void conv_uv_item(const Args& a, int t) {
    const int tid = threadIdx.x;
    const bool isv = t >= 256; const int tt = t & 255;
    const float* src = (isv ? a.in[I_PV] : a.in[I_PU]) + (size_t)tt * 65536;
    unsigned char* d8 = a.ws + (isv ? WS_VT : WS_UT) + (size_t)tt * 65536;
#pragma unroll 1
    for (int e0 = tid * 16; e0 < 65536; e0 += NTHR * 16 * 4) {
        f32x4 v[4][4];
#pragma unroll
        for (int u = 0; u < 4; ++u)
#pragma unroll
            for (int q = 0; q < 4; ++q) v[u][q] = *(const f32x4*)(src + e0 + u * NTHR * 16 + q * 4);
#pragma unroll
        for (int u = 0; u < 4; ++u) { u32x4 o;
#pragma unroll
            for (int q = 0; q < 4; ++q) { f32x4 x = v[u][q] * T_SCALE;
#pragma unroll
                for (int i = 0; i < 4; ++i) x[i] = fminf(fmaxf(x[i], -448.f), 448.f);
                int w = __builtin_amdgcn_cvt_pk_fp8_f32(x[0], x[1], 0, false); w = __builtin_amdgcn_cvt_pk_fp8_f32(x[2], x[3], w, true); o[q] = (unsigned)w; }
            *(u32x4*)(d8 + e0 + u * NTHR * 16) = o; }
    }
}
__device__ void phase_prep(const Args& a, char* lds, int vb, int nb) {
    const int tid = threadIdx.x;
    unsigned char* ws = a.ws;
    float* S = (float*)lds;
    float* T = (float*)lds;
    constexpr int N_MOD = 256, N_TIN = 448, N_TOUT = 384, N_TWQ = 512, N_RGW = 32, N_SUBK = 16, N_UV = 0, N_MISC = 1;
    constexpr int O_TIN = N_MOD, O_TOUT = O_TIN + N_TIN, O_TWQ = O_TOUT + N_TOUT, O_RGW = O_TWQ + N_TWQ, O_SUBK = O_RGW + N_RGW, O_UV = O_SUBK + N_SUBK, O_MISC = O_UV + N_UV, N_ALL = O_MISC + N_MISC;
    for (int it = vb; it < N_ALL; it += nb) {
        if (it < O_TIN) {
            {
                int tq = tid; asm volatile("" : "+v"(tq));
                const float* cp = a.in[I_C] + tq; const float* xp = a.in[I_CCTX] + tq;
                float cv[17];
#pragma unroll
                for (int i = 0; i < 17; ++i) cv[i] = cp[NTHR * i];
#pragma unroll
                for (int i = 0; i < 17; ++i) S[tid + NTHR * i] = silu_(cv[i]);
#pragma unroll
                for (int i = 0; i < 15; ++i) cv[i] = cp[NTHR * (17 + i)];
                cv[15] = xp[0]; cv[16] = xp[NTHR];
#pragma unroll
                for (int i = 0; i < 17; ++i) S[tid + NTHR * (17 + i)] = silu_(cv[i]);
            }
            __syncthreads();
            const int n0 = it * 24;
            const int cc = tid % 6, kk = tid / 6;
            float acc[17][4];
#pragma unroll
            for (int r = 0; r < 17; ++r) { acc[r][0] = 0.f; acc[r][1] = 0.f; acc[r][2] = 0.f; acc[r][3] = 0.f; }
            if (tid < 510) {
#pragma unroll 1
                for (int i0 = 0; i0 < 16; i0 += 4) {
                    f32x4 wv[4];
#pragma unroll
                    for (int i = 0; i < 4; ++i) { const int k = min(kk + 85 * (i0 + i), 1023); wv[i] = *(const f32x4*)(a.in[I_WMOD] + (size_t)k * 6144 + n0 + cc * 4); }
#pragma unroll
                    for (int i = 0; i < 4; ++i) { const int k = kk + 85 * (i0 + i); const bool ok = k < 1024; const int kc = min(k, 1023);
                        const f32x4 w = ok ? wv[i] : (f32x4){0.f, 0.f, 0.f, 0.f};
#pragma unroll
                        for (int r = 0; r < 17; ++r) { const float s = S[r * 1024 + kc]; acc[r][0] += s * w[0]; acc[r][1] += s * w[1]; acc[r][2] += s * w[2]; acc[r][3] += s * w[3]; }
                    }
                }
            }
            __syncthreads();
            if (tid < 510) {
#pragma unroll
                for (int r = 0; r < 17; ++r) { f32x4 v = {acc[r][0], acc[r][1], acc[r][2], acc[r][3]}; *(f32x4*)(S + (kk * 17 + r) * 24 + cc * 4) = v; }
            }
            __syncthreads();
            float* mod = (float*)(ws + WS_MOD);
            for (int e = tid; e < 17 * 24; e += NTHR) { const int r = e / 24, j = e % 24; float sum = 0.f;
                for (int q = 0; q < 85; ++q) sum += S[(q * 17 + r) * 24 + j];
                mod[r * 6144 + n0 + j] = sum + a.in[I_BMOD][n0 + j]; }
            __syncthreads();
        } else if (it < O_TOUT) {
            const int t = it - O_TIN, kt = t / 28, nt = t % 28;
            tr_tile(a.in[I_WIN], DIN, kt * 64, nt * 64, (bf16_t*)(ws + WS_WIN), DM, nt * 64, kt * 64, T);
        } else if (it < O_TWQ) {
            const int t = it - O_TOUT, kt = t / 16, nt = t % 16;
            const int sk = (kt < 16) ? kt * 64 : (kt - 16) * 64 + 512;
            tr_tile(a.in[I_WOUT], DM, sk, nt * 64, (bf16_t*)(ws + WS_WOUT), KOUT, nt * 64, kt * 64, T);
        } else if (it < O_RGW) {
            const int t = it - O_TWQ, kt = t / 32, nt = t % 32;
            tr_tile(a.in[I_PWQ], 2048, kt * 64, nt * 64, (bf16_t*)(ws + WS_WQ), DM, nt * 64, kt * 64, T);
        } else if (it < O_SUBK) {
            const int t = it - O_RGW, g = t & 1, dn = t >> 1;
            const float* src = (g == 0 ? a.in[I_RGWA] : a.in[I_RGWI]) + (size_t)dn * 4096;
            tr_tile(src, 64, 0, 0, (bf16_t*)(ws + WS_RGW) + (size_t)dn * 128 * 64 + g * 64 * 64, 64, 0, 0, T);
        } else if (it < O_UV) {
            const int t = it - O_SUBK; const float* src = a.in[I_PSUBK] + (size_t)t * 16384; bf16_t* dst = (bf16_t*)(ws + WS_SUBK) + (size_t)t * 16384;
            for (int e = tid * 4; e < 16384; e += NTHR * 4) { const f32x4 v = *(const f32x4*)(src + e); u32x2 o = {pk2(v[0], v[1]), pk2(v[2], v[3])}; *(u32x2*)(dst + e) = o; }
        } else {
            float* rope = (float*)(ws + WS_ROPE);
            for (int e = tid; e < 64 * 16; e += NTHR) { const int pos = e >> 4, f = e & 15; const float inv = powf(10000.f, -(float)f / 16.f); const float ang = (float)pos * inv; rope[e * 2] = cosf(ang); rope[e * 2 + 1] = sinf(ang); }
        }
    }
}

__device__ void phase_xn(const Args& a, int vb, int nb) {
    const int tid = threadIdx.x, lane = tid & 63, wid = tid >> 6;
    const float* mod = (const float*)(a.ws + WS_MOD);
    bf16_t* XN = (bf16_t*)(a.ws + WS_XN);
    const float* g = a.in[I_GPREMIX];
    const int chunk = (NROWS + nb - 1) / nb, rend = min(NROWS, (vb + 1) * chunk);
    f32x4 A[4], B[4]; int cur = -1;
    for (int row = vb * chunk + wid; row < rend; row += 8) {
        const float* src; int mrow;
        if (row < NTOK) { src = a.in[I_X] + (size_t)row * DM; mrow = row >> 11; } else { src = a.in[I_CTX] + (size_t)(row - NTOK) * DM; mrow = 16; }
        f32x4 v[4]; float ss = 0.f;
#pragma unroll
        for (int i = 0; i < 4; ++i) v[i] = *(const f32x4*)(src + i * 256 + lane * 4);
        if (mrow != cur) { cur = mrow; const float* sh = mod + (size_t)mrow * 6144, *sc = sh + 1024;
#pragma unroll
            for (int i = 0; i < 4; ++i) { const int c = i * 256 + lane * 4; const f32x4 gg = *(const f32x4*)(g + c), s1 = *(const f32x4*)(sc + c); B[i] = *(const f32x4*)(sh + c);
#pragma unroll
                for (int j = 0; j < 4; ++j) A[i][j] = gg[j] * (1.f + s1[j]); } }
#pragma unroll
        for (int i = 0; i < 4; ++i) ss += v[i][0] * v[i][0] + v[i][1] * v[i][1] + v[i][2] * v[i][2] + v[i][3] * v[i][3];
        ss = wave_sum(ss);
        const float rinv = rsqrtf(ss * (1.f / DM) + EPS);
#pragma unroll
        for (int i = 0; i < 4; ++i) { const int c = i * 256 + lane * 4;
            float o[4];
#pragma unroll
            for (int j = 0; j < 4; ++j) o[j] = v[i][j] * rinv * A[i][j] + B[i][j];
            u32x2 w = {pk2(o[0], o[1]), pk2(o[2], o[3])}; *(u32x2*)(XN + (size_t)row * DM + c) = w; }
    }
}

constexpr int E_PITCH = 272;
namespace g8 {
constexpr int BM = 256, BK = 64, HALF = 128, HT = HALF * BK, SHM_B = 8 * HT * 2;
__device__ __forceinline__ int lds_byte(int r, int c) { const int st = (r >> 4) * 2 + (c >> 5), rr = r & 15, cc = c & 31, ob = rr * 64 + cc * 2; return st * 1024 + (ob ^ (((ob >> 9) & 1) << 5)); }
__device__ __forceinline__ void stage_rc(int b, int& R, int& C) { const int st = b / 1024, sb = b % 1024, swz = sb ^ (((sb >> 9) & 1) << 5); R = (st >> 1) * 16 + swz / 64; C = (st & 1) * 32 + (swz % 64) / 2; }
__device__ __forceinline__ void core(f32x4 (&acc)[2][2][4][2], const bf16_t* __restrict__ A, const bf16_t* __restrict__ Bt, int brow, int bcol, int K, char* lds_) {
    LAS unsigned char* lds = (LAS unsigned char*)lds_;
    const int tid = threadIdx.x, wid = __builtin_amdgcn_readfirstlane(tid >> 6), lane = tid & 63, wr = wid >> 2, wc = wid & 3, fr = lane & 15, fq = lane >> 4;
    constexpr int HTB = HT * 2;
    unsigned voff[2];
#pragma unroll
    for (int i = 0; i < 2; ++i) { int R, C; stage_rc(tid * 16 + i * 8192, R, C); voff[i] = (unsigned)(R * K + C) * 2u; }
    const size_t kstep = (size_t)(BK * 2), hstep = (size_t)HALF * K * 2;
    const unsigned ldsw = (unsigned)wid * 1024u;
    const int aoff = lds_byte(wr * 64 + fr, fq * 8), boff = lds_byte(wc * 32 + fr, fq * 8);
#define G8_SA(b, h) (((b) * 2 + (h)) * HTB)
#define G8_SB(b, h) ((4 + (b) * 2 + (h)) * HTB)
#define G8_STAGE(bufoff, gbase) do { _Pragma("unroll") for (int _i = 0; _i < 2; ++_i) \
        __builtin_amdgcn_global_load_lds((const unsigned*)((const char*)(gbase) + voff[_i]), (LAS unsigned*)(lds + (bufoff) + ldsw + _i * 8192), 16, 0, 0); } while (0)
#define G8_LDA(dst, b, h) do { _Pragma("unroll") for (int m = 0; m < 4; ++m) _Pragma("unroll") for (int k = 0; k < 2; ++k) dst[m][k] = *(const LAS bf16x8*)(lds + G8_SA(b, h) + aoff + m * 2048 + k * 1024); } while (0)
#define G8_LDB(dst, b, h) do { _Pragma("unroll") for (int n = 0; n < 2; ++n) _Pragma("unroll") for (int k = 0; k < 2; ++k) dst[n][k] = *(const LAS bf16x8*)(lds + G8_SB(b, h) + boff + n * 2048 + k * 1024); } while (0)
#define G8_MMA(ai, bj, At_, Bt_) do { __builtin_amdgcn_s_setprio(1); \
    _Pragma("unroll") for (int m = 0; m < 4; ++m) _Pragma("unroll") for (int n = 0; n < 2; ++n) _Pragma("unroll") for (int k = 0; k < 2; ++k) \
      acc[ai][bj][m][n] = __builtin_amdgcn_mfma_f32_16x16x32_bf16(At_[m][k], Bt_[n][k], acc[ai][bj][m][n], 0, 0, 0); \
    __builtin_amdgcn_s_setprio(0); } while (0)
#define G8_WAIT_V(n) asm volatile("s_waitcnt vmcnt(" #n ")" ::: "memory")
#define G8_WAIT_L(n) asm volatile("s_waitcnt lgkmcnt(" #n ")" ::: "memory")
#define G8_BAR __builtin_amdgcn_s_barrier()
#define G8_SCHED __builtin_amdgcn_sched_barrier(0)
#pragma unroll
    for (int ai = 0; ai < 2; ++ai)
#pragma unroll
        for (int bj = 0; bj < 2; ++bj)
#pragma unroll
            for (int m = 0; m < 4; ++m)
#pragma unroll
                for (int n = 0; n < 2; ++n) acc[ai][bj][m][n] = (f32x4){0.f, 0.f, 0.f, 0.f};
    bf16x8 At[4][2], B0[2][2], B1[2][2];
    const int nt = K / BK;
    const char* cA = (const char*)(A + (size_t)brow * K); const char* cB = (const char*)(Bt + (size_t)bcol * K);
    G8_STAGE(G8_SB(0, 0), cB); G8_STAGE(G8_SA(0, 0), cA); G8_STAGE(G8_SB(0, 1), cB + hstep); G8_STAGE(G8_SA(0, 1), cA + hstep);
    if (wr == 1) G8_BAR;
    G8_WAIT_V(4); G8_BAR;
    G8_STAGE(G8_SB(1, 0), cB + kstep); G8_STAGE(G8_SA(1, 0), cA + kstep); G8_STAGE(G8_SB(1, 1), cB + hstep + kstep);
    G8_WAIT_V(6); G8_BAR;
#pragma unroll 1
    for (int t = 0; t < nt - 2; t += 2) {
        const char* a1 = cA + (size_t)(t + 1) * kstep; const char* a2 = cA + (size_t)(t + 2) * kstep; const char* b2 = cB + (size_t)(t + 2) * kstep;
        const char* a3 = a2 + kstep; const char* b3 = b2 + kstep;
        G8_LDB(B0, 0, 0); G8_SCHED; G8_LDA(At, 0, 0); G8_STAGE(G8_SA(1, 1), a1 + hstep);
        G8_WAIT_L(8); G8_BAR; G8_WAIT_L(0); G8_MMA(0, 0, At, B0); G8_BAR; G8_SCHED;
        G8_LDB(B1, 0, 1); G8_STAGE(G8_SB(0, 0), b2);
        G8_BAR; G8_WAIT_L(0); G8_MMA(0, 1, At, B1); G8_BAR;
        G8_LDA(At, 0, 1); G8_STAGE(G8_SA(0, 0), a2);
        G8_BAR; G8_WAIT_L(0); G8_MMA(1, 0, At, B0); G8_BAR; G8_SCHED;
        G8_STAGE(G8_SB(0, 1), b2 + hstep);
        G8_WAIT_V(6); G8_BAR; G8_MMA(1, 1, At, B1); G8_BAR;
        G8_LDB(B0, 1, 0); G8_SCHED; G8_LDA(At, 1, 0); G8_STAGE(G8_SA(0, 1), a2 + hstep);
        G8_WAIT_L(8); G8_BAR; G8_WAIT_L(0); G8_MMA(0, 0, At, B0); G8_BAR; G8_SCHED;
        G8_LDB(B1, 1, 1); G8_STAGE(G8_SB(1, 0), b3);
        G8_BAR; G8_WAIT_L(0); G8_MMA(0, 1, At, B1); G8_BAR;
        G8_LDA(At, 1, 1); G8_STAGE(G8_SA(1, 0), a3);
        G8_BAR; G8_WAIT_L(0); G8_MMA(1, 0, At, B0); G8_BAR; G8_SCHED;
        G8_STAGE(G8_SB(1, 1), b3 + hstep);
        G8_WAIT_V(6); G8_BAR; G8_MMA(1, 1, At, B1); G8_BAR;
    }
    { G8_LDB(B0, 0, 0); G8_LDA(At, 0, 0); G8_STAGE(G8_SA(1, 1), cA + (size_t)(nt - 1) * kstep + hstep);
      G8_BAR; G8_WAIT_L(0); G8_MMA(0, 0, At, B0); G8_BAR;
      G8_LDB(B1, 0, 1); G8_BAR; G8_WAIT_L(0); G8_MMA(0, 1, At, B1); G8_BAR;
      G8_LDA(At, 0, 1); G8_WAIT_V(4); G8_BAR; G8_WAIT_L(0); G8_MMA(1, 0, At, B0); G8_MMA(1, 1, At, B1); G8_BAR; }
    { G8_LDB(B0, 1, 0); G8_LDA(At, 1, 0); G8_WAIT_V(2); G8_BAR; G8_WAIT_L(0); G8_MMA(0, 0, At, B0); G8_BAR;
      G8_LDB(B1, 1, 1); G8_WAIT_V(0); G8_BAR; G8_WAIT_L(0); G8_MMA(0, 1, At, B1); G8_BAR;
      G8_LDA(At, 1, 1); G8_BAR; G8_WAIT_L(0); G8_MMA(1, 0, At, B0); G8_MMA(1, 1, At, B1); G8_BAR; }
    if (wr == 0) G8_BAR;
#undef G8_SA
#undef G8_SB
#undef G8_STAGE
#undef G8_LDA
#undef G8_LDB
#undef G8_MMA
#undef G8_WAIT_V
#undef G8_WAIT_L
#undef G8_BAR
#undef G8_SCHED
}
}

__device__ void phase_inproj(const Args& a, char* lds, int vb, int nb) {
    const int tid = threadIdx.x, lane = tid & 63, wid = tid >> 6, wr = wid >> 2, wc = wid & 3, fr = lane & 15, fq = lane >> 4;
    unsigned char* ws = a.ws;
    const bf16_t* XN = (const bf16_t*)(ws + WS_XN);
    const bf16_t* WIN = (const bf16_t*)(ws + WS_WIN);
    const float* rope = (const float*)(ws + WS_ROPE);
    bf16_t* Qo = (bf16_t*)(ws + WS_Q); bf16_t* Ko = (bf16_t*)(ws + WS_K); bf16_t* Vo = (bf16_t*)(ws + WS_VV); bf16_t* Lo = (bf16_t*)(ws + WS_L); bf16_t* Zo = (bf16_t*)(ws + WS_ZG);
    constexpr int N_LAT = 128 * 7, N_ALL = N_LAT + 16 * 3;
#pragma unroll 1
    for (int it = vb; it < N_ALL; it += nb) {
        int tt, ft;
        if (it < N_LAT) { tt = it / 7; ft = it % 7; } else { const int j = it - N_LAT; tt = 128 + j / 3; ft = 2 + j % 3; }
        f32x4 acc[2][2][4][2];
        g8::core(acc, WIN, XN, ft * 256, tt * 256, DM, lds);
        const bool lat = tt < 128;
#pragma unroll
        for (int ai = 0; ai < 2; ++ai) {
            const int g64 = ft * 4 + ai * 2 + wr;
            if (g64 < 10) {
                const bool isq = g64 < 8;
                const float* gn = isq ? a.in[I_QNG] : a.in[I_KNG];
                const float osc = isq ? 0.125f * 1.4426950408889634f : 1.f;
                float gnv[4][4];
#pragma unroll
                for (int m = 0; m < 4; ++m) { const f32x4 gv = *(const f32x4*)(gn + m * 16 + fq * 4); gnv[m][0] = gv[0]; gnv[m][1] = gv[1]; gnv[m][2] = gv[2]; gnv[m][3] = gv[3]; }
#pragma unroll
                for (int bj = 0; bj < 2; ++bj)
#pragma unroll
                    for (int n = 0; n < 2; ++n) {
                        float ss = 0.f;
#pragma unroll
                        for (int m = 0; m < 4; ++m)
#pragma unroll
                            for (int j = 0; j < 4; ++j) ss += acc[ai][bj][m][n][j] * acc[ai][bj][m][n][j];
                        ss += __shfl_xor(ss, 16); ss += __shfl_xor(ss, 32);
                        const float rinv = rsqrtf(ss * (1.f / 64.f) + EPS);
                        const int row = tt * 256 + bj * 128 + wc * 32 + n * 16 + fr;
                        int b, t, s_; if (lat) { b = row >> 11; t = row & 2047; s_ = CTX + t; } else { const int rc = row - NTOK; b = rc >> 8; t = 0; s_ = rc & 255; }
                        bf16_t* dst = isq ? Qo + ((size_t)(b * 8 + g64) * SEQ + t) * 64 : Ko + ((size_t)(b * 2 + (g64 - 8)) * STOT + s_) * 64;
                        f32x4 csv[2][2];
#pragma unroll
                        for (int ax = 0; ax < 2; ++ax) { const int pos = ax == 0 ? (t >> 6) : (t & 63); const float* rp = rope + (pos * 16 + fq * 4) * 2;
                            csv[ax][0] = *(const f32x4*)rp; csv[ax][1] = *(const f32x4*)(rp + 4); }
#pragma unroll
                        for (int ax = 0; ax < 2; ++ax) {
                            float o1[4], o2[4];
#pragma unroll
                            for (int j = 0; j < 4; ++j) {
                                const float x1 = acc[ai][bj][2 * ax][n][j] * rinv * gnv[2 * ax][j], x2 = acc[ai][bj][2 * ax + 1][n][j] * rinv * gnv[2 * ax + 1][j];
                                const float co = lat ? csv[ax][j >> 1][(j & 1) * 2] : 1.f, si = lat ? csv[ax][j >> 1][(j & 1) * 2 + 1] : 0.f;
                                const float c1 = x1 * co - x2 * si, c2 = x1 * si + x2 * co;
                                o1[j] = c1 * osc; o2[j] = c2 * osc; }
                            *(u32x2*)(dst + ax * 32 + fq * 4) = (u32x2){pk2(o1[0], o1[1]), pk2(o1[2], o1[3])};
                            *(u32x2*)(dst + ax * 32 + 16 + fq * 4) = (u32x2){pk2(o2[0], o2[1]), pk2(o2[2], o2[3])};
                        }
                    }
            } else if (g64 < 12) {
#pragma unroll
                for (int bj = 0; bj < 2; ++bj)
#pragma unroll
                    for (int n = 0; n < 2; ++n) {
                        const int row = tt * 256 + bj * 128 + wc * 32 + n * 16 + fr;
                        int b, s_; if (lat) { b = row >> 11; s_ = CTX + (row & 2047); } else { const int rc = row - NTOK; b = rc >> 8; s_ = rc & 255; }
                        bf16_t* vp = Vo + ((size_t)(b * 2 + (g64 - 10)) * 64) * STOT + s_;
#pragma unroll
                        for (int m = 0; m < 4; ++m)
#pragma unroll
                            for (int j = 0; j < 4; ++j) vp[(size_t)(m * 16 + fq * 4 + j) * STOT] = f2bf(acc[ai][bj][m][n][j]);
                    }
            } else {
                const bool isz = g64 >= 20;
#pragma unroll
                for (int bj = 0; bj < 2; ++bj)
#pragma unroll
                    for (int n = 0; n < 2; ++n) {
                        const int row = tt * 256 + bj * 128 + wc * 32 + n * 16 + fr;
                        bf16_t* dst;
                        if (isz) dst = Zo + (size_t)row * DLRU + (g64 - 20) * 64;
                        else { int b, s_; if (lat) { b = row >> 11; s_ = CTX + (row & 2047); } else { const int rc = row - NTOK; b = rc >> 8; s_ = rc & 255; }
                            dst = Lo + ((size_t)b * STOT + s_) * DLRU + (g64 - 12) * 64; }
#pragma unroll
                        for (int m = 0; m < 4; ++m) { f32x4 v = acc[ai][bj][m][n];
                            if (isz) { v[0] = gelu_tanh(v[0]); v[1] = gelu_tanh(v[1]); v[2] = gelu_tanh(v[2]); v[3] = gelu_tanh(v[3]); }
                            *(u32x2*)(dst + m * 16 + fq * 4) = (u32x2){pk2(v[0], v[1]), pk2(v[2], v[3])}; }
                    }
            }
        }
        __syncthreads();
    }
    {
        unsigned* ctr = (unsigned*)(ws + WS_CTL) + CTL_UVCTR;
        volatile int* slot = (volatile int*)lds;
        for (;;) {
            if (tid == 0) *slot = (int)__hip_atomic_fetch_add(ctr, 1u, __ATOMIC_RELAXED, __HIP_MEMORY_SCOPE_AGENT);
            __syncthreads();
            const int t = *slot;
            __syncthreads();
            if (t >= UV_ITEMS) break;
            conv_uv_item(a, t);
        }
    }
}

constexpr int AT_KP = 144, AT_VP = 136, AT_STAGE = 64 * AT_KP + 64 * AT_VP;
__device__ void attn_item(const Args& a, char* lds, int b, int head, int qblk) {
    const int tid = threadIdx.x, lane = tid & 63, wid = tid >> 6, r32 = lane & 31, hi = lane >> 5;
    unsigned char* ws = a.ws;
    const int kvh = head >> 2;
    const bf16_t* Qp = (const bf16_t*)(ws + WS_Q) + ((size_t)(b * 8 + head) * SEQ + qblk * 256 + wid * 32 + r32) * 64 + hi * 8;
    const bf16_t* Kp = (const bf16_t*)(ws + WS_K) + (size_t)(b * 2 + kvh) * STOT * 64;
    const bf16_t* Vp = (const bf16_t*)(ws + WS_VV) + (size_t)(b * 2 + kvh) * 64 * STOT;
    bf16x8 qf[4];
#pragma unroll
    for (int ds = 0; ds < 4; ++ds) qf[ds] = *(const bf16x8*)(Qp + ds * 16);
    const int srow = tid >> 3, sch = tid & 7;
    const bf16_t* kg = Kp + (size_t)srow * 64 + sch * 8;
    const bf16_t* vg = Vp + (size_t)srow * STOT + sch * 8;
    u32x4 krA, vrA, krB, vrB;
    f32x16 o[2]; float lsum = 0.f;
    float negM;
    { float gq = fabsf(a.in[I_QNG][lane]), gk = fabsf(a.in[I_KNG][lane]);
#pragma unroll
      for (int o_ = 32; o_ > 0; o_ >>= 1) { gq = fmaxf(gq, __shfl_xor(gq, o_)); gk = fmaxf(gk, __shfl_xor(gk, o_)); }
      negM = -(64.f * 0.125f * 1.4426950408889634f * 1.01f) * gq * gk; }
#pragma unroll
    for (int dt = 0; dt < 2; ++dt)
#pragma unroll
        for (int r = 0; r < 16; ++r) o[dt][r] = 0.f;
    char* KS = lds; char* VS = lds + 2 * 64 * AT_KP;
#define A_LOADK(X, s0) do { kr##X = *(const u32x4*)(kg + (size_t)(s0) * 64); } while (0)
#define A_LOADV(X, s0) do { vr##X = *(const u32x4*)(vg + (s0)); } while (0)
#define A_WRITEK(X, st) do { *(u32x4*)(KS + (st) * 64 * AT_KP + srow * AT_KP + sch * 16) = kr##X; } while (0)
#define A_WRITEV(X, st) do { char* vb_ = VS + (st) * 64 * AT_VP + srow * AT_VP + sch * 16; *(u32x2*)vb_ = (u32x2){vr##X[0], vr##X[1]}; *(u32x2*)(vb_ + 8) = (u32x2){vr##X[2], vr##X[3]}; } while (0)
    constexpr int NT = STOT / 64;
    f32x16 sc[2], sn[2];
    A_LOADK(A, 0); A_LOADV(A, 0); A_WRITEK(A, 0); A_WRITEV(A, 0); A_LOADK(A, 64); A_WRITEK(A, 1); A_LOADK(B, 128); A_LOADV(B, 64); __syncthreads();
#pragma unroll
    for (int kt = 0; kt < 2; ++kt) {
#pragma unroll
        for (int r = 0; r < 16; ++r) sc[kt][r] = negM;
#pragma unroll
        for (int ds = 0; ds < 4; ++ds) { const bf16x8 ka = *(const bf16x8*)(KS + (kt * 32 + r32) * AT_KP + (ds * 16 + hi * 8) * 2); sc[kt] = MFMA(ka, qf[ds], sc[kt]); }
    }
    __syncthreads();
    f32x16 ol;
#pragma unroll
    for (int r = 0; r < 16; ++r) ol[r] = 0.f;
    const u32x4 ones_w = {0x3F803F80u, 0x3F803F80u, 0x3F803F80u, 0x3F803F80u};
    const bf16x8 ones = *(const bf16x8*)&ones_w;
#define A_STEP(J, SC, SN, XW, XL) do { const int j_ = (J); \
        const int jk = (j_ + 3 < NT) ? j_ + 3 : NT - 1, jv = (j_ + 2 < NT) ? j_ + 2 : NT - 1; \
        A_LOADK(XL, jk * 64); A_LOADV(XL, jv * 64); \
        const char* ksn = KS + ((j_ + 1) & 1) * 64 * AT_KP; const char* vs = VS + (j_ & 1) * 64 * AT_VP; \
        _Pragma("unroll") for (int kt = 0; kt < 2; ++kt) { \
            _Pragma("unroll") for (int r = 0; r < 16; ++r) SN[kt][r] = negM; \
            _Pragma("unroll") for (int ds = 0; ds < 4; ++ds) { \
                const bf16x8 ka = *(const bf16x8*)(ksn + (kt * 32 + r32) * AT_KP + (ds * 16 + hi * 8) * 2); \
                SN[kt] = MFMA(ka, qf[ds], SN[kt]); \
                _Pragma("unroll") for (int e = 0; e < 4; ++e) { const int f = (kt * 4 + ds) * 4 + e; SC[f >> 4][f & 15] = __builtin_amdgcn_exp2f(SC[f >> 4][f & 15]); } \
                __builtin_amdgcn_sched_barrier(0); } } \
        _Pragma("unroll") for (int kt = 0; kt < 2; ++kt) \
            _Pragma("unroll") for (int s = 0; s < 2; ++s) { \
                u32x4 pw = {pk2(SC[kt][8 * s], SC[kt][8 * s + 1]), pk2(SC[kt][8 * s + 2], SC[kt][8 * s + 3]), pk2(SC[kt][8 * s + 4], SC[kt][8 * s + 5]), pk2(SC[kt][8 * s + 6], SC[kt][8 * s + 7])}; \
                const bf16x8 pb = *(bf16x8*)&pw; \
                _Pragma("unroll") for (int dt = 0; dt < 2; ++dt) { \
                    const char* vp = vs + (dt * 32 + r32) * AT_VP + (kt * 32 + s * 16 + hi * 4) * 2; \
                    const u32x2 lo = *(const u32x2*)vp, hh = *(const u32x2*)(vp + 16); \
                    u32x4 aw = {lo[0], lo[1], hh[0], hh[1]}; \
                    o[dt] = MFMA(*(bf16x8*)&aw, pb, o[dt]); } \
                ol = MFMA(ones, pb, ol); } \
        A_WRITEK(XW, j_ & 1); A_WRITEV(XW, (j_ + 1) & 1); \
        __syncthreads(); } while (0)
#pragma unroll 1
    for (int j = 0; j < NT; j += 2) { A_STEP(j, sc, sn, B, A); A_STEP(j + 1, sn, sc, A, B); }
#undef A_STEP
    lsum = ol[0];
#undef A_LOADK
#undef A_LOADV
#undef A_WRITEK
#undef A_WRITEV
    const float inv = fast_rcp(lsum);
    bf16_t* outp = (bf16_t*)(ws + WS_A2) + ((size_t)b * SEQ + qblk * 256 + wid * 32 + r32) * KOUT + head * 64;
#pragma unroll
    for (int dt = 0; dt < 2; ++dt)
#pragma unroll
        for (int g = 0; g < 4; ++g) {
            u32x2 v = {pk2(o[dt][4 * g] * inv, o[dt][4 * g + 1] * inv), pk2(o[dt][4 * g + 2] * inv, o[dt][4 * g + 3] * inv)};
            *(u32x2*)(outp + dt * 32 + g * 8 + hi * 4) = v;
        }
}

constexpr int LR_RAW = 0;
constexpr int LR_U   = 33792;
constexpr int LR_BB  = LR_U + 33280;
constexpr int LR_UB  = LR_BB + 33280;
constexpr int LR_WG  = LR_UB + 18432;
constexpr int LR_SEG = LR_WG + 18432;
constexpr int LR_HC  = LR_SEG + 4096;
constexpr int LR_CST = LR_HC + 512;
constexpr int LR_END = LR_CST + 768;
__device__ void lru_item(const Args& a, char* lds, int b, int n, int d) {
    const int tid = threadIdx.x, lane = tid & 63, wid = tid >> 6, r32 = lane & 31, hi = lane >> 5;
    unsigned char* ws = a.ws;
    float* RAW = (float*)(lds + LR_RAW); float* AA = (float*)(lds + LR_RAW); float* U = (float*)(lds + LR_U); float* BB = (float*)(lds + LR_BB);
    char* UB = lds + LR_UB; char* WG = lds + LR_WG; float* SEG = (float*)(lds + LR_SEG); float* HC = (float*)(lds + LR_HC);
    const bf16_t* Lg = (const bf16_t*)(ws + WS_L) + (size_t)b * STOT * DLRU + n * 64;
    const bf16_t* Zg = (const bf16_t*)(ws + WS_ZG) + (size_t)b * SEQ * DLRU + n * 64;
    bf16_t* Og = (bf16_t*)(ws + WS_A2) + (size_t)b * SEQ * KOUT + 512 + d * 512 + n * 64;
    {
        const bf16_t* wsrc = (const bf16_t*)(ws + WS_RGW) + (size_t)(d * 8 + n) * 128 * 64;
#pragma unroll
        for (int i = 0; i < 2; ++i) { const int c = tid + NTHR * i, r = c >> 3, ch = c & 7; *(u32x4*)(WG + r * 144 + ch * 16) = *(const u32x4*)(wsrc + r * 64 + ch * 8); }
        if (tid < 128) HC[tid] = 0.f;
    }
    const int ct = wid & 1, tt = wid >> 1;
    float* CST = (float*)(lds + LR_CST);
    if (tid < 64) { const int c = n * 64 + tid; CST[tid] = a.in[I_RGBA][d * 512 + c]; CST[64 + tid] = a.in[I_RGBI][d * 512 + c];
        const float x = -a.in[I_RGLAM][d * 512 + c]; CST[128 + tid] = -8.f * (fmaxf(x, 0.f) + log1pf(__expf(-fabsf(x)))); }
    const int sc = tid & 63, sg = tid >> 6;
    const float cw0 = a.in[I_CONVW][0 * 512 + n * 64 + sc], cw1 = a.in[I_CONVW][1 * 512 + n * 64 + sc], cw2 = a.in[I_CONVW][2 * 512 + n * 64 + sc], cw3 = a.in[I_CONVW][3 * 512 + n * 64 + sc];
    const float cbias = a.in[I_CONVB][n * 64 + sc];
#define LRU_TILE(step_, isctx_, sb_, sl_, t0_) const bool isctx_ = (step_) < 2; const int sb_ = isctx_ ? 0 : CTX, sl_ = isctx_ ? CTX : SEQ, \
        t0_ = (isctx_ ? (d == 0 ? (step_) : 1 - (step_)) : (d == 0 ? (step_) - 2 : 17 - (step_))) * 128
#define LRU_FETCH(pre_, sb_, sl_, t0_) do { _Pragma("unroll") for (int i_ = 0; i_ < 3; ++i_) { const int e_ = min(tid + NTHR * i_, 131 * 8 - 1), t_ = min(max((t0_) - 2 + (e_ >> 3), 0), (sl_) - 1); \
        pre_[i_] = *(const u32x4*)(Lg + (size_t)((sb_) + t_) * DLRU + (e_ & 7) * 8); } } while (0)
#define LRU_SPREAD(pre_, sl_, t0_) do { _Pragma("unroll") for (int i_ = 0; i_ < 3; ++i_) { const int e_ = tid + NTHR * i_, t_ = (t0_) - 2 + (e_ >> 3); if (e_ < 131 * 8) { float* dst = RAW + (e_ >> 3) * 64 + (e_ & 7) * 8; \
        const bool in_ = t_ >= 0 && t_ < (sl_); const u32x4 v = pre_[i_]; f32x4 lo_ = {bflo(v[0]), bfhi(v[0]), bflo(v[1]), bfhi(v[1])}, hi_ = {bflo(v[2]), bfhi(v[2]), bflo(v[3]), bfhi(v[3])}; \
        if (!in_) { lo_ = (f32x4){0.f, 0.f, 0.f, 0.f}; hi_ = lo_; } *(f32x4*)dst = lo_; *(f32x4*)(dst + 4) = hi_; } } } while (0)
    u32x4 pre[3];
    { LRU_TILE(0, c0_, sb0_, sl0_, t00_); LRU_FETCH(pre, sb0_, sl0_, t00_); LRU_SPREAD(pre, sl0_, t00_); }
    __syncthreads();
    int par = 0;
    for (int step = 0; step < 18; ++step) {
        LRU_TILE(step, isctx, sb, sl, t0);
        LRU_TILE(step < 17 ? step + 1 : 17, c1_, sb1_, sl1_, t01_);
        LRU_FETCH(pre, sb1_, sl1_, t01_);
        unsigned short zv[16];
        {
            const int tfirst = d == 0 ? sg * 16 : 127 - sg * 16;
            const bf16_t* zp = Zg + (size_t)(t0 + tfirst) * DLRU + sc; const int zstep = d == 0 ? DLRU : -DLRU;
#pragma unroll
            for (int k = 0; k < 16; ++k) zv[k] = *(const unsigned short*)(zp + k * zstep);
        }
        {
            const float* rp = RAW + (sg * 16) * 64 + sc;
            float x0 = rp[0], x1 = rp[64], x2 = rp[128];
            float* up = U + (sg * 16) * 65 + sc; char* ubp = UB + (sg * 16) * 144 + sc * 2;
#pragma unroll
            for (int i = 0; i < 16; ++i) { const float x3 = rp[(i + 3) * 64];
                const float u = cbias + cw0 * x0 + cw1 * x1 + cw2 * x2 + cw3 * x3;
                up[i * 65] = u; *(bf16_t*)(ubp + i * 144) = f2bf(u); x0 = x1; x1 = x2; x2 = x3; }
        }
        __syncthreads();
        {
            f32x16 ga, gi;
#pragma unroll
            for (int r = 0; r < 16; ++r) { ga[r] = 0.f; gi[r] = 0.f; }
#pragma unroll
            for (int ks = 0; ks < 4; ++ks) {
                const bf16x8 wa = *(const bf16x8*)(WG + (ct * 32 + r32) * 144 + (ks * 16 + hi * 8) * 2);
                const bf16x8 wi = *(const bf16x8*)(WG + (64 + ct * 32 + r32) * 144 + (ks * 16 + hi * 8) * 2);
                const bf16x8 ub = *(const bf16x8*)(UB + (tt * 32 + r32) * 144 + (ks * 16 + hi * 8) * 2);
                ga = MFMA(wa, ub, ga); gi = MFMA(wi, ub, gi);
            }
            const int t = tt * 32 + r32;
#pragma unroll
            for (int r = 0; r < 16; ++r) { const int c = ct * 32 + 8 * (r >> 2) + 4 * hi + (r & 3);
                const float rr = sigmoidf_(ga[r] + CST[c]), ii = sigmoidf_(gi[r] + CST[64 + c]);
                const float la = CST[128 + c] * rr, av = __expf(la), mult = __builtin_amdgcn_sqrtf(fmaxf(1.f - av * av, 0.f));
                const float u = U[t * 65 + c];
                AA[t * 65 + c] = av; BB[t * 65 + c] = mult * ii * u; }
        }
        __syncthreads();
        float av[16], bv[16]; float Ap = 1.f, Bp = 0.f;
#pragma unroll
        for (int k = 0; k < 16; ++k) { const int p = sg * 16 + k, t = d == 0 ? p : 127 - p; av[k] = AA[t * 65 + sc]; bv[k] = BB[t * 65 + sc]; Bp = av[k] * Bp + bv[k]; Ap = av[k] * Ap; }
        SEG[sg * 64 + sc] = Ap; SEG[512 + sg * 64 + sc] = Bp;
        __syncthreads();
        float h = HC[par * 64 + sc];
        for (int s2 = 0; s2 < sg; ++s2) h = SEG[s2 * 64 + sc] * h + SEG[512 + s2 * 64 + sc];
        {
            const int tfirst = d == 0 ? sg * 16 : 127 - sg * 16;
            bf16_t* op = Og + (size_t)(t0 + tfirst) * KOUT + sc;
            const int ostep = d == 0 ? KOUT : -KOUT;
#pragma unroll
            for (int k = 0; k < 16; ++k) { h = av[k] * h + bv[k];
                if (!isctx) { const float gz = __uint_as_float((unsigned)zv[k] << 16); *op = f2bf(h * gz); op += ostep; } }
        }
        LRU_SPREAD(pre, sl1_, t01_);
        if (sg == 7) HC[(par ^ 1) * 64 + sc] = h;
        par ^= 1;
        __syncthreads();
    }
}

#ifndef LRU_REPS
#define LRU_REPS 1
#endif
__device__ void phase_mixer(const Args& a, char* lds, int vb, int nb) {
#pragma unroll 1
    for (int it = vb; it < 256; it += nb) { for (int rep_ = 0; rep_ < LRU_REPS; ++rep_) { lru_item(a, lds, it >> 4, (it >> 1) & 7, it & 1); __syncthreads(); } }
#pragma unroll 1
    for (int at = vb; at < 1024; at += nb) { const int bk = at >> 5, w = at & 31; attn_item(a, lds, bk >> 1, (bk & 1) * 4 + (w >> 3), w & 7); __syncthreads(); }
}

__device__ void phase_outproj(const Args& a, char* lds, int vb, int nb) {
    const int tid = threadIdx.x, lane = tid & 63, wid = tid >> 6, wr = wid >> 2, wc = wid & 3, fr = lane & 15, fq = lane >> 4;
    const bf16_t* A2 = (const bf16_t*)(a.ws + WS_A2); const bf16_t* WO = (const bf16_t*)(a.ws + WS_WOUT);
    bf16_t* MIX = (bf16_t*)(a.ws + WS_MIX);
#pragma unroll 1
    for (int it = vb; it < 128 * 4; it += nb) {
        const int tt = it >> 2, ft = it & 3;
        f32x4 acc[2][2][4][2];
        g8::core(acc, WO, A2, ft * 256, tt * 256, KOUT, lds);
#pragma unroll
        for (int bj = 0; bj < 2; ++bj)
#pragma unroll
            for (int n = 0; n < 2; ++n) {
                bf16_t* rp = MIX + (size_t)(tt * 256 + bj * 128 + wc * 32 + n * 16 + fr) * DM + ft * 256 + wr * 64 + fq * 4;
#pragma unroll
                for (int ai = 0; ai < 2; ++ai)
#pragma unroll
                    for (int m = 0; m < 4; ++m) { const f32x4 v = acc[ai][bj][m][n]; *(u32x2*)(rp + ai * 128 + m * 16) = (u32x2){pk2(v[0], v[1]), pk2(v[2], v[3])}; }
            }
        __syncthreads();
    }
}

__device__ void phase_rowpass(const Args& a, int vb, int nb) {
    const int tid = threadIdx.x, lane = tid & 63, wid = tid >> 6;
    const float* mod = (const float*)(a.ws + WS_MOD);
    const bf16_t* MIX = (const bf16_t*)(a.ws + WS_MIX);
    bf16_t* HX = (bf16_t*)(a.ws + WS_HX2); bf16_t* XM = (bf16_t*)(a.ws + WS_XM);
    const int chunk = (NTOK + nb - 1) / nb, rend = min(NTOK, (vb + 1) * chunk);
    f32x4 G1[4], A2[4], B2[4]; int cur = -1;
    u32x2 mwn[4]; f32x4 xvn[4];
    {
        const int r0 = min(vb * chunk + wid, NTOK - 1);
#pragma unroll
        for (int i = 0; i < 4; ++i) { mwn[i] = *(const u32x2*)(MIX + (size_t)r0 * DM + i * 256 + lane * 4); xvn[i] = *(const f32x4*)(a.in[I_X] + (size_t)r0 * DM + i * 256 + lane * 4); }
    }
    for (int row = vb * chunk + wid; row < rend; row += 8) {
        const int b = row >> 11;
        f32x4 mv[4], xv[4]; float ss = 0.f;
#pragma unroll
        for (int i = 0; i < 4; ++i) { const u32x2 mw = mwn[i]; mv[i] = (f32x4){bflo(mw[0]), bfhi(mw[0]), bflo(mw[1]), bfhi(mw[1])}; xv[i] = xvn[i]; }
        {
            const int rn = min(row + 8, NTOK - 1);
#pragma unroll
            for (int i = 0; i < 4; ++i) { mwn[i] = *(const u32x2*)(MIX + (size_t)rn * DM + i * 256 + lane * 4); xvn[i] = *(const f32x4*)(a.in[I_X] + (size_t)rn * DM + i * 256 + lane * 4); }
        }
        if (b != cur) { cur = b; const float* mrow = mod + (size_t)b * 6144;
#pragma unroll
            for (int i = 0; i < 4; ++i) { const int c = i * 256 + lane * 4;
                const f32x4 gp = *(const f32x4*)(a.in[I_GPOSTMIX] + c), g1 = *(const f32x4*)(mrow + 2048 + c), gf = *(const f32x4*)(a.in[I_GPREFFN] + c), sc = *(const f32x4*)(mrow + 4096 + c);
                B2[i] = *(const f32x4*)(mrow + 3072 + c);
#pragma unroll
                for (int j = 0; j < 4; ++j) { G1[i][j] = g1[j] * gp[j]; A2[i][j] = gf[j] * (1.f + sc[j]); } } }
#pragma unroll
        for (int i = 0; i < 4; ++i) ss += mv[i][0] * mv[i][0] + mv[i][1] * mv[i][1] + mv[i][2] * mv[i][2] + mv[i][3] * mv[i][3];
        ss = wave_sum(ss);
        const float rinv = rsqrtf(ss * (1.f / DM) + EPS);
        float s2 = 0.f;
#pragma unroll
        for (int i = 0; i < 4; ++i) { const int c = i * 256 + lane * 4;
#pragma unroll
            for (int j = 0; j < 4; ++j) { const float xm = xv[i][j] + G1[i][j] * (mv[i][j] * rinv); xv[i][j] = xm; s2 += xm * xm; }
            const u32x2 xw = {pk2(xv[i][0], xv[i][1]), pk2(xv[i][2], xv[i][3])}; *(u32x2*)(XM + (size_t)row * DM + c) = xw; }
        s2 = wave_sum(s2);
        const float rinv2 = rsqrtf(s2 * (1.f / DM) + EPS);
#pragma unroll
        for (int i = 0; i < 4; ++i) { const int c = i * 256 + lane * 4;
            float o[4];
#pragma unroll
            for (int j = 0; j < 4; ++j) o[j] = xv[i][j] * rinv2 * A2[i][j] + B2[i][j];
            u32x2 w = {pk2(o[0], o[1]), pk2(o[2], o[3])}; *(u32x2*)(HX + (size_t)row * DM + c) = w; }
    }
}

__device__ __forceinline__ int fkey(float f) { const int b = __float_as_int(f); return b ^ ((b >> 31) & 0x7fffffff); }
__device__ __forceinline__ float fval(int k) { return __int_as_float(k ^ ((k >> 31) & 0x7fffffff)); }
#define CE_DESC(x, y) do { const int hi_ = max((x), (y)), lo_ = min((x), (y)); (x) = hi_; (y) = lo_; } while (0)
__device__ __forceinline__ void sort16_desc(int (&v)[16]) {
#pragma unroll
    for (int k = 2; k <= 16; k <<= 1)
#pragma unroll
        for (int j = k >> 1; j > 0; j >>= 1)
#pragma unroll
            for (int i = 0; i < 16; ++i) { const int l = i ^ j; if (l > i) { if ((i & k) == 0) { CE_DESC(v[i], v[l]); } else { CE_DESC(v[l], v[i]); } } }
}
__device__ __forceinline__ void merge16_desc(int (&v)[16]) {
#pragma unroll
    for (int j = 8; j > 0; j >>= 1)
#pragma unroll
        for (int i = 0; i < 16; ++i) { const int l = i ^ j; if (l > i) CE_DESC(v[i], v[l]); }
}
__device__ __forceinline__ void top16_merge(int (&A)[16], const int (&B)[16]) {
#pragma unroll
    for (int i = 0; i < 16; ++i) A[i] = max(A[i], B[15 - i]);
    merge16_desc(A);
}
constexpr int PK_QS = 0;
constexpr int PK_SK = 256 * E_PITCH;
constexpr int PK_ML = PK_SK + 128 * E_PITCH;
constexpr int PK_X  = PK_ML + 32768;
constexpr int PK_END = PK_X + 8192;
__device__ void phase_peer_topk(const Args& a, char* lds, int vb, int nb) {
    unsigned char* ws = a.ws;
    const bf16_t* HX = (const bf16_t*)(ws + WS_HX2); const bf16_t* WQ = (const bf16_t*)(ws + WS_WQ); const bf16_t* SUBK = (const bf16_t*)(ws + WS_SUBK);
    int* IDX = (int*)(ws + WS_IDX);
    int* ML = (int*)(lds + PK_ML); int* XB = (int*)(lds + PK_X);
    for (int it = vb; it < 128 * 8; it += nb) {
        const int rt = it >> 3, h = it & 7, row0 = rt * 256;
        bf16_t* park = (bf16_t*)(ws + WS_MIX) + (size_t)it * (256 * 128);
        int tid = threadIdx.x;
        {
            f32x4 acc8[2][2][4][2];
            g8::core(acc8, WQ, HX, h * 256, row0, DM, lds);
            __syncthreads();
            asm volatile("" : "+v"(tid));
            const int lane = tid & 63, wid = tid >> 6;
            const int w8r = wid >> 2, w8c = wid & 3, fr = lane & 15, fq = lane >> 4;
#pragma unroll
            for (int bj = 0; bj < 2; ++bj)
#pragma unroll
                for (int m = 0; m < 4; ++m)
#pragma unroll
                    for (int n = 0; n < 2; ++n) { const int tok = bj * 128 + w8c * 32 + n * 16 + fr, d = w8r * 64 + m * 16 + fq * 4;
                        const f32x4 v0 = acc8[0][bj][m][n], v1 = acc8[1][bj][m][n];
                        *(u32x2*)(lds + PK_QS + tok * E_PITCH + d * 2) = (u32x2){pk2(v0[0], v0[1]), pk2(v0[2], v0[3])};
                        *(u32x2*)(park + tok * 128 + d) = (u32x2){pk2(v1[0], v1[1]), pk2(v1[2], v1[3])}; }
        }
        const int lane = tid & 63, wid = tid >> 6, wm = wid & 3, wn = wid >> 2, r32 = lane & 31, hi = lane >> 5;
#pragma unroll 1
        for (int p = 0; p < 2; ++p) {
            f32x16 acc[2][2];
            if (p == 1) {
#pragma unroll
                for (int i = 0; i < 8; ++i) { const int c = tid + NTHR * i, tok = c >> 4, ch = c & 15; *(u32x4*)(lds + PK_QS + tok * E_PITCH + ch * 16) = *(const u32x4*)(park + tok * 128 + ch * 8); }
            }
            {
                const bf16_t* sk = SUBK + (size_t)(h * 2 + p) * 128 * 128;
#pragma unroll
                for (int i = 0; i < 4; ++i) { const int c = tid + NTHR * i, r = c >> 4, ch = c & 15; *(u32x4*)(lds + PK_SK + r * E_PITCH + ch * 16) = *(const u32x4*)(sk + r * 128 + ch * 8); }
            }
            __syncthreads();
#pragma unroll
            for (int ft = 0; ft < 2; ++ft)
#pragma unroll
                for (int tt = 0; tt < 2; ++tt)
#pragma unroll
                    for (int r = 0; r < 16; ++r) acc[ft][tt][r] = 0.f;
#pragma unroll
            for (int ks = 0; ks < 8; ++ks) {
                const bf16x8 a0 = *(const bf16x8*)(lds + PK_SK + (wn * 64 + r32) * E_PITCH + (ks * 16 + hi * 8) * 2), a1 = *(const bf16x8*)(lds + PK_SK + (wn * 64 + 32 + r32) * E_PITCH + (ks * 16 + hi * 8) * 2);
                const bf16x8 b0 = *(const bf16x8*)(lds + PK_QS + (wm * 64 + r32) * E_PITCH + (ks * 16 + hi * 8) * 2), b1 = *(const bf16x8*)(lds + PK_QS + (wm * 64 + 32 + r32) * E_PITCH + (ks * 16 + hi * 8) * 2);
                acc[0][0] = MFMA(a0, b0, acc[0][0]); acc[0][1] = MFMA(a0, b1, acc[0][1]);
                acc[1][0] = MFMA(a1, b0, acc[1][0]); acc[1][1] = MFMA(a1, b1, acc[1][1]);
            }
#pragma unroll
            for (int tt = 0; tt < 2; ++tt) {
                int A[16], B[16];
#pragma unroll
                for (int r = 0; r < 16; ++r) { const int key = wn * 64 + 8 * (r >> 2) + 4 * hi + (r & 3);
                    A[r] = (fkey(acc[0][tt][r]) & ~127) | key; B[r] = (fkey(acc[1][tt][r]) & ~127) | (key + 32); }
                sort16_desc(A); sort16_desc(B); top16_merge(A, B);
#pragma unroll
                for (int r = 0; r < 16; ++r) { auto rr = __builtin_amdgcn_permlane32_swap((unsigned)A[r], (unsigned)A[r], false, false); B[r] = (int)(hi ? rr[0] : rr[1]); }
                top16_merge(A, B);
                const int tok = wm * 64 + tt * 32 + r32;
                if (wn == 1 && hi == 0) {
#pragma unroll
                    for (int r = 0; r < 16; ++r) XB[(wm * 32 + r32) * 16 + r] = A[r];
                }
                __syncthreads();
                if (wn == 0 && hi == 0) {
#pragma unroll
                    for (int r = 0; r < 16; ++r) B[r] = XB[(wm * 32 + r32) * 16 + r];
                    top16_merge(A, B);
#pragma unroll
                    for (int r = 0; r < 16; ++r) ML[(tok * 2 + p) * 16 + r] = A[r];
                }
                __syncthreads();
            }
        }
        if (tid < 256) {
            const int tok = tid;
            int s1[16], s2[16];
#pragma unroll
            for (int r = 0; r < 16; ++r) { s1[r] = ML[(tok * 2 + 0) * 16 + r]; s2[r] = ML[(tok * 2 + 1) * 16 + r]; }
            float f1[16], f2[16];
#pragma unroll
            for (int r = 0; r < 16; ++r) { f1[r] = fval(s1[r] & ~127); f2[r] = fval(s2[r] & ~127); }
            int G0[16], G1[16], G2[16], G3[16];
#pragma unroll
            for (int bb = 0; bb < 16; ++bb) G0[bb] = (fkey(f1[0] + f2[bb]) & ~255) | (0 * 16 + bb);
#pragma unroll
            for (int bb = 0; bb < 8; ++bb) G1[bb] = (fkey(f1[1] + f2[bb]) & ~255) | (1 * 16 + bb);
#pragma unroll
            for (int bb = 0; bb < 5; ++bb) G1[8 + bb] = (fkey(f1[2] + f2[bb]) & ~255) | (2 * 16 + bb);
#pragma unroll
            for (int bb = 0; bb < 3; ++bb) G1[13 + bb] = (fkey(f1[3] + f2[bb]) & ~255) | (3 * 16 + bb);
            G2[0] = (fkey(f1[3] + f2[3]) & ~255) | (3 * 16 + 3);
#pragma unroll
            for (int bb = 0; bb < 3; ++bb) G2[1 + bb] = (fkey(f1[4] + f2[bb]) & ~255) | (4 * 16 + bb);
#pragma unroll
            for (int aa = 5; aa < 8; ++aa)
#pragma unroll
                for (int bb = 0; bb < 2; ++bb) G2[4 + (aa - 5) * 2 + bb] = (fkey(f1[aa] + f2[bb]) & ~255) | (aa * 16 + bb);
#pragma unroll
            for (int aa = 8; aa < 14; ++aa) G2[10 + (aa - 8)] = (fkey(f1[aa] + f2[0]) & ~255) | (aa * 16);
            G3[0] = (fkey(f1[14] + f2[0]) & ~255) | (14 * 16); G3[1] = (fkey(f1[15] + f2[0]) & ~255) | (15 * 16);
#pragma unroll
            for (int r = 2; r < 16; ++r) G3[r] = (int)0x80000000;
            sort16_desc(G0); sort16_desc(G1); sort16_desc(G2); sort16_desc(G3);
            top16_merge(G0, G1); top16_merge(G2, G3); top16_merge(G0, G2);
            float tv[16]; float mx = fval(G0[0] & ~255), sum = 0.f;
#pragma unroll
            for (int r = 0; r < 16; ++r) { tv[r] = __expf(fval(G0[r] & ~255) - mx); sum += tv[r]; }
            const float rs = 1.f / sum;
            const size_t ob = ((size_t)(row0 + tok) * 8 + h) * 16;
#pragma unroll
            for (int r = 0; r < 16; ++r) { const int code = G0[r] & 255, aa = code >> 4, bb = code & 15;
                const int i1 = ML[(tok * 2 + 0) * 16 + aa] & 127, i2 = ML[(tok * 2 + 1) * 16 + bb] & 127;
                IDX[ob + r] = (i1 * 128 + i2) | (int)((unsigned)f2bf(tv[r] * rs) << 16); }
        }
        __syncthreads();
    }
}

template <int CTRL> __device__ __forceinline__ float dpp_add(float v) { return v + __uint_as_float(__builtin_amdgcn_update_dpp(0u, __float_as_uint(v), CTRL, 0xf, 0xf, true)); }
__device__ __forceinline__ float wave_sum_bcast(float p) {
    p = dpp_add<0xB1>(p); p = dpp_add<0x4E>(p); p = dpp_add<0x141>(p); p = dpp_add<0x140>(p);
    const unsigned u = __float_as_uint(p);
    return (__uint_as_float(__builtin_amdgcn_readlane(u, 0)) + __uint_as_float(__builtin_amdgcn_readlane(u, 16))) + (__uint_as_float(__builtin_amdgcn_readlane(u, 32)) + __uint_as_float(__builtin_amdgcn_readlane(u, 48)));
}
typedef float f32x4v __attribute__((ext_vector_type(4)));
constexpr int P7_RS = 9;
constexpr int P7_NR = PEER_N >> P7_RS;
constexpr int P7_HTP = 1024 + 64;
constexpr float H_SCALE = 16.f;
constexpr int P7_ATP = 2048 + 16;
constexpr float W_SCALE = 16.f;
constexpr int P7_RING = 16384;
constexpr int P7_WLDS = P7_RING + 2048;
#ifndef P7_UREP
#define P7_UREP 1
#endif
#ifndef P7_UD
#define P7_UD 3
#endif
#ifndef P7_VMASK
#define P7_VMASK 16383u
#endif
#ifndef P7_VPROBE
#define P7_VPROBE 0
#endif
template <int MODE>
__device__ __forceinline__ void p7_vsweep(f32x16 (&acc)[8], const unsigned* LIST, const unsigned char* VT, int m32, int kh, unsigned psel, unsigned ntok) {
    constexpr unsigned EM = MODE == 1 ? P7_VMASK : 16383u;
    i32x8 abuf[8];
#pragma unroll
    for (int T = 0; T < 8; ++T)
#pragma unroll
        for (int i = 0; i < 16; ++i) acc[T][i] = 0.f;
    u32x4 c0 = *(const u32x4*)(LIST + kh * 8), c1 = *(const u32x4*)(LIST + kh * 8 + 4);
    {
        unsigned off[8];
#pragma unroll
        for (int j = 0; j < 8; ++j) off[j] = (((j < 4 ? c0[j & 3] : c1[j & 3]) & EM) << 10) + m32 * 4;
#pragma unroll
        for (int T = 0; T < 8; ++T) {
#pragma unroll
            for (int j = 0; j < 8; ++j) abuf[T][j] = *(const int*)(VT + off[j] + T * 128);
            __builtin_amdgcn_sched_barrier(0); }
    }
#pragma unroll 1
    for (int bi = 0; bi < 32; ++bi) {
        const int bn = (bi < 31 ? bi + 1 : 31);
        const u32x4 l0 = *(const u32x4*)(LIST + bn * 16 + kh * 8), l1 = *(const u32x4*)(LIST + bn * 16 + kh * 8 + 4);
        unsigned noff[8];
#pragma unroll
        for (int j = 0; j < 8; ++j) noff[j] = (((j < 4 ? l0[j & 3] : l1[j & 3]) & EM) << 10) + m32 * 4;
        i32x8 bop;
#pragma unroll
        for (int j = 0; j < 8; ++j) { const unsigned e = j < 4 ? c0[j & 3] : c1[j & 3];
            bop[j] = (((e >> 14) & 3u) == ntok) ? (int)__builtin_amdgcn_perm(0u, e, psel) : 0; }
        c0 = l0; c1 = l1;
#pragma unroll
        for (int T = 0; T < 8; ++T) {
            __builtin_amdgcn_sched_barrier(0);
            if (MODE != 2) asm volatile("s_waitcnt vmcnt(24)" ::: "memory");
            if (MODE == 1) { int t_ = abuf[T][0];
#pragma unroll
                for (int j = 1; j < 8; ++j) t_ |= abuf[T][j];
                acc[T][0] = __int_as_float(t_ | bop[0]); }
            else acc[T] = __builtin_amdgcn_mfma_scale_f32_32x32x64_f8f6f4(abuf[T], bop, acc[T], 0, 0, 0, 127, 0, 127);
            if (MODE != 2) {
#pragma unroll
                for (int j = 0; j < 8; ++j) abuf[T][j] = *(const int*)(VT + noff[j] + T * 128); }
        }
        __builtin_amdgcn_sched_barrier(0);
    }
    if (MODE != 0) {
#pragma unroll
        for (int T = 0; T < 8; ++T) asm volatile("" :: "v"(acc[T]));
    }
}
__device__ void phase_peer_gather(const Args& a, char* lds, int vb, int nb) {
    unsigned char* ws = a.ws;
    const bf16_t* HX = (const bf16_t*)(ws + WS_HX2);
    const int* IDX = (const int*)(ws + WS_IDX);
    const float* mod = (const float*)(ws + WS_MOD);
    const unsigned char* UT = ws + WS_UT; const unsigned char* VT = ws + WS_VT;
    const bf16_t* XM = (const bf16_t*)(ws + WS_XM);
#pragma unroll 1
    for (int tb = vb * 32; tb < NTOK; tb += nb * 32) {
        int tid = threadIdx.x; asm volatile("" : "+v"(tid));
        const int lane = tid & 63, wid = tid >> 6, r16 = lane & 15, kg = lane >> 4;
        char* HT = lds + wid * P7_WLDS; unsigned* LIST = (unsigned*)(HT + P7_RING); char* AT = HT;
        const int tok0 = tb + wid * 4;
        {
            int* HIST = (int*)HT; int* CUR = HIST + 128;
            int ee[8];
            const int* ip = IDX + (size_t)tok0 * 128 + lane;
#pragma unroll
            for (int k = 0; k < 4; ++k) { ee[2 * k] = ip[k * 128]; ee[2 * k + 1] = ip[k * 128 + 64]; }
            HIST[lane] = 0; HIST[64 + lane] = 0;
#pragma unroll
            for (int j = 0; j < 8; ++j) atomicAdd(&HIST[(((ee[j] >> P7_RS) & (P7_NR - 1)) << 2) | (j >> 1)], 1);
            const int c0 = HIST[2 * lane], c1 = HIST[2 * lane + 1];
            int inc = c0 + c1;
#pragma unroll
            for (int o = 1; o < 64; o <<= 1) { const int t = __shfl_up(inc, o); if (lane >= o) inc += t; }
            CUR[2 * lane] = inc - c0 - c1; CUR[2 * lane + 1] = inc - c1;
#pragma unroll
            for (int j = 0; j < 8; ++j) { const unsigned w = (unsigned)ee[j]; const int slot = atomicAdd(&CUR[(((w >> P7_RS) & (P7_NR - 1)) << 2) | (j >> 1)], 1);
                LIST[slot] = (w & 16383u) | ((unsigned)(j >> 1) << 14) | ((w >> 16) << 17); }
        }
#pragma unroll 1
        for (int urep = 0; urep < P7_UREP; ++urep) {
        if (urep) asm volatile("s_waitcnt vmcnt(0)" ::: "memory");
        {
            const bf16_t* hp = HX + (size_t)tok0 * DM + lane * 16;
#pragma unroll
            for (int k = 0; k < 4; ++k) { const u32x4 h0 = *(const u32x4*)(hp + k * DM), h1 = *(const u32x4*)(hp + k * DM + 8);
                u32x4 o, ol;
#pragma unroll
                for (int q = 0; q < 4; ++q) { const unsigned wa = q < 2 ? h0[2 * q] : h1[2 * q - 4], wb = q < 2 ? h0[2 * q + 1] : h1[2 * q - 3];
                    const float x0 = bflo(wa) * H_SCALE, x1 = bfhi(wa) * H_SCALE, x2 = bflo(wb) * H_SCALE, x3 = bfhi(wb) * H_SCALE;
                    int w = __builtin_amdgcn_cvt_pk_fp8_f32(sat8(x0), sat8(x1), 0, false); w = __builtin_amdgcn_cvt_pk_fp8_f32(sat8(x2), sat8(x3), w, true); o[q] = (unsigned)w;
                    const float r0 = (x0 - __builtin_amdgcn_cvt_f32_fp8(w, 0)) * 16.f, r1 = (x1 - __builtin_amdgcn_cvt_f32_fp8(w, 1)) * 16.f, r2 = (x2 - __builtin_amdgcn_cvt_f32_fp8(w, 2)) * 16.f, r3 = (x3 - __builtin_amdgcn_cvt_f32_fp8(w, 3)) * 16.f;
                    int wl = __builtin_amdgcn_cvt_pk_fp8_f32(sat8(r0), sat8(r1), 0, false); wl = __builtin_amdgcn_cvt_pk_fp8_f32(sat8(r2), sat8(r3), wl, true); ol[q] = (unsigned)wl; }
                *(u32x4*)(HT + (2 * k) * P7_HTP + lane * 16) = o; *(u32x4*)(HT + (2 * k + 1) * P7_HTP + lane * 16) = ol;
            }
        }
        {
            i32x8 hb[8];
            {
                const char* hp = HT + (2 * (lane & 3) + ((lane >> 2) & 1)) * P7_HTP + kg * 32;
#pragma unroll
                for (int kc = 0; kc < 8; ++kc) { const i32x4 x0 = *(const i32x4*)(hp + kc * 128), x1 = *(const i32x4*)(hp + kc * 128 + 16);
                    hb[kc] = __builtin_shufflevector(x0, x1, 0, 1, 2, 3, 4, 5, 6, 7); }
            }
            unsigned entv = LIST[r16];
            asm volatile("s_waitcnt lgkmcnt(0)" ::: "memory");
            LAS unsigned char* ring = (LAS unsigned char*)lds + __builtin_amdgcn_readfirstlane(wid) * P7_WLDS;
#define U_DMA(slot, gp) do { __builtin_amdgcn_global_load_lds((const unsigned*)(gp), (LAS unsigned*)(ring + (slot) * 2048), 16, 0, 0); } while (0)
            const int lrow = lane >> 3;
            const unsigned swz = (unsigned)(((lane & 7) ^ (((lrow >> 1) & 3) << 1)) << 4);
            unsigned olo = (((unsigned)__shfl((int)entv, lrow) & 16383u) << 10) + swz, ohi = (((unsigned)__shfl((int)entv, 8 + lrow) & 16383u) << 10) + swz;
#pragma unroll
            for (int st = 0; st < P7_UD; ++st) { U_DMA(st, UT + olo + st * 128); __builtin_amdgcn_global_load_lds((const unsigned*)(UT + ohi + st * 128), (LAS unsigned*)(ring + st * 2048 + 1024), 16, 0, 0); }
            const int ard = (r16 >> 3) * 1024 + (r16 & 7) * 128 + ((kg ^ ((r16 >> 1) & 3)) << 5);
            const float pscl = (lane & 8) ? 0.f : ((lane & 4) ? 1.f / 16.f : 1.f);
            asm volatile("s_waitcnt vmcnt(%0)" :: "n"(2 * P7_UD - 2) : "memory");
            i32x4 a0 = *(const LAS i32x4*)(ring + ard), a1 = *(const LAS i32x4*)(ring + ard + 16);
#pragma unroll 1
            for (int bi = 0; bi < 32; ++bi) {
                const unsigned entn = LIST[(bi < 31 ? bi + 1 : 31) * 16 + r16];
                const unsigned nlo = (((unsigned)__shfl((int)entn, lrow) & 16383u) << 10) + swz, nhi = (((unsigned)__shfl((int)entn, 8 + lrow) & 16383u) << 10) + swz;
                f32x4v D = {0.f, 0.f, 0.f, 0.f};
#pragma unroll
                for (int kc = 0; kc < 8; ++kc) {
                    asm volatile("" ::: "memory");
                    {
                        const unsigned glo = (kc + P7_UD < 8 ? olo : nlo) + ((kc + P7_UD) & 7) * 128, ghi = (kc + P7_UD < 8 ? ohi : nhi) + ((kc + P7_UD) & 7) * 128;
                        __builtin_amdgcn_global_load_lds((const unsigned*)(UT + glo), (LAS unsigned*)(ring + ((kc + P7_UD) & 7) * 2048), 16, 0, 0);
                        __builtin_amdgcn_global_load_lds((const unsigned*)(UT + ghi), (LAS unsigned*)(ring + ((kc + P7_UD) & 7) * 2048 + 1024), 16, 0, 0);
                    }
                    asm volatile("s_waitcnt vmcnt(%0)" :: "n"(2 * P7_UD - 2) : "memory");
                    const i32x4 n0 = *(const LAS i32x4*)(ring + ((kc + 1) & 7) * 2048 + ard), n1 = *(const LAS i32x4*)(ring + ((kc + 1) & 7) * 2048 + ard + 16);
                    D = __builtin_amdgcn_mfma_scale_f32_16x16x128_f8f6f4(__builtin_shufflevector(a0, a1, 0, 1, 2, 3, 4, 5, 6, 7), hb[kc], D, 0, 0, 0, 127, 0, 127);
                    a0 = n0; a1 = n1;
                }
                olo = nlo; ohi = nhi;
                float dsel = 0.f; unsigned esel = 0u;
#pragma unroll
                for (int i = 0; i < 4; ++i) {
                    const unsigned er = (unsigned)__shfl((int)entv, 4 * kg + i);
                    float m = (((er >> 14) & 3u) == (unsigned)(lane & 3)) ? D[i] * pscl : 0.f;
                    m = dpp_add<0xB1>(m); m = dpp_add<0x4E>(m); m = dpp_add<0x104>(m);
                    const bool pick = (lane & 3) == i; dsel = pick ? m : dsel; esel = pick ? er : esel;
                }
                if ((lane & 12) == 0) {
                    const float w = __uint_as_float((esel >> 17) << 16) * gelu_tanh(dsel * (1.f / (T_SCALE * H_SCALE))) * W_SCALE;
                    const int p0 = __builtin_amdgcn_cvt_pk_fp8_f32(sat8(w), 0.f, 0, false);
                    const float hf = __builtin_amdgcn_cvt_f32_fp8(p0, 0);
                    const int p1 = __builtin_amdgcn_cvt_pk_fp8_f32(sat8((w - hf) * 16.f), 0.f, 0, false);
                    LIST[bi * 16 + 4 * kg + (lane & 3)] = (esel & 0xffffu) | (((unsigned)p0 & 0xffu) << 16) | (((unsigned)p1 & 0xffu) << 24); }
                entv = entn;
            }
        }
        }
        {
            const int m32 = lane & 31, kh = lane >> 5, ntok = m32 >> 3, npart = (m32 >> 2) & 1, nc = m32 & 3;
            const unsigned psel = (0x0c0c0c0cu & ~(0xffu << (8 * nc))) | ((unsigned)(2 + npart) << (8 * nc));
            f32x16 acc[8];
#if P7_VPROBE
            p7_vsweep<P7_VPROBE>(acc, LIST, VT, m32, kh, psel, (unsigned)ntok);
#endif
            p7_vsweep<0>(acc, LIST, VT, m32, kh, psel, (unsigned)ntok);
            const float psc = npart ? V_SCALE / (W_SCALE * T_SCALE * 16.f) : V_SCALE / (W_SCALE * T_SCALE);
            char* arow = AT + ntok * P7_ATP + (16 * kh + nc) * 2;
#pragma unroll
            for (int T = 0; T < 8; ++T)
#pragma unroll
                for (int i = 0; i < 16; ++i) {
                    const float v = acc[T][i] * psc;
                    const float tot = (T & 1) ? dpp_add<0x114>(v) : dpp_add<0x104>(v);
                    if ((T & 1) == npart) *(_Float16*)(arow + (128 * T + 4 * ((i & 3) + 8 * (i >> 2))) * 2) = (_Float16)tot;
                }
        }
#pragma unroll
        for (int k = 0; k < 4; ++k) {
            const int tok = tok0 + k;
            float f[16]; float ss = 0.f;
            const u32x4 e0 = *(const u32x4*)(AT + k * P7_ATP + lane * 32), e1 = *(const u32x4*)(AT + k * P7_ATP + lane * 32 + 16);
#pragma unroll
            for (int i = 0; i < 8; ++i) { const unsigned cw = i < 4 ? e0[i] : e1[i - 4]; const h16x2 hv = as_h2(cw);
                f[2 * i] = (float)hv[0] * (1.f / V_SCALE); f[2 * i + 1] = (float)hv[1] * (1.f / V_SCALE); ss += f[2 * i] * f[2 * i] + f[2 * i + 1] * f[2 * i + 1]; }
            ss = wave_sum_bcast(ss);
            const float rinv = rsqrtf(ss * (1.f / DM) + EPS);
            const float* g2 = mod + (size_t)(tok >> 11) * 6144 + 5120;
            const u32x4 xa = *(const u32x4*)(XM + (size_t)tok * DM + lane * 16), xb = *(const u32x4*)(XM + (size_t)tok * DM + lane * 16 + 8);
#pragma unroll
            for (int q4 = 0; q4 < 4; ++q4) {
                const int c = lane * 16 + q4 * 4;
                const unsigned x01 = q4 < 2 ? xa[2 * q4] : xb[2 * q4 - 4], x23 = q4 < 2 ? xa[2 * q4 + 1] : xb[2 * q4 - 3];
                const f32x4 xm = {bflo(x01), bfhi(x01), bflo(x23), bfhi(x23)}, g2v = *(const f32x4*)(g2 + c), gp = *(const f32x4*)(a.in[I_GPOSTFFN] + c);
                f32x4 o;
#pragma unroll
                for (int jj = 0; jj < 4; ++jj) o[jj] = xm[jj] + g2v[jj] * (f[q4 * 4 + jj] * rinv * gp[jj]);
                *(f32x4*)(a.out + (size_t)tok * DM + c) = o; }
        }
    }
}

#ifdef DBG_DIGEST
__device__ void phase_digest(const Args& a, int vb, int nb) {
    const bf16_t* A2 = (const bf16_t*)(a.ws + WS_A2);
    const bf16_t* Q = (const bf16_t*)(a.ws + WS_Q); const bf16_t* K = (const bf16_t*)(a.ws + WS_K); const bf16_t* VV = (const bf16_t*)(a.ws + WS_VV);
    const bf16_t* L = (const bf16_t*)(a.ws + WS_L); const bf16_t* ZG = (const bf16_t*)(a.ws + WS_ZG);
    for (size_t e = (size_t)vb * NTHR + threadIdx.x; e < (size_t)NTOK * DM; e += (size_t)nb * NTHR) {
        float v = 0.f;
#if DBG_DIGEST == 3
        const size_t row = e >> 10; const int c = (int)(e & 1023);
        v = bf2f(A2[row * KOUT + c]); if (c < 512) v += bf2f(A2[row * KOUT + 1024 + c]);
#elif DBG_DIGEST == 2
        const size_t h = e % ((size_t)NTOK * 512);
        v = bf2f(Q[h]) + bf2f(ZG[h]) + bf2f(L[e % ((size_t)NB * STOT * 512)]);
        if (e < (size_t)NB * 2 * STOT * 64) v += bf2f(K[e]) + bf2f(VV[e]);
#endif
        a.out[e] = v; }
}
#endif
constexpr int LDS_BYTES = 155648;
constexpr int LDS_BARST = LDS_BYTES - 16;
static_assert(8 * P7_HTP <= P7_RING && 4 * P7_ATP <= P7_RING && 8 * P7_WLDS <= LDS_BARST && PK_END <= LDS_BARST && LR_END <= LDS_BARST && g8::SHM_B <= LDS_BARST && 17 * 1024 * 4 + 17 * 24 * 4 <= LDS_BARST, "LDS budget");
constexpr int N_PHASES = 8;

__global__ void __launch_bounds__(NTHR, 2) mk_fwd(Args a) {
    extern __shared__ __attribute__((aligned(16))) char lds[];
    const int nb = gridDim.x, bx = blockIdx.x;
    const int vb0 = (nb % 8 == 0) ? (bx % 8) * (nb / 8) + bx / 8 : bx;
    XcdBarrier bar; bar.bar = (unsigned*)(a.ws + WS_CTL); bar.x = 0; bar.st = (volatile LAS unsigned*)(LAS char*)(lds + LDS_BARST);
    const bool multi = (a.ph_hi - a.ph_lo) > 1;
    if (multi) {
        if (threadIdx.x < 4) ((volatile LAS unsigned*)(LAS char*)(lds + LDS_BARST))[threadIdx.x] = 0u;
        __syncthreads();
        bar = xcd_barrier_post((unsigned*)(a.ws + WS_CTL), (volatile LAS unsigned*)(LAS char*)(lds + LDS_BARST));
    }
#ifndef P7_PROBE
#define P7_PROBE -1
#endif
#ifndef DBL_PHASE
#define DBL_PHASE 0
#endif
#if DBL_PHASE != 0
#define RUN_PHASE(P, CALL) do { if (a.ph_lo <= (P) && (P) < a.ph_hi) { const int nrep_ = ((a.dbl >> (P)) & 1) ? 2 : 1; for (int rep_ = 0; rep_ < nrep_; ++rep_) { CALL; if ((P) + 1 < a.ph_hi || rep_ + 1 < nrep_) xcd_barrier(bar); } } } while (0)
#else
#define RUN_PHASE(P, CALL) do { if (a.ph_lo <= (P) && (P) < a.ph_hi) { CALL; if ((P) + 1 < a.ph_hi) xcd_barrier(bar); } } while (0)
#endif
#if !defined(ONLY_PHASE) || ONLY_PHASE == 0
    RUN_PHASE(0, phase_prep(a, lds, vb0, nb));
#endif
    int vb = vb0;
    if (multi && a.ph_lo == 0 && a.ph_hi > 1) {
        if (threadIdx.x == 0) { unsigned off = 0; for (unsigned j = 0; j < bar.x; ++j) off += xb_ld(&bar.bar[XB_XCNT(j)]); bar.st[3] = off + bar.st[2]; }
        __syncthreads();
        vb = (int)bar.st[3];
    }
#if !defined(ONLY_PHASE) || ONLY_PHASE == 1
    RUN_PHASE(1, phase_xn(a, vb, nb));
#endif
#if !defined(ONLY_PHASE) || ONLY_PHASE == 2
    RUN_PHASE(2, phase_inproj(a, lds, vb, nb));
#endif
#if (!defined(ONLY_PHASE) || ONLY_PHASE == 3) && !(defined(DBG_DIGEST) && DBG_DIGEST == 2)
    RUN_PHASE(3, phase_mixer(a, lds, vb, nb));
#endif
#ifdef DBG_DIGEST
    if (a.ph_lo <= 4 && 4 < a.ph_hi) phase_digest(a, vb, nb);
    return;
#endif
#if !defined(ONLY_PHASE) || ONLY_PHASE == 4
    RUN_PHASE(4, phase_outproj(a, lds, vb, nb));
#endif
#if !defined(ONLY_PHASE) || ONLY_PHASE == 5
    RUN_PHASE(5, phase_rowpass(a, vb, nb));
#endif
#if !defined(ONLY_PHASE) || ONLY_PHASE == 6
    RUN_PHASE(6, phase_peer_topk(a, lds, vb, nb));
#endif
#if !defined(ONLY_PHASE) || ONLY_PHASE == 7
    RUN_PHASE(7, phase_peer_gather(a, lds, vb, nb));
#endif
}

extern "C" void kernel_launch(void* const* d_in, const int* in_sizes, int n_in, void* d_out, int out_size, void* d_ws, size_t ws_size, hipStream_t stream) {
    static int grid = 0;
    if (grid == 0) {
        if (n_in != 25 || out_size != NTOK * DM || ws_size < WS_END) { fprintf(stderr, "kernel_launch: unexpected shapes (n_in %d, out %d, ws %zu, need %zu)\n", n_in, out_size, ws_size, (size_t)WS_END); grid = -1; return; }
        int dev = 0, cus = 0;
        if (hipGetDevice(&dev) != hipSuccess || hipDeviceGetAttribute(&cus, hipDeviceAttributeMultiprocessorCount, dev) != hipSuccess) { grid = -1; return; }
        if (hipFuncSetAttribute((const void*)mk_fwd, hipFuncAttributeMaxDynamicSharedMemorySize, LDS_BYTES) != hipSuccess) { fprintf(stderr, "kernel_launch: hipFuncSetAttribute failed\n"); grid = -1; return; }
        (void)hipGetLastError();
        grid = cus;
    }
    if (grid < 0) return;
    (void)hipMemsetAsync((char*)d_ws + WS_CTL, 0, CTL_BYTES, stream);
    Args a{};
    for (int i = 0; i < 25; ++i) a.in[i] = (const float*)d_in[i];
    a.out = (float*)d_out; a.ws = (unsigned char*)d_ws; a.dbl = DBL_PHASE; a.probe = P7_PROBE;
#if MK_N_LAUNCHES == 1
    a.ph_lo = 0; a.ph_hi = N_PHASES;
    hipLaunchKernelGGL(mk_fwd, dim3(grid), dim3(NTHR), LDS_BYTES, stream, a);
#else
    for (int ph = 0; ph < N_PHASES; ++ph) { a.ph_lo = ph; a.ph_hi = ph + 1; hipLaunchKernelGGL(mk_fwd, dim3(grid), dim3(NTHR), LDS_BYTES, stream, a); }
#endif
}
```

```cpp
#include <hip/hip_runtime.h>
#include <cstdio>
#include <cstdint>

#ifndef MK_N_LAUNCHES
#define MK_N_LAUNCHES 1
#endif

typedef unsigned short bf16_t;
typedef short bf16x8 __attribute__((ext_vector_type(8)));
typedef float f32x16 __attribute__((ext_vector_type(16)));
typedef float f32x4 __attribute__((ext_vector_type(4)));
typedef float f32x2 __attribute__((ext_vector_type(2)));
typedef unsigned u32x4 __attribute__((ext_vector_type(4)));
typedef unsigned u32x2 __attribute__((ext_vector_type(2)));
typedef int i32x8 __attribute__((ext_vector_type(8)));
typedef int i32x4 __attribute__((ext_vector_type(4)));
#define LAS __attribute__((address_space(3)))

constexpr int DM = 1024, NB = 16, SEQ = 2048, CTX = 256, STOT = SEQ + CTX;
constexpr int NTOK = NB * SEQ;
constexpr int NCTX = NB * CTX;
constexpr int NROWS = NTOK + NCTX;
constexpr int DIN = 1792, DLRU = 512;
constexpr int KOUT = 1536;
constexpr int PEER_N = 16384;
constexpr float EPS = 1e-6f;
constexpr int NTHR = 512;

constexpr size_t al256(size_t x) { return (x + 255) & ~(size_t)255; }
constexpr size_t WS_CTL   = 0;
constexpr size_t CTL_BYTES = 65536;
constexpr size_t WS_MOD   = WS_CTL + CTL_BYTES;
constexpr size_t WS_ROPE  = WS_MOD + al256(17 * 6144 * 4);
constexpr size_t WS_WIN   = WS_ROPE + al256(64 * 16 * 2 * 4);
constexpr size_t WS_WOUT  = WS_WIN + al256((size_t)DIN * DM * 2);
constexpr size_t WS_WQ    = WS_WOUT + al256((size_t)DM * KOUT * 2);
constexpr size_t WS_SUBK  = WS_WQ + al256((size_t)2048 * DM * 2);
constexpr size_t WS_RGW   = WS_SUBK + al256((size_t)8 * 2 * 128 * 128 * 2);
constexpr size_t WS_UT    = WS_RGW + al256((size_t)2 * 8 * 128 * 64 * 2);
constexpr size_t WS_VT    = WS_UT + al256((size_t)PEER_N * DM * 2);
constexpr size_t WS_XN    = WS_VT + al256((size_t)PEER_N * DM * 2);
constexpr size_t WS_Q     = WS_XN + al256((size_t)NROWS * DM * 2);
constexpr size_t WS_K     = WS_Q + al256((size_t)NTOK * 512 * 2);
constexpr size_t WS_VV    = WS_K + al256((size_t)NB * 2 * STOT * 64 * 2);
constexpr size_t WS_L     = WS_VV + al256((size_t)NB * 2 * STOT * 64 * 2);
constexpr size_t WS_ZG    = WS_L + al256((size_t)NB * STOT * DLRU * 2);
constexpr size_t WS_A2    = WS_ZG + al256((size_t)NTOK * DLRU * 2);
constexpr size_t WS_END   = WS_A2 + al256((size_t)NTOK * KOUT * 2);
constexpr size_t WS_MIX   = WS_XN;
constexpr size_t WS_HX2   = WS_A2;
constexpr size_t WS_XM    = WS_Q;
constexpr size_t WS_IDX   = WS_ZG;
constexpr size_t WS_GATE  = WS_ZG + (size_t)NTOK * 128 * 4;
static_assert(WS_MIX + (size_t)NTOK * DM * 4 <= WS_ZG, "MIX overlay must end before ZG");
static_assert(WS_GATE + (size_t)NTOK * 128 * 4 <= WS_A2, "IDX/GATE overlay must end before A2");

typedef __bf16 bf16x2_t __attribute__((ext_vector_type(2)));
__device__ __forceinline__ unsigned pk2(float lo, float hi) { const f32x2 v = {lo, hi}; const bf16x2_t b = __builtin_convertvector(v, bf16x2_t); return __builtin_bit_cast(unsigned, b); }
typedef _Float16 h16x2 __attribute__((ext_vector_type(2)));
constexpr float V_SCALE = 64.f;
constexpr float T_SCALE = 256.f;
#ifndef P7_FP8
#define P7_FP8 1
#endif
__device__ __forceinline__ unsigned pkh2(float lo, float hi) { const h16x2 h = {(_Float16)lo, (_Float16)hi}; return __builtin_bit_cast(unsigned, h); }
__device__ __forceinline__ bf16x2_t as_bf2(unsigned x) { return __builtin_bit_cast(bf16x2_t, x); }
__device__ __forceinline__ h16x2 as_h2(unsigned x) { return __builtin_bit_cast(h16x2, x); }
__device__ __forceinline__ bf16_t f2bf(float f) { return (bf16_t)(pk2(f, 0.f) & 0xffffu); }
__device__ __forceinline__ float bf2f(unsigned h) { return __uint_as_float(h << 16); }
__device__ __forceinline__ float bflo(unsigned w) { return __uint_as_float(w << 16); }
__device__ __forceinline__ float bfhi(unsigned w) { return __uint_as_float(w & 0xffff0000u); }
__device__ __forceinline__ float sat8(float x) { return fminf(fmaxf(x, -448.f), 448.f); }
__device__ __forceinline__ float fast_rcp(float x) { return __builtin_amdgcn_rcpf(x); }
__device__ __forceinline__ float sigmoidf_(float x) { return fast_rcp(1.f + __expf(-x)); }
__device__ __forceinline__ float gelu_tanh(float x) { const float y = 0.7978845608028654f * (x + 0.044715f * x * x * x); return x * fast_rcp(1.f + __expf(-2.f * y)); }
__device__ __forceinline__ float silu_(float x) { return x * sigmoidf_(x); }
__device__ __forceinline__ float wave_sum(float v) {
#pragma unroll
    for (int o = 32; o > 0; o >>= 1) v += __shfl_xor(v, o);
    return v;
}
__device__ __forceinline__ float half_swap_max(float v) { auto rr = __builtin_amdgcn_permlane32_swap(__float_as_uint(v), __float_as_uint(v), false, false); return fmaxf(__uint_as_float(rr[0]), __uint_as_float(rr[1])); }
__device__ __forceinline__ float half_swap_sum(float v) { auto rr = __builtin_amdgcn_permlane32_swap(__float_as_uint(v), __float_as_uint(v), false, false); return __uint_as_float(rr[0]) + __uint_as_float(rr[1]); }
#define MFMA(a, b, c) __builtin_amdgcn_mfma_f32_32x32x16_bf16((a), (b), (c), 0, 0, 0)

#define XB_TMO      128
#define XB_XCNT(j)  (256  + 64 * (j))
#define XB_XSUB(j)  (1280 + 64 * (j))
#define XB_XGEN(j)  (2304 + 64 * (j))
#define XB_TOP      3328
#define XB_TOPGEN   3392
#define XCD_BAR_WORDS 3456
#define XB_SPIN_CAP (1u << 20)
__device__ __forceinline__ unsigned xb_ld(unsigned* p)              { return __hip_atomic_load(p, __ATOMIC_RELAXED, __HIP_MEMORY_SCOPE_AGENT); }
__device__ __forceinline__ unsigned xb_add(unsigned* p, unsigned v) { return __hip_atomic_fetch_add(p, v, __ATOMIC_RELAXED, __HIP_MEMORY_SCOPE_AGENT); }
__device__ __forceinline__ unsigned xb_xcc_id() { return (unsigned)__builtin_amdgcn_s_getreg((3 << 11) | 20) & 0xFu; }
#define XB_SPIN(cond, bar) do { unsigned _sp = 0; while (cond) { __builtin_amdgcn_s_sleep(1); \
    if ((++_sp & 255u) == 0u) { if (xb_ld(&(bar)[XB_TMO])) break; if (_sp > XB_SPIN_CAP) { atomicAdd(&(bar)[XB_TMO], 1u); break; } } } } while (0)
struct XcdBarrier { unsigned* bar; unsigned x; volatile LAS unsigned* st; };
__device__ __forceinline__ XcdBarrier xcd_barrier_post(unsigned* bar, volatile LAS unsigned* st) {
    XcdBarrier b; b.bar = bar; b.x = xb_xcc_id(); b.st = st;
    if (threadIdx.x == 0) st[2] = xb_add(&bar[XB_XCNT(b.x)], 1u);
    return b;
}
__device__ __forceinline__ void xcd_barrier_complete(unsigned* bar, unsigned x, unsigned& nloc, unsigned& nx) {
    const unsigned G = gridDim.x * gridDim.y * gridDim.z;
    unsigned sum, cnt, mine, sp = 0u;
    for (;;) {
        sum = 0u; cnt = 0u; mine = 0u;
#pragma unroll
        for (unsigned j = 0; j < 16; ++j) { const unsigned c = xb_ld(&bar[XB_XCNT(j)]); sum += c; cnt += (c > 0u) ? 1u : 0u; mine = (j == x) ? c : mine; }
        if (sum == G) break;
        __builtin_amdgcn_s_sleep(1);
        if ((++sp & 255u) == 0u) { if (xb_ld(&bar[XB_TMO])) break; if (sp > XB_SPIN_CAP) { atomicAdd(&bar[XB_TMO], 1u); break; } }
    }
    nloc = mine > 0u ? mine : 1u; nx = cnt > 0u ? cnt : 1u;
}
__device__ __forceinline__ void xcd_barrier(const XcdBarrier& b) {
    asm volatile("s_waitcnt vmcnt(0)" ::: "memory");
    __syncthreads();
    if (threadIdx.x == 0) {
        unsigned* bar = b.bar;
        __builtin_amdgcn_s_waitcnt(0);
        unsigned nloc = b.st[0], nx = b.st[1];
        if (nloc == 0u) { xcd_barrier_complete(bar, b.x, nloc, nx); b.st[0] = nloc; b.st[1] = nx; }
        const unsigned old = xb_add(&bar[XB_XSUB(b.x)], 1u);
        const unsigned gen = old / nloc;
        if (old + 1u == (gen + 1u) * nloc) {
            __builtin_amdgcn_fence(__ATOMIC_RELEASE, "agent");
            asm volatile("s_waitcnt vmcnt(0)" ::: "memory");
            const unsigned og = xb_add(&bar[XB_TOP], 1u);
            const unsigned tg = og / nx;
            if (og + 1u == (tg + 1u) * nx) xb_add(&bar[XB_TOPGEN], 1u);
            else XB_SPIN(xb_ld(&bar[XB_TOPGEN]) == tg, bar);
            __builtin_amdgcn_fence(__ATOMIC_ACQUIRE, "agent");
            xb_add(&bar[XB_XGEN(b.x)], 1u);
            asm volatile("s_waitcnt vmcnt(0)" ::: "memory");
        } else {
            XB_SPIN(xb_ld(&bar[XB_XGEN(b.x)]) == gen, bar);
            __builtin_amdgcn_fence(__ATOMIC_ACQUIRE, "agent");
            asm volatile("s_waitcnt vmcnt(0)" ::: "memory");
        }
    }
    __syncthreads();
}

struct Args { const float* in[25]; float* out; unsigned char* ws; int ph_lo, ph_hi, dbl, probe; };
enum { I_X = 0, I_C, I_CTX, I_CCTX, I_WMOD, I_BMOD, I_GPREMIX, I_GPOSTMIX, I_GPREFFN, I_GPOSTFFN, I_WIN, I_QNG, I_KNG, I_CONVW, I_CONVB,
       I_RGWA, I_RGBA, I_RGWI, I_RGBI, I_RGLAM, I_WOUT, I_PWQ, I_PSUBK, I_PU, I_PV };

__device__ __forceinline__ void tr_tile(const float* __restrict__ src, int lds_, int sr0, int sc0, bf16_t* __restrict__ dst, int ldd, int dr0, int dc0, float* T) {
    const int tid = threadIdx.x;
#pragma unroll
    for (int i = 0; i < 8; ++i) { const int e = tid + NTHR * i, r = e >> 6, c = e & 63; T[r * 65 + c] = src[(size_t)(sr0 + r) * lds_ + sc0 + c]; }
    __syncthreads();
#pragma unroll
    for (int i = 0; i < 8; ++i) { const int e = tid + NTHR * i, c = e >> 6, r = e & 63; dst[(size_t)(dr0 + c) * ldd + dc0 + r] = f2bf(T[r * 65 + c]); }
    __syncthreads();
}
__device__ __forceinline__ void tr_tile2(const float* __restrict__ srcA, const float* __restrict__ srcB, int lds_, bf16_t* __restrict__ dstA, bf16_t* __restrict__ dstB, int ldd, float* T) {
    const int tid = threadIdx.x;
    float va[8], vb2[8];
#pragma unroll
    for (int i = 0; i < 8; ++i) { const int e = tid + NTHR * i, r = e >> 6, c = e & 63; va[i] = srcA[(size_t)r * lds_ + c]; vb2[i] = srcB[(size_t)r * lds_ + c]; }
#pragma unroll
    for (int i = 0; i < 8; ++i) { const int e = tid + NTHR * i, r = e >> 6, c = e & 63; T[r * 65 + c] = va[i]; T[4160 + r * 65 + c] = vb2[i]; }
    __syncthreads();
#pragma unroll
    for (int i = 0; i < 8; ++i) { const int e = tid + NTHR * i, c = e >> 6, r = e & 63; dstA[(size_t)c * ldd + r] = f2bf(T[r * 65 + c]); dstB[(size_t)c * ldd + r] = f2bf(T[4160 + r * 65 + c]); }
    __syncthreads();
}

constexpr int UV_ITEMS = 512;
constexpr int CTL_UVCTR = 8192;
__device__ __forceinline__ void conv_uv_item(const Args& a, int t) {
    const int tid = threadIdx.x;
    const bool isv = t >= 256; const int tt = t & 255;
    const float* src = (isv ? a.in[I_PV] : a.in[I_PU]) + (size_t)tt * 65536;
    unsigned char* d8 = a.ws + (isv ? WS_VT : WS_UT) + (size_t)tt * 65536;
#pragma unroll 1
    for (int e0 = tid * 16; e0 < 65536; e0 += NTHR * 16 * 4) {
        f32x4 v[4][4];
#pragma unroll
        for (int u = 0; u < 4; ++u)
#pragma unroll
            for (int q = 0; q < 4; ++q) v[u][q] = *(const f32x4*)(src + e0 + u * NTHR * 16 + q * 4);
#pragma unroll
        for (int u = 0; u < 4; ++u) { u32x4 o;
#pragma unroll
            for (int q = 0; q < 4; ++q) { f32x4 x = v[u][q] * T_SCALE;
#pragma unroll
                for (int i = 0; i < 4; ++i) x[i] = fminf(fmaxf(x[i], -448.f), 448.f);
                int w = __builtin_amdgcn_cvt_pk_fp8_f32(x[0], x[1], 0, false); w = __builtin_amdgcn_cvt_pk_fp8_f32(x[2], x[3], w, true); o[q] = (unsigned)w; }
            *(u32x4*)(d8 + e0 + u * NTHR * 16) = o; }
    }
}
__device__ void phase_prep(const Args& a, char* lds, int vb, int nb) {
    const int tid = threadIdx.x;
    unsigned char* ws = a.ws;
    float* S = (float*)lds;
    float* T = (float*)lds;
    constexpr int N_MOD = 256, N_TIN = 224, N_TOUT = 192, N_TWQ = 256, N_RGW = 16, N_SUBK = 16, N_UV = 0, N_MISC = 1;
    constexpr int O_TIN = N_MOD, O_TOUT = O_TIN + N_TIN, O_TWQ = O_TOUT + N_TOUT, O_RGW = O_TWQ + N_TWQ, O_SUBK = O_RGW + N_RGW, O_UV = O_SUBK + N_SUBK, O_MISC = O_UV + N_UV, N_ALL = O_MISC + N_MISC;
    for (int it = vb; it < N_ALL; it += nb) {
        if (it < O_TIN) {
            {
                int tq = tid; asm volatile("" : "+v"(tq));
                const float* cp = a.in[I_C] + tq; const float* xp = a.in[I_CCTX] + tq;
                float cv[17];
#pragma unroll
                for (int i = 0; i < 17; ++i) cv[i] = cp[NTHR * i];
#pragma unroll
                for (int i = 0; i < 17; ++i) S[tid + NTHR * i] = silu_(cv[i]);
#pragma unroll
                for (int i = 0; i < 15; ++i) cv[i] = cp[NTHR * (17 + i)];
                cv[15] = xp[0]; cv[16] = xp[NTHR];
#pragma unroll
                for (int i = 0; i < 17; ++i) S[tid + NTHR * (17 + i)] = silu_(cv[i]);
            }
            __syncthreads();
            const int n0 = it * 24;
            const int cc = tid % 6, kk = tid / 6;
            float acc[17][4];
#pragma unroll
            for (int r = 0; r < 17; ++r) { acc[r][0] = 0.f; acc[r][1] = 0.f; acc[r][2] = 0.f; acc[r][3] = 0.f; }
            if (tid < 510) {
#pragma unroll 1
                for (int i0 = 0; i0 < 16; i0 += 4) {
                    f32x4 wv[4];
#pragma unroll
                    for (int i = 0; i < 4; ++i) { const int k = min(kk + 85 * (i0 + i), 1023); wv[i] = *(const f32x4*)(a.in[I_WMOD] + (size_t)k * 6144 + n0 + cc * 4); }
#pragma unroll
                    for (int i = 0; i < 4; ++i) { const int k = kk + 85 * (i0 + i); const bool ok = k < 1024; const int kc = min(k, 1023);
                        const f32x4 w = ok ? wv[i] : (f32x4){0.f, 0.f, 0.f, 0.f};
#pragma unroll
                        for (int r = 0; r < 17; ++r) { const float s = S[r * 1024 + kc]; acc[r][0] += s * w[0]; acc[r][1] += s * w[1]; acc[r][2] += s * w[2]; acc[r][3] += s * w[3]; }
                    }
                }
            }
            __syncthreads();
            if (tid < 510) {
#pragma unroll
                for (int r = 0; r < 17; ++r) { f32x4 v = {acc[r][0], acc[r][1], acc[r][2], acc[r][3]}; *(f32x4*)(S + (kk * 17 + r) * 24 + cc * 4) = v; }
            }
            __syncthreads();
            float* mod = (float*)(ws + WS_MOD);
            for (int e = tid; e < 17 * 24; e += NTHR) { const int r = e / 24, j = e % 24; float sum = 0.f;
                for (int q = 0; q < 85; ++q) sum += S[(q * 17 + r) * 24 + j];
                mod[r * 6144 + n0 + j] = sum + a.in[I_BMOD][n0 + j]; }
            __syncthreads();
        } else if (it < O_TOUT) {
            const int t = it - O_TIN, kt = t / 14, nt = (t % 14) * 2;
            const float* sp = a.in[I_WIN] + (size_t)(kt * 64) * DIN + nt * 64; bf16_t* dp = (bf16_t*)(ws + WS_WIN) + (size_t)(nt * 64) * DM + kt * 64;
            tr_tile2(sp, sp + 64, DIN, dp, dp + (size_t)64 * DM, DM, T);
        } else if (it < O_TWQ) {
            const int t = it - O_TOUT, kt = t / 8, nt = (t % 8) * 2;
            const int sk = (kt < 16) ? kt * 64 : (kt - 16) * 64 + 512;
            const float* sp = a.in[I_WOUT] + (size_t)sk * DM + nt * 64; bf16_t* dp = (bf16_t*)(ws + WS_WOUT) + (size_t)(nt * 64) * KOUT + kt * 64;
            tr_tile2(sp, sp + 64, DM, dp, dp + (size_t)64 * KOUT, KOUT, T);
        } else if (it < O_RGW) {
            const int t = it - O_TWQ, kt = t / 16, nt = (t % 16) * 2;
            const float* sp = a.in[I_PWQ] + (size_t)(kt * 64) * 2048 + nt * 64; bf16_t* dp = (bf16_t*)(ws + WS_WQ) + (size_t)(nt * 64) * DM + kt * 64;
            tr_tile2(sp, sp + 64, 2048, dp, dp + (size_t)64 * DM, DM, T);
        } else if (it < O_SUBK) {
            const int dn = it - O_RGW;
            bf16_t* dp = (bf16_t*)(ws + WS_RGW) + (size_t)dn * 128 * 64;
            tr_tile2(a.in[I_RGWA] + (size_t)dn * 4096, a.in[I_RGWI] + (size_t)dn * 4096, 64, dp, dp + 64 * 64, 64, T);
        } else if (it < O_UV) {
            const int t = it - O_SUBK; const float* src = a.in[I_PSUBK] + (size_t)t * 16384; bf16_t* dst = (bf16_t*)(ws + WS_SUBK) + (size_t)t * 16384;
            for (int e = tid * 4; e < 16384; e += NTHR * 4) { const f32x4 v = *(const f32x4*)(src + e); u32x2 o = {pk2(v[0], v[1]), pk2(v[2], v[3])}; *(u32x2*)(dst + e) = o; }
        } else {
            float* rope = (float*)(ws + WS_ROPE);
            for (int e = tid; e < 64 * 16; e += NTHR) { const int pos = e >> 4, f = e & 15; const float inv = powf(10000.f, -(float)f / 16.f); const float ang = (float)pos * inv; rope[e * 2] = cosf(ang); rope[e * 2 + 1] = sinf(ang); }
        }
    }
}

__device__ void phase_xn(const Args& a, int vb, int nb) {
    const int tid = threadIdx.x, lane = tid & 63, wid = tid >> 6;
    const float* mod = (const float*)(a.ws + WS_MOD);
    bf16_t* XN = (bf16_t*)(a.ws + WS_XN);
    const float* g = a.in[I_GPREMIX];
    const int chunk = (NROWS + nb - 1) / nb, rend = min(NROWS, (vb + 1) * chunk);
    f32x4 A[4], B[4]; int cur = -1;
    for (int row = vb * chunk + wid; row < rend; row += 8) {
        const float* src; int mrow;
        if (row < NTOK) { src = a.in[I_X] + (size_t)row * DM; mrow = row >> 11; } else { src = a.in[I_CTX] + (size_t)(row - NTOK) * DM; mrow = 16; }
        f32x4 v[4]; float ss = 0.f;
#pragma unroll
        for (int i = 0; i < 4; ++i) v[i] = *(const f32x4*)(src + i * 256 + lane * 4);
        if (mrow != cur) { cur = mrow; const float* sh = mod + (size_t)mrow * 6144, *sc = sh + 1024;
#pragma unroll
            for (int i = 0; i < 4; ++i) { const int c = i * 256 + lane * 4; const f32x4 gg = *(const f32x4*)(g + c), s1 = *(const f32x4*)(sc + c); B[i] = *(const f32x4*)(sh + c);
#pragma unroll
                for (int j = 0; j < 4; ++j) A[i][j] = gg[j] * (1.f + s1[j]); } }
#pragma unroll
        for (int i = 0; i < 4; ++i) ss += v[i][0] * v[i][0] + v[i][1] * v[i][1] + v[i][2] * v[i][2] + v[i][3] * v[i][3];
        ss = wave_sum(ss);
        const float rinv = rsqrtf(ss * (1.f / DM) + EPS);
#pragma unroll
        for (int i = 0; i < 4; ++i) { const int c = i * 256 + lane * 4;
            float o[4];
#pragma unroll
            for (int j = 0; j < 4; ++j) o[j] = v[i][j] * rinv * A[i][j] + B[i][j];
            u32x2 w = {pk2(o[0], o[1]), pk2(o[2], o[3])}; *(u32x2*)(XN + (size_t)row * DM + c) = w; }
    }
}

constexpr int E_PITCH = 272;
namespace g8 {
constexpr int BM = 256, BK = 64, HALF = 128, HT = HALF * BK, SHM_B = 8 * HT * 2;
__device__ __forceinline__ int lds_byte(int r, int c) { const int st = (r >> 4) * 2 + (c >> 5), rr = r & 15, cc = c & 31, ob = rr * 64 + cc * 2; return st * 1024 + (ob ^ (((ob >> 9) & 1) << 5)); }
__device__ __forceinline__ void stage_rc(int b, int& R, int& C) { const int st = b / 1024, sb = b % 1024, swz = sb ^ (((sb >> 9) & 1) << 5); R = (st >> 1) * 16 + swz / 64; C = (st & 1) * 32 + (swz % 64) / 2; }
__device__ __forceinline__ void core_pre(const bf16_t* __restrict__ A, const bf16_t* __restrict__ Bt, int brow, int bcol, int K, char* lds_) {
    LAS unsigned char* lds = (LAS unsigned char*)lds_;
    const int tid = threadIdx.x, wid = __builtin_amdgcn_readfirstlane(tid >> 6);
    constexpr int HTB = HT * 2;
    unsigned voff[2];
#pragma unroll
    for (int i = 0; i < 2; ++i) { int R, C; stage_rc(tid * 16 + i * 8192, R, C); voff[i] = (unsigned)(R * K + C) * 2u; }
    const size_t hstep = (size_t)HALF * K * 2;
    const unsigned ldsw = (unsigned)wid * 1024u;
    const char* cA = (const char*)(A + (size_t)brow * K); const char* cB = (const char*)(Bt + (size_t)bcol * K);
#define G8P_STAGE(bufoff, gbase) do { _Pragma("unroll") for (int _i = 0; _i < 2; ++_i) \
        __builtin_amdgcn_global_load_lds((const unsigned*)((const char*)(gbase) + voff[_i]), (LAS unsigned*)(lds + (bufoff) + ldsw + _i * 8192), 16, 0, 0); } while (0)
    G8P_STAGE((4 + 0) * HTB, cB); G8P_STAGE(0 * HTB, cA); G8P_STAGE((4 + 1) * HTB, cB + hstep); G8P_STAGE(1 * HTB, cA + hstep);
#undef G8P_STAGE
}
template <bool PRE = false>
__device__ __forceinline__ void core(f32x4 (&acc)[2][2][4][2], const bf16_t* __restrict__ A, const bf16_t* __restrict__ Bt, int brow, int bcol, int K, char* lds_) {
    LAS unsigned char* lds = (LAS unsigned char*)lds_;
    const int tid = threadIdx.x, wid = __builtin_amdgcn_readfirstlane(tid >> 6), lane = tid & 63, wr = wid >> 2, wc = wid & 3, fr = lane & 15, fq = lane >> 4;
    constexpr int HTB = HT * 2;
    unsigned voff[2];
#pragma unroll
    for (int i = 0; i < 2; ++i) { int R, C; stage_rc(tid * 16 + i * 8192, R, C); voff[i] = (unsigned)(R * K + C) * 2u; }
    const size_t kstep = (size_t)(BK * 2), hstep = (size_t)HALF * K * 2;
    const unsigned ldsw = (unsigned)wid * 1024u;
    const int aoff = lds_byte(wr * 64 + fr, fq * 8), boff = lds_byte(wc * 32 + fr, fq * 8);
#define G8_SA(b, h) (((b) * 2 + (h)) * HTB)
#define G8_SB(b, h) ((4 + (b) * 2 + (h)) * HTB)
#define G8_STAGE(bufoff, gbase) do { _Pragma("unroll") for (int _i = 0; _i < 2; ++_i) \
        __builtin_amdgcn_global_load_lds((const unsigned*)((const char*)(gbase) + voff[_i]), (LAS unsigned*)(lds + (bufoff) + ldsw + _i * 8192), 16, 0, 0); } while (0)
#define G8_LDA(dst, b, h) do { _Pragma("unroll") for (int m = 0; m < 4; ++m) _Pragma("unroll") for (int k = 0; k < 2; ++k) dst[m][k] = *(const LAS bf16x8*)(lds + G8_SA(b, h) + aoff + m * 2048 + k * 1024); } while (0)
#define G8_LDB(dst, b, h) do { _Pragma("unroll") for (int n = 0; n < 2; ++n) _Pragma("unroll") for (int k = 0; k < 2; ++k) dst[n][k] = *(const LAS bf16x8*)(lds + G8_SB(b, h) + boff + n * 2048 + k * 1024); } while (0)
#define G8_MMA(ai, bj, At_, Bt_) do { __builtin_amdgcn_s_setprio(1); \
    _Pragma("unroll") for (int m = 0; m < 4; ++m) _Pragma("unroll") for (int n = 0; n < 2; ++n) _Pragma("unroll") for (int k = 0; k < 2; ++k) \
      acc[ai][bj][m][n] = __builtin_amdgcn_mfma_f32_16x16x32_bf16(At_[m][k], Bt_[n][k], acc[ai][bj][m][n], 0, 0, 0); \
    __builtin_amdgcn_s_setprio(0); } while (0)
#define G8_WAIT_V(n) asm volatile("s_waitcnt vmcnt(" #n ")" ::: "memory")
#define G8_WAIT_L(n) asm volatile("s_waitcnt lgkmcnt(" #n ")" ::: "memory")
#define G8_BAR __builtin_amdgcn_s_barrier()
#define G8_SCHED __builtin_amdgcn_sched_barrier(0)
#pragma unroll
    for (int ai = 0; ai < 2; ++ai)
#pragma unroll
        for (int bj = 0; bj < 2; ++bj)
#pragma unroll
            for (int m = 0; m < 4; ++m)
#pragma unroll
                for (int n = 0; n < 2; ++n) acc[ai][bj][m][n] = (f32x4){0.f, 0.f, 0.f, 0.f};
    bf16x8 At[4][2], B0[2][2], B1[2][2];
    const int nt = K / BK;
    const char* cA = (const char*)(A + (size_t)brow * K); const char* cB = (const char*)(Bt + (size_t)bcol * K);
    if (!PRE) { G8_STAGE(G8_SB(0, 0), cB); G8_STAGE(G8_SA(0, 0), cA); G8_STAGE(G8_SB(0, 1), cB + hstep); G8_STAGE(G8_SA(0, 1), cA + hstep); }
    if (wr == 1) G8_BAR;
    if (PRE) G8_WAIT_V(0); else G8_WAIT_V(4);
    G8_BAR;
    G8_STAGE(G8_SB(1, 0), cB + kstep); G8_STAGE(G8_SA(1, 0), cA + kstep); G8_STAGE(G8_SB(1, 1), cB + hstep + kstep);
    G8_WAIT_V(6); G8_BAR;
#pragma unroll 1
    for (int t = 0; t < nt - 2; t += 2) {
        const char* a1 = cA + (size_t)(t + 1) * kstep; const char* a2 = cA + (size_t)(t + 2) * kstep; const char* b2 = cB + (size_t)(t + 2) * kstep;
        const char* a3 = a2 + kstep; const char* b3 = b2 + kstep;
        G8_LDB(B0, 0, 0); G8_SCHED; G8_LDA(At, 0, 0); G8_STAGE(G8_SA(1, 1), a1 + hstep);
        G8_WAIT_L(8); G8_BAR; G8_WAIT_L(0); G8_MMA(0, 0, At, B0); G8_BAR; G8_SCHED;
        G8_LDB(B1, 0, 1); G8_STAGE(G8_SB(0, 0), b2);
        G8_BAR; G8_WAIT_L(0); G8_MMA(0, 1, At, B1); G8_BAR;
        G8_LDA(At, 0, 1); G8_STAGE(G8_SA(0, 0), a2);
        G8_BAR; G8_WAIT_L(0); G8_MMA(1, 0, At, B0); G8_BAR; G8_SCHED;
        G8_STAGE(G8_SB(0, 1), b2 + hstep);
        G8_WAIT_V(6); G8_BAR; G8_MMA(1, 1, At, B1); G8_BAR;
        G8_LDB(B0, 1, 0); G8_SCHED; G8_LDA(At, 1, 0); G8_STAGE(G8_SA(0, 1), a2 + hstep);
        G8_WAIT_L(8); G8_BAR; G8_WAIT_L(0); G8_MMA(0, 0, At, B0); G8_BAR; G8_SCHED;
        G8_LDB(B1, 1, 1); G8_STAGE(G8_SB(1, 0), b3);
        G8_BAR; G8_WAIT_L(0); G8_MMA(0, 1, At, B1); G8_BAR;
        G8_LDA(At, 1, 1); G8_STAGE(G8_SA(1, 0), a3);
        G8_BAR; G8_WAIT_L(0); G8_MMA(1, 0, At, B0); G8_BAR; G8_SCHED;
        G8_STAGE(G8_SB(1, 1), b3 + hstep);
        G8_WAIT_V(6); G8_BAR; G8_MMA(1, 1, At, B1); G8_BAR;
    }
    { G8_LDB(B0, 0, 0); G8_LDA(At, 0, 0); G8_STAGE(G8_SA(1, 1), cA + (size_t)(nt - 1) * kstep + hstep);
      G8_BAR; G8_WAIT_L(0); G8_MMA(0, 0, At, B0); G8_BAR;
      G8_LDB(B1, 0, 1); G8_BAR; G8_WAIT_L(0); G8_MMA(0, 1, At, B1); G8_BAR;
      G8_LDA(At, 0, 1); G8_WAIT_V(4); G8_BAR; G8_WAIT_L(0); G8_MMA(1, 0, At, B0); G8_MMA(1, 1, At, B1); G8_BAR; }
    { G8_LDB(B0, 1, 0); G8_LDA(At, 1, 0); G8_WAIT_V(2); G8_BAR; G8_WAIT_L(0); G8_MMA(0, 0, At, B0); G8_BAR;
      G8_LDB(B1, 1, 1); G8_WAIT_V(0); G8_BAR; G8_WAIT_L(0); G8_MMA(0, 1, At, B1); G8_BAR;
      G8_LDA(At, 1, 1); G8_BAR; G8_WAIT_L(0); G8_MMA(1, 0, At, B0); G8_MMA(1, 1, At, B1); G8_BAR; }
    if (wr == 0) G8_BAR;
#undef G8_SA
#undef G8_SB
#undef G8_STAGE
#undef G8_LDA
#undef G8_LDB
#undef G8_MMA
#undef G8_WAIT_V
#undef G8_WAIT_L
#undef G8_BAR
#undef G8_SCHED
}
}

__device__ void phase_inproj(const Args& a, char* lds, int vb, int nb) {
    const int tid = threadIdx.x, lane = tid & 63, wid = tid >> 6, wr = wid >> 2, wc = wid & 3, fr = lane & 15, fq = lane >> 4;
    unsigned char* ws = a.ws;
    const bf16_t* XN = (const bf16_t*)(ws + WS_XN);
    const bf16_t* WIN = (const bf16_t*)(ws + WS_WIN);
    const float* rope = (const float*)(ws + WS_ROPE);
    bf16_t* Qo = (bf16_t*)(ws + WS_Q); bf16_t* Ko = (bf16_t*)(ws + WS_K); bf16_t* Vo = (bf16_t*)(ws + WS_VV); bf16_t* Lo = (bf16_t*)(ws + WS_L); bf16_t* Zo = (bf16_t*)(ws + WS_ZG);
    constexpr int N_LAT = 128 * 7, N_ALL = N_LAT + 16 * 3;
#define P2_TILE(it_, tt_, ft_) int tt_, ft_; if ((it_) < N_LAT) { tt_ = (it_) / 7; ft_ = (it_) % 7; } else { const int j_ = (it_) - N_LAT; tt_ = 128 + j_ / 3; ft_ = 2 + j_ % 3; }
    if (vb < N_ALL) { P2_TILE(vb, t0_, f0_); g8::core_pre(WIN, XN, f0_ * 256, t0_ * 256, DM, lds); }
#pragma unroll 1
    for (int it = vb; it < N_ALL; it += nb) {
        P2_TILE(it, tt, ft);
        f32x4 acc[2][2][4][2];
        g8::core<true>(acc, WIN, XN, ft * 256, tt * 256, DM, lds);
        if (it + nb < N_ALL) { P2_TILE(it + nb, t1_, f1_); g8::core_pre(WIN, XN, f1_ * 256, t1_ * 256, DM, lds); }
        const bool lat = tt < 128;
#pragma unroll
        for (int ai = 0; ai < 2; ++ai) {
            const int g64 = ft * 4 + ai * 2 + wr;
            if (g64 < 10) {
                const bool isq = g64 < 8;
                const float* gn = isq ? a.in[I_QNG] : a.in[I_KNG];
                const float osc = isq ? 0.125f * 1.4426950408889634f : 1.f;
                float gnv[4][4];
#pragma unroll
                for (int m = 0; m < 4; ++m) { const f32x4 gv = *(const f32x4*)(gn + m * 16 + fq * 4); gnv[m][0] = gv[0]; gnv[m][1] = gv[1]; gnv[m][2] = gv[2]; gnv[m][3] = gv[3]; }
#pragma unroll
                for (int bj = 0; bj < 2; ++bj)
#pragma unroll
                    for (int n = 0; n < 2; ++n) {
                        float ss = 0.f;
#pragma unroll
                        for (int m = 0; m < 4; ++m)
#pragma unroll
                            for (int j = 0; j < 4; ++j) ss += acc[ai][bj][m][n][j] * acc[ai][bj][m][n][j];
                        ss += __shfl_xor(ss, 16); ss += __shfl_xor(ss, 32);
                        const float rinv = rsqrtf(ss * (1.f / 64.f) + EPS);
                        const int row = tt * 256 + bj * 128 + wc * 32 + n * 16 + fr;
                        int b, t, s_; if (lat) { b = row >> 11; t = row & 2047; s_ = CTX + t; } else { const int rc = row - NTOK; b = rc >> 8; t = 0; s_ = rc & 255; }
                        bf16_t* dst = isq ? Qo + ((size_t)(b * 8 + g64) * SEQ + t) * 64 : Ko + ((size_t)(b * 2 + (g64 - 8)) * STOT + s_) * 64;
                        f32x4 csv[2][2];
#pragma unroll
                        for (int ax = 0; ax < 2; ++ax) { const int pos = ax == 0 ? (t >> 6) : (t & 63); const float* rp = rope + (pos * 16 + fq * 4) * 2;
                            csv[ax][0] = *(const f32x4*)rp; csv[ax][1] = *(const f32x4*)(rp + 4); }
#pragma unroll
                        for (int ax = 0; ax < 2; ++ax) {
                            float o1[4], o2[4];
#pragma unroll
                            for (int j = 0; j < 4; ++j) {
                                const float x1 = acc[ai][bj][2 * ax][n][j] * rinv * gnv[2 * ax][j], x2 = acc[ai][bj][2 * ax + 1][n][j] * rinv * gnv[2 * ax + 1][j];
                                const float co = lat ? csv[ax][j >> 1][(j & 1) * 2] : 1.f, si = lat ? csv[ax][j >> 1][(j & 1) * 2 + 1] : 0.f;
                                const float c1 = x1 * co - x2 * si, c2 = x1 * si + x2 * co;
                                o1[j] = c1 * osc; o2[j] = c2 * osc; }
                            *(u32x2*)(dst + ax * 32 + fq * 4) = (u32x2){pk2(o1[0], o1[1]), pk2(o1[2], o1[3])};
                            *(u32x2*)(dst + ax * 32 + 16 + fq * 4) = (u32x2){pk2(o2[0], o2[1]), pk2(o2[2], o2[3])};
                        }
                    }
            } else if (g64 < 12) {
#pragma unroll
                for (int bj = 0; bj < 2; ++bj)
#pragma unroll
                    for (int n = 0; n < 2; ++n) {
                        const int row = tt * 256 + bj * 128 + wc * 32 + n * 16 + fr;
                        int b, s_; if (lat) { b = row >> 11; s_ = CTX + (row & 2047); } else { const int rc = row - NTOK; b = rc >> 8; s_ = rc & 255; }
                        bf16_t* vp = Vo + ((size_t)(b * 2 + (g64 - 10)) * 64) * STOT + s_;
#pragma unroll
                        for (int m = 0; m < 4; ++m)
#pragma unroll
                            for (int j = 0; j < 4; ++j) vp[(size_t)(m * 16 + fq * 4 + j) * STOT] = f2bf(acc[ai][bj][m][n][j]);
                    }
            } else {
                const bool isz = g64 >= 20;
#pragma unroll
                for (int bj = 0; bj < 2; ++bj)
#pragma unroll
                    for (int n = 0; n < 2; ++n) {
                        const int row = tt * 256 + bj * 128 + wc * 32 + n * 16 + fr;
                        bf16_t* dst;
                        if (isz) dst = Zo + (size_t)row * DLRU + (g64 - 20) * 64;
                        else { int b, s_; if (lat) { b = row >> 11; s_ = CTX + (row & 2047); } else { const int rc = row - NTOK; b = rc >> 8; s_ = rc & 255; }
                            dst = Lo + ((size_t)b * STOT + s_) * DLRU + (g64 - 12) * 64; }
#pragma unroll
                        for (int m = 0; m < 4; ++m) { f32x4 v = acc[ai][bj][m][n];
                            if (isz) { v[0] = gelu_tanh(v[0]); v[1] = gelu_tanh(v[1]); v[2] = gelu_tanh(v[2]); v[3] = gelu_tanh(v[3]); }
                            *(u32x2*)(dst + m * 16 + fq * 4) = (u32x2){pk2(v[0], v[1]), pk2(v[2], v[3])}; }
                    }
            }
        }
        __syncthreads();
    }
    {
        unsigned* ctr = (unsigned*)(ws + WS_CTL) + CTL_UVCTR;
        volatile int* slot = (volatile int*)lds;
        for (;;) {
            if (tid == 0) *slot = (int)__hip_atomic_fetch_add(ctr, 1u, __ATOMIC_RELAXED, __HIP_MEMORY_SCOPE_AGENT);
            __syncthreads();
            const int t = *slot;
            __syncthreads();
            if (t >= UV_ITEMS) break;
            conv_uv_item(a, t);
        }
    }
}

constexpr int AT_KP = 144, AT_VP = 136, AT_STAGE = 64 * AT_KP + 64 * AT_VP;
__device__ void attn_item(const Args& a, char* lds, int b, int head, int qblk) {
    const int tid = threadIdx.x, lane = tid & 63, wid = tid >> 6, r32 = lane & 31, hi = lane >> 5;
    unsigned char* ws = a.ws;
    const int kvh = head >> 2;
    const bf16_t* Qp = (const bf16_t*)(ws + WS_Q) + ((size_t)(b * 8 + head) * SEQ + qblk * 256 + wid * 32 + r32) * 64 + hi * 8;
    const bf16_t* Kp = (const bf16_t*)(ws + WS_K) + (size_t)(b * 2 + kvh) * STOT * 64;
    const bf16_t* Vp = (const bf16_t*)(ws + WS_VV) + (size_t)(b * 2 + kvh) * 64 * STOT;
    bf16x8 qf[4];
#pragma unroll
    for (int ds = 0; ds < 4; ++ds) qf[ds] = *(const bf16x8*)(Qp + ds * 16);
    const int srow = tid >> 3, sch = tid & 7;
    const bf16_t* kg = Kp + (size_t)srow * 64 + sch * 8;
    const bf16_t* vg = Vp + (size_t)srow * STOT + sch * 8;
    u32x4 krA, vrA, krB, vrB;
    f32x16 o[2]; float lsum = 0.f;
    float negM;
    { float gq = fabsf(a.in[I_QNG][lane]), gk = fabsf(a.in[I_KNG][lane]);
#pragma unroll
      for (int o_ = 32; o_ > 0; o_ >>= 1) { gq = fmaxf(gq, __shfl_xor(gq, o_)); gk = fmaxf(gk, __shfl_xor(gk, o_)); }
      negM = -(64.f * 0.125f * 1.4426950408889634f * 1.01f) * gq * gk; }
#pragma unroll
    for (int dt = 0; dt < 2; ++dt)
#pragma unroll
        for (int r = 0; r < 16; ++r) o[dt][r] = 0.f;
    char* KS = lds; char* VS = lds + 2 * 64 * AT_KP;
#define A_LOADK(X, s0) do { kr##X = *(const u32x4*)(kg + (size_t)(s0) * 64); } while (0)
#define A_LOADV(X, s0) do { vr##X = *(const u32x4*)(vg + (s0)); } while (0)
#define A_WRITEK(X, st) do { *(u32x4*)(KS + (st) * 64 * AT_KP + srow * AT_KP + sch * 16) = kr##X; } while (0)
#define A_WRITEV(X, st) do { char* vb_ = VS + (st) * 64 * AT_VP + srow * AT_VP + sch * 16; *(u32x2*)vb_ = (u32x2){vr##X[0], vr##X[1]}; *(u32x2*)(vb_ + 8) = (u32x2){vr##X[2], vr##X[3]}; } while (0)
    constexpr int NT = STOT / 64;
    f32x16 sc[2], sn[2];
    A_LOADK(A, 0); A_LOADV(A, 0); A_WRITEK(A, 0); A_WRITEV(A, 0); A_LOADK(A, 64); A_WRITEK(A, 1); A_LOADK(B, 128); A_LOADV(B, 64); __syncthreads();
#pragma unroll
    for (int kt = 0; kt < 2; ++kt) {
#pragma unroll
        for (int r = 0; r < 16; ++r) sc[kt][r] = negM;
#pragma unroll
        for (int ds = 0; ds < 4; ++ds) { const bf16x8 ka = *(const bf16x8*)(KS + (kt * 32 + r32) * AT_KP + (ds * 16 + hi * 8) * 2); sc[kt] = MFMA(ka, qf[ds], sc[kt]); }
    }
    __syncthreads();
    f32x16 ol;
#pragma unroll
    for (int r = 0; r < 16; ++r) ol[r] = 0.f;
    const u32x4 ones_w = {0x3F803F80u, 0x3F803F80u, 0x3F803F80u, 0x3F803F80u};
    const bf16x8 ones = *(const bf16x8*)&ones_w;
#define A_STEP(J, SC, SN, XW, XL) do { const int j_ = (J); \
        const int jk = (j_ + 3 < NT) ? j_ + 3 : NT - 1, jv = (j_ + 2 < NT) ? j_ + 2 : NT - 1; \
        A_LOADK(XL, jk * 64); A_LOADV(XL, jv * 64); \
        const char* ksn = KS + ((j_ + 1) & 1) * 64 * AT_KP; const char* vs = VS + (j_ & 1) * 64 * AT_VP; \
        _Pragma("unroll") for (int kt = 0; kt < 2; ++kt) { \
            _Pragma("unroll") for (int r = 0; r < 16; ++r) SN[kt][r] = negM; \
            _Pragma("unroll") for (int ds = 0; ds < 4; ++ds) { \
                const bf16x8 ka = *(const bf16x8*)(ksn + (kt * 32 + r32) * AT_KP + (ds * 16 + hi * 8) * 2); \
                SN[kt] = MFMA(ka, qf[ds], SN[kt]); \
                _Pragma("unroll") for (int e = 0; e < 4; ++e) { const int f = (kt * 4 + ds) * 4 + e; SC[f >> 4][f & 15] = __builtin_amdgcn_exp2f(SC[f >> 4][f & 15]); } \
                __builtin_amdgcn_sched_barrier(0); } } \
        _Pragma("unroll") for (int kt = 0; kt < 2; ++kt) \
            _Pragma("unroll") for (int s = 0; s < 2; ++s) { \
                u32x4 pw = {pk2(SC[kt][8 * s], SC[kt][8 * s + 1]), pk2(SC[kt][8 * s + 2], SC[kt][8 * s + 3]), pk2(SC[kt][8 * s + 4], SC[kt][8 * s + 5]), pk2(SC[kt][8 * s + 6], SC[kt][8 * s + 7])}; \
                const bf16x8 pb = *(bf16x8*)&pw; \
                _Pragma("unroll") for (int dt = 0; dt < 2; ++dt) { \
                    const char* vp = vs + (dt * 32 + r32) * AT_VP + (kt * 32 + s * 16 + hi * 4) * 2; \
                    const u32x2 lo = *(const u32x2*)vp, hh = *(const u32x2*)(vp + 16); \
                    u32x4 aw = {lo[0], lo[1], hh[0], hh[1]}; \
                    o[dt] = MFMA(*(bf16x8*)&aw, pb, o[dt]); } \
                ol = MFMA(ones, pb, ol); } \
        A_WRITEK(XW, j_ & 1); A_WRITEV(XW, (j_ + 1) & 1); \
        __syncthreads(); } while (0)
#pragma unroll 1
    for (int j = 0; j < NT; j += 2) { A_STEP(j, sc, sn, B, A); A_STEP(j + 1, sn, sc, A, B); }
#undef A_STEP
    lsum = ol[0];
#undef A_LOADK
#undef A_LOADV
#undef A_WRITEK
#undef A_WRITEV
    const float inv = fast_rcp(lsum);
    bf16_t* outp = (bf16_t*)(ws + WS_A2) + ((size_t)b * SEQ + qblk * 256 + wid * 32 + r32) * KOUT + head * 64;
#pragma unroll
    for (int dt = 0; dt < 2; ++dt)
#pragma unroll
        for (int g = 0; g < 4; ++g) {
            u32x2 v = {pk2(o[dt][4 * g] * inv, o[dt][4 * g + 1] * inv), pk2(o[dt][4 * g + 2] * inv, o[dt][4 * g + 3] * inv)};
            *(u32x2*)(outp + dt * 32 + g * 8 + hi * 4) = v;
        }
}

constexpr int LR_RAW = 0;
constexpr int LR_U   = 33792;
constexpr int LR_BB  = LR_U + 33280;
constexpr int LR_UB  = LR_BB + 33280;
constexpr int LR_WG  = LR_UB + 18432;
constexpr int LR_SEG = LR_WG + 18432;
constexpr int LR_HC  = LR_SEG + 4096;
constexpr int LR_CST = LR_HC + 512;
constexpr int LR_END = LR_CST + 768;
__device__ void lru_item(const Args& a, char* lds, int b, int n, int d) {
    const int tid = threadIdx.x, lane = tid & 63, wid = tid >> 6, r32 = lane & 31, hi = lane >> 5;
    unsigned char* ws = a.ws;
    float* RAW = (float*)(lds + LR_RAW); float* AA = (float*)(lds + LR_RAW); float* U = (float*)(lds + LR_U); float* BB = (float*)(lds + LR_BB);
    char* UB = lds + LR_UB; char* WG = lds + LR_WG; float* SEG = (float*)(lds + LR_SEG); float* HC = (float*)(lds + LR_HC);
    const bf16_t* Lg = (const bf16_t*)(ws + WS_L) + (size_t)b * STOT * DLRU + n * 64;
    const bf16_t* Zg = (const bf16_t*)(ws + WS_ZG) + (size_t)b * SEQ * DLRU + n * 64;
    bf16_t* Og = (bf16_t*)(ws + WS_A2) + (size_t)b * SEQ * KOUT + 512 + d * 512 + n * 64;
    {
        const bf16_t* wsrc = (const bf16_t*)(ws + WS_RGW) + (size_t)(d * 8 + n) * 128 * 64;
#pragma unroll
        for (int i = 0; i < 2; ++i) { const int c = tid + NTHR * i, r = c >> 3, ch = c & 7; *(u32x4*)(WG + r * 144 + ch * 16) = *(const u32x4*)(wsrc + r * 64 + ch * 8); }
        if (tid < 128) HC[tid] = 0.f;
    }
    const int ct = wid & 1, tt = wid >> 1;
    float* CST = (float*)(lds + LR_CST);
    if (tid < 64) { const int c = n * 64 + tid; CST[tid] = a.in[I_RGBA][d * 512 + c]; CST[64 + tid] = a.in[I_RGBI][d * 512 + c];
        const float x = -a.in[I_RGLAM][d * 512 + c]; CST[128 + tid] = -8.f * (fmaxf(x, 0.f) + log1pf(__expf(-fabsf(x)))); }
    const int sc = tid & 63, sg = tid >> 6;
    const float cw0 = a.in[I_CONVW][0 * 512 + n * 64 + sc], cw1 = a.in[I_CONVW][1 * 512 + n * 64 + sc], cw2 = a.in[I_CONVW][2 * 512 + n * 64 + sc], cw3 = a.in[I_CONVW][3 * 512 + n * 64 + sc];
    const float cbias = a.in[I_CONVB][n * 64 + sc];
#define LRU_TILE(step_, isctx_, sb_, sl_, t0_) const bool isctx_ = (step_) < 2; const int sb_ = isctx_ ? 0 : CTX, sl_ = isctx_ ? CTX : SEQ, \
        t0_ = (isctx_ ? (d == 0 ? (step_) : 1 - (step_)) : (d == 0 ? (step_) - 2 : 17 - (step_))) * 128
#define LRU_FETCH(pre_, sb_, sl_, t0_) do { _Pragma("unroll") for (int i_ = 0; i_ < 3; ++i_) { const int e_ = min(tid + NTHR * i_, 131 * 8 - 1), t_ = min(max((t0_) - 2 + (e_ >> 3), 0), (sl_) - 1); \
        pre_[i_] = *(const u32x4*)(Lg + (size_t)((sb_) + t_) * DLRU + (e_ & 7) * 8); } } while (0)
#define LRU_SPREAD(pre_, sl_, t0_) do { _Pragma("unroll") for (int i_ = 0; i_ < 3; ++i_) { const int e_ = tid + NTHR * i_, t_ = (t0_) - 2 + (e_ >> 3); if (e_ < 131 * 8) { float* dst = RAW + (e_ >> 3) * 64 + (e_ & 7) * 8; \
        const bool in_ = t_ >= 0 && t_ < (sl_); const u32x4 v = pre_[i_]; f32x4 lo_ = {bflo(v[0]), bfhi(v[0]), bflo(v[1]), bfhi(v[1])}, hi_ = {bflo(v[2]), bfhi(v[2]), bflo(v[3]), bfhi(v[3])}; \
        if (!in_) { lo_ = (f32x4){0.f, 0.f, 0.f, 0.f}; hi_ = lo_; } *(f32x4*)dst = lo_; *(f32x4*)(dst + 4) = hi_; } } } while (0)
    u32x4 pre[3];
    { LRU_TILE(0, c0_, sb0_, sl0_, t00_); LRU_FETCH(pre, sb0_, sl0_, t00_); LRU_SPREAD(pre, sl0_, t00_); }
    __syncthreads();
    int par = 0;
    for (int step = 0; step < 18; ++step) {
        LRU_TILE(step, isctx, sb, sl, t0);
        LRU_TILE(step < 17 ? step + 1 : 17, c1_, sb1_, sl1_, t01_);
        LRU_FETCH(pre, sb1_, sl1_, t01_);
        unsigned short zv[16];
        {
            const int tfirst = d == 0 ? sg * 16 : 127 - sg * 16;
            const bf16_t* zp = Zg + (size_t)(t0 + tfirst) * DLRU + sc; const int zstep = d == 0 ? DLRU : -DLRU;
#pragma unroll
            for (int k = 0; k < 16; ++k) zv[k] = *(const unsigned short*)(zp + k * zstep);
        }
        {
            const float* rp = RAW + (sg * 16) * 64 + sc;
            float x0 = rp[0], x1 = rp[64], x2 = rp[128];
            float* up = U + (sg * 16) * 65 + sc; char* ubp = UB + (sg * 16) * 144 + sc * 2;
#pragma unroll
            for (int i = 0; i < 16; ++i) { const float x3 = rp[(i + 3) * 64];
                const float u = cbias + cw0 * x0 + cw1 * x1 + cw2 * x2 + cw3 * x3;
                up[i * 65] = u; *(bf16_t*)(ubp + i * 144) = f2bf(u); x0 = x1; x1 = x2; x2 = x3; }
        }
        __syncthreads();
        {
            f32x16 ga, gi;
#pragma unroll
            for (int r = 0; r < 16; ++r) { ga[r] = 0.f; gi[r] = 0.f; }
#pragma unroll
            for (int ks = 0; ks < 4; ++ks) {
                const bf16x8 wa = *(const bf16x8*)(WG + (ct * 32 + r32) * 144 + (ks * 16 + hi * 8) * 2);
                const bf16x8 wi = *(const bf16x8*)(WG + (64 + ct * 32 + r32) * 144 + (ks * 16 + hi * 8) * 2);
                const bf16x8 ub = *(const bf16x8*)(UB + (tt * 32 + r32) * 144 + (ks * 16 + hi * 8) * 2);
                ga = MFMA(wa, ub, ga); gi = MFMA(wi, ub, gi);
            }
            const int t = tt * 32 + r32;
#pragma unroll
            for (int r = 0; r < 16; ++r) { const int c = ct * 32 + 8 * (r >> 2) + 4 * hi + (r & 3);
                const float rr = sigmoidf_(ga[r] + CST[c]), ii = sigmoidf_(gi[r] + CST[64 + c]);
                const float la = CST[128 + c] * rr, av = __expf(la), mult = __builtin_amdgcn_sqrtf(fmaxf(1.f - av * av, 0.f));
                const float u = U[t * 65 + c];
                AA[t * 65 + c] = av; BB[t * 65 + c] = mult * ii * u; }
        }
        __syncthreads();
        float av[16], bv[16]; float Ap = 1.f, Bp = 0.f;
#pragma unroll
        for (int k = 0; k < 16; ++k) { const int p = sg * 16 + k, t = d == 0 ? p : 127 - p; av[k] = AA[t * 65 + sc]; bv[k] = BB[t * 65 + sc]; Bp = av[k] * Bp + bv[k]; Ap = av[k] * Ap; }
        SEG[sg * 64 + sc] = Ap; SEG[512 + sg * 64 + sc] = Bp;
        __syncthreads();
        float h = HC[par * 64 + sc];
        {
            float sa[7], sb_[7];
#pragma unroll
            for (int s2 = 0; s2 < 7; ++s2) { sa[s2] = SEG[s2 * 64 + sc]; sb_[s2] = SEG[512 + s2 * 64 + sc]; }
#pragma unroll
            for (int s2 = 0; s2 < 7; ++s2) { const bool on = s2 < sg; h = (on ? sa[s2] : 1.f) * h + (on ? sb_[s2] : 0.f); }
        }
        {
            const int tfirst = d == 0 ? sg * 16 : 127 - sg * 16;
            bf16_t* op = Og + (size_t)(t0 + tfirst) * KOUT + sc;
            const int ostep = d == 0 ? KOUT : -KOUT;
#pragma unroll
            for (int k = 0; k < 16; ++k) { h = av[k] * h + bv[k];
                if (!isctx) { const float gz = __uint_as_float((unsigned)zv[k] << 16); *op = f2bf(h * gz); op += ostep; } }
        }
        LRU_SPREAD(pre, sl1_, t01_);
        if (sg == 7) HC[(par ^ 1) * 64 + sc] = h;
        par ^= 1;
        __syncthreads();
    }
}

#ifndef LRU_REPS
#define LRU_REPS 1
#endif
__device__ void phase_mixer(const Args& a, char* lds, int vb, int nb) {
#pragma unroll 1
    for (int it = vb; it < 256; it += nb) { for (int rep_ = 0; rep_ < LRU_REPS; ++rep_) { lru_item(a, lds, it >> 4, (it >> 1) & 7, it & 1); __syncthreads(); } }
#pragma unroll 1
    for (int at = vb; at < 1024; at += nb) { const int bk = at >> 5, w = at & 31; attn_item(a, lds, bk >> 1, (bk & 1) * 4 + (w >> 3), w & 7); __syncthreads(); }
}

__device__ void phase_outproj(const Args& a, char* lds, int vb, int nb) {
    const int tid = threadIdx.x, lane = tid & 63, wid = tid >> 6, wr = wid >> 2, wc = wid & 3, fr = lane & 15, fq = lane >> 4;
    const bf16_t* A2 = (const bf16_t*)(a.ws + WS_A2); const bf16_t* WO = (const bf16_t*)(a.ws + WS_WOUT);
    bf16_t* MIX = (bf16_t*)(a.ws + WS_MIX);
    if (vb < 128 * 4) g8::core_pre(WO, A2, (vb & 3) * 256, (vb >> 2) * 256, KOUT, lds);
#pragma unroll 1
    for (int it = vb; it < 128 * 4; it += nb) {
        const int tt = it >> 2, ft = it & 3;
        f32x4 acc[2][2][4][2];
        g8::core<true>(acc, WO, A2, ft * 256, tt * 256, KOUT, lds);
        if (it + nb < 128 * 4) g8::core_pre(WO, A2, ((it + nb) & 3) * 256, ((it + nb) >> 2) * 256, KOUT, lds);
#pragma unroll
        for (int bj = 0; bj < 2; ++bj)
#pragma unroll
            for (int n = 0; n < 2; ++n) {
                bf16_t* rp = MIX + (size_t)(tt * 256 + bj * 128 + wc * 32 + n * 16 + fr) * DM + ft * 256 + wr * 64 + fq * 4;
#pragma unroll
                for (int ai = 0; ai < 2; ++ai)
#pragma unroll
                    for (int m = 0; m < 4; ++m) { const f32x4 v = acc[ai][bj][m][n]; *(u32x2*)(rp + ai * 128 + m * 16) = (u32x2){pk2(v[0], v[1]), pk2(v[2], v[3])}; }
            }
        __syncthreads();
    }
}

__device__ void phase_rowpass(const Args& a, int vb, int nb) {
    const int tid = threadIdx.x, lane = tid & 63, wid = tid >> 6;
    const float* mod = (const float*)(a.ws + WS_MOD);
    const bf16_t* MIX = (const bf16_t*)(a.ws + WS_MIX);
    bf16_t* HX = (bf16_t*)(a.ws + WS_HX2); bf16_t* XM = (bf16_t*)(a.ws + WS_XM);
    const int chunk = (NTOK + nb - 1) / nb, rend = min(NTOK, (vb + 1) * chunk);
    f32x4 G1[4], A2[4], B2[4]; int cur = -1;
    u32x2 mwn[4]; f32x4 xvn[4];
    {
        const int r0 = min(vb * chunk + wid, NTOK - 1);
#pragma unroll
        for (int i = 0; i < 4; ++i) { mwn[i] = *(const u32x2*)(MIX + (size_t)r0 * DM + i * 256 + lane * 4); xvn[i] = *(const f32x4*)(a.in[I_X] + (size_t)r0 * DM + i * 256 + lane * 4); }
    }
    for (int row = vb * chunk + wid; row < rend; row += 8) {
        const int b = row >> 11;
        f32x4 mv[4], xv[4]; float ss = 0.f;
#pragma unroll
        for (int i = 0; i < 4; ++i) { const u32x2 mw = mwn[i]; mv[i] = (f32x4){bflo(mw[0]), bfhi(mw[0]), bflo(mw[1]), bfhi(mw[1])}; xv[i] = xvn[i]; }
        {
            const int rn = min(row + 8, NTOK - 1);
#pragma unroll
            for (int i = 0; i < 4; ++i) { mwn[i] = *(const u32x2*)(MIX + (size_t)rn * DM + i * 256 + lane * 4); xvn[i] = *(const f32x4*)(a.in[I_X] + (size_t)rn * DM + i * 256 + lane * 4); }
        }
        if (b != cur) { cur = b; const float* mrow = mod + (size_t)b * 6144;
#pragma unroll
            for (int i = 0; i < 4; ++i) { const int c = i * 256 + lane * 4;
                const f32x4 gp = *(const f32x4*)(a.in[I_GPOSTMIX] + c), g1 = *(const f32x4*)(mrow + 2048 + c), gf = *(const f32x4*)(a.in[I_GPREFFN] + c), sc = *(const f32x4*)(mrow + 4096 + c);
                B2[i] = *(const f32x4*)(mrow + 3072 + c);
#pragma unroll
                for (int j = 0; j < 4; ++j) { G1[i][j] = g1[j] * gp[j]; A2[i][j] = gf[j] * (1.f + sc[j]); } } }
#pragma unroll
        for (int i = 0; i < 4; ++i) ss += mv[i][0] * mv[i][0] + mv[i][1] * mv[i][1] + mv[i][2] * mv[i][2] + mv[i][3] * mv[i][3];
        ss = wave_sum(ss);
        const float rinv = rsqrtf(ss * (1.f / DM) + EPS);
        float s2 = 0.f;
#pragma unroll
        for (int i = 0; i < 4; ++i) { const int c = i * 256 + lane * 4;
#pragma unroll
            for (int j = 0; j < 4; ++j) { const float xm = xv[i][j] + G1[i][j] * (mv[i][j] * rinv); xv[i][j] = xm; s2 += xm * xm; }
            const u32x2 xw = {pk2(xv[i][0], xv[i][1]), pk2(xv[i][2], xv[i][3])}; *(u32x2*)(XM + (size_t)row * DM + c) = xw; }
        s2 = wave_sum(s2);
        const float rinv2 = rsqrtf(s2 * (1.f / DM) + EPS);
#pragma unroll
        for (int i = 0; i < 4; ++i) { const int c = i * 256 + lane * 4;
            float o[4];
#pragma unroll
            for (int j = 0; j < 4; ++j) o[j] = xv[i][j] * rinv2 * A2[i][j] + B2[i][j];
            u32x2 w = {pk2(o[0], o[1]), pk2(o[2], o[3])}; *(u32x2*)(HX + (size_t)row * DM + c) = w; }
    }
}

__device__ __forceinline__ int fkey(float f) { const int b = __float_as_int(f); return b ^ ((b >> 31) & 0x7fffffff); }
__device__ __forceinline__ float fval(int k) { return __int_as_float(k ^ ((k >> 31) & 0x7fffffff)); }
#define CE_DESC(x, y) do { const int hi_ = max((x), (y)), lo_ = min((x), (y)); (x) = hi_; (y) = lo_; } while (0)
__device__ __forceinline__ void sort16_desc(int (&v)[16]) {
#pragma unroll
    for (int k = 2; k <= 16; k <<= 1)
#pragma unroll
        for (int j = k >> 1; j > 0; j >>= 1)
#pragma unroll
            for (int i = 0; i < 16; ++i) { const int l = i ^ j; if (l > i) { if ((i & k) == 0) { CE_DESC(v[i], v[l]); } else { CE_DESC(v[l], v[i]); } } }
}
__device__ __forceinline__ void merge16_desc(int (&v)[16]) {
#pragma unroll
    for (int j = 8; j > 0; j >>= 1)
#pragma unroll
        for (int i = 0; i < 16; ++i) { const int l = i ^ j; if (l > i) CE_DESC(v[i], v[l]); }
}
__device__ __forceinline__ void top16_merge(int (&A)[16], const int (&B)[16]) {
#pragma unroll
    for (int i = 0; i < 16; ++i) A[i] = max(A[i], B[15 - i]);
    merge16_desc(A);
}
constexpr int PK_QS = 0;
constexpr int PK_SK = 256 * E_PITCH;
constexpr int PK_ML = PK_SK + 128 * E_PITCH;
constexpr int PK_X  = PK_ML + 32768;
constexpr int PK_END = PK_X + 8192;
__device__ void phase_peer_topk(const Args& a, char* lds, int vb, int nb) {
    unsigned char* ws = a.ws;
    const bf16_t* HX = (const bf16_t*)(ws + WS_HX2); const bf16_t* WQ = (const bf16_t*)(ws + WS_WQ); const bf16_t* SUBK = (const bf16_t*)(ws + WS_SUBK);
    int* IDX = (int*)(ws + WS_IDX);
    int* ML = (int*)(lds + PK_ML); int* XB = (int*)(lds + PK_X);
    for (int it = vb; it < 128 * 8; it += nb) {
        const int rt = it >> 3, h = it & 7, row0 = rt * 256;
        bf16_t* park = (bf16_t*)(ws + WS_MIX) + (size_t)it * (256 * 128);
        int tid = threadIdx.x;
        {
            f32x4 acc8[2][2][4][2];
            g8::core(acc8, WQ, HX, h * 256, row0, DM, lds);
            __syncthreads();
            asm volatile("" : "+v"(tid));
            const int lane = tid & 63, wid = tid >> 6;
            const int w8r = wid >> 2, w8c = wid & 3, fr = lane & 15, fq = lane >> 4;
#pragma unroll
            for (int bj = 0; bj < 2; ++bj)
#pragma unroll
                for (int m = 0; m < 4; ++m)
#pragma unroll
                    for (int n = 0; n < 2; ++n) { const int tok = bj * 128 + w8c * 32 + n * 16 + fr, d = w8r * 64 + m * 16 + fq * 4;
                        const f32x4 v0 = acc8[0][bj][m][n], v1 = acc8[1][bj][m][n];
                        *(u32x2*)(lds + PK_QS + tok * E_PITCH + d * 2) = (u32x2){pk2(v0[0], v0[1]), pk2(v0[2], v0[3])};
                        *(u32x2*)(park + tok * 128 + d) = (u32x2){pk2(v1[0], v1[1]), pk2(v1[2], v1[3])}; }
        }
        const int lane = tid & 63, wid = tid >> 6, wm = wid & 3, wn = wid >> 2, r32 = lane & 31, hi = lane >> 5;
#pragma unroll 1
        for (int p = 0; p < 2; ++p) {
            f32x16 acc[2][2];
            if (p == 1) {
#pragma unroll
                for (int i = 0; i < 8; ++i) { const int c = tid + NTHR * i, tok = c >> 4, ch = c & 15; *(u32x4*)(lds + PK_QS + tok * E_PITCH + ch * 16) = *(const u32x4*)(park + tok * 128 + ch * 8); }
            }
            {
                const bf16_t* sk = SUBK + (size_t)(h * 2 + p) * 128 * 128;
#pragma unroll
                for (int i = 0; i < 4; ++i) { const int c = tid + NTHR * i, r = c >> 4, ch = c & 15; *(u32x4*)(lds + PK_SK + r * E_PITCH + ch * 16) = *(const u32x4*)(sk + r * 128 + ch * 8); }
            }
            __syncthreads();
#pragma unroll
            for (int ft = 0; ft < 2; ++ft)
#pragma unroll
                for (int tt = 0; tt < 2; ++tt)
#pragma unroll
                    for (int r = 0; r < 16; ++r) acc[ft][tt][r] = 0.f;
#pragma unroll
            for (int ks = 0; ks < 8; ++ks) {
                const bf16x8 a0 = *(const bf16x8*)(lds + PK_SK + (wn * 64 + r32) * E_PITCH + (ks * 16 + hi * 8) * 2), a1 = *(const bf16x8*)(lds + PK_SK + (wn * 64 + 32 + r32) * E_PITCH + (ks * 16 + hi * 8) * 2);
                const bf16x8 b0 = *(const bf16x8*)(lds + PK_QS + (wm * 64 + r32) * E_PITCH + (ks * 16 + hi * 8) * 2), b1 = *(const bf16x8*)(lds + PK_QS + (wm * 64 + 32 + r32) * E_PITCH + (ks * 16 + hi * 8) * 2);
                acc[0][0] = MFMA(a0, b0, acc[0][0]); acc[0][1] = MFMA(a0, b1, acc[0][1]);
                acc[1][0] = MFMA(a1, b0, acc[1][0]); acc[1][1] = MFMA(a1, b1, acc[1][1]);
            }
#pragma unroll
            for (int tt = 0; tt < 2; ++tt) {
                int A[16], B[16];
#pragma unroll
                for (int r = 0; r < 16; ++r) { const int key = wn * 64 + 8 * (r >> 2) + 4 * hi + (r & 3);
                    A[r] = (fkey(acc[0][tt][r]) & ~127) | key; B[r] = (fkey(acc[1][tt][r]) & ~127) | (key + 32); }
                sort16_desc(A); sort16_desc(B); top16_merge(A, B);
#pragma unroll
                for (int r = 0; r < 16; ++r) { auto rr = __builtin_amdgcn_permlane32_swap((unsigned)A[r], (unsigned)A[r], false, false); B[r] = (int)(hi ? rr[0] : rr[1]); }
                top16_merge(A, B);
                const int tok = wm * 64 + tt * 32 + r32;
                if (wn == 1 && hi == 0) {
#pragma unroll
                    for (int r = 0; r < 16; ++r) XB[(wm * 32 + r32) * 16 + r] = A[r];
                }
                __syncthreads();
                if (wn == 0 && hi == 0) {
#pragma unroll
                    for (int r = 0; r < 16; ++r) B[r] = XB[(wm * 32 + r32) * 16 + r];
                    top16_merge(A, B);
#pragma unroll
                    for (int r = 0; r < 16; ++r) ML[(tok * 2 + p) * 16 + r] = A[r];
                }
                __syncthreads();
            }
        }
        if (tid < 256) {
            const int tok = tid;
            int s1[16], s2[16];
#pragma unroll
            for (int r = 0; r < 16; ++r) { s1[r] = ML[(tok * 2 + 0) * 16 + r]; s2[r] = ML[(tok * 2 + 1) * 16 + r]; }
            float f1[16], f2[16];
#pragma unroll
            for (int r = 0; r < 16; ++r) { f1[r] = fval(s1[r] & ~127); f2[r] = fval(s2[r] & ~127); }
            int G0[16], G1[16], G2[16], G3[16];
#pragma unroll
            for (int bb = 0; bb < 16; ++bb) G0[bb] = (fkey(f1[0] + f2[bb]) & ~255) | (0 * 16 + bb);
#pragma unroll
            for (int bb = 0; bb < 8; ++bb) G1[bb] = (fkey(f1[1] + f2[bb]) & ~255) | (1 * 16 + bb);
#pragma unroll
            for (int bb = 0; bb < 5; ++bb) G1[8 + bb] = (fkey(f1[2] + f2[bb]) & ~255) | (2 * 16 + bb);
#pragma unroll
            for (int bb = 0; bb < 3; ++bb) G1[13 + bb] = (fkey(f1[3] + f2[bb]) & ~255) | (3 * 16 + bb);
            G2[0] = (fkey(f1[3] + f2[3]) & ~255) | (3 * 16 + 3);
#pragma unroll
            for (int bb = 0; bb < 3; ++bb) G2[1 + bb] = (fkey(f1[4] + f2[bb]) & ~255) | (4 * 16 + bb);
#pragma unroll
            for (int aa = 5; aa < 8; ++aa)
#pragma unroll
                for (int bb = 0; bb < 2; ++bb) G2[4 + (aa - 5) * 2 + bb] = (fkey(f1[aa] + f2[bb]) & ~255) | (aa * 16 + bb);
#pragma unroll
            for (int aa = 8; aa < 14; ++aa) G2[10 + (aa - 8)] = (fkey(f1[aa] + f2[0]) & ~255) | (aa * 16);
            G3[0] = (fkey(f1[14] + f2[0]) & ~255) | (14 * 16); G3[1] = (fkey(f1[15] + f2[0]) & ~255) | (15 * 16);
#pragma unroll
            for (int r = 2; r < 16; ++r) G3[r] = (int)0x80000000;
            sort16_desc(G0); sort16_desc(G1); sort16_desc(G2); sort16_desc(G3);
            top16_merge(G0, G1); top16_merge(G2, G3); top16_merge(G0, G2);
            float tv[16]; float mx = fval(G0[0] & ~255), sum = 0.f;
#pragma unroll
            for (int r = 0; r < 16; ++r) { tv[r] = __expf(fval(G0[r] & ~255) - mx); sum += tv[r]; }
            const float rs = 1.f / sum;
            const size_t ob = ((size_t)(row0 + tok) * 8 + h) * 16;
#pragma unroll
            for (int r = 0; r < 16; ++r) { const int code = G0[r] & 255, aa = code >> 4, bb = code & 15;
                const int i1 = ML[(tok * 2 + 0) * 16 + aa] & 127, i2 = ML[(tok * 2 + 1) * 16 + bb] & 127;
                IDX[ob + r] = (i1 * 128 + i2) | (int)((unsigned)f2bf(tv[r] * rs) << 16); }
        }
        __syncthreads();
    }
}

template <int CTRL> __device__ __forceinline__ float dpp_add(float v) { return v + __uint_as_float(__builtin_amdgcn_update_dpp(0u, __float_as_uint(v), CTRL, 0xf, 0xf, true)); }
__device__ __forceinline__ float wave_sum_bcast(float p) {
    p = dpp_add<0xB1>(p); p = dpp_add<0x4E>(p); p = dpp_add<0x141>(p); p = dpp_add<0x140>(p);
    const unsigned u = __float_as_uint(p);
    return (__uint_as_float(__builtin_amdgcn_readlane(u, 0)) + __uint_as_float(__builtin_amdgcn_readlane(u, 16))) + (__uint_as_float(__builtin_amdgcn_readlane(u, 32)) + __uint_as_float(__builtin_amdgcn_readlane(u, 48)));
}
typedef float f32x4v __attribute__((ext_vector_type(4)));
constexpr int P7_RS = 9;
constexpr int P7_NR = PEER_N >> P7_RS;
constexpr int P7_HTP = 1024 + 64;
constexpr float H_SCALE = 16.f;
constexpr int P7_ATP = 2048 + 16;
constexpr float W_SCALE = 16.f;
constexpr int P7_RING = 16384;
constexpr int P7_WLDS = P7_RING + 2048;
#ifndef P7_UREP
#define P7_UREP 1
#endif
#ifndef P7_UD
#define P7_UD 3
#endif
#ifndef P7_VMASK
#define P7_VMASK 16383u
#endif
#ifndef P7_VPROBE
#define P7_VPROBE 0
#endif
template <int MODE>
__device__ __forceinline__ void p7_vsweep(f32x16 (&acc)[8], const unsigned* LIST, const unsigned char* VT, int m32, int kh, unsigned psel, unsigned ntok) {
    constexpr unsigned EM = MODE == 1 ? P7_VMASK : 16383u;
    i32x8 abuf[8];
#pragma unroll
    for (int T = 0; T < 8; ++T)
#pragma unroll
        for (int i = 0; i < 16; ++i) acc[T][i] = 0.f;
    u32x4 c0 = *(const u32x4*)(LIST + kh * 8), c1 = *(const u32x4*)(LIST + kh * 8 + 4);
    {
        unsigned off[8];
#pragma unroll
        for (int j = 0; j < 8; ++j) off[j] = (((j < 4 ? c0[j & 3] : c1[j & 3]) & EM) << 10) + m32 * 4;
#pragma unroll
        for (int T = 0; T < 8; ++T) {
#pragma unroll
            for (int j = 0; j < 8; ++j) abuf[T][j] = *(const int*)(VT + off[j] + T * 128);
            __builtin_amdgcn_sched_barrier(0); }
    }
#pragma unroll 1
    for (int bi = 0; bi < 32; ++bi) {
        const int bn = (bi < 31 ? bi + 1 : 31);
        const u32x4 l0 = *(const u32x4*)(LIST + bn * 16 + kh * 8), l1 = *(const u32x4*)(LIST + bn * 16 + kh * 8 + 4);
        unsigned noff[8];
#pragma unroll
        for (int j = 0; j < 8; ++j) noff[j] = (((j < 4 ? l0[j & 3] : l1[j & 3]) & EM) << 10) + m32 * 4;
        i32x8 bop;
#pragma unroll
        for (int j = 0; j < 8; ++j) { const unsigned e = j < 4 ? c0[j & 3] : c1[j & 3];
            bop[j] = (((e >> 14) & 3u) == ntok) ? (int)__builtin_amdgcn_perm(0u, e, psel) : 0; }
        c0 = l0; c1 = l1;
#pragma unroll
        for (int T = 0; T < 8; ++T) {
            __builtin_amdgcn_sched_barrier(0);
            if (MODE != 2) asm volatile("s_waitcnt vmcnt(24)" ::: "memory");
            if (MODE == 1) { int t_ = abuf[T][0];
#pragma unroll
                for (int j = 1; j < 8; ++j) t_ |= abuf[T][j];
                acc[T][0] = __int_as_float(t_ | bop[0]); }
            else acc[T] = __builtin_amdgcn_mfma_scale_f32_32x32x64_f8f6f4(abuf[T], bop, acc[T], 0, 0, 0, 127, 0, 127);
            if (MODE != 2) {
#pragma unroll
                for (int j = 0; j < 8; ++j) abuf[T][j] = *(const int*)(VT + noff[j] + T * 128); }
        }
        __builtin_amdgcn_sched_barrier(0);
    }
    if (MODE != 0) {
#pragma unroll
        for (int T = 0; T < 8; ++T) asm volatile("" :: "v"(acc[T]));
    }
}
__device__ void phase_peer_gather(const Args& a, char* lds, int vb, int nb) {
    unsigned char* ws = a.ws;
    const bf16_t* HX = (const bf16_t*)(ws + WS_HX2);
    const int* IDX = (const int*)(ws + WS_IDX);
    const float* mod = (const float*)(ws + WS_MOD);
    const unsigned char* UT = ws + WS_UT; const unsigned char* VT = ws + WS_VT;
    const bf16_t* XM = (const bf16_t*)(ws + WS_XM);
#pragma unroll 1
    for (int tb = vb * 32; tb < NTOK; tb += nb * 32) {
        int tid = threadIdx.x; asm volatile("" : "+v"(tid));
        const int lane = tid & 63, wid = tid >> 6, r16 = lane & 15, kg = lane >> 4;
        char* HT = lds + wid * P7_WLDS; unsigned* LIST = (unsigned*)(HT + P7_RING); char* AT = HT;
        const int tok0 = tb + wid * 4;
        {
            int* HIST = (int*)HT; int* CUR = HIST + 128;
            int ee[8];
            const int* ip = IDX + (size_t)tok0 * 128 + lane;
#pragma unroll
            for (int k = 0; k < 4; ++k) { ee[2 * k] = ip[k * 128]; ee[2 * k + 1] = ip[k * 128 + 64]; }
            HIST[lane] = 0; HIST[64 + lane] = 0;
#pragma unroll
            for (int j = 0; j < 8; ++j) atomicAdd(&HIST[(((ee[j] >> P7_RS) & (P7_NR - 1)) << 2) | (j >> 1)], 1);
            const int c0 = HIST[2 * lane], c1 = HIST[2 * lane + 1];
            int inc = c0 + c1;
#pragma unroll
            for (int o = 1; o < 64; o <<= 1) { const int t = __shfl_up(inc, o); if (lane >= o) inc += t; }
            CUR[2 * lane] = inc - c0 - c1; CUR[2 * lane + 1] = inc - c1;
#pragma unroll
            for (int j = 0; j < 8; ++j) { const unsigned w = (unsigned)ee[j]; const int slot = atomicAdd(&CUR[(((w >> P7_RS) & (P7_NR - 1)) << 2) | (j >> 1)], 1);
                LIST[slot] = (w & 16383u) | ((unsigned)(j >> 1) << 14) | ((w >> 16) << 17); }
        }
#pragma unroll 1
        for (int urep = 0; urep < P7_UREP; ++urep) {
        if (urep) asm volatile("s_waitcnt vmcnt(0)" ::: "memory");
        {
            const bf16_t* hp = HX + (size_t)tok0 * DM + lane * 16;
#pragma unroll
            for (int k = 0; k < 4; ++k) { const u32x4 h0 = *(const u32x4*)(hp + k * DM), h1 = *(const u32x4*)(hp + k * DM + 8);
                u32x4 o, ol;
#pragma unroll
                for (int q = 0; q < 4; ++q) { const unsigned wa = q < 2 ? h0[2 * q] : h1[2 * q - 4], wb = q < 2 ? h0[2 * q + 1] : h1[2 * q - 3];
                    const float x0 = bflo(wa) * H_SCALE, x1 = bfhi(wa) * H_SCALE, x2 = bflo(wb) * H_SCALE, x3 = bfhi(wb) * H_SCALE;
                    int w = __builtin_amdgcn_cvt_pk_fp8_f32(sat8(x0), sat8(x1), 0, false); w = __builtin_amdgcn_cvt_pk_fp8_f32(sat8(x2), sat8(x3), w, true); o[q] = (unsigned)w;
                    const float r0 = (x0 - __builtin_amdgcn_cvt_f32_fp8(w, 0)) * 16.f, r1 = (x1 - __builtin_amdgcn_cvt_f32_fp8(w, 1)) * 16.f, r2 = (x2 - __builtin_amdgcn_cvt_f32_fp8(w, 2)) * 16.f, r3 = (x3 - __builtin_amdgcn_cvt_f32_fp8(w, 3)) * 16.f;
                    int wl = __builtin_amdgcn_cvt_pk_fp8_f32(sat8(r0), sat8(r1), 0, false); wl = __builtin_amdgcn_cvt_pk_fp8_f32(sat8(r2), sat8(r3), wl, true); ol[q] = (unsigned)wl; }
                *(u32x4*)(HT + (2 * k) * P7_HTP + lane * 16) = o; *(u32x4*)(HT + (2 * k + 1) * P7_HTP + lane * 16) = ol;
            }
        }
        {
            i32x8 hb[8];
            {
                const char* hp = HT + (2 * (lane & 3) + ((lane >> 2) & 1)) * P7_HTP + kg * 32;
#pragma unroll
                for (int kc = 0; kc < 8; ++kc) { const i32x4 x0 = *(const i32x4*)(hp + kc * 128), x1 = *(const i32x4*)(hp + kc * 128 + 16);
                    hb[kc] = __builtin_shufflevector(x0, x1, 0, 1, 2, 3, 4, 5, 6, 7); }
            }
            unsigned entv = LIST[r16];
            asm volatile("s_waitcnt lgkmcnt(0)" ::: "memory");
            LAS unsigned char* ring = (LAS unsigned char*)lds + __builtin_amdgcn_readfirstlane(wid) * P7_WLDS;
#define U_DMA(slot, gp) do { __builtin_amdgcn_global_load_lds((const unsigned*)(gp), (LAS unsigned*)(ring + (slot) * 2048), 16, 0, 0); } while (0)
            const int lrow = lane >> 3;
            const unsigned swz = (unsigned)(((lane & 7) ^ (((lrow >> 1) & 3) << 1)) << 4);
            unsigned olo = (((unsigned)__shfl((int)entv, lrow) & 16383u) << 10) + swz, ohi = (((unsigned)__shfl((int)entv, 8 + lrow) & 16383u) << 10) + swz;
#pragma unroll
            for (int st = 0; st < P7_UD; ++st) { U_DMA(st, UT + olo + st * 128); __builtin_amdgcn_global_load_lds((const unsigned*)(UT + ohi + st * 128), (LAS unsigned*)(ring + st * 2048 + 1024), 16, 0, 0); }
            const int ard = (r16 >> 3) * 1024 + (r16 & 7) * 128 + ((kg ^ ((r16 >> 1) & 3)) << 5);
            const float pscl = (lane & 8) ? 0.f : ((lane & 4) ? 1.f / 16.f : 1.f);
            asm volatile("s_waitcnt vmcnt(%0)" :: "n"(2 * P7_UD - 2) : "memory");
            i32x4 a0 = *(const LAS i32x4*)(ring + ard), a1 = *(const LAS i32x4*)(ring + ard + 16);
#pragma unroll 1
            for (int bi = 0; bi < 32; ++bi) {
                const unsigned entn = LIST[(bi < 31 ? bi + 1 : 31) * 16 + r16];
                const unsigned nlo = (((unsigned)__shfl((int)entn, lrow) & 16383u) << 10) + swz, nhi = (((unsigned)__shfl((int)entn, 8 + lrow) & 16383u) << 10) + swz;
                f32x4v D = {0.f, 0.f, 0.f, 0.f};
#pragma unroll
                for (int kc = 0; kc < 8; ++kc) {
                    asm volatile("" ::: "memory");
                    {
                        const unsigned glo = (kc + P7_UD < 8 ? olo : nlo) + ((kc + P7_UD) & 7) * 128, ghi = (kc + P7_UD < 8 ? ohi : nhi) + ((kc + P7_UD) & 7) * 128;
                        __builtin_amdgcn_global_load_lds((const unsigned*)(UT + glo), (LAS unsigned*)(ring + ((kc + P7_UD) & 7) * 2048), 16, 0, 0);
                        __builtin_amdgcn_global_load_lds((const unsigned*)(UT + ghi), (LAS unsigned*)(ring + ((kc + P7_UD) & 7) * 2048 + 1024), 16, 0, 0);
                    }
                    asm volatile("s_waitcnt vmcnt(%0)" :: "n"(2 * P7_UD - 2) : "memory");
                    const i32x4 n0 = *(const LAS i32x4*)(ring + ((kc + 1) & 7) * 2048 + ard), n1 = *(const LAS i32x4*)(ring + ((kc + 1) & 7) * 2048 + ard + 16);
                    D = __builtin_amdgcn_mfma_scale_f32_16x16x128_f8f6f4(__builtin_shufflevector(a0, a1, 0, 1, 2, 3, 4, 5, 6, 7), hb[kc], D, 0, 0, 0, 127, 0, 127);
                    a0 = n0; a1 = n1;
                }
                olo = nlo; ohi = nhi;
                float dsel = 0.f; unsigned esel = 0u;
#pragma unroll
                for (int i = 0; i < 4; ++i) {
                    const unsigned er = (unsigned)__shfl((int)entv, 4 * kg + i);
                    float m = (((er >> 14) & 3u) == (unsigned)(lane & 3)) ? D[i] * pscl : 0.f;
                    m = dpp_add<0xB1>(m); m = dpp_add<0x4E>(m); m = dpp_add<0x104>(m);
                    const bool pick = (lane & 3) == i; dsel = pick ? m : dsel; esel = pick ? er : esel;
                }
                if ((lane & 12) == 0) {
                    const float w = __uint_as_float((esel >> 17) << 16) * gelu_tanh(dsel * (1.f / (T_SCALE * H_SCALE))) * W_SCALE;
                    const int p0 = __builtin_amdgcn_cvt_pk_fp8_f32(sat8(w), 0.f, 0, false);
                    const float hf = __builtin_amdgcn_cvt_f32_fp8(p0, 0);
                    const int p1 = __builtin_amdgcn_cvt_pk_fp8_f32(sat8((w - hf) * 16.f), 0.f, 0, false);
                    LIST[bi * 16 + 4 * kg + (lane & 3)] = (esel & 0xffffu) | (((unsigned)p0 & 0xffu) << 16) | (((unsigned)p1 & 0xffu) << 24); }
                entv = entn;
            }
        }
        }
        {
            const int m32 = lane & 31, kh = lane >> 5, ntok = m32 >> 3, npart = (m32 >> 2) & 1, nc = m32 & 3;
            const unsigned psel = (0x0c0c0c0cu & ~(0xffu << (8 * nc))) | ((unsigned)(2 + npart) << (8 * nc));
            f32x16 acc[8];
#if P7_VPROBE
            p7_vsweep<P7_VPROBE>(acc, LIST, VT, m32, kh, psel, (unsigned)ntok);
#endif
            p7_vsweep<0>(acc, LIST, VT, m32, kh, psel, (unsigned)ntok);
            const float psc = npart ? V_SCALE / (W_SCALE * T_SCALE * 16.f) : V_SCALE / (W_SCALE * T_SCALE);
            char* arow = AT + ntok * P7_ATP + (16 * kh + nc) * 2;
#pragma unroll
            for (int T = 0; T < 8; ++T)
#pragma unroll
                for (int i = 0; i < 16; ++i) {
                    const float v = acc[T][i] * psc;
                    const float tot = (T & 1) ? dpp_add<0x114>(v) : dpp_add<0x104>(v);
                    if ((T & 1) == npart) *(_Float16*)(arow + (128 * T + 4 * ((i & 3) + 8 * (i >> 2))) * 2) = (_Float16)tot;
                }
        }
#pragma unroll
        for (int k = 0; k < 4; ++k) {
            const int tok = tok0 + k;
            float f[16]; float ss = 0.f;
            const u32x4 e0 = *(const u32x4*)(AT + k * P7_ATP + lane * 32), e1 = *(const u32x4*)(AT + k * P7_ATP + lane * 32 + 16);
#pragma unroll
            for (int i = 0; i < 8; ++i) { const unsigned cw = i < 4 ? e0[i] : e1[i - 4]; const h16x2 hv = as_h2(cw);
                f[2 * i] = (float)hv[0] * (1.f / V_SCALE); f[2 * i + 1] = (float)hv[1] * (1.f / V_SCALE); ss += f[2 * i] * f[2 * i] + f[2 * i + 1] * f[2 * i + 1]; }
            ss = wave_sum_bcast(ss);
            const float rinv = rsqrtf(ss * (1.f / DM) + EPS);
            const float* g2 = mod + (size_t)(tok >> 11) * 6144 + 5120;
            const u32x4 xa = *(const u32x4*)(XM + (size_t)tok * DM + lane * 16), xb = *(const u32x4*)(XM + (size_t)tok * DM + lane * 16 + 8);
#pragma unroll
            for (int q4 = 0; q4 < 4; ++q4) {
                const int c = lane * 16 + q4 * 4;
                const unsigned x01 = q4 < 2 ? xa[2 * q4] : xb[2 * q4 - 4], x23 = q4 < 2 ? xa[2 * q4 + 1] : xb[2 * q4 - 3];
                const f32x4 xm = {bflo(x01), bfhi(x01), bflo(x23), bfhi(x23)}, g2v = *(const f32x4*)(g2 + c), gp = *(const f32x4*)(a.in[I_GPOSTFFN] + c);
                f32x4 o;
#pragma unroll
                for (int jj = 0; jj < 4; ++jj) o[jj] = xm[jj] + g2v[jj] * (f[q4 * 4 + jj] * rinv * gp[jj]);
                *(f32x4*)(a.out + (size_t)tok * DM + c) = o; }
        }
    }
}

#ifdef DBG_DIGEST
__device__ void phase_digest(const Args& a, int vb, int nb) {
    const bf16_t* A2 = (const bf16_t*)(a.ws + WS_A2);
    const bf16_t* Q = (const bf16_t*)(a.ws + WS_Q); const bf16_t* K = (const bf16_t*)(a.ws + WS_K); const bf16_t* VV = (const bf16_t*)(a.ws + WS_VV);
    const bf16_t* L = (const bf16_t*)(a.ws + WS_L); const bf16_t* ZG = (const bf16_t*)(a.ws + WS_ZG);
    for (size_t e = (size_t)vb * NTHR + threadIdx.x; e < (size_t)NTOK * DM; e += (size_t)nb * NTHR) {
        float v = 0.f;
#if DBG_DIGEST == 3
        const size_t row = e >> 10; const int c = (int)(e & 1023);
        v = bf2f(A2[row * KOUT + c]); if (c < 512) v += bf2f(A2[row * KOUT + 1024 + c]);
#elif DBG_DIGEST == 2
        const size_t h = e % ((size_t)NTOK * 512);
        v = bf2f(Q[h]) + bf2f(ZG[h]) + bf2f(L[e % ((size_t)NB * STOT * 512)]);
        if (e < (size_t)NB * 2 * STOT * 64) v += bf2f(K[e]) + bf2f(VV[e]);
#endif
        a.out[e] = v; }
}
#endif
constexpr int LDS_BYTES = 155648;
constexpr int LDS_BARST = LDS_BYTES - 16;
static_assert(8 * P7_HTP <= P7_RING && 4 * P7_ATP <= P7_RING && 8 * P7_WLDS <= LDS_BARST && PK_END <= LDS_BARST && LR_END <= LDS_BARST && g8::SHM_B <= LDS_BARST && 17 * 1024 * 4 + 17 * 24 * 4 <= LDS_BARST, "LDS budget");
constexpr int N_PHASES = 8;

__global__ void __launch_bounds__(NTHR, 2) mk_fwd(Args a) {
    extern __shared__ __attribute__((aligned(16))) char lds[];
    const int nb = gridDim.x, bx = blockIdx.x;
    const int vb0 = (nb % 8 == 0) ? (bx % 8) * (nb / 8) + bx / 8 : bx;
    XcdBarrier bar; bar.bar = (unsigned*)(a.ws + WS_CTL); bar.x = 0; bar.st = (volatile LAS unsigned*)(LAS char*)(lds + LDS_BARST);
    const bool multi = (a.ph_hi - a.ph_lo) > 1;
    if (multi) {
        if (threadIdx.x < 4) ((volatile LAS unsigned*)(LAS char*)(lds + LDS_BARST))[threadIdx.x] = 0u;
        __syncthreads();
        bar = xcd_barrier_post((unsigned*)(a.ws + WS_CTL), (volatile LAS unsigned*)(LAS char*)(lds + LDS_BARST));
    }
#ifndef P7_PROBE
#define P7_PROBE -1
#endif
#ifndef DBL_PHASE
#define DBL_PHASE 0
#endif
#if DBL_PHASE != 0
#define RUN_PHASE(P, CALL) do { if (a.ph_lo <= (P) && (P) < a.ph_hi) { const int nrep_ = ((a.dbl >> (P)) & 1) ? 2 : 1; for (int rep_ = 0; rep_ < nrep_; ++rep_) { CALL; if ((P) + 1 < a.ph_hi || rep_ + 1 < nrep_) xcd_barrier(bar); } } } while (0)
#else
#define RUN_PHASE(P, CALL) do { if (a.ph_lo <= (P) && (P) < a.ph_hi) { CALL; if ((P) + 1 < a.ph_hi) xcd_barrier(bar); } } while (0)
#endif
#if !defined(ONLY_PHASE) || ONLY_PHASE == 0
    RUN_PHASE(0, phase_prep(a, lds, vb0, nb));
#endif
    int vb = vb0;
    if (multi && a.ph_lo == 0 && a.ph_hi > 1) {
        if (threadIdx.x == 0) { unsigned off = 0; for (unsigned j = 0; j < bar.x; ++j) off += xb_ld(&bar.bar[XB_XCNT(j)]); bar.st[3] = off + bar.st[2]; }
        __syncthreads();
        vb = (int)bar.st[3];
    }
#if !defined(ONLY_PHASE) || ONLY_PHASE == 1
    RUN_PHASE(1, phase_xn(a, vb, nb));
#endif
#if !defined(ONLY_PHASE) || ONLY_PHASE == 2
    RUN_PHASE(2, phase_inproj(a, lds, vb, nb));
#endif
#if (!defined(ONLY_PHASE) || ONLY_PHASE == 3) && !(defined(DBG_DIGEST) && DBG_DIGEST == 2)
    RUN_PHASE(3, phase_mixer(a, lds, vb, nb));
#endif
#ifdef DBG_DIGEST
    if (a.ph_lo <= 4 && 4 < a.ph_hi) phase_digest(a, vb, nb);
    return;
#endif
#if !defined(ONLY_PHASE) || ONLY_PHASE == 4
    RUN_PHASE(4, phase_outproj(a, lds, vb, nb));
#endif
#if !defined(ONLY_PHASE) || ONLY_PHASE == 5
    RUN_PHASE(5, phase_rowpass(a, vb, nb));
#endif
#if !defined(ONLY_PHASE) || ONLY_PHASE == 6
    RUN_PHASE(6, phase_peer_topk(a, lds, vb, nb));
#endif
#if !defined(ONLY_PHASE) || ONLY_PHASE == 7
    RUN_PHASE(7, phase_peer_gather(a, lds, vb, nb));
#endif
}

extern "C" void kernel_launch(void* const* d_in, const int* in_sizes, int n_in, void* d_out, int out_size, void* d_ws, size_t ws_size, hipStream_t stream) {
    static int grid = 0;
    if (grid == 0) {
        if (n_in != 25 || out_size != NTOK * DM || ws_size < WS_END) { fprintf(stderr, "kernel_launch: unexpected shapes (n_in %d, out %d, ws %zu, need %zu)\n", n_in, out_size, ws_size, (size_t)WS_END); grid = -1; return; }
        int dev = 0, cus = 0;
        if (hipGetDevice(&dev) != hipSuccess || hipDeviceGetAttribute(&cus, hipDeviceAttributeMultiprocessorCount, dev) != hipSuccess) { grid = -1; return; }
        if (hipFuncSetAttribute((const void*)mk_fwd, hipFuncAttributeMaxDynamicSharedMemorySize, LDS_BYTES) != hipSuccess) { fprintf(stderr, "kernel_launch: hipFuncSetAttribute failed\n"); grid = -1; return; }
        (void)hipGetLastError();
        grid = cus;
    }
    if (grid < 0) return;
    (void)hipMemsetAsync((char*)d_ws + WS_CTL, 0, CTL_BYTES, stream);
    Args a{};
    for (int i = 0; i < 25; ++i) a.in[i] = (const float*)d_in[i];
    a.out = (float*)d_out; a.ws = (unsigned char*)d_ws; a.dbl = DBL_PHASE; a.probe = P7_PROBE;
#if MK_N_LAUNCHES == 1
    a.ph_lo = 0; a.ph_hi = N_PHASES;
    hipLaunchKernelGGL(mk_fwd, dim3(grid), dim3(NTHR), LDS_BYTES, stream, a);
#else
    for (int ph = 0; ph < N_PHASES; ++ph) { a.ph_lo = ph; a.ph_hi = ph + 1; hipLaunchKernelGGL(mk_fwd, dim3(grid), dim3(NTHR), LDS_BYTES, stream, a); }
#endif
}
```

```cpp
#include <hip/hip_runtime.h>
#include <cstdio>
#include <cstdint>

#ifndef MK_N_LAUNCHES
#define MK_N_LAUNCHES 1
#endif

typedef unsigned short bf16_t;
typedef short bf16x8 __attribute__((ext_vector_type(8)));
typedef float f32x16 __attribute__((ext_vector_type(16)));
typedef float f32x4 __attribute__((ext_vector_type(4)));
typedef float f32x2 __attribute__((ext_vector_type(2)));
typedef unsigned u32x4 __attribute__((ext_vector_type(4)));
typedef unsigned u32x2 __attribute__((ext_vector_type(2)));
typedef int i32x8 __attribute__((ext_vector_type(8)));
typedef int i32x4 __attribute__((ext_vector_type(4)));
#define LAS __attribute__((address_space(3)))

constexpr int DM = 1024, NB = 16, SEQ = 2048, CTX = 256, STOT = SEQ + CTX;
constexpr int NTOK = NB * SEQ;
constexpr int NCTX = NB * CTX;
constexpr int NROWS = NTOK + NCTX;
constexpr int DIN = 1792, DLRU = 512;
constexpr int KOUT = 1536;
constexpr int PEER_N = 16384;
constexpr float EPS = 1e-6f;
constexpr int NTHR = 512;

constexpr size_t al256(size_t x) { return (x + 255) & ~(size_t)255; }
constexpr size_t WS_CTL   = 0;
constexpr size_t CTL_BYTES = 65536;
constexpr size_t WS_MOD   = WS_CTL + CTL_BYTES;
constexpr size_t WS_ROPE  = WS_MOD + al256(17 * 6144 * 4);
constexpr size_t WS_WIN   = WS_ROPE + al256(64 * 16 * 2 * 4);
constexpr size_t WS_WOUT  = WS_WIN + al256((size_t)DIN * DM * 2);
constexpr size_t WS_WQ    = WS_WOUT + al256((size_t)DM * KOUT * 2);
constexpr size_t WS_SUBK  = WS_WQ + al256((size_t)2048 * DM * 2);
constexpr size_t WS_RGW   = WS_SUBK + al256((size_t)8 * 2 * 128 * 128 * 2);
constexpr size_t WS_UT    = WS_RGW + al256((size_t)2 * 8 * 128 * 64 * 2);
constexpr size_t WS_VT    = WS_UT + al256((size_t)PEER_N * DM * 2);
constexpr size_t WS_XN    = WS_VT + al256((size_t)PEER_N * DM * 2);
constexpr size_t WS_Q     = WS_XN + al256((size_t)NROWS * DM * 2);
constexpr size_t WS_K     = WS_Q + al256((size_t)NTOK * 512 * 2);
constexpr size_t WS_VV    = WS_K + al256((size_t)NB * 2 * STOT * 64 * 2);
constexpr size_t WS_L     = WS_VV + al256((size_t)NB * 2 * STOT * 64 * 2);
constexpr size_t WS_ZG    = WS_L + al256((size_t)NB * STOT * DLRU * 2);
constexpr size_t WS_A2    = WS_ZG + al256((size_t)NTOK * DLRU * 2);
constexpr size_t WS_END   = WS_A2 + al256((size_t)NTOK * KOUT * 2);
constexpr size_t WS_MIX   = WS_XN;
constexpr size_t WS_HX2   = WS_A2;
constexpr size_t WS_XM    = WS_Q;
constexpr size_t WS_IDX   = WS_ZG;
constexpr size_t WS_GATE  = WS_ZG + (size_t)NTOK * 128 * 4;
static_assert(WS_MIX + (size_t)NTOK * DM * 4 <= WS_ZG, "MIX overlay must end before ZG");
static_assert(WS_GATE + (size_t)NTOK * 128 * 4 <= WS_A2, "IDX/GATE overlay must end before A2");

typedef __bf16 bf16x2_t __attribute__((ext_vector_type(2)));
__device__ __forceinline__ unsigned pk2(float lo, float hi) { const f32x2 v = {lo, hi}; const bf16x2_t b = __builtin_convertvector(v, bf16x2_t); return __builtin_bit_cast(unsigned, b); }
typedef _Float16 h16x2 __attribute__((ext_vector_type(2)));
constexpr float V_SCALE = 64.f;
constexpr float T_SCALE = 256.f;
#ifndef P7_FP8
#define P7_FP8 1
#endif
__device__ __forceinline__ unsigned pkh2(float lo, float hi) { const h16x2 h = {(_Float16)lo, (_Float16)hi}; return __builtin_bit_cast(unsigned, h); }
__device__ __forceinline__ bf16x2_t as_bf2(unsigned x) { return __builtin_bit_cast(bf16x2_t, x); }
__device__ __forceinline__ h16x2 as_h2(unsigned x) { return __builtin_bit_cast(h16x2, x); }
__device__ __forceinline__ bf16_t f2bf(float f) { return (bf16_t)(pk2(f, 0.f) & 0xffffu); }
__device__ __forceinline__ float bf2f(unsigned h) { return __uint_as_float(h << 16); }
__device__ __forceinline__ float bflo(unsigned w) { return __uint_as_float(w << 16); }
__device__ __forceinline__ float bfhi(unsigned w) { return __uint_as_float(w & 0xffff0000u); }
__device__ __forceinline__ float sat8(float x) { return fminf(fmaxf(x, -448.f), 448.f); }
__device__ __forceinline__ float fast_rcp(float x) { return __builtin_amdgcn_rcpf(x); }
__device__ __forceinline__ float sigmoidf_(float x) { return fast_rcp(1.f + __expf(-x)); }
__device__ __forceinline__ float gelu_tanh(float x) { const float y = 0.7978845608028654f * (x + 0.044715f * x * x * x); return x * fast_rcp(1.f + __expf(-2.f * y)); }
__device__ __forceinline__ float silu_(float x) { return x * sigmoidf_(x); }
__device__ __forceinline__ float wave_sum(float v) {
#pragma unroll
    for (int o = 32; o > 0; o >>= 1) v += __shfl_xor(v, o);
    return v;
}
__device__ __forceinline__ float half_swap_max(float v) { auto rr = __builtin_amdgcn_permlane32_swap(__float_as_uint(v), __float_as_uint(v), false, false); return fmaxf(__uint_as_float(rr[0]), __uint_as_float(rr[1])); }
__device__ __forceinline__ float half_swap_sum(float v) { auto rr = __builtin_amdgcn_permlane32_swap(__float_as_uint(v), __float_as_uint(v), false, false); return __uint_as_float(rr[0]) + __uint_as_float(rr[1]); }
#define MFMA(a, b, c) __builtin_amdgcn_mfma_f32_32x32x16_bf16((a), (b), (c), 0, 0, 0)

#define XB_TMO      128
#define XB_XCNT(j)  (256  + 64 * (j))
#define XB_XSUB(j)  (1280 + 64 * (j))
#define XB_XGEN(j)  (2304 + 64 * (j))
#define XB_TOP      3328
#define XB_TOPGEN   3392
#define XCD_BAR_WORDS 3456
#define XB_SPIN_CAP (1u << 20)
__device__ __forceinline__ unsigned xb_ld(unsigned* p)              { return __hip_atomic_load(p, __ATOMIC_RELAXED, __HIP_MEMORY_SCOPE_AGENT); }
__device__ __forceinline__ unsigned xb_add(unsigned* p, unsigned v) { return __hip_atomic_fetch_add(p, v, __ATOMIC_RELAXED, __HIP_MEMORY_SCOPE_AGENT); }
__device__ __forceinline__ unsigned xb_xcc_id() { return (unsigned)__builtin_amdgcn_s_getreg((3 << 11) | 20) & 0xFu; }
#define XB_SPIN(cond, bar) do { unsigned _sp = 0; while (cond) { __builtin_amdgcn_s_sleep(1); \
    if ((++_sp & 255u) == 0u) { if (xb_ld(&(bar)[XB_TMO])) break; if (_sp > XB_SPIN_CAP) { atomicAdd(&(bar)[XB_TMO], 1u); break; } } } } while (0)
struct XcdBarrier { unsigned* bar; unsigned x; volatile LAS unsigned* st; };
__device__ __forceinline__ XcdBarrier xcd_barrier_post(unsigned* bar, volatile LAS unsigned* st) {
    XcdBarrier b; b.bar = bar; b.x = xb_xcc_id(); b.st = st;
    if (threadIdx.x == 0) st[2] = xb_add(&bar[XB_XCNT(b.x)], 1u);
    return b;
}
__device__ __forceinline__ void xcd_barrier_complete(unsigned* bar, unsigned x, unsigned& nloc, unsigned& nx) {
    const unsigned G = gridDim.x * gridDim.y * gridDim.z;
    unsigned sum, cnt, mine, sp = 0u;
    for (;;) {
        sum = 0u; cnt = 0u; mine = 0u;
#pragma unroll
        for (unsigned j = 0; j < 16; ++j) { const unsigned c = xb_ld(&bar[XB_XCNT(j)]); sum += c; cnt += (c > 0u) ? 1u : 0u; mine = (j == x) ? c : mine; }
        if (sum == G) break;
        __builtin_amdgcn_s_sleep(1);
        if ((++sp & 255u) == 0u) { if (xb_ld(&bar[XB_TMO])) break; if (sp > XB_SPIN_CAP) { atomicAdd(&bar[XB_TMO], 1u); break; } }
    }
    nloc = mine > 0u ? mine : 1u; nx = cnt > 0u ? cnt : 1u;
}
__device__ __forceinline__ void xcd_barrier(const XcdBarrier& b) {
    asm volatile("s_waitcnt vmcnt(0)" ::: "memory");
    __syncthreads();
    if (threadIdx.x == 0) {
        unsigned* bar = b.bar;
        __builtin_amdgcn_s_waitcnt(0);
        unsigned nloc = b.st[0], nx = b.st[1];
        if (nloc == 0u) { xcd_barrier_complete(bar, b.x, nloc, nx); b.st[0] = nloc; b.st[1] = nx; }
        const unsigned old = xb_add(&bar[XB_XSUB(b.x)], 1u);
        const unsigned gen = old / nloc;
        if (old + 1u == (gen + 1u) * nloc) {
            __builtin_amdgcn_fence(__ATOMIC_RELEASE, "agent");
            asm volatile("s_waitcnt vmcnt(0)" ::: "memory");
            const unsigned og = xb_add(&bar[XB_TOP], 1u);
            const unsigned tg = og / nx;
            if (og + 1u == (tg + 1u) * nx) xb_add(&bar[XB_TOPGEN], 1u);
            else XB_SPIN(xb_ld(&bar[XB_TOPGEN]) == tg, bar);
            __builtin_amdgcn_fence(__ATOMIC_ACQUIRE, "agent");
            xb_add(&bar[XB_XGEN(b.x)], 1u);
            asm volatile("s_waitcnt vmcnt(0)" ::: "memory");
        } else {
            XB_SPIN(xb_ld(&bar[XB_XGEN(b.x)]) == gen, bar);
            __builtin_amdgcn_fence(__ATOMIC_ACQUIRE, "agent");
            asm volatile("s_waitcnt vmcnt(0)" ::: "memory");
        }
    }
    __syncthreads();
}

struct Args { const float* in[25]; float* out; unsigned char* ws; int ph_lo, ph_hi, dbl, probe; };
enum { I_X = 0, I_C, I_CTX, I_CCTX, I_WMOD, I_BMOD, I_GPREMIX, I_GPOSTMIX, I_GPREFFN, I_GPOSTFFN, I_WIN, I_QNG, I_KNG, I_CONVW, I_CONVB,
       I_RGWA, I_RGBA, I_RGWI, I_RGBI, I_RGLAM, I_WOUT, I_PWQ, I_PSUBK, I_PU, I_PV };

__device__ __forceinline__ void tr_tile(const float* __restrict__ src, int lds_, int sr0, int sc0, bf16_t* __restrict__ dst, int ldd, int dr0, int dc0, float* T) {
    const int tid = threadIdx.x;
#pragma unroll
    for (int i = 0; i < 8; ++i) { const int e = tid + NTHR * i, r = e >> 6, c = e & 63; T[r * 65 + c] = src[(size_t)(sr0 + r) * lds_ + sc0 + c]; }
    __syncthreads();
#pragma unroll
    for (int i = 0; i < 8; ++i) { const int e = tid + NTHR * i, c = e >> 6, r = e & 63; dst[(size_t)(dr0 + c) * ldd + dc0 + r] = f2bf(T[r * 65 + c]); }
    __syncthreads();
}
__device__ __forceinline__ void tr_tile2(const float* __restrict__ srcA, const float* __restrict__ srcB, int lds_, bf16_t* __restrict__ dstA, bf16_t* __restrict__ dstB, int ldd, float* T) {
    const int tid = threadIdx.x;
    float va[8], vb2[8];
#pragma unroll
    for (int i = 0; i < 8; ++i) { const int e = tid + NTHR * i, r = e >> 6, c = e & 63; va[i] = srcA[(size_t)r * lds_ + c]; vb2[i] = srcB[(size_t)r * lds_ + c]; }
#pragma unroll
    for (int i = 0; i < 8; ++i) { const int e = tid + NTHR * i, r = e >> 6, c = e & 63; T[r * 65 + c] = va[i]; T[4160 + r * 65 + c] = vb2[i]; }
    __syncthreads();
#pragma unroll
    for (int i = 0; i < 8; ++i) { const int e = tid + NTHR * i, c = e >> 6, r = e & 63; dstA[(size_t)c * ldd + r] = f2bf(T[r * 65 + c]); dstB[(size_t)c * ldd + r] = f2bf(T[4160 + r * 65 + c]); }
    __syncthreads();
}

constexpr int UV_ITEMS = 512;
constexpr int CTL_UVCTR = 8192;
__device__ __forceinline__ void conv_uv_item(const Args& a, int t) {
    const int tid = threadIdx.x;
    const bool isv = t >= 256; const int tt = t & 255;
    const float* src = (isv ? a.in[I_PV] : a.in[I_PU]) + (size_t)tt * 65536;
    unsigned char* d8 = a.ws + (isv ? WS_VT : WS_UT) + (size_t)tt * 65536;
#pragma unroll 1
    for (int e0 = tid * 16; e0 < 65536; e0 += NTHR * 16 * 4) {
        f32x4 v[4][4];
#pragma unroll
        for (int u = 0; u < 4; ++u)
#pragma unroll
            for (int q = 0; q < 4; ++q) v[u][q] = *(const f32x4*)(src + e0 + u * NTHR * 16 + q * 4);
#pragma unroll
        for (int u = 0; u < 4; ++u) { u32x4 o;
#pragma unroll
            for (int q = 0; q < 4; ++q) { f32x4 x = v[u][q] * T_SCALE;
#pragma unroll
                for (int i = 0; i < 4; ++i) x[i] = fminf(fmaxf(x[i], -448.f), 448.f);
                int w = __builtin_amdgcn_cvt_pk_fp8_f32(x[0], x[1], 0, false); w = __builtin_amdgcn_cvt_pk_fp8_f32(x[2], x[3], w, true); o[q] = (unsigned)w; }
            *(u32x4*)(d8 + e0 + u * NTHR * 16) = o; }
    }
}
__device__ void phase_prep(const Args& a, char* lds, int vb, int nb) {
    const int tid = threadIdx.x;
    unsigned char* ws = a.ws;
    float* S = (float*)lds;
    float* T = (float*)lds;
    constexpr int N_MOD = 256, N_TIN = 224, N_TOUT = 192, N_TWQ = 256, N_RGW = 16, N_SUBK = 16, N_UV = 0, N_MISC = 1;
    constexpr int O_TIN = N_MOD, O_TOUT = O_TIN + N_TIN, O_TWQ = O_TOUT + N_TOUT, O_RGW = O_TWQ + N_TWQ, O_SUBK = O_RGW + N_RGW, O_UV = O_SUBK + N_SUBK, O_MISC = O_UV + N_UV, N_ALL = O_MISC + N_MISC;
    for (int it = vb; it < N_ALL; it += nb) {
        if (it < O_TIN) {
            {
                int tq = tid; asm volatile("" : "+v"(tq));
                const float* cp = a.in[I_C] + tq; const float* xp = a.in[I_CCTX] + tq;
                float cv[17];
#pragma unroll
                for (int i = 0; i < 17; ++i) cv[i] = cp[NTHR * i];
#pragma unroll
                for (int i = 0; i < 17; ++i) S[tid + NTHR * i] = silu_(cv[i]);
#pragma unroll
                for (int i = 0; i < 15; ++i) cv[i] = cp[NTHR * (17 + i)];
                cv[15] = xp[0]; cv[16] = xp[NTHR];
#pragma unroll
                for (int i = 0; i < 17; ++i) S[tid + NTHR * (17 + i)] = silu_(cv[i]);
            }
            __syncthreads();
            const int n0 = it * 24;
            const int cc = tid % 6, kk = tid / 6;
            float acc[17][4];
#pragma unroll
            for (int r = 0; r < 17; ++r) { acc[r][0] = 0.f; acc[r][1] = 0.f; acc[r][2] = 0.f; acc[r][3] = 0.f; }
            if (tid < 510) {
#pragma unroll 1
                for (int i0 = 0; i0 < 16; i0 += 4) {
                    f32x4 wv[4];
#pragma unroll
                    for (int i = 0; i < 4; ++i) { const int k = min(kk + 85 * (i0 + i), 1023); wv[i] = *(const f32x4*)(a.in[I_WMOD] + (size_t)k * 6144 + n0 + cc * 4); }
#pragma unroll
                    for (int i = 0; i < 4; ++i) { const int k = kk + 85 * (i0 + i); const bool ok = k < 1024; const int kc = min(k, 1023);
                        const f32x4 w = ok ? wv[i] : (f32x4){0.f, 0.f, 0.f, 0.f};
#pragma unroll
                        for (int r = 0; r < 17; ++r) { const float s = S[r * 1024 + kc]; acc[r][0] += s * w[0]; acc[r][1] += s * w[1]; acc[r][2] += s * w[2]; acc[r][3] += s * w[3]; }
                    }
                }
            }
            __syncthreads();
            if (tid < 510) {
#pragma unroll
                for (int r = 0; r < 17; ++r) { f32x4 v = {acc[r][0], acc[r][1], acc[r][2], acc[r][3]}; *(f32x4*)(S + (kk * 17 + r) * 24 + cc * 4) = v; }
            }
            __syncthreads();
            float* mod = (float*)(ws + WS_MOD);
            for (int e = tid; e < 17 * 24; e += NTHR) { const int r = e / 24, j = e % 24; float sum = 0.f;
                for (int q = 0; q < 85; ++q) sum += S[(q * 17 + r) * 24 + j];
                mod[r * 6144 + n0 + j] = sum + a.in[I_BMOD][n0 + j]; }
            __syncthreads();
        } else if (it < O_TOUT) {
            const int t = it - O_TIN, kt = t / 14, nt = (t % 14) * 2;
            const float* sp = a.in[I_WIN] + (size_t)(kt * 64) * DIN + nt * 64; bf16_t* dp = (bf16_t*)(ws + WS_WIN) + (size_t)(nt * 64) * DM + kt * 64;
            tr_tile2(sp, sp + 64, DIN, dp, dp + (size_t)64 * DM, DM, T);
        } else if (it < O_TWQ) {
            const int t = it - O_TOUT, kt = t / 8, nt = (t % 8) * 2;
            const int sk = (kt < 16) ? kt * 64 : (kt - 16) * 64 + 512;
            const float* sp = a.in[I_WOUT] + (size_t)sk * DM + nt * 64; bf16_t* dp = (bf16_t*)(ws + WS_WOUT) + (size_t)(nt * 64) * KOUT + kt * 64;
            tr_tile2(sp, sp + 64, DM, dp, dp + (size_t)64 * KOUT, KOUT, T);
        } else if (it < O_RGW) {
            const int t = it - O_TWQ, kt = t / 16, nt = (t % 16) * 2;
            const float* sp = a.in[I_PWQ] + (size_t)(kt * 64) * 2048 + nt * 64; bf16_t* dp = (bf16_t*)(ws + WS_WQ) + (size_t)(nt * 64) * DM + kt * 64;
            tr_tile2(sp, sp + 64, 2048, dp, dp + (size_t)64 * DM, DM, T);
        } else if (it < O_SUBK) {
            const int dn = it - O_RGW;
            bf16_t* dp = (bf16_t*)(ws + WS_RGW) + (size_t)dn * 128 * 64;
            tr_tile2(a.in[I_RGWA] + (size_t)dn * 4096, a.in[I_RGWI] + (size_t)dn * 4096, 64, dp, dp + 64 * 64, 64, T);
        } else if (it < O_UV) {
            const int t = it - O_SUBK; const float* src = a.in[I_PSUBK] + (size_t)t * 16384; bf16_t* dst = (bf16_t*)(ws + WS_SUBK) + (size_t)t * 16384;
            for (int e = tid * 4; e < 16384; e += NTHR * 4) { const f32x4 v = *(const f32x4*)(src + e); u32x2 o = {pk2(v[0], v[1]), pk2(v[2], v[3])}; *(u32x2*)(dst + e) = o; }
        } else {
            float* rope = (float*)(ws + WS_ROPE);
            for (int e = tid; e < 64 * 16; e += NTHR) { const int pos = e >> 4, f = e & 15; const float inv = powf(10000.f, -(float)f / 16.f); const float ang = (float)pos * inv; rope[e * 2] = cosf(ang); rope[e * 2 + 1] = sinf(ang); }
        }
    }
}

__device__ void phase_xn(const Args& a, int vb, int nb) {
    const int tid = threadIdx.x, lane = tid & 63, wid = tid >> 6;
    const float* mod = (const float*)(a.ws + WS_MOD);
    bf16_t* XN = (bf16_t*)(a.ws + WS_XN);
    const float* g = a.in[I_GPREMIX];
    const int chunk = (NROWS + nb - 1) / nb, rend = min(NROWS, (vb + 1) * chunk);
    f32x4 A[4], B[4]; int cur = -1;
    for (int row = vb * chunk + wid; row < rend; row += 8) {
        const float* src; int mrow;
        if (row < NTOK) { src = a.in[I_X] + (size_t)row * DM; mrow = row >> 11; } else { src = a.in[I_CTX] + (size_t)(row - NTOK) * DM; mrow = 16; }
        f32x4 v[4]; float ss = 0.f;
#pragma unroll
        for (int i = 0; i < 4; ++i) v[i] = *(const f32x4*)(src + i * 256 + lane * 4);
        if (mrow != cur) { cur = mrow; const float* sh = mod + (size_t)mrow * 6144, *sc = sh + 1024;
#pragma unroll
            for (int i = 0; i < 4; ++i) { const int c = i * 256 + lane * 4; const f32x4 gg = *(const f32x4*)(g + c), s1 = *(const f32x4*)(sc + c); B[i] = *(const f32x4*)(sh + c);
#pragma unroll
                for (int j = 0; j < 4; ++j) A[i][j] = gg[j] * (1.f + s1[j]); } }
#pragma unroll
        for (int i = 0; i < 4; ++i) ss += v[i][0] * v[i][0] + v[i][1] * v[i][1] + v[i][2] * v[i][2] + v[i][3] * v[i][3];
        ss = wave_sum(ss);
        const float rinv = rsqrtf(ss * (1.f / DM) + EPS);
#pragma unroll
        for (int i = 0; i < 4; ++i) { const int c = i * 256 + lane * 4;
            float o[4];
#pragma unroll
            for (int j = 0; j < 4; ++j) o[j] = v[i][j] * rinv * A[i][j] + B[i][j];
            u32x2 w = {pk2(o[0], o[1]), pk2(o[2], o[3])}; *(u32x2*)(XN + (size_t)row * DM + c) = w; }
    }
}

constexpr int E_PITCH = 272;
namespace g8 {
constexpr int BM = 256, BK = 64, HALF = 128, HT = HALF * BK, SHM_B = 8 * HT * 2;
__device__ __forceinline__ int lds_byte(int r, int c) { const int st = (r >> 4) * 2 + (c >> 5), rr = r & 15, cc = c & 31, ob = rr * 64 + cc * 2; return st * 1024 + (ob ^ (((ob >> 9) & 1) << 5)); }
__device__ __forceinline__ void stage_rc(int b, int& R, int& C) { const int st = b / 1024, sb = b % 1024, swz = sb ^ (((sb >> 9) & 1) << 5); R = (st >> 1) * 16 + swz / 64; C = (st & 1) * 32 + (swz % 64) / 2; }
__device__ __forceinline__ void core_pre(const bf16_t* __restrict__ A, const bf16_t* __restrict__ Bt, int brow, int bcol, int K, char* lds_) {
    LAS unsigned char* lds = (LAS unsigned char*)lds_;
    const int tid = threadIdx.x, wid = __builtin_amdgcn_readfirstlane(tid >> 6);
    constexpr int HTB = HT * 2;
    unsigned voff[2];
#pragma unroll
    for (int i = 0; i < 2; ++i) { int R, C; stage_rc(tid * 16 + i * 8192, R, C); voff[i] = (unsigned)(R * K + C) * 2u; }
    const size_t hstep = (size_t)HALF * K * 2;
    const unsigned ldsw = (unsigned)wid * 1024u;
    const char* cA = (const char*)(A + (size_t)brow * K); const char* cB = (const char*)(Bt + (size_t)bcol * K);
#define G8P_STAGE(bufoff, gbase) do { _Pragma("unroll") for (int _i = 0; _i < 2; ++_i) \
        __builtin_amdgcn_global_load_lds((const unsigned*)((const char*)(gbase) + voff[_i]), (LAS unsigned*)(lds + (bufoff) + ldsw + _i * 8192), 16, 0, 0); } while (0)
    G8P_STAGE((4 + 0) * HTB, cB); G8P_STAGE(0 * HTB, cA); G8P_STAGE((4 + 1) * HTB, cB + hstep); G8P_STAGE(1 * HTB, cA + hstep);
#undef G8P_STAGE
}
template <bool PRE = false>
__device__ __forceinline__ void core(f32x4 (&acc)[2][2][4][2], const bf16_t* __restrict__ A, const bf16_t* __restrict__ Bt, int brow, int bcol, int K, char* lds_) {
    LAS unsigned char* lds = (LAS unsigned char*)lds_;
    const int tid = threadIdx.x, wid = __builtin_amdgcn_readfirstlane(tid >> 6), lane = tid & 63, wr = wid >> 2, wc = wid & 3, fr = lane & 15, fq = lane >> 4;
    constexpr int HTB = HT * 2;
    unsigned voff[2];
#pragma unroll
    for (int i = 0; i < 2; ++i) { int R, C; stage_rc(tid * 16 + i * 8192, R, C); voff[i] = (unsigned)(R * K + C) * 2u; }
    const size_t kstep = (size_t)(BK * 2), hstep = (size_t)HALF * K * 2;
    const unsigned ldsw = (unsigned)wid * 1024u;
    const int aoff = lds_byte(wr * 64 + fr, fq * 8), boff = lds_byte(wc * 32 + fr, fq * 8);
#define G8_SA(b, h) (((b) * 2 + (h)) * HTB)
#define G8_SB(b, h) ((4 + (b) * 2 + (h)) * HTB)
#define G8_STAGE(bufoff, gbase) do { _Pragma("unroll") for (int _i = 0; _i < 2; ++_i) \
        __builtin_amdgcn_global_load_lds((const unsigned*)((const char*)(gbase) + voff[_i]), (LAS unsigned*)(lds + (bufoff) + ldsw + _i * 8192), 16, 0, 0); } while (0)
#define G8_LDA(dst, b, h) do { _Pragma("unroll") for (int m = 0; m < 4; ++m) _Pragma("unroll") for (int k = 0; k < 2; ++k) dst[m][k] = *(const LAS bf16x8*)(lds + G8_SA(b, h) + aoff + m * 2048 + k * 1024); } while (0)
#define G8_LDB(dst, b, h) do { _Pragma("unroll") for (int n = 0; n < 2; ++n) _Pragma("unroll") for (int k = 0; k < 2; ++k) dst[n][k] = *(const LAS bf16x8*)(lds + G8_SB(b, h) + boff + n * 2048 + k * 1024); } while (0)
#define G8_MMA(ai, bj, At_, Bt_) do { __builtin_amdgcn_s_setprio(1); \
    _Pragma("unroll") for (int m = 0; m < 4; ++m) _Pragma("unroll") for (int n = 0; n < 2; ++n) _Pragma("unroll") for (int k = 0; k < 2; ++k) \
      acc[ai][bj][m][n] = __builtin_amdgcn_mfma_f32_16x16x32_bf16(At_[m][k], Bt_[n][k], acc[ai][bj][m][n], 0, 0, 0); \
    __builtin_amdgcn_s_setprio(0); } while (0)
#define G8_WAIT_V(n) asm volatile("s_waitcnt vmcnt(" #n ")" ::: "memory")
#define G8_WAIT_L(n) asm volatile("s_waitcnt lgkmcnt(" #n ")" ::: "memory")
#define G8_BAR __builtin_amdgcn_s_barrier()
#define G8_SCHED __builtin_amdgcn_sched_barrier(0)
#pragma unroll
    for (int ai = 0; ai < 2; ++ai)
#pragma unroll
        for (int bj = 0; bj < 2; ++bj)
#pragma unroll
            for (int m = 0; m < 4; ++m)
#pragma unroll
                for (int n = 0; n < 2; ++n) acc[ai][bj][m][n] = (f32x4){0.f, 0.f, 0.f, 0.f};
    bf16x8 At[4][2], B0[2][2], B1[2][2];
    const int nt = K / BK;
    const char* cA = (const char*)(A + (size_t)brow * K); const char* cB = (const char*)(Bt + (size_t)bcol * K);
    if (!PRE) { G8_STAGE(G8_SB(0, 0), cB); G8_STAGE(G8_SA(0, 0), cA); G8_STAGE(G8_SB(0, 1), cB + hstep); G8_STAGE(G8_SA(0, 1), cA + hstep); }
    if (wr == 1) G8_BAR;
    if (PRE) G8_WAIT_V(0); else G8_WAIT_V(4);
    G8_BAR;
    G8_STAGE(G8_SB(1, 0), cB + kstep); G8_STAGE(G8_SA(1, 0), cA + kstep); G8_STAGE(G8_SB(1, 1), cB + hstep + kstep);
    G8_WAIT_V(6); G8_BAR;
#pragma unroll 1
    for (int t = 0; t < nt - 2; t += 2) {
        const char* a1 = cA + (size_t)(t + 1) * kstep; const char* a2 = cA + (size_t)(t + 2) * kstep; const char* b2 = cB + (size_t)(t + 2) * kstep;
        const char* a3 = a2 + kstep; const char* b3 = b2 + kstep;
        G8_LDB(B0, 0, 0); G8_SCHED; G8_LDA(At, 0, 0); G8_STAGE(G8_SA(1, 1), a1 + hstep);
        G8_WAIT_L(8); G8_BAR; G8_WAIT_L(0); G8_MMA(0, 0, At, B0); G8_BAR; G8_SCHED;
        G8_LDB(B1, 0, 1); G8_STAGE(G8_SB(0, 0), b2);
        G8_BAR; G8_WAIT_L(0); G8_MMA(0, 1, At, B1); G8_BAR;
        G8_LDA(At, 0, 1); G8_STAGE(G8_SA(0, 0), a2);
        G8_BAR; G8_WAIT_L(0); G8_MMA(1, 0, At, B0); G8_BAR; G8_SCHED;
        G8_STAGE(G8_SB(0, 1), b2 + hstep);
        G8_WAIT_V(6); G8_BAR; G8_MMA(1, 1, At, B1); G8_BAR;
        G8_LDB(B0, 1, 0); G8_SCHED; G8_LDA(At, 1, 0); G8_STAGE(G8_SA(0, 1), a2 + hstep);
        G8_WAIT_L(8); G8_BAR; G8_WAIT_L(0); G8_MMA(0, 0, At, B0); G8_BAR; G8_SCHED;
        G8_LDB(B1, 1, 1); G8_STAGE(G8_SB(1, 0), b3);
        G8_BAR; G8_WAIT_L(0); G8_MMA(0, 1, At, B1); G8_BAR;
        G8_LDA(At, 1, 1); G8_STAGE(G8_SA(1, 0), a3);
        G8_BAR; G8_WAIT_L(0); G8_MMA(1, 0, At, B0); G8_BAR; G8_SCHED;
        G8_STAGE(G8_SB(1, 1), b3 + hstep);
        G8_WAIT_V(6); G8_BAR; G8_MMA(1, 1, At, B1); G8_BAR;
    }
    { G8_LDB(B0, 0, 0); G8_LDA(At, 0, 0); G8_STAGE(G8_SA(1, 1), cA + (size_t)(nt - 1) * kstep + hstep);
      G8_BAR; G8_WAIT_L(0); G8_MMA(0, 0, At, B0); G8_BAR;
      G8_LDB(B1, 0, 1); G8_BAR; G8_WAIT_L(0); G8_MMA(0, 1, At, B1); G8_BAR;
      G8_LDA(At, 0, 1); G8_WAIT_V(4); G8_BAR; G8_WAIT_L(0); G8_MMA(1, 0, At, B0); G8_MMA(1, 1, At, B1); G8_BAR; }
    { G8_LDB(B0, 1, 0); G8_LDA(At, 1, 0); G8_WAIT_V(2); G8_BAR; G8_WAIT_L(0); G8_MMA(0, 0, At, B0); G8_BAR;
      G8_LDB(B1, 1, 1); G8_WAIT_V(0); G8_BAR; G8_WAIT_L(0); G8_MMA(0, 1, At, B1); G8_BAR;
      G8_LDA(At, 1, 1); G8_BAR; G8_WAIT_L(0); G8_MMA(1, 0, At, B0); G8_MMA(1, 1, At, B1); G8_BAR; }
    if (wr == 0) G8_BAR;
#undef G8_SA
#undef G8_SB
#undef G8_STAGE
#undef G8_LDA
#undef G8_LDB
#undef G8_MMA
#undef G8_WAIT_V
#undef G8_WAIT_L
#undef G8_BAR
#undef G8_SCHED
}
}

__device__ void phase_inproj(const Args& a, char* lds, int vb, int nb) {
    const int tid = threadIdx.x, lane = tid & 63, wid = tid >> 6, wr = wid >> 2, wc = wid & 3, fr = lane & 15, fq = lane >> 4;
    unsigned char* ws = a.ws;
    const bf16_t* XN = (const bf16_t*)(ws + WS_XN);
    const bf16_t* WIN = (const bf16_t*)(ws + WS_WIN);
    const float* rope = (const float*)(ws + WS_ROPE);
    bf16_t* Qo = (bf16_t*)(ws + WS_Q); bf16_t* Ko = (bf16_t*)(ws + WS_K); bf16_t* Vo = (bf16_t*)(ws + WS_VV); bf16_t* Lo = (bf16_t*)(ws + WS_L); bf16_t* Zo = (bf16_t*)(ws + WS_ZG);
    constexpr int N_LAT = 128 * 7, N_ALL = N_LAT + 16 * 3;
#define P2_TILE(it_, tt_, ft_) int tt_, ft_; if ((it_) < N_LAT) { tt_ = (it_) / 7; ft_ = (it_) % 7; } else { const int j_ = (it_) - N_LAT; tt_ = 128 + j_ / 3; ft_ = 2 + j_ % 3; }
    if (vb < N_ALL) { P2_TILE(vb, t0_, f0_); g8::core_pre(WIN, XN, f0_ * 256, t0_ * 256, DM, lds); }
#pragma unroll 1
    for (int it = vb; it < N_ALL; it += nb) {
        P2_TILE(it, tt, ft);
        f32x4 acc[2][2][4][2];
        g8::core<true>(acc, WIN, XN, ft * 256, tt * 256, DM, lds);
        if (it + nb < N_ALL) { P2_TILE(it + nb, t1_, f1_); g8::core_pre(WIN, XN, f1_ * 256, t1_ * 256, DM, lds); }
        const bool lat = tt < 128;
#pragma unroll
        for (int ai = 0; ai < 2; ++ai) {
            const int g64 = ft * 4 + ai * 2 + wr;
            if (g64 < 10) {
                const bool isq = g64 < 8;
                const float* gn = isq ? a.in[I_QNG] : a.in[I_KNG];
                const float osc = isq ? 0.125f * 1.4426950408889634f : 1.f;
                float gnv[4][4];
#pragma unroll
                for (int m = 0; m < 4; ++m) { const f32x4 gv = *(const f32x4*)(gn + m * 16 + fq * 4); gnv[m][0] = gv[0]; gnv[m][1] = gv[1]; gnv[m][2] = gv[2]; gnv[m][3] = gv[3]; }
#pragma unroll
                for (int bj = 0; bj < 2; ++bj)
#pragma unroll
                    for (int n = 0; n < 2; ++n) {
                        float ss = 0.f;
#pragma unroll
                        for (int m = 0; m < 4; ++m)
#pragma unroll
                            for (int j = 0; j < 4; ++j) ss += acc[ai][bj][m][n][j] * acc[ai][bj][m][n][j];
                        ss += __shfl_xor(ss, 16); ss += __shfl_xor(ss, 32);
                        const float rinv = rsqrtf(ss * (1.f / 64.f) + EPS);
                        const int row = tt * 256 + bj * 128 + wc * 32 + n * 16 + fr;
                        int b, t, s_; if (lat) { b = row >> 11; t = row & 2047; s_ = CTX + t; } else { const int rc = row - NTOK; b = rc >> 8; t = 0; s_ = rc & 255; }
                        bf16_t* dst = isq ? Qo + ((size_t)(b * 8 + g64) * SEQ + t) * 64 : Ko + ((size_t)(b * 2 + (g64 - 8)) * STOT + s_) * 64;
                        f32x4 csv[2][2];
#pragma unroll
                        for (int ax = 0; ax < 2; ++ax) { const int pos = ax == 0 ? (t >> 6) : (t & 63); const float* rp = rope + (pos * 16 + fq * 4) * 2;
                            csv[ax][0] = *(const f32x4*)rp; csv[ax][1] = *(const f32x4*)(rp + 4); }
#pragma unroll
                        for (int ax = 0; ax < 2; ++ax) {
                            float o1[4], o2[4];
#pragma unroll
                            for (int j = 0; j < 4; ++j) {
                                const float x1 = acc[ai][bj][2 * ax][n][j] * rinv * gnv[2 * ax][j], x2 = acc[ai][bj][2 * ax + 1][n][j] * rinv * gnv[2 * ax + 1][j];
                                const float co = lat ? csv[ax][j >> 1][(j & 1) * 2] : 1.f, si = lat ? csv[ax][j >> 1][(j & 1) * 2 + 1] : 0.f;
                                const float c1 = x1 * co - x2 * si, c2 = x1 * si + x2 * co;
                                o1[j] = c1 * osc; o2[j] = c2 * osc; }
                            *(u32x2*)(dst + ax * 32 + fq * 4) = (u32x2){pk2(o1[0], o1[1]), pk2(o1[2], o1[3])};
                            *(u32x2*)(dst + ax * 32 + 16 + fq * 4) = (u32x2){pk2(o2[0], o2[1]), pk2(o2[2], o2[3])};
                        }
                    }
            } else if (g64 < 12) {
#pragma unroll
                for (int bj = 0; bj < 2; ++bj)
#pragma unroll
                    for (int n = 0; n < 2; ++n) {
                        const int row = tt * 256 + bj * 128 + wc * 32 + n * 16 + fr;
                        int b, s_; if (lat) { b = row >> 11; s_ = CTX + (row & 2047); } else { const int rc = row - NTOK; b = rc >> 8; s_ = rc & 255; }
                        bf16_t* vp = Vo + ((size_t)(b * 2 + (g64 - 10)) * 64) * STOT + s_;
#pragma unroll
                        for (int m = 0; m < 4; ++m)
#pragma unroll
                            for (int j = 0; j < 4; ++j) vp[(size_t)(m * 16 + fq * 4 + j) * STOT] = f2bf(acc[ai][bj][m][n][j]);
                    }
            } else {
                const bool isz = g64 >= 20;
#pragma unroll
                for (int bj = 0; bj < 2; ++bj)
#pragma unroll
                    for (int n = 0; n < 2; ++n) {
                        const int row = tt * 256 + bj * 128 + wc * 32 + n * 16 + fr;
                        bf16_t* dst;
                        if (isz) dst = Zo + (size_t)row * DLRU + (g64 - 20) * 64;
                        else { int b, s_; if (lat) { b = row >> 11; s_ = CTX + (row & 2047); } else { const int rc = row - NTOK; b = rc >> 8; s_ = rc & 255; }
                            dst = Lo + ((size_t)b * STOT + s_) * DLRU + (g64 - 12) * 64; }
#pragma unroll
                        for (int m = 0; m < 4; ++m) { f32x4 v = acc[ai][bj][m][n];
                            if (isz) { v[0] = gelu_tanh(v[0]); v[1] = gelu_tanh(v[1]); v[2] = gelu_tanh(v[2]); v[3] = gelu_tanh(v[3]); }
                            *(u32x2*)(dst + m * 16 + fq * 4) = (u32x2){pk2(v[0], v[1]), pk2(v[2], v[3])}; }
                    }
            }
        }
        __syncthreads();
    }
    {
        unsigned* ctr = (unsigned*)(ws + WS_CTL) + CTL_UVCTR;
        volatile int* slot = (volatile int*)lds;
        for (;;) {
            if (tid == 0) *slot = (int)__hip_atomic_fetch_add(ctr, 1u, __ATOMIC_RELAXED, __HIP_MEMORY_SCOPE_AGENT);
            __syncthreads();
            const int t = *slot;
            __syncthreads();
            if (t >= UV_ITEMS) break;
            conv_uv_item(a, t);
        }
    }
}

constexpr int AT_KP = 144, AT_VP = 136, AT_STAGE = 64 * AT_KP + 64 * AT_VP;
__device__ void attn_item(const Args& a, char* lds, int b, int head, int qblk) {
    const int tid = threadIdx.x, lane = tid & 63, wid = tid >> 6, r32 = lane & 31, hi = lane >> 5;
    unsigned char* ws = a.ws;
    const int kvh = head >> 2;
    const bf16_t* Qp = (const bf16_t*)(ws + WS_Q) + ((size_t)(b * 8 + head) * SEQ + qblk * 256 + wid * 32 + r32) * 64 + hi * 8;
    const bf16_t* Kp = (const bf16_t*)(ws + WS_K) + (size_t)(b * 2 + kvh) * STOT * 64;
    const bf16_t* Vp = (const bf16_t*)(ws + WS_VV) + (size_t)(b * 2 + kvh) * 64 * STOT;
    bf16x8 qf[4];
#pragma unroll
    for (int ds = 0; ds < 4; ++ds) qf[ds] = *(const bf16x8*)(Qp + ds * 16);
    const int srow = tid >> 3, sch = tid & 7;
    const bf16_t* kg = Kp + (size_t)srow * 64 + sch * 8;
    const bf16_t* vg = Vp + (size_t)srow * STOT + sch * 8;
    u32x4 krA, vrA, krB, vrB;
    f32x16 o[2]; float lsum = 0.f;
    float negM;
    { float gq = fabsf(a.in[I_QNG][lane]), gk = fabsf(a.in[I_KNG][lane]);
#pragma unroll
      for (int o_ = 32; o_ > 0; o_ >>= 1) { gq = fmaxf(gq, __shfl_xor(gq, o_)); gk = fmaxf(gk, __shfl_xor(gk, o_)); }
      negM = -(64.f * 0.125f * 1.4426950408889634f * 1.01f) * gq * gk; }
#pragma unroll
    for (int dt = 0; dt < 2; ++dt)
#pragma unroll
        for (int r = 0; r < 16; ++r) o[dt][r] = 0.f;
    char* KS = lds; char* VS = lds + 2 * 64 * AT_KP;
#define A_LOADK(X, s0) do { kr##X = *(const u32x4*)(kg + (size_t)(s0) * 64); } while (0)
#define A_LOADV(X, s0) do { vr##X = *(const u32x4*)(vg + (s0)); } while (0)
#define A_WRITEK(X, st) do { *(u32x4*)(KS + (st) * 64 * AT_KP + srow * AT_KP + sch * 16) = kr##X; } while (0)
#define A_WRITEV(X, st) do { char* vb_ = VS + (st) * 64 * AT_VP + srow * AT_VP + sch * 16; *(u32x2*)vb_ = (u32x2){vr##X[0], vr##X[1]}; *(u32x2*)(vb_ + 8) = (u32x2){vr##X[2], vr##X[3]}; } while (0)
    constexpr int NT = STOT / 64;
    f32x16 sc[2], sn[2];
    A_LOADK(A, 0); A_LOADV(A, 0); A_WRITEK(A, 0); A_WRITEV(A, 0); A_LOADK(A, 64); A_WRITEK(A, 1); A_LOADK(B, 128); A_LOADV(B, 64); __syncthreads();
#pragma unroll
    for (int kt = 0; kt < 2; ++kt) {
#pragma unroll
        for (int r = 0; r < 16; ++r) sc[kt][r] = negM;
#pragma unroll
        for (int ds = 0; ds < 4; ++ds) { const bf16x8 ka = *(const bf16x8*)(KS + (kt * 32 + r32) * AT_KP + (ds * 16 + hi * 8) * 2); sc[kt] = MFMA(ka, qf[ds], sc[kt]); }
    }
    __syncthreads();
    f32x16 ol;
#pragma unroll
    for (int r = 0; r < 16; ++r) ol[r] = 0.f;
    const u32x4 ones_w = {0x3F803F80u, 0x3F803F80u, 0x3F803F80u, 0x3F803F80u};
    const bf16x8 ones = *(const bf16x8*)&ones_w;
#define A_STEP(J, SC, SN, XW, XL) do { const int j_ = (J); \
        const int jk = (j_ + 3 < NT) ? j_ + 3 : NT - 1, jv = (j_ + 2 < NT) ? j_ + 2 : NT - 1; \
        A_LOADK(XL, jk * 64); A_LOADV(XL, jv * 64); \
        const char* ksn = KS + ((j_ + 1) & 1) * 64 * AT_KP; const char* vs = VS + (j_ & 1) * 64 * AT_VP; \
        _Pragma("unroll") for (int kt = 0; kt < 2; ++kt) { \
            _Pragma("unroll") for (int r = 0; r < 16; ++r) SN[kt][r] = negM; \
            _Pragma("unroll") for (int ds = 0; ds < 4; ++ds) { \
                const bf16x8 ka = *(const bf16x8*)(ksn + (kt * 32 + r32) * AT_KP + (ds * 16 + hi * 8) * 2); \
                SN[kt] = MFMA(ka, qf[ds], SN[kt]); \
                _Pragma("unroll") for (int e = 0; e < 4; ++e) { const int f = (kt * 4 + ds) * 4 + e; SC[f >> 4][f & 15] = __builtin_amdgcn_exp2f(SC[f >> 4][f & 15]); } \
                __builtin_amdgcn_sched_barrier(0); } } \
        _Pragma("unroll") for (int kt = 0; kt < 2; ++kt) \
            _Pragma("unroll") for (int s = 0; s < 2; ++s) { \
                u32x4 pw = {pk2(SC[kt][8 * s], SC[kt][8 * s + 1]), pk2(SC[kt][8 * s + 2], SC[kt][8 * s + 3]), pk2(SC[kt][8 * s + 4], SC[kt][8 * s + 5]), pk2(SC[kt][8 * s + 6], SC[kt][8 * s + 7])}; \
                const bf16x8 pb = *(bf16x8*)&pw; \
                _Pragma("unroll") for (int dt = 0; dt < 2; ++dt) { \
                    const char* vp = vs + (dt * 32 + r32) * AT_VP + (kt * 32 + s * 16 + hi * 4) * 2; \
                    const u32x2 lo = *(const u32x2*)vp, hh = *(const u32x2*)(vp + 16); \
                    u32x4 aw = {lo[0], lo[1], hh[0], hh[1]}; \
                    o[dt] = MFMA(*(bf16x8*)&aw, pb, o[dt]); } \
                ol = MFMA(ones, pb, ol); } \
        A_WRITEK(XW, j_ & 1); A_WRITEV(XW, (j_ + 1) & 1); \
        __syncthreads(); } while (0)
#pragma unroll 1
    for (int j = 0; j < NT; j += 2) { A_STEP(j, sc, sn, B, A); A_STEP(j + 1, sn, sc, A, B); }
#undef A_STEP
    lsum = ol[0];
#undef A_LOADK
#undef A_LOADV
#undef A_WRITEK
#undef A_WRITEV
    const float inv = fast_rcp(lsum);
    bf16_t* outp = (bf16_t*)(ws + WS_A2) + ((size_t)b * SEQ + qblk * 256 + wid * 32 + r32) * KOUT + head * 64;
#pragma unroll
    for (int dt = 0; dt < 2; ++dt)
#pragma unroll
        for (int g = 0; g < 4; ++g) {
            u32x2 v = {pk2(o[dt][4 * g] * inv, o[dt][4 * g + 1] * inv), pk2(o[dt][4 * g + 2] * inv, o[dt][4 * g + 3] * inv)};
            *(u32x2*)(outp + dt * 32 + g * 8 + hi * 4) = v;
        }
}

constexpr int LR_RAW = 0;
constexpr int LR_U   = 33792;
constexpr int LR_BB  = LR_U + 33280;
constexpr int LR_UB  = LR_BB + 33280;
constexpr int LR_WG  = LR_UB + 18432;
constexpr int LR_SEG = LR_WG + 18432;
constexpr int LR_HC  = LR_SEG + 4096;
constexpr int LR_CST = LR_HC + 512;
constexpr int LR_END = LR_CST + 768;
__device__ void lru_item(const Args& a, char* lds, int b, int n, int d) {
    const int tid = threadIdx.x, lane = tid & 63, wid = tid >> 6, r32 = lane & 31, hi = lane >> 5;
    unsigned char* ws = a.ws;
    float* RAW = (float*)(lds + LR_RAW); float* AA = (float*)(lds + LR_RAW); float* U = (float*)(lds + LR_U); float* BB = (float*)(lds + LR_BB);
    char* UB = lds + LR_UB; char* WG = lds + LR_WG; float* SEG = (float*)(lds + LR_SEG); float* HC = (float*)(lds + LR_HC);
    const bf16_t* Lg = (const bf16_t*)(ws + WS_L) + (size_t)b * STOT * DLRU + n * 64;
    const bf16_t* Zg = (const bf16_t*)(ws + WS_ZG) + (size_t)b * SEQ * DLRU + n * 64;
    bf16_t* Og = (bf16_t*)(ws + WS_A2) + (size_t)b * SEQ * KOUT + 512 + d * 512 + n * 64;
    {
        const bf16_t* wsrc = (const bf16_t*)(ws + WS_RGW) + (size_t)(d * 8 + n) * 128 * 64;
#pragma unroll
        for (int i = 0; i < 2; ++i) { const int c = tid + NTHR * i, r = c >> 3, ch = c & 7; *(u32x4*)(WG + r * 144 + ch * 16) = *(const u32x4*)(wsrc + r * 64 + ch * 8); }
        if (tid < 128) HC[tid] = 0.f;
    }
    const int ct = wid & 1, tt = wid >> 1;
    float* CST = (float*)(lds + LR_CST);
    if (tid < 64) { const int c = n * 64 + tid; CST[tid] = a.in[I_RGBA][d * 512 + c]; CST[64 + tid] = a.in[I_RGBI][d * 512 + c];
        const float x = -a.in[I_RGLAM][d * 512 + c]; CST[128 + tid] = -8.f * (fmaxf(x, 0.f) + log1pf(__expf(-fabsf(x)))); }
    const int sc = tid & 63, sg = tid >> 6;
    const float cw0 = a.in[I_CONVW][0 * 512 + n * 64 + sc], cw1 = a.in[I_CONVW][1 * 512 + n * 64 + sc], cw2 = a.in[I_CONVW][2 * 512 + n * 64 + sc], cw3 = a.in[I_CONVW][3 * 512 + n * 64 + sc];
    const float cbias = a.in[I_CONVB][n * 64 + sc];
#define LRU_TILE(step_, isctx_, sb_, sl_, t0_) const bool isctx_ = (step_) < 2; const int sb_ = isctx_ ? 0 : CTX, sl_ = isctx_ ? CTX : SEQ, \
        t0_ = (isctx_ ? (d == 0 ? (step_) : 1 - (step_)) : (d == 0 ? (step_) - 2 : 17 - (step_))) * 128
#define LRU_FETCH(pre_, sb_, sl_, t0_) do { _Pragma("unroll") for (int i_ = 0; i_ < 3; ++i_) { const int e_ = min(tid + NTHR * i_, 131 * 8 - 1), t_ = min(max((t0_) - 2 + (e_ >> 3), 0), (sl_) - 1); \
        pre_[i_] = *(const u32x4*)(Lg + (size_t)((sb_) + t_) * DLRU + (e_ & 7) * 8); } } while (0)
#define LRU_SPREAD(pre_, sl_, t0_) do { _Pragma("unroll") for (int i_ = 0; i_ < 3; ++i_) { const int e_ = tid + NTHR * i_, t_ = (t0_) - 2 + (e_ >> 3); if (e_ < 131 * 8) { float* dst = RAW + (e_ >> 3) * 64 + (e_ & 7) * 8; \
        const bool in_ = t_ >= 0 && t_ < (sl_); const u32x4 v = pre_[i_]; f32x4 lo_ = {bflo(v[0]), bfhi(v[0]), bflo(v[1]), bfhi(v[1])}, hi_ = {bflo(v[2]), bfhi(v[2]), bflo(v[3]), bfhi(v[3])}; \
        if (!in_) { lo_ = (f32x4){0.f, 0.f, 0.f, 0.f}; hi_ = lo_; } *(f32x4*)dst = lo_; *(f32x4*)(dst + 4) = hi_; } } } while (0)
    u32x4 pre[3];
    { LRU_TILE(0, c0_, sb0_, sl0_, t00_); LRU_FETCH(pre, sb0_, sl0_, t00_); LRU_SPREAD(pre, sl0_, t00_); }
    __syncthreads();
    int par = 0;
    for (int step = 0; step < 18; ++step) {
        LRU_TILE(step, isctx, sb, sl, t0);
        LRU_TILE(step < 17 ? step + 1 : 17, c1_, sb1_, sl1_, t01_);
        LRU_FETCH(pre, sb1_, sl1_, t01_);
        unsigned short zv[16];
        {
            const int tfirst = d == 0 ? sg * 16 : 127 - sg * 16;
            const bf16_t* zp = Zg + (size_t)(t0 + tfirst) * DLRU + sc; const int zstep = d == 0 ? DLRU : -DLRU;
#pragma unroll
            for (int k = 0; k < 16; ++k) zv[k] = *(const unsigned short*)(zp + k * zstep);
        }
        {
            const float* rp = RAW + (sg * 16) * 64 + sc;
            float x0 = rp[0], x1 = rp[64], x2 = rp[128];
            float* up = U + (sg * 16) * 65 + sc; char* ubp = UB + (sg * 16) * 144 + sc * 2;
#pragma unroll
            for (int i = 0; i < 16; ++i) { const float x3 = rp[(i + 3) * 64];
                const float u = cbias + cw0 * x0 + cw1 * x1 + cw2 * x2 + cw3 * x3;
                up[i * 65] = u; *(bf16_t*)(ubp + i * 144) = f2bf(u); x0 = x1; x1 = x2; x2 = x3; }
        }
        __syncthreads();
        {
            f32x16 ga, gi;
#pragma unroll
            for (int r = 0; r < 16; ++r) { ga[r] = 0.f; gi[r] = 0.f; }
#pragma unroll
            for (int ks = 0; ks < 4; ++ks) {
                const bf16x8 wa = *(const bf16x8*)(WG + (ct * 32 + r32) * 144 + (ks * 16 + hi * 8) * 2);
                const bf16x8 wi = *(const bf16x8*)(WG + (64 + ct * 32 + r32) * 144 + (ks * 16 + hi * 8) * 2);
                const bf16x8 ub = *(const bf16x8*)(UB + (tt * 32 + r32) * 144 + (ks * 16 + hi * 8) * 2);
                ga = MFMA(wa, ub, ga); gi = MFMA(wi, ub, gi);
            }
            const int t = tt * 32 + r32;
#pragma unroll
            for (int r = 0; r < 16; ++r) { const int c = ct * 32 + 8 * (r >> 2) + 4 * hi + (r & 3);
                const float rr = sigmoidf_(ga[r] + CST[c]), ii = sigmoidf_(gi[r] + CST[64 + c]);
                const float la = CST[128 + c] * rr, av = __expf(la), mult = __builtin_amdgcn_sqrtf(fmaxf(1.f - av * av, 0.f));
                const float u = U[t * 65 + c];
                AA[t * 65 + c] = av; BB[t * 65 + c] = mult * ii * u; }
        }
        __syncthreads();
        float av[16], bv[16]; float Ap = 1.f, Bp = 0.f;
#pragma unroll
        for (int k = 0; k < 16; ++k) { const int p = sg * 16 + k, t = d == 0 ? p : 127 - p; av[k] = AA[t * 65 + sc]; bv[k] = BB[t * 65 + sc]; Bp = av[k] * Bp + bv[k]; Ap = av[k] * Ap; }
        SEG[sg * 64 + sc] = Ap; SEG[512 + sg * 64 + sc] = Bp;
        __syncthreads();
        float h = HC[par * 64 + sc];
        {
            float sa[7], sb_[7];
#pragma unroll
            for (int s2 = 0; s2 < 7; ++s2) { sa[s2] = SEG[s2 * 64 + sc]; sb_[s2] = SEG[512 + s2 * 64 + sc]; }
#pragma unroll
            for (int s2 = 0; s2 < 7; ++s2) { const bool on = s2 < sg; h = (on ? sa[s2] : 1.f) * h + (on ? sb_[s2] : 0.f); }
        }
        {
            const int tfirst = d == 0 ? sg * 16 : 127 - sg * 16;
            bf16_t* op = Og + (size_t)(t0 + tfirst) * KOUT + sc;
            const int ostep = d == 0 ? KOUT : -KOUT;
#pragma unroll
            for (int k = 0; k < 16; ++k) { h = av[k] * h + bv[k];
                if (!isctx) { const float gz = __uint_as_float((unsigned)zv[k] << 16); *op = f2bf(h * gz); op += ostep; } }
        }
        LRU_SPREAD(pre, sl1_, t01_);
        if (sg == 7) HC[(par ^ 1) * 64 + sc] = h;
        par ^= 1;
        __syncthreads();
    }
}

#ifndef LRU_REPS
#define LRU_REPS 1
#endif
__device__ void phase_mixer(const Args& a, char* lds, int vb, int nb) {
#pragma unroll 1
    for (int it = vb; it < 256; it += nb) { for (int rep_ = 0; rep_ < LRU_REPS; ++rep_) { lru_item(a, lds, it >> 4, (it >> 1) & 7, it & 1); __syncthreads(); } }
#pragma unroll 1
    for (int at = vb; at < 1024; at += nb) { const int bk = at >> 5, w = at & 31; attn_item(a, lds, bk >> 1, (bk & 1) * 4 + (w >> 3), w & 7); __syncthreads(); }
}

__device__ void phase_outproj(const Args& a, char* lds, int vb, int nb) {
    const int tid = threadIdx.x, lane = tid & 63, wid = tid >> 6, wr = wid >> 2, wc = wid & 3, fr = lane & 15, fq = lane >> 4;
    const bf16_t* A2 = (const bf16_t*)(a.ws + WS_A2); const bf16_t* WO = (const bf16_t*)(a.ws + WS_WOUT);
    bf16_t* MIX = (bf16_t*)(a.ws + WS_MIX);
    if (vb < 128 * 4) g8::core_pre(WO, A2, (vb & 3) * 256, (vb >> 2) * 256, KOUT, lds);
#pragma unroll 1
    for (int it = vb; it < 128 * 4; it += nb) {
        const int tt = it >> 2, ft = it & 3;
        f32x4 acc[2][2][4][2];
        g8::core<true>(acc, WO, A2, ft * 256, tt * 256, KOUT, lds);
        if (it + nb < 128 * 4) g8::core_pre(WO, A2, ((it + nb) & 3) * 256, ((it + nb) >> 2) * 256, KOUT, lds);
#pragma unroll
        for (int bj = 0; bj < 2; ++bj)
#pragma unroll
            for (int n = 0; n < 2; ++n) {
                bf16_t* rp = MIX + (size_t)(tt * 256 + bj * 128 + wc * 32 + n * 16 + fr) * DM + ft * 256 + wr * 64 + fq * 4;
#pragma unroll
                for (int ai = 0; ai < 2; ++ai)
#pragma unroll
                    for (int m = 0; m < 4; ++m) { const f32x4 v = acc[ai][bj][m][n]; *(u32x2*)(rp + ai * 128 + m * 16) = (u32x2){pk2(v[0], v[1]), pk2(v[2], v[3])}; }
            }
        __syncthreads();
    }
}

__device__ void phase_rowpass(const Args& a, int vb, int nb) {
    const int tid = threadIdx.x, lane = tid & 63, wid = tid >> 6;
    const float* mod = (const float*)(a.ws + WS_MOD);
    const bf16_t* MIX = (const bf16_t*)(a.ws + WS_MIX);
    bf16_t* HX = (bf16_t*)(a.ws + WS_HX2); bf16_t* XM = (bf16_t*)(a.ws + WS_XM);
    const int chunk = (NTOK + nb - 1) / nb, rend = min(NTOK, (vb + 1) * chunk);
    f32x4 G1[4], A2[4], B2[4]; int cur = -1;
    u32x2 mwn[4]; f32x4 xvn[4];
    {
        const int r0 = min(vb * chunk + wid, NTOK - 1);
#pragma unroll
        for (int i = 0; i < 4; ++i) { mwn[i] = *(const u32x2*)(MIX + (size_t)r0 * DM + i * 256 + lane * 4); xvn[i] = *(const f32x4*)(a.in[I_X] + (size_t)r0 * DM + i * 256 + lane * 4); }
    }
    for (int row = vb * chunk + wid; row < rend; row += 8) {
        const int b = row >> 11;
        f32x4 mv[4], xv[4]; float ss = 0.f;
#pragma unroll
        for (int i = 0; i < 4; ++i) { const u32x2 mw = mwn[i]; mv[i] = (f32x4){bflo(mw[0]), bfhi(mw[0]), bflo(mw[1]), bfhi(mw[1])}; xv[i] = xvn[i]; }
        {
            const int rn = min(row + 8, NTOK - 1);
#pragma unroll
            for (int i = 0; i < 4; ++i) { mwn[i] = *(const u32x2*)(MIX + (size_t)rn * DM + i * 256 + lane * 4); xvn[i] = *(const f32x4*)(a.in[I_X] + (size_t)rn * DM + i * 256 + lane * 4); }
        }
        if (b != cur) { cur = b; const float* mrow = mod + (size_t)b * 6144;
#pragma unroll
            for (int i = 0; i < 4; ++i) { const int c = i * 256 + lane * 4;
                const f32x4 gp = *(const f32x4*)(a.in[I_GPOSTMIX] + c), g1 = *(const f32x4*)(mrow + 2048 + c), gf = *(const f32x4*)(a.in[I_GPREFFN] + c), sc = *(const f32x4*)(mrow + 4096 + c);
                B2[i] = *(const f32x4*)(mrow + 3072 + c);
#pragma unroll
                for (int j = 0; j < 4; ++j) { G1[i][j] = g1[j] * gp[j]; A2[i][j] = gf[j] * (1.f + sc[j]); } } }
#pragma unroll
        for (int i = 0; i < 4; ++i) ss += mv[i][0] * mv[i][0] + mv[i][1] * mv[i][1] + mv[i][2] * mv[i][2] + mv[i][3] * mv[i][3];
        ss = wave_sum(ss);
        const float rinv = rsqrtf(ss * (1.f / DM) + EPS);
        float s2 = 0.f;
#pragma unroll
        for (int i = 0; i < 4; ++i) { const int c = i * 256 + lane * 4;
#pragma unroll
            for (int j = 0; j < 4; ++j) { const float xm = xv[i][j] + G1[i][j] * (mv[i][j] * rinv); xv[i][j] = xm; s2 += xm * xm; }
            const u32x2 xw = {pk2(xv[i][0], xv[i][1]), pk2(xv[i][2], xv[i][3])}; *(u32x2*)(XM + (size_t)row * DM + c) = xw; }
        s2 = wave_sum(s2);
        const float rinv2 = rsqrtf(s2 * (1.f / DM) + EPS);
#pragma unroll
        for (int i = 0; i < 4; ++i) { const int c = i * 256 + lane * 4;
            float o[4];
#pragma unroll
            for (int j = 0; j < 4; ++j) o[j] = xv[i][j] * rinv2 * A2[i][j] + B2[i][j];
            u32x2 w = {pk2(o[0], o[1]), pk2(o[2], o[3])}; *(u32x2*)(HX + (size_t)row * DM + c) = w; }
    }
}

__device__ __forceinline__ int fkey(float f) { const int b = __float_as_int(f); return b ^ ((b >> 31) & 0x7fffffff); }
__device__ __forceinline__ float fval(int k) { return __int_as_float(k ^ ((k >> 31) & 0x7fffffff)); }
#define CE_DESC(x, y) do { const int hi_ = max((x), (y)), lo_ = min((x), (y)); (x) = hi_; (y) = lo_; } while (0)
__device__ __forceinline__ void sort16_desc(int (&v)[16]) {
#pragma unroll
    for (int k = 2; k <= 16; k <<= 1)
#pragma unroll
        for (int j = k >> 1; j > 0; j >>= 1)
#pragma unroll
            for (int i = 0; i < 16; ++i) { const int l = i ^ j; if (l > i) { if ((i & k) == 0) { CE_DESC(v[i], v[l]); } else { CE_DESC(v[l], v[i]); } } }
}
__device__ __forceinline__ void merge16_desc(int (&v)[16]) {
#pragma unroll
    for (int j = 8; j > 0; j >>= 1)
#pragma unroll
        for (int i = 0; i < 16; ++i) { const int l = i ^ j; if (l > i) CE_DESC(v[i], v[l]); }
}
__device__ __forceinline__ void top16_merge(int (&A)[16], const int (&B)[16]) {
#pragma unroll
    for (int i = 0; i < 16; ++i) A[i] = max(A[i], B[15 - i]);
    merge16_desc(A);
}
constexpr int PK_QS = 0;
constexpr int PK_SK = 256 * E_PITCH;
constexpr int PK_ML = PK_SK + 128 * E_PITCH;
constexpr int PK_X  = PK_ML + 32768;
constexpr int PK_END = PK_X + 8192;
__device__ void phase_peer_topk(const Args& a, char* lds, int vb, int nb) {
    unsigned char* ws = a.ws;
    const bf16_t* HX = (const bf16_t*)(ws + WS_HX2); const bf16_t* WQ = (const bf16_t*)(ws + WS_WQ); const bf16_t* SUBK = (const bf16_t*)(ws + WS_SUBK);
    int* IDX = (int*)(ws + WS_IDX);
    int* ML = (int*)(lds + PK_ML); int* XB = (int*)(lds + PK_X);
    for (int it = vb; it < 128 * 8; it += nb) {
        const int rt = it >> 3, h = it & 7, row0 = rt * 256;
        bf16_t* park = (bf16_t*)(ws + WS_MIX) + (size_t)it * (256 * 128);
        int tid = threadIdx.x;
        {
            f32x4 acc8[2][2][4][2];
            g8::core(acc8, WQ, HX, h * 256, row0, DM, lds);
            __syncthreads();
            asm volatile("" : "+v"(tid));
            const int lane = tid & 63, wid = tid >> 6;
            const int w8r = wid >> 2, w8c = wid & 3, fr = lane & 15, fq = lane >> 4;
#pragma unroll
            for (int bj = 0; bj < 2; ++bj)
#pragma unroll
                for (int m = 0; m < 4; ++m)
#pragma unroll
                    for (int n = 0; n < 2; ++n) { const int tok = bj * 128 + w8c * 32 + n * 16 + fr, d = w8r * 64 + m * 16 + fq * 4;
                        const f32x4 v0 = acc8[0][bj][m][n], v1 = acc8[1][bj][m][n];
                        *(u32x2*)(lds + PK_QS + tok * E_PITCH + d * 2) = (u32x2){pk2(v0[0], v0[1]), pk2(v0[2], v0[3])};
                        *(u32x2*)(park + tok * 128 + d) = (u32x2){pk2(v1[0], v1[1]), pk2(v1[2], v1[3])}; }
        }
        const int lane = tid & 63, wid = tid >> 6, wm = wid & 3, wn = wid >> 2, r32 = lane & 31, hi = lane >> 5;
#pragma unroll 1
        for (int p = 0; p < 2; ++p) {
            f32x16 acc[2][2];
            if (p == 1) {
#pragma unroll
                for (int i = 0; i < 8; ++i) { const int c = tid + NTHR * i, tok = c >> 4, ch = c & 15; *(u32x4*)(lds + PK_QS + tok * E_PITCH + ch * 16) = *(const u32x4*)(park + tok * 128 + ch * 8); }
            }
            {
                const bf16_t* sk = SUBK + (size_t)(h * 2 + p) * 128 * 128;
#pragma unroll
                for (int i = 0; i < 4; ++i) { const int c = tid + NTHR * i, r = c >> 4, ch = c & 15; *(u32x4*)(lds + PK_SK + r * E_PITCH + ch * 16) = *(const u32x4*)(sk + r * 128 + ch * 8); }
            }
            __syncthreads();
#pragma unroll
            for (int ft = 0; ft < 2; ++ft)
#pragma unroll
                for (int tt = 0; tt < 2; ++tt)
#pragma unroll
                    for (int r = 0; r < 16; ++r) acc[ft][tt][r] = 0.f;
#pragma unroll
            for (int ks = 0; ks < 8; ++ks) {
                const bf16x8 a0 = *(const bf16x8*)(lds + PK_SK + (wn * 64 + r32) * E_PITCH + (ks * 16 + hi * 8) * 2), a1 = *(const bf16x8*)(lds + PK_SK + (wn * 64 + 32 + r32) * E_PITCH + (ks * 16 + hi * 8) * 2);
                const bf16x8 b0 = *(const bf16x8*)(lds + PK_QS + (wm * 64 + r32) * E_PITCH + (ks * 16 + hi * 8) * 2), b1 = *(const bf16x8*)(lds + PK_QS + (wm * 64 + 32 + r32) * E_PITCH + (ks * 16 + hi * 8) * 2);
                acc[0][0] = MFMA(a0, b0, acc[0][0]); acc[0][1] = MFMA(a0, b1, acc[0][1]);
                acc[1][0] = MFMA(a1, b0, acc[1][0]); acc[1][1] = MFMA(a1, b1, acc[1][1]);
            }
#pragma unroll
            for (int tt = 0; tt < 2; ++tt) {
                int A[16], B[16];
#pragma unroll
                for (int r = 0; r < 16; ++r) { const int key = wn * 64 + 8 * (r >> 2) + 4 * hi + (r & 3);
                    A[r] = (fkey(acc[0][tt][r]) & ~127) | key; B[r] = (fkey(acc[1][tt][r]) & ~127) | (key + 32); }
                sort16_desc(A); sort16_desc(B); top16_merge(A, B);
#pragma unroll
                for (int r = 0; r < 16; ++r) { auto rr = __builtin_amdgcn_permlane32_swap((unsigned)A[r], (unsigned)A[r], false, false); B[r] = (int)(hi ? rr[0] : rr[1]); }
                top16_merge(A, B);
                const int tok = wm * 64 + tt * 32 + r32;
                if (wn == 1 && hi == 0) {
#pragma unroll
                    for (int r = 0; r < 16; ++r) XB[(wm * 32 + r32) * 16 + r] = A[r];
                }
                __syncthreads();
                if (wn == 0 && hi == 0) {
#pragma unroll
                    for (int r = 0; r < 16; ++r) B[r] = XB[(wm * 32 + r32) * 16 + r];
                    top16_merge(A, B);
#pragma unroll
                    for (int r = 0; r < 16; ++r) ML[(tok * 2 + p) * 16 + r] = A[r];
                }
                __syncthreads();
            }
        }
        if (tid < 256) {
            const int tok = tid;
            int s1[16], s2[16];
#pragma unroll
            for (int r = 0; r < 16; ++r) { s1[r] = ML[(tok * 2 + 0) * 16 + r]; s2[r] = ML[(tok * 2 + 1) * 16 + r]; }
            float f1[16], f2[16];
#pragma unroll
            for (int r = 0; r < 16; ++r) { f1[r] = fval(s1[r] & ~127); f2[r] = fval(s2[r] & ~127); }
            int G0[16], G1[16], G2[16], G3[16];
#pragma unroll
            for (int bb = 0; bb < 16; ++bb) G0[bb] = (fkey(f1[0] + f2[bb]) & ~255) | (0 * 16 + bb);
#pragma unroll
            for (int bb = 0; bb < 8; ++bb) G1[bb] = (fkey(f1[1] + f2[bb]) & ~255) | (1 * 16 + bb);
#pragma unroll
            for (int bb = 0; bb < 5; ++bb) G1[8 + bb] = (fkey(f1[2] + f2[bb]) & ~255) | (2 * 16 + bb);
#pragma unroll
            for (int bb = 0; bb < 3; ++bb) G1[13 + bb] = (fkey(f1[3] + f2[bb]) & ~255) | (3 * 16 + bb);
            G2[0] = (fkey(f1[3] + f2[3]) & ~255) | (3 * 16 + 3);
#pragma unroll
            for (int bb = 0; bb < 3; ++bb) G2[1 + bb] = (fkey(f1[4] + f2[bb]) & ~255) | (4 * 16 + bb);
#pragma unroll
            for (int aa = 5; aa < 8; ++aa)
#pragma unroll
                for (int bb = 0; bb < 2; ++bb) G2[4 + (aa - 5) * 2 + bb] = (fkey(f1[aa] + f2[bb]) & ~255) | (aa * 16 + bb);
#pragma unroll
            for (int aa = 8; aa < 14; ++aa) G2[10 + (aa - 8)] = (fkey(f1[aa] + f2[0]) & ~255) | (aa * 16);
            G3[0] = (fkey(f1[14] + f2[0]) & ~255) | (14 * 16); G3[1] = (fkey(f1[15] + f2[0]) & ~255) | (15 * 16);
#pragma unroll
            for (int r = 2; r < 16; ++r) G3[r] = (int)0x80000000;
            sort16_desc(G0); sort16_desc(G1); sort16_desc(G2); sort16_desc(G3);
            top16_merge(G0, G1); top16_merge(G2, G3); top16_merge(G0, G2);
            float tv[16]; float mx = fval(G0[0] & ~255), sum = 0.f;
#pragma unroll
            for (int r = 0; r < 16; ++r) { tv[r] = __expf(fval(G0[r] & ~255) - mx); sum += tv[r]; }
            const float rs = 1.f / sum;
            const size_t ob = ((size_t)(row0 + tok) * 8 + h) * 16;
#pragma unroll
            for (int r = 0; r < 16; ++r) { const int code = G0[r] & 255, aa = code >> 4, bb = code & 15;
                const int i1 = ML[(tok * 2 + 0) * 16 + aa] & 127, i2 = ML[(tok * 2 + 1) * 16 + bb] & 127;
                IDX[ob + r] = (i1 * 128 + i2) | (int)((unsigned)f2bf(tv[r] * rs) << 16); }
        }
        __syncthreads();
    }
}

template <int CTRL> __device__ __forceinline__ float dpp_add(float v) { return v + __uint_as_float(__builtin_amdgcn_update_dpp(0u, __float_as_uint(v), CTRL, 0xf, 0xf, true)); }
__device__ __forceinline__ float wave_sum_bcast(float p) {
    p = dpp_add<0xB1>(p); p = dpp_add<0x4E>(p); p = dpp_add<0x141>(p); p = dpp_add<0x140>(p);
    const unsigned u = __float_as_uint(p);
    return (__uint_as_float(__builtin_amdgcn_readlane(u, 0)) + __uint_as_float(__builtin_amdgcn_readlane(u, 16))) + (__uint_as_float(__builtin_amdgcn_readlane(u, 32)) + __uint_as_float(__builtin_amdgcn_readlane(u, 48)));
}
typedef float f32x4v __attribute__((ext_vector_type(4)));
constexpr int P7_RS = 9;
constexpr int P7_NR = PEER_N >> P7_RS;
constexpr int P7_HTP = 1024 + 64;
constexpr float H_SCALE = 16.f;
constexpr int P7_ATP = 2048 + 16;
constexpr float W_SCALE = 16.f;
constexpr int P7_RING = 16384;
constexpr int P7_WLDS = P7_RING + 2048;
#ifndef P7_UREP
#define P7_UREP 1
#endif
#ifndef P7_UD
#define P7_UD 3
#endif
#ifndef P7_VMASK
#define P7_VMASK 16383u
#endif
#ifndef P7_VPROBE
#define P7_VPROBE 0
#endif
template <int MODE>
__device__ __forceinline__ void p7_vsweep(f32x16 (&acc)[8], const unsigned* LIST, const unsigned char* VT, int m32, int kh, unsigned psel, unsigned ntok) {
    constexpr unsigned EM = MODE == 1 ? P7_VMASK : 16383u;
    i32x8 abuf[8];
#pragma unroll
    for (int T = 0; T < 8; ++T)
#pragma unroll
        for (int i = 0; i < 16; ++i) acc[T][i] = 0.f;
    u32x4 c0 = *(const u32x4*)(LIST + kh * 8), c1 = *(const u32x4*)(LIST + kh * 8 + 4);
    {
        unsigned off[8];
#pragma unroll
        for (int j = 0; j < 8; ++j) off[j] = (((j < 4 ? c0[j & 3] : c1[j & 3]) & EM) << 10) + m32 * 4;
#pragma unroll
        for (int T = 0; T < 8; ++T) {
#pragma unroll
            for (int j = 0; j < 8; ++j) abuf[T][j] = *(const int*)(VT + off[j] + T * 128);
            __builtin_amdgcn_sched_barrier(0); }
    }
#pragma unroll 1
    for (int bi = 0; bi < 32; ++bi) {
        const int bn = (bi < 31 ? bi + 1 : 31);
        const u32x4 l0 = *(const u32x4*)(LIST + bn * 16 + kh * 8), l1 = *(const u32x4*)(LIST + bn * 16 + kh * 8 + 4);
        unsigned noff[8];
#pragma unroll
        for (int j = 0; j < 8; ++j) noff[j] = (((j < 4 ? l0[j & 3] : l1[j & 3]) & EM) << 10) + m32 * 4;
        i32x8 bop;
#pragma unroll
        for (int j = 0; j < 8; ++j) { const unsigned e = j < 4 ? c0[j & 3] : c1[j & 3];
            bop[j] = (((e >> 14) & 3u) == ntok) ? (int)__builtin_amdgcn_perm(0u, e, psel) : 0; }
        c0 = l0; c1 = l1;
#pragma unroll
        for (int T = 0; T < 8; ++T) {
            __builtin_amdgcn_sched_barrier(0);
            if (MODE != 2) asm volatile("s_waitcnt vmcnt(12)" ::: "memory");
            if (MODE == 1) { int t_ = abuf[T][0];
#pragma unroll
                for (int j = 1; j < 8; ++j) t_ |= abuf[T][j];
                acc[T][0] = __int_as_float(t_ | bop[0]); }
            else acc[T] = __builtin_amdgcn_mfma_scale_f32_32x32x64_f8f6f4(abuf[T], bop, acc[T], 0, 0, 0, 127, 0, 127);
            if (MODE != 2) {
#pragma unroll
                for (int j = 0; j < 8; ++j) abuf[T][j] = *(const int*)(VT + noff[j] + T * 128); }
        }
        __builtin_amdgcn_sched_barrier(0);
    }
    if (MODE != 0) {
#pragma unroll
        for (int T = 0; T < 8; ++T) asm volatile("" :: "v"(acc[T]));
    }
}
__device__ void phase_peer_gather(const Args& a, char* lds, int vb, int nb) {
    unsigned char* ws = a.ws;
    const bf16_t* HX = (const bf16_t*)(ws + WS_HX2);
    const int* IDX = (const int*)(ws + WS_IDX);
    const float* mod = (const float*)(ws + WS_MOD);
    const unsigned char* UT = ws + WS_UT; const unsigned char* VT = ws + WS_VT;
    const bf16_t* XM = (const bf16_t*)(ws + WS_XM);
#pragma unroll 1
    for (int tb = vb * 32; tb < NTOK; tb += nb * 32) {
        int tid = threadIdx.x; asm volatile("" : "+v"(tid));
        const int lane = tid & 63, wid = tid >> 6, r16 = lane & 15, kg = lane >> 4;
        char* HT = lds + wid * P7_WLDS; unsigned* LIST = (unsigned*)(HT + P7_RING); char* AT = HT;
        const int tok0 = tb + wid * 4;
        {
            int* HIST = (int*)HT; int* CUR = HIST + 128;
            int ee[8];
            const int* ip = IDX + (size_t)tok0 * 128 + lane;
#pragma unroll
            for (int k = 0; k < 4; ++k) { ee[2 * k] = ip[k * 128]; ee[2 * k + 1] = ip[k * 128 + 64]; }
            HIST[lane] = 0; HIST[64 + lane] = 0;
#pragma unroll
            for (int j = 0; j < 8; ++j) atomicAdd(&HIST[(((ee[j] >> P7_RS) & (P7_NR - 1)) << 2) | (j >> 1)], 1);
            const int c0 = HIST[2 * lane], c1 = HIST[2 * lane + 1];
            int inc = c0 + c1;
#pragma unroll
            for (int o = 1; o < 64; o <<= 1) { const int t = __shfl_up(inc, o); if (lane >= o) inc += t; }
            CUR[2 * lane] = inc - c0 - c1; CUR[2 * lane + 1] = inc - c1;
#pragma unroll
            for (int j = 0; j < 8; ++j) { const unsigned w = (unsigned)ee[j]; const int slot = atomicAdd(&CUR[(((w >> P7_RS) & (P7_NR - 1)) << 2) | (j >> 1)], 1);
                LIST[slot] = (w & 16383u) | ((unsigned)(j >> 1) << 14) | ((w >> 16) << 17); }
        }
#pragma unroll 1
        for (int urep = 0; urep < P7_UREP; ++urep) {
        if (urep) asm volatile("s_waitcnt vmcnt(0)" ::: "memory");
        {
            const bf16_t* hp = HX + (size_t)tok0 * DM + lane * 16;
#pragma unroll
            for (int k = 0; k < 4; ++k) { const u32x4 h0 = *(const u32x4*)(hp + k * DM), h1 = *(const u32x4*)(hp + k * DM + 8);
                u32x4 o, ol;
#pragma unroll
                for (int q = 0; q < 4; ++q) { const unsigned wa = q < 2 ? h0[2 * q] : h1[2 * q - 4], wb = q < 2 ? h0[2 * q + 1] : h1[2 * q - 3];
                    const float x0 = bflo(wa) * H_SCALE, x1 = bfhi(wa) * H_SCALE, x2 = bflo(wb) * H_SCALE, x3 = bfhi(wb) * H_SCALE;
                    int w = __builtin_amdgcn_cvt_pk_fp8_f32(sat8(x0), sat8(x1), 0, false); w = __builtin_amdgcn_cvt_pk_fp8_f32(sat8(x2), sat8(x3), w, true); o[q] = (unsigned)w;
                    const float r0 = (x0 - __builtin_amdgcn_cvt_f32_fp8(w, 0)) * 16.f, r1 = (x1 - __builtin_amdgcn_cvt_f32_fp8(w, 1)) * 16.f, r2 = (x2 - __builtin_amdgcn_cvt_f32_fp8(w, 2)) * 16.f, r3 = (x3 - __builtin_amdgcn_cvt_f32_fp8(w, 3)) * 16.f;
                    int wl = __builtin_amdgcn_cvt_pk_fp8_f32(sat8(r0), sat8(r1), 0, false); wl = __builtin_amdgcn_cvt_pk_fp8_f32(sat8(r2), sat8(r3), wl, true); ol[q] = (unsigned)wl; }
                *(u32x4*)(HT + (2 * k) * P7_HTP + lane * 16) = o; *(u32x4*)(HT + (2 * k + 1) * P7_HTP + lane * 16) = ol;
            }
        }
        {
            i32x8 hb[8];
            {
                const char* hp = HT + (2 * (lane & 3) + ((lane >> 2) & 1)) * P7_HTP + kg * 32;
#pragma unroll
                for (int kc = 0; kc < 8; ++kc) { const i32x4 x0 = *(const i32x4*)(hp + kc * 128), x1 = *(const i32x4*)(hp + kc * 128 + 16);
                    hb[kc] = __builtin_shufflevector(x0, x1, 0, 1, 2, 3, 4, 5, 6, 7); }
            }
            unsigned entv = LIST[r16];
            asm volatile("s_waitcnt lgkmcnt(0)" ::: "memory");
            LAS unsigned char* ring = (LAS unsigned char*)lds + __builtin_amdgcn_readfirstlane(wid) * P7_WLDS;
#define U_DMA(slot, gp) do { __builtin_amdgcn_global_load_lds((const unsigned*)(gp), (LAS unsigned*)(ring + (slot) * 2048), 16, 0, 0); } while (0)
            const int lrow = lane >> 3;
            const unsigned swz = (unsigned)(((lane & 7) ^ (((lrow >> 1) & 3) << 1)) << 4);
            unsigned olo = (((unsigned)__shfl((int)entv, lrow) & 16383u) << 10) + swz, ohi = (((unsigned)__shfl((int)entv, 8 + lrow) & 16383u) << 10) + swz;
#pragma unroll
            for (int st = 0; st < P7_UD; ++st) { U_DMA(st, UT + olo + st * 128); __builtin_amdgcn_global_load_lds((const unsigned*)(UT + ohi + st * 128), (LAS unsigned*)(ring + st * 2048 + 1024), 16, 0, 0); }
            const int ard = (r16 >> 3) * 1024 + (r16 & 7) * 128 + ((kg ^ ((r16 >> 1) & 3)) << 5);
            const float pscl = (lane & 8) ? 0.f : ((lane & 4) ? 1.f / 16.f : 1.f);
            asm volatile("s_waitcnt vmcnt(%0)" :: "n"(2 * P7_UD - 2) : "memory");
            i32x4 a0 = *(const LAS i32x4*)(ring + ard), a1 = *(const LAS i32x4*)(ring + ard + 16);
#pragma unroll 1
            for (int bi = 0; bi < 32; ++bi) {
                const unsigned entn = LIST[(bi < 31 ? bi + 1 : 31) * 16 + r16];
                const unsigned nlo = (((unsigned)__shfl((int)entn, lrow) & 16383u) << 10) + swz, nhi = (((unsigned)__shfl((int)entn, 8 + lrow) & 16383u) << 10) + swz;
                f32x4v D = {0.f, 0.f, 0.f, 0.f};
#pragma unroll
                for (int kc = 0; kc < 8; ++kc) {
                    asm volatile("" ::: "memory");
                    {
                        const unsigned glo = (kc + P7_UD < 8 ? olo : nlo) + ((kc + P7_UD) & 7) * 128, ghi = (kc + P7_UD < 8 ? ohi : nhi) + ((kc + P7_UD) & 7) * 128;
                        __builtin_amdgcn_global_load_lds((const unsigned*)(UT + glo), (LAS unsigned*)(ring + ((kc + P7_UD) & 7) * 2048), 16, 0, 0);
                        __builtin_amdgcn_global_load_lds((const unsigned*)(UT + ghi), (LAS unsigned*)(ring + ((kc + P7_UD) & 7) * 2048 + 1024), 16, 0, 0);
                    }
                    asm volatile("s_waitcnt vmcnt(%0)" :: "n"(2 * P7_UD - 2) : "memory");
                    const i32x4 n0 = *(const LAS i32x4*)(ring + ((kc + 1) & 7) * 2048 + ard), n1 = *(const LAS i32x4*)(ring + ((kc + 1) & 7) * 2048 + ard + 16);
                    D = __builtin_amdgcn_mfma_scale_f32_16x16x128_f8f6f4(__builtin_shufflevector(a0, a1, 0, 1, 2, 3, 4, 5, 6, 7), hb[kc], D, 0, 0, 0, 127, 0, 127);
                    a0 = n0; a1 = n1;
                }
                olo = nlo; ohi = nhi;
                float dsel = 0.f; unsigned esel = 0u;
#pragma unroll
                for (int i = 0; i < 4; ++i) {
                    const unsigned er = (unsigned)__shfl((int)entv, 4 * kg + i);
                    float m = (((er >> 14) & 3u) == (unsigned)(lane & 3)) ? D[i] * pscl : 0.f;
                    m = dpp_add<0xB1>(m); m = dpp_add<0x4E>(m); m = dpp_add<0x104>(m);
                    const bool pick = (lane & 3) == i; dsel = pick ? m : dsel; esel = pick ? er : esel;
                }
                if ((lane & 12) == 0) {
                    const float w = __uint_as_float((esel >> 17) << 16) * gelu_tanh(dsel * (1.f / (T_SCALE * H_SCALE))) * W_SCALE;
                    const int p0 = __builtin_amdgcn_cvt_pk_fp8_f32(sat8(w), 0.f, 0, false);
                    const float hf = __builtin_amdgcn_cvt_f32_fp8(p0, 0);
                    const int p1 = __builtin_amdgcn_cvt_pk_fp8_f32(sat8((w - hf) * 16.f), 0.f, 0, false);
                    LIST[bi * 16 + 4 * kg + (lane & 3)] = (esel & 0xffffu) | (((unsigned)p0 & 0xffu) << 16) | (((unsigned)p1 & 0xffu) << 24); }
                entv = entn;
            }
        }
        }
        {
            const int m32 = lane & 31, kh = lane >> 5, ntok = m32 >> 3, npart = (m32 >> 2) & 1, nc = m32 & 3;
            const unsigned psel = (0x0c0c0c0cu & ~(0xffu << (8 * nc))) | ((unsigned)(2 + npart) << (8 * nc));
            f32x16 acc[8];
#if P7_VPROBE
            p7_vsweep<P7_VPROBE>(acc, LIST, VT, m32, kh, psel, (unsigned)ntok);
#endif
            p7_vsweep<0>(acc, LIST, VT, m32, kh, psel, (unsigned)ntok);
            const float psc = npart ? V_SCALE / (W_SCALE * T_SCALE * 16.f) : V_SCALE / (W_SCALE * T_SCALE);
            char* arow = AT + ntok * P7_ATP + (16 * kh + nc) * 2;
#pragma unroll
            for (int T = 0; T < 8; ++T)
#pragma unroll
                for (int i = 0; i < 16; ++i) {
                    const float v = acc[T][i] * psc;
                    const float tot = (T & 1) ? dpp_add<0x114>(v) : dpp_add<0x104>(v);
                    if ((T & 1) == npart) *(_Float16*)(arow + (128 * T + 4 * ((i & 3) + 8 * (i >> 2))) * 2) = (_Float16)tot;
                }
        }
#pragma unroll
        for (int k = 0; k < 4; ++k) {
            const int tok = tok0 + k;
            float f[16]; float ss = 0.f;
            const u32x4 e0 = *(const u32x4*)(AT + k * P7_ATP + lane * 32), e1 = *(const u32x4*)(AT + k * P7_ATP + lane * 32 + 16);
#pragma unroll
            for (int i = 0; i < 8; ++i) { const unsigned cw = i < 4 ? e0[i] : e1[i - 4]; const h16x2 hv = as_h2(cw);
                f[2 * i] = (float)hv[0] * (1.f / V_SCALE); f[2 * i + 1] = (float)hv[1] * (1.f / V_SCALE); ss += f[2 * i] * f[2 * i] + f[2 * i + 1] * f[2 * i + 1]; }
            ss = wave_sum_bcast(ss);
            const float rinv = rsqrtf(ss * (1.f / DM) + EPS);
            const float* g2 = mod + (size_t)(tok >> 11) * 6144 + 5120;
            const u32x4 xa = *(const u32x4*)(XM + (size_t)tok * DM + lane * 16), xb = *(const u32x4*)(XM + (size_t)tok * DM + lane * 16 + 8);
#pragma unroll
            for (int q4 = 0; q4 < 4; ++q4) {
                const int c = lane * 16 + q4 * 4;
                const unsigned x01 = q4 < 2 ? xa[2 * q4] : xb[2 * q4 - 4], x23 = q4 < 2 ? xa[2 * q4 + 1] : xb[2 * q4 - 3];
                const f32x4 xm = {bflo(x01), bfhi(x01), bflo(x23), bfhi(x23)}, g2v = *(const f32x4*)(g2 + c), gp = *(const f32x4*)(a.in[I_GPOSTFFN] + c);
                f32x4 o;
#pragma unroll
                for (int jj = 0; jj < 4; ++jj) o[jj] = xm[jj] + g2v[jj] * (f[q4 * 4 + jj] * rinv * gp[jj]);
                *(f32x4*)(a.out + (size_t)tok * DM + c) = o; }
        }
    }
}

#ifdef DBG_DIGEST
__device__ void phase_digest(const Args& a, int vb, int nb) {
    const bf16_t* A2 = (const bf16_t*)(a.ws + WS_A2);
    const bf16_t* Q = (const bf16_t*)(a.ws + WS_Q); const bf16_t* K = (const bf16_t*)(a.ws + WS_K); const bf16_t* VV = (const bf16_t*)(a.ws + WS_VV);
    const bf16_t* L = (const bf16_t*)(a.ws + WS_L); const bf16_t* ZG = (const bf16_t*)(a.ws + WS_ZG);
    for (size_t e = (size_t)vb * NTHR + threadIdx.x; e < (size_t)NTOK * DM; e += (size_t)nb * NTHR) {
        float v = 0.f;
#if DBG_DIGEST == 3
        const size_t row = e >> 10; const int c = (int)(e & 1023);
        v = bf2f(A2[row * KOUT + c]); if (c < 512) v += bf2f(A2[row * KOUT + 1024 + c]);
#elif DBG_DIGEST == 2
        const size_t h = e % ((size_t)NTOK * 512);
        v = bf2f(Q[h]) + bf2f(ZG[h]) + bf2f(L[e % ((size_t)NB * STOT * 512)]);
        if (e < (size_t)NB * 2 * STOT * 64) v += bf2f(K[e]) + bf2f(VV[e]);
#endif
        a.out[e] = v; }
}
#endif
constexpr int LDS_BYTES = 155648;
constexpr int LDS_BARST = LDS_BYTES - 16;
static_assert(8 * P7_HTP <= P7_RING && 4 * P7_ATP <= P7_RING && 8 * P7_WLDS <= LDS_BARST && PK_END <= LDS_BARST && LR_END <= LDS_BARST && g8::SHM_B <= LDS_BARST && 17 * 1024 * 4 + 17 * 24 * 4 <= LDS_BARST, "LDS budget");
constexpr int N_PHASES = 8;

__global__ void __launch_bounds__(NTHR, 2) mk_fwd(Args a) {
    extern __shared__ __attribute__((aligned(16))) char lds[];
    const int nb = gridDim.x, bx = blockIdx.x;
    const int vb0 = (nb % 8 == 0) ? (bx % 8) * (nb / 8) + bx / 8 : bx;
    XcdBarrier bar; bar.bar = (unsigned*)(a.ws + WS_CTL); bar.x = 0; bar.st = (volatile LAS unsigned*)(LAS char*)(lds + LDS_BARST);
    const bool multi = (a.ph_hi - a.ph_lo) > 1;
    if (multi) {
        if (threadIdx.x < 4) ((volatile LAS unsigned*)(LAS char*)(lds + LDS_BARST))[threadIdx.x] = 0u;
        __syncthreads();
        bar = xcd_barrier_post((unsigned*)(a.ws + WS_CTL), (volatile LAS unsigned*)(LAS char*)(lds + LDS_BARST));
    }
#ifndef P7_PROBE
#define P7_PROBE -1
#endif
#ifndef DBL_PHASE
#define DBL_PHASE 0
#endif
#if DBL_PHASE != 0
#define RUN_PHASE(P, CALL) do { if (a.ph_lo <= (P) && (P) < a.ph_hi) { const int nrep_ = ((a.dbl >> (P)) & 1) ? 2 : 1; for (int rep_ = 0; rep_ < nrep_; ++rep_) { CALL; if ((P) + 1 < a.ph_hi || rep_ + 1 < nrep_) xcd_barrier(bar); } } } while (0)
#else
#define RUN_PHASE(P, CALL) do { if (a.ph_lo <= (P) && (P) < a.ph_hi) { CALL; if ((P) + 1 < a.ph_hi) xcd_barrier(bar); } } while (0)
#endif
#if !defined(ONLY_PHASE) || ONLY_PHASE == 0
    RUN_PHASE(0, phase_prep(a, lds, vb0, nb));
#endif
    int vb = vb0;
    if (multi && a.ph_lo == 0 && a.ph_hi > 1) {
        if (threadIdx.x == 0) { unsigned off = 0; for (unsigned j = 0; j < bar.x; ++j) off += xb_ld(&bar.bar[XB_XCNT(j)]); bar.st[3] = off + bar.st[2]; }
        __syncthreads();
        vb = (int)bar.st[3];
    }
#if !defined(ONLY_PHASE) || ONLY_PHASE == 1
    RUN_PHASE(1, phase_xn(a, vb, nb));
#endif
#if !defined(ONLY_PHASE) || ONLY_PHASE == 2
    RUN_PHASE(2, phase_inproj(a, lds, vb, nb));
#endif
#if (!defined(ONLY_PHASE) || ONLY_PHASE == 3) && !(defined(DBG_DIGEST) && DBG_DIGEST == 2)
    RUN_PHASE(3, phase_mixer(a, lds, vb, nb));
#endif
#ifdef DBG_DIGEST
    if (a.ph_lo <= 4 && 4 < a.ph_hi) phase_digest(a, vb, nb);
    return;
#endif
#if !defined(ONLY_PHASE) || ONLY_PHASE == 4
    RUN_PHASE(4, phase_outproj(a, lds, vb, nb));
#endif
#if !defined(ONLY_PHASE) || ONLY_PHASE == 5
    RUN_PHASE(5, phase_rowpass(a, vb, nb));
#endif
#if !defined(ONLY_PHASE) || ONLY_PHASE == 6
    RUN_PHASE(6, phase_peer_topk(a, lds, vb, nb));
#endif
#if !defined(ONLY_PHASE) || ONLY_PHASE == 7
    RUN_PHASE(7, phase_peer_gather(a, lds, vb, nb));
#endif
}

extern "C" void kernel_launch(void* const* d_in, const int* in_sizes, int n_in, void* d_out, int out_size, void* d_ws, size_t ws_size, hipStream_t stream) {
    static int grid = 0;
    if (grid == 0) {
        if (n_in != 25 || out_size != NTOK * DM || ws_size < WS_END) { fprintf(stderr, "kernel_launch: unexpected shapes (n_in %d, out %d, ws %zu, need %zu)\n", n_in, out_size, ws_size, (size_t)WS_END); grid = -1; return; }
        int dev = 0, cus = 0;
        if (hipGetDevice(&dev) != hipSuccess || hipDeviceGetAttribute(&cus, hipDeviceAttributeMultiprocessorCount, dev) != hipSuccess) { grid = -1; return; }
        if (hipFuncSetAttribute((const void*)mk_fwd, hipFuncAttributeMaxDynamicSharedMemorySize, LDS_BYTES) != hipSuccess) { fprintf(stderr, "kernel_launch: hipFuncSetAttribute failed\n"); grid = -1; return; }
        (void)hipGetLastError();
        grid = cus;
    }
    if (grid < 0) return;
    (void)hipMemsetAsync((char*)d_ws + WS_CTL, 0, CTL_BYTES, stream);
    Args a{};
    for (int i = 0; i < 25; ++i) a.in[i] = (const float*)d_in[i];
    a.out = (float*)d_out; a.ws = (unsigned char*)d_ws; a.dbl = DBL_PHASE; a.probe = P7_PROBE;
#if MK_N_LAUNCHES == 1
    a.ph_lo = 0; a.ph_hi = N_PHASES;
    hipLaunchKernelGGL(mk_fwd, dim3(grid), dim3(NTHR), LDS_BYTES, stream, a);
#else
    for (int ph = 0; ph < N_PHASES; ++ph) { a.ph_lo = ph; a.ph_hi = ph + 1; hipLaunchKernelGGL(mk_fwd, dim3(grid), dim3(NTHR), LDS_BYTES, stream, a); }
#endif
}
```

```cpp
#include <hip/hip_runtime.h>
#include <cstdio>
#include <cstdint>

#ifndef MK_N_LAUNCHES
#define MK_N_LAUNCHES 1
#endif

typedef unsigned short bf16_t;
typedef short bf16x8 __attribute__((ext_vector_type(8)));
typedef float f32x16 __attribute__((ext_vector_type(16)));
typedef float f32x4 __attribute__((ext_vector_type(4)));
typedef float f32x2 __attribute__((ext_vector_type(2)));
typedef unsigned u32x4 __attribute__((ext_vector_type(4)));
typedef unsigned u32x2 __attribute__((ext_vector_type(2)));
typedef int i32x8 __attribute__((ext_vector_type(8)));
typedef unsigned u32x6 __attribute__((ext_vector_type(6)));
typedef short s16x2 __attribute__((ext_vector_type(2)));
typedef unsigned short us2 __attribute__((ext_vector_type(2)));
typedef int i32x4 __attribute__((ext_vector_type(4)));
#define LAS __attribute__((address_space(3)))

constexpr int DM = 1024, NB = 16, SEQ = 2048, CTX = 256, STOT = SEQ + CTX;
constexpr int NTOK = NB * SEQ;
constexpr int NCTX = NB * CTX;
constexpr int NROWS = NTOK + NCTX;
constexpr int DIN = 1792, DLRU = 512;
constexpr int KOUT = 1024;
constexpr int PEER_N = 16384;
constexpr float EPS = 1e-6f;
constexpr int NTHR = 512;

constexpr size_t al256(size_t x) { return (x + 255) & ~(size_t)255; }
constexpr size_t WS_CTL   = 0;
constexpr size_t CTL_BYTES = 65536;
constexpr size_t WS_MOD   = WS_CTL + CTL_BYTES;
constexpr size_t WS_ROPE  = WS_MOD + al256(17 * 6144 * 4);
constexpr size_t WS_WIN   = WS_ROPE + al256(64 * 16 * 2 * 4);
constexpr size_t WS_WOUT  = WS_WIN + al256((size_t)DIN * DM * 2);
constexpr size_t WS_WQ    = WS_WOUT + al256((size_t)DM * KOUT * 2);
constexpr size_t WS_SUBK  = WS_WQ + al256((size_t)2048 * DM * 2);
constexpr size_t WS_RGW   = WS_SUBK + al256((size_t)8 * 2 * 128 * 128 * 2);
constexpr size_t WS_UT    = WS_RGW + al256((size_t)2 * 8 * 128 * 64 * 2);
constexpr size_t WS_VT    = WS_UT + al256((size_t)PEER_N * DM * 2);
constexpr size_t WS_XN    = WS_VT + al256((size_t)PEER_N * DM * 2);
constexpr size_t WS_Q     = WS_XN + al256((size_t)NROWS * DM * 2);
constexpr size_t WS_K     = WS_Q + al256((size_t)NTOK * 512 * 2);
constexpr size_t WS_VV    = WS_K + al256((size_t)NB * 2 * STOT * 64 * 2);
constexpr size_t WS_L     = WS_VV + al256((size_t)NB * 2 * STOT * 64 * 2);
constexpr size_t WS_ZG    = WS_L + al256((size_t)NB * STOT * DLRU * 2);
constexpr size_t WS_A2    = WS_ZG + al256((size_t)NTOK * DLRU * 2);
constexpr size_t WS_END   = WS_A2 + al256((size_t)NTOK * KOUT * 2);
constexpr size_t WS_MIX   = WS_XN;
constexpr size_t WS_HX2   = WS_A2;
constexpr size_t WS_XM    = WS_Q;
constexpr size_t WS_IDX   = WS_ZG;
constexpr size_t WS_GATE  = WS_ZG + (size_t)NTOK * 128 * 4;
static_assert(WS_MIX + (size_t)NTOK * DM * 4 <= WS_ZG, "MIX overlay must end before ZG");
static_assert(WS_GATE + (size_t)NTOK * 128 * 4 <= WS_A2, "IDX/GATE overlay must end before A2");

typedef __bf16 bf16x2_t __attribute__((ext_vector_type(2)));
__device__ __forceinline__ unsigned pk2(float lo, float hi) { const f32x2 v = {lo, hi}; const bf16x2_t b = __builtin_convertvector(v, bf16x2_t); return __builtin_bit_cast(unsigned, b); }
typedef _Float16 h16x2 __attribute__((ext_vector_type(2)));
constexpr float V_SCALE = 64.f;
constexpr float T_SCALE = 256.f;
constexpr int U6_ROW = 768;
constexpr size_t U6_SCALE_OFF = (size_t)16 << 20;
#ifndef P7_FP8
#define P7_FP8 1
#endif
__device__ __forceinline__ unsigned pkh2(float lo, float hi) { const h16x2 h = {(_Float16)lo, (_Float16)hi}; return __builtin_bit_cast(unsigned, h); }
__device__ __forceinline__ bf16x2_t as_bf2(unsigned x) { return __builtin_bit_cast(bf16x2_t, x); }
__device__ __forceinline__ h16x2 as_h2(unsigned x) { return __builtin_bit_cast(h16x2, x); }
__device__ __forceinline__ bf16_t f2bf(float f) { return (bf16_t)(pk2(f, 0.f) & 0xffffu); }
__device__ __forceinline__ float bf2f(unsigned h) { return __uint_as_float(h << 16); }
__device__ __forceinline__ float bflo(unsigned w) { return __uint_as_float(w << 16); }
__device__ __forceinline__ float bfhi(unsigned w) { return __uint_as_float(w & 0xffff0000u); }
__device__ __forceinline__ float sat8(float x) { return fminf(fmaxf(x, -448.f), 448.f); }
__device__ __forceinline__ float fast_rcp(float x) { return __builtin_amdgcn_rcpf(x); }
__device__ __forceinline__ float sigmoidf_(float x) { return fast_rcp(1.f + __expf(-x)); }
__device__ __forceinline__ float gelu_tanh(float x) { const float y = 0.7978845608028654f * (x + 0.044715f * x * x * x); return x * fast_rcp(1.f + __expf(-2.f * y)); }
__device__ __forceinline__ float silu_(float x) { return x * sigmoidf_(x); }
__device__ __forceinline__ float wave_sum(float v) {
#pragma unroll
    for (int o = 32; o > 0; o >>= 1) v += __shfl_xor(v, o);
    return v;
}
__device__ __forceinline__ float half_swap_max(float v) { auto rr = __builtin_amdgcn_permlane32_swap(__float_as_uint(v), __float_as_uint(v), false, false); return fmaxf(__uint_as_float(rr[0]), __uint_as_float(rr[1])); }
__device__ __forceinline__ float half_swap_sum(float v) { auto rr = __builtin_amdgcn_permlane32_swap(__float_as_uint(v), __float_as_uint(v), false, false); return __uint_as_float(rr[0]) + __uint_as_float(rr[1]); }
#define MFMA(a, b, c) __builtin_amdgcn_mfma_f32_32x32x16_bf16((a), (b), (c), 0, 0, 0)

#define XB_TMO      128
#define XB_XCNT(j)  (256  + 64 * (j))
#define XB_XSUB(j)  (1280 + 64 * (j))
#define XB_XGEN(j)  (2304 + 64 * (j))
#define XB_TOP      3328
#define XB_TOPGEN   3392
#define XCD_BAR_WORDS 3456
#define XB_SPIN_CAP (1u << 20)
__device__ __forceinline__ unsigned xb_ld(unsigned* p)              { return __hip_atomic_load(p, __ATOMIC_RELAXED, __HIP_MEMORY_SCOPE_AGENT); }
__device__ __forceinline__ unsigned xb_add(unsigned* p, unsigned v) { return __hip_atomic_fetch_add(p, v, __ATOMIC_RELAXED, __HIP_MEMORY_SCOPE_AGENT); }
__device__ __forceinline__ unsigned xb_xcc_id() { return (unsigned)__builtin_amdgcn_s_getreg((3 << 11) | 20) & 0xFu; }
#define XB_SPIN(cond, bar) do { unsigned _sp = 0; while (cond) { __builtin_amdgcn_s_sleep(1); \
    if ((++_sp & 255u) == 0u) { if (xb_ld(&(bar)[XB_TMO])) break; if (_sp > XB_SPIN_CAP) { atomicAdd(&(bar)[XB_TMO], 1u); break; } } } } while (0)
struct XcdBarrier { unsigned* bar; unsigned x; volatile LAS unsigned* st; };
__device__ __forceinline__ XcdBarrier xcd_barrier_post(unsigned* bar, volatile LAS unsigned* st) {
    XcdBarrier b; b.bar = bar; b.x = xb_xcc_id(); b.st = st;
    if (threadIdx.x == 0) st[2] = xb_add(&bar[XB_XCNT(b.x)], 1u);
    return b;
}
__device__ __forceinline__ void xcd_barrier_complete(unsigned* bar, unsigned x, unsigned& nloc, unsigned& nx) {
    const unsigned G = gridDim.x * gridDim.y * gridDim.z;
    unsigned sum, cnt, mine, sp = 0u;
    for (;;) {
        sum = 0u; cnt = 0u; mine = 0u;
#pragma unroll
        for (unsigned j = 0; j < 16; ++j) { const unsigned c = xb_ld(&bar[XB_XCNT(j)]); sum += c; cnt += (c > 0u) ? 1u : 0u; mine = (j == x) ? c : mine; }
        if (sum == G) break;
        __builtin_amdgcn_s_sleep(1);
        if ((++sp & 255u) == 0u) { if (xb_ld(&bar[XB_TMO])) break; if (sp > XB_SPIN_CAP) { atomicAdd(&bar[XB_TMO], 1u); break; } }
    }
    nloc = mine > 0u ? mine : 1u; nx = cnt > 0u ? cnt : 1u;
}
__device__ __forceinline__ void xcd_barrier(const XcdBarrier& b) {
    asm volatile("s_waitcnt vmcnt(0)" ::: "memory");
    __syncthreads();
    if (threadIdx.x == 0) {
        unsigned* bar = b.bar;
        __builtin_amdgcn_s_waitcnt(0);
        unsigned nloc = b.st[0], nx = b.st[1];
        if (nloc == 0u) { xcd_barrier_complete(bar, b.x, nloc, nx); b.st[0] = nloc; b.st[1] = nx; }
        const unsigned old = xb_add(&bar[XB_XSUB(b.x)], 1u);
        const unsigned gen = old / nloc;
        if (old + 1u == (gen + 1u) * nloc) {
            __builtin_amdgcn_fence(__ATOMIC_RELEASE, "agent");
            asm volatile("s_waitcnt vmcnt(0)" ::: "memory");
            const unsigned og = xb_add(&bar[XB_TOP], 1u);
            const unsigned tg = og / nx;
            if (og + 1u == (tg + 1u) * nx) xb_add(&bar[XB_TOPGEN], 1u);
            else XB_SPIN(xb_ld(&bar[XB_TOPGEN]) == tg, bar);
            __builtin_amdgcn_fence(__ATOMIC_ACQUIRE, "agent");
            xb_add(&bar[XB_XGEN(b.x)], 1u);
            asm volatile("s_waitcnt vmcnt(0)" ::: "memory");
        } else {
            XB_SPIN(xb_ld(&bar[XB_XGEN(b.x)]) == gen, bar);
            __builtin_amdgcn_fence(__ATOMIC_ACQUIRE, "agent");
            asm volatile("s_waitcnt vmcnt(0)" ::: "memory");
        }
    }
    __syncthreads();
}

struct Args { const float* in[25]; float* out; unsigned char* ws; int ph_lo, ph_hi, dbl, probe; };
enum { I_X = 0, I_C, I_CTX, I_CCTX, I_WMOD, I_BMOD, I_GPREMIX, I_GPOSTMIX, I_GPREFFN, I_GPOSTFFN, I_WIN, I_QNG, I_KNG, I_CONVW, I_CONVB,
       I_RGWA, I_RGBA, I_RGWI, I_RGBI, I_RGLAM, I_WOUT, I_PWQ, I_PSUBK, I_PU, I_PV };

__device__ __forceinline__ void tr_tile(const float* __restrict__ src, int lds_, int sr0, int sc0, bf16_t* __restrict__ dst, int ldd, int dr0, int dc0, float* T) {
    const int tid = threadIdx.x;
#pragma unroll
    for (int i = 0; i < 8; ++i) { const int e = tid + NTHR * i, r = e >> 6, c = e & 63; T[r * 65 + c] = src[(size_t)(sr0 + r) * lds_ + sc0 + c]; }
    __syncthreads();
#pragma unroll
    for (int i = 0; i < 8; ++i) { const int e = tid + NTHR * i, c = e >> 6, r = e & 63; dst[(size_t)(dr0 + c) * ldd + dc0 + r] = f2bf(T[r * 65 + c]); }
    __syncthreads();
}
__device__ __forceinline__ void tr_tile2(const float* __restrict__ srcA, const float* __restrict__ srcB, int lds_, bf16_t* __restrict__ dstA, bf16_t* __restrict__ dstB, int ldd, float* T) {
    const int tid = threadIdx.x;
    float va[8], vb2[8];
#pragma unroll
    for (int i = 0; i < 8; ++i) { const int e = tid + NTHR * i, r = e >> 6, c = e & 63; va[i] = srcA[(size_t)r * lds_ + c]; vb2[i] = srcB[(size_t)r * lds_ + c]; }
#pragma unroll
    for (int i = 0; i < 8; ++i) { const int e = tid + NTHR * i, r = e >> 6, c = e & 63; T[r * 65 + c] = va[i]; T[4160 + r * 65 + c] = vb2[i]; }
    __syncthreads();
#pragma unroll
    for (int i = 0; i < 8; ++i) { const int e = tid + NTHR * i, c = e >> 6, r = e & 63; dstA[(size_t)c * ldd + r] = f2bf(T[r * 65 + c]); dstB[(size_t)c * ldd + r] = f2bf(T[4160 + r * 65 + c]); }
    __syncthreads();
}

constexpr int UV_ITEMS = 512;
constexpr int CTL_UVCTR = 8192;
__device__ __forceinline__ unsigned q_e2m3(float x) {
    const float a = fminf(fabsf(x), 7.5f);
    const float sc = a < 2.f ? 8.f : (a < 4.f ? 4.f : 2.f);
    const unsigned add = a < 2.f ? 0u : (a < 4.f ? 8u : 16u);
    const unsigned q = (unsigned)__builtin_rintf(a * sc) + add;
    return q | (x < 0.f ? 32u : 0u);
}
__device__ __forceinline__ float d_e2m3(unsigned c) {
    const float mag = (c & 24u) ? __uint_as_float(((126u + ((c >> 3) & 3u)) << 23) | ((c & 7u) << 20)) : (float)(c & 7u) * 0.125f;
    return (c & 32u) ? -mag : mag;
}
__device__ __forceinline__ int mx_row_exp(float amax) {
    const int e = (int)((__float_as_uint(amax * (1.f / 7.5f)) >> 23) & 255u) - 126;
    return amax > 0.f ? min(max(e, -100), 100) : 0;
}
__device__ __forceinline__ void conv_uv_item(const Args& a, int t) {
    const int tid = threadIdx.x;
    const bool isv = t >= 256; const int tt = t & 255;
    const float* src = (isv ? a.in[I_PV] : a.in[I_PU]) + (size_t)tt * 65536;
    unsigned char* d8 = a.ws + (isv ? WS_VT : WS_UT) + (size_t)tt * 65536;
#pragma unroll 1
    for (int e0 = tid * 16; e0 < 65536; e0 += NTHR * 16 * 4) {
        f32x4 v[4][4];
#pragma unroll
        for (int u = 0; u < 4; ++u)
#pragma unroll
            for (int q = 0; q < 4; ++q) v[u][q] = *(const f32x4*)(src + e0 + u * NTHR * 16 + q * 4);
        if (!isv) {
#pragma unroll
            for (int u = 0; u < 4; ++u) { unsigned c[16];
                const int e = e0 + u * NTHR * 16, row = tt * 64 + (e >> 10);
                float amax = 0.f;
#pragma unroll
                for (int q = 0; q < 4; ++q)
#pragma unroll
                    for (int i = 0; i < 4; ++i) amax = fmaxf(amax, fabsf(v[u][q][i]));
#pragma unroll
                for (int o_ = 32; o_ > 0; o_ >>= 1) amax = fmaxf(amax, __shfl_xor(amax, o_));
                const int ex = mx_row_exp(amax);
                const float inv = __uint_as_float((unsigned)(127 - ex) << 23);
                if ((tid & 63) == 0) (a.ws + WS_UT + U6_SCALE_OFF)[row] = (unsigned char)(127 + ex);
                f32x16 xe, xo;
#pragma unroll
                for (int i = 0; i < 8; ++i) { xe[i] = v[u][i >> 1][(2 * i) & 3] * inv; xo[i] = v[u][i >> 1][(2 * i + 1) & 3] * inv; xe[8 + i] = 0.f; xo[8 + i] = 0.f; }
                const u32x6 w6 = __builtin_amdgcn_cvt_scalef32_2xpk16_fp6_f32(xe, xo, 1.0f);
                const unsigned w0 = w6[0], w1 = w6[1], w2 = w6[2]; (void)c;
                unsigned* dp = (unsigned*)(a.ws + WS_UT + (size_t)row * U6_ROW + ((e & 1023) * 3 >> 2));
                dp[0] = w0; dp[1] = w1; dp[2] = w2; }
        } else
#pragma unroll
        for (int u = 0; u < 4; ++u) { u32x4 o;
#pragma unroll
            for (int q = 0; q < 4; ++q) { f32x4 x = v[u][q] * T_SCALE;
#pragma unroll
                for (int i = 0; i < 4; ++i) x[i] = fminf(fmaxf(x[i], -448.f), 448.f);
                int w = __builtin_amdgcn_cvt_pk_fp8_f32(x[0], x[1], 0, false); w = __builtin_amdgcn_cvt_pk_fp8_f32(x[2], x[3], w, true); o[q] = (unsigned)w; }
            *(u32x4*)(d8 + e0 + u * NTHR * 16) = o; }
    }
}
__device__ __forceinline__ void phase_prep(const Args& a, char* lds, int vb, int nb) {
    const int tid = threadIdx.x;
    unsigned char* ws = a.ws;
    float* S = (float*)lds;
    float* T = (float*)lds;
    constexpr int N_MOD = 256, N_TIN = 224, N_TOUT = 128, N_TWQ = 256, N_RGW = 16, N_SUBK = 0, N_UV = 0, N_MISC = 1;
    constexpr int O_TIN = N_MOD, O_TOUT = O_TIN + N_TIN, O_TWQ = O_TOUT + N_TOUT, O_RGW = O_TWQ + N_TWQ, O_SUBK = O_RGW + N_RGW, O_UV = O_SUBK + N_SUBK, O_MISC = O_UV + N_UV, N_ALL = O_MISC + N_MISC;
    for (int it = vb; it < N_ALL; it += nb) {
        if (it < O_TIN) {
            {
                int tq = tid; asm volatile("" : "+v"(tq));
                const float* cp = a.in[I_C] + tq; const float* xp = a.in[I_CCTX] + tq;
                float cv[17];
#pragma unroll
                for (int i = 0; i < 17; ++i) cv[i] = cp[NTHR * i];
#pragma unroll
                for (int i = 0; i < 17; ++i) S[tid + NTHR * i] = silu_(cv[i]);
#pragma unroll
                for (int i = 0; i < 15; ++i) cv[i] = cp[NTHR * (17 + i)];
                cv[15] = xp[0]; cv[16] = xp[NTHR];
#pragma unroll
                for (int i = 0; i < 17; ++i) S[tid + NTHR * (17 + i)] = silu_(cv[i]);
            }
            __syncthreads();
            const int n0 = it * 24;
            const int cc = tid % 6, kk = tid / 6;
            float acc[17][4];
#pragma unroll
            for (int r = 0; r < 17; ++r) { acc[r][0] = 0.f; acc[r][1] = 0.f; acc[r][2] = 0.f; acc[r][3] = 0.f; }
            if (tid < 510) {
#pragma unroll 1
                for (int i0 = 0; i0 < 16; i0 += 4) {
                    f32x4 wv[4];
#pragma unroll
                    for (int i = 0; i < 4; ++i) { const int k = min(kk + 85 * (i0 + i), 1023); wv[i] = *(const f32x4*)(a.in[I_WMOD] + (size_t)k * 6144 + n0 + cc * 4); }
#pragma unroll
                    for (int i = 0; i < 4; ++i) { const int k = kk + 85 * (i0 + i); const bool ok = k < 1024; const int kc = min(k, 1023);
                        const f32x4 w = ok ? wv[i] : (f32x4){0.f, 0.f, 0.f, 0.f};
#pragma unroll
                        for (int r = 0; r < 17; ++r) { const float s = S[r * 1024 + kc]; acc[r][0] += s * w[0]; acc[r][1] += s * w[1]; acc[r][2] += s * w[2]; acc[r][3] += s * w[3]; }
                    }
                }
            }
            __syncthreads();
            if (tid < 510) {
#pragma unroll
                for (int r = 0; r < 17; ++r) { f32x4 v = {acc[r][0], acc[r][1], acc[r][2], acc[r][3]}; *(f32x4*)(S + (kk * 17 + r) * 24 + cc * 4) = v; }
            }
            __syncthreads();
            float* mod = (float*)(ws + WS_MOD);
            for (int e = tid; e < 17 * 24; e += NTHR) { const int r = e / 24, j = e % 24; float sum = 0.f;
                for (int q = 0; q < 85; ++q) sum += S[(q * 17 + r) * 24 + j];
                mod[r * 6144 + n0 + j] = sum + a.in[I_BMOD][n0 + j]; }
            __syncthreads();
        } else if (it < O_TOUT) {
            const int t = it - O_TIN, kt = t / 14, nt = (t % 14) * 2;
            const float* sp = a.in[I_WIN] + (size_t)(kt * 64) * DIN + nt * 64; bf16_t* dp = (bf16_t*)(ws + WS_WIN) + (size_t)(nt * 64) * DM + kt * 64;
            tr_tile2(sp, sp + 64, DIN, dp, dp + (size_t)64 * DM, DM, T);
        } else if (it < O_TWQ) {
            const int t = it - O_TOUT, kt = t / 8, nt = (t % 8) * 2;
            const int sk = kt * 64;
            const float* sp = a.in[I_WOUT] + (size_t)sk * DM + nt * 64; bf16_t* dp = (bf16_t*)(ws + WS_WOUT) + (size_t)(nt * 64) * KOUT + kt * 64;
            tr_tile2(sp, sp + 64, DM, dp, dp + (size_t)64 * KOUT, KOUT, T);
        } else if (it < O_RGW) {
            const int t = it - O_TWQ, hp = t >> 4, kb = t & 15;
            int tq = tid; asm volatile("" : "+v"(tq));
            const int lane = tq & 63, wid = tq >> 6, r32 = lane & 31, hi = lane >> 5, mt = wid & 3, nt = wid >> 2;
            const float* ap = a.in[I_PSUBK] + (size_t)hp * 16384 + (size_t)(mt * 32 + r32) * 128 + hi * 8;
            const float* bp = a.in[I_PWQ] + (size_t)(kb * 64 + nt * 32 + r32) * 2048 + hp * 128 + hi * 8;
            f32x16 acc;
#pragma unroll
            for (int r = 0; r < 16; ++r) acc[r] = 0.f;
#pragma unroll
            for (int ks = 0; ks < 8; ++ks) {
                const f32x4 a0 = *(const f32x4*)(ap + ks * 16), a1 = *(const f32x4*)(ap + ks * 16 + 4), b0 = *(const f32x4*)(bp + ks * 16), b1 = *(const f32x4*)(bp + ks * 16 + 4);
                const u32x4 aw = {pk2(a0[0], a0[1]), pk2(a0[2], a0[3]), pk2(a1[0], a1[1]), pk2(a1[2], a1[3])}, bw = {pk2(b0[0], b0[1]), pk2(b0[2], b0[3]), pk2(b1[0], b1[1]), pk2(b1[2], b1[3])};
                acc = MFMA(__builtin_bit_cast(bf16x8, aw), __builtin_bit_cast(bf16x8, bw), acc);
            }
            bf16_t* dp = (bf16_t*)(ws + WS_WQ) + (size_t)(hp * 128 + mt * 32 + 4 * hi) * DM + kb * 64 + nt * 32 + r32;
#pragma unroll
            for (int r = 0; r < 16; ++r) dp[(size_t)(8 * (r >> 2) + (r & 3)) * DM] = f2bf(acc[r]);
        } else if (it < O_SUBK) {
            const int dn = it - O_RGW;
            bf16_t* dp = (bf16_t*)(ws + WS_RGW) + (size_t)dn * 128 * 64;
            tr_tile2(a.in[I_RGWA] + (size_t)dn * 4096, a.in[I_RGWI] + (size_t)dn * 4096, 64, dp, dp + 64 * 64, 64, T);
        } else if (it < O_UV) {
            const int t = it - O_SUBK; const float* src = a.in[I_PSUBK] + (size_t)t * 16384; bf16_t* dst = (bf16_t*)(ws + WS_SUBK) + (size_t)t * 16384;
            for (int e = tid * 4; e < 16384; e += NTHR * 4) { const f32x4 v = *(const f32x4*)(src + e); u32x2 o = {pk2(v[0], v[1]), pk2(v[2], v[3])}; *(u32x2*)(dst + e) = o; }
        } else {
            float* rope = (float*)(ws + WS_ROPE);
            for (int e = tid; e < 64 * 16; e += NTHR) { const int pos = e >> 4, f = e & 15; const float inv = powf(10000.f, -(float)f / 16.f); const float ang = (float)pos * inv; rope[e * 2] = cosf(ang); rope[e * 2 + 1] = sinf(ang); }
        }
    }
}

__device__ __forceinline__ void phase_xn(const Args& a, int vb, int nb) {
    const int tid = threadIdx.x, lane = tid & 63, wid = tid >> 6;
    const float* mod = (const float*)(a.ws + WS_MOD);
    bf16_t* XN = (bf16_t*)(a.ws + WS_XN);
    const float* g = a.in[I_GPREMIX];
    const int chunk = (NROWS + nb - 1) / nb, rend = min(NROWS, (vb + 1) * chunk);
    f32x4 A[4], B[4]; int cur = -1;
    for (int row = vb * chunk + wid; row < rend; row += 8) {
        const float* src; int mrow;
        if (row < NTOK) { src = a.in[I_X] + (size_t)row * DM; mrow = row >> 11; } else { src = a.in[I_CTX] + (size_t)(row - NTOK) * DM; mrow = 16; }
        f32x4 v[4]; float ss = 0.f;
#pragma unroll
        for (int i = 0; i < 4; ++i) v[i] = __builtin_nontemporal_load((const f32x4*)(src + i * 256 + lane * 4));
        if (mrow != cur) { cur = mrow; const float* sh = mod + (size_t)mrow * 6144, *sc = sh + 1024;
#pragma unroll
            for (int i = 0; i < 4; ++i) { const int c = i * 256 + lane * 4; const f32x4 gg = *(const f32x4*)(g + c), s1 = *(const f32x4*)(sc + c); B[i] = *(const f32x4*)(sh + c);
#pragma unroll
                for (int j = 0; j < 4; ++j) A[i][j] = gg[j] * (1.f + s1[j]); } }
#pragma unroll
        for (int i = 0; i < 4; ++i) ss += v[i][0] * v[i][0] + v[i][1] * v[i][1] + v[i][2] * v[i][2] + v[i][3] * v[i][3];
        ss = wave_sum(ss);
        const float rinv = rsqrtf(ss * (1.f / DM) + EPS);
#pragma unroll
        for (int i = 0; i < 4; ++i) { const int c = i * 256 + lane * 4;
            float o[4];
#pragma unroll
            for (int j = 0; j < 4; ++j) o[j] = v[i][j] * rinv * A[i][j] + B[i][j];
            u32x2 w = {pk2(o[0], o[1]), pk2(o[2], o[3])}; *(u32x2*)(XN + (size_t)row * DM + c) = w; }
    }
}

constexpr int E_PITCH = 272;
namespace g8 {
constexpr int BM = 256, BK = 64, HALF = 128, HT = HALF * BK, SHM_B = 8 * HT * 2;
__device__ __forceinline__ int lds_byte(int r, int c) { const int st = (r >> 4) * 2 + (c >> 5), rr = r & 15, cc = c & 31, ob = rr * 64 + cc * 2; return st * 1024 + (ob ^ (((ob >> 9) & 1) << 5)); }
__device__ __forceinline__ void stage_rc(int b, int& R, int& C) { const int st = b / 1024, sb = b % 1024, swz = sb ^ (((sb >> 9) & 1) << 5); R = (st >> 1) * 16 + swz / 64; C = (st & 1) * 32 + (swz % 64) / 2; }
__device__ __forceinline__ void core_pre(const bf16_t* __restrict__ A, const bf16_t* __restrict__ Bt, int brow, int bcol, int K, char* lds_) {
    LAS unsigned char* lds = (LAS unsigned char*)lds_;
    const int tid = threadIdx.x, wid = __builtin_amdgcn_readfirstlane(tid >> 6);
    constexpr int HTB = HT * 2;
    unsigned voff[2];
#pragma unroll
    for (int i = 0; i < 2; ++i) { int R, C; stage_rc(tid * 16 + i * 8192, R, C); voff[i] = (unsigned)(R * K + C) * 2u; }
    const size_t hstep = (size_t)HALF * K * 2;
    const unsigned ldsw = (unsigned)wid * 1024u;
    const char* cA = (const char*)(A + (size_t)brow * K); const char* cB = (const char*)(Bt + (size_t)bcol * K);
#define G8P_STAGE(bufoff, gbase) do { _Pragma("unroll") for (int _i = 0; _i < 2; ++_i) \
        __builtin_amdgcn_global_load_lds((const unsigned*)((const char*)(gbase) + voff[_i]), (LAS unsigned*)(lds + (bufoff) + ldsw + _i * 8192), 16, 0, 0); } while (0)
    G8P_STAGE((4 + 0) * HTB, cB); G8P_STAGE(0 * HTB, cA); G8P_STAGE((4 + 1) * HTB, cB + hstep); G8P_STAGE(1 * HTB, cA + hstep);
#undef G8P_STAGE
}
template <bool PRE = false>
__device__ __forceinline__ void core(f32x4 (&acc)[2][2][4][2], const bf16_t* __restrict__ A, const bf16_t* __restrict__ Bt, int brow, int bcol, int K, char* lds_) {
    LAS unsigned char* lds = (LAS unsigned char*)lds_;
    const int tid = threadIdx.x, wid = __builtin_amdgcn_readfirstlane(tid >> 6), lane = tid & 63, wr = wid >> 2, wc = wid & 3, fr = lane & 15, fq = lane >> 4;
    constexpr int HTB = HT * 2;
    unsigned voff[2];
#pragma unroll
    for (int i = 0; i < 2; ++i) { int R, C; stage_rc(tid * 16 + i * 8192, R, C); voff[i] = (unsigned)(R * K + C) * 2u; }
    const size_t kstep = (size_t)(BK * 2), hstep = (size_t)HALF * K * 2;
    const unsigned ldsw = (unsigned)wid * 1024u;
    const int aoff = lds_byte(wr * 64 + fr, fq * 8), boff = lds_byte(wc * 32 + fr, fq * 8);
#define G8_SA(b, h) (((b) * 2 + (h)) * HTB)
#define G8_SB(b, h) ((4 + (b) * 2 + (h)) * HTB)
#define G8_STAGE(bufoff, gbase) do { _Pragma("unroll") for (int _i = 0; _i < 2; ++_i) \
        __builtin_amdgcn_global_load_lds((const unsigned*)((const char*)(gbase) + voff[_i]), (LAS unsigned*)(lds + (bufoff) + ldsw + _i * 8192), 16, 0, 0); } while (0)
#define G8_LDA(dst, b, h) do { _Pragma("unroll") for (int m = 0; m < 4; ++m) _Pragma("unroll") for (int k = 0; k < 2; ++k) dst[m][k] = *(const LAS bf16x8*)(lds + G8_SA(b, h) + aoff + m * 2048 + k * 1024); } while (0)
#define G8_LDB(dst, b, h) do { _Pragma("unroll") for (int n = 0; n < 2; ++n) _Pragma("unroll") for (int k = 0; k < 2; ++k) dst[n][k] = *(const LAS bf16x8*)(lds + G8_SB(b, h) + boff + n * 2048 + k * 1024); } while (0)
#define G8_MMA(ai, bj, At_, Bt_) do { __builtin_amdgcn_s_setprio(1); \
    _Pragma("unroll") for (int m = 0; m < 4; ++m) _Pragma("unroll") for (int n = 0; n < 2; ++n) _Pragma("unroll") for (int k = 0; k < 2; ++k) \
      acc[ai][bj][m][n] = __builtin_amdgcn_mfma_f32_16x16x32_bf16(At_[m][k], Bt_[n][k], acc[ai][bj][m][n], 0, 0, 0); \
    __builtin_amdgcn_s_setprio(0); } while (0)
#define G8_WAIT_V(n) asm volatile("s_waitcnt vmcnt(" #n ")" ::: "memory")
#define G8_WAIT_L(n) asm volatile("s_waitcnt lgkmcnt(" #n ")" ::: "memory")
#define G8_BAR __builtin_amdgcn_s_barrier()
#define G8_SCHED __builtin_amdgcn_sched_barrier(0)
#pragma unroll
    for (int ai = 0; ai < 2; ++ai)
#pragma unroll
        for (int bj = 0; bj < 2; ++bj)
#pragma unroll
            for (int m = 0; m < 4; ++m)
#pragma unroll
                for (int n = 0; n < 2; ++n) acc[ai][bj][m][n] = (f32x4){0.f, 0.f, 0.f, 0.f};
    bf16x8 At[4][2], B0[2][2], B1[2][2];
    const int nt = K / BK;
    const char* cA = (const char*)(A + (size_t)brow * K); const char* cB = (const char*)(Bt + (size_t)bcol * K);
    if (!PRE) { G8_STAGE(G8_SB(0, 0), cB); G8_STAGE(G8_SA(0, 0), cA); G8_STAGE(G8_SB(0, 1), cB + hstep); G8_STAGE(G8_SA(0, 1), cA + hstep); }
    if (wr == 1) G8_BAR;
    if (PRE) G8_WAIT_V(0); else G8_WAIT_V(4);
    G8_BAR;
    G8_STAGE(G8_SB(1, 0), cB + kstep); G8_STAGE(G8_SA(1, 0), cA + kstep); G8_STAGE(G8_SB(1, 1), cB + hstep + kstep);
    G8_WAIT_V(6); G8_BAR;
#pragma unroll 1
    for (int t = 0; t < nt - 2; t += 2) {
        const char* a1 = cA + (size_t)(t + 1) * kstep; const char* a2 = cA + (size_t)(t + 2) * kstep; const char* b2 = cB + (size_t)(t + 2) * kstep;
        const char* a3 = a2 + kstep; const char* b3 = b2 + kstep;
        G8_LDB(B0, 0, 0); G8_SCHED; G8_LDA(At, 0, 0); G8_STAGE(G8_SA(1, 1), a1 + hstep);
        G8_WAIT_L(8); G8_BAR; G8_WAIT_L(0); G8_MMA(0, 0, At, B0); G8_BAR; G8_SCHED;
        G8_LDB(B1, 0, 1); G8_STAGE(G8_SB(0, 0), b2);
        G8_BAR; G8_WAIT_L(0); G8_MMA(0, 1, At, B1); G8_BAR;
        G8_LDA(At, 0, 1); G8_STAGE(G8_SA(0, 0), a2);
        G8_BAR; G8_WAIT_L(0); G8_MMA(1, 0, At, B0); G8_BAR; G8_SCHED;
        G8_STAGE(G8_SB(0, 1), b2 + hstep);
        G8_WAIT_V(6); G8_BAR; G8_MMA(1, 1, At, B1); G8_BAR;
        G8_LDB(B0, 1, 0); G8_SCHED; G8_LDA(At, 1, 0); G8_STAGE(G8_SA(0, 1), a2 + hstep);
        G8_WAIT_L(8); G8_BAR; G8_WAIT_L(0); G8_MMA(0, 0, At, B0); G8_BAR; G8_SCHED;
        G8_LDB(B1, 1, 1); G8_STAGE(G8_SB(1, 0), b3);
        G8_BAR; G8_WAIT_L(0); G8_MMA(0, 1, At, B1); G8_BAR;
        G8_LDA(At, 1, 1); G8_STAGE(G8_SA(1, 0), a3);
        G8_BAR; G8_WAIT_L(0); G8_MMA(1, 0, At, B0); G8_BAR; G8_SCHED;
        G8_STAGE(G8_SB(1, 1), b3 + hstep);
        G8_WAIT_V(6); G8_BAR; G8_MMA(1, 1, At, B1); G8_BAR;
    }
    { G8_LDB(B0, 0, 0); G8_LDA(At, 0, 0); G8_STAGE(G8_SA(1, 1), cA + (size_t)(nt - 1) * kstep + hstep);
      G8_BAR; G8_WAIT_L(0); G8_MMA(0, 0, At, B0); G8_BAR;
      G8_LDB(B1, 0, 1); G8_BAR; G8_WAIT_L(0); G8_MMA(0, 1, At, B1); G8_BAR;
      G8_LDA(At, 0, 1); G8_WAIT_V(4); G8_BAR; G8_WAIT_L(0); G8_MMA(1, 0, At, B0); G8_MMA(1, 1, At, B1); G8_BAR; }
    { G8_LDB(B0, 1, 0); G8_LDA(At, 1, 0); G8_WAIT_V(2); G8_BAR; G8_WAIT_L(0); G8_MMA(0, 0, At, B0); G8_BAR;
      G8_LDB(B1, 1, 1); G8_WAIT_V(0); G8_BAR; G8_WAIT_L(0); G8_MMA(0, 1, At, B1); G8_BAR;
      G8_LDA(At, 1, 1); G8_BAR; G8_WAIT_L(0); G8_MMA(1, 0, At, B0); G8_MMA(1, 1, At, B1); G8_BAR; }
    if (wr == 0) G8_BAR;
#undef G8_SA
#undef G8_SB
#undef G8_STAGE
#undef G8_LDA
#undef G8_LDB
#undef G8_MMA
#undef G8_WAIT_V
#undef G8_WAIT_L
#undef G8_BAR
#undef G8_SCHED
}
}

__device__ __forceinline__ void phase_inproj(const Args& a, char* lds, int vb, int nb) {
    const int tid = threadIdx.x, lane = tid & 63, wid = tid >> 6, wr = wid >> 2, wc = wid & 3, fr = lane & 15, fq = lane >> 4;
    unsigned char* ws = a.ws;
    const bf16_t* XN = (const bf16_t*)(ws + WS_XN);
    const bf16_t* WIN = (const bf16_t*)(ws + WS_WIN);
    const float* rope = (const float*)(ws + WS_ROPE);
    bf16_t* Qo = (bf16_t*)(ws + WS_Q); bf16_t* Ko = (bf16_t*)(ws + WS_K); bf16_t* Vo = (bf16_t*)(ws + WS_VV); bf16_t* Lo = (bf16_t*)(ws + WS_L); bf16_t* Zo = (bf16_t*)(ws + WS_ZG);
    constexpr int N_LAT = 128 * 7, N_ALL = N_LAT + 16 * 3;
#define P2_TILE(it_, tt_, ft_) int tt_, ft_; if ((it_) < N_LAT) { tt_ = (it_) / 7; ft_ = (it_) % 7; } else { const int j_ = (it_) - N_LAT; tt_ = 128 + j_ / 3; ft_ = 2 + j_ % 3; }
    if (vb < N_ALL) { P2_TILE(vb, t0_, f0_); g8::core_pre(WIN, XN, f0_ * 256, t0_ * 256, DM, lds); }
#pragma unroll 1
    for (int it = vb; it < N_ALL; it += nb) {
        P2_TILE(it, tt, ft);
        f32x4 acc[2][2][4][2];
        g8::core<true>(acc, WIN, XN, ft * 256, tt * 256, DM, lds);
        if (it + nb < N_ALL) { P2_TILE(it + nb, t1_, f1_); g8::core_pre(WIN, XN, f1_ * 256, t1_ * 256, DM, lds); }
        const bool lat = tt < 128;
#pragma unroll
        for (int ai = 0; ai < 2; ++ai) {
            const int g64 = ft * 4 + ai * 2 + wr;
            if (g64 < 10) {
                const bool isq = g64 < 8;
                const float* gn = isq ? a.in[I_QNG] : a.in[I_KNG];
                const float osc = isq ? 0.125f * 1.4426950408889634f * 8.f : 1.f;
                char* QS = lds + (wid < 3 ? 32768 + wid * 9216 : 98304 + (wid - 3) * 9216);
                float gnv[4][4];
#pragma unroll
                for (int m = 0; m < 4; ++m) { const f32x4 gv = *(const f32x4*)(gn + m * 16 + fq * 4); gnv[m][0] = gv[0]; gnv[m][1] = gv[1]; gnv[m][2] = gv[2]; gnv[m][3] = gv[3]; }
#pragma unroll
                for (int bj = 0; bj < 2; ++bj)
#pragma unroll
                    for (int n = 0; n < 2; ++n) {
                        float ss = 0.f;
#pragma unroll
                        for (int m = 0; m < 4; ++m)
#pragma unroll
                            for (int j = 0; j < 4; ++j) ss += acc[ai][bj][m][n][j] * acc[ai][bj][m][n][j];
                        ss += __shfl_xor(ss, 16); ss += __shfl_xor(ss, 32);
                        const float rinv = rsqrtf(ss * (1.f / 64.f) + EPS);
                        const int row = tt * 256 + bj * 128 + wc * 32 + n * 16 + fr;
                        int b, t, s_; if (lat) { b = row >> 11; t = row & 2047; s_ = CTX + t; } else { const int rc = row - NTOK; b = rc >> 8; t = 0; s_ = rc & 255; }
                        unsigned char* dst = isq ? (unsigned char*)Qo + ((size_t)(b * 8 + g64) * SEQ + t) * 64 : (unsigned char*)Ko + ((size_t)(b * 2 + (g64 - 8)) * STOT + s_) * 64;
                        f32x4 csv[2][2];
#pragma unroll
                        for (int ax = 0; ax < 2; ++ax) { const int pos = ax == 0 ? (t >> 6) : (t & 63); const float* rp = rope + (pos * 16 + fq * 4) * 2;
                            csv[ax][0] = *(const f32x4*)rp; csv[ax][1] = *(const f32x4*)(rp + 4); }
#pragma unroll
                        for (int ax = 0; ax < 2; ++ax) {
                            float o1[4], o2[4];
#pragma unroll
                            for (int j = 0; j < 4; ++j) {
                                const float x1 = acc[ai][bj][2 * ax][n][j] * rinv * gnv[2 * ax][j], x2 = acc[ai][bj][2 * ax + 1][n][j] * rinv * gnv[2 * ax + 1][j];
                                const float co = lat ? csv[ax][j >> 1][(j & 1) * 2] : 1.f, si = lat ? csv[ax][j >> 1][(j & 1) * 2 + 1] : 0.f;
                                const float c1 = x1 * co - x2 * si, c2 = x1 * si + x2 * co;
                                o1[j] = c1 * osc; o2[j] = c2 * osc; }
                            { int w1 = __builtin_amdgcn_cvt_pk_fp8_f32(sat8(o1[0]), sat8(o1[1]), 0, false); w1 = __builtin_amdgcn_cvt_pk_fp8_f32(sat8(o1[2]), sat8(o1[3]), w1, true);
                              int w2 = __builtin_amdgcn_cvt_pk_fp8_f32(sat8(o2[0]), sat8(o2[1]), 0, false); w2 = __builtin_amdgcn_cvt_pk_fp8_f32(sat8(o2[2]), sat8(o2[3]), w2, true);
                              char* os_ = QS + (bj * 32 + n * 16 + fr) * 80 + ax * 32 + fq * 4; *(int*)os_ = w1; *(int*)(os_ + 16) = w2; }
                        }
                    }
#pragma unroll 1
                for (int j = 0; j < 4; ++j) { const int c = lane + 64 * j, lr = c >> 2, col = (c & 3) * 16;
                    const int row = tt * 256 + (lr >> 5) * 128 + wc * 32 + (lr & 31);
                    int b, t, s_; if (lat) { b = row >> 11; t = row & 2047; s_ = CTX + t; } else { const int rc = row - NTOK; b = rc >> 8; t = 0; s_ = rc & 255; }
                    unsigned char* dst = isq ? (unsigned char*)Qo + ((size_t)(b * 8 + g64) * SEQ + t) * 64 : (unsigned char*)Ko + ((size_t)(b * 2 + (g64 - 8)) * STOT + s_) * 64;
                    *(u32x4*)(dst + col) = *(const u32x4*)(QS + lr * 80 + col); }
            } else if (g64 < 12) {
#pragma unroll
                for (int bj = 0; bj < 2; ++bj)
#pragma unroll
                    for (int n = 0; n < 2; ++n) {
                        const int row = tt * 256 + bj * 128 + wc * 32 + n * 16 + fr;
                        int b, s_; if (lat) { b = row >> 11; s_ = CTX + (row & 2047); } else { const int rc = row - NTOK; b = rc >> 8; s_ = rc & 255; }
                        unsigned char* vp = (unsigned char*)Vo + ((size_t)(b * 2 + (g64 - 10)) * 64) * STOT + s_;
#pragma unroll
                        for (int m = 0; m < 4; ++m)
#pragma unroll
                            for (int j = 0; j < 4; ++j) vp[(size_t)(m * 16 + fq * 4 + j) * STOT] = (unsigned char)__builtin_amdgcn_cvt_pk_fp8_f32(sat8(acc[ai][bj][m][n][j]), 0.f, 0, false);
                    }
            } else {
                const bool isz = g64 >= 20;
                char* OS = lds + (wid < 3 ? 32768 + wid * 9216 : 98304 + (wid - 3) * 9216);
#pragma unroll
                for (int bj = 0; bj < 2; ++bj)
#pragma unroll
                    for (int n = 0; n < 2; ++n)
#pragma unroll
                        for (int m = 0; m < 4; ++m) { f32x4 v = acc[ai][bj][m][n];
                            if (isz) { v[0] = gelu_tanh(v[0]); v[1] = gelu_tanh(v[1]); v[2] = gelu_tanh(v[2]); v[3] = gelu_tanh(v[3]); }
                            *(u32x2*)(OS + (bj * 32 + n * 16 + fr) * 144 + m * 32 + fq * 8) = (u32x2){pk2(v[0], v[1]), pk2(v[2], v[3])}; }
#pragma unroll
                for (int j = 0; j < 8; ++j) { const int c = lane + 64 * j, lr = c >> 3, col = (c & 7) * 16;
                    const int row = tt * 256 + (lr >> 5) * 128 + wc * 32 + (lr & 31);
                    char* dst;
                    if (isz) dst = (char*)(Zo + (size_t)row * DLRU + (g64 - 20) * 64);
                    else { int b, s_; if (lat) { b = row >> 11; s_ = CTX + (row & 2047); } else { const int rc = row - NTOK; b = rc >> 8; s_ = rc & 255; }
                        dst = (char*)(Lo + ((size_t)b * STOT + s_) * DLRU + (g64 - 12) * 64); }
                    *(u32x4*)(dst + col) = *(const u32x4*)(OS + lr * 144 + col); }
            }
        }
        __syncthreads();
    }
    {
        unsigned* ctr = (unsigned*)(ws + WS_CTL) + CTL_UVCTR;
        volatile int* slot = (volatile int*)lds;
        for (;;) {
            if (tid == 0) *slot = (int)__hip_atomic_fetch_add(ctr, 1u, __ATOMIC_RELAXED, __HIP_MEMORY_SCOPE_AGENT);
            __syncthreads();
            const int t = *slot;
            __syncthreads();
            if (t >= UV_ITEMS) break;
            conv_uv_item(a, t);
        }
    }
}

constexpr int AT_K8 = 80;
constexpr int AT_KP = 144, AT_VP = 136, AT_STAGE = 64 * AT_KP + 64 * AT_VP;
__device__ __forceinline__ void attn_item(const Args& a, char* lds, int b, int head, int qblk) {
    int tid = threadIdx.x; asm volatile("" : "+v"(tid));
    const int lane = tid & 63, wid = tid >> 6, r32 = lane & 31, hi = lane >> 5;
    unsigned char* ws = a.ws;
    const int kvh = head >> 2;
    const unsigned char* Qp = ws + WS_Q + ((size_t)(b * 8 + head) * SEQ + qblk * 256 + wid * 32 + r32) * 64 + hi * 32;
    const unsigned char* Kp = ws + WS_K + (size_t)(b * 2 + kvh) * STOT * 64;
    const unsigned char* Vp = ws + WS_VV + (size_t)(b * 2 + kvh) * 64 * STOT;
    i32x8 qf;
    { const i32x4 q0 = *(const i32x4*)Qp, q1 = *(const i32x4*)(Qp + 16); qf = __builtin_shufflevector(q0, q1, 0, 1, 2, 3, 4, 5, 6, 7); }
    const int srow = tid >> 3, sch = tid & 7;
    const unsigned char* kg = Kp + (size_t)srow * 64 + sch * 8;
    const unsigned char* vg = Vp + (size_t)srow * STOT + sch * 8;
    u32x2 krA, krB, vrA, vrB;
    f32x16 o[2]; float lsum = 0.f;
    float negM;
    { float gq = fabsf(a.in[I_QNG][lane]), gk = fabsf(a.in[I_KNG][lane]);
#pragma unroll
      for (int o_ = 32; o_ > 0; o_ >>= 1) { gq = fmaxf(gq, __shfl_xor(gq, o_)); gk = fmaxf(gk, __shfl_xor(gk, o_)); }
      negM = -(64.f * 0.125f * 1.4426950408889634f * 1.01f) * gq * gk; }
#pragma unroll
    for (int dt = 0; dt < 2; ++dt)
#pragma unroll
        for (int r = 0; r < 16; ++r) o[dt][r] = 0.f;
    char* KS = lds; char* VS = lds + 2 * 64 * AT_K8;
#define A_LOADK(X, s0) do { kr##X = *(const u32x2*)(kg + (size_t)(s0) * 64); } while (0)
#define A_LOADV(X, s0) do { vr##X = *(const u32x2*)(vg + (s0)); } while (0)
#define A_WRITEK(X, st) do { *(u32x2*)(KS + (st) * 64 * AT_K8 + srow * AT_K8 + sch * 8) = kr##X; } while (0)
#define A_WRITEV(X, st) do { char* vb_ = VS + (st) * 64 * AT_K8 + srow * AT_K8 + (sch >> 2) * 16 + (sch & 3) * 4; *(unsigned*)vb_ = vr##X[0]; *(unsigned*)(vb_ + 32) = vr##X[1]; } while (0)
    constexpr int NT = STOT / 64;
    f32x16 sc[2], sn[2];
    A_LOADK(A, 0); A_LOADV(A, 0); A_WRITEK(A, 0); A_WRITEV(A, 0); A_LOADK(A, 64); A_WRITEK(A, 1); A_LOADK(B, 128); A_LOADV(B, 64); __syncthreads();
    f32x16 negv;
#pragma unroll
    for (int r = 0; r < 16; ++r) negv[r] = negM;
#define A_SCORE(dst, kbase, kt) do { const char* kp_ = (kbase) + ((kt) * 32 + r32) * AT_K8 + hi * 32; const i32x4 k0_ = *(const i32x4*)kp_, k1_ = *(const i32x4*)(kp_ + 16); \
        dst = __builtin_amdgcn_mfma_scale_f32_32x32x64_f8f6f4(__builtin_shufflevector(k0_, k1_, 0, 1, 2, 3, 4, 5, 6, 7), qf, negv, 0, 0, 0, 127, 0, 124); } while (0)
#pragma unroll
    for (int kt = 0; kt < 2; ++kt) A_SCORE(sc[kt], KS, kt);
    __syncthreads();
    f32x16 ol;
#pragma unroll
    for (int r = 0; r < 16; ++r) ol[r] = 0.f;
    const i32x8 ones8 = {0x38383838, 0x38383838, 0x38383838, 0x38383838, 0x38383838, 0x38383838, 0x38383838, 0x38383838};
#define A_STEP(J, SC, SN, XW, XL) do { const int j_ = (J); \
        const int jk = (j_ + 3 < NT) ? j_ + 3 : NT - 1, jv = (j_ + 2 < NT) ? j_ + 2 : NT - 1; \
        A_LOADK(XL, jk * 64); A_LOADV(XL, jv * 64); \
        const char* ksn = KS + ((j_ + 1) & 1) * 64 * AT_K8; const char* vs = VS + (j_ & 1) * 64 * AT_K8; \
        _Pragma("unroll") for (int kt = 0; kt < 2; ++kt) { \
            A_SCORE(SN[kt], ksn, kt); \
            _Pragma("unroll") for (int e = 0; e < 16; ++e) { SC[kt][e] = __builtin_amdgcn_exp2f(SC[kt][e]); } \
            __builtin_amdgcn_sched_barrier(0); } \
        { i32x8 pb;   \
          float mx_ = fmaxf(SC[0][0], SC[0][1]); \
          _Pragma("unroll") for (int r = 2; r < 16; r += 2) mx_ = fmaxf(fmaxf(mx_, SC[0][r]), SC[0][r + 1]); \
          _Pragma("unroll") for (int r = 0; r < 16; r += 2) mx_ = fmaxf(fmaxf(mx_, SC[1][r]), SC[1][r + 1]); \
          const int psc_ = min(max((int)((__float_as_uint(mx_) >> 23) & 255u) - 7, 1), 254);        \
          const float pscf_ = __uint_as_float((unsigned)psc_ << 23); \
          _Pragma("unroll") for (int kt = 0; kt < 2; ++kt) _Pragma("unroll") for (int g = 0; g < 4; ++g) { \
                int u_; asm volatile("" : "=v"(u_));   \
                s16x2 w_ = __builtin_bit_cast(s16x2, u_); w_ = __builtin_amdgcn_cvt_scalef32_pk_fp8_f32(w_, SC[kt][4 * g], SC[kt][4 * g + 1], pscf_, false); \
                w_ = __builtin_amdgcn_cvt_scalef32_pk_fp8_f32(w_, SC[kt][4 * g + 2], SC[kt][4 * g + 3], pscf_, true); pb[kt * 4 + g] = __builtin_bit_cast(int, w_); } \
          _Pragma("unroll") for (int dt = 0; dt < 2; ++dt) { \
                const char* vp = vs + (dt * 32 + r32) * AT_K8 + hi * 32; \
                const i32x4 v0_ = *(const i32x4*)vp, v1_ = *(const i32x4*)(vp + 16); \
                o[dt] = __builtin_amdgcn_mfma_scale_f32_32x32x64_f8f6f4(__builtin_shufflevector(v0_, v1_, 0, 1, 2, 3, 4, 5, 6, 7), pb, o[dt], 0, 0, 0, 127, 0, psc_); } \
          ol = __builtin_amdgcn_mfma_scale_f32_32x32x64_f8f6f4(ones8, pb, ol, 0, 0, 0, 127, 0, psc_); } \
        A_WRITEK(XW, j_ & 1); A_WRITEV(XW, (j_ + 1) & 1); \
        __syncthreads(); } while (0)
#pragma unroll 1
    for (int j = 0; j < NT; j += 2) { A_STEP(j, sc, sn, B, A); A_STEP(j + 1, sn, sc, A, B); }
#undef A_STEP
    lsum = ol[0];
#undef A_LOADK
#undef A_LOADV
#undef A_WRITEK
#undef A_WRITEV
    const float inv = fast_rcp(lsum);
    char* OS = lds + 4 * 64 * AT_K8 + wid * (32 * 144);
#pragma unroll
    for (int dt = 0; dt < 2; ++dt)
#pragma unroll
        for (int g = 0; g < 4; ++g) {
            u32x2 v = {pk2(o[dt][4 * g] * inv, o[dt][4 * g + 1] * inv), pk2(o[dt][4 * g + 2] * inv, o[dt][4 * g + 3] * inv)};
            *(u32x2*)(OS + r32 * 144 + (dt * 32 + g * 8 + hi * 4) * 2) = v;
        }
    char* outb = (char*)((bf16_t*)(ws + WS_A2) + ((size_t)b * SEQ + qblk * 256 + wid * 32) * KOUT + head * 64);
#pragma unroll
    for (int j = 0; j < 4; ++j) { const int c = lane + 64 * j, row = c >> 3, col = (c & 7) * 16;
        const u32x4 q = *(const u32x4*)(OS + row * 144 + col);
        *(u32x4*)(outb + (size_t)row * (KOUT * 2) + col) = q; }
}

constexpr int LR_RAW = 0;
constexpr int LR_U   = 33792;
constexpr int LR_BB  = LR_U + 33280;
constexpr int LR_UB  = LR_BB + 33280;
constexpr int LR_WG  = LR_UB + 18432;
constexpr int LR_SEG = LR_WG + 18432;
constexpr int LR_HC  = LR_SEG + 4096;
constexpr int LR_CST = LR_HC + 512;
constexpr int LR_END = LR_CST + 768;
__device__ __forceinline__ void lru_item(const Args& a, char* lds, int b, int n, int d) {
    int tid = threadIdx.x; asm volatile("" : "+v"(tid));
    const int lane = tid & 63, wid = tid >> 6, r32 = lane & 31, hi = lane >> 5;
    unsigned char* ws = a.ws;
    float* RAW = (float*)(lds + LR_RAW); float* AA = (float*)(lds + LR_RAW); float* U = (float*)(lds + LR_U); float* BB = (float*)(lds + LR_BB);
    char* UB = lds + LR_UB; char* WG = lds + LR_WG; float* SEG = (float*)(lds + LR_SEG); float* HC = (float*)(lds + LR_HC);
    const bf16_t* Lg = (const bf16_t*)(ws + WS_L) + (size_t)b * STOT * DLRU + n * 64;
    const bf16_t* Zg = (const bf16_t*)(ws + WS_ZG) + (size_t)b * SEQ * DLRU + n * 64;
    bf16_t* Og = (bf16_t*)(ws + WS_A2) + (size_t)b * SEQ * KOUT + 512 + n * 64;
    {
        const bf16_t* wsrc = (const bf16_t*)(ws + WS_RGW) + (size_t)(d * 8 + n) * 128 * 64;
#pragma unroll
        for (int i = 0; i < 2; ++i) { const int c = tid + NTHR * i, r = c >> 3, ch = c & 7; *(u32x4*)(WG + r * 144 + ch * 16) = *(const u32x4*)(wsrc + r * 64 + ch * 8); }
        if (tid < 128) HC[tid] = 0.f;
    }
    const int ct = wid & 1, tt = wid >> 1;
    float* CST = (float*)(lds + LR_CST);
    constexpr float LOG2E = 1.4426950408889634f;
    if (tid < 64) { const int c = n * 64 + tid; CST[tid] = -LOG2E * a.in[I_RGBA][d * 512 + c]; CST[64 + tid] = -LOG2E * a.in[I_RGBI][d * 512 + c];
        const float x = -a.in[I_RGLAM][d * 512 + c]; CST[128 + tid] = -8.f * LOG2E * (fmaxf(x, 0.f) + log1pf(__expf(-fabsf(x)))); }
    const int sc = tid & 63, sg = tid >> 6;
    const float cw0 = a.in[I_CONVW][0 * 512 + n * 64 + sc], cw1 = a.in[I_CONVW][1 * 512 + n * 64 + sc], cw2 = a.in[I_CONVW][2 * 512 + n * 64 + sc], cw3 = a.in[I_CONVW][3 * 512 + n * 64 + sc];
    const float cbias = a.in[I_CONVB][n * 64 + sc];
#define LRU_TILE(step_, isctx_, sb_, sl_, t0_) const bool isctx_ = (step_) < 2; const int sb_ = isctx_ ? 0 : CTX, sl_ = isctx_ ? CTX : SEQ, \
        t0_ = (isctx_ ? (d == 0 ? (step_) : 1 - (step_)) : (d == 0 ? (step_) - 2 : 17 - (step_))) * 128
#define LRU_FETCH(pre_, sb_, sl_, t0_) do { _Pragma("unroll") for (int i_ = 0; i_ < 3; ++i_) { const int e_ = min(tid + NTHR * i_, 131 * 8 - 1), t_ = min(max((t0_) - 2 + (e_ >> 3), 0), (sl_) - 1); \
        pre_[i_] = *(const u32x4*)(Lg + (size_t)((sb_) + t_) * DLRU + (e_ & 7) * 8); } } while (0)
#define LRU_SPREAD(pre_, sl_, t0_) do { _Pragma("unroll") for (int i_ = 0; i_ < 3; ++i_) { const int e_ = tid + NTHR * i_, t_ = (t0_) - 2 + (e_ >> 3); if (e_ < 131 * 8) { float* dst = RAW + (e_ >> 3) * 64 + (e_ & 7) * 8; \
        const bool in_ = t_ >= 0 && t_ < (sl_); const u32x4 v = pre_[i_]; f32x4 lo_ = {bflo(v[0]), bfhi(v[0]), bflo(v[1]), bfhi(v[1])}, hi_ = {bflo(v[2]), bfhi(v[2]), bflo(v[3]), bfhi(v[3])}; \
        if (!in_) { lo_ = (f32x4){0.f, 0.f, 0.f, 0.f}; hi_ = lo_; } *(f32x4*)dst = lo_; *(f32x4*)(dst + 4) = hi_; } } } while (0)
    u32x4 pre[3];
    { LRU_TILE(0, c0_, sb0_, sl0_, t00_); LRU_FETCH(pre, sb0_, sl0_, t00_); LRU_SPREAD(pre, sl0_, t00_); }
    __syncthreads();
    int par = 0;
    for (int step = 0; step < 18; ++step) {
        LRU_TILE(step, isctx, sb, sl, t0);
        LRU_TILE(step < 17 ? step + 1 : 17, c1_, sb1_, sl1_, t01_);
        LRU_FETCH(pre, sb1_, sl1_, t01_);

        {
            const float* rp = RAW + (sg * 16) * 64 + sc;
            float x0 = rp[0], x1 = rp[64], x2 = rp[128];
            float* up = U + (sg * 16) * 65 + sc; char* ubp = UB + (sg * 16) * 144 + sc * 2;
#pragma unroll
            for (int i = 0; i < 16; ++i) { const float x3 = rp[(i + 3) * 64];
                const float u = cbias + cw0 * x0 + cw1 * x1 + cw2 * x2 + cw3 * x3;
                up[i * 65] = u; *(bf16_t*)(ubp + i * 144) = f2bf(u); x0 = x1; x1 = x2; x2 = x3; }
        }
        __syncthreads();
        {
            f32x16 ga, gi;
#pragma unroll
            for (int r = 0; r < 16; ++r) { ga[r] = 0.f; gi[r] = 0.f; }
#pragma unroll
            for (int ks = 0; ks < 4; ++ks) {
                const bf16x8 wa = *(const bf16x8*)(WG + (ct * 32 + r32) * 144 + (ks * 16 + hi * 8) * 2);
                const bf16x8 wi = *(const bf16x8*)(WG + (64 + ct * 32 + r32) * 144 + (ks * 16 + hi * 8) * 2);
                const bf16x8 ub = *(const bf16x8*)(UB + (tt * 32 + r32) * 144 + (ks * 16 + hi * 8) * 2);
                ga = MFMA(wa, ub, ga); gi = MFMA(wi, ub, gi);
            }
            const int t = tt * 32 + r32;
#pragma unroll
            for (int r = 0; r < 16; ++r) { const int c = ct * 32 + 8 * (r >> 2) + 4 * hi + (r & 3);
                const float rr = fast_rcp(1.f + __builtin_amdgcn_exp2f(__builtin_fmaf(ga[r], -LOG2E, CST[c]))), ii = fast_rcp(1.f + __builtin_amdgcn_exp2f(__builtin_fmaf(gi[r], -LOG2E, CST[64 + c])));
                const float av = __builtin_amdgcn_exp2f(CST[128 + c] * rr), mult = __builtin_amdgcn_sqrtf(fmaxf(1.f - av * av, 0.f));
                const float u = U[t * 65 + c];
                AA[t * 65 + c] = av; BB[t * 65 + c] = mult * ii * u; }
        }
        __syncthreads();
        us2 zv[8];
        {
            const int tfirst = d == 0 ? sg * 16 : 127 - sg * 16;
            const bf16_t* zp = Zg + (size_t)(t0 + tfirst) * DLRU + sc; const int zstep = d == 0 ? DLRU : -DLRU;
#pragma unroll
            for (int k = 0; k < 16; ++k) zv[k >> 1][k & 1] = *(const unsigned short*)(zp + k * zstep);
        }
        us2 ov[8];
        {
            const int tfirst = d == 0 ? sg * 16 : 127 - sg * 16;
            const bf16_t* op0 = Og + (size_t)(t0 + tfirst) * KOUT + sc; const int ostep0 = d == 0 ? KOUT : -KOUT;
#pragma unroll
            for (int k = 0; k < 16; ++k) ov[k >> 1][k & 1] = *(const unsigned short*)(op0 + k * ostep0);
        }
        float av[16], bv[16]; float Ap = 1.f, Bp = 0.f;
#pragma unroll
        for (int k = 0; k < 16; ++k) { const int p = sg * 16 + k, t = d == 0 ? p : 127 - p; av[k] = AA[t * 65 + sc]; bv[k] = BB[t * 65 + sc]; Bp = av[k] * Bp + bv[k]; Ap = av[k] * Ap; }
        SEG[sg * 64 + sc] = Ap; SEG[512 + sg * 64 + sc] = Bp;
        __syncthreads();
        float h = HC[par * 64 + sc];
        {
            float sa[7], sb_[7];
#pragma unroll
            for (int s2 = 0; s2 < 7; ++s2) { sa[s2] = SEG[s2 * 64 + sc]; sb_[s2] = SEG[512 + s2 * 64 + sc]; }
#pragma unroll
            for (int s2 = 0; s2 < 7; ++s2) { const bool on = s2 < sg; h = (on ? sa[s2] : 1.f) * h + (on ? sb_[s2] : 0.f); }
        }
        {
            const int tfirst = d == 0 ? sg * 16 : 127 - sg * 16;
            bf16_t* op = Og + (size_t)(t0 + tfirst) * KOUT + sc;
            const int ostep = d == 0 ? KOUT : -KOUT;
#pragma unroll
            for (int k = 0; k < 16; ++k) { h = av[k] * h + bv[k];
                if (!isctx) { const float gz = __uint_as_float((unsigned)zv[k >> 1][k & 1] << 16); *op = f2bf(h * gz + (d == 0 ? 0.f : __uint_as_float((unsigned)ov[k >> 1][k & 1] << 16))); op += ostep; } }
        }
        LRU_SPREAD(pre, sl1_, t01_);
        if (sg == 7) HC[(par ^ 1) * 64 + sc] = h;
        par ^= 1;
        __syncthreads();
    }
}

#ifndef LRU_REPS
#define LRU_REPS 1
#endif
constexpr int LDS_MIXSLOT = 155616;
constexpr int CTL_MIXCTR = 8256;
__device__ __forceinline__ void phase_mixer(const Args& a, char* lds, int vb, int nb) {
    unsigned* ctr = (unsigned*)(a.ws + WS_CTL) + CTL_MIXCTR;
    volatile int* slot = (volatile int*)(lds + LDS_MIXSLOT);
#pragma unroll 1
    for (;;) {
        if (threadIdx.x == 0) *slot = (int)__hip_atomic_fetch_add(ctr, 1u, __ATOMIC_RELAXED, __HIP_MEMORY_SCOPE_AGENT);
        __syncthreads();
        const int it = *slot;
        __syncthreads();
        if (it >= 128) break;
#pragma unroll 1
        for (int d = 0; d < 2; ++d) { lru_item(a, lds, it >> 3, it & 7, d); __syncthreads(); }
    }
#pragma unroll 1
    for (;;) {
        if (threadIdx.x == 0) *slot = (int)__hip_atomic_fetch_add(ctr + 16, 1u, __ATOMIC_RELAXED, __HIP_MEMORY_SCOPE_AGENT);
        __syncthreads();
        const int at = *slot;
        __syncthreads();
        if (at >= 1024) break;
        const int bk = at >> 5, w = at & 31; attn_item(a, lds, bk >> 1, (bk & 1) * 4 + (w >> 3), w & 7); __syncthreads();
    }
}

__device__ __forceinline__ void phase_outproj(const Args& a, char* lds, int vb, int nb) {
    const int tid = threadIdx.x, lane = tid & 63, wid = tid >> 6, wr = wid >> 2, wc = wid & 3, fr = lane & 15, fq = lane >> 4;
    const bf16_t* A2 = (const bf16_t*)(a.ws + WS_A2); const bf16_t* WO = (const bf16_t*)(a.ws + WS_WOUT);
    bf16_t* MIX = (bf16_t*)(a.ws + WS_MIX);
    if (vb < 128 * 4) g8::core_pre(WO, A2, (vb & 3) * 256, (vb >> 2) * 256, KOUT, lds);
#pragma unroll 1
    for (int it = vb; it < 128 * 4; it += nb) {
        const int tt = it >> 2, ft = it & 3;
        f32x4 acc[2][2][4][2];
        g8::core<true>(acc, WO, A2, ft * 256, tt * 256, KOUT, lds);
        if (it + nb < 128 * 4) g8::core_pre(WO, A2, ((it + nb) & 3) * 256, ((it + nb) >> 2) * 256, KOUT, lds);
        char* OS = lds + (wid < 3 ? 32768 + wid * 9216 : 98304 + (wid - 3) * 9216);
#pragma unroll
        for (int ai = 0; ai < 2; ++ai) {
#pragma unroll
            for (int bj = 0; bj < 2; ++bj)
#pragma unroll
                for (int n = 0; n < 2; ++n)
#pragma unroll
                    for (int m = 0; m < 4; ++m) { const f32x4 v = acc[ai][bj][m][n];
                        *(u32x2*)(OS + (bj * 32 + n * 16 + fr) * 144 + m * 32 + fq * 8) = (u32x2){pk2(v[0], v[1]), pk2(v[2], v[3])}; }
            char* ob = (char*)(MIX + (size_t)(tt * 256 + wc * 32) * DM + ft * 256 + ai * 128 + wr * 64);
#pragma unroll
            for (int j = 0; j < 8; ++j) { const int c = lane + 64 * j, row = c >> 3, col = (c & 7) * 16;
                const u32x4 q = *(const u32x4*)(OS + row * 144 + col);
                *(u32x4*)(ob + (size_t)((row >> 5) * 128 + (row & 31)) * (DM * 2) + col) = q; }
        }
        __syncthreads();
    }
}

__device__ __forceinline__ void phase_rowpass(const Args& a, int vb, int nb) {
    const int tid = threadIdx.x, lane = tid & 63, wid = tid >> 6;
    const float* mod = (const float*)(a.ws + WS_MOD);
    const bf16_t* MIX = (const bf16_t*)(a.ws + WS_MIX);
    bf16_t* HX = (bf16_t*)(a.ws + WS_HX2); bf16_t* XM = (bf16_t*)(a.ws + WS_XM);
    const int chunk = (NTOK + nb - 1) / nb, rend = min(NTOK, (vb + 1) * chunk);
    f32x4 G1[4], A2[4], B2[4]; int cur = -1;
    u32x2 mwn[4]; f32x4 xvn[4];
    {
        const int r0 = min(vb * chunk + wid, NTOK - 1);
#pragma unroll
        for (int i = 0; i < 4; ++i) { mwn[i] = __builtin_nontemporal_load((const u32x2*)(MIX + (size_t)r0 * DM + i * 256 + lane * 4)); xvn[i] = __builtin_nontemporal_load((const f32x4*)(a.in[I_X] + (size_t)r0 * DM + i * 256 + lane * 4)); }
    }
    for (int row = vb * chunk + wid; row < rend; row += 8) {
        const int b = row >> 11;
        f32x4 mv[4], xv[4]; float ss = 0.f;
#pragma unroll
        for (int i = 0; i < 4; ++i) { const u32x2 mw = mwn[i]; mv[i] = (f32x4){bflo(mw[0]), bfhi(mw[0]), bflo(mw[1]), bfhi(mw[1])}; xv[i] = xvn[i]; }
        {
            const int rn = min(row + 8, NTOK - 1);
#pragma unroll
            for (int i = 0; i < 4; ++i) { mwn[i] = __builtin_nontemporal_load((const u32x2*)(MIX + (size_t)rn * DM + i * 256 + lane * 4)); xvn[i] = __builtin_nontemporal_load((const f32x4*)(a.in[I_X] + (size_t)rn * DM + i * 256 + lane * 4)); }
        }
        if (b != cur) { cur = b; const float* mrow = mod + (size_t)b * 6144;
#pragma unroll
            for (int i = 0; i < 4; ++i) { const int c = i * 256 + lane * 4;
                const f32x4 gp = *(const f32x4*)(a.in[I_GPOSTMIX] + c), g1 = *(const f32x4*)(mrow + 2048 + c), gf = *(const f32x4*)(a.in[I_GPREFFN] + c), sc = *(const f32x4*)(mrow + 4096 + c);
                B2[i] = *(const f32x4*)(mrow + 3072 + c);
#pragma unroll
                for (int j = 0; j < 4; ++j) { G1[i][j] = g1[j] * gp[j]; A2[i][j] = gf[j] * (1.f + sc[j]); } } }
#pragma unroll
        for (int i = 0; i < 4; ++i) ss += mv[i][0] * mv[i][0] + mv[i][1] * mv[i][1] + mv[i][2] * mv[i][2] + mv[i][3] * mv[i][3];
        ss = wave_sum(ss);
        const float rinv = rsqrtf(ss * (1.f / DM) + EPS);
        float s2 = 0.f;
#pragma unroll
        for (int i = 0; i < 4; ++i) { const int c = i * 256 + lane * 4;
#pragma unroll
            for (int j = 0; j < 4; ++j) { const float xm = xv[i][j] + G1[i][j] * (mv[i][j] * rinv); xv[i][j] = xm; s2 += xm * xm; }
            const u32x2 xw = {pk2(xv[i][0], xv[i][1]), pk2(xv[i][2], xv[i][3])}; *(u32x2*)(XM + (size_t)row * DM + c) = xw; }
        s2 = wave_sum(s2);
        const float rinv2 = rsqrtf(s2 * (1.f / DM) + EPS);
#pragma unroll
        for (int i = 0; i < 4; ++i) { const int c = i * 256 + lane * 4;
            float o[4];
#pragma unroll
            for (int j = 0; j < 4; ++j) o[j] = xv[i][j] * rinv2 * A2[i][j] + B2[i][j];
            u32x2 w = {pk2(o[0], o[1]), pk2(o[2], o[3])}; *(u32x2*)(HX + (size_t)row * DM + c) = w; }
    }
}

__device__ __forceinline__ int fkey(float f) { const int b = __float_as_int(f); return b ^ ((b >> 31) & 0x7fffffff); }
__device__ __forceinline__ float fval(int k) { return __int_as_float(k ^ ((k >> 31) & 0x7fffffff)); }
#define CE_DESC(x, y) do { const int hi_ = max((x), (y)), lo_ = min((x), (y)); (x) = hi_; (y) = lo_; } while (0)
__device__ __forceinline__ void sort16_desc(int (&v)[16]) {
#pragma unroll
    for (int k = 2; k <= 16; k <<= 1)
#pragma unroll
        for (int j = k >> 1; j > 0; j >>= 1)
#pragma unroll
            for (int i = 0; i < 16; ++i) { const int l = i ^ j; if (l > i) { if ((i & k) == 0) { CE_DESC(v[i], v[l]); } else { CE_DESC(v[l], v[i]); } } }
}
__device__ __forceinline__ void merge16_desc(int (&v)[16]) {
#pragma unroll
    for (int j = 8; j > 0; j >>= 1)
#pragma unroll
        for (int i = 0; i < 16; ++i) { const int l = i ^ j; if (l > i) CE_DESC(v[i], v[l]); }
}
__device__ __forceinline__ void top16_merge(int (&A)[16], const int (&B)[16]) {
#pragma unroll
    for (int i = 0; i < 16; ++i) A[i] = max(A[i], B[15 - i]);
    merge16_desc(A);
}
constexpr int PK_X  = 0;
constexpr int PK_ML = 32768;
constexpr int PK_END = 65536;
__device__ __forceinline__ void phase_peer_topk(const Args& a, char* lds, int vb, int nb) {
    unsigned char* ws = a.ws;
    const bf16_t* HX = (const bf16_t*)(ws + WS_HX2); const bf16_t* WQ = (const bf16_t*)(ws + WS_WQ);
    int* IDX = (int*)(ws + WS_IDX);
    int* ML = (int*)(lds + PK_ML); int* XB = (int*)(lds + PK_X);
    for (int it = vb; it < 128 * 8; it += nb) {
        const int rt = it >> 3, h = it & 7, row0 = rt * 256;
        int tid = threadIdx.x;
        {
            f32x4 acc8[2][2][4][2];
            g8::core(acc8, WQ, HX, h * 256, row0, DM, lds);
            __syncthreads();
            asm volatile("" : "+v"(tid));
            const int lane = tid & 63, wid = tid >> 6;
            const int w8r = wid >> 2, w8c = wid & 3, fq = lane >> 4;
            int NL[2][16];
#pragma unroll
            for (int p = 0; p < 2; ++p) {
                int M0[16], M1[16];
#pragma unroll
                for (int bj = 0; bj < 2; ++bj) {
                    int A[16], B[16];
#pragma unroll
                    for (int m = 0; m < 4; ++m)
#pragma unroll
                        for (int i = 0; i < 4; ++i) { const int key = w8r * 64 + m * 16 + fq * 4 + i; const f32x4 v0 = acc8[p][bj][m][0], v1 = acc8[p][bj][m][1];
                            A[m * 4 + i] = (fkey(v0[i]) & ~127) | key; B[m * 4 + i] = (fkey(v1[i]) & ~127) | key; }
                    sort16_desc(A); sort16_desc(B);
#pragma unroll
                    for (int r = 0; r < 16; ++r) { auto rr = __builtin_amdgcn_permlane16_swap((unsigned)A[r], (unsigned)B[r], false, false); A[r] = (int)rr[0]; B[r] = (int)rr[1]; }
                    top16_merge(A, B);
#pragma unroll
                    for (int r = 0; r < 16; ++r) { if (bj == 0) M0[r] = A[r]; else M1[r] = A[r]; }
                }
#pragma unroll
                for (int r = 0; r < 16; ++r) { auto rr = __builtin_amdgcn_permlane32_swap((unsigned)M0[r], (unsigned)M1[r], false, false); M0[r] = (int)rr[0]; M1[r] = (int)rr[1]; }
                top16_merge(M0, M1);
#pragma unroll
                for (int r = 0; r < 16; ++r) NL[p][r] = M0[r];
            }
            int msk = -w8r; asm volatile("" : "+v"(msk));
#pragma unroll
            for (int r = 0; r < 16; ++r) XB[r * 512 + tid] = (NL[0][r] & msk) | (NL[1][r] & ~msk);
            __syncthreads();
            int F[16], G[16];
#pragma unroll
            for (int r = 0; r < 16; ++r) { F[r] = (NL[1][r] & msk) | (NL[0][r] & ~msk); G[r] = XB[r * 512 + (tid ^ 256)]; }
            top16_merge(F, G);
            const int tokf = 128 * (lane >> 5) + 32 * w8c + (lane & 31);
#pragma unroll
            for (int r = 0; r < 16; ++r) ML[(w8r * 16 + r) * 256 + tokf] = F[r];
            __syncthreads();
        }
        if (tid < 256) {
            const int tok = tid;
            int s1[16], s2[16];
#pragma unroll
            for (int r = 0; r < 16; ++r) { s1[r] = ML[r * 256 + tok]; s2[r] = ML[(16 + r) * 256 + tok]; }
            float f1[16], f2[16];
#pragma unroll
            for (int r = 0; r < 16; ++r) { f1[r] = fval(s1[r] & ~127); f2[r] = fval(s2[r] & ~127); }
            int G0[16], G1[16], G2[16], G3[16];
#pragma unroll
            for (int bb = 0; bb < 16; ++bb) G0[bb] = (fkey(f1[0] + f2[bb]) & ~255) | (0 * 16 + bb);
#pragma unroll
            for (int bb = 0; bb < 8; ++bb) G1[bb] = (fkey(f1[1] + f2[bb]) & ~255) | (1 * 16 + bb);
#pragma unroll
            for (int bb = 0; bb < 5; ++bb) G1[8 + bb] = (fkey(f1[2] + f2[bb]) & ~255) | (2 * 16 + bb);
#pragma unroll
            for (int bb = 0; bb < 3; ++bb) G1[13 + bb] = (fkey(f1[3] + f2[bb]) & ~255) | (3 * 16 + bb);
            G2[0] = (fkey(f1[3] + f2[3]) & ~255) | (3 * 16 + 3);
#pragma unroll
            for (int bb = 0; bb < 3; ++bb) G2[1 + bb] = (fkey(f1[4] + f2[bb]) & ~255) | (4 * 16 + bb);
#pragma unroll
            for (int aa = 5; aa < 8; ++aa)
#pragma unroll
                for (int bb = 0; bb < 2; ++bb) G2[4 + (aa - 5) * 2 + bb] = (fkey(f1[aa] + f2[bb]) & ~255) | (aa * 16 + bb);
#pragma unroll
            for (int aa = 8; aa < 14; ++aa) G2[10 + (aa - 8)] = (fkey(f1[aa] + f2[0]) & ~255) | (aa * 16);
            G3[0] = (fkey(f1[14] + f2[0]) & ~255) | (14 * 16); G3[1] = (fkey(f1[15] + f2[0]) & ~255) | (15 * 16);
#pragma unroll
            for (int r = 2; r < 16; ++r) G3[r] = (int)0x80000000;
            sort16_desc(G0); sort16_desc(G1); sort16_desc(G2); sort16_desc(G3);
            top16_merge(G0, G1); top16_merge(G2, G3); top16_merge(G0, G2);
            float tv[16]; float mx = fval(G0[0] & ~255), sum = 0.f;
#pragma unroll
            for (int r = 0; r < 16; ++r) { tv[r] = __expf(fval(G0[r] & ~255) - mx); sum += tv[r]; }
            const float rs = 1.f / sum;
            int ov[16];
#pragma unroll
            for (int r = 0; r < 16; ++r) { const int code = G0[r] & 255, aa = code >> 4, bb = code & 15;
                const int i1 = ML[aa * 256 + tok] & 127, i2 = ML[(16 + bb) * 256 + tok] & 127;
                ov[r] = (i1 * 128 + i2) | (int)((unsigned)f2bf(tv[r] * rs) << 16); }
#pragma unroll
            for (int q = 0; q < 4; ++q) *(i32x4*)(XB + tok * 16 + q * 4) = (i32x4){ov[4 * q], ov[4 * q + 1], ov[4 * q + 2], ov[4 * q + 3]};
        }
        __syncthreads();
#pragma unroll
        for (int j = 0; j < 2; ++j) { const int c = tid + NTHR * j, tk = c >> 2, part = c & 3;
            *(i32x4*)(IDX + ((size_t)(row0 + tk) * 8 + h) * 16 + part * 4) = *(const i32x4*)(XB + tk * 16 + part * 4); }
        __syncthreads();
    }
}

template <int CTRL> __device__ __forceinline__ float dpp_add(float v) { return v + __uint_as_float(__builtin_amdgcn_update_dpp(0u, __float_as_uint(v), CTRL, 0xf, 0xf, true)); }
__device__ __forceinline__ float wave_sum_bcast(float p) {
    p = dpp_add<0xB1>(p); p = dpp_add<0x4E>(p); p = dpp_add<0x141>(p); p = dpp_add<0x140>(p);
    const unsigned u = __float_as_uint(p);
    return (__uint_as_float(__builtin_amdgcn_readlane(u, 0)) + __uint_as_float(__builtin_amdgcn_readlane(u, 16))) + (__uint_as_float(__builtin_amdgcn_readlane(u, 32)) + __uint_as_float(__builtin_amdgcn_readlane(u, 48)));
}
typedef float f32x4v __attribute__((ext_vector_type(4)));
constexpr int P7_RS = 8;
constexpr int P7_NR = PEER_N >> P7_RS;
constexpr int P7_HTP = 1024 + 64;
constexpr float H_SCALE = 16.f;
constexpr int P7_ATP = 2048 + 16;
constexpr float W_SCALE = 16.f;
constexpr int P7_RING = 12288;
constexpr int P7_WLDS = P7_RING + 2048 + 512;
#ifndef P7_UREP
#define P7_UREP 1
#endif
#ifndef P7_UD
#define P7_UD 3
#endif
#ifndef P7_VSYNC
#define P7_VSYNC 16
#endif
#ifndef P7_VMASK
#define P7_VMASK 16383u
#endif
#ifndef P7_VPROBE
#define P7_VPROBE 0
#endif
template <int MODE>
__device__ __forceinline__ void p7_vsweep(f32x16 (&acc)[8], const unsigned* LIST, const unsigned char* VT, int m32, int kh, unsigned psel, unsigned ntok) {
    constexpr unsigned EM = MODE == 1 ? P7_VMASK : 16383u;
    i32x8 abuf[8];
#pragma unroll
    for (int T = 0; T < 8; ++T)
#pragma unroll
        for (int i = 0; i < 16; ++i) acc[T][i] = 0.f;
    u32x4 c0 = *(const u32x4*)(LIST + kh * 8), c1 = *(const u32x4*)(LIST + kh * 8 + 4);
    {
        unsigned off[8];
#pragma unroll
        for (int j = 0; j < 8; ++j) off[j] = (((j < 4 ? c0[j & 3] : c1[j & 3]) & EM) << 10) + m32 * 4;
#pragma unroll
        for (int T = 0; T < 8; ++T) {
#pragma unroll
            for (int j = 0; j < 8; ++j) abuf[T][j] = *(const int*)(VT + off[j] + T * 128);
            __builtin_amdgcn_sched_barrier(0); }
    }
#pragma unroll 1
    for (int bi = 0; bi < 32; ++bi) {
        if (P7_VSYNC && (bi & (P7_VSYNC - 1)) == 0) __syncthreads();
        const int bn = (bi < 31 ? bi + 1 : 31);
        const u32x4 l0 = *(const u32x4*)(LIST + bn * 16 + kh * 8), l1 = *(const u32x4*)(LIST + bn * 16 + kh * 8 + 4);
        unsigned noff[8];
#pragma unroll
        for (int j = 0; j < 8; ++j) noff[j] = (((j < 4 ? l0[j & 3] : l1[j & 3]) & EM) << 10) + m32 * 4;
        i32x8 bop;
#pragma unroll
        for (int j = 0; j < 8; ++j) { const unsigned e = j < 4 ? c0[j & 3] : c1[j & 3];
            bop[j] = (((e >> 14) & 3u) == ntok) ? (int)__builtin_amdgcn_perm(0u, e, psel) : 0; }
        c0 = l0; c1 = l1;
#pragma unroll
        for (int T = 0; T < 8; ++T) {
            __builtin_amdgcn_sched_barrier(0);
            if (MODE != 2) asm volatile("s_waitcnt vmcnt(12)" ::: "memory");
            if (MODE == 1) { int t_ = abuf[T][0];
#pragma unroll
                for (int j = 1; j < 8; ++j) t_ |= abuf[T][j];
                acc[T][0] = __int_as_float(t_ | bop[0]); }
            else acc[T] = __builtin_amdgcn_mfma_scale_f32_32x32x64_f8f6f4(abuf[T], bop, acc[T], 0, 0, 0, 127, 0, 127);
            if (MODE != 2) {
#pragma unroll
                for (int j = 0; j < 8; ++j) abuf[T][j] = *(const int*)(VT + noff[j] + T * 128); }
        }
        __builtin_amdgcn_sched_barrier(0);
    }
    if (MODE != 0) {
#pragma unroll
        for (int T = 0; T < 8; ++T) asm volatile("" :: "v"(acc[T]));
    }
}
__device__ __forceinline__ void phase_peer_gather(const Args& a, char* lds, int vb, int nb) {
    unsigned char* ws = a.ws;
    const bf16_t* HX = (const bf16_t*)(ws + WS_HX2);
    const int* IDX = (const int*)(ws + WS_IDX);
    const float* mod = (const float*)(ws + WS_MOD);
    const unsigned char* UT = ws + WS_UT; const unsigned char* VT = ws + WS_VT;
    const bf16_t* XM = (const bf16_t*)(ws + WS_XM);
    unsigned char* STB = (unsigned char*)lds + 8 * P7_WLDS;
    {
        const int t0 = threadIdx.x;
#pragma unroll
        for (int i = 0; i < 2; ++i) ((u32x4*)STB)[t0 + NTHR * i] = ((const u32x4*)(ws + WS_UT + U6_SCALE_OFF))[t0 + NTHR * i];
        __syncthreads();
    }
#pragma unroll 1
    for (int tb = vb * 32; tb < NTOK; tb += nb * 32) {
        int tid = threadIdx.x; asm volatile("" : "+v"(tid));
        const int lane = tid & 63, wid = tid >> 6, r16 = lane & 15, kg = lane >> 4;
        char* HT = lds + wid * P7_WLDS; unsigned* LIST = (unsigned*)(HT + P7_RING); unsigned char* SCL = (unsigned char*)(HT + P7_RING + 2048); char* AT = HT;
        const int tok0 = tb + wid * 4;
        u32x4 hraw[4][2];
        {
            const bf16_t* hp = HX + (size_t)tok0 * DM + lane * 16;
#pragma unroll
            for (int k = 0; k < 4; ++k) { hraw[k][0] = __builtin_nontemporal_load((const u32x4*)(hp + k * DM)); hraw[k][1] = __builtin_nontemporal_load((const u32x4*)(hp + k * DM + 8)); }
        }
        {
            int* HIST = (int*)HT; int* CUR = HIST + 4 * P7_NR;
            int ee[8];
            const int* ip = IDX + (size_t)tok0 * 128 + lane;
#pragma unroll
            for (int k = 0; k < 4; ++k) { ee[2 * k] = __builtin_nontemporal_load(ip + k * 128); ee[2 * k + 1] = __builtin_nontemporal_load(ip + k * 128 + 64); }
#pragma unroll
            for (int q = 0; q < P7_NR / 16; ++q) HIST[q * 64 + lane] = 0;
#pragma unroll
            for (int j = 0; j < 8; ++j) atomicAdd(&HIST[(((ee[j] >> P7_RS) & (P7_NR - 1)) << 2) | (j >> 1)], 1);
            constexpr int BPL = P7_NR / 16;
            int cnt[BPL]; int inc = 0;
#pragma unroll
            for (int q = 0; q < BPL; ++q) { cnt[q] = HIST[BPL * lane + q]; inc += cnt[q]; }
            const int tot = inc;
#pragma unroll
            for (int o = 1; o < 64; o <<= 1) { const int t = __shfl_up(inc, o); if (lane >= o) inc += t; }
            int run = inc - tot;
#pragma unroll
            for (int q = 0; q < BPL; ++q) { CUR[BPL * lane + q] = run; run += cnt[q]; }
            unsigned usc[8];
#pragma unroll
            for (int j = 0; j < 8; ++j) usc[j] = STB[(unsigned)ee[j] & 16383u];
#pragma unroll
            for (int j = 0; j < 8; ++j) { const unsigned w = (unsigned)ee[j]; const int slot = atomicAdd(&CUR[(((w >> P7_RS) & (P7_NR - 1)) << 2) | (j >> 1)], 1);
                LIST[slot] = (w & 16383u) | ((unsigned)(j >> 1) << 14) | ((w >> 16) << 17); SCL[slot] = (unsigned char)usc[j]; }
        }
#pragma unroll 1
        for (int urep = 0; urep < P7_UREP; ++urep) {
        if (urep) asm volatile("s_waitcnt vmcnt(0)" ::: "memory");
        int hexp[4];
        {
#pragma unroll
            for (int k = 0; k < 4; ++k) { const u32x4 h0 = hraw[k][0], h1 = hraw[k][1];
                float x[16]; float amax = 0.f;
#pragma unroll
                for (int q = 0; q < 4; ++q) { const unsigned wa = q < 2 ? h0[2 * q] : h1[2 * q - 4], wb = q < 2 ? h0[2 * q + 1] : h1[2 * q - 3];
                    x[4 * q] = bflo(wa); x[4 * q + 1] = bfhi(wa); x[4 * q + 2] = bflo(wb); x[4 * q + 3] = bfhi(wb); }
#pragma unroll
                for (int i = 0; i < 16; ++i) amax = fmaxf(amax, fabsf(x[i]));
#pragma unroll
                for (int o_ = 32; o_ > 0; o_ >>= 1) amax = fmaxf(amax, __shfl_xor(amax, o_));
                const int ex = __builtin_amdgcn_readfirstlane(mx_row_exp(amax)); hexp[k] = ex;
                const float inv = __uint_as_float((unsigned)(127 - ex) << 23);
                f32x16 xe, xo;
#pragma unroll
                for (int i = 0; i < 8; ++i) { xe[i] = x[2 * i] * inv; xo[i] = x[2 * i + 1] * inv; xe[8 + i] = 0.f; xo[8 + i] = 0.f; }
                const u32x6 w6 = __builtin_amdgcn_cvt_scalef32_2xpk16_fp6_f32(xe, xo, 1.0f);
                { unsigned* dp = (unsigned*)(HT + k * P7_HTP + lane * 12); dp[0] = w6[0]; dp[1] = w6[1]; dp[2] = w6[2]; }
                __builtin_amdgcn_sched_barrier(0);
            }
        }
        {
            i32x8 hb[8];
            const int hsel = lane & 3;
            const int sbv = 127 + (hsel == 0 ? hexp[0] : hsel == 1 ? hexp[1] : hsel == 2 ? hexp[2] : hexp[3]);
            {
                const char* hp = HT + (lane & 3) * P7_HTP + kg * 24;
#pragma unroll
                for (int kc = 0; kc < 8; ++kc) { const long x0 = *(const long*)(hp + kc * 96), x1 = *(const long*)(hp + kc * 96 + 8), x2 = *(const long*)(hp + kc * 96 + 16);
                    hb[kc] = (i32x8){(int)x0, (int)(x0 >> 32), (int)x1, (int)(x1 >> 32), (int)x2, (int)(x2 >> 32), 0, 0}; }
            }
            unsigned entv = LIST[r16];
            asm volatile("s_waitcnt lgkmcnt(0)" ::: "memory");
            LAS unsigned char* ring = (LAS unsigned char*)lds + __builtin_amdgcn_readfirstlane(wid) * P7_WLDS;
            const int lrow = lane >> 3;
            const unsigned swz = (unsigned)(((lane & 7) ^ (((lrow >> 1) & 3) << 1)) << 4);
            unsigned olo = (((unsigned)__shfl((int)entv, lrow) & 16383u) * (unsigned)U6_ROW) + swz, ohi = (((unsigned)__shfl((int)entv, 8 + lrow) & 16383u) * (unsigned)U6_ROW) + swz;
#pragma unroll
            for (int st = 0; st < 3; ++st) { __builtin_amdgcn_global_load_lds((const unsigned*)(UT + olo + st * 128), (LAS unsigned*)(ring + st * 2048), 16, 0, 0);
                __builtin_amdgcn_global_load_lds((const unsigned*)(UT + ohi + st * 128), (LAS unsigned*)(ring + st * 2048 + 1024), 16, 0, 0); }
            const int rowb = (r16 >> 3) * 1024 + (r16 & 7) * 128, rsw = ((r16 >> 1) & 3) << 1;
            const float pscl = (lane & 12) ? 0.f : 1.f;
#define U6_PIECE(off_) (*(const LAS long*)(ring + (((off_) >> 7) * 2048 + rowb + (((((off_) & 127) >> 4) ^ rsw) << 4) + ((off_) & 8))))
#define U6_KSTEP(kc_) do { const int off_ = 96 * (kc_) + 24 * kg; const long p0_ = U6_PIECE(off_), p1_ = U6_PIECE(off_ + 8), p2_ = U6_PIECE(off_ + 16); \
        const i32x8 av_ = {(int)p0_, (int)(p0_ >> 32), (int)p1_, (int)(p1_ >> 32), (int)p2_, (int)(p2_ >> 32), 0, 0}; \
        D = __builtin_amdgcn_mfma_scale_f32_16x16x128_f8f6f4(av_, hb[kc_], D, 2, 2, 0, scv, 0, sbv); } while (0)
#pragma unroll 1
            for (int bi = 0; bi < 32; ++bi) {
                const unsigned entn = LIST[(bi < 31 ? bi + 1 : 31) * 16 + r16];
                const unsigned nlo = (((unsigned)__shfl((int)entn, lrow) & 16383u) * (unsigned)U6_ROW) + swz, nhi = (((unsigned)__shfl((int)entn, 8 + lrow) & 16383u) * (unsigned)U6_ROW) + swz;
                f32x4v D = {0.f, 0.f, 0.f, 0.f};
                const int scv = (int)SCL[bi * 16 + r16];
#pragma unroll
                for (int ls = 0; ls < 6; ++ls) {
                    asm volatile("" ::: "memory");
                    {
                        const unsigned glo = (ls + 3 < 6 ? olo : nlo) + ((ls + 3) % 6) * 128, ghi = (ls + 3 < 6 ? ohi : nhi) + ((ls + 3) % 6) * 128;
                        __builtin_amdgcn_global_load_lds((const unsigned*)(UT + glo), (LAS unsigned*)(ring + ((ls + 3) % 6) * 2048), 16, 0, 0);
                        __builtin_amdgcn_global_load_lds((const unsigned*)(UT + ghi), (LAS unsigned*)(ring + ((ls + 3) % 6) * 2048 + 1024), 16, 0, 0);
                    }
                    asm volatile("s_waitcnt vmcnt(6)" ::: "memory");
                    if (ls == 0) { U6_KSTEP(0); }
                    if (ls == 1) { U6_KSTEP(1); }
                    if (ls == 2) { U6_KSTEP(2); U6_KSTEP(3); }
                    if (ls == 3) { U6_KSTEP(4); }
                    if (ls == 4) { U6_KSTEP(5); }
                    if (ls == 5) { U6_KSTEP(6); U6_KSTEP(7); }
                }
                olo = nlo; ohi = nhi;
                float dsel = 0.f; unsigned esel = 0u;
#pragma unroll
                for (int i = 0; i < 4; ++i) {
                    const unsigned er = (unsigned)__shfl((int)entv, 4 * kg + i);
                    float m = (((er >> 14) & 3u) == (unsigned)(lane & 3)) ? D[i] * pscl : 0.f;
                    m = dpp_add<0xB1>(m); m = dpp_add<0x4E>(m); m = dpp_add<0x104>(m);
                    const bool pick = (lane & 3) == i; dsel = pick ? m : dsel; esel = pick ? er : esel;
                }
                if ((lane & 12) == 0) {
                    const float w = __uint_as_float((esel >> 17) << 16) * gelu_tanh(dsel) * W_SCALE;
                    const int p0 = __builtin_amdgcn_cvt_pk_fp8_f32(sat8(w), 0.f, 0, false);
                    const float hf = __builtin_amdgcn_cvt_f32_fp8(p0, 0);
                    const int p1 = __builtin_amdgcn_cvt_pk_fp8_f32(sat8((w - hf) * 16.f), 0.f, 0, false);
                    LIST[bi * 16 + 4 * kg + (lane & 3)] = (esel & 0xffffu) | (((unsigned)p0 & 0xffu) << 16) | (((unsigned)p1 & 0xffu) << 24); }
                entv = entn;
            }
        }
        }
        u32x2 xmv[4][4];
        {
            const int m32 = lane & 31, kh = lane >> 5, ntok = m32 >> 3, npart = (m32 >> 2) & 1, nc = m32 & 3;
            const unsigned psel = (0x0c0c0c0cu & ~(0xffu << (8 * nc))) | ((unsigned)(2 + npart) << (8 * nc));
            f32x16 acc[8];
#if P7_VPROBE
            p7_vsweep<P7_VPROBE>(acc, LIST, VT, m32, kh, psel, (unsigned)ntok);
#endif
            p7_vsweep<0>(acc, LIST, VT, m32, kh, psel, (unsigned)ntok);
#pragma unroll
            for (int k = 0; k < 4; ++k)
#pragma unroll
                for (int q4 = 0; q4 < 4; ++q4) xmv[k][q4] = *(const u32x2*)(XM + (size_t)(tok0 + k) * DM + q4 * 256 + lane * 4);
            __builtin_amdgcn_sched_barrier(0);
            const float psc = npart ? V_SCALE / (W_SCALE * T_SCALE * 16.f) : V_SCALE / (W_SCALE * T_SCALE);
            char* arow = AT + ntok * P7_ATP + (16 * kh + nc) * 2;
#pragma unroll
            for (int T = 0; T < 8; ++T)
#pragma unroll
                for (int i = 0; i < 16; ++i) {
                    const float v = acc[T][i] * psc;
                    const float tot = (T & 1) ? dpp_add<0x114>(v) : dpp_add<0x104>(v);
                    if ((T & 1) == npart) *(_Float16*)(arow + (128 * T + 4 * ((i & 3) + 8 * (i >> 2))) * 2) = (_Float16)tot;
                }
        }
#pragma unroll
        for (int k = 0; k < 4; ++k) {
            const int tok = tok0 + k;
            float f[16]; float ss = 0.f;
#pragma unroll
            for (int q4 = 0; q4 < 4; ++q4) { const u32x2 ev = *(const u32x2*)(AT + k * P7_ATP + (q4 * 256 + lane * 4) * 2);
#pragma unroll
                for (int i = 0; i < 2; ++i) { const unsigned cw = ev[i]; const h16x2 hv = as_h2(cw); const int i2 = q4 * 2 + i;
                    f[2 * i2] = (float)hv[0] * (1.f / V_SCALE); f[2 * i2 + 1] = (float)hv[1] * (1.f / V_SCALE); ss += f[2 * i2] * f[2 * i2] + f[2 * i2 + 1] * f[2 * i2 + 1]; } }
            ss = wave_sum_bcast(ss);
            const float rinv = rsqrtf(ss * (1.f / DM) + EPS);
            const float* g2 = mod + (size_t)(tok >> 11) * 6144 + 5120;
#pragma unroll
            for (int q4 = 0; q4 < 4; ++q4) {
                const int c = q4 * 256 + lane * 4;
                const u32x2 xq = xmv[k][q4]; const unsigned x01 = xq[0], x23 = xq[1];
                const f32x4 xm = {bflo(x01), bfhi(x01), bflo(x23), bfhi(x23)}, g2v = *(const f32x4*)(g2 + c), gp = *(const f32x4*)(a.in[I_GPOSTFFN] + c);
                f32x4 o;
#pragma unroll
                for (int jj = 0; jj < 4; ++jj) o[jj] = xm[jj] + g2v[jj] * (f[q4 * 4 + jj] * rinv * gp[jj]);
                *(f32x4*)(a.out + (size_t)tok * DM + c) = o; }
        }
    }
}

#ifdef DBG_DIGEST
__device__ __forceinline__ void phase_digest(const Args& a, int vb, int nb) {
    const bf16_t* A2 = (const bf16_t*)(a.ws + WS_A2);
    const bf16_t* Q = (const bf16_t*)(a.ws + WS_Q); const bf16_t* K = (const bf16_t*)(a.ws + WS_K); const bf16_t* VV = (const bf16_t*)(a.ws + WS_VV);
    const bf16_t* L = (const bf16_t*)(a.ws + WS_L); const bf16_t* ZG = (const bf16_t*)(a.ws + WS_ZG);
    for (size_t e = (size_t)vb * NTHR + threadIdx.x; e < (size_t)NTOK * DM; e += (size_t)nb * NTHR) {
        float v = 0.f;
#if DBG_DIGEST == 3
        const size_t row = e >> 10; const int c = (int)(e & 1023);
        v = bf2f(A2[row * KOUT + c]); if (c < 512) v += bf2f(A2[row * KOUT + 1024 + c]);
#elif DBG_DIGEST == 2
        const size_t h = e % ((size_t)NTOK * 512);
        v = bf2f(Q[h]) + bf2f(ZG[h]) + bf2f(L[e % ((size_t)NB * STOT * 512)]);
        if (e < (size_t)NB * 2 * STOT * 64) v += bf2f(K[e]) + bf2f(VV[e]);
#endif
        a.out[e] = v; }
}
#endif
constexpr int LDS_BYTES = 155648;
constexpr int LDS_BARST = LDS_BYTES - 16;
static_assert(LR_END <= LDS_MIXSLOT && LDS_MIXSLOT + 16 <= LDS_BARST && 8 * P7_HTP <= P7_RING && 4 * P7_ATP <= P7_RING && 8 * P7_WLDS + 16384 <= LDS_BARST && PK_END <= LDS_BARST && LR_END <= LDS_BARST && g8::SHM_B <= LDS_BARST && 17 * 1024 * 4 + 17 * 24 * 4 <= LDS_BARST, "LDS budget");
constexpr int N_PHASES = 8;

__global__ void __launch_bounds__(NTHR, 2) mk_fwd(Args a) {
    extern __shared__ __attribute__((aligned(16))) char lds[];
    const int nb = gridDim.x, bx = blockIdx.x;
    const int vb0 = (nb % 8 == 0) ? (bx % 8) * (nb / 8) + bx / 8 : bx;
    XcdBarrier bar; bar.bar = (unsigned*)(a.ws + WS_CTL); bar.x = 0; bar.st = (volatile LAS unsigned*)(LAS char*)(lds + LDS_BARST);
    const bool multi = (a.ph_hi - a.ph_lo) > 1;
    if (multi) {
        if (threadIdx.x < 4) ((volatile LAS unsigned*)(LAS char*)(lds + LDS_BARST))[threadIdx.x] = 0u;
        __syncthreads();
        bar = xcd_barrier_post((unsigned*)(a.ws + WS_CTL), (volatile LAS unsigned*)(LAS char*)(lds + LDS_BARST));
    }
#ifndef P7_PROBE
#define P7_PROBE -1
#endif
#ifndef DBL_PHASE
#define DBL_PHASE 0
#endif
#if DBL_PHASE != 0
#define RUN_PHASE(P, CALL) do { if (a.ph_lo <= (P) && (P) < a.ph_hi) { const int nrep_ = ((a.dbl >> (P)) & 1) ? 2 : 1; for (int rep_ = 0; rep_ < nrep_; ++rep_) { CALL; if ((P) + 1 < a.ph_hi || rep_ + 1 < nrep_) xcd_barrier(bar); } } } while (0)
#else
#define RUN_PHASE(P, CALL) do { if (a.ph_lo <= (P) && (P) < a.ph_hi) { CALL; if ((P) + 1 < a.ph_hi) xcd_barrier(bar); } } while (0)
#endif
#if !defined(ONLY_PHASE) || ONLY_PHASE == 0
    RUN_PHASE(0, phase_prep(a, lds, vb0, nb));
#endif
    int vb = vb0;
    if (multi && a.ph_lo == 0 && a.ph_hi > 1) {
        if (threadIdx.x == 0) { unsigned off = 0; for (unsigned j = 0; j < bar.x; ++j) off += xb_ld(&bar.bar[XB_XCNT(j)]); bar.st[3] = off + bar.st[2]; }
        __syncthreads();
        vb = (int)bar.st[3];
    }
#if !defined(ONLY_PHASE) || ONLY_PHASE == 1
    RUN_PHASE(1, phase_xn(a, vb, nb));
#endif
#if !defined(ONLY_PHASE) || ONLY_PHASE == 2
    RUN_PHASE(2, phase_inproj(a, lds, vb, nb));
#endif
#if (!defined(ONLY_PHASE) || ONLY_PHASE == 3) && !(defined(DBG_DIGEST) && DBG_DIGEST == 2)
    RUN_PHASE(3, phase_mixer(a, lds, vb, nb));
#endif
#ifdef DBG_DIGEST
    if (a.ph_lo <= 4 && 4 < a.ph_hi) phase_digest(a, vb, nb);
    return;
#endif
#if !defined(ONLY_PHASE) || ONLY_PHASE == 4
    RUN_PHASE(4, phase_outproj(a, lds, vb, nb));
#endif
#if !defined(ONLY_PHASE) || ONLY_PHASE == 5
    RUN_PHASE(5, phase_rowpass(a, vb, nb));
#endif
#if !defined(ONLY_PHASE) || ONLY_PHASE == 6
    RUN_PHASE(6, phase_peer_topk(a, lds, vb, nb));
#endif
#if !defined(ONLY_PHASE) || ONLY_PHASE == 7
    RUN_PHASE(7, phase_peer_gather(a, lds, vb, nb));
#endif
}

extern "C" void kernel_launch(void* const* d_in, const int* in_sizes, int n_in, void* d_out, int out_size, void* d_ws, size_t ws_size, hipStream_t stream) {
    static int grid = 0;
    if (grid == 0) {
        if (n_in != 25 || out_size != NTOK * DM || ws_size < WS_END) { fprintf(stderr, "kernel_launch: unexpected shapes (n_in %d, out %d, ws %zu, need %zu)\n", n_in, out_size, ws_size, (size_t)WS_END); grid = -1; return; }
        int dev = 0, cus = 0;
        if (hipGetDevice(&dev) != hipSuccess || hipDeviceGetAttribute(&cus, hipDeviceAttributeMultiprocessorCount, dev) != hipSuccess) { grid = -1; return; }
        if (hipFuncSetAttribute((const void*)mk_fwd, hipFuncAttributeMaxDynamicSharedMemorySize, LDS_BYTES) != hipSuccess) { fprintf(stderr, "kernel_launch: hipFuncSetAttribute failed\n"); grid = -1; return; }
        (void)hipGetLastError();
        grid = cus;
    }
    if (grid < 0) return;
    (void)hipMemsetAsync((char*)d_ws + WS_CTL, 0, CTL_BYTES, stream);
    Args a{};
    for (int i = 0; i < 25; ++i) a.in[i] = (const float*)d_in[i];
    a.out = (float*)d_out; a.ws = (unsigned char*)d_ws; a.dbl = DBL_PHASE; a.probe = P7_PROBE;
#if MK_N_LAUNCHES == 1
    a.ph_lo = 0; a.ph_hi = N_PHASES;
    hipLaunchKernelGGL(mk_fwd, dim3(grid), dim3(NTHR), LDS_BYTES, stream, a);
#else
    for (int ph = 0; ph < N_PHASES; ++ph) { a.ph_lo = ph; a.ph_hi = ph + 1; hipLaunchKernelGGL(mk_fwd, dim3(grid), dim3(NTHR), LDS_BYTES, stream, a); }
#endif
}
```
